# Optimizing an MI355X kernel written in HIP

```python
import math
import jax, jax.numpy as jnp
from jax import lax
import numpy as np

D_MODEL = 2048
BATCH = 2
SEQ = 8192
DEPTH = 4

N_A_LAYERS = DEPTH // 2
N_B_LAYERS = DEPTH - N_A_LAYERS
NORM_EPS = 1e-6
GDN_HEADS = D_MODEL // 128
GDN_HEAD_DIM = 128
GDN_WIDTH = GDN_HEADS * GDN_HEAD_DIM
GDN_IN_WIDTH = 4 * GDN_WIDTH + 2 * GDN_HEADS
CONV_K = 4
CHUNK = 64
DIFF_HEADS = D_MODEL // 256
DIFF_HEAD_DIM = 128
DIFF_Q_WIDTH = DIFF_HEADS * 2 * DIFF_HEAD_DIM
DIFF_V_WIDTH = DIFF_HEADS * 2 * DIFF_HEAD_DIM
Q_BLOCK = 128
ROPE_THETA = 10000.0
PEER_HEADS = 8
PEER_QUERY_DIM = 256
PEER_HALF = PEER_QUERY_DIM // 2
N_KEYS = 128
N_EXPERTS = N_KEYS * N_KEYS
PEER_TOPK = 16
PEER_TOKEN_BLOCK = 128

kernel_name = 'yoco_gdn_diffattn_peer_adaln'


def rmsnorm(x, g):
    xf = x.astype(jnp.float32)
    y = xf * lax.rsqrt(jnp.mean(xf * xf, axis=-1, keepdims=True) + NORM_EPS)
    return (y * g.astype(jnp.float32)).astype(x.dtype)


def modulate(h, shift, scale):
    return h * (1 + scale[:, None, :]) + shift[:, None, :]


def adaln(c, w, b):
    return jax.nn.silu(c) @ w + b


def l2norm(x):
    xf = x.astype(jnp.float32)
    return xf * lax.rsqrt(jnp.sum(xf * xf, axis=-1, keepdims=True) + NORM_EPS)


def rope_tables(positions):
    inv_freq = ROPE_THETA ** (-jnp.arange(0, DIFF_HEAD_DIM, 2, dtype=jnp.float32) / DIFF_HEAD_DIM)
    ang = positions.astype(jnp.float32)[..., None] * inv_freq
    return jnp.cos(ang), jnp.sin(ang)


def apply_rope(x, cos, sin):
    cos = cos[:, :, None, None, :]
    sin = sin[:, :, None, None, :]
    xf = x.astype(jnp.float32)
    x1, x2 = jnp.split(xf, 2, axis=-1)
    return jnp.concatenate([x1 * cos - x2 * sin, x2 * cos + x1 * sin], axis=-1)


def causal_short_conv(x, w):
    s = x.shape[1]
    xp = jnp.pad(x, ((0, 0), (CONV_K - 1, 0), (0, 0)))
    out = xp[:, 0:s, :] * w[0]
    for i in range(1, CONV_K):
        out = out + xp[:, i:i + s, :] * w[i]
    return out


def chunk_gated_delta_rule(q, k, v, g, beta):
    b, s, nh, dk = q.shape
    dv = v.shape[-1]
    n = s // CHUNK

    def to_chunks(t):
        t = jnp.moveaxis(t.astype(jnp.float32), 2, 1)
        return t.reshape((b, nh, n, CHUNK) + t.shape[3:])

    q, k, v, g, beta = [to_chunks(t) for t in (q, k, v, g, beta)]
    G = jnp.cumsum(g, axis=-1)
    diff = G[..., :, None] - G[..., None, :]
    idx = jnp.arange(CHUNK)
    strict = idx[:, None] > idx[None, :]
    incl = idx[:, None] >= idx[None, :]
    kb = k * beta[..., None]
    L = jnp.einsum('bhnid,bhnjd->bhnij', kb, k) * jnp.exp(jnp.where(strict, diff, -jnp.inf))
    T = L + jnp.eye(CHUNK, dtype=jnp.float32)
    w = lax.linalg.triangular_solve(T, kb * jnp.exp(G)[..., None],
                                    left_side=True, lower=True, unit_diagonal=True)
    u_tilde = lax.linalg.triangular_solve(T, v * beta[..., None],
                                          left_side=True, lower=True, unit_diagonal=True)
    a_qk = jnp.einsum('bhnid,bhnjd->bhnij', q, k) * jnp.exp(jnp.where(incl, diff, -jnp.inf))
    q_g = q * jnp.exp(G)[..., None]
    k_d = k * jnp.exp(G[..., -1:] - G)[..., None]
    g_last = jnp.exp(G[..., -1])

    def step(state, inp):
        w_c, u_c, a_c, q_c, k_c, gl = inp
        u_new = u_c - jnp.einsum('bhck,bhkv->bhcv', w_c, state)
        o = jnp.einsum('bhck,bhkv->bhcv', q_c, state) + jnp.einsum('bhij,bhjv->bhiv', a_c, u_new)
        state = gl[..., None, None] * state + jnp.einsum('bhck,bhcv->bhkv', k_c, u_new)
        return state, o

    xs = tuple(jnp.moveaxis(t, 2, 0) for t in (w, u_tilde, a_qk, q_g, k_d, g_last))
    state0 = jnp.zeros((b, nh, dk, dv), jnp.float32)
    _, o = lax.scan(step, state0, xs)
    o = jnp.moveaxis(o, 0, 2).reshape(b, nh, s, dv)
    return jnp.moveaxis(o, 1, 2)


def gated_deltanet(h, w_in, conv_w, a_log, dt_bias, o_gain, w_out):
    b, s, _ = h.shape
    W = GDN_WIDTH
    proj = h @ w_in
    qkv = jax.nn.silu(causal_short_conv(proj[..., :3 * W], conv_w))
    z = proj[..., 3 * W:4 * W]
    a = proj[..., 4 * W:4 * W + GDN_HEADS]
    beta_logit = proj[..., 4 * W + GDN_HEADS:]
    q, k, v = [t.reshape(b, s, GDN_HEADS, GDN_HEAD_DIM) for t in jnp.split(qkv, 3, axis=-1)]
    q = l2norm(q) * GDN_HEAD_DIM ** -0.5
    k = l2norm(k)
    g = -jnp.exp(a_log.astype(jnp.float32)) * jax.nn.softplus(a.astype(jnp.float32) + dt_bias.astype(jnp.float32))
    beta = jax.nn.sigmoid(beta_logit.astype(jnp.float32))
    o = chunk_gated_delta_rule(q, k, v, g, beta)
    o = rmsnorm(o, o_gain) * jax.nn.silu(z.reshape(b, s, GDN_HEADS, GDN_HEAD_DIM).astype(jnp.float32))
    return o.reshape(b, s, W).astype(h.dtype) @ w_out


def shared_kv(x, c, norm_g, ada_w, ada_b, w_kv, cos, sin):
    b, s, _ = x.shape
    shift, scale = jnp.split(adaln(c, ada_w, ada_b), 2, axis=-1)
    h = modulate(rmsnorm(x, norm_g), shift, scale)
    kv = h @ w_kv
    k = apply_rope(kv[..., :DIFF_Q_WIDTH].reshape(b, s, DIFF_HEADS, 2, DIFF_HEAD_DIM), cos, sin)
    v = kv[..., DIFF_Q_WIDTH:].reshape(b, s, DIFF_HEADS, 2 * DIFF_HEAD_DIM).astype(jnp.float32)
    return jnp.transpose(k, (0, 2, 3, 1, 4)), jnp.transpose(v, (0, 2, 1, 3))


def diff_attention(h, k_sh, v_sh, cos, sin, w_q, lam_p, subln_g, w_out, lambda_init):
    b, s, _ = h.shape
    d = DIFF_HEAD_DIM
    q = apply_rope((h @ w_q).reshape(b, s, DIFF_HEADS, 2, d), cos, sin) * d ** -0.5
    lp = lam_p.astype(jnp.float32)
    lam = jnp.exp(jnp.sum(lp[0] * lp[1])) - jnp.exp(jnp.sum(lp[2] * lp[3])) + lambda_init
    nb = s // Q_BLOCK
    q_blocks = jnp.transpose(q, (0, 2, 3, 1, 4)).reshape(b, DIFF_HEADS, 2, nb, Q_BLOCK, d)
    q_blocks = jnp.moveaxis(q_blocks, 3, 0)
    starts = jnp.arange(nb, dtype=jnp.int32) * Q_BLOCK
    k_pos = jnp.arange(s, dtype=jnp.int32)

    def block(args):
        qb, start = args
        scores = jnp.einsum('bhcqd,bhckd->bhcqk', qb, k_sh)
        mask = k_pos[None, :] <= (start + jnp.arange(Q_BLOCK, dtype=jnp.int32))[:, None]
        p = jax.nn.softmax(jnp.where(mask, scores, -jnp.inf), axis=-1)
        attn = p[:, :, 0] - lam * p[:, :, 1]
        return jnp.einsum('bhqk,bhkv->bhqv', attn, v_sh)

    o = lax.map(block, (q_blocks, starts))
    o = jnp.moveaxis(o, 0, 2).reshape(b, DIFF_HEADS, s, 2 * d)
    o = jnp.moveaxis(o, 1, 2)
    o = rmsnorm(o, subln_g) * (1.0 - lambda_init)
    return o.reshape(b, s, DIFF_V_WIDTH).astype(h.dtype) @ w_out


def peer_ffn(h, w_q, sub_keys, u_tab, v_tab):
    b, s, dm = h.shape
    q = (h @ w_q).reshape(b, s, PEER_HEADS, 2, PEER_HALF).astype(jnp.float32)
    sc = jnp.einsum('bspjd,jnd->bspjn', q, sub_keys.astype(jnp.float32))
    s1, i1 = lax.top_k(sc[..., 0, :], PEER_TOPK)
    s2, i2 = lax.top_k(sc[..., 1, :], PEER_TOPK)
    n_cand = PEER_TOPK * PEER_TOPK
    cand = (s1[..., :, None] + s2[..., None, :]).reshape(b, s, PEER_HEADS, n_cand)
    cidx = (i1[..., :, None] * N_KEYS + i2[..., None, :]).reshape(b, s, PEER_HEADS, n_cand)
    best, pos = lax.top_k(cand, PEER_TOPK)
    idx = jnp.take_along_axis(cidx, pos, axis=-1)
    gate = jax.nn.softmax(best, axis=-1)
    n_sel = PEER_HEADS * PEER_TOPK
    nblk = (b * s) // PEER_TOKEN_BLOCK
    hb = h.reshape(nblk, PEER_TOKEN_BLOCK, dm)
    ib = idx.reshape(nblk, PEER_TOKEN_BLOCK, n_sel)
    gb = gate.reshape(nblk, PEER_TOKEN_BLOCK, n_sel).astype(h.dtype)

    def block(args):
        hx, ix, gx = args
        act = jax.nn.gelu(jnp.einsum('td,ted->te', hx, u_tab[ix]), approximate=False)
        return jnp.einsum('te,ted->td', gx * act, v_tab[ix])

    out = lax.map(block, (hb, ib, gb))
    return out.reshape(b, s, dm)


def setup_inputs(seed: int = 0) -> dict:
    key = jax.random.key(seed)
    ks = jax.random.split(key, 32)
    f32 = jnp.float32

    def nrm(k, shape, scale):
        return jax.random.normal(k, shape, f32) * scale

    def gain(k, shape):
        return 1.0 + 0.02 * jax.random.normal(k, shape, f32)

    D = D_MODEL
    x = nrm(ks[0], (BATCH, SEQ, D), 1.0)
    c = nrm(ks[1], (BATCH, D), 1.0)
    positions = (jax.random.randint(ks[2], (BATCH, 1), 0, 4096, dtype=jnp.int32)
                 + jnp.arange(SEQ, dtype=jnp.int32)[None, :])
    ada_w = nrm(ks[3], (DEPTH, D, 6 * D), 0.5 * D ** -0.5)
    ada_b = nrm(ks[4], (DEPTH, 6 * D), 0.02)
    norm_mix_g = gain(ks[5], (DEPTH, D))
    norm_ffn_g = gain(ks[6], (DEPTH, D))
    gdn_w_in = nrm(ks[7], (N_A_LAYERS, D, GDN_IN_WIDTH), D ** -0.5)
    gdn_conv_w = nrm(ks[8], (N_A_LAYERS, CONV_K, 3 * GDN_WIDTH), CONV_K ** -0.5)
    gdn_a_log = jnp.log(jax.random.uniform(ks[9], (N_A_LAYERS, GDN_HEADS), f32, 1.0, 16.0))
    dt = jnp.exp(jax.random.uniform(ks[10], (N_A_LAYERS, GDN_HEADS), f32, math.log(0.001), math.log(0.1)))
    gdn_dt_bias = dt + jnp.log(-jnp.expm1(-dt))
    gdn_o_gain = gain(ks[11], (N_A_LAYERS, GDN_HEAD_DIM))
    gdn_w_out = nrm(ks[12], (N_A_LAYERS, GDN_WIDTH, D), GDN_WIDTH ** -0.5)
    kv_norm_g = gain(ks[13], (D,))
    kv_ada_w = nrm(ks[14], (D, 2 * D), 0.5 * D ** -0.5)
    kv_ada_b = nrm(ks[15], (2 * D,), 0.02)
    kv_w = nrm(ks[16], (D, DIFF_Q_WIDTH + DIFF_V_WIDTH), D ** -0.5)
    diff_w_q = nrm(ks[17], (N_B_LAYERS, D, DIFF_Q_WIDTH), D ** -0.5)
    diff_lambda = nrm(ks[18], (N_B_LAYERS, 4, DIFF_HEAD_DIM), 0.1)
    diff_subln_g = gain(ks[19], (N_B_LAYERS, 2 * DIFF_HEAD_DIM))
    diff_w_out = nrm(ks[20], (N_B_LAYERS, DIFF_V_WIDTH, D), DIFF_V_WIDTH ** -0.5)
    peer_w_q = nrm(ks[21], (DEPTH, D, PEER_HEADS * PEER_QUERY_DIM), D ** -0.5)
    peer_sub_keys = nrm(ks[22], (DEPTH, 2, N_KEYS, PEER_HALF), PEER_HALF ** -0.5)
    peer_u = nrm(ks[23], (DEPTH, N_EXPERTS, D), D ** -0.5)
    peer_v = nrm(ks[24], (DEPTH, N_EXPERTS, D), PEER_HEADS ** -0.5)
    final_g = gain(ks[25], (D,))
    return {'x': x, 'c': c, 'positions': positions,
            'ada_w': ada_w, 'ada_b': ada_b, 'norm_mix_g': norm_mix_g, 'norm_ffn_g': norm_ffn_g,
            'gdn_w_in': gdn_w_in, 'gdn_conv_w': gdn_conv_w, 'gdn_a_log': gdn_a_log,
            'gdn_dt_bias': gdn_dt_bias, 'gdn_o_gain': gdn_o_gain, 'gdn_w_out': gdn_w_out,
            'kv_norm_g': kv_norm_g, 'kv_ada_w': kv_ada_w, 'kv_ada_b': kv_ada_b, 'kv_w': kv_w,
            'diff_w_q': diff_w_q, 'diff_lambda': diff_lambda, 'diff_subln_g': diff_subln_g,
            'diff_w_out': diff_w_out,
            'peer_w_q': peer_w_q, 'peer_sub_keys': peer_sub_keys, 'peer_u': peer_u, 'peer_v': peer_v,
            'final_g': final_g}


def reference(x, c, positions, ada_w, ada_b, norm_mix_g, norm_ffn_g,
              gdn_w_in, gdn_conv_w, gdn_a_log, gdn_dt_bias, gdn_o_gain, gdn_w_out,
              kv_norm_g, kv_ada_w, kv_ada_b, kv_w,
              diff_w_q, diff_lambda, diff_subln_g, diff_w_out,
              peer_w_q, peer_sub_keys, peer_u, peer_v, final_g):
    cos, sin = rope_tables(positions)
    k_sh, v_sh = None, None
    for l in range(DEPTH):
        sh1, sc1, gt1, sh2, sc2, gt2 = jnp.split(adaln(c, ada_w[l], ada_b[l]), 6, axis=-1)
        h = modulate(rmsnorm(x, norm_mix_g[l]), sh1, sc1)
        if l < N_A_LAYERS:
            y = gated_deltanet(h, gdn_w_in[l], gdn_conv_w[l], gdn_a_log[l], gdn_dt_bias[l],
                               gdn_o_gain[l], gdn_w_out[l])
        else:
            j = l - N_A_LAYERS
            lambda_init = 0.8 - 0.6 * math.exp(-0.3 * l)
            y = diff_attention(h, k_sh, v_sh, cos, sin, diff_w_q[j], diff_lambda[j],
                               diff_subln_g[j], diff_w_out[j], lambda_init)
        x = x + gt1[:, None, :] * y
        h = modulate(rmsnorm(x, norm_ffn_g[l]), sh2, sc2)
        x = x + gt2[:, None, :] * peer_ffn(h, peer_w_q[l], peer_sub_keys[l], peer_u[l], peer_v[l])
        if l == N_A_LAYERS - 1:
            k_sh, v_sh = shared_kv(x, c, kv_norm_g, kv_ada_w, kv_ada_b, kv_w, cos, sin)
    return rmsnorm(x, final_g)
```

```cpp
#include <hip/hip_runtime.h>
#include <hip/hip_bf16.h>
#include <cstdio>
#include <cstdint>

#ifndef MK_N_LAUNCHES
#define MK_N_LAUNCHES 1
#endif
#ifndef MK_DUP
#define MK_DUP 0
#endif
#ifndef MK_SKIP
#define MK_SKIP 0
#endif

constexpr int NB = 2, SEQ = 8192, T = NB * SEQ, D = 2048, DEPTH = 4;
constexpr int GH = 16, GIN = 8224, GINP = 8448;
constexpr int MODC = 4 * 12288 + 4096;
constexpr float NORM_EPS = 1e-6f;

typedef unsigned short bf16_t;
typedef short bf16x8 __attribute__((ext_vector_type(8)));
typedef short s16x4 __attribute__((ext_vector_type(4)));
typedef float f32x4 __attribute__((ext_vector_type(4)));
typedef float f32x2 __attribute__((ext_vector_type(2)));
typedef float f32x16 __attribute__((ext_vector_type(16)));
typedef unsigned u32x4 __attribute__((ext_vector_type(4)));
typedef unsigned u32x2 __attribute__((ext_vector_type(2)));
typedef __bf16 bfx2 __attribute__((ext_vector_type(2)));
#define LAS __attribute__((address_space(3)))
#define DI __device__ __forceinline__

DI float bf2f(bf16_t v) { return __uint_as_float(((unsigned)v) << 16); }
DI float bflo(unsigned w) { return __uint_as_float(w << 16); }
DI float bfhi(unsigned w) { return __uint_as_float(w & 0xffff0000u); }
DI bf16_t f2bf(float f) { unsigned u = __float_as_uint(f); u += 0x7FFFu + ((u >> 16) & 1u); return (bf16_t)(u >> 16); }
DI unsigned cvt_pk_bf16(float lo, float hi) { const f32x2 v = {lo, hi}; return __builtin_bit_cast(unsigned, __builtin_convertvector(v, bfx2)); }
template <int M> DI float sw_xor(float v) { return __int_as_float(__builtin_amdgcn_ds_swizzle(__float_as_int(v), (M << 10) | 0x1f)); }
DI float sw_xor32_sum(float v) { auto rr = __builtin_amdgcn_permlane32_swap(__float_as_uint(v), __float_as_uint(v), false, false); return __uint_as_float(rr[0]) + __uint_as_float(rr[1]); }
DI float wave_max(float v) {
    v = fmaxf(v, sw_xor<1>(v)); v = fmaxf(v, sw_xor<2>(v)); v = fmaxf(v, sw_xor<4>(v)); v = fmaxf(v, sw_xor<8>(v)); v = fmaxf(v, sw_xor<16>(v));
    auto rr = __builtin_amdgcn_permlane32_swap(__float_as_uint(v), __float_as_uint(v), false, false); return fmaxf(__uint_as_float(rr[0]), __uint_as_float(rr[1]));
}
DI float wave_sum(float v) {
    v += sw_xor<1>(v); v += sw_xor<2>(v); v += sw_xor<4>(v); v += sw_xor<8>(v); v += sw_xor<16>(v);
    return sw_xor32_sum(v);
}
DI void lds_barrier() { asm volatile("s_waitcnt lgkmcnt(0)" ::: "memory"); __builtin_amdgcn_s_barrier(); asm volatile("" ::: "memory"); }
DI float silu_f(float v) { return v / (1.f + __expf(-v)); }
DI int lane_id() { int l; asm volatile("v_mbcnt_lo_u32_b32 %0, -1, 0\n\tv_mbcnt_hi_u32_b32 %0, -1, %0" : "=v"(l)); return l; }
DI int ltid(const int wv) { int t = wv * 64 + lane_id(); asm volatile("" : "+v"(t)); return t; }

constexpr size_t al4k(size_t x) { return (x + 4095) & ~(size_t)4095; }
constexpr size_t WS_BAR   = 0;
constexpr size_t WS_MOD   = 16384;
constexpr size_t WS_COS   = al4k(WS_MOD + (size_t)2 * MODC * 4);
constexpr size_t WS_SIN   = WS_COS + (size_t)T * 64 * 4;
constexpr size_t WS_SUBK  = WS_SIN + (size_t)T * 64 * 4;
constexpr size_t WS_WIN   = WS_SUBK + (size_t)4 * 2 * 128 * 128 * 2;
constexpr size_t WS_WOUT  = WS_WIN + (size_t)2 * GINP * D * 2;
constexpr size_t WS_KVW   = WS_WOUT + (size_t)2 * D * D * 2;
constexpr size_t WS_DWQ   = WS_KVW + (size_t)4096 * D * 2;
constexpr size_t WS_DWO   = WS_DWQ + (size_t)2 * D * D * 2;
constexpr size_t WS_PWQ   = WS_DWO + (size_t)2 * D * D * 2;
constexpr size_t WS_PU    = WS_PWQ + (size_t)4 * D * D * 2;
constexpr size_t WS_PUS   = WS_PU + (size_t)16384 * 1024;
constexpr size_t WS_PV    = WS_PU + (size_t)16384 * D * 2;
constexpr size_t WS_PVS   = WS_PV + (size_t)16384 * 1024;
constexpr size_t WS_XCUR  = WS_PV + (size_t)16384 * D * 2;
constexpr size_t WS_HBUF  = WS_XCUR + (size_t)T * D * 4;
constexpr size_t WS_OBUF  = WS_HBUF + (size_t)T * D * 2;
constexpr size_t WS_PROJ  = WS_OBUF + (size_t)T * D * 2;
constexpr size_t WS_PAB   = WS_PROJ + (size_t)T * GINP * 2;
constexpr size_t WS_PQ    = WS_PROJ + (size_t)T * GINP * 2;
constexpr size_t WS_PIDX  = WS_PQ + (size_t)T * D * 2;
constexpr size_t WS_PGATE = WS_PIDX + (size_t)T * 128 * 4;
constexpr size_t WS_GA    = WS_PGATE + (size_t)T * 128 * 4;
constexpr size_t WS_GB    = WS_GA + (size_t)4096 * 128 * 128 * 2;
constexpr size_t WS_GQ    = WS_GB + (size_t)4096 * 128 * 128 * 2;
constexpr size_t WS_GO    = WS_GQ + (size_t)4096 * 64 * 128 * 2;
constexpr size_t WS_GS    = WS_GO + (size_t)4096 * 64 * 128 * 2;
constexpr size_t WS_GL    = WS_GS + (size_t)4096 * 128 * 128 * 2;
constexpr size_t WS_END   = WS_GL + 16384;
constexpr size_t WS_OAT   = WS_GA;
constexpr size_t WS_KSH   = WS_GB;
constexpr size_t WS_VSH   = WS_GB + (size_t)67108864;
constexpr size_t WS_QD    = WS_GQ;

constexpr int LDS_BYTES = 147456;
constexpr int LDS_BARW  = 147456 - 64;

struct Params { const float* in[26]; float* out; unsigned char* ws; int ph_lo, ph_hi; };
typedef const Params __attribute__((address_space(4)))* PK;
#define PK_FRESH(p) asm volatile("" : "+s"(p))

#define XB_TMO      128
#define XB_XCNT(j)  (256  + 64 * (j))
#define XB_XSUB(j)  (1280 + 64 * (j))
#define XB_XGEN(j)  (2304 + 64 * (j))
#define XB_TOP      3328
#define XB_TOPGEN   3392
#define XCD_BAR_WORDS 3456
#define XB_SPIN_CAP (1u << 20)

__device__ __forceinline__ unsigned xb_ld(unsigned* p)              { return __hip_atomic_load(p, __ATOMIC_RELAXED, __HIP_MEMORY_SCOPE_AGENT); }
__device__ __forceinline__ unsigned xb_add(unsigned* p, unsigned v) { return __hip_atomic_fetch_add(p, v, __ATOMIC_RELAXED, __HIP_MEMORY_SCOPE_AGENT); }
__device__ __forceinline__ unsigned xb_xcc_id() { return (unsigned)__builtin_amdgcn_s_getreg((3 << 11) | 20) & 0xFu; }
#define XB_SPIN(cond, bar) do { unsigned _sp = 0; while (cond) { __builtin_amdgcn_s_sleep(1); \
    if ((++_sp & 255u) == 0u) { if (xb_ld(&(bar)[XB_TMO])) break; if (_sp > XB_SPIN_CAP) { atomicAdd(&(bar)[XB_TMO], 1u); break; } } } } while (0)

struct XcdBarrier { unsigned* bar; unsigned x; volatile LAS unsigned* st; int wv; };

__device__ __forceinline__ XcdBarrier xcd_barrier_post(unsigned* bar, volatile LAS unsigned* st, int wv) {
    XcdBarrier b; b.bar = bar; b.x = xb_xcc_id(); b.st = st; b.wv = wv;
    if (wv == 0 && lane_id() == 0) (void)xb_add(&bar[XB_XCNT(b.x)], 1u);
    return b;
}
__device__ __forceinline__ void xcd_barrier_complete(unsigned* bar, unsigned x, unsigned& nloc, unsigned& nx) {
    const unsigned G = gridDim.x * gridDim.y * gridDim.z;
    unsigned sum, cnt, mine, sp = 0u;
    for (;;) {
        sum = 0u; cnt = 0u; mine = 0u;
#pragma unroll
        for (unsigned j = 0; j < 16; ++j) { const unsigned c = xb_ld(&bar[XB_XCNT(j)]); sum += c; cnt += (c > 0u) ? 1u : 0u; mine = (j == x) ? c : mine; }
        if (sum == G) break;
        __builtin_amdgcn_s_sleep(1);
        if ((++sp & 255u) == 0u) { if (xb_ld(&bar[XB_TMO])) break; if (sp > XB_SPIN_CAP) { atomicAdd(&bar[XB_TMO], 1u); break; } }
    }
    nloc = mine > 0u ? mine : 1u; nx = cnt > 0u ? cnt : 1u;
}
__device__ __forceinline__ void xcd_barrier(const XcdBarrier& b) {
    asm volatile("s_waitcnt vmcnt(0)" ::: "memory");
    __syncthreads();
    if (b.wv == 0 && lane_id() == 0) {
        unsigned* bar = b.bar;
        __builtin_amdgcn_s_waitcnt(0);
        unsigned nloc = b.st[0], nx = b.st[1];
        if (nloc == 0u) { xcd_barrier_complete(bar, b.x, nloc, nx); b.st[0] = nloc; b.st[1] = nx; }
        const unsigned old = xb_add(&bar[XB_XSUB(b.x)], 1u);
        const unsigned gen = old / nloc;
        if (old + 1u == (gen + 1u) * nloc) {
            __builtin_amdgcn_fence(__ATOMIC_RELEASE, "agent");
            asm volatile("s_waitcnt vmcnt(0)" ::: "memory");
            const unsigned og = xb_add(&bar[XB_TOP], 1u);
            const unsigned tg = og / nx;
            if (og + 1u == (tg + 1u) * nx) xb_add(&bar[XB_TOPGEN], 1u);
            else XB_SPIN(xb_ld(&bar[XB_TOPGEN]) == tg, bar);
            __builtin_amdgcn_fence(__ATOMIC_ACQUIRE, "agent");
            xb_add(&bar[XB_XGEN(b.x)], 1u);
            asm volatile("s_waitcnt vmcnt(0)" ::: "memory");
        } else {
            XB_SPIN(xb_ld(&bar[XB_XGEN(b.x)]) == gen, bar);
            __builtin_amdgcn_fence(__ATOMIC_ACQUIRE, "agent");
            asm volatile("s_waitcnt vmcnt(0)" ::: "memory");
        }
    }
    __syncthreads();
}

namespace pg8 {
#define PG8_LAS __attribute__((address_space(3)))
constexpr int BM = 256, BK = 64, HALF = 128, HTB = HALF * BK * 2, STAGE_BYTES = 8 * HTB, NXCD = 8, WGM = 8;
__host__ __device__ __forceinline__ int lds_byte(int r, int c) { const int st = (r >> 4) * 2 + (c >> 5), rr = r & 15, cc = c & 31, ob = rr * 64 + cc * 2; return st * 1024 + (ob ^ (((ob >> 9) & 1) << 5)); }
__host__ __device__ __forceinline__ void stage_rc(int b, int& R, int& C) { const int st = b / 1024, sb = b % 1024, swz = sb ^ (((sb >> 9) & 1) << 5); R = (st >> 1) * 16 + swz / 64; C = (st & 1) * 32 + (swz % 64) / 2; }
__host__ __device__ __forceinline__ int perm32(int rho) { const int n = rho >> 4, i = rho & 15; return 8 * (i >> 2) + 4 * n + (i & 3); }
struct Unit { int pm, pn; };
struct Gemm { const bf16_t* A; const bf16_t* Bt; int M, N, K; int ld; int ksplit; };
struct StaticOrder {
    int nM, nN, nwg, G, c;
    __host__ __device__ void init(int M, int N, int G_, int c_) { nM = M / BM; nN = N / BM; nwg = nM * nN; G = G_; c = c_; }
    __host__ __device__ bool next(int i, Unit& u) const {
        const long L = (long)i * G + c; if (L >= nwg) return false;
        int wgid = (int)L; { const int q = nwg / NXCD, r = nwg % NXCD, xcd = wgid % NXCD, off = wgid / NXCD; wgid = (xcd < r ? xcd * (q + 1) : r * (q + 1) + (xcd - r) * q) + off; }
        const int nig = WGM * nN, gid = wgid / nig, fm = gid * WGM, gsz = (nM - fm) < WGM ? (nM - fm) : WGM;
        u.pm = fm + ((wgid % nig) % gsz); u.pn = (wgid % nig) / gsz; return true;
    }
    __device__ __forceinline__ void a_ready(const Unit&) const {}
    __device__ __forceinline__ void done(const Unit&) const {}
};

struct EpiMk {
    static constexpr bool PERM = true, AFTER_DRAIN = false;
    int mode; bf16_t* O; int ldc; const float* xin; const bf16_t* xinb; bf16_t* xout; const float* gate; float gmul;
    bf16_t* O2; int nrope; const float* cosT; const float* sinT;
    float* xoutf;
    __device__ __forceinline__ void operator()(const f32x4 (&acc)[2][2][4][2], const Unit& u, int wr, int wc, int fr, int fq) const {
        const int row0 = u.pm * BM + wr * 64 + fr, col0 = u.pn * BM + wc * 32 + 8 * fq;
        if (mode == 0) {
#pragma unroll
            for (int ai = 0; ai < 2; ++ai)
#pragma unroll
                for (int m = 0; m < 4; ++m) { bf16_t* rowp = O + (size_t)(row0 + ai * HALF + m * 16) * ldc + col0;
#pragma unroll
                    for (int bj = 0; bj < 2; ++bj) { const f32x4 v0 = acc[ai][bj][m][0], v1 = acc[ai][bj][m][1];
                        u32x4 w; w.x = cvt_pk_bf16(v0[0], v0[1]); w.y = cvt_pk_bf16(v0[2], v0[3]); w.z = cvt_pk_bf16(v1[0], v1[1]); w.w = cvt_pk_bf16(v1[2], v1[3]);
                        *(u32x4*)(rowp + bj * HALF) = w; } }
        } else if (mode == 3) {
            if (wc == 0) {
#pragma unroll
                for (int ai = 0; ai < 2; ++ai)
#pragma unroll
                    for (int m = 0; m < 4; ++m) { const int row = row0 + ai * HALF + m * 16; float* dp = xoutf + ((size_t)u.pn * T + row) * 32 + 8 * fq;
                        *(f32x4*)dp = acc[ai][0][m][0]; *(f32x4*)(dp + 4) = acc[ai][0][m][1]; }
            }
        } else if (mode == 2) {
#pragma unroll
            for (int ai = 0; ai < 2; ++ai)
#pragma unroll
                for (int m = 0; m < 4; ++m) { const int row = row0 + ai * HALF + m * 16, bb = row >> 13, ss = row & 8191;
#pragma unroll
                    for (int bj = 0; bj < 2; ++bj) { const int col = col0 + bj * HALF; const f32x4 v0 = acc[ai][bj][m][0], v1 = acc[ai][bj][m][1];
                        if (col < nrope) { const int hc = col >> 7, j0 = ((col & 127) >> 3) * 4;
                            const f32x4 cs = *(const f32x4*)(cosT + (size_t)row * 64 + j0), sn = *(const f32x4*)(sinT + (size_t)row * 64 + j0);
                            bf16_t* dp = O + ((size_t)(bb * 16 + hc) * SEQ + ss) * 128 + j0;
                            u32x2 w1, w2; w1.x = cvt_pk_bf16(v0[0] * cs[0] - v1[0] * sn[0], v0[1] * cs[1] - v1[1] * sn[1]); w1.y = cvt_pk_bf16(v0[2] * cs[2] - v1[2] * sn[2], v0[3] * cs[3] - v1[3] * sn[3]);
                            w2.x = cvt_pk_bf16(v1[0] * cs[0] + v0[0] * sn[0], v1[1] * cs[1] + v0[1] * sn[1]); w2.y = cvt_pk_bf16(v1[2] * cs[2] + v0[2] * sn[2], v1[3] * cs[3] + v0[3] * sn[3]);
                            *(u32x2*)dp = w1; *(u32x2*)(dp + 64) = w2;
                        } else { const int cv = col - nrope, hc = cv >> 7;
                            u32x4 w; w.x = cvt_pk_bf16(v0[0], v0[1]); w.y = cvt_pk_bf16(v0[2], v0[3]); w.z = cvt_pk_bf16(v1[0], v1[1]); w.w = cvt_pk_bf16(v1[2], v1[3]);
                            *(u32x4*)(O2 + ((size_t)(bb * 16 + hc) * SEQ + ss) * 128 + (cv & 127)) = w; } } }
        } else {
#pragma unroll
            for (int ai = 0; ai < 2; ++ai)
#pragma unroll
                for (int m = 0; m < 4; ++m) { const int row = row0 + ai * HALF + m * 16; const float* gp = gate + (size_t)(row >> 13) * MODC + col0;
                    bf16_t* xo = xout + (size_t)row * D + col0;
#pragma unroll
                    for (int bj = 0; bj < 2; ++bj) {
                        const f32x4 g0 = *(const f32x4*)(gp + bj * HALF), g1 = *(const f32x4*)(gp + bj * HALF + 4);
                        f32x4 x0, x1;
                        if (xin) { x0 = *(const f32x4*)(xin + (size_t)row * D + col0 + bj * HALF); x1 = *(const f32x4*)(xin + (size_t)row * D + col0 + bj * HALF + 4); }
                        else { const u32x4 xb = *(const u32x4*)(xinb + (size_t)row * D + col0 + bj * HALF);
                            x0 = (f32x4){bflo(xb.x), bfhi(xb.x), bflo(xb.y), bfhi(xb.y)}; x1 = (f32x4){bflo(xb.z), bfhi(xb.z), bflo(xb.w), bfhi(xb.w)}; }
                        const f32x4 y0 = x0 + gmul * g0 * acc[ai][bj][m][0], y1 = x1 + gmul * g1 * acc[ai][bj][m][1];
                        u32x4 w; w.x = cvt_pk_bf16(y0[0], y0[1]); w.y = cvt_pk_bf16(y0[2], y0[3]); w.z = cvt_pk_bf16(y1[0], y1[1]); w.w = cvt_pk_bf16(y1[2], y1[3]);
                        *(u32x4*)(xo + bj * HALF) = w; } }
        }
    }
};

template <class Epi, class Sched>
__device__ __forceinline__ void gemm_phase(PG8_LAS unsigned char* lds, const Gemm g, const Sched& S, const Epi& E, const int wv) {
    const int tid = ltid(wv), wid = __builtin_amdgcn_readfirstlane(tid >> 6), lane = tid & 63, wr = wid >> 2, wc = wid & 3, fr = lane & 15, fq = lane >> 4;
    const int K = g.K, nt = K / BK, ld = g.ld;
    unsigned voffA[2], voffB[2];
#pragma unroll
    for (int i = 0; i < 2; ++i) { int R, C; stage_rc(tid * 16 + i * 8192, R, C); const int Rb = Epi::PERM ? ((R & ~31) + perm32(R & 31)) : R;
        voffA[i] = (unsigned)(R * ld + C) * 2u; voffB[i] = (unsigned)(Rb * ld + C) * 2u; }
    const size_t kstep = (size_t)(BK * 2);
    const size_t hstep = (size_t)HALF * ld * 2;
    const size_t tstep = 2 * hstep;
    const unsigned ldsw = (unsigned)wid * 1024u;
    const int aoff = lds_byte(wr * 64 + fr, fq * 8), boff = lds_byte(wc * 32 + fr, fq * 8);
#define PG8_SA(b, h) (((b) * 2 + (h)) * HTB)
#define PG8_SB(b, h) ((4 + (b) * 2 + (h)) * HTB)
#define PG8_STAGE(bufoff, gbase, voff) do { _Pragma("unroll") for (int _i = 0; _i < 2; ++_i) \
        __builtin_amdgcn_global_load_lds((const unsigned*)((const char*)(gbase) + (voff)[_i]), (PG8_LAS unsigned*)(lds + (bufoff) + ldsw + _i * 8192), 16, 0, 0); } while (0)
#define PG8_LDA(dst, b, h) do { _Pragma("unroll") for (int m = 0; m < 4; ++m) _Pragma("unroll") for (int k = 0; k < 2; ++k) dst[m][k] = *(const PG8_LAS bf16x8*)(lds + PG8_SA(b, h) + aoff + m * 2048 + k * 1024); } while (0)
#define PG8_LDB(dst, b, h) do { _Pragma("unroll") for (int n = 0; n < 2; ++n) _Pragma("unroll") for (int k = 0; k < 2; ++k) dst[n][k] = *(const PG8_LAS bf16x8*)(lds + PG8_SB(b, h) + boff + n * 2048 + k * 1024); } while (0)
#define PG8_MMA(ai, bj, At, Bt) do { __builtin_amdgcn_s_setprio(1); _Pragma("unroll") for (int m = 0; m < 4; ++m) _Pragma("unroll") for (int n = 0; n < 2; ++n) _Pragma("unroll") for (int k = 0; k < 2; ++k) \
        acc[ai][bj][m][n] = __builtin_amdgcn_mfma_f32_16x16x32_bf16(Bt[n][k], At[m][k], acc[ai][bj][m][n], 0, 0, 0); __builtin_amdgcn_s_setprio(0); } while (0)
#define PG8_WAIT_V(n) asm volatile("s_waitcnt vmcnt(" #n ")" ::: "memory")
#define PG8_WAIT_L(n) asm volatile("s_waitcnt lgkmcnt(" #n ")" ::: "memory")
#define PG8_BAR __builtin_amdgcn_s_barrier()
#define PG8_SCHED __builtin_amdgcn_sched_barrier(0)
    Unit cur, nxt; int ui = 0;
    if (!S.next(0, cur)) return;
    f32x4 acc[2][2][4][2];
#pragma unroll
    for (int a = 0; a < 2; ++a)
#pragma unroll
        for (int b = 0; b < 2; ++b)
#pragma unroll
            for (int m = 0; m < 4; ++m)
#pragma unroll
                for (int n = 0; n < 2; ++n) acc[a][b][m][n] = (f32x4){0.f, 0.f, 0.f, 0.f};
    bf16x8 At[4][2], B0[2][2], B1[2][2];
    const size_t bstep = g.ksplit ? (size_t)K * 2 : tstep, astep = g.ksplit ? (size_t)K * 2 : 0;
    const char* cA = (const char*)g.A + (size_t)cur.pm * tstep + (size_t)cur.pn * astep; const char* cB = (const char*)g.Bt + (size_t)cur.pn * bstep;
    S.a_ready(cur);
    PG8_STAGE(PG8_SB(0, 0), cB, voffB); PG8_STAGE(PG8_SA(0, 0), cA, voffA); PG8_STAGE(PG8_SB(0, 1), cB + hstep, voffB); PG8_STAGE(PG8_SA(0, 1), cA + hstep, voffA);
    if (wr == 1) PG8_BAR;
    PG8_WAIT_V(4); PG8_BAR;
    PG8_STAGE(PG8_SB(1, 0), cB + kstep, voffB); PG8_STAGE(PG8_SA(1, 0), cA + kstep, voffA); PG8_STAGE(PG8_SB(1, 1), cB + hstep + kstep, voffB);
    PG8_WAIT_V(6); PG8_BAR;
    for (;;) {
        const bool has_next = S.next(ui + 1, nxt);
        const char* nA = has_next ? (const char*)g.A + (size_t)nxt.pm * tstep + (size_t)nxt.pn * astep : cA; const char* nB = has_next ? (const char*)g.Bt + (size_t)nxt.pn * bstep : cB;
        for (int t = 0; t < nt; t += 2) {
            const bool last = (t == nt - 2);
            const char* a1 = cA + (size_t)(t + 1) * kstep;
            const char* a2 = last ? nA : cA + (size_t)(t + 2) * kstep; const char* b2 = last ? nB : cB + (size_t)(t + 2) * kstep;
            const char* a3 = a2 + kstep; const char* b3 = b2 + kstep;
            if (last && has_next) S.a_ready(nxt);
            PG8_LDB(B0, 0, 0); PG8_SCHED; PG8_LDA(At, 0, 0); PG8_STAGE(PG8_SA(1, 1), a1 + hstep, voffA);
            PG8_WAIT_L(8); PG8_BAR; PG8_WAIT_L(0); PG8_MMA(0, 0, At, B0); PG8_BAR; PG8_SCHED;
            PG8_LDB(B1, 0, 1); PG8_STAGE(PG8_SB(0, 0), b2, voffB);
            PG8_BAR; PG8_WAIT_L(0); PG8_MMA(0, 1, At, B1); PG8_BAR;
            PG8_LDA(At, 0, 1); PG8_STAGE(PG8_SA(0, 0), a2, voffA);
            PG8_BAR; PG8_WAIT_L(0); PG8_MMA(1, 0, At, B0); PG8_BAR; PG8_SCHED;
            PG8_STAGE(PG8_SB(0, 1), b2 + hstep, voffB);
            PG8_WAIT_V(6); PG8_BAR; PG8_MMA(1, 1, At, B1); PG8_BAR;
            PG8_LDB(B0, 1, 0); PG8_SCHED; PG8_LDA(At, 1, 0); PG8_STAGE(PG8_SA(0, 1), a2 + hstep, voffA);
            PG8_WAIT_L(8); PG8_BAR; PG8_WAIT_L(0); PG8_MMA(0, 0, At, B0); PG8_BAR; PG8_SCHED;
            PG8_LDB(B1, 1, 1); PG8_STAGE(PG8_SB(1, 0), b3, voffB);
            PG8_BAR; PG8_WAIT_L(0); PG8_MMA(0, 1, At, B1); PG8_BAR;
            PG8_LDA(At, 1, 1); PG8_STAGE(PG8_SA(1, 0), a3, voffA);
            PG8_BAR; PG8_WAIT_L(0); PG8_MMA(1, 0, At, B0); PG8_BAR; PG8_SCHED;
            PG8_STAGE(PG8_SB(1, 1), b3 + hstep, voffB);
            PG8_WAIT_V(6); PG8_BAR; PG8_MMA(1, 1, At, B1); PG8_BAR;
        }
        E(acc, cur, wr, wc, fr, fq); S.done(cur);
        if (!has_next) break;
#pragma unroll
        for (int a = 0; a < 2; ++a)
#pragma unroll
            for (int b = 0; b < 2; ++b)
#pragma unroll
                for (int m = 0; m < 4; ++m)
#pragma unroll
                    for (int n = 0; n < 2; ++n) acc[a][b][m][n] = (f32x4){0.f, 0.f, 0.f, 0.f};
        cur = nxt; cA = nA; cB = nB; ++ui;
    }
    PG8_WAIT_V(0);
    if (wr == 0) PG8_BAR;
    PG8_BAR;
#undef PG8_SA
#undef PG8_SB
#undef PG8_STAGE
#undef PG8_LDA
#undef PG8_LDB
#undef PG8_MMA
#undef PG8_WAIT_V
#undef PG8_WAIT_L
#undef PG8_BAR
#undef PG8_SCHED
}
}

namespace att {
constexpr int D = 128;
constexpr float THR = 8.f;
constexpr bool WSKIP = false;
constexpr float SCALE = 0.08838834764831845f;
constexpr int NW = 8, QBLK = 32, KVBLK = 64, QB = NW * QBLK;
constexpr int SHM_V = KVBLK * D * 2, SHM_K = KVBLK * D * 2;
constexpr int LDS_BYTES = 2 * SHM_V + 2 * SHM_K + NW * 64 * 4;
using bf16 = __hip_bfloat16;
template <class A, class Bt> struct same_t { static constexpr bool v = false; };
template <class A> struct same_t<A, A> { static constexpr bool v = true; };
#define KSWZ(row, colB) ((row) * 256 + ((colB) ^ (((row) & 7) << 4)))
#define SBAR() __builtin_amdgcn_sched_barrier(0)
__device__ __forceinline__ int v_st(int k, int c) { const int kk = (k & ~0xC) | ((k & 4) << 1) | ((k & 8) >> 1); return ((kk >> 3) * 4 + (c >> 5)) * 512 + ((kk & 7) * 32 + (c & 31)) * 2; }
__device__ __forceinline__ int v_rd_base(int lane) { return ((lane & 3) << 3) | (((lane >> 2) & 3) << 6) | (((lane >> 4) & 1) << 5) | (((lane >> 5) & 1) << 8); }
constexpr int v_rd_off(int d0, int ks, int half) { return d0 * 512 + ks * 4096 + half * 2048; }
__device__ __forceinline__ int crow(int r, int hi) { return (r & 3) + 8 * (r >> 2) + 4 * hi; }
__device__ __forceinline__ unsigned cvtpk(float lo, float hi) {
    unsigned r; asm volatile("v_cvt_pk_bf16_f32 %0, %1, %2" : "=v"(r) : "v"(lo), "v"(hi)); return r;
}
__device__ __forceinline__ bf16x8 pack8(f32x4 a, f32x4 b) {
    u32x4 w = {cvtpk(a[0], a[1]), cvtpk(a[2], a[3]), cvtpk(b[0], b[1]), cvtpk(b[2], b[3])};
    return *reinterpret_cast<bf16x8*>(&w);
}
template <class T> __device__ __forceinline__ bf16x8 load8(const T* p) {
    if constexpr (same_t<T, float>::v) { return pack8(*(const f32x4*)p, *(const f32x4*)(p + 4)); }
    else { return *reinterpret_cast<const bf16x8*>(p); }
}
__device__ __forceinline__ void mask_tile(f32x16& p0, f32x16& p1, int dq, unsigned W) {
    const float NEG = -__builtin_inff();
#pragma unroll
    for (int r = 0; r < 16; ++r) {
        const int c = (r & 3) + 8 * (r >> 2);
        if ((unsigned)(dq - c) >= W) p0[r] = NEG;
        if ((unsigned)(dq - c - 32) >= W) p1[r] = NEG;
    }
}
__device__ __forceinline__ void partialSM(f32x16& p0, f32x16& p1, float& m_reg, float& mn, float& alpha) {
    float pmax = p0[0]; for (int r = 1; r < 16; ++r) pmax = fmaxf(pmax, p0[r]); for (int r = 0; r < 16; ++r) pmax = fmaxf(pmax, p1[r]);
    { auto rr = __builtin_amdgcn_permlane32_swap(__float_as_uint(pmax), __float_as_uint(pmax), false, false);
      pmax = fmaxf(__uint_as_float(rr[0]), __uint_as_float(rr[1])); }
    constexpr float C2 = 1.4426950408889634f * SCALE;
    if (__builtin_expect(__all((pmax - m_reg) * SCALE <= THR), 1)) { mn = m_reg; alpha = 1.f; }
    else { mn = fmaxf(m_reg, pmax); alpha = __builtin_amdgcn_exp2f((m_reg - mn) * C2); m_reg = mn; }
    const float mnL = -mn * C2;
    for (int r = 0; r < 16; ++r) p0[r] = fmaf(p0[r], C2, mnL); for (int r = 0; r < 16; ++r) p1[r] = fmaf(p1[r], C2, mnL);
    for (int r = 0; r < 16; ++r) p0[r] = __builtin_amdgcn_exp2f(p0[r]);
}
__device__ __forceinline__ void finishSM(f32x16& p0, f32x16& p1, float alpha, float& l_reg, bf16x8& pa0, bf16x8& pa1, bf16x8& pa2, bf16x8& pa3) {
    for (int r = 0; r < 16; ++r) p1[r] = __builtin_amdgcn_exp2f(p1[r]);
    float ps = 0; for (int r = 0; r < 16; ++r) ps += p0[r]; for (int r = 0; r < 16; ++r) ps += p1[r];
    { auto rr = __builtin_amdgcn_permlane32_swap(__float_as_uint(ps), __float_as_uint(ps), false, false);
      ps = __uint_as_float(rr[0]) + __uint_as_float(rr[1]); }
    l_reg = l_reg * alpha + ps;
#define PK4(P, B_, OUT) do { unsigned a0 = cvtpk(P[B_+0], P[B_+1]), a1 = cvtpk(P[B_+2], P[B_+3]);                          \
        unsigned b0 = cvtpk(P[B_+4], P[B_+5]), b1 = cvtpk(P[B_+6], P[B_+7]);                                             \
        auto r0 = __builtin_amdgcn_permlane32_swap(a0, b0, false, false); auto r1 = __builtin_amdgcn_permlane32_swap(a1, b1, false, false); \
        u32x4 w = {r0[0], r1[0], r0[1], r1[1]}; OUT = *reinterpret_cast<bf16x8*>(&w); } while (0)
    PK4(p0, 0, pa0); PK4(p0, 8, pa1); PK4(p1, 0, pa2); PK4(p1, 8, pa3);
#undef PK4
}
template <int KB, bool SK>
__device__ __forceinline__ void qkt(f32x16& p0, f32x16& p1, const char* K_lds, int r32, int hi, const bf16x8* qr, bool act) {
    if (SK && !act) { const float NEG = -__builtin_inff();
#pragma unroll
        for (int r = 0; r < 16; ++r) { p0[r] = NEG; p1[r] = NEG; } return; }
    p0 = f32x16{}; p1 = f32x16{};
    const char* kb[4];
#pragma unroll
    for (int dd = 0; dd < 4; ++dd) kb[dd] = K_lds + KB * SHM_K + KSWZ(r32, (dd * 16 + hi * 8) * 2);
#pragma unroll
    for (int d0 = 0; d0 < 8; ++d0) { const char* a = kb[d0 & 3] + (d0 >> 2) * 128;
        bf16x8 b0 = *reinterpret_cast<const bf16x8*>(a);
        bf16x8 b1 = *reinterpret_cast<const bf16x8*>(a + 32 * 256);
        p0 = __builtin_amdgcn_mfma_f32_32x32x16_bf16(b0, qr[d0], p0, 0, 0, 0);
        p1 = __builtin_amdgcn_mfma_f32_32x32x16_bf16(b1, qr[d0], p1, 0, 0, 0); }
}
template <int VB, bool SK>
__device__ __forceinline__ void pv_tile(f32x16* o, int vb0, bf16x8 pa0, bf16x8 pa1, bf16x8 pa2, bf16x8 pa3, bool act) {
    if (SK && !act) return;
#define TRRD(dst, off) asm volatile("ds_read_b64_tr_b16 %0, %1 offset:%2" : "=&v"(dst) : "v"(vb0), "i"(off) : "memory")
#define PV_D0(d0) do { s16x4 l0, l1, l2, l3, h0, h1, h2, h3; constexpr int b_ = VB * SHM_V + v_rd_off(d0, 0, 0);     \
        TRRD(l0, b_); TRRD(h0, b_ + 2048); TRRD(l1, b_ + 4096); TRRD(h1, b_ + 6144); TRRD(l2, b_ + 8192); TRRD(h2, b_ + 10240); TRRD(l3, b_ + 12288); TRRD(h3, b_ + 14336); \
        asm volatile("s_waitcnt lgkmcnt(0)" ::: "memory"); SBAR();                 \
        o[d0] = __builtin_amdgcn_mfma_f32_32x32x16_bf16(pa0, (bf16x8){l0[0], l0[1], l0[2], l0[3], h0[0], h0[1], h0[2], h0[3]}, o[d0], 0, 0, 0);   \
        o[d0] = __builtin_amdgcn_mfma_f32_32x32x16_bf16(pa1, (bf16x8){l1[0], l1[1], l1[2], l1[3], h1[0], h1[1], h1[2], h1[3]}, o[d0], 0, 0, 0);   \
        o[d0] = __builtin_amdgcn_mfma_f32_32x32x16_bf16(pa2, (bf16x8){l2[0], l2[1], l2[2], l2[3], h2[0], h2[1], h2[2], h2[3]}, o[d0], 0, 0, 0);   \
        o[d0] = __builtin_amdgcn_mfma_f32_32x32x16_bf16(pa3, (bf16x8){l3[0], l3[1], l3[2], l3[3], h3[0], h3[1], h3[2], h3[3]}, o[d0], 0, 0, 0); } while (0)
    PV_D0(0); PV_D0(1); PV_D0(2); PV_D0(3);
#undef PV_D0
#undef TRRD
}

template <class TIn, class TOut> struct BlockRef { const TIn* Q; const TIn* K; const TIn* V; TOut* O; int P0; };
template <class TIn> struct Seam {
    bf16x8 qr[8];
    bf16x8 st_v0, st_v1, st_k0, st_k1; f32x4 sf0, sf1, sf2, sf3;
    f32x4 tq[16];
};
__device__ __forceinline__ int swa_jlo(int P0, int W) { const int lowk = P0 - W + 1; return lowk > 0 ? lowk / KVBLK : 0; }
#define ROW(p, k0, rr) ((p) + (size_t)((k0) + (rr)) * D + sc)
#define VMW() asm volatile("s_waitcnt vmcnt(0)" ::: "memory")
#define VMWN(n) asm volatile("s_waitcnt vmcnt(%0)" :: "i"(n) : "memory")
#define SLOAD_H(Kp, Vp, k0) do { S.st_v0 = load8<TIn>(ROW(Vp, k0, sr)); S.st_v1 = load8<TIn>(ROW(Vp, k0, 32 + sr));              \
                         S.st_k0 = load8<TIn>(ROW(Kp, k0, sr)); S.st_k1 = load8<TIn>(ROW(Kp, k0, 32 + sr)); } while (0)
#define SWRITE_HK(bf) do { *(bf16x8*)(K_lds + (bf) * SHM_K + kws) = S.st_k0; *(bf16x8*)(K_lds + (bf) * SHM_K + kws + 32 * 256) = S.st_k1; } while (0)
#define SWRITE_HV(bf) do { *(bf16x8*)(V_lds + (bf) * SHM_V + vst0) = S.st_v0; *(bf16x8*)(V_lds + (bf) * SHM_V + vst1) = S.st_v1; } while (0)
#define SWRITE_H(bf) do { SWRITE_HV(bf); SWRITE_HK(bf); } while (0)
#define SLOAD_F(p, k0) do { S.sf0 = *(const f32x4*)ROW(p, k0, sr); S.sf1 = *(const f32x4*)(ROW(p, k0, sr) + 4);                \
                            S.sf2 = *(const f32x4*)ROW(p, k0, 32 + sr); S.sf3 = *(const f32x4*)(ROW(p, k0, 32 + sr) + 4); } while (0)
#define SWRITE_KF(bf) do { *(bf16x8*)(K_lds + (bf) * SHM_K + kws) = pack8(S.sf0, S.sf1); *(bf16x8*)(K_lds + (bf) * SHM_K + kws + 32 * 256) = pack8(S.sf2, S.sf3); } while (0)
#define SWRITE_VF(bf) do { *(bf16x8*)(V_lds + (bf) * SHM_V + vst0) = pack8(S.sf0, S.sf1); *(bf16x8*)(V_lds + (bf) * SHM_V + vst1) = pack8(S.sf2, S.sf3); } while (0)
template <class TIn, class TOut>
__device__ __forceinline__ void causal_swa_prime(const BlockRef<TIn, TOut>& cur, int W, char* lds, Seam<TIn>& S, const int wv) {
    constexpr bool F32 = same_t<TIn, float>::v;
    const int tid = ltid(wv), wid = __builtin_amdgcn_readfirstlane(tid >> 6), lane = tid & 63, r32 = lane & 31, hi = lane >> 5;
    const int sr = tid >> 4, sc = (tid & 15) * 8, kws = KSWZ(sr, sc * 2); char* K_lds = lds + 2 * SHM_V;
    const int kb0 = swa_jlo(cur.P0, W) * KVBLK;
    for (int d0 = 0; d0 < 8; ++d0) S.qr[d0] = load8<TIn>(cur.Q + (size_t)(wid * QBLK + r32) * D + d0 * 16 + hi * 8);
    if constexpr (F32) { SLOAD_F((const float*)cur.K, kb0); VMW(); SWRITE_KF(0); SBAR(); SLOAD_F((const float*)cur.V, kb0); }
    else { SLOAD_H(cur.K, cur.V, kb0); VMW(); SWRITE_HK(0); }
    __syncthreads();
}
template <class TIn, class TOut>
__device__ __forceinline__ void causal_swa_block(const BlockRef<TIn, TOut>& cur, const BlockRef<TIn, TOut>& nxt, int skv, int W, char* lds, Seam<TIn>& S, const int wv) {
    constexpr bool F32 = same_t<TIn, float>::v;
    const int tid = ltid(wv), wid = __builtin_amdgcn_readfirstlane(tid >> 6), lane = tid & 63, r32 = lane & 31, hi = lane >> 5;
    const int j_lo = swa_jlo(cur.P0, W);
    int j_hi = (cur.P0 + QB - 1) / KVBLK + 1; if (j_hi > skv / KVBLK) j_hi = skv / KVBLK;
    const int NT = j_hi - j_lo;
    const int kbn = swa_jlo(nxt.P0, W) * KVBLK;
    const int qlo = cur.P0 + wid * QBLK, qm = qlo + r32 - 4 * hi;
    char* V_lds = lds; char* K_lds = lds + 2 * SHM_V;
    float* ws = (float*)(lds + 2 * SHM_V + 2 * SHM_K) + wid * 64; float* li_l = ws, * al_l = ws + 32;
    float m_reg = -1e30f, l_reg = 0; f32x16 o[4] = {};
    const int sr = tid >> 4, sc = (tid & 15) * 8, vst0 = v_st(sr, sc), vst1 = v_st(32 + sr, sc), kws = KSWZ(sr, sc * 2);
    const int vb0 = (int)(uintptr_t)V_lds + v_rd_base(lane);
    const TIn* Kh = cur.K; const TIn* Vh = cur.V;
#define RESC(a) do { if (__any((a) < 1.f)) { if (hi == 0) al_l[r32] = (a); asm volatile("s_waitcnt lgkmcnt(0)" ::: "memory");              \
                     for (int d_ = 0; d_ < 4; ++d_) for (int r = 0; r < 16; ++r) o[d_][r] *= al_l[crow(r, hi)]; } } while (0)
#define KBASE(t) ((j_lo + (t)) * KVBLK)
#define ACT(t) (KBASE(t) <= qlo + QBLK - 1 && KBASE(t) + KVBLK - 1 >= qlo - W + 1)
#define MASKT(P0_, P1_, t) do { const int kb_ = KBASE(t); if ((!SK || ACT(t)) && (kb_ + KVBLK - 1 > qlo || kb_ <= qlo + QBLK - 1 - W)) mask_tile(P0_, P1_, qm - kb_, (unsigned)W); } while (0)
    constexpr int NQL = F32 ? 16 : 8;
    constexpr bool SK = WSKIP && !F32;
#define SEAM_K0() do { VMWN(NQL); if constexpr (F32) { SWRITE_KF(0); SBAR(); SLOAD_F((const float*)nxt.V, kbn); } else { SWRITE_HK(0); } SBAR(); } while (0)
    f32x16 pA0, pA1, pB0, pB1; float mnA, mnB, alA, alB; bf16x8 pa0, pa1, pa2, pa3;
    if constexpr (F32) { VMW(); SWRITE_VF(0); SBAR(); } else { SWRITE_HV(0); SBAR(); }
    if (NT > 1) { if constexpr (F32) SLOAD_F((const float*)Kh, KBASE(1)); else SLOAD_H(Kh, Vh, KBASE(1)); }
    SBAR(); qkt<0, SK>(pA0, pA1, K_lds, r32, hi, S.qr, ACT(0));
    if constexpr (F32) { if (NT > 1) { VMW(); SWRITE_KF(1); SBAR(); SLOAD_F((const float*)Vh, KBASE(1)); } }
    MASKT(pA0, pA1, 0); partialSM(pA0, pA1, m_reg, mnA, alA);
    if (NT > 1) { VMW(); if constexpr (F32) { SWRITE_VF(1); SBAR(); if (NT > 2) SLOAD_F((const float*)Kh, KBASE(2)); } else SWRITE_H(1); }
    __syncthreads();
#define HALF_STEP(PX0, PX1, mnX, alX, PY0, PY1, alY, t, KB, VB, SB) do {                                                      \
        SBAR(); qkt<KB, SK>(PX0, PX1, K_lds, r32, hi, S.qr, ACT(t));                                             \
        finishSM(PY0, PY1, alY, l_reg, pa0, pa1, pa2, pa3); SBAR();                                                           \
        if ((t) + 1 < NT) { if constexpr (F32) { VMW(); SWRITE_KF(SB); SBAR(); SLOAD_F((const float*)Vh, KBASE((t) + 1)); }  \
                            else { SLOAD_H(Kh, Vh, KBASE((t) + 1)); } SBAR(); }                                               \
        pv_tile<VB, SK>(o, vb0, pa0, pa1, pa2, pa3, ACT((t) - 1)); MASKT(PX0, PX1, (t)); partialSM(PX0, PX1, m_reg, mnX, alX);                                        \
        __syncthreads();                                                                                                      \
        if ((t) + 1 < NT) { VMW(); if constexpr (F32) { SWRITE_VF(SB); SBAR(); if ((t) + 2 < NT) SLOAD_F((const float*)Kh, KBASE((t) + 2)); } \
                            else { SWRITE_H(SB); } }                                                                          \
        RESC(alX); __syncthreads(); } while (0)
    for (int t = 1; t + 1 < NT; t += 2) {
        HALF_STEP(pB0, pB1, mnB, alB, pA0, pA1, alA, t, 1, 0, 0);
        HALF_STEP(pA0, pA1, mnA, alA, pB0, pB1, alB, t + 1, 0, 1, 1);
    }
    const bool even = (NT & 1) == 0;
    if (even) { SBAR(); qkt<1, SK>(pB0, pB1, K_lds, r32, hi, S.qr, ACT(NT - 1)); SBAR(); }
#define QROW(e) (nxt.Q + (size_t)(wid * QBLK + r32) * D + ((e) >> 1) * 16 + hi * 8 + ((e) & 1) * 4)
    if constexpr (F32) { SLOAD_F((const float*)nxt.K, kbn); SBAR();
#pragma unroll
        for (int e = 0; e < 8; ++e) S.tq[e] = *(const f32x4*)QROW(e); }
    else { SLOAD_H(nxt.K, nxt.V, kbn); SBAR();
#pragma unroll
        for (int d0 = 0; d0 < 8; ++d0) S.qr[d0] = load8<TIn>(nxt.Q + (size_t)(wid * QBLK + r32) * D + d0 * 16 + hi * 8); }
    SBAR();
    finishSM(pA0, pA1, alA, l_reg, pa0, pa1, pa2, pa3); SBAR();
    if constexpr (F32) {
#pragma unroll
        for (int e = 8; e < 16; ++e) S.tq[e] = *(const f32x4*)QROW(e); SBAR(); }
#undef QROW
    pv_tile<0, SK>(o, vb0, pa0, pa1, pa2, pa3, ACT(even ? NT - 2 : NT - 1));
    if (even) { MASKT(pB0, pB1, NT - 1); partialSM(pB0, pB1, m_reg, mnB, alB); __syncthreads(); RESC(alB);
        finishSM(pB0, pB1, alB, l_reg, pa0, pa1, pa2, pa3); SBAR(); pv_tile<1, SK>(o, vb0, pa0, pa1, pa2, pa3, ACT(NT - 1)); }
    SBAR(); SEAM_K0();
    if (hi == 0) li_l[r32] = l_reg; asm volatile("s_waitcnt lgkmcnt(0)" ::: "memory");
    float rli[16];
#pragma unroll
    for (int r = 0; r < 16; ++r) rli[r] = __builtin_amdgcn_rcpf(li_l[crow(r, hi)]);
    TOut* Ow = cur.O + (size_t)(wid * QBLK) * D;
#pragma unroll
    for (int r = 0; r < 16; ++r) { const int orow = crow(r, hi);
#pragma unroll
        for (int d0 = 0; d0 < 4; ++d0) { const float v = o[d0][r] * rli[r];
            if constexpr (same_t<TOut, float>::v) { Ow[(size_t)orow * D + d0 * 32 + r32] = v; }
            else { const float vn = sw_xor<1>(v);
                   if ((r32 & 1) == 0) *(unsigned*)(Ow + (size_t)orow * D + d0 * 32 + r32) = cvtpk(v, vn); } } }
    if constexpr (F32) {
#pragma unroll
        for (int d0 = 0; d0 < 8; ++d0) S.qr[d0] = pack8(S.tq[2 * d0], S.tq[2 * d0 + 1]); }
    __syncthreads();
#undef RESC
#undef KBASE
#undef ACT
#undef MASKT
#undef SEAM_K0
#undef HALF_STEP
}
#undef ROW
#undef VMW
#undef VMWN
#undef SLOAD_H
#undef SWRITE_HK
#undef SWRITE_HV
#undef SWRITE_H
#undef SLOAD_F
#undef SWRITE_KF
#undef SWRITE_VF
#undef KSWZ
#undef SBAR
}

#define MFMA16(a, b, c) __builtin_amdgcn_mfma_f32_16x16x32_bf16((a), (b), (c), 0, 0, 0)
#define MFMA32(a, b, c) __builtin_amdgcn_mfma_f32_32x32x16_bf16((a), (b), (c), 0, 0, 0)
#define WSP(T_, off) ((T_*)(p->ws + (off)))

DI void sincos_red(double r, float& s, float& c) {
    const double r2 = r * r; double sp = 1.0, cp = 1.0;
#pragma unroll
    for (int k = 13; k >= 1; --k) { sp = 1.0 - sp * r2 * (1.0 / (double)((2 * k) * (2 * k + 1))); cp = 1.0 - cp * r2 * (1.0 / (double)((2 * k - 1) * (2 * k))); }
    s = (float)(r * sp); c = (float)cp;
}

DI void cvt_wt_job(const float* src, bf16_t* dst, int N, int Npad, int nperm, float* tile, const int wv) {
    const int tid = ltid(wv), K = 2048, ntn = Npad / 64, ntiles = ntn * (K / 64);
    for (int tl = blockIdx.x; tl < ntiles; tl += gridDim.x) {
        const int tn = tl % ntn, tk = tl / ntn, k0 = tk * 64, n0 = tn * 64, c = tid & 63;
        int ns = n0 + c;
        if (ns < nperm) { const int p7 = ns & 127, u = p7 >> 3, e = p7 & 7; ns = (ns & ~127) + ((e < 4) ? 4 * u + e : 64 + 4 * u + (e - 4)); }
#pragma unroll
        for (int i = 0; i < 8; ++i) { const int r = (tid >> 6) + 8 * i, n = n0 + c; tile[r * 65 + c] = (n < N) ? src[(size_t)(k0 + r) * N + ns] : 0.f; }
        __syncthreads();
#pragma unroll
        for (int i = 0; i < 4; ++i) { const int id = tid + 512 * i, rr = id >> 5, cp = id & 31;
            ((unsigned*)dst)[((size_t)(n0 + rr) * K + k0) / 2 + cp] = cvt_pk_bf16(tile[(2 * cp) * 65 + rr], tile[(2 * cp + 1) * 65 + rr]); }
        __syncthreads();
    }
}

DI void ph_prologue(PK p, unsigned char* lds, const int wv) {
    PK_FRESH(p);
    const int tid = ltid(wv), lane = tid & 63, wave = __builtin_amdgcn_readfirstlane(tid >> 6);
    float* ldsf = (float*)lds;
    {
        float* sc = ldsf; float* red = ldsf + 4096;
        for (int i = tid; i < 4096; i += 512) sc[i] = silu_f(p->in[1][i]);
        __syncthreads();
        float* mod = WSP(float, WS_MOD);
        for (int item = blockIdx.x; item < MODC / 64; item += gridDim.x) {
            const int col0 = item * 64, col = col0 + lane;
            const float* W; size_t stride;
            if (col0 < 4 * 12288) { const int l = col0 / 12288, j = col - l * 12288; W = p->in[3] + (size_t)l * 2048 * 12288 + j; stride = 12288; }
            else { W = p->in[14] + (col - 4 * 12288); stride = 4096; }
            float a0 = 0.f, a1 = 0.f;
            const int kb = wave * 256;
#pragma unroll 8
            for (int k = 0; k < 256; ++k) { const float wv = W[(size_t)(kb + k) * stride]; a0 += sc[kb + k] * wv; a1 += sc[2048 + kb + k] * wv; }
            red[(wave * 64 + lane) * 2 + 0] = a0; red[(wave * 64 + lane) * 2 + 1] = a1;
            __syncthreads();
            if (tid < 128) { const int ln = tid & 63, b = tid >> 6; float s = 0.f;
#pragma unroll
                for (int w = 0; w < 8; ++w) s += red[(w * 64 + ln) * 2 + b];
                const int cc = col0 + ln; const float bias = (cc < 4 * 12288) ? p->in[4][cc] : p->in[15][cc - 4 * 12288];
                mod[(size_t)b * MODC + cc] = s + bias; }
            __syncthreads();
        }
    }
    for (int job = 0; job < 9; ++job) {
        const float* src; bf16_t* dst; int N = 2048, Npad = 2048, nperm = 0;
        if (job < 2) { src = p->in[7] + (size_t)job * 2048 * GIN; dst = WSP(bf16_t, WS_WIN) + (size_t)job * GINP * 2048; N = GIN; Npad = GINP; }
        else if (job < 4) { src = p->in[12] + (size_t)(job - 2) * 2048 * 2048; dst = WSP(bf16_t, WS_WOUT) + (size_t)(job - 2) * 2048 * 2048; }
        else if (job == 4) { src = p->in[16]; dst = WSP(bf16_t, WS_KVW); N = 4096; Npad = 4096; nperm = 2048; }
        else if (job < 7) { src = p->in[17] + (size_t)(job - 5) * 2048 * 2048; dst = WSP(bf16_t, WS_DWQ) + (size_t)(job - 5) * 2048 * 2048; nperm = 2048; }
        else { src = p->in[20] + (size_t)(job - 7) * 2048 * 2048; dst = WSP(bf16_t, WS_DWO) + (size_t)(job - 7) * 2048 * 2048; }
        cvt_wt_job(src, dst, N, Npad, nperm, ldsf, wv);
    }
    {
        const int lane = tid & 63, r16 = lane & 15, quad = lane >> 4;
        bf16_t* wdst = WSP(bf16_t, WS_PWQ);
        for (int task = (blockIdx.x * 8 + wave); task < 4 * 16 * 128; task += gridDim.x * 8) {
            const int kt = task & 127, pj = (task >> 7) & 15, l = task >> 11, pp = pj >> 1, jh = pj & 1;
            const float* wq = p->in[21] + ((size_t)l * 2048 + kt * 16 + r16) * 2048 + pp * 256 + jh * 128 + quad * 8;
            const float* ky = p->in[22] + ((size_t)(l * 2 + jh) * 128 + r16) * 128 + quad * 8;
            bf16x8 bw[4];
#pragma unroll
            for (int ks = 0; ks < 4; ++ks) { const f32x4 a = *(const f32x4*)(wq + ks * 32), b = *(const f32x4*)(wq + ks * 32 + 4);
                u32x4 w; w.x = cvt_pk_bf16(a[0], a[1]); w.y = cvt_pk_bf16(a[2], a[3]); w.z = cvt_pk_bf16(b[0], b[1]); w.w = cvt_pk_bf16(b[2], b[3]); bw[ks] = __builtin_bit_cast(bf16x8, w); }
#pragma unroll
            for (int nt = 0; nt < 8; ++nt) { f32x4 acc = {0.f, 0.f, 0.f, 0.f};
#pragma unroll
                for (int ks = 0; ks < 4; ++ks) { const f32x4 a = *(const f32x4*)(ky + (size_t)nt * 16 * 128 + ks * 32), b = *(const f32x4*)(ky + (size_t)nt * 16 * 128 + ks * 32 + 4);
                    u32x4 w; w.x = cvt_pk_bf16(a[0], a[1]); w.y = cvt_pk_bf16(a[2], a[3]); w.z = cvt_pk_bf16(b[0], b[1]); w.w = cvt_pk_bf16(b[2], b[3]);
                    acc = MFMA16(__builtin_bit_cast(bf16x8, w), bw[ks], acc); }
#pragma unroll
                for (int r = 0; r < 4; ++r) wdst[((size_t)l * 2048 + pp * 256 + jh * 128 + nt * 16 + quad * 4 + r) * 2048 + kt * 16 + r16] = f2bf(acc[r]); }
        }
    }
    {
        float* cosT = WSP(float, WS_COS); float* sinT = WSP(float, WS_SIN); const int* pos = (const int*)p->in[2];
        for (int idx = blockIdx.x * 512 + tid; idx < T * 64; idx += gridDim.x * 512) {
            const int t = idx >> 6, j = idx & 63;
            const double inv = exp(-(double)j * (9.210340371976184 / 64.0));
            const double ang = (double)pos[t] * inv;
            const double n = rint(ang * 0.15915494309189535);
            double r = fma(-n, 6.283185307179586, ang); r = fma(-n, 2.4492935982947064e-16, r);
            float s, c; sincos_red(r, s, c); cosT[idx] = c; sinT[idx] = s;
        }
    }
    {
        bf16_t* sk = WSP(bf16_t, WS_SUBK);
        for (int idx = blockIdx.x * 512 + tid; idx < 4 * 2 * 128 * 128; idx += gridDim.x * 512) sk[idx] = f2bf(p->in[22][idx]);
    }
}

template <int MODE>
DI void ph_norm(const float* x, const bf16_t* xb, const float* g, const float* shift, const float* scale, bf16_t* dstb, float* dstf, const int wv) {
    const int tid = ltid(wv), lane = tid & 63, wave = __builtin_amdgcn_readfirstlane(tid >> 6);
    for (int row = blockIdx.x * 8 + wave; row < T; row += gridDim.x * 8) {
        const int b = row >> 13;
        f32x4 v[8]; float ss = 0.f;
#pragma unroll
        for (int i = 0; i < 8; ++i) {
            if (MODE == 2) { const u32x2 w = *(const u32x2*)(xb + (size_t)row * D + i * 256 + lane * 4); v[i] = (f32x4){bflo(w.x), bfhi(w.x), bflo(w.y), bfhi(w.y)}; }
            else v[i] = *(const f32x4*)(x + (size_t)row * D + i * 256 + lane * 4);
            ss += v[i][0] * v[i][0] + v[i][1] * v[i][1] + v[i][2] * v[i][2] + v[i][3] * v[i][3]; }
        ss = wave_sum(ss);
        const float r = rsqrtf(ss * (1.f / D) + NORM_EPS);
#pragma unroll
        for (int i = 0; i < 8; ++i) { const int col = i * 256 + lane * 4; const f32x4 gv = *(const f32x4*)(g + col);
            if (MODE != 1) { const f32x4 sh = *(const f32x4*)(shift + (size_t)b * MODC + col), sc = *(const f32x4*)(scale + (size_t)b * MODC + col);
                f32x4 y;
#pragma unroll
                for (int e = 0; e < 4; ++e) y[e] = v[i][e] * r * gv[e] * (1.f + sc[e]) + sh[e];
                u32x2 w; w.x = cvt_pk_bf16(y[0], y[1]); w.y = cvt_pk_bf16(y[2], y[3]); *(u32x2*)(dstb + (size_t)row * D + col) = w; }
            else { f32x4 y;
#pragma unroll
                for (int e = 0; e < 4; ++e) y[e] = v[i][e] * r * gv[e];
                *(f32x4*)(dstf + (size_t)row * D + col) = y; } }
    }
}

DI void pc_load(PK p, int l, int row, f32x4 (&v)[8], const int lane) {
    const float* s = ((row >= 16384) ? p->in[24] : p->in[23]) + ((size_t)l * 16384 + (row & 16383)) * 2048;
#pragma unroll
    for (int i = 0; i < 8; ++i) v[i] = *(const f32x4*)(s + lane * 32 + i * 4);
}
DI void pc_store(PK p, int row, const f32x4 (&v)[8], const int lane) {
    const bool second = row >= 16384; const int r = row & 16383;
    unsigned char* dq = WSP(unsigned char, second ? WS_PV : WS_PU); unsigned* ds = WSP(unsigned, second ? WS_PVS : WS_PUS);
    float m0 = 0.f, m1 = 0.f;
#pragma unroll
    for (int i = 0; i < 8; ++i) { const float mm = fmaxf(fmaxf(fabsf(v[i][0]), fabsf(v[i][1])), fmaxf(fabsf(v[i][2]), fabsf(v[i][3]))); if (i < 4) m0 = fmaxf(m0, mm); else m1 = fmaxf(m1, mm); }
    const bf16_t sb0 = (m0 > 0.f) ? f2bf(m0 * (1.004f / 6.f)) : (bf16_t)0x3f80, sb1 = (m1 > 0.f) ? f2bf(m1 * (1.004f / 6.f)) : (bf16_t)0x3f80;
    const float inv0 = 1.f / bf2f(sb0), inv1 = 1.f / bf2f(sb1);
    u32x4 w;
#pragma unroll
    for (int c = 0; c < 4; ++c) { unsigned x = 0u; const float inv = (c < 2) ? inv0 : inv1;
        x = __builtin_amdgcn_cvt_scalef32_pk_fp4_f32(x, v[2 * c][0] * inv, v[2 * c][1] * inv, 1.0f, 0);
        x = __builtin_amdgcn_cvt_scalef32_pk_fp4_f32(x, v[2 * c][2] * inv, v[2 * c][3] * inv, 1.0f, 1);
        x = __builtin_amdgcn_cvt_scalef32_pk_fp4_f32(x, v[2 * c + 1][0] * inv, v[2 * c + 1][1] * inv, 1.0f, 2);
        x = __builtin_amdgcn_cvt_scalef32_pk_fp4_f32(x, v[2 * c + 1][2] * inv, v[2 * c + 1][3] * inv, 1.0f, 3);
        w[c] = x; }
    *(u32x4*)(dq + (size_t)r * 1024 + lane * 16) = w;
    ds[(size_t)r * 64 + lane] = (unsigned)sb0 | ((unsigned)sb1 << 16);
}
DI void ph_peer_cvt(PK p, int l, const int wv) {
    PK_FRESH(p);
    const int tid = ltid(wv), lane = tid & 63, wave = __builtin_amdgcn_readfirstlane(tid >> 6);
    for (int row = blockIdx.x * 8 + wave; row < 2 * 16384; row += gridDim.x * 8) { f32x4 v[8]; pc_load(p, l, row, v, lane); pc_store(p, row, v, lane); }
}


template <int I, int J>
DI void tinv_block(const bf16_t* Lb, bf16_t* Ti, bf16_t* TT, bf16_t* XT, const int r16, const int quad) {
    constexpr int nK = 16 * (I - J);
    const bf16x8 zero8 = {0, 0, 0, 0, 0, 0, 0, 0};
    f32x4 acc = {0.f, 0.f, 0.f, 0.f};
#pragma unroll
    for (int ks = 0; ks < (nK + 31) / 32; ++ks) {
        const int k0 = ks * 32 + quad * 8; const bool valid = k0 < nK;
        const bf16x8 a = valid ? *(const bf16x8*)(Lb + (16 * I + r16) * 72 + 16 * J + k0) : zero8;
        const bf16x8 b = valid ? *(const bf16x8*)(TT + (16 * J + r16) * 72 + 16 * J + k0) : zero8;
        acc = MFMA16(a, b, acc);
    }
    { u32x2 w; w.x = cvt_pk_bf16(acc[0], acc[1]); w.y = cvt_pk_bf16(acc[2], acc[3]); *(u32x2*)(XT + r16 * 24 + quad * 4) = w; }
    asm volatile("s_waitcnt lgkmcnt(0)" ::: "memory");
    const bool v2 = quad < 2;
    const bf16x8 a2 = v2 ? *(const bf16x8*)(Ti + (16 * I + r16) * 72 + 16 * I + quad * 8) : zero8;
    const bf16x8 b2 = v2 ? *(const bf16x8*)(XT + r16 * 24 + quad * 8) : zero8;
    f32x4 m = {0.f, 0.f, 0.f, 0.f};
    m = MFMA16(a2, b2, m);
#pragma unroll
    for (int r = 0; r < 4; ++r) Ti[(16 * I + quad * 4 + r) * 72 + 16 * J + r16] = f2bf(-m[r]);
    { u32x2 w; w.x = cvt_pk_bf16(-m[0], -m[1]); w.y = cvt_pk_bf16(-m[2], -m[3]); *(u32x2*)(TT + (16 * J + r16) * 72 + 16 * I + quad * 4) = w; }
    asm volatile("s_waitcnt lgkmcnt(0)" ::: "memory");
}

DI void ph_gdn_p1(PK p, int l, unsigned char* lds, const int wv) {
    PK_FRESH(p);
    const bf16_t* proj = WSP(const bf16_t, WS_PROJ);
    const float* convw = p->in[8] + (size_t)l * 4 * 6144; const float* alog = p->in[9] + l * 16; const float* dtb = p->in[10] + l * 16;
    bf16_t* Ag = WSP(bf16_t, WS_GA); bf16_t* Bg = WSP(bf16_t, WS_GB); bf16_t* Qg = WSP(bf16_t, WS_GQ); bf16_t* Og = WSP(bf16_t, WS_GO); float* glg = WSP(float, WS_GL);
    bf16_t* qb  = (bf16_t*)(lds + 0);
    bf16_t* kb  = (bf16_t*)(lds + 17408);
    bf16_t* Lb  = (bf16_t*)(lds + 34816);
    bf16_t* wT  = (bf16_t*)(lds + 17408);
    bf16_t* vbT = (bf16_t*)(lds + 44032);
    bf16_t* kdT = (bf16_t*)(lds + 62464);
    bf16_t* kbT = (bf16_t*)(lds + 80896);
    bf16_t* uT  = (bf16_t*)(lds + 80896);
    bf16_t* aqk = (bf16_t*)(lds + 99328);
    bf16_t* Ti  = (bf16_t*)(lds + 108544);
    bf16_t* TT  = (bf16_t*)(lds + 117760);
    float*  Ld  = (float*)(lds + 126976);
    bf16_t* XT  = (bf16_t*)(lds + 132096);
    float*  sc  = (float*)(lds + 133120);
    float*  cw  = (float*)(lds + 134144);
    int cached_bh = -1;
    for (int it = blockIdx.x; it < 4096; it += gridDim.x) {
        const int tid = ltid(wv), lane = tid & 63, wave = __builtin_amdgcn_readfirstlane(tid >> 6), r16 = lane & 15, quad = lane >> 4;
        const int bh = it & 31, n = it >> 5, hd = bh & 15, b = bh >> 4, tok0 = b * SEQ + n * 64, ci = bh * 128 + n;
        if (bh != cached_bh) {
            for (int idx = tid; idx < 1536; idx += 512) { const int part = idx >> 9, tap = (idx >> 7) & 3, c = idx & 127; cw[idx] = convw[tap * 6144 + part * 2048 + hd * 128 + c]; }
            cached_bh = bh;
            lds_barrier();
        }
        float pa_[4] = {0.f, 0.f, 0.f, 0.f}, pb_[4] = {0.f, 0.f, 0.f, 0.f}, dtbv = 0.f, alogv = 0.f;
        if (tid < 64) { const float* pab = WSP(const float, WS_PAB) + (size_t)(tok0 + tid) * 32 + hd; const size_t qs = (size_t)T * 32;
#pragma unroll
            for (int q4 = 0; q4 < 4; ++q4) { pa_[q4] = pab[q4 * qs]; pb_[q4] = pab[q4 * qs + 16]; }
            dtbv = dtb[hd]; alogv = alog[hd]; }
        {
            const int c16 = tid & 15, t0 = (tid >> 4) * 2;
#pragma unroll
            for (int part = 0; part < 3; ++part) {
                const int ch = part * 2048 + hd * 128 + c16 * 8;
                float xr[5][8];
#pragma unroll
                for (int r = 0; r < 5; ++r) {
                    const int sp = n * 64 + t0 - 3 + r;
                    u32x4 raw = {0u, 0u, 0u, 0u};
                    if (sp >= 0) raw = *(const u32x4*)(proj + (size_t)(b * SEQ + sp) * GINP + ch);
                    xr[r][0] = bflo(raw.x); xr[r][1] = bfhi(raw.x); xr[r][2] = bflo(raw.y); xr[r][3] = bfhi(raw.y); xr[r][4] = bflo(raw.z); xr[r][5] = bfhi(raw.z); xr[r][6] = bflo(raw.w); xr[r][7] = bfhi(raw.w);
                }
                float wt[4][8];
#pragma unroll
                for (int tap = 0; tap < 4; ++tap) { const f32x4 w0 = *(const f32x4*)(cw + (part * 4 + tap) * 128 + c16 * 8), w1 = *(const f32x4*)(cw + (part * 4 + tap) * 128 + c16 * 8 + 4);
                    wt[tap][0] = w0[0]; wt[tap][1] = w0[1]; wt[tap][2] = w0[2]; wt[tap][3] = w0[3]; wt[tap][4] = w1[0]; wt[tap][5] = w1[1]; wt[tap][6] = w1[2]; wt[tap][7] = w1[3]; }
                float av[2][8];
#pragma unroll
                for (int u = 0; u < 2; ++u) {
                    float ss = 0.f;
#pragma unroll
                    for (int e = 0; e < 8; ++e) { float a = wt[0][e] * xr[u][e]; a = fmaf(wt[1][e], xr[u + 1][e], a); a = fmaf(wt[2][e], xr[u + 2][e], a); a = fmaf(wt[3][e], xr[u + 3][e], a);
                        a = silu_f(a); av[u][e] = a; ss += a * a; }
                    if (part < 2) {
                        ss += sw_xor<1>(ss); ss += sw_xor<2>(ss); ss += sw_xor<4>(ss); ss += sw_xor<8>(ss);
                        const float r = rsqrtf(ss + NORM_EPS) * (part == 0 ? 0.08838834764831845f : 1.f);
                        u32x4 w; w.x = cvt_pk_bf16(av[u][0] * r, av[u][1] * r); w.y = cvt_pk_bf16(av[u][2] * r, av[u][3] * r); w.z = cvt_pk_bf16(av[u][4] * r, av[u][5] * r); w.w = cvt_pk_bf16(av[u][6] * r, av[u][7] * r);
                        *(u32x4*)((part == 0 ? qb : kb) + (t0 + u) * 136 + c16 * 8) = w;
                    }
                }
                if (part == 2) {
#pragma unroll
                    for (int e = 0; e < 8; ++e) *(unsigned*)(vbT + (c16 * 8 + e) * 72 + t0) = cvt_pk_bf16(av[0][e], av[1][e]);
                }
            }
        }
        if (tid < 64) {
            const int t = tid;
            const float av = (pa_[0] + pa_[1]) + (pa_[2] + pa_[3]), bv = (pb_[0] + pb_[1]) + (pb_[2] + pb_[3]);
            const float xx = av + dtbv;
            const float ex = __expf(xx); const float sp = (xx > 20.f) ? xx : ((xx < -8.f) ? ex * (1.f - 0.5f * ex) : __logf(1.f + ex));
            const float g = -__expf(alogv) * sp;
            const float beta = 1.f / (1.f + __expf(-bv));
            float G = g;
#pragma unroll
            for (int d = 1; d < 64; d <<= 1) { const float o = __int_as_float(__builtin_amdgcn_ds_bpermute(((t - d) & 63) << 2, __float_as_int(G))); if (t >= d) G += o; }
            const float Gl = __int_as_float(__builtin_amdgcn_readlane(__float_as_int(G), 63));
            sc[t] = beta; sc[64 + t] = G; sc[128 + t] = __expf(G); sc[192 + t] = __expf(Gl - G);
            if (t == 63) glg[ci] = __expf(G);
        }
        lds_barrier();
        {
            const int which = wave >> 2, mi = wave & 3;
#pragma unroll
            for (int ni = 0; ni < 4; ++ni) {
                if (which == 0 ? (ni >= mi) : (ni <= mi)) {
                    f32x4 acc = {0.f, 0.f, 0.f, 0.f};
                    const bf16_t* Ab = (which ? qb : kb) + (mi * 16 + r16) * 136 + quad * 8;
                    const bf16_t* Bb = kb + (ni * 16 + r16) * 136 + quad * 8;
#pragma unroll
                    for (int ks = 0; ks < 4; ++ks) acc = MFMA16(*(const bf16x8*)(Ab + ks * 32), *(const bf16x8*)(Bb + ks * 32), acc);
                    const int cidx = ni * 16 + r16; const float Gc = sc[64 + cidx];
                    if (which == 0) {
                        const float bi = sc[cidx]; f32x4 lv;
#pragma unroll
                        for (int r = 0; r < 4; ++r) { const int jj = mi * 16 + quad * 4 + r; lv[r] = (jj < cidx) ? bi * acc[r] * __expf(fminf(Gc - sc[64 + jj], 0.f)) : 0.f; }
                        if (ni == mi) *(f32x4*)(Ld + mi * 320 + r16 * 20 + quad * 4) = lv;
                        else { u32x2 w; w.x = cvt_pk_bf16(lv[0], lv[1]); w.y = cvt_pk_bf16(lv[2], lv[3]); *(u32x2*)(Lb + cidx * 72 + mi * 16 + quad * 4) = w; }
                    } else {
#pragma unroll
                        for (int r = 0; r < 4; ++r) { const int ii = mi * 16 + quad * 4 + r; aqk[ii * 72 + cidx] = f2bf((cidx <= ii) ? acc[r] * __expf(fminf(sc[64 + ii] - Gc, 0.f)) : 0.f); }
                    }
                } else if (which == 1) {
#pragma unroll
                    for (int r = 0; r < 4; ++r) aqk[(mi * 16 + quad * 4 + r) * 72 + ni * 16 + r16] = 0;
                }
            }
        }
        lds_barrier();
        {
            const int a = tid & 127, tq = tid >> 7;
#pragma unroll
            for (int q = 0; q < 2; ++q) { const int t0 = tq * 16 + q * 8; float v[8];
#pragma unroll
                for (int e = 0; e < 8; ++e) v[e] = bf2f(kb[(t0 + e) * 136 + a]);
                u32x4 w; w.x = cvt_pk_bf16(v[0], v[1]); w.y = cvt_pk_bf16(v[2], v[3]); w.z = cvt_pk_bf16(v[4], v[5]); w.w = cvt_pk_bf16(v[6], v[7]);
                *(u32x4*)(kbT + a * 72 + t0) = w;
#pragma unroll
                for (int e = 0; e < 8; ++e) v[e] *= sc[192 + t0 + e];
                w.x = cvt_pk_bf16(v[0], v[1]); w.y = cvt_pk_bf16(v[2], v[3]); w.z = cvt_pk_bf16(v[4], v[5]); w.w = cvt_pk_bf16(v[6], v[7]);
                *(u32x4*)(kdT + a * 72 + t0) = w; }
        }
        if (wave == 0) {
            const float* Lrow = Ld + quad * 320;
            float x[16];
#pragma unroll
            for (int i = 0; i < 16; ++i) { float s = (i == r16) ? 1.f : 0.f;
#pragma unroll
                for (int j = 0; j < i; ++j) s -= Lrow[i * 20 + j] * x[j];
                x[i] = s; }
#pragma unroll
            for (int i = 0; i < 16; ++i) Ti[(16 * quad + i) * 72 + 16 * quad + r16] = f2bf(x[i]);
            { u32x4 w0, w1; w0.x = cvt_pk_bf16(x[0], x[1]); w0.y = cvt_pk_bf16(x[2], x[3]); w0.z = cvt_pk_bf16(x[4], x[5]); w0.w = cvt_pk_bf16(x[6], x[7]);
              w1.x = cvt_pk_bf16(x[8], x[9]); w1.y = cvt_pk_bf16(x[10], x[11]); w1.z = cvt_pk_bf16(x[12], x[13]); w1.w = cvt_pk_bf16(x[14], x[15]);
              *(u32x4*)(TT + (16 * quad + r16) * 72 + 16 * quad) = w0; *(u32x4*)(TT + (16 * quad + r16) * 72 + 16 * quad + 8) = w1; }
            asm volatile("s_waitcnt lgkmcnt(0)" ::: "memory");
            tinv_block<1, 0>(Lb, Ti, TT, XT, r16, quad); tinv_block<2, 1>(Lb, Ti, TT, XT, r16, quad); tinv_block<3, 2>(Lb, Ti, TT, XT, r16, quad);
            tinv_block<2, 0>(Lb, Ti, TT, XT, r16, quad); tinv_block<3, 1>(Lb, Ti, TT, XT, r16, quad);
            tinv_block<3, 0>(Lb, Ti, TT, XT, r16, quad);
        }
        lds_barrier();
        {
            const int i = tid >> 3, t0 = (tid & 7) * 8; const bool low = (t0 >> 4) <= (i >> 4);
            const u32x4 raw = *(const u32x4*)(Ti + i * 72 + t0);
            float v[8] = {bflo(raw.x), bfhi(raw.x), bflo(raw.y), bfhi(raw.y), bflo(raw.z), bfhi(raw.z), bflo(raw.w), bfhi(raw.w)}; float tw[8], tu[8];
#pragma unroll
            for (int e = 0; e < 8; ++e) { const float be = sc[t0 + e]; tu[e] = low ? v[e] * be : 0.f; tw[e] = low ? v[e] * be * sc[128 + t0 + e] : 0.f; }
            u32x4 w; w.x = cvt_pk_bf16(tw[0], tw[1]); w.y = cvt_pk_bf16(tw[2], tw[3]); w.z = cvt_pk_bf16(tw[4], tw[5]); w.w = cvt_pk_bf16(tw[6], tw[7]);
            u32x4 u; u.x = cvt_pk_bf16(tu[0], tu[1]); u.y = cvt_pk_bf16(tu[2], tu[3]); u.z = cvt_pk_bf16(tu[4], tu[5]); u.w = cvt_pk_bf16(tu[6], tu[7]);
            *(u32x4*)(Ti + i * 72 + t0) = w; *(u32x4*)(TT + i * 72 + t0) = u;
        }
        lds_barrier();
#pragma unroll
        for (int pass = 0; pass < 2; ++pass) {
            const bf16_t* Aop = pass ? TT : Ti; const bf16_t* Bop = pass ? vbT : kbT; bf16_t* outT = pass ? uT : wT;
            f32x4 acc4[4];
#pragma unroll
            for (int mi = 0; mi < 4; ++mi) { f32x4 acc = {0.f, 0.f, 0.f, 0.f};
#pragma unroll
                for (int ks = 0; ks < 2; ++ks) acc = MFMA16(*(const bf16x8*)(Aop + (mi * 16 + r16) * 72 + ks * 32 + quad * 8), *(const bf16x8*)(Bop + (wave * 16 + r16) * 72 + ks * 32 + quad * 8), acc);
                acc4[mi] = acc; }
            if (pass == 1) lds_barrier();
#pragma unroll
            for (int mi = 0; mi < 4; ++mi) { u32x2 w; w.x = cvt_pk_bf16(acc4[mi][0], acc4[mi][1]); w.y = cvt_pk_bf16(acc4[mi][2], acc4[mi][3]); *(u32x2*)(outT + (wave * 16 + r16) * 72 + mi * 16 + quad * 4) = w; }
        }
        lds_barrier();
        {
#pragma unroll
            for (int i = 0; i < 24; ++i) {
                const int prod = (i < 8) ? 0 : (i < 16) ? 1 : (i < 20) ? 2 : 3;
                const int mi = (i < 8) ? i : (i < 16) ? (i - 8) : (i < 20) ? (i - 16) : (i - 20), ni = wave;
                const bf16_t* X = ((prod < 2) ? kdT : aqk) + (mi * 16 + r16) * 72 + quad * 8;
                const bf16_t* Y = ((prod & 1) ? uT : wT) + (ni * 16 + r16) * 72 + quad * 8;
                f32x4 acc = {0.f, 0.f, 0.f, 0.f};
#pragma unroll
                for (int ks = 0; ks < 2; ++ks) acc = MFMA16(*(const bf16x8*)(Y + ks * 32), *(const bf16x8*)(X + ks * 32), acc);
                const int m = mi * 16 + r16, n0 = ni * 16 + quad * 4;
                if (prod == 0) acc = -acc;
                if (prod == 2) { const u32x2 qv = *(const u32x2*)(qb + m * 136 + n0); const float eg = sc[128 + m];
                    acc[0] = bflo(qv.x) * eg - acc[0]; acc[1] = bfhi(qv.x) * eg - acc[1]; acc[2] = bflo(qv.y) * eg - acc[2]; acc[3] = bfhi(qv.y) * eg - acc[3]; }
                bf16_t* outp = ((prod == 0) ? (Ag + (size_t)ci * 16384) : (prod == 1) ? (Bg + (size_t)ci * 16384) : (prod == 2) ? (Qg + (size_t)ci * 8192) : (Og + (size_t)ci * 8192)) + m * 128 + n0;
                u32x2 w; w.x = cvt_pk_bf16(acc[0], acc[1]); w.y = cvt_pk_bf16(acc[2], acc[3]); *(u32x2*)outp = w;
            }
        }
        lds_barrier();
    }
}

DI void ph_gdn_p2(PK p, unsigned char* lds, const int wv) {
    PK_FRESH(p);
    const int tid = ltid(wv), lane = tid & 63, wave = __builtin_amdgcn_readfirstlane(tid >> 6), r16 = lane & 15, quad = lane >> 4, a0 = wave * 16;
    const bf16_t* Ag = WSP(const bf16_t, WS_GA); const bf16_t* Bg = WSP(const bf16_t, WS_GB); bf16_t* Sg = WSP(bf16_t, WS_GS); const float* glg = WSP(const float, WS_GL);
    bf16_t* ST = (bf16_t*)lds;
#define P2_LOAD(AF, BM, GL, cidx) do { const size_t c_ = (cidx); _Pragma("unroll") for (int ks = 0; ks < 4; ++ks) AF[ks] = *(const bf16x8*)(Ag + c_ * 16384 + (size_t)(a0 + r16) * 128 + ks * 32 + quad * 8); \
        _Pragma("unroll") for (int r = 0; r < 4; ++r) BM[r] = Bg[c_ * 16384 + (size_t)(a0 + quad * 4 + r) * 128 + v0 + r16]; GL = glg[c_]; } while (0)
    for (int item = blockIdx.x; item < 256; item += gridDim.x) {
        const int bh = (item & 7) * 4 + (item >> 6), v0 = ((item >> 3) & 7) * 16;
        const size_t cb = (size_t)bh * 128;
        f32x4 S = {0.f, 0.f, 0.f, 0.f};
        bf16x8 afA[4], afB[4], afC[4], afD[4]; bf16_t bmA[4], bmB[4], bmC[4], bmD[4]; float glA, glB, glC, glD;
        P2_LOAD(afA, bmA, glA, cb); P2_LOAD(afB, bmB, glB, cb + 1); P2_LOAD(afC, bmC, glC, cb + 2);
#define P2_STEP(AFc, BMc, GLc, AFp, BMp, GLp, nn) do { const int n_ = (nn); const size_t ci = cb + n_; \
            P2_LOAD(AFp, BMp, GLp, cb + ((n_ + 3 < 128) ? n_ + 3 : 127));        \
            u32x2 sp; sp.x = cvt_pk_bf16(S[0], S[1]); sp.y = cvt_pk_bf16(S[2], S[3]); \
            bf16_t* STb = ST + (n_ & 1) * (16 * 136); \
            *(u32x2*)(STb + r16 * 136 + a0 + quad * 4) = sp; \
            *(u32x2*)(Sg + ci * 16384 + (size_t)(v0 + r16) * 128 + a0 + quad * 4) = sp; \
            lds_barrier(); \
            f32x4 acc; _Pragma("unroll") for (int r = 0; r < 4; ++r) acc[r] = GLc * S[r] + bf2f(BMc[r]); \
            bf16x8 bfr_[4]; _Pragma("unroll") for (int ks = 0; ks < 4; ++ks) bfr_[ks] = *(const bf16x8*)(STb + r16 * 136 + ks * 32 + quad * 8);        \
            _Pragma("unroll") for (int ks = 0; ks < 4; ++ks) acc = MFMA16(AFc[ks], bfr_[ks], acc); \
            S = acc; } while (0)
        for (int n = 0; n < 128; n += 4) {
            P2_STEP(afA, bmA, glA, afD, bmD, glD, n);
            P2_STEP(afB, bmB, glB, afA, bmA, glA, n + 1);
            P2_STEP(afC, bmC, glC, afB, bmB, glB, n + 2);
            P2_STEP(afD, bmD, glD, afC, bmC, glC, n + 3);
        }
#undef P2_STEP
        lds_barrier();
    }
#undef P2_LOAD
}

DI void ph_gdn_p3(PK p, int l, const int wv) {
    PK_FRESH(p);
    const int tid = ltid(wv), lane = tid & 63, wave = __builtin_amdgcn_readfirstlane(tid >> 6), r16 = lane & 15, quad = lane >> 4;
    const bf16_t* Qg = WSP(const bf16_t, WS_GQ); const bf16_t* Og = WSP(const bf16_t, WS_GO); const bf16_t* Sg = WSP(const bf16_t, WS_GS);
    const bf16_t* proj = WSP(const bf16_t, WS_PROJ); bf16_t* obuf = WSP(bf16_t, WS_OBUF); const float* ogain = p->in[11] + l * 128;
    for (int it = blockIdx.x; it < 2048; it += gridDim.x) {
        const int ci = it * 2 + (wave >> 2), mi = wave & 3;
        const int n = ci & 127, bh = ci >> 7, hd = bh & 15, b = bh >> 4;
        const int i = mi * 16 + r16; const size_t tok = (size_t)b * SEQ + n * 64 + i;
        bf16x8 qa[4], sf[4][8]; u32x2 ov[8], zv[8];
#pragma unroll
        for (int ks = 0; ks < 4; ++ks) { qa[ks] = *(const bf16x8*)(Qg + (size_t)ci * 8192 + i * 128 + ks * 32 + quad * 8);
#pragma unroll
            for (int ni = 0; ni < 8; ++ni) sf[ks][ni] = *(const bf16x8*)(Sg + (size_t)ci * 16384 + (ni * 16 + r16) * 128 + ks * 32 + quad * 8); }
#pragma unroll
        for (int ni = 0; ni < 8; ++ni) { ov[ni] = *(const u32x2*)(Og + (size_t)ci * 8192 + i * 128 + ni * 16 + quad * 4); zv[ni] = *(const u32x2*)(proj + tok * GINP + 6144 + hd * 128 + ni * 16 + quad * 4); }
        f32x4 acc[8];
#pragma unroll
        for (int ni = 0; ni < 8; ++ni) acc[ni] = (f32x4){0.f, 0.f, 0.f, 0.f};
#pragma unroll
        for (int ks = 0; ks < 4; ++ks)
#pragma unroll
            for (int ni = 0; ni < 8; ++ni) acc[ni] = MFMA16(sf[ks][ni], qa[ks], acc[ni]);
        float ss = 0.f;
#pragma unroll
        for (int ni = 0; ni < 8; ++ni) {
            acc[ni][0] += bflo(ov[ni].x); acc[ni][1] += bfhi(ov[ni].x); acc[ni][2] += bflo(ov[ni].y); acc[ni][3] += bfhi(ov[ni].y);
            ss += acc[ni][0] * acc[ni][0] + acc[ni][1] * acc[ni][1] + acc[ni][2] * acc[ni][2] + acc[ni][3] * acc[ni][3]; }
        ss += sw_xor<16>(ss); ss = sw_xor32_sum(ss);
        const float rms = rsqrtf(ss * (1.f / 128.f) + NORM_EPS);
#pragma unroll
        for (int ni = 0; ni < 8; ++ni) { const int v = ni * 16 + quad * 4; const f32x4 gv = *(const f32x4*)(ogain + v);
            const float y0 = acc[ni][0] * rms * gv[0] * silu_f(bflo(zv[ni].x)), y1 = acc[ni][1] * rms * gv[1] * silu_f(bfhi(zv[ni].x));
            const float y2 = acc[ni][2] * rms * gv[2] * silu_f(bflo(zv[ni].y)), y3 = acc[ni][3] * rms * gv[3] * silu_f(bfhi(zv[ni].y));
            u32x2 w; w.x = cvt_pk_bf16(y0, y1); w.y = cvt_pk_bf16(y2, y3); *(u32x2*)(obuf + tok * D + hd * 128 + v) = w; }
    }
}

DI void ph_rope(PK p, const bf16_t* src, int ld, bf16_t* dst, const int wv) {
    PK_FRESH(p);
    const int tid = ltid(wv); const float* cosT = WSP(const float, WS_COS); const float* sinT = WSP(const float, WS_SIN);
    for (int idx = blockIdx.x * 512 + tid; idx < T * 128; idx += gridDim.x * 512) {
        const int jc = idx & 7, hc = (idx >> 3) & 15, t = idx >> 7;
        const bf16_t* sp = src + (size_t)t * ld + hc * 128 + jc * 8;
        const u32x4 x1 = *(const u32x4*)sp, x2 = *(const u32x4*)(sp + 64);
        const f32x4 c0 = *(const f32x4*)(cosT + t * 64 + jc * 8), c1 = *(const f32x4*)(cosT + t * 64 + jc * 8 + 4);
        const f32x4 s0 = *(const f32x4*)(sinT + t * 64 + jc * 8), s1 = *(const f32x4*)(sinT + t * 64 + jc * 8 + 4);
        float a[8] = {bflo(x1.x), bfhi(x1.x), bflo(x1.y), bfhi(x1.y), bflo(x1.z), bfhi(x1.z), bflo(x1.w), bfhi(x1.w)};
        float bb[8] = {bflo(x2.x), bfhi(x2.x), bflo(x2.y), bfhi(x2.y), bflo(x2.z), bfhi(x2.z), bflo(x2.w), bfhi(x2.w)};
        float cs[8] = {c0[0], c0[1], c0[2], c0[3], c1[0], c1[1], c1[2], c1[3]}, sn[8] = {s0[0], s0[1], s0[2], s0[3], s1[0], s1[1], s1[2], s1[3]};
        float o1[8], o2[8];
#pragma unroll
        for (int e = 0; e < 8; ++e) { o1[e] = a[e] * cs[e] - bb[e] * sn[e]; o2[e] = bb[e] * cs[e] + a[e] * sn[e]; }
        const int b = t >> 13, s = t & 8191;
        bf16_t* dp = dst + ((size_t)(b * 16 + hc) * SEQ + s) * 128 + jc * 8;
        u32x4 w1, w2;
        w1.x = cvt_pk_bf16(o1[0], o1[1]); w1.y = cvt_pk_bf16(o1[2], o1[3]); w1.z = cvt_pk_bf16(o1[4], o1[5]); w1.w = cvt_pk_bf16(o1[6], o1[7]);
        w2.x = cvt_pk_bf16(o2[0], o2[1]); w2.y = cvt_pk_bf16(o2[2], o2[3]); w2.z = cvt_pk_bf16(o2[4], o2[5]); w2.w = cvt_pk_bf16(o2[6], o2[7]);
        *(u32x4*)dp = w1; *(u32x4*)(dp + 64) = w2;
    }
}
DI void ph_vrelayout(const bf16_t* src, bf16_t* dst, const int wv) {
    const int tid = ltid(wv);
    for (int idx = blockIdx.x * 512 + tid; idx < T * 256; idx += gridDim.x * 512) {
        const int ch = idx & 15, hc = (idx >> 4) & 15, t = idx >> 8; const int b = t >> 13, s = t & 8191;
        *(u32x4*)(dst + ((size_t)(b * 16 + hc) * SEQ + s) * 128 + ch * 8) = *(const u32x4*)(src + (size_t)t * 4096 + 2048 + hc * 128 + ch * 8);
    }
}

DI void ph_attn(PK p, unsigned char* lds, const int wv) {
    PK_FRESH(p);
    using att::bf16;
    const bf16* Qd = WSP(const bf16, WS_QD); const bf16* Ksh = WSP(const bf16, WS_KSH); const bf16* Vsh = WSP(const bf16, WS_VSH); bf16* Oat = WSP(bf16, WS_OAT);
    const int total = 64 * 16, stride = gridDim.x, W = SEQ;
    int L = blockIdx.x;
    if (L < total) {
        auto mkref = [&](int Li, int pass) {
            const int xcd = Li & 7, jk = Li >> 3, mm = (jk & 127) >> 4, x = jk & 15, h64 = xcd * 8 + mm, qb = pass ? (31 - x) : x;
            const int vh = h64 & 1, c = (h64 >> 1) & 1, bh = h64 >> 2;
            att::BlockRef<bf16, bf16> r;
            r.Q = Qd + ((size_t)(bh * 2 + c) * SEQ + (size_t)qb * 256) * 128;
            r.K = Ksh + (size_t)(bh * 2 + c) * SEQ * 128;
            r.V = Vsh + (size_t)(bh * 2 + vh) * SEQ * 128;
            r.O = Oat + ((size_t)((bh * 2 + c) * 2 + vh) * SEQ + (size_t)qb * 256) * 128;
            r.P0 = qb * 256; return r; };
        int pass = 0;
        att::BlockRef<bf16, bf16> cur = mkref(L, 0);
        att::Seam<bf16> S;
        att::causal_swa_prime<bf16, bf16>(cur, W, (char*)lds, S, wv);
        for (;;) {
            const bool more_pass = pass == 0, more_item = L + stride < total, last = !more_pass && !more_item;
            int passn = pass + 1, Ln = L;
            if (!more_pass) { passn = 0; Ln = more_item ? L + stride : L; }
            const att::BlockRef<bf16, bf16> nxt = last ? cur : mkref(Ln, passn);
            att::causal_swa_block<bf16, bf16>(cur, nxt, SEQ, W, (char*)lds, S, wv);
            if (last) break;
            cur = nxt; pass = passn; L = Ln;
        }
    }
    __syncthreads();
}

DI void ph_diff_combine(PK p, int j, int l, unsigned char* lds, const int wv) {
    PK_FRESH(p);
    const int tid = ltid(wv), lane = tid & 63, wave = __builtin_amdgcn_readfirstlane(tid >> 6);
    float* ldsf = (float*)lds;
    const float lambda_init = 0.8f - 0.6f * expf(-0.3f * (float)l);
    if (wave == 0) { const float* lp = p->in[18] + j * 512;
        float a = lp[lane] * lp[128 + lane] + lp[64 + lane] * lp[192 + lane], bsum = lp[256 + lane] * lp[384 + lane] + lp[320 + lane] * lp[448 + lane];
        a = wave_sum(a); bsum = wave_sum(bsum);
        if (lane == 0) ldsf[0] = expf(a) - expf(bsum) + lambda_init; }
    __syncthreads();
    const float lam = ldsf[0], om = 1.f - lambda_init;
    const bf16_t* Oat = WSP(const bf16_t, WS_OAT); bf16_t* obuf = WSP(bf16_t, WS_OBUF); const float* sg = p->in[19] + j * 256;
    for (int row = blockIdx.x * 8 + wave; row < T * 8; row += gridDim.x * 8) {
        const int t = row >> 3, h = row & 7, b = t >> 13, s = t & 8191, vh = lane >> 5, d = (lane & 31) * 4;
        const u32x2 o1 = *(const u32x2*)(Oat + ((size_t)(((b * 8 + h) * 2 + 0) * 2 + vh) * SEQ + s) * 128 + d);
        const u32x2 o2 = *(const u32x2*)(Oat + ((size_t)(((b * 8 + h) * 2 + 1) * 2 + vh) * SEQ + s) * 128 + d);
        float v[4] = {bflo(o1.x) - lam * bflo(o2.x), bfhi(o1.x) - lam * bfhi(o2.x), bflo(o1.y) - lam * bflo(o2.y), bfhi(o1.y) - lam * bfhi(o2.y)};
        float ss = v[0] * v[0] + v[1] * v[1] + v[2] * v[2] + v[3] * v[3];
        ss = wave_sum(ss);
        const float rms = rsqrtf(ss * (1.f / 256.f) + NORM_EPS) * om;
        const f32x4 gv = *(const f32x4*)(sg + vh * 128 + d);
        u32x2 w; w.x = cvt_pk_bf16(v[0] * rms * gv[0], v[1] * rms * gv[1]); w.y = cvt_pk_bf16(v[2] * rms * gv[2], v[3] * rms * gv[3]);
        *(u32x2*)(obuf + (size_t)t * D + h * 256 + vh * 128 + d) = w;
    }
    __syncthreads();
}

#define INS16(Lr, vv) do { _Pragma("unroll") for (int k_ = 0; k_ < 16; ++k_) { const float hi_ = fmaxf(Lr[k_], vv); vv = fminf(Lr[k_], vv); Lr[k_] = hi_; } } while (0)
DI void sort16_desc(float (&L)[16]) {
#pragma unroll
    for (int k = 2; k <= 16; k <<= 1)
#pragma unroll
        for (int j = k >> 1; j >= 1; j >>= 1)
#pragma unroll
            for (int i = 0; i < 16; ++i) { const int l = i ^ j;
                if (l > i) { const float hi_ = fmaxf(L[i], L[l]), lo_ = fminf(L[i], L[l]); const bool desc = (i & k) == 0; L[i] = desc ? hi_ : lo_; L[l] = desc ? lo_ : hi_; } }
}
template <int XM> DI void merge16(float (&L)[16]) {
    float P[16];
#pragma unroll
    for (int i = 0; i < 16; ++i) P[i] = sw_xor<XM>(L[15 - i]);
#pragma unroll
    for (int i = 0; i < 16; ++i) L[i] = fmaxf(L[i], P[i]);
#pragma unroll
    for (int s = 8; s >= 1; s >>= 1)
#pragma unroll
        for (int i = 0; i < 16; ++i) if ((i & s) == 0) { const float hi_ = fmaxf(L[i], L[i + s]), lo_ = fminf(L[i], L[i + s]); L[i] = hi_; L[i + s] = lo_; }
}
__constant__ unsigned char kStair[56] = {0, 1, 2, 3, 4, 5, 6, 7, 8, 9, 10, 11, 12, 13, 14, 15, 16, 17, 18, 19, 20, 21, 22, 23, 32, 33, 34, 35, 36, 48, 49, 50, 51, 64, 65, 66, 80, 81, 96, 97, 112, 113, 128, 144, 160, 176, 192, 208, 224, 240, 255, 255, 255, 255, 255, 255};
DI void ph_peer_topk(PK p, int l, unsigned char* lds, const int wv) {
    PK_FRESH(p);
    const int tid = ltid(wv);
    float* tops = (float*)lds; float* fin = tops + 64 * 2 * 16;
    const bf16_t* pq = WSP(const bf16_t, WS_PQ);
    int* pidx = WSP(int, WS_PIDX); float* pgate = WSP(float, WS_PGATE);
    const float NEG = -__builtin_inff();
    const int rowl = tid >> 3, half = (tid >> 2) & 1, quarter = tid & 3, l8 = tid & 7;
    const int nitems = T * 8 / 64;
    const int lane = tid & 63, wave = __builtin_amdgcn_readfirstlane(tid >> 6);
    int crow = blockIdx.x * 8 + wave; const int cstep = gridDim.x * 8;
    u32x4 wn[4];
    if ((int)blockIdx.x < nitems) { const int row = blockIdx.x * 64 + rowl; const bf16_t* sp = pq + (size_t)(row >> 3) * 2048 + (row & 7) * 256 + half * 128 + quarter * 32;
#pragma unroll
        for (int c = 0; c < 4; ++c) wn[c] = *(const u32x4*)(sp + c * 8); }
    for (int item = blockIdx.x; item < nitems; item += gridDim.x) {
        const int row0 = item * 64;
        u32x4 wc[4];
#pragma unroll
        for (int c = 0; c < 4; ++c) wc[c] = wn[c];
        { const int itn = (item + (int)gridDim.x < nitems) ? item + (int)gridDim.x : item; const int row = itn * 64 + rowl;
          const bf16_t* sp = pq + (size_t)(row >> 3) * 2048 + (row & 7) * 256 + half * 128 + quarter * 32;
#pragma unroll
          for (int c = 0; c < 4; ++c) wn[c] = *(const u32x4*)(sp + c * 8); }
        f32x4 cv[8]; const bool cA = crow < 2 * 16384; if (cA) pc_load(p, l, crow, cv, lane);
        float Lr[16], Lq[16];
#pragma unroll
        for (int c = 0; c < 4; ++c)
#pragma unroll
            for (int e = 0; e < 4; ++e) { const unsigned w = wc[c][e];
                const float v0 = __uint_as_float((w << 16) | (unsigned)(quarter * 32 + c * 8 + e * 2)), v1 = __uint_as_float((w & 0xffff0000u) | (unsigned)(quarter * 32 + c * 8 + e * 2 + 1));
                if (c < 2) { Lr[c * 8 + e * 2] = v0; Lr[c * 8 + e * 2 + 1] = v1; } else { Lq[(c - 2) * 8 + e * 2] = v0; Lq[(c - 2) * 8 + e * 2 + 1] = v1; } }
        sort16_desc(Lr); sort16_desc(Lq);
#pragma unroll
        for (int i = 0; i < 16; ++i) Lr[i] = fmaxf(Lr[i], Lq[15 - i]);
#pragma unroll
        for (int s = 8; s >= 1; s >>= 1)
#pragma unroll
            for (int i = 0; i < 16; ++i) if ((i & s) == 0) { const float hi_ = fmaxf(Lr[i], Lr[i + s]), lo_ = fminf(Lr[i], Lr[i + s]); Lr[i] = hi_; Lr[i + s] = lo_; }
        if (cA) { pc_store(p, crow, cv, lane); crow += cstep; }
        const bool cB = crow < 2 * 16384; if (cB) pc_load(p, l, crow, cv, lane);
        merge16<1>(Lr); merge16<2>(Lr);
        if (quarter == 0) {
#pragma unroll
            for (int k = 0; k < 16; ++k) tops[(rowl * 2 + half) * 16 + k] = Lr[k];
        }
        asm volatile("s_waitcnt lgkmcnt(0)" ::: "memory");
        float M[16];
#pragma unroll
        for (int k = 0; k < 16; ++k) M[k] = NEG;
        {
            const float* ta = tops + (rowl * 2) * 16; const float* tb = ta + 16;
#pragma unroll
            for (int m = 0; m < 7; ++m) { const unsigned code = kStair[l8 + 8 * m];
                float s = (code < 255u) ? ta[code >> 4] + tb[code & 15u] : NEG;
                s = (code < 255u) ? __uint_as_float((__float_as_uint(s) & ~255u) | code) : NEG; INS16(M, s); }
        }
        merge16<1>(M); merge16<2>(M); merge16<4>(M);
        float sum = 0.f;
#pragma unroll
        for (int k = 0; k < 16; ++k) sum += __expf(M[k] - M[0]);
        if (l8 == 0) {
#pragma unroll
            for (int k = 0; k < 16; ++k) fin[rowl * 16 + k] = M[k];
        }
        asm volatile("s_waitcnt lgkmcnt(0)" ::: "memory");
        {
            const float inv = 1.f / sum, m0 = M[0]; const int row = row0 + rowl; const size_t ob = (size_t)(row >> 3) * 128 + (row & 7) * 16;
#pragma unroll
            for (int u = 0; u < 2; ++u) { const int k = l8 * 2 + u; const float mk = fin[rowl * 16 + k]; const unsigned code = __float_as_uint(mk) & 255u;
                const unsigned i1 = __float_as_uint(tops[(rowl * 2) * 16 + (code >> 4)]) & 127u, i2 = __float_as_uint(tops[(rowl * 2 + 1) * 16 + (code & 15u)]) & 127u;
                pidx[ob + k] = (int)(i1 * 128u + i2); pgate[ob + k] = __expf(mk - m0) * inv; }
        }
        if (cB) { pc_store(p, crow, cv, lane); crow += cstep; }
        asm volatile("s_waitcnt lgkmcnt(0)" ::: "memory");
    }
    for (; crow < 2 * 16384; crow += cstep) { f32x4 cv[8]; pc_load(p, l, crow, cv, lane); pc_store(p, crow, cv, lane); }
}

DI float gelu_f(float v) {
    const float av = fabsf(v), t = __builtin_amdgcn_rcpf(fmaf(av, 0.2316418882f, 1.0f));
    float q = fmaf(t, 0.5307027145f, -0.7265760135f); q = fmaf(q, t, 0.7107068705f); q = fmaf(q, t, -0.142248368f); q = fmaf(q, t, 0.127414796f); q = q * t;
    const float e = __builtin_amdgcn_exp2f(v * v * -0.72134752044f), m = v * (q * e);
    return v < 0.f ? m : v - m;
}
#define FP4X8(w, o) const f32x2 o##0 = __builtin_amdgcn_cvt_scalef32_pk_f32_fp4(w, 1.0f, 0), o##1 = __builtin_amdgcn_cvt_scalef32_pk_f32_fp4(w, 1.0f, 1), \
                                o##2 = __builtin_amdgcn_cvt_scalef32_pk_f32_fp4(w, 1.0f, 2), o##3 = __builtin_amdgcn_cvt_scalef32_pk_f32_fp4(w, 1.0f, 3)
DI void ph_peer_gather(PK p, int l, unsigned char* lds, const int wv, const bool apply = true) {
    PK_FRESH(p);
    const int tid = ltid(wv), lane = tid & 63, wave = __builtin_amdgcn_readfirstlane(tid >> 6);
    const bf16_t* hb = WSP(const bf16_t, WS_HBUF); const unsigned char* ub = WSP(const unsigned char, WS_PU); const unsigned char* vb = WSP(const unsigned char, WS_PV);
    const unsigned* pus = WSP(const unsigned, WS_PUS); const unsigned* pvs = WSP(const unsigned, WS_PVS);
    const int* pidx = WSP(const int, WS_PIDX); const float* pgate = WSP(const float, WS_PGATE); bf16_t* xc = WSP(bf16_t, WS_XCUR);
    const float* gt2 = WSP(const float, WS_MOD) + l * 12288 + 5 * 2048;
    const unsigned l16 = (unsigned)lane * 16u, l4 = (unsigned)lane * 4u; const unsigned char* pus8 = (const unsigned char*)pus; const unsigned char* pvs8 = (const unsigned char*)pvs;
    for (int tok = blockIdx.x * 8 + wave; tok < T; tok += gridDim.x * 8) {
        f32x2 hf2[16];
#pragma unroll
        for (int c = 0; c < 4; ++c) { const u32x4 w = *(const u32x4*)(hb + (size_t)tok * D + lane * 32 + c * 8);
            hf2[c * 4 + 0] = (f32x2){bflo(w.x), bfhi(w.x)}; hf2[c * 4 + 1] = (f32x2){bflo(w.y), bfhi(w.y)}; hf2[c * 4 + 2] = (f32x2){bflo(w.z), bfhi(w.z)}; hf2[c * 4 + 3] = (f32x2){bflo(w.w), bfhi(w.w)}; }
        f32x2 acc2[16];
#pragma unroll
        for (int i = 0; i < 16; ++i) acc2[i] = (f32x2){0.f, 0.f};
        u32x2* sraw = (u32x2*)(lds + wave * 2048); u32x2* ssrt = sraw + 128;
        {
            const unsigned k0 = (unsigned)pidx[(size_t)tok * 128 + lane], k1 = (unsigned)pidx[(size_t)tok * 128 + 64 + lane];
            const float g0 = pgate[(size_t)tok * 128 + lane], g1 = pgate[(size_t)tok * 128 + 64 + lane];
            sraw[lane] = (u32x2){k0, __float_as_uint(g0)}; sraw[64 + lane] = (u32x2){k1, __float_as_uint(g1)};
            asm volatile("s_waitcnt lgkmcnt(0)" ::: "memory");
            const unsigned key0 = k0 * 128u + (unsigned)lane, key1 = k1 * 128u + 64u + (unsigned)lane; unsigned r0 = 0, r1 = 0;
            for (int j = 0; j < 128; ++j) { const unsigned kj = sraw[j].x * 128u + (unsigned)j; r0 += (kj < key0) ? 1u : 0u; r1 += (kj < key1) ? 1u : 0u; }
            ssrt[r0] = (u32x2){k0, __float_as_uint(g0)}; ssrt[r1] = (u32x2){k1, __float_as_uint(g1)};
            asm volatile("s_waitcnt lgkmcnt(0)" ::: "memory");
        }
#define G_LOAD(gi, UR, VR, US, VS, GT) do { _Pragma("unroll") for (int q = 0; q < 4; ++q) { const u32x2 pr = ssrt[(gi) * 4 + q]; const unsigned e_ = (unsigned)__builtin_amdgcn_readfirstlane((int)pr.x); GT[q] = __uint_as_float(pr.y); \
            UR[q] = *(const u32x4*)(ub + (size_t)e_ * 1024 + l16); US[q] = *(const unsigned*)(pus8 + (size_t)e_ * 256 + l4); \
            VR[q] = *(const u32x4*)(vb + (size_t)e_ * 1024 + l16); VS[q] = *(const unsigned*)(pvs8 + (size_t)e_ * 256 + l4); } } while (0)
#define G_COMP(UR, VR, US, VS, GT) do { float cf[4]; \
            _Pragma("unroll") for (int q = 0; q < 4; ++q) { float d0 = 0.f, d1 = 0.f; \
                _Pragma("unroll") for (int c = 0; c < 4; ++c) { FP4X8(UR[q][c], a); \
                    f32x2 t2 = a0 * hf2[c * 4 + 0]; t2 = a1 * hf2[c * 4 + 1] + t2; t2 = a2 * hf2[c * 4 + 2] + t2; t2 = a3 * hf2[c * 4 + 3] + t2; \
                    if (c < 2) d0 += t2.x + t2.y; else d1 += t2.x + t2.y; } \
                const float d = wave_sum(fmaf(d0, bflo(US[q]), d1 * bfhi(US[q]))); \
                cf[q] = GT[q] * gelu_f(d); } \
            _Pragma("unroll") for (int q = 0; q < 4; ++q) { const float cs0 = cf[q] * bflo(VS[q]), cs1 = cf[q] * bfhi(VS[q]); \
                _Pragma("unroll") for (int c = 0; c < 4; ++c) { FP4X8(VR[q][c], b); const float cs = (c < 2) ? cs0 : cs1; const f32x2 cs2 = {cs, cs}; \
                    acc2[c * 4 + 0] = cs2 * b0 + acc2[c * 4 + 0]; acc2[c * 4 + 1] = cs2 * b1 + acc2[c * 4 + 1]; acc2[c * 4 + 2] = cs2 * b2 + acc2[c * 4 + 2]; acc2[c * 4 + 3] = cs2 * b3 + acc2[c * 4 + 3]; } } } while (0)
        {
            u32x4 urA[4], vrA[4], urB[4], vrB[4]; unsigned usA[4], vsA[4], usB[4], vsB[4]; float gtA[4], gtB[4];
            G_LOAD(0, urA, vrA, usA, vsA, gtA);
            for (int g = 0; g < 32; g += 2) {
                G_LOAD(g + 1, urB, vrB, usB, vsB, gtB);
                G_COMP(urA, vrA, usA, vsA, gtA);
                G_LOAD((g + 2 < 32) ? g + 2 : 31, urA, vrA, usA, vsA, gtA);
                G_COMP(urB, vrB, usB, vsB, gtB);
            }
        }
#undef G_LOAD
#undef G_COMP
        float acc[32];
#pragma unroll
        for (int i = 0; i < 16; ++i) { acc[2 * i] = acc2[i].x; acc[2 * i + 1] = acc2[i].y; }
        if (!apply) { if (p->ph_hi == -12345) { for (int i = 0; i < 32; ++i) xc[i * 64 + lane] = f2bf(acc[i]); } continue; }
        const int b = tok >> 13; const float gm = ((MK_SKIP >> (2 * l + 1)) & 1) ? 0.f : 1.f;
        float ss = 0.f;
#pragma unroll
        for (int c = 0; c < 4; ++c) { const int col = lane * 32 + c * 8; bf16_t* xp = xc + (size_t)tok * D + col;
            const u32x4 xb = *(const u32x4*)xp; const f32x4 g0 = *(const f32x4*)(gt2 + (size_t)b * MODC + col), g1 = *(const f32x4*)(gt2 + (size_t)b * MODC + col + 4);
            const float x8[8] = {bflo(xb.x), bfhi(xb.x), bflo(xb.y), bfhi(xb.y), bflo(xb.z), bfhi(xb.z), bflo(xb.w), bfhi(xb.w)}; float y8[8];
#pragma unroll
            for (int e2 = 0; e2 < 8; ++e2) { y8[e2] = x8[e2] + gm * ((e2 < 4) ? g0[e2] : g1[e2 - 4]) * acc[c * 8 + e2]; acc[c * 8 + e2] = y8[e2]; ss += y8[e2] * y8[e2]; }
            if (l < 3) { u32x4 w; w.x = cvt_pk_bf16(y8[0], y8[1]); w.y = cvt_pk_bf16(y8[2], y8[3]); w.z = cvt_pk_bf16(y8[4], y8[5]); w.w = cvt_pk_bf16(y8[6], y8[7]); *(u32x4*)xp = w; } }
        const float rn = rsqrtf(wave_sum(ss) * (1.f / D) + NORM_EPS);
        const float* modall = WSP(const float, WS_MOD) + (size_t)b * MODC;
        if (l == 3) {
#pragma unroll
            for (int c = 0; c < 8; ++c) { const int col = lane * 32 + c * 4; const f32x4 gv = *(const f32x4*)(p->in[25] + col); f32x4 o;
#pragma unroll
                for (int e2 = 0; e2 < 4; ++e2) o[e2] = acc[c * 4 + e2] * rn * gv[e2];
                *(f32x4*)(p->out + (size_t)tok * D + col) = o; }
        } else {
            const float* g1 = (l == 1) ? p->in[13] : (p->in[5] + (l + 1) * D);
            const float* sh1 = (l == 1) ? (modall + 4 * 12288) : (modall + (l + 1) * 12288);
            const float* sc1 = sh1 + D;
            bf16_t* d1 = WSP(bf16_t, WS_HBUF) + (size_t)tok * D;
#pragma unroll
            for (int c = 0; c < 4; ++c) { u32x4 w;
#pragma unroll
                for (int hh = 0; hh < 2; ++hh) { const int col = lane * 32 + c * 8 + hh * 4; const f32x4 gv = *(const f32x4*)(g1 + col), sv = *(const f32x4*)(sh1 + col), cv = *(const f32x4*)(sc1 + col); float o[4];
#pragma unroll
                    for (int e2 = 0; e2 < 4; ++e2) o[e2] = acc[c * 8 + hh * 4 + e2] * rn * gv[e2] * (1.f + cv[e2]) + sv[e2];
                    w[hh * 2] = cvt_pk_bf16(o[0], o[1]); w[hh * 2 + 1] = cvt_pk_bf16(o[2], o[3]); }
                *(u32x4*)(d1 + lane * 32 + c * 8) = w; }
            if (l == 1) {
                const float* g2 = p->in[5] + 2 * D; const float* sh2 = modall + 2 * 12288; const float* sc2 = sh2 + D;
                bf16_t* d2 = WSP(bf16_t, WS_OBUF) + (size_t)tok * D;
#pragma unroll
                for (int c = 0; c < 4; ++c) { u32x4 w;
#pragma unroll
                    for (int hh = 0; hh < 2; ++hh) { const int col = lane * 32 + c * 8 + hh * 4; const f32x4 gv = *(const f32x4*)(g2 + col), sv = *(const f32x4*)(sh2 + col), cv = *(const f32x4*)(sc2 + col); float o[4];
#pragma unroll
                        for (int e2 = 0; e2 < 4; ++e2) o[e2] = acc[c * 8 + hh * 4 + e2] * rn * gv[e2] * (1.f + cv[e2]) + sv[e2];
                        w[hh * 2] = cvt_pk_bf16(o[0], o[1]); w[hh * 2 + 1] = cvt_pk_bf16(o[2], o[3]); }
                    *(u32x4*)(d2 + lane * 32 + c * 8) = w; }
            }
        }
    }
}
#undef FP4X8

DI void ph_dbg(PK p, int mode, const int wv) {
    PK_FRESH(p);
    const int tid = ltid(wv);
    const bf16_t* Ag = WSP(const bf16_t, WS_GA); const bf16_t* Bg = WSP(const bf16_t, WS_GB); const bf16_t* Qg = WSP(const bf16_t, WS_GQ); const bf16_t* Og = WSP(const bf16_t, WS_GO); const bf16_t* Sg = WSP(const bf16_t, WS_GS);
    const bf16_t* proj = WSP(const bf16_t, WS_PROJ); bf16_t* obuf = WSP(bf16_t, WS_OBUF);
    for (int idx = blockIdx.x * 512 + tid; idx < T * D; idx += gridDim.x * 512) {
        const int tok = idx >> 11, col = idx & 2047, hd = col >> 7, v = col & 127, b = tok >> 13, s = tok & 8191, n = s >> 6, i = s & 63;
        const size_t ci = (size_t)(b * 16 + hd) * 128 + n;
        float r = 0.f;
        if (mode == 1) r = bf2f(Og[ci * 8192 + i * 128 + v]) + bf2f(Qg[ci * 8192 + i * 128 + v]);
        if (mode == 2) r = bf2f(Ag[ci * 16384 + i * 128 + v]) + bf2f(Bg[ci * 16384 + (i + 64) * 128 + v]) + bf2f(Ag[ci * 16384 + (i + 64) * 128 + v]) + bf2f(Bg[ci * 16384 + i * 128 + v]);
        if (mode == 3) r = bf2f(Sg[ci * 16384 + i * 128 + v]) + bf2f(Sg[ci * 16384 + (i + 64) * 128 + v]);
        if (mode == 4) r = bf2f(proj[(size_t)tok * GINP + col]) + bf2f(proj[(size_t)tok * GINP + 2048 + col]) + bf2f(proj[(size_t)tok * GINP + 4096 + col]) + bf2f(proj[(size_t)tok * GINP + 6144 + col]) + ((col < 256) ? bf2f(proj[(size_t)tok * GINP + 8192 + col]) : 0.f);
        obuf[idx] = f2bf(r);
    }
}
#ifndef MK_AOUT
#define MK_AOUT obuf
#endif
constexpr int NPHASES = 1 + 1 + 2 * 9 + 2 * 8 + 1;

__global__ void __launch_bounds__(512, 2) mk_fwd(Params p_arg) {
    extern __shared__ __attribute__((aligned(16))) unsigned char lds[];
    PK p = (PK)__builtin_amdgcn_kernarg_segment_ptr();
    const int lo = p->ph_lo, hi = p->ph_hi;
    const int wv = __builtin_amdgcn_readfirstlane((int)threadIdx.x >> 6);
    volatile LAS unsigned* st = (volatile LAS unsigned*)((LAS unsigned char*)lds + LDS_BARW);
    if (wv == 0 && lane_id() == 0) { st[0] = 0u; st[1] = 0u; }
    __syncthreads();
    XcdBarrier bar; bar.bar = (unsigned*)(p->ws + WS_BAR); bar.x = 0; bar.st = st; bar.wv = wv;
    if (hi - lo > 1) bar = xcd_barrier_post((unsigned*)(p->ws + WS_BAR), st, wv);
    int ph = 0;
#define PH_BEGIN if (lo <= ph && ph < hi) { PK_FRESH(p);
#define PH_END   if (ph + 1 < hi) xcd_barrier(bar); } ++ph;
#define mod  WSP(const float, WS_MOD)
#define xcur WSP(bf16_t, WS_XCUR)
#define hbuf WSP(bf16_t, WS_HBUF)
#define obuf WSP(bf16_t, WS_OBUF)
#define G    ((int)gridDim.x)
#define bx   ((int)blockIdx.x)
#define modl (mod + l * 12288)

    PH_BEGIN ph_prologue(p, lds, wv); if (MK_DUP & 1) { __syncthreads(); ph_prologue(p, lds, wv); } PH_END

    for (int l = 0; l < DEPTH; ++l) {
        if (l == 0) { PH_BEGIN ph_norm<0>(p->in[0], nullptr, p->in[5], modl + 0 * D, modl + 1 * D, hbuf, nullptr, wv); PH_END }
        PH_BEGIN
            pg8::Gemm g; pg8::EpiMk E; E.mode = 0; E.xin = nullptr; E.xinb = nullptr; E.xout = nullptr; E.gate = nullptr; E.gmul = 1.f; E.xoutf = nullptr; E.O2 = nullptr; E.nrope = 0; E.cosT = WSP(const float, WS_COS); E.sinT = WSP(const float, WS_SIN);
            g.A = (l == 2) ? obuf : hbuf; g.M = T; g.K = D; g.ld = D; g.ksplit = 0;
            if (l < 2) { g.Bt = WSP(const bf16_t, WS_WIN) + (size_t)l * GINP * D; g.N = 8192; E.O = WSP(bf16_t, WS_PROJ); E.ldc = GINP; }
            else { g.Bt = WSP(const bf16_t, WS_DWQ) + (size_t)(l - 2) * D * D; g.N = D; E.mode = 2; E.O = WSP(bf16_t, WS_QD); E.nrope = D; }
            pg8::StaticOrder S; S.init(g.M, g.N, G, bx);
            pg8::gemm_phase<pg8::EpiMk, pg8::StaticOrder>((PG8_LAS unsigned char*)lds, g, S, E, wv);
            if (MK_DUP & 2) { __syncthreads(); pg8::gemm_phase<pg8::EpiMk, pg8::StaticOrder>((PG8_LAS unsigned char*)lds, g, S, E, wv); }
            if (l < 2) {
                pg8::Gemm g2; g2.A = hbuf; g2.Bt = WSP(const bf16_t, WS_WIN) + (size_t)l * GINP * D + (size_t)8192 * D; g2.M = T; g2.N = 1024; g2.K = 512; g2.ld = D; g2.ksplit = 1;
                pg8::EpiMk E2 = E; E2.mode = 3; E2.xoutf = WSP(float, WS_PAB);
                pg8::StaticOrder S2; S2.init(g2.M, g2.N, G, bx);
                pg8::gemm_phase<pg8::EpiMk, pg8::StaticOrder>((PG8_LAS unsigned char*)lds, g2, S2, E2, wv);
            }
        PH_END
        if (l < 2) {
            PH_BEGIN ph_gdn_p1(p, l, lds, wv); if (MK_DUP & 8) { __syncthreads(); ph_gdn_p1(p, l, lds, wv); } PH_END
            PH_BEGIN ph_gdn_p2(p, lds, wv); if (MK_DUP & 16) { __syncthreads(); ph_gdn_p2(p, lds, wv); } PH_END
#ifdef MK_DBG
            PH_BEGIN ph_dbg(p, MK_DBG, wv); PH_END
#else
            PH_BEGIN ph_gdn_p3(p, l, wv); if (MK_DUP & 32) { __syncthreads(); ph_gdn_p3(p, l, wv); } PH_END
#endif
        } else {
            PH_BEGIN ph_attn(p, lds, wv); if (MK_DUP & 64) { __syncthreads(); ph_attn(p, lds, wv); } PH_END
            PH_BEGIN ph_diff_combine(p, l - 2, l, lds, wv); PH_END
        }
        PH_BEGIN
            pg8::Gemm g; pg8::EpiMk E; E.mode = 1; E.O = nullptr; E.ldc = 0; E.xoutf = nullptr; E.O2 = nullptr; E.nrope = 0; E.cosT = nullptr; E.sinT = nullptr; E.xin = (l == 0) ? p->in[0] : nullptr; E.xinb = xcur; E.xout = xcur; E.gate = modl + 2 * D; E.gmul = ((MK_SKIP >> (2 * l)) & 1) ? 0.f : 1.f;
            g.A = MK_AOUT; g.M = T; g.K = D; g.N = D; g.ld = D; g.ksplit = 0;
            g.Bt = (l < 2) ? (WSP(const bf16_t, WS_WOUT) + (size_t)l * D * D) : (WSP(const bf16_t, WS_DWO) + (size_t)(l - 2) * D * D);
            pg8::StaticOrder S; S.init(g.M, g.N, G, bx);
            pg8::gemm_phase<pg8::EpiMk, pg8::StaticOrder>((PG8_LAS unsigned char*)lds, g, S, E, wv);
        PH_END
        PH_BEGIN ph_norm<2>(nullptr, xcur, p->in[6] + l * D, modl + 3 * D, modl + 4 * D, hbuf, nullptr, wv); PH_END
        PH_BEGIN
            pg8::Gemm g; pg8::EpiMk E; E.mode = 0; E.xin = nullptr; E.xinb = nullptr; E.xout = nullptr; E.gate = nullptr; E.gmul = 1.f; E.xoutf = nullptr; E.O2 = nullptr; E.nrope = 0; E.cosT = WSP(const float, WS_COS); E.sinT = WSP(const float, WS_SIN); E.O = WSP(bf16_t, WS_PQ); E.ldc = D;
            g.A = hbuf; g.M = T; g.K = D; g.N = D; g.ld = D; g.ksplit = 0; g.Bt = WSP(const bf16_t, WS_PWQ) + (size_t)l * D * D;
            pg8::StaticOrder S; S.init(g.M, g.N, G, bx);
            pg8::gemm_phase<pg8::EpiMk, pg8::StaticOrder>((PG8_LAS unsigned char*)lds, g, S, E, wv);
        PH_END
        PH_BEGIN ph_peer_topk(p, l, lds, wv); if (MK_DUP & 128) { __syncthreads(); ph_peer_topk(p, l, lds, wv); } PH_END
        PH_BEGIN ph_peer_gather(p, l, lds, wv); if (MK_DUP & 256) { __syncthreads(); ph_peer_gather(p, l, lds, wv, false); } PH_END
        if (l == 1) {
            PH_BEGIN
                pg8::Gemm g; pg8::EpiMk E; E.mode = 0; E.xin = nullptr; E.xinb = nullptr; E.xout = nullptr; E.gate = nullptr; E.gmul = 1.f; E.xoutf = nullptr; E.O2 = nullptr; E.nrope = 0; E.cosT = WSP(const float, WS_COS); E.sinT = WSP(const float, WS_SIN); E.mode = 2; E.O = WSP(bf16_t, WS_KSH); E.O2 = WSP(bf16_t, WS_VSH); E.nrope = 2048;
                g.A = hbuf; g.M = T; g.K = D; g.N = 4096; g.ld = D; g.ksplit = 0; g.Bt = WSP(const bf16_t, WS_KVW);
                pg8::StaticOrder S; S.init(g.M, g.N, G, bx);
                pg8::gemm_phase<pg8::EpiMk, pg8::StaticOrder>((PG8_LAS unsigned char*)lds, g, S, E, wv);
            PH_END
        }
    }
#undef PH_BEGIN
#undef PH_END
#undef mod
#undef xcur
#undef hbuf
#undef obuf
#undef G
#undef bx
#undef modl
}

extern "C" void kernel_launch(void* const* d_in, const int* in_sizes, int n_in, void* d_out, int out_size, void* d_ws, size_t ws_size, hipStream_t stream) {
    static int grid = 0;
    if (grid == 0) {
        if (n_in != 26 || in_sizes[0] != T * D || out_size != T * D || ws_size < WS_END) {
            fprintf(stderr, "kernel_launch: unexpected shapes: n_in %d in0 %d out %d ws %zu (need %zu)\n", n_in, n_in > 0 ? in_sizes[0] : -1, out_size, ws_size, (size_t)WS_END); grid = -1; return; }
        int dev = 0, cus = 0;
        if (hipGetDevice(&dev) != hipSuccess || hipDeviceGetAttribute(&cus, hipDeviceAttributeMultiprocessorCount, dev) != hipSuccess || cus <= 0) cus = 256;
        if (hipFuncSetAttribute((const void*)mk_fwd, hipFuncAttributeMaxDynamicSharedMemorySize, LDS_BYTES) != hipSuccess) { fprintf(stderr, "kernel_launch: hipFuncSetAttribute failed\n"); grid = -1; return; }
        int per_cu = 0;
        if (hipOccupancyMaxActiveBlocksPerMultiprocessor(&per_cu, (const void*)mk_fwd, 512, LDS_BYTES) != hipSuccess || per_cu < 1) fprintf(stderr, "kernel_launch: occupancy query says %d\n", per_cu);
        (void)hipGetLastError();
        grid = cus;
    }
    if (grid < 0) return;
    (void)hipMemsetAsync((char*)d_ws + WS_BAR, 0, 16384, stream);
    Params p{};
    for (int i = 0; i < 26; ++i) p.in[i] = (const float*)d_in[i];
    p.out = (float*)d_out; p.ws = (unsigned char*)d_ws;
#if MK_N_LAUNCHES == 1
    p.ph_lo = 0; p.ph_hi = NPHASES;
    hipLaunchKernelGGL(mk_fwd, dim3(grid), dim3(512), LDS_BYTES, stream, p);
#else
#ifndef MK_PHMASK
#define MK_PHMASK 0xffffffffu
#endif
#ifndef MK_STOP
#define MK_STOP NPHASES
#endif
    for (int ph = 0; ph < NPHASES; ++ph) { if (ph >= MK_STOP && ph != NPHASES - 1) continue; if (!(MK_PHMASK >> (ph < 31 ? ph : 31) & 1u) && ph != NPHASES - 1) continue; p.ph_lo = ph; p.ph_hi = ph + 1; hipLaunchKernelGGL(mk_fwd, dim3(grid), dim3(512), LDS_BYTES, stream, p); }
#endif
    const hipError_t le = hipPeekAtLastError();
    if (le != hipSuccess) fprintf(stderr, "kernel_launch: launch failed: %s\n", hipGetErrorName(le));
}
```

```cpp
#include <hip/hip_runtime.h>
#include <hip/hip_bf16.h>
#include <cstdio>
#include <cstdint>

#ifndef MK_N_LAUNCHES
#define MK_N_LAUNCHES 1
#endif
#ifndef MK_DUP
#define MK_DUP 0
#endif
#ifndef MK_SKIP
#define MK_SKIP 0
#endif

constexpr int NB = 2, SEQ = 8192, T = NB * SEQ, D = 2048, DEPTH = 4;
constexpr int GH = 16, GIN = 8224, GINP = 8448;
constexpr int MODC = 4 * 12288 + 4096;
constexpr float NORM_EPS = 1e-6f;

typedef unsigned short bf16_t;
typedef short bf16x8 __attribute__((ext_vector_type(8)));
typedef short s16x4 __attribute__((ext_vector_type(4)));
typedef float f32x4 __attribute__((ext_vector_type(4)));
typedef float f32x2 __attribute__((ext_vector_type(2)));
typedef float f32x16 __attribute__((ext_vector_type(16)));
typedef unsigned u32x4 __attribute__((ext_vector_type(4)));
typedef unsigned u32x2 __attribute__((ext_vector_type(2)));
typedef __bf16 bfx2 __attribute__((ext_vector_type(2)));
#define LAS __attribute__((address_space(3)))
#define DI __device__ __forceinline__

DI float bf2f(bf16_t v) { return __uint_as_float(((unsigned)v) << 16); }
DI float bflo(unsigned w) { return __uint_as_float(w << 16); }
DI float bfhi(unsigned w) { return __uint_as_float(w & 0xffff0000u); }
DI bf16_t f2bf(float f) { unsigned u = __float_as_uint(f); u += 0x7FFFu + ((u >> 16) & 1u); return (bf16_t)(u >> 16); }
DI unsigned cvt_pk_bf16(float lo, float hi) { const f32x2 v = {lo, hi}; return __builtin_bit_cast(unsigned, __builtin_convertvector(v, bfx2)); }
template <int M> DI float sw_xor(float v) { return __int_as_float(__builtin_amdgcn_ds_swizzle(__float_as_int(v), (M << 10) | 0x1f)); }
DI float sw_xor32_sum(float v) { auto rr = __builtin_amdgcn_permlane32_swap(__float_as_uint(v), __float_as_uint(v), false, false); return __uint_as_float(rr[0]) + __uint_as_float(rr[1]); }
DI float wave_max(float v) {
    v = fmaxf(v, sw_xor<1>(v)); v = fmaxf(v, sw_xor<2>(v)); v = fmaxf(v, sw_xor<4>(v)); v = fmaxf(v, sw_xor<8>(v)); v = fmaxf(v, sw_xor<16>(v));
    auto rr = __builtin_amdgcn_permlane32_swap(__float_as_uint(v), __float_as_uint(v), false, false); return fmaxf(__uint_as_float(rr[0]), __uint_as_float(rr[1]));
}
DI float wave_sum(float v) {
    v += sw_xor<1>(v); v += sw_xor<2>(v); v += sw_xor<4>(v); v += sw_xor<8>(v); v += sw_xor<16>(v);
    return sw_xor32_sum(v);
}
DI void lds_barrier() { asm volatile("s_waitcnt lgkmcnt(0)" ::: "memory"); __builtin_amdgcn_s_barrier(); asm volatile("" ::: "memory"); }
DI float silu_f(float v) { return v / (1.f + __expf(-v)); }
DI int lane_id() { int l; asm volatile("v_mbcnt_lo_u32_b32 %0, -1, 0\n\tv_mbcnt_hi_u32_b32 %0, -1, %0" : "=v"(l)); return l; }
DI int ltid(const int wv) { int t = wv * 64 + lane_id(); asm volatile("" : "+v"(t)); return t; }

constexpr size_t al4k(size_t x) { return (x + 4095) & ~(size_t)4095; }
constexpr size_t WS_BAR   = 0;
constexpr size_t WS_MOD   = 16384;
constexpr size_t WS_COS   = al4k(WS_MOD + (size_t)2 * MODC * 4);
constexpr size_t WS_SIN   = WS_COS + (size_t)T * 64 * 4;
constexpr size_t WS_SUBK  = WS_SIN + (size_t)T * 64 * 4;
constexpr size_t WS_WIN   = WS_SUBK + (size_t)4 * 2 * 128 * 128 * 2;
constexpr size_t WS_WOUT  = WS_WIN + (size_t)2 * GINP * D * 2;
constexpr size_t WS_KVW   = WS_WOUT + (size_t)2 * D * D * 2;
constexpr size_t WS_DWQ   = WS_KVW + (size_t)4096 * D * 2;
constexpr size_t WS_DWO   = WS_DWQ + (size_t)2 * D * D * 2;
constexpr size_t WS_PWQ   = WS_DWO + (size_t)2 * D * D * 2;
constexpr size_t WS_PU    = WS_PWQ + (size_t)4 * D * D * 2;
constexpr size_t WS_PUS   = WS_PU + (size_t)16384 * 1024;
constexpr size_t WS_PV    = WS_PU + (size_t)16384 * D * 2;
constexpr size_t WS_PVS   = WS_PV + (size_t)16384 * 1024;
constexpr size_t WS_XCUR  = WS_PV + (size_t)16384 * D * 2;
constexpr size_t WS_HBUF  = WS_XCUR + (size_t)T * D * 4;
constexpr size_t WS_OBUF  = WS_HBUF + (size_t)T * D * 2;
constexpr size_t WS_PROJ  = WS_OBUF + (size_t)T * D * 2;
constexpr size_t WS_PAB   = WS_PROJ + (size_t)T * GINP * 2;
constexpr size_t WS_PQ    = WS_PROJ + (size_t)T * GINP * 2;
constexpr size_t WS_PIDX  = WS_PQ + (size_t)T * D * 2;
constexpr size_t WS_PGATE = WS_PIDX + (size_t)T * 128 * 4;
constexpr size_t WS_GA    = WS_PGATE + (size_t)T * 128 * 4;
constexpr size_t WS_GB    = WS_GA + (size_t)4096 * 128 * 128 * 2;
constexpr size_t WS_GQ    = WS_GB + (size_t)4096 * 128 * 128 * 2;
constexpr size_t WS_GO    = WS_GQ + (size_t)4096 * 64 * 128 * 2;
constexpr size_t WS_GS    = WS_GO + (size_t)4096 * 64 * 128 * 2;
constexpr size_t WS_GL    = WS_GS + (size_t)4096 * 128 * 128 * 2;
constexpr size_t WS_END   = WS_GL + 16384;
constexpr size_t WS_OAT   = WS_GA;
constexpr size_t WS_KSH   = WS_GB;
constexpr size_t WS_VSH   = WS_GB + (size_t)67108864;
constexpr size_t WS_QD    = WS_GQ;

constexpr int LDS_BYTES = 147456;
constexpr int LDS_BARW  = 147456 - 64;

struct Params { const float* in[26]; float* out; unsigned char* ws; int ph_lo, ph_hi; };
typedef const Params __attribute__((address_space(4)))* PK;
#define PK_FRESH(p) asm volatile("" : "+s"(p))

#define XB_TMO      128
#define XB_XCNT(j)  (256  + 64 * (j))
#define XB_XSUB(j)  (1280 + 64 * (j))
#define XB_XGEN(j)  (2304 + 64 * (j))
#define XB_TOP      3328
#define XB_TOPGEN   3392
#define XCD_BAR_WORDS 3456
#define XB_SPIN_CAP (1u << 20)

__device__ __forceinline__ unsigned xb_ld(unsigned* p)              { return __hip_atomic_load(p, __ATOMIC_RELAXED, __HIP_MEMORY_SCOPE_AGENT); }
__device__ __forceinline__ unsigned xb_add(unsigned* p, unsigned v) { return __hip_atomic_fetch_add(p, v, __ATOMIC_RELAXED, __HIP_MEMORY_SCOPE_AGENT); }
__device__ __forceinline__ unsigned xb_xcc_id() { return (unsigned)__builtin_amdgcn_s_getreg((3 << 11) | 20) & 0xFu; }
#define XB_SPIN(cond, bar) do { unsigned _sp = 0; while (cond) { __builtin_amdgcn_s_sleep(1); \
    if ((++_sp & 255u) == 0u) { if (xb_ld(&(bar)[XB_TMO])) break; if (_sp > XB_SPIN_CAP) { atomicAdd(&(bar)[XB_TMO], 1u); break; } } } } while (0)

struct XcdBarrier { unsigned* bar; unsigned x; volatile LAS unsigned* st; int wv; };

__device__ __forceinline__ XcdBarrier xcd_barrier_post(unsigned* bar, volatile LAS unsigned* st, int wv) {
    XcdBarrier b; b.bar = bar; b.x = xb_xcc_id(); b.st = st; b.wv = wv;
    if (wv == 0 && lane_id() == 0) (void)xb_add(&bar[XB_XCNT(b.x)], 1u);
    return b;
}
__device__ __forceinline__ void xcd_barrier_complete(unsigned* bar, unsigned x, unsigned& nloc, unsigned& nx) {
    const unsigned G = gridDim.x * gridDim.y * gridDim.z;
    unsigned sum, cnt, mine, sp = 0u;
    for (;;) {
        sum = 0u; cnt = 0u; mine = 0u;
#pragma unroll
        for (unsigned j = 0; j < 16; ++j) { const unsigned c = xb_ld(&bar[XB_XCNT(j)]); sum += c; cnt += (c > 0u) ? 1u : 0u; mine = (j == x) ? c : mine; }
        if (sum == G) break;
        __builtin_amdgcn_s_sleep(1);
        if ((++sp & 255u) == 0u) { if (xb_ld(&bar[XB_TMO])) break; if (sp > XB_SPIN_CAP) { atomicAdd(&bar[XB_TMO], 1u); break; } }
    }
    nloc = mine > 0u ? mine : 1u; nx = cnt > 0u ? cnt : 1u;
}
__device__ __forceinline__ void xcd_barrier(const XcdBarrier& b) {
    asm volatile("s_waitcnt vmcnt(0)" ::: "memory");
    __syncthreads();
    if (b.wv == 0 && lane_id() == 0) {
        unsigned* bar = b.bar;
        __builtin_amdgcn_s_waitcnt(0);
        unsigned nloc = b.st[0], nx = b.st[1];
        if (nloc == 0u) { xcd_barrier_complete(bar, b.x, nloc, nx); b.st[0] = nloc; b.st[1] = nx; }
        const unsigned old = xb_add(&bar[XB_XSUB(b.x)], 1u);
        const unsigned gen = old / nloc;
        if (old + 1u == (gen + 1u) * nloc) {
            __builtin_amdgcn_fence(__ATOMIC_RELEASE, "agent");
            asm volatile("s_waitcnt vmcnt(0)" ::: "memory");
            const unsigned og = xb_add(&bar[XB_TOP], 1u);
            const unsigned tg = og / nx;
            if (og + 1u == (tg + 1u) * nx) xb_add(&bar[XB_TOPGEN], 1u);
            else XB_SPIN(xb_ld(&bar[XB_TOPGEN]) == tg, bar);
            __builtin_amdgcn_fence(__ATOMIC_ACQUIRE, "agent");
            xb_add(&bar[XB_XGEN(b.x)], 1u);
            asm volatile("s_waitcnt vmcnt(0)" ::: "memory");
        } else {
            XB_SPIN(xb_ld(&bar[XB_XGEN(b.x)]) == gen, bar);
            __builtin_amdgcn_fence(__ATOMIC_ACQUIRE, "agent");
            asm volatile("s_waitcnt vmcnt(0)" ::: "memory");
        }
    }
    __syncthreads();
}

namespace pg8 {
#define PG8_LAS __attribute__((address_space(3)))
constexpr int BM = 256, BK = 64, HALF = 128, HTB = HALF * BK * 2, STAGE_BYTES = 8 * HTB, NXCD = 8, WGM = 8;
__host__ __device__ __forceinline__ int lds_byte(int r, int c) { const int st = (r >> 4) * 2 + (c >> 5), rr = r & 15, cc = c & 31, ob = rr * 64 + cc * 2; return st * 1024 + (ob ^ (((ob >> 9) & 1) << 5)); }
__host__ __device__ __forceinline__ void stage_rc(int b, int& R, int& C) { const int st = b / 1024, sb = b % 1024, swz = sb ^ (((sb >> 9) & 1) << 5); R = (st >> 1) * 16 + swz / 64; C = (st & 1) * 32 + (swz % 64) / 2; }
__host__ __device__ __forceinline__ int perm32(int rho) { const int n = rho >> 4, i = rho & 15; return 8 * (i >> 2) + 4 * n + (i & 3); }
struct Unit { int pm, pn; };
struct Gemm { const bf16_t* A; const bf16_t* Bt; int M, N, K; int ld; int ksplit; };
struct StaticOrder {
    int nM, nN, nwg, G, c;
    __host__ __device__ void init(int M, int N, int G_, int c_) { nM = M / BM; nN = N / BM; nwg = nM * nN; G = G_; c = c_; }
    __host__ __device__ bool next(int i, Unit& u) const {
        const long L = (long)i * G + c; if (L >= nwg) return false;
        int wgid = (int)L; { const int q = nwg / NXCD, r = nwg % NXCD, xcd = wgid % NXCD, off = wgid / NXCD; wgid = (xcd < r ? xcd * (q + 1) : r * (q + 1) + (xcd - r) * q) + off; }
        const int nig = WGM * nN, gid = wgid / nig, fm = gid * WGM, gsz = (nM - fm) < WGM ? (nM - fm) : WGM;
        u.pm = fm + ((wgid % nig) % gsz); u.pn = (wgid % nig) / gsz; return true;
    }
    __device__ __forceinline__ void a_ready(const Unit&) const {}
    __device__ __forceinline__ void done(const Unit&) const {}
};

struct EpiMk {
    static constexpr bool PERM = true, AFTER_DRAIN = false;
    int mode; bf16_t* O; int ldc; const float* xin; const bf16_t* xinb; bf16_t* xout; const float* gate; float gmul;
    bf16_t* O2; int nrope; const float* cosT; const float* sinT;
    float* xoutf;
    __device__ __forceinline__ void operator()(const f32x4 (&acc)[2][2][4][2], const Unit& u, int wr, int wc, int fr, int fq) const {
        const int row0 = u.pm * BM + wr * 64 + fr, col0 = u.pn * BM + wc * 32 + 8 * fq;
        if (mode == 0) {
#pragma unroll
            for (int ai = 0; ai < 2; ++ai)
#pragma unroll
                for (int m = 0; m < 4; ++m) { bf16_t* rowp = O + (size_t)(row0 + ai * HALF + m * 16) * ldc + col0;
#pragma unroll
                    for (int bj = 0; bj < 2; ++bj) { const f32x4 v0 = acc[ai][bj][m][0], v1 = acc[ai][bj][m][1];
                        u32x4 w; w.x = cvt_pk_bf16(v0[0], v0[1]); w.y = cvt_pk_bf16(v0[2], v0[3]); w.z = cvt_pk_bf16(v1[0], v1[1]); w.w = cvt_pk_bf16(v1[2], v1[3]);
                        *(u32x4*)(rowp + bj * HALF) = w; } }
        } else if (mode == 3) {
            if (wc == 0) {
#pragma unroll
                for (int ai = 0; ai < 2; ++ai)
#pragma unroll
                    for (int m = 0; m < 4; ++m) { const int row = row0 + ai * HALF + m * 16; float* dp = xoutf + ((size_t)u.pn * T + row) * 32 + 8 * fq;
                        *(f32x4*)dp = acc[ai][0][m][0]; *(f32x4*)(dp + 4) = acc[ai][0][m][1]; }
            }
        } else if (mode == 2) {
#pragma unroll
            for (int ai = 0; ai < 2; ++ai)
#pragma unroll
                for (int m = 0; m < 4; ++m) { const int row = row0 + ai * HALF + m * 16, bb = row >> 13, ss = row & 8191;
#pragma unroll
                    for (int bj = 0; bj < 2; ++bj) { const int col = col0 + bj * HALF; const f32x4 v0 = acc[ai][bj][m][0], v1 = acc[ai][bj][m][1];
                        if (col < nrope) { const int hc = col >> 7, j0 = ((col & 127) >> 3) * 4;
                            const f32x4 cs = *(const f32x4*)(cosT + (size_t)row * 64 + j0), sn = *(const f32x4*)(sinT + (size_t)row * 64 + j0);
                            bf16_t* dp = O + ((size_t)(bb * 16 + hc) * SEQ + ss) * 128 + j0;
                            u32x2 w1, w2; w1.x = cvt_pk_bf16(v0[0] * cs[0] - v1[0] * sn[0], v0[1] * cs[1] - v1[1] * sn[1]); w1.y = cvt_pk_bf16(v0[2] * cs[2] - v1[2] * sn[2], v0[3] * cs[3] - v1[3] * sn[3]);
                            w2.x = cvt_pk_bf16(v1[0] * cs[0] + v0[0] * sn[0], v1[1] * cs[1] + v0[1] * sn[1]); w2.y = cvt_pk_bf16(v1[2] * cs[2] + v0[2] * sn[2], v1[3] * cs[3] + v0[3] * sn[3]);
                            *(u32x2*)dp = w1; *(u32x2*)(dp + 64) = w2;
                        } else { const int cv = col - nrope, hc = cv >> 7;
                            u32x4 w; w.x = cvt_pk_bf16(v0[0], v0[1]); w.y = cvt_pk_bf16(v0[2], v0[3]); w.z = cvt_pk_bf16(v1[0], v1[1]); w.w = cvt_pk_bf16(v1[2], v1[3]);
                            *(u32x4*)(O2 + ((size_t)(bb * 16 + hc) * SEQ + ss) * 128 + (cv & 127)) = w; } } }
        } else {
#pragma unroll
            for (int ai = 0; ai < 2; ++ai)
#pragma unroll
                for (int m = 0; m < 4; ++m) { const int row = row0 + ai * HALF + m * 16; const float* gp = gate + (size_t)(row >> 13) * MODC + col0;
                    bf16_t* xo = xout + (size_t)row * D + col0;
#pragma unroll
                    for (int bj = 0; bj < 2; ++bj) {
                        const f32x4 g0 = *(const f32x4*)(gp + bj * HALF), g1 = *(const f32x4*)(gp + bj * HALF + 4);
                        f32x4 x0, x1;
                        if (xin) { x0 = *(const f32x4*)(xin + (size_t)row * D + col0 + bj * HALF); x1 = *(const f32x4*)(xin + (size_t)row * D + col0 + bj * HALF + 4); }
                        else { const u32x4 xb = *(const u32x4*)(xinb + (size_t)row * D + col0 + bj * HALF);
                            x0 = (f32x4){bflo(xb.x), bfhi(xb.x), bflo(xb.y), bfhi(xb.y)}; x1 = (f32x4){bflo(xb.z), bfhi(xb.z), bflo(xb.w), bfhi(xb.w)}; }
                        const f32x4 y0 = x0 + gmul * g0 * acc[ai][bj][m][0], y1 = x1 + gmul * g1 * acc[ai][bj][m][1];
                        u32x4 w; w.x = cvt_pk_bf16(y0[0], y0[1]); w.y = cvt_pk_bf16(y0[2], y0[3]); w.z = cvt_pk_bf16(y1[0], y1[1]); w.w = cvt_pk_bf16(y1[2], y1[3]);
                        *(u32x4*)(xo + bj * HALF) = w; } }
        }
    }
};

template <class Epi, class Sched>
__device__ __forceinline__ void gemm_phase(PG8_LAS unsigned char* lds, const Gemm g, const Sched& S, const Epi& E, const int wv) {
    const int tid = ltid(wv), wid = __builtin_amdgcn_readfirstlane(tid >> 6), lane = tid & 63, wr = wid >> 2, wc = wid & 3, fr = lane & 15, fq = lane >> 4;
    const int K = g.K, nt = K / BK, ld = g.ld;
    unsigned voffA[2], voffB[2];
#pragma unroll
    for (int i = 0; i < 2; ++i) { int R, C; stage_rc(tid * 16 + i * 8192, R, C); const int Rb = Epi::PERM ? ((R & ~31) + perm32(R & 31)) : R;
        voffA[i] = (unsigned)(R * ld + C) * 2u; voffB[i] = (unsigned)(Rb * ld + C) * 2u; }
    const size_t kstep = (size_t)(BK * 2);
    const size_t hstep = (size_t)HALF * ld * 2;
    const size_t tstep = 2 * hstep;
    const unsigned ldsw = (unsigned)wid * 1024u;
    const int aoff = lds_byte(wr * 64 + fr, fq * 8), boff = lds_byte(wc * 32 + fr, fq * 8);
#define PG8_SA(b, h) (((b) * 2 + (h)) * HTB)
#define PG8_SB(b, h) ((4 + (b) * 2 + (h)) * HTB)
#define PG8_STAGE(bufoff, gbase, voff) do { _Pragma("unroll") for (int _i = 0; _i < 2; ++_i) \
        __builtin_amdgcn_global_load_lds((const unsigned*)((const char*)(gbase) + (voff)[_i]), (PG8_LAS unsigned*)(lds + (bufoff) + ldsw + _i * 8192), 16, 0, 0); } while (0)
#define PG8_LDA(dst, b, h) do { _Pragma("unroll") for (int m = 0; m < 4; ++m) _Pragma("unroll") for (int k = 0; k < 2; ++k) dst[m][k] = *(const PG8_LAS bf16x8*)(lds + PG8_SA(b, h) + aoff + m * 2048 + k * 1024); } while (0)
#define PG8_LDB(dst, b, h) do { _Pragma("unroll") for (int n = 0; n < 2; ++n) _Pragma("unroll") for (int k = 0; k < 2; ++k) dst[n][k] = *(const PG8_LAS bf16x8*)(lds + PG8_SB(b, h) + boff + n * 2048 + k * 1024); } while (0)
#define PG8_MMA(ai, bj, At, Bt) do { __builtin_amdgcn_s_setprio(1); _Pragma("unroll") for (int m = 0; m < 4; ++m) _Pragma("unroll") for (int n = 0; n < 2; ++n) _Pragma("unroll") for (int k = 0; k < 2; ++k) \
        acc[ai][bj][m][n] = __builtin_amdgcn_mfma_f32_16x16x32_bf16(Bt[n][k], At[m][k], acc[ai][bj][m][n], 0, 0, 0); __builtin_amdgcn_s_setprio(0); } while (0)
#define PG8_WAIT_V(n) asm volatile("s_waitcnt vmcnt(" #n ")" ::: "memory")
#define PG8_WAIT_L(n) asm volatile("s_waitcnt lgkmcnt(" #n ")" ::: "memory")
#define PG8_BAR __builtin_amdgcn_s_barrier()
#define PG8_SCHED __builtin_amdgcn_sched_barrier(0)
    Unit cur, nxt; int ui = 0;
    if (!S.next(0, cur)) return;
    f32x4 acc[2][2][4][2];
#pragma unroll
    for (int a = 0; a < 2; ++a)
#pragma unroll
        for (int b = 0; b < 2; ++b)
#pragma unroll
            for (int m = 0; m < 4; ++m)
#pragma unroll
                for (int n = 0; n < 2; ++n) acc[a][b][m][n] = (f32x4){0.f, 0.f, 0.f, 0.f};
    bf16x8 At[4][2], B0[2][2], B1[2][2];
    const size_t bstep = g.ksplit ? (size_t)K * 2 : tstep, astep = g.ksplit ? (size_t)K * 2 : 0;
    const char* cA = (const char*)g.A + (size_t)cur.pm * tstep + (size_t)cur.pn * astep; const char* cB = (const char*)g.Bt + (size_t)cur.pn * bstep;
    S.a_ready(cur);
    PG8_STAGE(PG8_SB(0, 0), cB, voffB); PG8_STAGE(PG8_SA(0, 0), cA, voffA); PG8_STAGE(PG8_SB(0, 1), cB + hstep, voffB); PG8_STAGE(PG8_SA(0, 1), cA + hstep, voffA);
    if (wr == 1) PG8_BAR;
    PG8_WAIT_V(4); PG8_BAR;
    PG8_STAGE(PG8_SB(1, 0), cB + kstep, voffB); PG8_STAGE(PG8_SA(1, 0), cA + kstep, voffA); PG8_STAGE(PG8_SB(1, 1), cB + hstep + kstep, voffB);
    PG8_WAIT_V(6); PG8_BAR;
    for (;;) {
        const bool has_next = S.next(ui + 1, nxt);
        const char* nA = has_next ? (const char*)g.A + (size_t)nxt.pm * tstep + (size_t)nxt.pn * astep : cA; const char* nB = has_next ? (const char*)g.Bt + (size_t)nxt.pn * bstep : cB;
        for (int t = 0; t < nt; t += 2) {
            const bool last = (t == nt - 2);
            const char* a1 = cA + (size_t)(t + 1) * kstep;
            const char* a2 = last ? nA : cA + (size_t)(t + 2) * kstep; const char* b2 = last ? nB : cB + (size_t)(t + 2) * kstep;
            const char* a3 = a2 + kstep; const char* b3 = b2 + kstep;
            if (last && has_next) S.a_ready(nxt);
            PG8_LDB(B0, 0, 0); PG8_SCHED; PG8_LDA(At, 0, 0); PG8_STAGE(PG8_SA(1, 1), a1 + hstep, voffA);
            PG8_WAIT_L(8); PG8_BAR; PG8_WAIT_L(0); PG8_MMA(0, 0, At, B0); PG8_BAR; PG8_SCHED;
            PG8_LDB(B1, 0, 1); PG8_STAGE(PG8_SB(0, 0), b2, voffB);
            PG8_BAR; PG8_WAIT_L(0); PG8_MMA(0, 1, At, B1); PG8_BAR;
            PG8_LDA(At, 0, 1); PG8_STAGE(PG8_SA(0, 0), a2, voffA);
            PG8_BAR; PG8_WAIT_L(0); PG8_MMA(1, 0, At, B0); PG8_BAR; PG8_SCHED;
            PG8_STAGE(PG8_SB(0, 1), b2 + hstep, voffB);
            PG8_WAIT_V(6); PG8_BAR; PG8_MMA(1, 1, At, B1); PG8_BAR;
            PG8_LDB(B0, 1, 0); PG8_SCHED; PG8_LDA(At, 1, 0); PG8_STAGE(PG8_SA(0, 1), a2 + hstep, voffA);
            PG8_WAIT_L(8); PG8_BAR; PG8_WAIT_L(0); PG8_MMA(0, 0, At, B0); PG8_BAR; PG8_SCHED;
            PG8_LDB(B1, 1, 1); PG8_STAGE(PG8_SB(1, 0), b3, voffB);
            PG8_BAR; PG8_WAIT_L(0); PG8_MMA(0, 1, At, B1); PG8_BAR;
            PG8_LDA(At, 1, 1); PG8_STAGE(PG8_SA(1, 0), a3, voffA);
            PG8_BAR; PG8_WAIT_L(0); PG8_MMA(1, 0, At, B0); PG8_BAR; PG8_SCHED;
            PG8_STAGE(PG8_SB(1, 1), b3 + hstep, voffB);
            PG8_WAIT_V(6); PG8_BAR; PG8_MMA(1, 1, At, B1); PG8_BAR;
        }
        E(acc, cur, wr, wc, fr, fq); S.done(cur);
        if (!has_next) break;
#pragma unroll
        for (int a = 0; a < 2; ++a)
#pragma unroll
            for (int b = 0; b < 2; ++b)
#pragma unroll
                for (int m = 0; m < 4; ++m)
#pragma unroll
                    for (int n = 0; n < 2; ++n) acc[a][b][m][n] = (f32x4){0.f, 0.f, 0.f, 0.f};
        cur = nxt; cA = nA; cB = nB; ++ui;
    }
    PG8_WAIT_V(0);
    if (wr == 0) PG8_BAR;
    PG8_BAR;
#undef PG8_SA
#undef PG8_SB
#undef PG8_STAGE
#undef PG8_LDA
#undef PG8_LDB
#undef PG8_MMA
#undef PG8_WAIT_V
#undef PG8_WAIT_L
#undef PG8_BAR
#undef PG8_SCHED
}
}

namespace att {
constexpr int D = 128;
constexpr float THR = 8.f;
constexpr bool WSKIP = false;
constexpr float SCALE = 0.08838834764831845f;
constexpr int NW = 8, QBLK = 32, KVBLK = 64, QB = NW * QBLK;
constexpr int SHM_V = KVBLK * D * 2, SHM_K = KVBLK * D * 2;
constexpr int LDS_BYTES = 2 * SHM_V + 2 * SHM_K + NW * 64 * 4;
using bf16 = __hip_bfloat16;
template <class A, class Bt> struct same_t { static constexpr bool v = false; };
template <class A> struct same_t<A, A> { static constexpr bool v = true; };
#define KSWZ(row, colB) ((row) * 256 + ((colB) ^ (((row) & 7) << 4)))
#define SBAR() __builtin_amdgcn_sched_barrier(0)
__device__ __forceinline__ int v_st(int k, int c) { const int kk = (k & ~0xC) | ((k & 4) << 1) | ((k & 8) >> 1); return ((kk >> 3) * 4 + (c >> 5)) * 512 + ((kk & 7) * 32 + (c & 31)) * 2; }
__device__ __forceinline__ int v_rd_base(int lane) { return ((lane & 3) << 3) | (((lane >> 2) & 3) << 6) | (((lane >> 4) & 1) << 5) | (((lane >> 5) & 1) << 8); }
constexpr int v_rd_off(int d0, int ks, int half) { return d0 * 512 + ks * 4096 + half * 2048; }
__device__ __forceinline__ int crow(int r, int hi) { return (r & 3) + 8 * (r >> 2) + 4 * hi; }
__device__ __forceinline__ unsigned cvtpk(float lo, float hi) {
    unsigned r; asm volatile("v_cvt_pk_bf16_f32 %0, %1, %2" : "=v"(r) : "v"(lo), "v"(hi)); return r;
}
__device__ __forceinline__ bf16x8 pack8(f32x4 a, f32x4 b) {
    u32x4 w = {cvtpk(a[0], a[1]), cvtpk(a[2], a[3]), cvtpk(b[0], b[1]), cvtpk(b[2], b[3])};
    return *reinterpret_cast<bf16x8*>(&w);
}
template <class T> __device__ __forceinline__ bf16x8 load8(const T* p) {
    if constexpr (same_t<T, float>::v) { return pack8(*(const f32x4*)p, *(const f32x4*)(p + 4)); }
    else { return *reinterpret_cast<const bf16x8*>(p); }
}
__device__ __forceinline__ void mask_tile(f32x16& p0, f32x16& p1, int dq, unsigned W) {
    const float NEG = -__builtin_inff();
#pragma unroll
    for (int r = 0; r < 16; ++r) {
        const int c = (r & 3) + 8 * (r >> 2);
        if ((unsigned)(dq - c) >= W) p0[r] = NEG;
        if ((unsigned)(dq - c - 32) >= W) p1[r] = NEG;
    }
}
__device__ __forceinline__ void partialSM(f32x16& p0, f32x16& p1, float& m_reg, float& mn, float& alpha) {
    float pmax = p0[0]; for (int r = 1; r < 16; ++r) pmax = fmaxf(pmax, p0[r]); for (int r = 0; r < 16; ++r) pmax = fmaxf(pmax, p1[r]);
    { auto rr = __builtin_amdgcn_permlane32_swap(__float_as_uint(pmax), __float_as_uint(pmax), false, false);
      pmax = fmaxf(__uint_as_float(rr[0]), __uint_as_float(rr[1])); }
    constexpr float C2 = 1.4426950408889634f * SCALE;
    if (__builtin_expect(__all((pmax - m_reg) * SCALE <= THR), 1)) { mn = m_reg; alpha = 1.f; }
    else { mn = fmaxf(m_reg, pmax); alpha = __builtin_amdgcn_exp2f((m_reg - mn) * C2); m_reg = mn; }
    const float mnL = -mn * C2;
    for (int r = 0; r < 16; ++r) p0[r] = fmaf(p0[r], C2, mnL); for (int r = 0; r < 16; ++r) p1[r] = fmaf(p1[r], C2, mnL);
    for (int r = 0; r < 16; ++r) p0[r] = __builtin_amdgcn_exp2f(p0[r]);
}
__device__ __forceinline__ void finishSM(f32x16& p0, f32x16& p1, float alpha, float& l_reg, bf16x8& pa0, bf16x8& pa1, bf16x8& pa2, bf16x8& pa3) {
    for (int r = 0; r < 16; ++r) p1[r] = __builtin_amdgcn_exp2f(p1[r]);
    float ps = 0; for (int r = 0; r < 16; ++r) ps += p0[r]; for (int r = 0; r < 16; ++r) ps += p1[r];
    { auto rr = __builtin_amdgcn_permlane32_swap(__float_as_uint(ps), __float_as_uint(ps), false, false);
      ps = __uint_as_float(rr[0]) + __uint_as_float(rr[1]); }
    l_reg = l_reg * alpha + ps;
#define PK4(P, B_, OUT) do { unsigned a0 = cvtpk(P[B_+0], P[B_+1]), a1 = cvtpk(P[B_+2], P[B_+3]);                          \
        unsigned b0 = cvtpk(P[B_+4], P[B_+5]), b1 = cvtpk(P[B_+6], P[B_+7]);                                             \
        auto r0 = __builtin_amdgcn_permlane32_swap(a0, b0, false, false); auto r1 = __builtin_amdgcn_permlane32_swap(a1, b1, false, false); \
        u32x4 w = {r0[0], r1[0], r0[1], r1[1]}; OUT = *reinterpret_cast<bf16x8*>(&w); } while (0)
    PK4(p0, 0, pa0); PK4(p0, 8, pa1); PK4(p1, 0, pa2); PK4(p1, 8, pa3);
#undef PK4
}
template <int KB, bool SK>
__device__ __forceinline__ void qkt(f32x16& p0, f32x16& p1, const char* K_lds, int r32, int hi, const bf16x8* qr, bool act) {
    if (SK && !act) { const float NEG = -__builtin_inff();
#pragma unroll
        for (int r = 0; r < 16; ++r) { p0[r] = NEG; p1[r] = NEG; } return; }
    p0 = f32x16{}; p1 = f32x16{};
    const char* kb[4];
#pragma unroll
    for (int dd = 0; dd < 4; ++dd) kb[dd] = K_lds + KB * SHM_K + KSWZ(r32, (dd * 16 + hi * 8) * 2);
#pragma unroll
    for (int d0 = 0; d0 < 8; ++d0) { const char* a = kb[d0 & 3] + (d0 >> 2) * 128;
        bf16x8 b0 = *reinterpret_cast<const bf16x8*>(a);
        bf16x8 b1 = *reinterpret_cast<const bf16x8*>(a + 32 * 256);
        p0 = __builtin_amdgcn_mfma_f32_32x32x16_bf16(b0, qr[d0], p0, 0, 0, 0);
        p1 = __builtin_amdgcn_mfma_f32_32x32x16_bf16(b1, qr[d0], p1, 0, 0, 0); }
}
template <int VB, bool SK>
__device__ __forceinline__ void pv_tile(f32x16* o, int vb0, bf16x8 pa0, bf16x8 pa1, bf16x8 pa2, bf16x8 pa3, bool act) {
    if (SK && !act) return;
#define TRRD(dst, off) asm volatile("ds_read_b64_tr_b16 %0, %1 offset:%2" : "=&v"(dst) : "v"(vb0), "i"(off) : "memory")
#define PV_D0(d0) do { s16x4 l0, l1, l2, l3, h0, h1, h2, h3; constexpr int b_ = VB * SHM_V + v_rd_off(d0, 0, 0);     \
        TRRD(l0, b_); TRRD(h0, b_ + 2048); TRRD(l1, b_ + 4096); TRRD(h1, b_ + 6144); TRRD(l2, b_ + 8192); TRRD(h2, b_ + 10240); TRRD(l3, b_ + 12288); TRRD(h3, b_ + 14336); \
        asm volatile("s_waitcnt lgkmcnt(0)" ::: "memory"); SBAR();                 \
        o[d0] = __builtin_amdgcn_mfma_f32_32x32x16_bf16(pa0, (bf16x8){l0[0], l0[1], l0[2], l0[3], h0[0], h0[1], h0[2], h0[3]}, o[d0], 0, 0, 0);   \
        o[d0] = __builtin_amdgcn_mfma_f32_32x32x16_bf16(pa1, (bf16x8){l1[0], l1[1], l1[2], l1[3], h1[0], h1[1], h1[2], h1[3]}, o[d0], 0, 0, 0);   \
        o[d0] = __builtin_amdgcn_mfma_f32_32x32x16_bf16(pa2, (bf16x8){l2[0], l2[1], l2[2], l2[3], h2[0], h2[1], h2[2], h2[3]}, o[d0], 0, 0, 0);   \
        o[d0] = __builtin_amdgcn_mfma_f32_32x32x16_bf16(pa3, (bf16x8){l3[0], l3[1], l3[2], l3[3], h3[0], h3[1], h3[2], h3[3]}, o[d0], 0, 0, 0); } while (0)
    PV_D0(0); PV_D0(1); PV_D0(2); PV_D0(3);
#undef PV_D0
#undef TRRD
}

template <class TIn, class TOut> struct BlockRef { const TIn* Q; const TIn* K; const TIn* V; TOut* O; int P0; };
template <class TIn> struct Seam {
    bf16x8 qr[8];
    bf16x8 st_v0, st_v1, st_k0, st_k1; f32x4 sf0, sf1, sf2, sf3;
    f32x4 tq[16];
};
__device__ __forceinline__ int swa_jlo(int P0, int W) { const int lowk = P0 - W + 1; return lowk > 0 ? lowk / KVBLK : 0; }
#define ROW(p, k0, rr) ((p) + (size_t)((k0) + (rr)) * D + sc)
#define VMW() asm volatile("s_waitcnt vmcnt(0)" ::: "memory")
#define VMWN(n) asm volatile("s_waitcnt vmcnt(%0)" :: "i"(n) : "memory")
#define SLOAD_H(Kp, Vp, k0) do { S.st_v0 = load8<TIn>(ROW(Vp, k0, sr)); S.st_v1 = load8<TIn>(ROW(Vp, k0, 32 + sr));              \
                         S.st_k0 = load8<TIn>(ROW(Kp, k0, sr)); S.st_k1 = load8<TIn>(ROW(Kp, k0, 32 + sr)); } while (0)
#define SWRITE_HK(bf) do { *(bf16x8*)(K_lds + (bf) * SHM_K + kws) = S.st_k0; *(bf16x8*)(K_lds + (bf) * SHM_K + kws + 32 * 256) = S.st_k1; } while (0)
#define SWRITE_HV(bf) do { *(bf16x8*)(V_lds + (bf) * SHM_V + vst0) = S.st_v0; *(bf16x8*)(V_lds + (bf) * SHM_V + vst1) = S.st_v1; } while (0)
#define SWRITE_H(bf) do { SWRITE_HV(bf); SWRITE_HK(bf); } while (0)
#define SLOAD_F(p, k0) do { S.sf0 = *(const f32x4*)ROW(p, k0, sr); S.sf1 = *(const f32x4*)(ROW(p, k0, sr) + 4);                \
                            S.sf2 = *(const f32x4*)ROW(p, k0, 32 + sr); S.sf3 = *(const f32x4*)(ROW(p, k0, 32 + sr) + 4); } while (0)
#define SWRITE_KF(bf) do { *(bf16x8*)(K_lds + (bf) * SHM_K + kws) = pack8(S.sf0, S.sf1); *(bf16x8*)(K_lds + (bf) * SHM_K + kws + 32 * 256) = pack8(S.sf2, S.sf3); } while (0)
#define SWRITE_VF(bf) do { *(bf16x8*)(V_lds + (bf) * SHM_V + vst0) = pack8(S.sf0, S.sf1); *(bf16x8*)(V_lds + (bf) * SHM_V + vst1) = pack8(S.sf2, S.sf3); } while (0)
template <class TIn, class TOut>
__device__ __forceinline__ void causal_swa_prime(const BlockRef<TIn, TOut>& cur, int W, char* lds, Seam<TIn>& S, const int wv) {
    constexpr bool F32 = same_t<TIn, float>::v;
    const int tid = ltid(wv), wid = __builtin_amdgcn_readfirstlane(tid >> 6), lane = tid & 63, r32 = lane & 31, hi = lane >> 5;
    const int sr = tid >> 4, sc = (tid & 15) * 8, kws = KSWZ(sr, sc * 2); char* K_lds = lds + 2 * SHM_V;
    const int kb0 = swa_jlo(cur.P0, W) * KVBLK;
    for (int d0 = 0; d0 < 8; ++d0) S.qr[d0] = load8<TIn>(cur.Q + (size_t)(wid * QBLK + r32) * D + d0 * 16 + hi * 8);
    if constexpr (F32) { SLOAD_F((const float*)cur.K, kb0); VMW(); SWRITE_KF(0); SBAR(); SLOAD_F((const float*)cur.V, kb0); }
    else { SLOAD_H(cur.K, cur.V, kb0); VMW(); SWRITE_HK(0); }
    __syncthreads();
}
template <class TIn, class TOut>
__device__ __forceinline__ void causal_swa_block(const BlockRef<TIn, TOut>& cur, const BlockRef<TIn, TOut>& nxt, int skv, int W, char* lds, Seam<TIn>& S, const int wv) {
    constexpr bool F32 = same_t<TIn, float>::v;
    const int tid = ltid(wv), wid = __builtin_amdgcn_readfirstlane(tid >> 6), lane = tid & 63, r32 = lane & 31, hi = lane >> 5;
    const int j_lo = swa_jlo(cur.P0, W);
    int j_hi = (cur.P0 + QB - 1) / KVBLK + 1; if (j_hi > skv / KVBLK) j_hi = skv / KVBLK;
    const int NT = j_hi - j_lo;
    const int kbn = swa_jlo(nxt.P0, W) * KVBLK;
    const int qlo = cur.P0 + wid * QBLK, qm = qlo + r32 - 4 * hi;
    char* V_lds = lds; char* K_lds = lds + 2 * SHM_V;
    float* ws = (float*)(lds + 2 * SHM_V + 2 * SHM_K) + wid * 64; float* li_l = ws, * al_l = ws + 32;
    float m_reg = -1e30f, l_reg = 0; f32x16 o[4] = {};
    const int sr = tid >> 4, sc = (tid & 15) * 8, vst0 = v_st(sr, sc), vst1 = v_st(32 + sr, sc), kws = KSWZ(sr, sc * 2);
    const int vb0 = (int)(uintptr_t)V_lds + v_rd_base(lane);
    const TIn* Kh = cur.K; const TIn* Vh = cur.V;
#define RESC(a) do { if (__any((a) < 1.f)) { if (hi == 0) al_l[r32] = (a); asm volatile("s_waitcnt lgkmcnt(0)" ::: "memory");              \
                     for (int d_ = 0; d_ < 4; ++d_) for (int r = 0; r < 16; ++r) o[d_][r] *= al_l[crow(r, hi)]; } } while (0)
#define KBASE(t) ((j_lo + (t)) * KVBLK)
#define ACT(t) (KBASE(t) <= qlo + QBLK - 1 && KBASE(t) + KVBLK - 1 >= qlo - W + 1)
#define MASKT(P0_, P1_, t) do { const int kb_ = KBASE(t); if ((!SK || ACT(t)) && (kb_ + KVBLK - 1 > qlo || kb_ <= qlo + QBLK - 1 - W)) mask_tile(P0_, P1_, qm - kb_, (unsigned)W); } while (0)
    constexpr int NQL = F32 ? 16 : 8;
    constexpr bool SK = WSKIP && !F32;
#define SEAM_K0() do { VMWN(NQL); if constexpr (F32) { SWRITE_KF(0); SBAR(); SLOAD_F((const float*)nxt.V, kbn); } else { SWRITE_HK(0); } SBAR(); } while (0)
    f32x16 pA0, pA1, pB0, pB1; float mnA, mnB, alA, alB; bf16x8 pa0, pa1, pa2, pa3;
    if constexpr (F32) { VMW(); SWRITE_VF(0); SBAR(); } else { SWRITE_HV(0); SBAR(); }
    if (NT > 1) { if constexpr (F32) SLOAD_F((const float*)Kh, KBASE(1)); else SLOAD_H(Kh, Vh, KBASE(1)); }
    SBAR(); qkt<0, SK>(pA0, pA1, K_lds, r32, hi, S.qr, ACT(0));
    if constexpr (F32) { if (NT > 1) { VMW(); SWRITE_KF(1); SBAR(); SLOAD_F((const float*)Vh, KBASE(1)); } }
    MASKT(pA0, pA1, 0); partialSM(pA0, pA1, m_reg, mnA, alA);
    if (NT > 1) { VMW(); if constexpr (F32) { SWRITE_VF(1); SBAR(); if (NT > 2) SLOAD_F((const float*)Kh, KBASE(2)); } else SWRITE_H(1); }
    __syncthreads();
#define HALF_STEP(PX0, PX1, mnX, alX, PY0, PY1, alY, t, KB, VB, SB) do {                                                      \
        SBAR(); qkt<KB, SK>(PX0, PX1, K_lds, r32, hi, S.qr, ACT(t));                                             \
        finishSM(PY0, PY1, alY, l_reg, pa0, pa1, pa2, pa3); SBAR();                                                           \
        if ((t) + 1 < NT) { if constexpr (F32) { VMW(); SWRITE_KF(SB); SBAR(); SLOAD_F((const float*)Vh, KBASE((t) + 1)); }  \
                            else { SLOAD_H(Kh, Vh, KBASE((t) + 1)); } SBAR(); }                                               \
        pv_tile<VB, SK>(o, vb0, pa0, pa1, pa2, pa3, ACT((t) - 1)); MASKT(PX0, PX1, (t)); partialSM(PX0, PX1, m_reg, mnX, alX);                                        \
        __syncthreads();                                                                                                      \
        if ((t) + 1 < NT) { VMW(); if constexpr (F32) { SWRITE_VF(SB); SBAR(); if ((t) + 2 < NT) SLOAD_F((const float*)Kh, KBASE((t) + 2)); } \
                            else { SWRITE_H(SB); } }                                                                          \
        RESC(alX); __syncthreads(); } while (0)
    for (int t = 1; t + 1 < NT; t += 2) {
        HALF_STEP(pB0, pB1, mnB, alB, pA0, pA1, alA, t, 1, 0, 0);
        HALF_STEP(pA0, pA1, mnA, alA, pB0, pB1, alB, t + 1, 0, 1, 1);
    }
    const bool even = (NT & 1) == 0;
    if (even) { SBAR(); qkt<1, SK>(pB0, pB1, K_lds, r32, hi, S.qr, ACT(NT - 1)); SBAR(); }
#define QROW(e) (nxt.Q + (size_t)(wid * QBLK + r32) * D + ((e) >> 1) * 16 + hi * 8 + ((e) & 1) * 4)
    if constexpr (F32) { SLOAD_F((const float*)nxt.K, kbn); SBAR();
#pragma unroll
        for (int e = 0; e < 8; ++e) S.tq[e] = *(const f32x4*)QROW(e); }
    else { SLOAD_H(nxt.K, nxt.V, kbn); SBAR();
#pragma unroll
        for (int d0 = 0; d0 < 8; ++d0) S.qr[d0] = load8<TIn>(nxt.Q + (size_t)(wid * QBLK + r32) * D + d0 * 16 + hi * 8); }
    SBAR();
    finishSM(pA0, pA1, alA, l_reg, pa0, pa1, pa2, pa3); SBAR();
    if constexpr (F32) {
#pragma unroll
        for (int e = 8; e < 16; ++e) S.tq[e] = *(const f32x4*)QROW(e); SBAR(); }
#undef QROW
    pv_tile<0, SK>(o, vb0, pa0, pa1, pa2, pa3, ACT(even ? NT - 2 : NT - 1));
    if (even) { MASKT(pB0, pB1, NT - 1); partialSM(pB0, pB1, m_reg, mnB, alB); __syncthreads(); RESC(alB);
        finishSM(pB0, pB1, alB, l_reg, pa0, pa1, pa2, pa3); SBAR(); pv_tile<1, SK>(o, vb0, pa0, pa1, pa2, pa3, ACT(NT - 1)); }
    SBAR(); SEAM_K0();
    if (hi == 0) li_l[r32] = l_reg; asm volatile("s_waitcnt lgkmcnt(0)" ::: "memory");
    float rli[16];
#pragma unroll
    for (int r = 0; r < 16; ++r) rli[r] = __builtin_amdgcn_rcpf(li_l[crow(r, hi)]);
    TOut* Ow = cur.O + (size_t)(wid * QBLK) * D;
#pragma unroll
    for (int r = 0; r < 16; ++r) { const int orow = crow(r, hi);
#pragma unroll
        for (int d0 = 0; d0 < 4; ++d0) { const float v = o[d0][r] * rli[r];
            if constexpr (same_t<TOut, float>::v) { Ow[(size_t)orow * D + d0 * 32 + r32] = v; }
            else { const float vn = sw_xor<1>(v);
                   if ((r32 & 1) == 0) *(unsigned*)(Ow + (size_t)orow * D + d0 * 32 + r32) = cvtpk(v, vn); } } }
    if constexpr (F32) {
#pragma unroll
        for (int d0 = 0; d0 < 8; ++d0) S.qr[d0] = pack8(S.tq[2 * d0], S.tq[2 * d0 + 1]); }
    __syncthreads();
#undef RESC
#undef KBASE
#undef ACT
#undef MASKT
#undef SEAM_K0
#undef HALF_STEP
}
#undef ROW
#undef VMW
#undef VMWN
#undef SLOAD_H
#undef SWRITE_HK
#undef SWRITE_HV
#undef SWRITE_H
#undef SLOAD_F
#undef SWRITE_KF
#undef SWRITE_VF
#undef KSWZ
#undef SBAR
}

#define MFMA16(a, b, c) __builtin_amdgcn_mfma_f32_16x16x32_bf16((a), (b), (c), 0, 0, 0)
#define MFMA32(a, b, c) __builtin_amdgcn_mfma_f32_32x32x16_bf16((a), (b), (c), 0, 0, 0)
#define WSP(T_, off) ((T_*)(p->ws + (off)))

DI void sincos_red(double r, float& s, float& c) {
    const double r2 = r * r; double sp = 1.0, cp = 1.0;
#pragma unroll
    for (int k = 13; k >= 1; --k) { sp = 1.0 - sp * r2 * (1.0 / (double)((2 * k) * (2 * k + 1))); cp = 1.0 - cp * r2 * (1.0 / (double)((2 * k - 1) * (2 * k))); }
    s = (float)(r * sp); c = (float)cp;
}

DI void cvt_wt_job(const float* src, bf16_t* dst, int N, int Npad, int nperm, float* tile, const int wv) {
    const int tid = ltid(wv), K = 2048, ntn = Npad / 64, ntiles = ntn * (K / 64);
    for (int tl = blockIdx.x; tl < ntiles; tl += gridDim.x) {
        const int tn = tl % ntn, tk = tl / ntn, k0 = tk * 64, n0 = tn * 64, c = tid & 63;
        int ns = n0 + c;
        if (ns < nperm) { const int p7 = ns & 127, u = p7 >> 3, e = p7 & 7; ns = (ns & ~127) + ((e < 4) ? 4 * u + e : 64 + 4 * u + (e - 4)); }
#pragma unroll
        for (int i = 0; i < 8; ++i) { const int r = (tid >> 6) + 8 * i, n = n0 + c; tile[r * 65 + c] = (n < N) ? src[(size_t)(k0 + r) * N + ns] : 0.f; }
        __syncthreads();
#pragma unroll
        for (int i = 0; i < 4; ++i) { const int id = tid + 512 * i, rr = id >> 5, cp = id & 31;
            ((unsigned*)dst)[((size_t)(n0 + rr) * K + k0) / 2 + cp] = cvt_pk_bf16(tile[(2 * cp) * 65 + rr], tile[(2 * cp + 1) * 65 + rr]); }
        __syncthreads();
    }
}

DI void ph_prologue(PK p, unsigned char* lds, const int wv) {
    PK_FRESH(p);
    const int tid = ltid(wv), lane = tid & 63, wave = __builtin_amdgcn_readfirstlane(tid >> 6);
    float* ldsf = (float*)lds;
    {
        float* sc = ldsf; float* red = ldsf + 4096;
        for (int i = tid; i < 4096; i += 512) sc[i] = silu_f(p->in[1][i]);
        __syncthreads();
        float* mod = WSP(float, WS_MOD);
        for (int item = blockIdx.x; item < MODC / 64; item += gridDim.x) {
            const int col0 = item * 64, col = col0 + lane;
            const float* W; size_t stride;
            if (col0 < 4 * 12288) { const int l = col0 / 12288, j = col - l * 12288; W = p->in[3] + (size_t)l * 2048 * 12288 + j; stride = 12288; }
            else { W = p->in[14] + (col - 4 * 12288); stride = 4096; }
            float a0 = 0.f, a1 = 0.f;
            const int kb = wave * 256;
#pragma unroll 8
            for (int k = 0; k < 256; ++k) { const float wv = W[(size_t)(kb + k) * stride]; a0 += sc[kb + k] * wv; a1 += sc[2048 + kb + k] * wv; }
            red[(wave * 64 + lane) * 2 + 0] = a0; red[(wave * 64 + lane) * 2 + 1] = a1;
            __syncthreads();
            if (tid < 128) { const int ln = tid & 63, b = tid >> 6; float s = 0.f;
#pragma unroll
                for (int w = 0; w < 8; ++w) s += red[(w * 64 + ln) * 2 + b];
                const int cc = col0 + ln; const float bias = (cc < 4 * 12288) ? p->in[4][cc] : p->in[15][cc - 4 * 12288];
                mod[(size_t)b * MODC + cc] = s + bias; }
            __syncthreads();
        }
    }
    for (int job = 0; job < 9; ++job) {
        const float* src; bf16_t* dst; int N = 2048, Npad = 2048, nperm = 0;
        if (job < 2) { src = p->in[7] + (size_t)job * 2048 * GIN; dst = WSP(bf16_t, WS_WIN) + (size_t)job * GINP * 2048; N = GIN; Npad = GINP; }
        else if (job < 4) { src = p->in[12] + (size_t)(job - 2) * 2048 * 2048; dst = WSP(bf16_t, WS_WOUT) + (size_t)(job - 2) * 2048 * 2048; }
        else if (job == 4) { src = p->in[16]; dst = WSP(bf16_t, WS_KVW); N = 4096; Npad = 4096; nperm = 2048; }
        else if (job < 7) { src = p->in[17] + (size_t)(job - 5) * 2048 * 2048; dst = WSP(bf16_t, WS_DWQ) + (size_t)(job - 5) * 2048 * 2048; nperm = 2048; }
        else { src = p->in[20] + (size_t)(job - 7) * 2048 * 2048; dst = WSP(bf16_t, WS_DWO) + (size_t)(job - 7) * 2048 * 2048; }
        cvt_wt_job(src, dst, N, Npad, nperm, ldsf, wv);
    }
    {
        const int lane = tid & 63, r16 = lane & 15, quad = lane >> 4;
        bf16_t* wdst = WSP(bf16_t, WS_PWQ);
        for (int task = (blockIdx.x * 8 + wave); task < 4 * 16 * 128; task += gridDim.x * 8) {
            const int kt = task & 127, pj = (task >> 7) & 15, l = task >> 11, pp = pj >> 1, jh = pj & 1;
            const float* wq = p->in[21] + ((size_t)l * 2048 + kt * 16 + r16) * 2048 + pp * 256 + jh * 128 + quad * 8;
            const float* ky = p->in[22] + ((size_t)(l * 2 + jh) * 128 + r16) * 128 + quad * 8;
            bf16x8 bw[4];
#pragma unroll
            for (int ks = 0; ks < 4; ++ks) { const f32x4 a = *(const f32x4*)(wq + ks * 32), b = *(const f32x4*)(wq + ks * 32 + 4);
                u32x4 w; w.x = cvt_pk_bf16(a[0], a[1]); w.y = cvt_pk_bf16(a[2], a[3]); w.z = cvt_pk_bf16(b[0], b[1]); w.w = cvt_pk_bf16(b[2], b[3]); bw[ks] = __builtin_bit_cast(bf16x8, w); }
#pragma unroll
            for (int nt = 0; nt < 8; ++nt) { f32x4 acc = {0.f, 0.f, 0.f, 0.f};
#pragma unroll
                for (int ks = 0; ks < 4; ++ks) { const f32x4 a = *(const f32x4*)(ky + (size_t)nt * 16 * 128 + ks * 32), b = *(const f32x4*)(ky + (size_t)nt * 16 * 128 + ks * 32 + 4);
                    u32x4 w; w.x = cvt_pk_bf16(a[0], a[1]); w.y = cvt_pk_bf16(a[2], a[3]); w.z = cvt_pk_bf16(b[0], b[1]); w.w = cvt_pk_bf16(b[2], b[3]);
                    acc = MFMA16(__builtin_bit_cast(bf16x8, w), bw[ks], acc); }
#pragma unroll
                for (int r = 0; r < 4; ++r) wdst[((size_t)l * 2048 + pp * 256 + jh * 128 + nt * 16 + quad * 4 + r) * 2048 + kt * 16 + r16] = f2bf(acc[r]); }
        }
    }
    {
        float* cosT = WSP(float, WS_COS); float* sinT = WSP(float, WS_SIN); const int* pos = (const int*)p->in[2];
        for (int idx = blockIdx.x * 512 + tid; idx < T * 64; idx += gridDim.x * 512) {
            const int t = idx >> 6, j = idx & 63;
            const double inv = exp(-(double)j * (9.210340371976184 / 64.0));
            const double ang = (double)pos[t] * inv;
            const double n = rint(ang * 0.15915494309189535);
            double r = fma(-n, 6.283185307179586, ang); r = fma(-n, 2.4492935982947064e-16, r);
            float s, c; sincos_red(r, s, c); cosT[idx] = c; sinT[idx] = s;
        }
    }
    {
        bf16_t* sk = WSP(bf16_t, WS_SUBK);
        for (int idx = blockIdx.x * 512 + tid; idx < 4 * 2 * 128 * 128; idx += gridDim.x * 512) sk[idx] = f2bf(p->in[22][idx]);
    }
}

template <int MODE>
DI void ph_norm(const float* x, const bf16_t* xb, const float* g, const float* shift, const float* scale, bf16_t* dstb, float* dstf, const int wv) {
    const int tid = ltid(wv), lane = tid & 63, wave = __builtin_amdgcn_readfirstlane(tid >> 6);
    for (int row = blockIdx.x * 8 + wave; row < T; row += gridDim.x * 8) {
        const int b = row >> 13;
        f32x4 v[8]; float ss = 0.f;
#pragma unroll
        for (int i = 0; i < 8; ++i) {
            if (MODE == 2) { const u32x2 w = *(const u32x2*)(xb + (size_t)row * D + i * 256 + lane * 4); v[i] = (f32x4){bflo(w.x), bfhi(w.x), bflo(w.y), bfhi(w.y)}; }
            else v[i] = *(const f32x4*)(x + (size_t)row * D + i * 256 + lane * 4);
            ss += v[i][0] * v[i][0] + v[i][1] * v[i][1] + v[i][2] * v[i][2] + v[i][3] * v[i][3]; }
        ss = wave_sum(ss);
        const float r = rsqrtf(ss * (1.f / D) + NORM_EPS);
#pragma unroll
        for (int i = 0; i < 8; ++i) { const int col = i * 256 + lane * 4; const f32x4 gv = *(const f32x4*)(g + col);
            if (MODE != 1) { const f32x4 sh = *(const f32x4*)(shift + (size_t)b * MODC + col), sc = *(const f32x4*)(scale + (size_t)b * MODC + col);
                f32x4 y;
#pragma unroll
                for (int e = 0; e < 4; ++e) y[e] = v[i][e] * r * gv[e] * (1.f + sc[e]) + sh[e];
                u32x2 w; w.x = cvt_pk_bf16(y[0], y[1]); w.y = cvt_pk_bf16(y[2], y[3]); *(u32x2*)(dstb + (size_t)row * D + col) = w; }
            else { f32x4 y;
#pragma unroll
                for (int e = 0; e < 4; ++e) y[e] = v[i][e] * r * gv[e];
                *(f32x4*)(dstf + (size_t)row * D + col) = y; } }
    }
}

DI void pc_load(PK p, int l, int row, f32x4 (&v)[8], const int lane) {
    const float* s = ((row >= 16384) ? p->in[24] : p->in[23]) + ((size_t)l * 16384 + (row & 16383)) * 2048;
#pragma unroll
    for (int i = 0; i < 8; ++i) v[i] = *(const f32x4*)(s + lane * 32 + i * 4);
}
DI void pc_store(PK p, int row, const f32x4 (&v)[8], const int lane) {
    const bool second = row >= 16384; const int r = row & 16383;
    unsigned char* dq = WSP(unsigned char, second ? WS_PV : WS_PU); unsigned short* ds = WSP(unsigned short, second ? WS_PVS : WS_PUS);
    float m0 = 0.f;
#pragma unroll
    for (int i = 0; i < 8; ++i) { const float mm = fmaxf(fmaxf(fabsf(v[i][0]), fabsf(v[i][1])), fmaxf(fabsf(v[i][2]), fabsf(v[i][3]))); m0 = fmaxf(m0, mm); }
    const bf16_t sb0 = (m0 > 0.f) ? f2bf(m0 * (1.004f / 6.f)) : (bf16_t)0x3f80;
    const float inv = 1.f / bf2f(sb0);
    u32x4 w;
#pragma unroll
    for (int c = 0; c < 4; ++c) { unsigned x = 0u;
        x = __builtin_amdgcn_cvt_scalef32_pk_fp4_f32(x, v[2 * c][0] * inv, v[2 * c][1] * inv, 1.0f, 0);
        x = __builtin_amdgcn_cvt_scalef32_pk_fp4_f32(x, v[2 * c][2] * inv, v[2 * c][3] * inv, 1.0f, 1);
        x = __builtin_amdgcn_cvt_scalef32_pk_fp4_f32(x, v[2 * c + 1][0] * inv, v[2 * c + 1][1] * inv, 1.0f, 2);
        x = __builtin_amdgcn_cvt_scalef32_pk_fp4_f32(x, v[2 * c + 1][2] * inv, v[2 * c + 1][3] * inv, 1.0f, 3);
        w[c] = x; }
    *(u32x4*)(dq + (size_t)r * 1024 + lane * 16) = w;
    ds[(size_t)r * 64 + lane] = (unsigned short)sb0;
}
DI void ph_peer_cvt(PK p, int l, const int wv) {
    PK_FRESH(p);
    const int tid = ltid(wv), lane = tid & 63, wave = __builtin_amdgcn_readfirstlane(tid >> 6);
    for (int row = blockIdx.x * 8 + wave; row < 2 * 16384; row += gridDim.x * 8) { f32x4 v[8]; pc_load(p, l, row, v, lane); pc_store(p, row, v, lane); }
}


template <int I, int J>
DI void tinv_block(const bf16_t* Lb, bf16_t* Ti, bf16_t* TT, bf16_t* XT, const int r16, const int quad) {
    constexpr int nK = 16 * (I - J);
    const bf16x8 zero8 = {0, 0, 0, 0, 0, 0, 0, 0};
    f32x4 acc = {0.f, 0.f, 0.f, 0.f};
#pragma unroll
    for (int ks = 0; ks < (nK + 31) / 32; ++ks) {
        const int k0 = ks * 32 + quad * 8; const bool valid = k0 < nK;
        const bf16x8 a = valid ? *(const bf16x8*)(Lb + (16 * I + r16) * 72 + 16 * J + k0) : zero8;
        const bf16x8 b = valid ? *(const bf16x8*)(TT + (16 * J + r16) * 72 + 16 * J + k0) : zero8;
        acc = MFMA16(a, b, acc);
    }
    { u32x2 w; w.x = cvt_pk_bf16(acc[0], acc[1]); w.y = cvt_pk_bf16(acc[2], acc[3]); *(u32x2*)(XT + r16 * 24 + quad * 4) = w; }
    asm volatile("s_waitcnt lgkmcnt(0)" ::: "memory");
    const bool v2 = quad < 2;
    const bf16x8 a2 = v2 ? *(const bf16x8*)(Ti + (16 * I + r16) * 72 + 16 * I + quad * 8) : zero8;
    const bf16x8 b2 = v2 ? *(const bf16x8*)(XT + r16 * 24 + quad * 8) : zero8;
    f32x4 m = {0.f, 0.f, 0.f, 0.f};
    m = MFMA16(a2, b2, m);
#pragma unroll
    for (int r = 0; r < 4; ++r) Ti[(16 * I + quad * 4 + r) * 72 + 16 * J + r16] = f2bf(-m[r]);
    { u32x2 w; w.x = cvt_pk_bf16(-m[0], -m[1]); w.y = cvt_pk_bf16(-m[2], -m[3]); *(u32x2*)(TT + (16 * J + r16) * 72 + 16 * I + quad * 4) = w; }
    asm volatile("s_waitcnt lgkmcnt(0)" ::: "memory");
}

DI void ph_gdn_p1(PK p, int l, unsigned char* lds, const int wv) {
    PK_FRESH(p);
    const bf16_t* proj = WSP(const bf16_t, WS_PROJ);
    const float* convw = p->in[8] + (size_t)l * 4 * 6144; const float* alog = p->in[9] + l * 16; const float* dtb = p->in[10] + l * 16;
    bf16_t* Ag = WSP(bf16_t, WS_GA); bf16_t* Bg = WSP(bf16_t, WS_GB); bf16_t* Qg = WSP(bf16_t, WS_GQ); bf16_t* Og = WSP(bf16_t, WS_GO); float* glg = WSP(float, WS_GL);
    bf16_t* qb  = (bf16_t*)(lds + 0);
    bf16_t* kb  = (bf16_t*)(lds + 17408);
    bf16_t* Lb  = (bf16_t*)(lds + 34816);
    bf16_t* wT  = (bf16_t*)(lds + 17408);
    bf16_t* vbT = (bf16_t*)(lds + 44032);
    bf16_t* kdT = (bf16_t*)(lds + 62464);
    bf16_t* kbT = (bf16_t*)(lds + 80896);
    bf16_t* uT  = (bf16_t*)(lds + 80896);
    bf16_t* aqk = (bf16_t*)(lds + 99328);
    bf16_t* Ti  = (bf16_t*)(lds + 108544);
    bf16_t* TT  = (bf16_t*)(lds + 117760);
    float*  Ld  = (float*)(lds + 126976);
    bf16_t* XT  = (bf16_t*)(lds + 132096);
    float*  sc  = (float*)(lds + 133120);
    float*  cw  = (float*)(lds + 134144);
    int cached_bh = -1;
    for (int it = blockIdx.x; it < 4096; it += gridDim.x) {
        const int tid = ltid(wv), lane = tid & 63, wave = __builtin_amdgcn_readfirstlane(tid >> 6), r16 = lane & 15, quad = lane >> 4;
        const int bh = it & 31, n = it >> 5, hd = bh & 15, b = bh >> 4, tok0 = b * SEQ + n * 64, ci = bh * 128 + n;
        if (bh != cached_bh) {
            for (int idx = tid; idx < 1536; idx += 512) { const int part = idx >> 9, tap = (idx >> 7) & 3, c = idx & 127; cw[idx] = convw[tap * 6144 + part * 2048 + hd * 128 + c]; }
            cached_bh = bh;
            lds_barrier();
        }
        float pa_[4] = {0.f, 0.f, 0.f, 0.f}, pb_[4] = {0.f, 0.f, 0.f, 0.f}, dtbv = 0.f, alogv = 0.f;
        if (tid < 64) { const float* pab = WSP(const float, WS_PAB) + (size_t)(tok0 + tid) * 32 + hd; const size_t qs = (size_t)T * 32;
#pragma unroll
            for (int q4 = 0; q4 < 4; ++q4) { pa_[q4] = pab[q4 * qs]; pb_[q4] = pab[q4 * qs + 16]; }
            dtbv = dtb[hd]; alogv = alog[hd]; }
        {
            const int c16 = tid & 15, t0 = (tid >> 4) * 2;
#pragma unroll
            for (int part = 0; part < 3; ++part) {
                const int ch = part * 2048 + hd * 128 + c16 * 8;
                float xr[5][8];
#pragma unroll
                for (int r = 0; r < 5; ++r) {
                    const int sp = n * 64 + t0 - 3 + r;
                    u32x4 raw = {0u, 0u, 0u, 0u};
                    if (sp >= 0) raw = *(const u32x4*)(proj + (size_t)(b * SEQ + sp) * GINP + ch);
                    xr[r][0] = bflo(raw.x); xr[r][1] = bfhi(raw.x); xr[r][2] = bflo(raw.y); xr[r][3] = bfhi(raw.y); xr[r][4] = bflo(raw.z); xr[r][5] = bfhi(raw.z); xr[r][6] = bflo(raw.w); xr[r][7] = bfhi(raw.w);
                }
                float wt[4][8];
#pragma unroll
                for (int tap = 0; tap < 4; ++tap) { const f32x4 w0 = *(const f32x4*)(cw + (part * 4 + tap) * 128 + c16 * 8), w1 = *(const f32x4*)(cw + (part * 4 + tap) * 128 + c16 * 8 + 4);
                    wt[tap][0] = w0[0]; wt[tap][1] = w0[1]; wt[tap][2] = w0[2]; wt[tap][3] = w0[3]; wt[tap][4] = w1[0]; wt[tap][5] = w1[1]; wt[tap][6] = w1[2]; wt[tap][7] = w1[3]; }
                float av[2][8];
#pragma unroll
                for (int u = 0; u < 2; ++u) {
                    float ss = 0.f;
#pragma unroll
                    for (int e = 0; e < 8; ++e) { float a = wt[0][e] * xr[u][e]; a = fmaf(wt[1][e], xr[u + 1][e], a); a = fmaf(wt[2][e], xr[u + 2][e], a); a = fmaf(wt[3][e], xr[u + 3][e], a);
                        a = silu_f(a); av[u][e] = a; ss += a * a; }
                    if (part < 2) {
                        ss += sw_xor<1>(ss); ss += sw_xor<2>(ss); ss += sw_xor<4>(ss); ss += sw_xor<8>(ss);
                        const float r = rsqrtf(ss + NORM_EPS) * (part == 0 ? 0.08838834764831845f : 1.f);
                        u32x4 w; w.x = cvt_pk_bf16(av[u][0] * r, av[u][1] * r); w.y = cvt_pk_bf16(av[u][2] * r, av[u][3] * r); w.z = cvt_pk_bf16(av[u][4] * r, av[u][5] * r); w.w = cvt_pk_bf16(av[u][6] * r, av[u][7] * r);
                        *(u32x4*)((part == 0 ? qb : kb) + (t0 + u) * 136 + c16 * 8) = w;
                    }
                }
                if (part == 2) {
#pragma unroll
                    for (int e = 0; e < 8; ++e) *(unsigned*)(vbT + (c16 * 8 + e) * 72 + t0) = cvt_pk_bf16(av[0][e], av[1][e]);
                }
            }
        }
        if (tid < 64) {
            const int t = tid;
            const float av = (pa_[0] + pa_[1]) + (pa_[2] + pa_[3]), bv = (pb_[0] + pb_[1]) + (pb_[2] + pb_[3]);
            const float xx = av + dtbv;
            const float ex = __expf(xx); const float sp = (xx > 20.f) ? xx : ((xx < -8.f) ? ex * (1.f - 0.5f * ex) : __logf(1.f + ex));
            const float g = -__expf(alogv) * sp;
            const float beta = 1.f / (1.f + __expf(-bv));
            float G = g;
#pragma unroll
            for (int d = 1; d < 64; d <<= 1) { const float o = __int_as_float(__builtin_amdgcn_ds_bpermute(((t - d) & 63) << 2, __float_as_int(G))); if (t >= d) G += o; }
            const float Gl = __int_as_float(__builtin_amdgcn_readlane(__float_as_int(G), 63));
            sc[t] = beta; sc[64 + t] = G; sc[128 + t] = __expf(G); sc[192 + t] = __expf(Gl - G);
            if (t == 63) glg[ci] = __expf(G);
        }
        lds_barrier();
        {
            const int which = wave >> 2, mi = wave & 3;
#pragma unroll
            for (int ni = 0; ni < 4; ++ni) {
                if (which == 0 ? (ni >= mi) : (ni <= mi)) {
                    f32x4 acc = {0.f, 0.f, 0.f, 0.f};
                    const bf16_t* Ab = (which ? qb : kb) + (mi * 16 + r16) * 136 + quad * 8;
                    const bf16_t* Bb = kb + (ni * 16 + r16) * 136 + quad * 8;
#pragma unroll
                    for (int ks = 0; ks < 4; ++ks) acc = MFMA16(*(const bf16x8*)(Ab + ks * 32), *(const bf16x8*)(Bb + ks * 32), acc);
                    const int cidx = ni * 16 + r16; const float Gc = sc[64 + cidx];
                    if (which == 0) {
                        const float bi = sc[cidx]; f32x4 lv;
#pragma unroll
                        for (int r = 0; r < 4; ++r) { const int jj = mi * 16 + quad * 4 + r; lv[r] = (jj < cidx) ? bi * acc[r] * __expf(fminf(Gc - sc[64 + jj], 0.f)) : 0.f; }
                        if (ni == mi) *(f32x4*)(Ld + mi * 320 + r16 * 20 + quad * 4) = lv;
                        else { u32x2 w; w.x = cvt_pk_bf16(lv[0], lv[1]); w.y = cvt_pk_bf16(lv[2], lv[3]); *(u32x2*)(Lb + cidx * 72 + mi * 16 + quad * 4) = w; }
                    } else {
#pragma unroll
                        for (int r = 0; r < 4; ++r) { const int ii = mi * 16 + quad * 4 + r; aqk[ii * 72 + cidx] = f2bf((cidx <= ii) ? acc[r] * __expf(fminf(sc[64 + ii] - Gc, 0.f)) : 0.f); }
                    }
                } else if (which == 1) {
#pragma unroll
                    for (int r = 0; r < 4; ++r) aqk[(mi * 16 + quad * 4 + r) * 72 + ni * 16 + r16] = 0;
                }
            }
        }
        lds_barrier();
        {
            const int a = tid & 127, tq = tid >> 7;
#pragma unroll
            for (int q = 0; q < 2; ++q) { const int t0 = tq * 16 + q * 8; float v[8];
#pragma unroll
                for (int e = 0; e < 8; ++e) v[e] = bf2f(kb[(t0 + e) * 136 + a]);
                u32x4 w; w.x = cvt_pk_bf16(v[0], v[1]); w.y = cvt_pk_bf16(v[2], v[3]); w.z = cvt_pk_bf16(v[4], v[5]); w.w = cvt_pk_bf16(v[6], v[7]);
                *(u32x4*)(kbT + a * 72 + t0) = w;
#pragma unroll
                for (int e = 0; e < 8; ++e) v[e] *= sc[192 + t0 + e];
                w.x = cvt_pk_bf16(v[0], v[1]); w.y = cvt_pk_bf16(v[2], v[3]); w.z = cvt_pk_bf16(v[4], v[5]); w.w = cvt_pk_bf16(v[6], v[7]);
                *(u32x4*)(kdT + a * 72 + t0) = w; }
        }
        if (wave == 0) {
            const float* Lrow = Ld + quad * 320;
            float x[16];
#pragma unroll
            for (int i = 0; i < 16; ++i) { float s = (i == r16) ? 1.f : 0.f;
#pragma unroll
                for (int j = 0; j < i; ++j) s -= Lrow[i * 20 + j] * x[j];
                x[i] = s; }
#pragma unroll
            for (int i = 0; i < 16; ++i) Ti[(16 * quad + i) * 72 + 16 * quad + r16] = f2bf(x[i]);
            { u32x4 w0, w1; w0.x = cvt_pk_bf16(x[0], x[1]); w0.y = cvt_pk_bf16(x[2], x[3]); w0.z = cvt_pk_bf16(x[4], x[5]); w0.w = cvt_pk_bf16(x[6], x[7]);
              w1.x = cvt_pk_bf16(x[8], x[9]); w1.y = cvt_pk_bf16(x[10], x[11]); w1.z = cvt_pk_bf16(x[12], x[13]); w1.w = cvt_pk_bf16(x[14], x[15]);
              *(u32x4*)(TT + (16 * quad + r16) * 72 + 16 * quad) = w0; *(u32x4*)(TT + (16 * quad + r16) * 72 + 16 * quad + 8) = w1; }
            asm volatile("s_waitcnt lgkmcnt(0)" ::: "memory");
            tinv_block<1, 0>(Lb, Ti, TT, XT, r16, quad); tinv_block<2, 1>(Lb, Ti, TT, XT, r16, quad); tinv_block<3, 2>(Lb, Ti, TT, XT, r16, quad);
            tinv_block<2, 0>(Lb, Ti, TT, XT, r16, quad); tinv_block<3, 1>(Lb, Ti, TT, XT, r16, quad);
            tinv_block<3, 0>(Lb, Ti, TT, XT, r16, quad);
        }
        lds_barrier();
        {
            const int i = tid >> 3, t0 = (tid & 7) * 8; const bool low = (t0 >> 4) <= (i >> 4);
            const u32x4 raw = *(const u32x4*)(Ti + i * 72 + t0);
            float v[8] = {bflo(raw.x), bfhi(raw.x), bflo(raw.y), bfhi(raw.y), bflo(raw.z), bfhi(raw.z), bflo(raw.w), bfhi(raw.w)}; float tw[8], tu[8];
#pragma unroll
            for (int e = 0; e < 8; ++e) { const float be = sc[t0 + e]; tu[e] = low ? v[e] * be : 0.f; tw[e] = low ? v[e] * be * sc[128 + t0 + e] : 0.f; }
            u32x4 w; w.x = cvt_pk_bf16(tw[0], tw[1]); w.y = cvt_pk_bf16(tw[2], tw[3]); w.z = cvt_pk_bf16(tw[4], tw[5]); w.w = cvt_pk_bf16(tw[6], tw[7]);
            u32x4 u; u.x = cvt_pk_bf16(tu[0], tu[1]); u.y = cvt_pk_bf16(tu[2], tu[3]); u.z = cvt_pk_bf16(tu[4], tu[5]); u.w = cvt_pk_bf16(tu[6], tu[7]);
            *(u32x4*)(Ti + i * 72 + t0) = w; *(u32x4*)(TT + i * 72 + t0) = u;
        }
        lds_barrier();
#pragma unroll
        for (int pass = 0; pass < 2; ++pass) {
            const bf16_t* Aop = pass ? TT : Ti; const bf16_t* Bop = pass ? vbT : kbT; bf16_t* outT = pass ? uT : wT;
            f32x4 acc4[4];
#pragma unroll
            for (int mi = 0; mi < 4; ++mi) { f32x4 acc = {0.f, 0.f, 0.f, 0.f};
#pragma unroll
                for (int ks = 0; ks < 2; ++ks) acc = MFMA16(*(const bf16x8*)(Aop + (mi * 16 + r16) * 72 + ks * 32 + quad * 8), *(const bf16x8*)(Bop + (wave * 16 + r16) * 72 + ks * 32 + quad * 8), acc);
                acc4[mi] = acc; }
            if (pass == 1) lds_barrier();
#pragma unroll
            for (int mi = 0; mi < 4; ++mi) { u32x2 w; w.x = cvt_pk_bf16(acc4[mi][0], acc4[mi][1]); w.y = cvt_pk_bf16(acc4[mi][2], acc4[mi][3]); *(u32x2*)(outT + (wave * 16 + r16) * 72 + mi * 16 + quad * 4) = w; }
        }
        lds_barrier();
        {
#pragma unroll
            for (int i = 0; i < 24; ++i) {
                const int prod = (i < 8) ? 0 : (i < 16) ? 1 : (i < 20) ? 2 : 3;
                const int mi = (i < 8) ? i : (i < 16) ? (i - 8) : (i < 20) ? (i - 16) : (i - 20), ni = wave;
                const bf16_t* X = ((prod < 2) ? kdT : aqk) + (mi * 16 + r16) * 72 + quad * 8;
                const bf16_t* Y = ((prod & 1) ? uT : wT) + (ni * 16 + r16) * 72 + quad * 8;
                f32x4 acc = {0.f, 0.f, 0.f, 0.f};
#pragma unroll
                for (int ks = 0; ks < 2; ++ks) acc = MFMA16(*(const bf16x8*)(Y + ks * 32), *(const bf16x8*)(X + ks * 32), acc);
                const int m = mi * 16 + r16, n0 = ni * 16 + quad * 4;
                if (prod == 0) acc = -acc;
                if (prod == 2) { const u32x2 qv = *(const u32x2*)(qb + m * 136 + n0); const float eg = sc[128 + m];
                    acc[0] = bflo(qv.x) * eg - acc[0]; acc[1] = bfhi(qv.x) * eg - acc[1]; acc[2] = bflo(qv.y) * eg - acc[2]; acc[3] = bfhi(qv.y) * eg - acc[3]; }
                bf16_t* outp = ((prod == 0) ? (Ag + (size_t)ci * 16384) : (prod == 1) ? (Bg + (size_t)ci * 16384) : (prod == 2) ? (Qg + (size_t)ci * 8192) : (Og + (size_t)ci * 8192)) + m * 128 + n0;
                u32x2 w; w.x = cvt_pk_bf16(acc[0], acc[1]); w.y = cvt_pk_bf16(acc[2], acc[3]); *(u32x2*)outp = w;
            }
        }
        lds_barrier();
    }
}

DI void ph_gdn_p2(PK p, unsigned char* lds, const int wv) {
    PK_FRESH(p);
    const int tid = ltid(wv), lane = tid & 63, wave = __builtin_amdgcn_readfirstlane(tid >> 6), r16 = lane & 15, quad = lane >> 4, a0 = wave * 16;
    const bf16_t* Ag = WSP(const bf16_t, WS_GA); const bf16_t* Bg = WSP(const bf16_t, WS_GB); bf16_t* Sg = WSP(bf16_t, WS_GS); const float* glg = WSP(const float, WS_GL);
    bf16_t* ST = (bf16_t*)lds;
#define P2_LOAD(AF, BM, GL, cidx) do { const size_t c_ = (cidx); _Pragma("unroll") for (int ks = 0; ks < 4; ++ks) AF[ks] = *(const bf16x8*)(Ag + c_ * 16384 + (size_t)(a0 + r16) * 128 + ks * 32 + quad * 8); \
        _Pragma("unroll") for (int r = 0; r < 4; ++r) BM[r] = Bg[c_ * 16384 + (size_t)(a0 + quad * 4 + r) * 128 + v0 + r16]; GL = glg[c_]; } while (0)
    for (int item = blockIdx.x; item < 256; item += gridDim.x) {
        const int bh = (item & 7) * 4 + (item >> 6), v0 = ((item >> 3) & 7) * 16;
        const size_t cb = (size_t)bh * 128;
        f32x4 S = {0.f, 0.f, 0.f, 0.f};
        bf16x8 afA[4], afB[4], afC[4], afD[4]; bf16_t bmA[4], bmB[4], bmC[4], bmD[4]; float glA, glB, glC, glD;
        P2_LOAD(afA, bmA, glA, cb); P2_LOAD(afB, bmB, glB, cb + 1); P2_LOAD(afC, bmC, glC, cb + 2);
#define P2_STEP(AFc, BMc, GLc, AFp, BMp, GLp, nn) do { const int n_ = (nn); const size_t ci = cb + n_; \
            P2_LOAD(AFp, BMp, GLp, cb + ((n_ + 3 < 128) ? n_ + 3 : 127));        \
            u32x2 sp; sp.x = cvt_pk_bf16(S[0], S[1]); sp.y = cvt_pk_bf16(S[2], S[3]); \
            bf16_t* STb = ST + (n_ & 1) * (16 * 136); \
            *(u32x2*)(STb + r16 * 136 + a0 + quad * 4) = sp; \
            *(u32x2*)(Sg + ci * 16384 + (size_t)(v0 + r16) * 128 + a0 + quad * 4) = sp; \
            lds_barrier(); \
            f32x4 acc; _Pragma("unroll") for (int r = 0; r < 4; ++r) acc[r] = GLc * S[r] + bf2f(BMc[r]); \
            bf16x8 bfr_[4]; _Pragma("unroll") for (int ks = 0; ks < 4; ++ks) bfr_[ks] = *(const bf16x8*)(STb + r16 * 136 + ks * 32 + quad * 8);        \
            _Pragma("unroll") for (int ks = 0; ks < 4; ++ks) acc = MFMA16(AFc[ks], bfr_[ks], acc); \
            S = acc; } while (0)
        for (int n = 0; n < 128; n += 4) {
            P2_STEP(afA, bmA, glA, afD, bmD, glD, n);
            P2_STEP(afB, bmB, glB, afA, bmA, glA, n + 1);
            P2_STEP(afC, bmC, glC, afB, bmB, glB, n + 2);
            P2_STEP(afD, bmD, glD, afC, bmC, glC, n + 3);
        }
#undef P2_STEP
        lds_barrier();
    }
#undef P2_LOAD
}

DI void ph_gdn_p3(PK p, int l, const int wv) {
    PK_FRESH(p);
    const int tid = ltid(wv), lane = tid & 63, wave = __builtin_amdgcn_readfirstlane(tid >> 6), r16 = lane & 15, quad = lane >> 4;
    const bf16_t* Qg = WSP(const bf16_t, WS_GQ); const bf16_t* Og = WSP(const bf16_t, WS_GO); const bf16_t* Sg = WSP(const bf16_t, WS_GS);
    const bf16_t* proj = WSP(const bf16_t, WS_PROJ); bf16_t* obuf = WSP(bf16_t, WS_OBUF); const float* ogain = p->in[11] + l * 128;
    for (int it = blockIdx.x; it < 2048; it += gridDim.x) {
        const int ci = it * 2 + (wave >> 2), mi = wave & 3;
        const int n = ci & 127, bh = ci >> 7, hd = bh & 15, b = bh >> 4;
        const int i = mi * 16 + r16; const size_t tok = (size_t)b * SEQ + n * 64 + i;
        bf16x8 qa[4], sf[4][8]; u32x2 ov[8], zv[8];
#pragma unroll
        for (int ks = 0; ks < 4; ++ks) { qa[ks] = *(const bf16x8*)(Qg + (size_t)ci * 8192 + i * 128 + ks * 32 + quad * 8);
#pragma unroll
            for (int ni = 0; ni < 8; ++ni) sf[ks][ni] = *(const bf16x8*)(Sg + (size_t)ci * 16384 + (ni * 16 + r16) * 128 + ks * 32 + quad * 8); }
#pragma unroll
        for (int ni = 0; ni < 8; ++ni) { ov[ni] = *(const u32x2*)(Og + (size_t)ci * 8192 + i * 128 + ni * 16 + quad * 4); zv[ni] = *(const u32x2*)(proj + tok * GINP + 6144 + hd * 128 + ni * 16 + quad * 4); }
        f32x4 acc[8];
#pragma unroll
        for (int ni = 0; ni < 8; ++ni) acc[ni] = (f32x4){0.f, 0.f, 0.f, 0.f};
#pragma unroll
        for (int ks = 0; ks < 4; ++ks)
#pragma unroll
            for (int ni = 0; ni < 8; ++ni) acc[ni] = MFMA16(sf[ks][ni], qa[ks], acc[ni]);
        float ss = 0.f;
#pragma unroll
        for (int ni = 0; ni < 8; ++ni) {
            acc[ni][0] += bflo(ov[ni].x); acc[ni][1] += bfhi(ov[ni].x); acc[ni][2] += bflo(ov[ni].y); acc[ni][3] += bfhi(ov[ni].y);
            ss += acc[ni][0] * acc[ni][0] + acc[ni][1] * acc[ni][1] + acc[ni][2] * acc[ni][2] + acc[ni][3] * acc[ni][3]; }
        ss += sw_xor<16>(ss); ss = sw_xor32_sum(ss);
        const float rms = rsqrtf(ss * (1.f / 128.f) + NORM_EPS);
#pragma unroll
        for (int ni = 0; ni < 8; ++ni) { const int v = ni * 16 + quad * 4; const f32x4 gv = *(const f32x4*)(ogain + v);
            const float y0 = acc[ni][0] * rms * gv[0] * silu_f(bflo(zv[ni].x)), y1 = acc[ni][1] * rms * gv[1] * silu_f(bfhi(zv[ni].x));
            const float y2 = acc[ni][2] * rms * gv[2] * silu_f(bflo(zv[ni].y)), y3 = acc[ni][3] * rms * gv[3] * silu_f(bfhi(zv[ni].y));
            u32x2 w; w.x = cvt_pk_bf16(y0, y1); w.y = cvt_pk_bf16(y2, y3); *(u32x2*)(obuf + tok * D + hd * 128 + v) = w; }
    }
}

DI void ph_rope(PK p, const bf16_t* src, int ld, bf16_t* dst, const int wv) {
    PK_FRESH(p);
    const int tid = ltid(wv); const float* cosT = WSP(const float, WS_COS); const float* sinT = WSP(const float, WS_SIN);
    for (int idx = blockIdx.x * 512 + tid; idx < T * 128; idx += gridDim.x * 512) {
        const int jc = idx & 7, hc = (idx >> 3) & 15, t = idx >> 7;
        const bf16_t* sp = src + (size_t)t * ld + hc * 128 + jc * 8;
        const u32x4 x1 = *(const u32x4*)sp, x2 = *(const u32x4*)(sp + 64);
        const f32x4 c0 = *(const f32x4*)(cosT + t * 64 + jc * 8), c1 = *(const f32x4*)(cosT + t * 64 + jc * 8 + 4);
        const f32x4 s0 = *(const f32x4*)(sinT + t * 64 + jc * 8), s1 = *(const f32x4*)(sinT + t * 64 + jc * 8 + 4);
        float a[8] = {bflo(x1.x), bfhi(x1.x), bflo(x1.y), bfhi(x1.y), bflo(x1.z), bfhi(x1.z), bflo(x1.w), bfhi(x1.w)};
        float bb[8] = {bflo(x2.x), bfhi(x2.x), bflo(x2.y), bfhi(x2.y), bflo(x2.z), bfhi(x2.z), bflo(x2.w), bfhi(x2.w)};
        float cs[8] = {c0[0], c0[1], c0[2], c0[3], c1[0], c1[1], c1[2], c1[3]}, sn[8] = {s0[0], s0[1], s0[2], s0[3], s1[0], s1[1], s1[2], s1[3]};
        float o1[8], o2[8];
#pragma unroll
        for (int e = 0; e < 8; ++e) { o1[e] = a[e] * cs[e] - bb[e] * sn[e]; o2[e] = bb[e] * cs[e] + a[e] * sn[e]; }
        const int b = t >> 13, s = t & 8191;
        bf16_t* dp = dst + ((size_t)(b * 16 + hc) * SEQ + s) * 128 + jc * 8;
        u32x4 w1, w2;
        w1.x = cvt_pk_bf16(o1[0], o1[1]); w1.y = cvt_pk_bf16(o1[2], o1[3]); w1.z = cvt_pk_bf16(o1[4], o1[5]); w1.w = cvt_pk_bf16(o1[6], o1[7]);
        w2.x = cvt_pk_bf16(o2[0], o2[1]); w2.y = cvt_pk_bf16(o2[2], o2[3]); w2.z = cvt_pk_bf16(o2[4], o2[5]); w2.w = cvt_pk_bf16(o2[6], o2[7]);
        *(u32x4*)dp = w1; *(u32x4*)(dp + 64) = w2;
    }
}
DI void ph_vrelayout(const bf16_t* src, bf16_t* dst, const int wv) {
    const int tid = ltid(wv);
    for (int idx = blockIdx.x * 512 + tid; idx < T * 256; idx += gridDim.x * 512) {
        const int ch = idx & 15, hc = (idx >> 4) & 15, t = idx >> 8; const int b = t >> 13, s = t & 8191;
        *(u32x4*)(dst + ((size_t)(b * 16 + hc) * SEQ + s) * 128 + ch * 8) = *(const u32x4*)(src + (size_t)t * 4096 + 2048 + hc * 128 + ch * 8);
    }
}

DI void ph_attn(PK p, unsigned char* lds, const int wv) {
    PK_FRESH(p);
    using att::bf16;
    const bf16* Qd = WSP(const bf16, WS_QD); const bf16* Ksh = WSP(const bf16, WS_KSH); const bf16* Vsh = WSP(const bf16, WS_VSH); bf16* Oat = WSP(bf16, WS_OAT);
    const int total = 64 * 16, stride = gridDim.x, W = SEQ;
    int L = blockIdx.x;
    if (L < total) {
        auto mkref = [&](int Li, int pass) {
            const int xcd = Li & 7, jk = Li >> 3, mm = (jk & 127) >> 4, x = jk & 15, h64 = xcd * 8 + mm, qb = pass ? (31 - x) : x;
            const int vh = h64 & 1, c = (h64 >> 1) & 1, bh = h64 >> 2;
            att::BlockRef<bf16, bf16> r;
            r.Q = Qd + ((size_t)(bh * 2 + c) * SEQ + (size_t)qb * 256) * 128;
            r.K = Ksh + (size_t)(bh * 2 + c) * SEQ * 128;
            r.V = Vsh + (size_t)(bh * 2 + vh) * SEQ * 128;
            r.O = Oat + ((size_t)((bh * 2 + c) * 2 + vh) * SEQ + (size_t)qb * 256) * 128;
            r.P0 = qb * 256; return r; };
        int pass = 0;
        att::BlockRef<bf16, bf16> cur = mkref(L, 0);
        att::Seam<bf16> S;
        att::causal_swa_prime<bf16, bf16>(cur, W, (char*)lds, S, wv);
        for (;;) {
            const bool more_pass = pass == 0, more_item = L + stride < total, last = !more_pass && !more_item;
            int passn = pass + 1, Ln = L;
            if (!more_pass) { passn = 0; Ln = more_item ? L + stride : L; }
            const att::BlockRef<bf16, bf16> nxt = last ? cur : mkref(Ln, passn);
            att::causal_swa_block<bf16, bf16>(cur, nxt, SEQ, W, (char*)lds, S, wv);
            if (last) break;
            cur = nxt; pass = passn; L = Ln;
        }
    }
    __syncthreads();
}

DI void ph_diff_combine(PK p, int j, int l, unsigned char* lds, const int wv) {
    PK_FRESH(p);
    const int tid = ltid(wv), lane = tid & 63, wave = __builtin_amdgcn_readfirstlane(tid >> 6);
    float* ldsf = (float*)lds;
    const float lambda_init = 0.8f - 0.6f * expf(-0.3f * (float)l);
    if (wave == 0) { const float* lp = p->in[18] + j * 512;
        float a = lp[lane] * lp[128 + lane] + lp[64 + lane] * lp[192 + lane], bsum = lp[256 + lane] * lp[384 + lane] + lp[320 + lane] * lp[448 + lane];
        a = wave_sum(a); bsum = wave_sum(bsum);
        if (lane == 0) ldsf[0] = expf(a) - expf(bsum) + lambda_init; }
    __syncthreads();
    const float lam = ldsf[0], om = 1.f - lambda_init;
    const bf16_t* Oat = WSP(const bf16_t, WS_OAT); bf16_t* obuf = WSP(bf16_t, WS_OBUF); const float* sg = p->in[19] + j * 256;
    for (int row = blockIdx.x * 8 + wave; row < T * 8; row += gridDim.x * 8) {
        const int t = row >> 3, h = row & 7, b = t >> 13, s = t & 8191, vh = lane >> 5, d = (lane & 31) * 4;
        const u32x2 o1 = *(const u32x2*)(Oat + ((size_t)(((b * 8 + h) * 2 + 0) * 2 + vh) * SEQ + s) * 128 + d);
        const u32x2 o2 = *(const u32x2*)(Oat + ((size_t)(((b * 8 + h) * 2 + 1) * 2 + vh) * SEQ + s) * 128 + d);
        float v[4] = {bflo(o1.x) - lam * bflo(o2.x), bfhi(o1.x) - lam * bfhi(o2.x), bflo(o1.y) - lam * bflo(o2.y), bfhi(o1.y) - lam * bfhi(o2.y)};
        float ss = v[0] * v[0] + v[1] * v[1] + v[2] * v[2] + v[3] * v[3];
        ss = wave_sum(ss);
        const float rms = rsqrtf(ss * (1.f / 256.f) + NORM_EPS) * om;
        const f32x4 gv = *(const f32x4*)(sg + vh * 128 + d);
        u32x2 w; w.x = cvt_pk_bf16(v[0] * rms * gv[0], v[1] * rms * gv[1]); w.y = cvt_pk_bf16(v[2] * rms * gv[2], v[3] * rms * gv[3]);
        *(u32x2*)(obuf + (size_t)t * D + h * 256 + vh * 128 + d) = w;
    }
    __syncthreads();
}

#define INS16(Lr, vv) do { _Pragma("unroll") for (int k_ = 0; k_ < 16; ++k_) { const float hi_ = fmaxf(Lr[k_], vv); vv = fminf(Lr[k_], vv); Lr[k_] = hi_; } } while (0)
DI void sort16_desc(float (&L)[16]) {
#pragma unroll
    for (int k = 2; k <= 16; k <<= 1)
#pragma unroll
        for (int j = k >> 1; j >= 1; j >>= 1)
#pragma unroll
            for (int i = 0; i < 16; ++i) { const int l = i ^ j;
                if (l > i) { const float hi_ = fmaxf(L[i], L[l]), lo_ = fminf(L[i], L[l]); const bool desc = (i & k) == 0; L[i] = desc ? hi_ : lo_; L[l] = desc ? lo_ : hi_; } }
}
template <int XM> DI void merge16(float (&L)[16]) {
    float P[16];
#pragma unroll
    for (int i = 0; i < 16; ++i) P[i] = sw_xor<XM>(L[15 - i]);
#pragma unroll
    for (int i = 0; i < 16; ++i) L[i] = fmaxf(L[i], P[i]);
#pragma unroll
    for (int s = 8; s >= 1; s >>= 1)
#pragma unroll
        for (int i = 0; i < 16; ++i) if ((i & s) == 0) { const float hi_ = fmaxf(L[i], L[i + s]), lo_ = fminf(L[i], L[i + s]); L[i] = hi_; L[i + s] = lo_; }
}
__constant__ unsigned char kStair[56] = {0, 1, 2, 3, 4, 5, 6, 7, 8, 9, 10, 11, 12, 13, 14, 15, 16, 17, 18, 19, 20, 21, 22, 23, 32, 33, 34, 35, 36, 48, 49, 50, 51, 64, 65, 66, 80, 81, 96, 97, 112, 113, 128, 144, 160, 176, 192, 208, 224, 240, 255, 255, 255, 255, 255, 255};
DI void ph_peer_topk(PK p, int l, unsigned char* lds, const int wv) {
    PK_FRESH(p);
    const int tid = ltid(wv);
    float* tops = (float*)lds; float* fin = tops + 64 * 2 * 16;
    const bf16_t* pq = WSP(const bf16_t, WS_PQ);
    int* pidx = WSP(int, WS_PIDX); float* pgate = WSP(float, WS_PGATE);
    const float NEG = -__builtin_inff();
    const int rowl = tid >> 3, half = (tid >> 2) & 1, quarter = tid & 3, l8 = tid & 7;
    const int nitems = T * 8 / 64;
    const int lane = tid & 63, wave = __builtin_amdgcn_readfirstlane(tid >> 6);
    int crow = blockIdx.x * 8 + wave; const int cstep = gridDim.x * 8;
    u32x4 wn[4];
    if ((int)blockIdx.x < nitems) { const int row = blockIdx.x * 64 + rowl; const bf16_t* sp = pq + (size_t)(row >> 3) * 2048 + (row & 7) * 256 + half * 128 + quarter * 32;
#pragma unroll
        for (int c = 0; c < 4; ++c) wn[c] = *(const u32x4*)(sp + c * 8); }
    for (int item = blockIdx.x; item < nitems; item += gridDim.x) {
        const int row0 = item * 64;
        u32x4 wc[4];
#pragma unroll
        for (int c = 0; c < 4; ++c) wc[c] = wn[c];
        { const int itn = (item + (int)gridDim.x < nitems) ? item + (int)gridDim.x : item; const int row = itn * 64 + rowl;
          const bf16_t* sp = pq + (size_t)(row >> 3) * 2048 + (row & 7) * 256 + half * 128 + quarter * 32;
#pragma unroll
          for (int c = 0; c < 4; ++c) wn[c] = *(const u32x4*)(sp + c * 8); }
        f32x4 cv[8]; const bool cA = crow < 2 * 16384; if (cA) pc_load(p, l, crow, cv, lane);
        float Lr[16], Lq[16];
#pragma unroll
        for (int c = 0; c < 4; ++c)
#pragma unroll
            for (int e = 0; e < 4; ++e) { const unsigned w = wc[c][e];
                const float v0 = __uint_as_float((w << 16) | (unsigned)(quarter * 32 + c * 8 + e * 2)), v1 = __uint_as_float((w & 0xffff0000u) | (unsigned)(quarter * 32 + c * 8 + e * 2 + 1));
                if (c < 2) { Lr[c * 8 + e * 2] = v0; Lr[c * 8 + e * 2 + 1] = v1; } else { Lq[(c - 2) * 8 + e * 2] = v0; Lq[(c - 2) * 8 + e * 2 + 1] = v1; } }
        sort16_desc(Lr); sort16_desc(Lq);
#pragma unroll
        for (int i = 0; i < 16; ++i) Lr[i] = fmaxf(Lr[i], Lq[15 - i]);
#pragma unroll
        for (int s = 8; s >= 1; s >>= 1)
#pragma unroll
            for (int i = 0; i < 16; ++i) if ((i & s) == 0) { const float hi_ = fmaxf(Lr[i], Lr[i + s]), lo_ = fminf(Lr[i], Lr[i + s]); Lr[i] = hi_; Lr[i + s] = lo_; }
        if (cA) { pc_store(p, crow, cv, lane); crow += cstep; }
        const bool cB = crow < 2 * 16384; if (cB) pc_load(p, l, crow, cv, lane);
        merge16<1>(Lr); merge16<2>(Lr);
        if (quarter == 0) {
#pragma unroll
            for (int k = 0; k < 16; ++k) tops[(rowl * 2 + half) * 16 + k] = Lr[k];
        }
        asm volatile("s_waitcnt lgkmcnt(0)" ::: "memory");
        float M[16];
#pragma unroll
        for (int k = 0; k < 16; ++k) M[k] = NEG;
        {
            const float* ta = tops + (rowl * 2) * 16; const float* tb = ta + 16;
#pragma unroll
            for (int m = 0; m < 7; ++m) { const unsigned code = kStair[l8 + 8 * m];
                float s = (code < 255u) ? ta[code >> 4] + tb[code & 15u] : NEG;
                s = (code < 255u) ? __uint_as_float((__float_as_uint(s) & ~255u) | code) : NEG; INS16(M, s); }
        }
        merge16<1>(M); merge16<2>(M); merge16<4>(M);
        float sum = 0.f;
#pragma unroll
        for (int k = 0; k < 16; ++k) sum += __expf(M[k] - M[0]);
        if (l8 == 0) {
#pragma unroll
            for (int k = 0; k < 16; ++k) fin[rowl * 16 + k] = M[k];
        }
        asm volatile("s_waitcnt lgkmcnt(0)" ::: "memory");
        {
            const float inv = 1.f / sum, m0 = M[0]; const int row = row0 + rowl; const size_t ob = (size_t)(row >> 3) * 128 + (row & 7) * 16;
#pragma unroll
            for (int u = 0; u < 2; ++u) { const int k = l8 * 2 + u; const float mk = fin[rowl * 16 + k]; const unsigned code = __float_as_uint(mk) & 255u;
                const unsigned i1 = __float_as_uint(tops[(rowl * 2) * 16 + (code >> 4)]) & 127u, i2 = __float_as_uint(tops[(rowl * 2 + 1) * 16 + (code & 15u)]) & 127u;
                pidx[ob + k] = (int)(i1 * 128u + i2); pgate[ob + k] = __expf(mk - m0) * inv; }
        }
        if (cB) { pc_store(p, crow, cv, lane); crow += cstep; }
        asm volatile("s_waitcnt lgkmcnt(0)" ::: "memory");
    }
    for (; crow < 2 * 16384; crow += cstep) { f32x4 cv[8]; pc_load(p, l, crow, cv, lane); pc_store(p, crow, cv, lane); }
}

DI float gelu_f(float v) {
    const float av = fabsf(v), t = __builtin_amdgcn_rcpf(fmaf(av, 0.2316418882f, 1.0f));
    float q = fmaf(t, 0.5307027145f, -0.7265760135f); q = fmaf(q, t, 0.7107068705f); q = fmaf(q, t, -0.142248368f); q = fmaf(q, t, 0.127414796f); q = q * t;
    const float e = __builtin_amdgcn_exp2f(v * v * -0.72134752044f), m = v * (q * e);
    return v < 0.f ? m : v - m;
}
#define FP4X8(w, o) const f32x2 o##0 = __builtin_amdgcn_cvt_scalef32_pk_f32_fp4(w, 1.0f, 0), o##1 = __builtin_amdgcn_cvt_scalef32_pk_f32_fp4(w, 1.0f, 1), \
                                o##2 = __builtin_amdgcn_cvt_scalef32_pk_f32_fp4(w, 1.0f, 2), o##3 = __builtin_amdgcn_cvt_scalef32_pk_f32_fp4(w, 1.0f, 3)
DI void ph_peer_gather(PK p, int l, unsigned char* lds, const int wv, const bool apply = true) {
    PK_FRESH(p);
    const int tid = ltid(wv), lane = tid & 63, wave = __builtin_amdgcn_readfirstlane(tid >> 6);
    const bf16_t* hb = WSP(const bf16_t, WS_HBUF); const unsigned char* ub = WSP(const unsigned char, WS_PU); const unsigned char* vb = WSP(const unsigned char, WS_PV);
    const unsigned* pus = WSP(const unsigned, WS_PUS); const unsigned* pvs = WSP(const unsigned, WS_PVS);
    const int* pidx = WSP(const int, WS_PIDX); const float* pgate = WSP(const float, WS_PGATE); bf16_t* xc = WSP(bf16_t, WS_XCUR);
    const float* gt2 = WSP(const float, WS_MOD) + l * 12288 + 5 * 2048;
    const unsigned l16 = (unsigned)lane * 16u, l2 = (unsigned)(lane >> 1) * 4u, ssh = (unsigned)(lane & 1) * 16u;     const unsigned char* pus8 = (const unsigned char*)pus; const unsigned char* pvs8 = (const unsigned char*)pvs;
    for (int tok = blockIdx.x * 8 + wave; tok < T; tok += gridDim.x * 8) {
        f32x2 hf2[16];
#pragma unroll
        for (int c = 0; c < 4; ++c) { const u32x4 w = *(const u32x4*)(hb + (size_t)tok * D + lane * 32 + c * 8);
            hf2[c * 4 + 0] = (f32x2){bflo(w.x), bfhi(w.x)}; hf2[c * 4 + 1] = (f32x2){bflo(w.y), bfhi(w.y)}; hf2[c * 4 + 2] = (f32x2){bflo(w.z), bfhi(w.z)}; hf2[c * 4 + 3] = (f32x2){bflo(w.w), bfhi(w.w)}; }
        f32x2 acc2[16];
#pragma unroll
        for (int i = 0; i < 16; ++i) acc2[i] = (f32x2){0.f, 0.f};
        u32x2* sraw = (u32x2*)(lds + wave * 2048); u32x2* ssrt = sraw + 128;
        {
            const unsigned k0 = (unsigned)pidx[(size_t)tok * 128 + lane], k1 = (unsigned)pidx[(size_t)tok * 128 + 64 + lane];
            const float g0 = pgate[(size_t)tok * 128 + lane], g1 = pgate[(size_t)tok * 128 + 64 + lane];
            sraw[lane] = (u32x2){k0, __float_as_uint(g0)}; sraw[64 + lane] = (u32x2){k1, __float_as_uint(g1)};
            asm volatile("s_waitcnt lgkmcnt(0)" ::: "memory");
            const unsigned key0 = k0 * 128u + (unsigned)lane, key1 = k1 * 128u + 64u + (unsigned)lane; unsigned r0 = 0, r1 = 0;
            for (int j = 0; j < 128; ++j) { const unsigned kj = sraw[j].x * 128u + (unsigned)j; r0 += (kj < key0) ? 1u : 0u; r1 += (kj < key1) ? 1u : 0u; }
            ssrt[r0] = (u32x2){k0, __float_as_uint(g0)}; ssrt[r1] = (u32x2){k1, __float_as_uint(g1)};
            asm volatile("s_waitcnt lgkmcnt(0)" ::: "memory");
        }
#define G_LOAD(gi, UR, VR, US, VS, GT) do { _Pragma("unroll") for (int q = 0; q < 4; ++q) { const u32x2 pr = ssrt[(gi) * 4 + q]; const unsigned e_ = (unsigned)__builtin_amdgcn_readfirstlane((int)pr.x); GT[q] = __uint_as_float(pr.y); \
            UR[q] = *(const u32x4*)(ub + (size_t)e_ * 1024 + l16); US[q] = *(const unsigned*)(pus8 + (size_t)e_ * 128 + l2); \
            VR[q] = *(const u32x4*)(vb + (size_t)e_ * 1024 + l16); VS[q] = *(const unsigned*)(pvs8 + (size_t)e_ * 128 + l2); } } while (0)
#define G_COMP(UR, VR, US, VS, GT) do { float cf[4]; \
            _Pragma("unroll") for (int q = 0; q < 4; ++q) { f32x2 t2 = {0.f, 0.f}, t3 = {0.f, 0.f}; \
                _Pragma("unroll") for (int c = 0; c < 4; ++c) { FP4X8(UR[q][c], a); \
                    t2 = a0 * hf2[c * 4 + 0] + t2; t3 = a1 * hf2[c * 4 + 1] + t3; t2 = a2 * hf2[c * 4 + 2] + t2; t3 = a3 * hf2[c * 4 + 3] + t3; } \
                t2 = t2 + t3; \
                const float d = wave_sum((t2.x + t2.y) * __uint_as_float((US[q] >> ssh) << 16)); \
                cf[q] = GT[q] * gelu_f(d); } \
            _Pragma("unroll") for (int q = 0; q < 4; ++q) { const float cs = cf[q] * __uint_as_float((VS[q] >> ssh) << 16); const f32x2 cs2 = {cs, cs}; \
                _Pragma("unroll") for (int c = 0; c < 4; ++c) { FP4X8(VR[q][c], b); \
                    acc2[c * 4 + 0] = cs2 * b0 + acc2[c * 4 + 0]; acc2[c * 4 + 1] = cs2 * b1 + acc2[c * 4 + 1]; acc2[c * 4 + 2] = cs2 * b2 + acc2[c * 4 + 2]; acc2[c * 4 + 3] = cs2 * b3 + acc2[c * 4 + 3]; } } } while (0)
        {
            u32x4 urA[4], vrA[4], urB[4], vrB[4]; unsigned usA[4], vsA[4], usB[4], vsB[4]; float gtA[4], gtB[4];
            G_LOAD(0, urA, vrA, usA, vsA, gtA);
            for (int g = 0; g < 32; g += 2) {
                G_LOAD(g + 1, urB, vrB, usB, vsB, gtB);
                G_COMP(urA, vrA, usA, vsA, gtA);
                G_LOAD((g + 2 < 32) ? g + 2 : 31, urA, vrA, usA, vsA, gtA);
                G_COMP(urB, vrB, usB, vsB, gtB);
            }
        }
#undef G_LOAD
#undef G_COMP
        float acc[32];
#pragma unroll
        for (int i = 0; i < 16; ++i) { acc[2 * i] = acc2[i].x; acc[2 * i + 1] = acc2[i].y; }
        if (!apply) { if (p->ph_hi == -12345) { for (int i = 0; i < 32; ++i) xc[i * 64 + lane] = f2bf(acc[i]); } continue; }
        const int b = tok >> 13; const float gm = ((MK_SKIP >> (2 * l + 1)) & 1) ? 0.f : 1.f;
        float ss = 0.f;
#pragma unroll
        for (int c = 0; c < 4; ++c) { const int col = lane * 32 + c * 8; bf16_t* xp = xc + (size_t)tok * D + col;
            const u32x4 xb = *(const u32x4*)xp; const f32x4 g0 = *(const f32x4*)(gt2 + (size_t)b * MODC + col), g1 = *(const f32x4*)(gt2 + (size_t)b * MODC + col + 4);
            const float x8[8] = {bflo(xb.x), bfhi(xb.x), bflo(xb.y), bfhi(xb.y), bflo(xb.z), bfhi(xb.z), bflo(xb.w), bfhi(xb.w)}; float y8[8];
#pragma unroll
            for (int e2 = 0; e2 < 8; ++e2) { y8[e2] = x8[e2] + gm * ((e2 < 4) ? g0[e2] : g1[e2 - 4]) * acc[c * 8 + e2]; acc[c * 8 + e2] = y8[e2]; ss += y8[e2] * y8[e2]; }
            if (l < 3) { u32x4 w; w.x = cvt_pk_bf16(y8[0], y8[1]); w.y = cvt_pk_bf16(y8[2], y8[3]); w.z = cvt_pk_bf16(y8[4], y8[5]); w.w = cvt_pk_bf16(y8[6], y8[7]); *(u32x4*)xp = w; } }
        const float rn = rsqrtf(wave_sum(ss) * (1.f / D) + NORM_EPS);
        const float* modall = WSP(const float, WS_MOD) + (size_t)b * MODC;
        if (l == 3) {
#pragma unroll
            for (int c = 0; c < 8; ++c) { const int col = lane * 32 + c * 4; const f32x4 gv = *(const f32x4*)(p->in[25] + col); f32x4 o;
#pragma unroll
                for (int e2 = 0; e2 < 4; ++e2) o[e2] = acc[c * 4 + e2] * rn * gv[e2];
                *(f32x4*)(p->out + (size_t)tok * D + col) = o; }
        } else {
            const float* g1 = (l == 1) ? p->in[13] : (p->in[5] + (l + 1) * D);
            const float* sh1 = (l == 1) ? (modall + 4 * 12288) : (modall + (l + 1) * 12288);
            const float* sc1 = sh1 + D;
            bf16_t* d1 = WSP(bf16_t, WS_HBUF) + (size_t)tok * D;
#pragma unroll
            for (int c = 0; c < 4; ++c) { u32x4 w;
#pragma unroll
                for (int hh = 0; hh < 2; ++hh) { const int col = lane * 32 + c * 8 + hh * 4; const f32x4 gv = *(const f32x4*)(g1 + col), sv = *(const f32x4*)(sh1 + col), cv = *(const f32x4*)(sc1 + col); float o[4];
#pragma unroll
                    for (int e2 = 0; e2 < 4; ++e2) o[e2] = acc[c * 8 + hh * 4 + e2] * rn * gv[e2] * (1.f + cv[e2]) + sv[e2];
                    w[hh * 2] = cvt_pk_bf16(o[0], o[1]); w[hh * 2 + 1] = cvt_pk_bf16(o[2], o[3]); }
                *(u32x4*)(d1 + lane * 32 + c * 8) = w; }
            if (l == 1) {
                const float* g2 = p->in[5] + 2 * D; const float* sh2 = modall + 2 * 12288; const float* sc2 = sh2 + D;
                bf16_t* d2 = WSP(bf16_t, WS_OBUF) + (size_t)tok * D;
#pragma unroll
                for (int c = 0; c < 4; ++c) { u32x4 w;
#pragma unroll
                    for (int hh = 0; hh < 2; ++hh) { const int col = lane * 32 + c * 8 + hh * 4; const f32x4 gv = *(const f32x4*)(g2 + col), sv = *(const f32x4*)(sh2 + col), cv = *(const f32x4*)(sc2 + col); float o[4];
#pragma unroll
                        for (int e2 = 0; e2 < 4; ++e2) o[e2] = acc[c * 8 + hh * 4 + e2] * rn * gv[e2] * (1.f + cv[e2]) + sv[e2];
                        w[hh * 2] = cvt_pk_bf16(o[0], o[1]); w[hh * 2 + 1] = cvt_pk_bf16(o[2], o[3]); }
                    *(u32x4*)(d2 + lane * 32 + c * 8) = w; }
            }
        }
    }
}
#undef FP4X8

DI void ph_dbg(PK p, int mode, const int wv) {
    PK_FRESH(p);
    const int tid = ltid(wv);
    const bf16_t* Ag = WSP(const bf16_t, WS_GA); const bf16_t* Bg = WSP(const bf16_t, WS_GB); const bf16_t* Qg = WSP(const bf16_t, WS_GQ); const bf16_t* Og = WSP(const bf16_t, WS_GO); const bf16_t* Sg = WSP(const bf16_t, WS_GS);
    const bf16_t* proj = WSP(const bf16_t, WS_PROJ); bf16_t* obuf = WSP(bf16_t, WS_OBUF);
    for (int idx = blockIdx.x * 512 + tid; idx < T * D; idx += gridDim.x * 512) {
        const int tok = idx >> 11, col = idx & 2047, hd = col >> 7, v = col & 127, b = tok >> 13, s = tok & 8191, n = s >> 6, i = s & 63;
        const size_t ci = (size_t)(b * 16 + hd) * 128 + n;
        float r = 0.f;
        if (mode == 1) r = bf2f(Og[ci * 8192 + i * 128 + v]) + bf2f(Qg[ci * 8192 + i * 128 + v]);
        if (mode == 2) r = bf2f(Ag[ci * 16384 + i * 128 + v]) + bf2f(Bg[ci * 16384 + (i + 64) * 128 + v]) + bf2f(Ag[ci * 16384 + (i + 64) * 128 + v]) + bf2f(Bg[ci * 16384 + i * 128 + v]);
        if (mode == 3) r = bf2f(Sg[ci * 16384 + i * 128 + v]) + bf2f(Sg[ci * 16384 + (i + 64) * 128 + v]);
        if (mode == 4) r = bf2f(proj[(size_t)tok * GINP + col]) + bf2f(proj[(size_t)tok * GINP + 2048 + col]) + bf2f(proj[(size_t)tok * GINP + 4096 + col]) + bf2f(proj[(size_t)tok * GINP + 6144 + col]) + ((col < 256) ? bf2f(proj[(size_t)tok * GINP + 8192 + col]) : 0.f);
        obuf[idx] = f2bf(r);
    }
}
#ifndef MK_AOUT
#define MK_AOUT obuf
#endif
constexpr int NPHASES = 1 + 1 + 2 * 9 + 2 * 8 + 1;

__global__ void __launch_bounds__(512, 2) mk_fwd(Params p_arg) {
    extern __shared__ __attribute__((aligned(16))) unsigned char lds[];
    PK p = (PK)__builtin_amdgcn_kernarg_segment_ptr();
    const int lo = p->ph_lo, hi = p->ph_hi;
    const int wv = __builtin_amdgcn_readfirstlane((int)threadIdx.x >> 6);
    volatile LAS unsigned* st = (volatile LAS unsigned*)((LAS unsigned char*)lds + LDS_BARW);
    if (wv == 0 && lane_id() == 0) { st[0] = 0u; st[1] = 0u; }
    __syncthreads();
    XcdBarrier bar; bar.bar = (unsigned*)(p->ws + WS_BAR); bar.x = 0; bar.st = st; bar.wv = wv;
    if (hi - lo > 1) bar = xcd_barrier_post((unsigned*)(p->ws + WS_BAR), st, wv);
    int ph = 0;
#define PH_BEGIN if (lo <= ph && ph < hi) { PK_FRESH(p);
#define PH_END   if (ph + 1 < hi) xcd_barrier(bar); } ++ph;
#define mod  WSP(const float, WS_MOD)
#define xcur WSP(bf16_t, WS_XCUR)
#define hbuf WSP(bf16_t, WS_HBUF)
#define obuf WSP(bf16_t, WS_OBUF)
#define G    ((int)gridDim.x)
#define bx   ((int)blockIdx.x)
#define modl (mod + l * 12288)

    PH_BEGIN ph_prologue(p, lds, wv); if (MK_DUP & 1) { __syncthreads(); ph_prologue(p, lds, wv); } PH_END

    for (int l = 0; l < DEPTH; ++l) {
        if (l == 0) { PH_BEGIN ph_norm<0>(p->in[0], nullptr, p->in[5], modl + 0 * D, modl + 1 * D, hbuf, nullptr, wv); PH_END }
        PH_BEGIN
            pg8::Gemm g; pg8::EpiMk E; E.mode = 0; E.xin = nullptr; E.xinb = nullptr; E.xout = nullptr; E.gate = nullptr; E.gmul = 1.f; E.xoutf = nullptr; E.O2 = nullptr; E.nrope = 0; E.cosT = WSP(const float, WS_COS); E.sinT = WSP(const float, WS_SIN);
            g.A = (l == 2) ? obuf : hbuf; g.M = T; g.K = D; g.ld = D; g.ksplit = 0;
            if (l < 2) { g.Bt = WSP(const bf16_t, WS_WIN) + (size_t)l * GINP * D; g.N = 8192; E.O = WSP(bf16_t, WS_PROJ); E.ldc = GINP; }
            else { g.Bt = WSP(const bf16_t, WS_DWQ) + (size_t)(l - 2) * D * D; g.N = D; E.mode = 2; E.O = WSP(bf16_t, WS_QD); E.nrope = D; }
            pg8::StaticOrder S; S.init(g.M, g.N, G, bx);
            pg8::gemm_phase<pg8::EpiMk, pg8::StaticOrder>((PG8_LAS unsigned char*)lds, g, S, E, wv);
            if (MK_DUP & 2) { __syncthreads(); pg8::gemm_phase<pg8::EpiMk, pg8::StaticOrder>((PG8_LAS unsigned char*)lds, g, S, E, wv); }
            if (l < 2) {
                pg8::Gemm g2; g2.A = hbuf; g2.Bt = WSP(const bf16_t, WS_WIN) + (size_t)l * GINP * D + (size_t)8192 * D; g2.M = T; g2.N = 1024; g2.K = 512; g2.ld = D; g2.ksplit = 1;
                pg8::EpiMk E2 = E; E2.mode = 3; E2.xoutf = WSP(float, WS_PAB);
                pg8::StaticOrder S2; S2.init(g2.M, g2.N, G, bx);
                pg8::gemm_phase<pg8::EpiMk, pg8::StaticOrder>((PG8_LAS unsigned char*)lds, g2, S2, E2, wv);
            }
        PH_END
        if (l < 2) {
            PH_BEGIN ph_gdn_p1(p, l, lds, wv); if (MK_DUP & 8) { __syncthreads(); ph_gdn_p1(p, l, lds, wv); } PH_END
            PH_BEGIN ph_gdn_p2(p, lds, wv); if (MK_DUP & 16) { __syncthreads(); ph_gdn_p2(p, lds, wv); } PH_END
#ifdef MK_DBG
            PH_BEGIN ph_dbg(p, MK_DBG, wv); PH_END
#else
            PH_BEGIN ph_gdn_p3(p, l, wv); if (MK_DUP & 32) { __syncthreads(); ph_gdn_p3(p, l, wv); } PH_END
#endif
        } else {
            PH_BEGIN ph_attn(p, lds, wv); if (MK_DUP & 64) { __syncthreads(); ph_attn(p, lds, wv); } PH_END
            PH_BEGIN ph_diff_combine(p, l - 2, l, lds, wv); PH_END
        }
        PH_BEGIN
            pg8::Gemm g; pg8::EpiMk E; E.mode = 1; E.O = nullptr; E.ldc = 0; E.xoutf = nullptr; E.O2 = nullptr; E.nrope = 0; E.cosT = nullptr; E.sinT = nullptr; E.xin = (l == 0) ? p->in[0] : nullptr; E.xinb = xcur; E.xout = xcur; E.gate = modl + 2 * D; E.gmul = ((MK_SKIP >> (2 * l)) & 1) ? 0.f : 1.f;
            g.A = MK_AOUT; g.M = T; g.K = D; g.N = D; g.ld = D; g.ksplit = 0;
            g.Bt = (l < 2) ? (WSP(const bf16_t, WS_WOUT) + (size_t)l * D * D) : (WSP(const bf16_t, WS_DWO) + (size_t)(l - 2) * D * D);
            pg8::StaticOrder S; S.init(g.M, g.N, G, bx);
            pg8::gemm_phase<pg8::EpiMk, pg8::StaticOrder>((PG8_LAS unsigned char*)lds, g, S, E, wv);
        PH_END
        PH_BEGIN ph_norm<2>(nullptr, xcur, p->in[6] + l * D, modl + 3 * D, modl + 4 * D, hbuf, nullptr, wv); PH_END
        PH_BEGIN
            pg8::Gemm g; pg8::EpiMk E; E.mode = 0; E.xin = nullptr; E.xinb = nullptr; E.xout = nullptr; E.gate = nullptr; E.gmul = 1.f; E.xoutf = nullptr; E.O2 = nullptr; E.nrope = 0; E.cosT = WSP(const float, WS_COS); E.sinT = WSP(const float, WS_SIN); E.O = WSP(bf16_t, WS_PQ); E.ldc = D;
            g.A = hbuf; g.M = T; g.K = D; g.N = D; g.ld = D; g.ksplit = 0; g.Bt = WSP(const bf16_t, WS_PWQ) + (size_t)l * D * D;
            pg8::StaticOrder S; S.init(g.M, g.N, G, bx);
            pg8::gemm_phase<pg8::EpiMk, pg8::StaticOrder>((PG8_LAS unsigned char*)lds, g, S, E, wv);
        PH_END
        PH_BEGIN ph_peer_topk(p, l, lds, wv); if (MK_DUP & 128) { __syncthreads(); ph_peer_topk(p, l, lds, wv); } PH_END
        PH_BEGIN ph_peer_gather(p, l, lds, wv); if (MK_DUP & 256) { __syncthreads(); ph_peer_gather(p, l, lds, wv, false); } PH_END
        if (l == 1) {
            PH_BEGIN
                pg8::Gemm g; pg8::EpiMk E; E.mode = 0; E.xin = nullptr; E.xinb = nullptr; E.xout = nullptr; E.gate = nullptr; E.gmul = 1.f; E.xoutf = nullptr; E.O2 = nullptr; E.nrope = 0; E.cosT = WSP(const float, WS_COS); E.sinT = WSP(const float, WS_SIN); E.mode = 2; E.O = WSP(bf16_t, WS_KSH); E.O2 = WSP(bf16_t, WS_VSH); E.nrope = 2048;
                g.A = hbuf; g.M = T; g.K = D; g.N = 4096; g.ld = D; g.ksplit = 0; g.Bt = WSP(const bf16_t, WS_KVW);
                pg8::StaticOrder S; S.init(g.M, g.N, G, bx);
                pg8::gemm_phase<pg8::EpiMk, pg8::StaticOrder>((PG8_LAS unsigned char*)lds, g, S, E, wv);
            PH_END
        }
    }
#undef PH_BEGIN
#undef PH_END
#undef mod
#undef xcur
#undef hbuf
#undef obuf
#undef G
#undef bx
#undef modl
}

extern "C" void kernel_launch(void* const* d_in, const int* in_sizes, int n_in, void* d_out, int out_size, void* d_ws, size_t ws_size, hipStream_t stream) {
    static int grid = 0;
    if (grid == 0) {
        if (n_in != 26 || in_sizes[0] != T * D || out_size != T * D || ws_size < WS_END) {
            fprintf(stderr, "kernel_launch: unexpected shapes: n_in %d in0 %d out %d ws %zu (need %zu)\n", n_in, n_in > 0 ? in_sizes[0] : -1, out_size, ws_size, (size_t)WS_END); grid = -1; return; }
        int dev = 0, cus = 0;
        if (hipGetDevice(&dev) != hipSuccess || hipDeviceGetAttribute(&cus, hipDeviceAttributeMultiprocessorCount, dev) != hipSuccess || cus <= 0) cus = 256;
        if (hipFuncSetAttribute((const void*)mk_fwd, hipFuncAttributeMaxDynamicSharedMemorySize, LDS_BYTES) != hipSuccess) { fprintf(stderr, "kernel_launch: hipFuncSetAttribute failed\n"); grid = -1; return; }
        int per_cu = 0;
        if (hipOccupancyMaxActiveBlocksPerMultiprocessor(&per_cu, (const void*)mk_fwd, 512, LDS_BYTES) != hipSuccess || per_cu < 1) fprintf(stderr, "kernel_launch: occupancy query says %d\n", per_cu);
        (void)hipGetLastError();
        grid = cus;
    }
    if (grid < 0) return;
    (void)hipMemsetAsync((char*)d_ws + WS_BAR, 0, 16384, stream);
    Params p{};
    for (int i = 0; i < 26; ++i) p.in[i] = (const float*)d_in[i];
    p.out = (float*)d_out; p.ws = (unsigned char*)d_ws;
#if MK_N_LAUNCHES == 1
    p.ph_lo = 0; p.ph_hi = NPHASES;
    hipLaunchKernelGGL(mk_fwd, dim3(grid), dim3(512), LDS_BYTES, stream, p);
#else
#ifndef MK_PHMASK
#define MK_PHMASK 0xffffffffu
#endif
#ifndef MK_STOP
#define MK_STOP NPHASES
#endif
    for (int ph = 0; ph < NPHASES; ++ph) { if (ph >= MK_STOP && ph != NPHASES - 1) continue; if (!(MK_PHMASK >> (ph < 31 ? ph : 31) & 1u) && ph != NPHASES - 1) continue; p.ph_lo = ph; p.ph_hi = ph + 1; hipLaunchKernelGGL(mk_fwd, dim3(grid), dim3(512), LDS_BYTES, stream, p); }
#endif
    const hipError_t le = hipPeekAtLastError();
    if (le != hipSuccess) fprintf(stderr, "kernel_launch: launch failed: %s\n", hipGetErrorName(le));
}
```

```cpp
#include <hip/hip_runtime.h>
#include <hip/hip_bf16.h>
#include <cstdio>
#include <cstdint>

#ifndef MK_N_LAUNCHES
#define MK_N_LAUNCHES 1
#endif
#ifndef MK_DUP
#define MK_DUP 0
#endif
#ifndef MK_SKIP
#define MK_SKIP 0
#endif

constexpr int NB = 2, SEQ = 8192, T = NB * SEQ, D = 2048, DEPTH = 4;
constexpr int GH = 16, GIN = 8224, GINP = 8448;
constexpr int MODC = 4 * 12288 + 4096;
constexpr float NORM_EPS = 1e-6f;

typedef unsigned short bf16_t;
typedef short bf16x8 __attribute__((ext_vector_type(8)));
typedef short s16x4 __attribute__((ext_vector_type(4)));
typedef float f32x4 __attribute__((ext_vector_type(4)));
typedef float f32x2 __attribute__((ext_vector_type(2)));
typedef float f32x16 __attribute__((ext_vector_type(16)));
typedef unsigned u32x4 __attribute__((ext_vector_type(4)));
typedef unsigned u32x2 __attribute__((ext_vector_type(2)));
typedef __bf16 bfx2 __attribute__((ext_vector_type(2)));
#define LAS __attribute__((address_space(3)))
#define DI __device__ __forceinline__

DI float bf2f(bf16_t v) { return __uint_as_float(((unsigned)v) << 16); }
DI float bflo(unsigned w) { return __uint_as_float(w << 16); }
DI float bfhi(unsigned w) { return __uint_as_float(w & 0xffff0000u); }
DI bf16_t f2bf(float f) { unsigned u = __float_as_uint(f); u += 0x7FFFu + ((u >> 16) & 1u); return (bf16_t)(u >> 16); }
DI unsigned cvt_pk_bf16(float lo, float hi) { const f32x2 v = {lo, hi}; return __builtin_bit_cast(unsigned, __builtin_convertvector(v, bfx2)); }
template <int M> DI float sw_xor(float v) { return __int_as_float(__builtin_amdgcn_ds_swizzle(__float_as_int(v), (M << 10) | 0x1f)); }
DI float sw_xor32_sum(float v) { auto rr = __builtin_amdgcn_permlane32_swap(__float_as_uint(v), __float_as_uint(v), false, false); return __uint_as_float(rr[0]) + __uint_as_float(rr[1]); }
DI float wave_max(float v) {
    v = fmaxf(v, sw_xor<1>(v)); v = fmaxf(v, sw_xor<2>(v)); v = fmaxf(v, sw_xor<4>(v)); v = fmaxf(v, sw_xor<8>(v)); v = fmaxf(v, sw_xor<16>(v));
    auto rr = __builtin_amdgcn_permlane32_swap(__float_as_uint(v), __float_as_uint(v), false, false); return fmaxf(__uint_as_float(rr[0]), __uint_as_float(rr[1]));
}
DI float wave_sum(float v) {
    v += sw_xor<1>(v); v += sw_xor<2>(v); v += sw_xor<4>(v); v += sw_xor<8>(v); v += sw_xor<16>(v);
    return sw_xor32_sum(v);
}
DI void lds_barrier() { asm volatile("s_waitcnt lgkmcnt(0)" ::: "memory"); __builtin_amdgcn_s_barrier(); asm volatile("" ::: "memory"); }
DI float silu_f(float v) { return v / (1.f + __expf(-v)); }
DI int lane_id() { int l; asm volatile("v_mbcnt_lo_u32_b32 %0, -1, 0\n\tv_mbcnt_hi_u32_b32 %0, -1, %0" : "=v"(l)); return l; }
DI int ltid(const int wv) { int t = wv * 64 + lane_id(); asm volatile("" : "+v"(t)); return t; }

constexpr size_t al4k(size_t x) { return (x + 4095) & ~(size_t)4095; }
constexpr size_t WS_BAR   = 0;
constexpr size_t WS_MOD   = 16384;
constexpr size_t WS_COS   = al4k(WS_MOD + (size_t)2 * MODC * 4);
constexpr size_t WS_SIN   = WS_COS + (size_t)T * 64 * 4;
constexpr size_t WS_SUBK  = WS_SIN + (size_t)T * 64 * 4;
constexpr size_t WS_WIN   = WS_SUBK + (size_t)4 * 2 * 128 * 128 * 2;
constexpr size_t WS_WOUT  = WS_WIN + (size_t)2 * GINP * D * 2;
constexpr size_t WS_KVW   = WS_WOUT + (size_t)2 * D * D * 2;
constexpr size_t WS_DWQ   = WS_KVW + (size_t)4096 * D * 2;
constexpr size_t WS_DWO   = WS_DWQ + (size_t)2 * D * D * 2;
constexpr size_t WS_PWQ   = WS_DWO + (size_t)2 * D * D * 2;
constexpr size_t WS_PU    = WS_PWQ + (size_t)4 * D * D * 2;
constexpr size_t WS_PUS   = WS_PU + (size_t)16384 * 1024;
constexpr size_t WS_PV    = WS_PU + (size_t)16384 * D * 2;
constexpr size_t WS_PVS   = WS_PV + (size_t)16384 * 1024;
constexpr size_t WS_XCUR  = WS_PV + (size_t)16384 * D * 2;
constexpr size_t WS_HBUF  = WS_XCUR + (size_t)T * D * 4;
constexpr size_t WS_OBUF  = WS_HBUF + (size_t)T * D * 2;
constexpr size_t WS_PROJ  = WS_OBUF + (size_t)T * D * 2;
constexpr size_t WS_PAB   = WS_PROJ + (size_t)T * GINP * 2;
constexpr size_t WS_PQ    = WS_PROJ + (size_t)T * GINP * 2;
constexpr size_t WS_PIDX  = WS_PQ + (size_t)T * D * 2;
constexpr size_t WS_PGATE = WS_PIDX + (size_t)T * 128 * 4;
constexpr size_t WS_GA    = WS_PGATE + (size_t)T * 128 * 4;
constexpr size_t WS_GB    = WS_GA + (size_t)4096 * 128 * 128 * 2;
constexpr size_t WS_GQ    = WS_GB + (size_t)4096 * 128 * 128 * 2;
constexpr size_t WS_GO    = WS_GQ + (size_t)4096 * 64 * 128 * 2;
constexpr size_t WS_GS    = WS_GO + (size_t)4096 * 64 * 128 * 2;
constexpr size_t WS_GL    = WS_GS + (size_t)4096 * 128 * 128 * 2;
constexpr size_t WS_END   = WS_GL + 16384;
constexpr size_t WS_OAT   = WS_GA;
constexpr size_t WS_KSH   = WS_GB;
constexpr size_t WS_VSH   = WS_GB + (size_t)67108864;
constexpr size_t WS_QD    = WS_GQ;

constexpr int LDS_BYTES = 147456;
constexpr int LDS_BARW  = 147456 - 64;

struct Params { const float* in[26]; float* out; unsigned char* ws; int ph_lo, ph_hi; };
typedef const Params __attribute__((address_space(4)))* PK;
#define PK_FRESH(p) asm volatile("" : "+s"(p))

#define XB_TMO      128
#define XB_XCNT(j)  (256  + 64 * (j))
#define XB_XSUB(j)  (1280 + 64 * (j))
#define XB_XGEN(j)  (2304 + 64 * (j))
#define XB_TOP      3328
#define XB_TOPGEN   3392
#define XCD_BAR_WORDS 3456
#define XB_SPIN_CAP (1u << 20)

__device__ __forceinline__ unsigned xb_ld(unsigned* p)              { return __hip_atomic_load(p, __ATOMIC_RELAXED, __HIP_MEMORY_SCOPE_AGENT); }
__device__ __forceinline__ unsigned xb_add(unsigned* p, unsigned v) { return __hip_atomic_fetch_add(p, v, __ATOMIC_RELAXED, __HIP_MEMORY_SCOPE_AGENT); }
__device__ __forceinline__ unsigned xb_xcc_id() { return (unsigned)__builtin_amdgcn_s_getreg((3 << 11) | 20) & 0xFu; }
#define XB_SPIN(cond, bar) do { unsigned _sp = 0; while (cond) { __builtin_amdgcn_s_sleep(1); \
    if ((++_sp & 255u) == 0u) { if (xb_ld(&(bar)[XB_TMO])) break; if (_sp > XB_SPIN_CAP) { atomicAdd(&(bar)[XB_TMO], 1u); break; } } } } while (0)

struct XcdBarrier { unsigned* bar; unsigned x; volatile LAS unsigned* st; int wv; };

__device__ __forceinline__ XcdBarrier xcd_barrier_post(unsigned* bar, volatile LAS unsigned* st, int wv) {
    XcdBarrier b; b.bar = bar; b.x = xb_xcc_id(); b.st = st; b.wv = wv;
    if (wv == 0 && lane_id() == 0) (void)xb_add(&bar[XB_XCNT(b.x)], 1u);
    return b;
}
__device__ __forceinline__ void xcd_barrier_complete(unsigned* bar, unsigned x, unsigned& nloc, unsigned& nx) {
    const unsigned G = gridDim.x * gridDim.y * gridDim.z;
    unsigned sum, cnt, mine, sp = 0u;
    for (;;) {
        sum = 0u; cnt = 0u; mine = 0u;
#pragma unroll
        for (unsigned j = 0; j < 16; ++j) { const unsigned c = xb_ld(&bar[XB_XCNT(j)]); sum += c; cnt += (c > 0u) ? 1u : 0u; mine = (j == x) ? c : mine; }
        if (sum == G) break;
        __builtin_amdgcn_s_sleep(1);
        if ((++sp & 255u) == 0u) { if (xb_ld(&bar[XB_TMO])) break; if (sp > XB_SPIN_CAP) { atomicAdd(&bar[XB_TMO], 1u); break; } }
    }
    nloc = mine > 0u ? mine : 1u; nx = cnt > 0u ? cnt : 1u;
}
__device__ __forceinline__ void xcd_barrier(const XcdBarrier& b) {
    asm volatile("s_waitcnt vmcnt(0)" ::: "memory");
    __syncthreads();
    if (b.wv == 0 && lane_id() == 0) {
        unsigned* bar = b.bar;
        __builtin_amdgcn_s_waitcnt(0);
        unsigned nloc = b.st[0], nx = b.st[1];
        if (nloc == 0u) { xcd_barrier_complete(bar, b.x, nloc, nx); b.st[0] = nloc; b.st[1] = nx; }
        const unsigned old = xb_add(&bar[XB_XSUB(b.x)], 1u);
        const unsigned gen = old / nloc;
        if (old + 1u == (gen + 1u) * nloc) {
            __builtin_amdgcn_fence(__ATOMIC_RELEASE, "agent");
            asm volatile("s_waitcnt vmcnt(0)" ::: "memory");
            const unsigned og = xb_add(&bar[XB_TOP], 1u);
            const unsigned tg = og / nx;
            if (og + 1u == (tg + 1u) * nx) xb_add(&bar[XB_TOPGEN], 1u);
            else XB_SPIN(xb_ld(&bar[XB_TOPGEN]) == tg, bar);
            __builtin_amdgcn_fence(__ATOMIC_ACQUIRE, "agent");
            xb_add(&bar[XB_XGEN(b.x)], 1u);
            asm volatile("s_waitcnt vmcnt(0)" ::: "memory");
        } else {
            XB_SPIN(xb_ld(&bar[XB_XGEN(b.x)]) == gen, bar);
            __builtin_amdgcn_fence(__ATOMIC_ACQUIRE, "agent");
            asm volatile("s_waitcnt vmcnt(0)" ::: "memory");
        }
    }
    __syncthreads();
}

namespace pg8 {
#define PG8_LAS __attribute__((address_space(3)))
constexpr int BM = 256, BK = 64, HALF = 128, HTB = HALF * BK * 2, STAGE_BYTES = 8 * HTB, NXCD = 8, WGM = 8;
__host__ __device__ __forceinline__ int lds_byte(int r, int c) { const int st = (r >> 4) * 2 + (c >> 5), rr = r & 15, cc = c & 31, ob = rr * 64 + cc * 2; return st * 1024 + (ob ^ (((ob >> 9) & 1) << 5)); }
__host__ __device__ __forceinline__ void stage_rc(int b, int& R, int& C) { const int st = b / 1024, sb = b % 1024, swz = sb ^ (((sb >> 9) & 1) << 5); R = (st >> 1) * 16 + swz / 64; C = (st & 1) * 32 + (swz % 64) / 2; }
__host__ __device__ __forceinline__ int perm32(int rho) { const int n = rho >> 4, i = rho & 15; return 8 * (i >> 2) + 4 * n + (i & 3); }
struct Unit { int pm, pn; };
struct Gemm { const bf16_t* A; const bf16_t* Bt; int M, N, K; int ld; int ksplit; };
struct StaticOrder {
    int nM, nN, nwg, G, c;
    __host__ __device__ void init(int M, int N, int G_, int c_) { nM = M / BM; nN = N / BM; nwg = nM * nN; G = G_; c = c_; }
    __host__ __device__ bool next(int i, Unit& u) const {
        const long L = (long)i * G + c; if (L >= nwg) return false;
        int wgid = (int)L; { const int q = nwg / NXCD, r = nwg % NXCD, xcd = wgid % NXCD, off = wgid / NXCD; wgid = (xcd < r ? xcd * (q + 1) : r * (q + 1) + (xcd - r) * q) + off; }
        const int nig = WGM * nN, gid = wgid / nig, fm = gid * WGM, gsz = (nM - fm) < WGM ? (nM - fm) : WGM;
        u.pm = fm + ((wgid % nig) % gsz); u.pn = (wgid % nig) / gsz; return true;
    }
    __device__ __forceinline__ void a_ready(const Unit&) const {}
    __device__ __forceinline__ void done(const Unit&) const {}
};

struct EpiMk {
    static constexpr bool PERM = true, AFTER_DRAIN = false;
    int mode; bf16_t* O; int ldc; const float* xin; const bf16_t* xinb; bf16_t* xout; const float* gate; float gmul;
    bf16_t* O2; int nrope; const float* cosT; const float* sinT;
    float* xoutf;
    __device__ __forceinline__ void operator()(const f32x4 (&acc)[2][2][4][2], const Unit& u, int wr, int wc, int fr, int fq) const {
        const int row0 = u.pm * BM + wr * 64 + fr, col0 = u.pn * BM + wc * 32 + 8 * fq;
        if (mode == 0) {
#pragma unroll
            for (int ai = 0; ai < 2; ++ai)
#pragma unroll
                for (int m = 0; m < 4; ++m) { bf16_t* rowp = O + (size_t)(row0 + ai * HALF + m * 16) * ldc + col0;
#pragma unroll
                    for (int bj = 0; bj < 2; ++bj) { const f32x4 v0 = acc[ai][bj][m][0], v1 = acc[ai][bj][m][1];
                        u32x4 w; w.x = cvt_pk_bf16(v0[0], v0[1]); w.y = cvt_pk_bf16(v0[2], v0[3]); w.z = cvt_pk_bf16(v1[0], v1[1]); w.w = cvt_pk_bf16(v1[2], v1[3]);
                        *(u32x4*)(rowp + bj * HALF) = w; } }
        } else if (mode == 3) {
            if (wc == 0) {
#pragma unroll
                for (int ai = 0; ai < 2; ++ai)
#pragma unroll
                    for (int m = 0; m < 4; ++m) { const int row = row0 + ai * HALF + m * 16; float* dp = xoutf + ((size_t)u.pn * T + row) * 32 + 8 * fq;
                        *(f32x4*)dp = acc[ai][0][m][0]; *(f32x4*)(dp + 4) = acc[ai][0][m][1]; }
            }
        } else if (mode == 2) {
#pragma unroll
            for (int ai = 0; ai < 2; ++ai)
#pragma unroll
                for (int m = 0; m < 4; ++m) { const int row = row0 + ai * HALF + m * 16, bb = row >> 13, ss = row & 8191;
#pragma unroll
                    for (int bj = 0; bj < 2; ++bj) { const int col = col0 + bj * HALF; const f32x4 v0 = acc[ai][bj][m][0], v1 = acc[ai][bj][m][1];
                        if (col < nrope) { const int hc = col >> 7, j0 = ((col & 127) >> 3) * 4;
                            const f32x4 cs = *(const f32x4*)(cosT + (size_t)row * 64 + j0), sn = *(const f32x4*)(sinT + (size_t)row * 64 + j0);
                            bf16_t* dp = O + ((size_t)(bb * 16 + hc) * SEQ + ss) * 128 + j0;
                            u32x2 w1, w2; w1.x = cvt_pk_bf16(v0[0] * cs[0] - v1[0] * sn[0], v0[1] * cs[1] - v1[1] * sn[1]); w1.y = cvt_pk_bf16(v0[2] * cs[2] - v1[2] * sn[2], v0[3] * cs[3] - v1[3] * sn[3]);
                            w2.x = cvt_pk_bf16(v1[0] * cs[0] + v0[0] * sn[0], v1[1] * cs[1] + v0[1] * sn[1]); w2.y = cvt_pk_bf16(v1[2] * cs[2] + v0[2] * sn[2], v1[3] * cs[3] + v0[3] * sn[3]);
                            *(u32x2*)dp = w1; *(u32x2*)(dp + 64) = w2;
                        } else { const int cv = col - nrope, hc = cv >> 7;
                            u32x4 w; w.x = cvt_pk_bf16(v0[0], v0[1]); w.y = cvt_pk_bf16(v0[2], v0[3]); w.z = cvt_pk_bf16(v1[0], v1[1]); w.w = cvt_pk_bf16(v1[2], v1[3]);
                            *(u32x4*)(O2 + ((size_t)(bb * 16 + hc) * SEQ + ss) * 128 + (cv & 127)) = w; } } }
        } else {
#pragma unroll
            for (int ai = 0; ai < 2; ++ai)
#pragma unroll
                for (int m = 0; m < 4; ++m) { const int row = row0 + ai * HALF + m * 16; const float* gp = gate + (size_t)(row >> 13) * MODC + col0;
                    bf16_t* xo = xout + (size_t)row * D + col0;
#pragma unroll
                    for (int bj = 0; bj < 2; ++bj) {
                        const f32x4 g0 = *(const f32x4*)(gp + bj * HALF), g1 = *(const f32x4*)(gp + bj * HALF + 4);
                        f32x4 x0, x1;
                        if (xin) { x0 = *(const f32x4*)(xin + (size_t)row * D + col0 + bj * HALF); x1 = *(const f32x4*)(xin + (size_t)row * D + col0 + bj * HALF + 4); }
                        else { const u32x4 xb = *(const u32x4*)(xinb + (size_t)row * D + col0 + bj * HALF);
                            x0 = (f32x4){bflo(xb.x), bfhi(xb.x), bflo(xb.y), bfhi(xb.y)}; x1 = (f32x4){bflo(xb.z), bfhi(xb.z), bflo(xb.w), bfhi(xb.w)}; }
                        const f32x4 y0 = x0 + gmul * g0 * acc[ai][bj][m][0], y1 = x1 + gmul * g1 * acc[ai][bj][m][1];
                        u32x4 w; w.x = cvt_pk_bf16(y0[0], y0[1]); w.y = cvt_pk_bf16(y0[2], y0[3]); w.z = cvt_pk_bf16(y1[0], y1[1]); w.w = cvt_pk_bf16(y1[2], y1[3]);
                        *(u32x4*)(xo + bj * HALF) = w; } }
        }
    }
};

template <class Epi, class Sched>
__device__ __forceinline__ void gemm_phase(PG8_LAS unsigned char* lds, const Gemm g, const Sched& S, const Epi& E, const int wv) {
    const int tid = ltid(wv), wid = __builtin_amdgcn_readfirstlane(tid >> 6), lane = tid & 63, wr = wid >> 2, wc = wid & 3, fr = lane & 15, fq = lane >> 4;
    const int K = g.K, nt = K / BK, ld = g.ld;
    unsigned voffA[2], voffB[2];
#pragma unroll
    for (int i = 0; i < 2; ++i) { int R, C; stage_rc(tid * 16 + i * 8192, R, C); const int Rb = Epi::PERM ? ((R & ~31) + perm32(R & 31)) : R;
        voffA[i] = (unsigned)(R * ld + C) * 2u; voffB[i] = (unsigned)(Rb * ld + C) * 2u; }
    const size_t kstep = (size_t)(BK * 2);
    const size_t hstep = (size_t)HALF * ld * 2;
    const size_t tstep = 2 * hstep;
    const unsigned ldsw = (unsigned)wid * 1024u;
    const int aoff = lds_byte(wr * 64 + fr, fq * 8), boff = lds_byte(wc * 32 + fr, fq * 8);
#define PG8_SA(b, h) (((b) * 2 + (h)) * HTB)
#define PG8_SB(b, h) ((4 + (b) * 2 + (h)) * HTB)
#define PG8_STAGE(bufoff, gbase, voff) do { _Pragma("unroll") for (int _i = 0; _i < 2; ++_i) \
        __builtin_amdgcn_global_load_lds((const unsigned*)((const char*)(gbase) + (voff)[_i]), (PG8_LAS unsigned*)(lds + (bufoff) + ldsw + _i * 8192), 16, 0, 0); } while (0)
#define PG8_LDA(dst, b, h) do { _Pragma("unroll") for (int m = 0; m < 4; ++m) _Pragma("unroll") for (int k = 0; k < 2; ++k) dst[m][k] = *(const PG8_LAS bf16x8*)(lds + PG8_SA(b, h) + aoff + m * 2048 + k * 1024); } while (0)
#define PG8_LDB(dst, b, h) do { _Pragma("unroll") for (int n = 0; n < 2; ++n) _Pragma("unroll") for (int k = 0; k < 2; ++k) dst[n][k] = *(const PG8_LAS bf16x8*)(lds + PG8_SB(b, h) + boff + n * 2048 + k * 1024); } while (0)
#define PG8_MMA(ai, bj, At, Bt) do { __builtin_amdgcn_s_setprio(1); _Pragma("unroll") for (int m = 0; m < 4; ++m) _Pragma("unroll") for (int n = 0; n < 2; ++n) _Pragma("unroll") for (int k = 0; k < 2; ++k) \
        acc[ai][bj][m][n] = __builtin_amdgcn_mfma_f32_16x16x32_bf16(Bt[n][k], At[m][k], acc[ai][bj][m][n], 0, 0, 0); __builtin_amdgcn_s_setprio(0); } while (0)
#define PG8_WAIT_V(n) asm volatile("s_waitcnt vmcnt(" #n ")" ::: "memory")
#define PG8_WAIT_L(n) asm volatile("s_waitcnt lgkmcnt(" #n ")" ::: "memory")
#define PG8_BAR __builtin_amdgcn_s_barrier()
#define PG8_SCHED __builtin_amdgcn_sched_barrier(0)
    Unit cur, nxt; int ui = 0;
    if (!S.next(0, cur)) return;
    f32x4 acc[2][2][4][2];
#pragma unroll
    for (int a = 0; a < 2; ++a)
#pragma unroll
        for (int b = 0; b < 2; ++b)
#pragma unroll
            for (int m = 0; m < 4; ++m)
#pragma unroll
                for (int n = 0; n < 2; ++n) acc[a][b][m][n] = (f32x4){0.f, 0.f, 0.f, 0.f};
    bf16x8 At[4][2], B0[2][2], B1[2][2];
    const size_t bstep = g.ksplit ? (size_t)K * 2 : tstep, astep = g.ksplit ? (size_t)K * 2 : 0;
    const char* cA = (const char*)g.A + (size_t)cur.pm * tstep + (size_t)cur.pn * astep; const char* cB = (const char*)g.Bt + (size_t)cur.pn * bstep;
    S.a_ready(cur);
    PG8_STAGE(PG8_SB(0, 0), cB, voffB); PG8_STAGE(PG8_SA(0, 0), cA, voffA); PG8_STAGE(PG8_SB(0, 1), cB + hstep, voffB); PG8_STAGE(PG8_SA(0, 1), cA + hstep, voffA);
    if (wr == 1) PG8_BAR;
    PG8_WAIT_V(4); PG8_BAR;
    PG8_STAGE(PG8_SB(1, 0), cB + kstep, voffB); PG8_STAGE(PG8_SA(1, 0), cA + kstep, voffA); PG8_STAGE(PG8_SB(1, 1), cB + hstep + kstep, voffB);
    PG8_WAIT_V(6); PG8_BAR;
    for (;;) {
        const bool has_next = S.next(ui + 1, nxt);
        const char* nA = has_next ? (const char*)g.A + (size_t)nxt.pm * tstep + (size_t)nxt.pn * astep : cA; const char* nB = has_next ? (const char*)g.Bt + (size_t)nxt.pn * bstep : cB;
        for (int t = 0; t < nt; t += 2) {
            const bool last = (t == nt - 2);
            const char* a1 = cA + (size_t)(t + 1) * kstep;
            const char* a2 = last ? nA : cA + (size_t)(t + 2) * kstep; const char* b2 = last ? nB : cB + (size_t)(t + 2) * kstep;
            const char* a3 = a2 + kstep; const char* b3 = b2 + kstep;
            if (last && has_next) S.a_ready(nxt);
            PG8_LDB(B0, 0, 0); PG8_SCHED; PG8_LDA(At, 0, 0); PG8_STAGE(PG8_SA(1, 1), a1 + hstep, voffA);
            PG8_WAIT_L(8); PG8_BAR; PG8_WAIT_L(0); PG8_MMA(0, 0, At, B0); PG8_BAR; PG8_SCHED;
            PG8_LDB(B1, 0, 1); PG8_STAGE(PG8_SB(0, 0), b2, voffB);
            PG8_BAR; PG8_WAIT_L(0); PG8_MMA(0, 1, At, B1); PG8_BAR;
            PG8_LDA(At, 0, 1); PG8_STAGE(PG8_SA(0, 0), a2, voffA);
            PG8_BAR; PG8_WAIT_L(0); PG8_MMA(1, 0, At, B0); PG8_BAR; PG8_SCHED;
            PG8_STAGE(PG8_SB(0, 1), b2 + hstep, voffB);
            PG8_WAIT_V(6); PG8_BAR; PG8_MMA(1, 1, At, B1); PG8_BAR;
            PG8_LDB(B0, 1, 0); PG8_SCHED; PG8_LDA(At, 1, 0); PG8_STAGE(PG8_SA(0, 1), a2 + hstep, voffA);
            PG8_WAIT_L(8); PG8_BAR; PG8_WAIT_L(0); PG8_MMA(0, 0, At, B0); PG8_BAR; PG8_SCHED;
            PG8_LDB(B1, 1, 1); PG8_STAGE(PG8_SB(1, 0), b3, voffB);
            PG8_BAR; PG8_WAIT_L(0); PG8_MMA(0, 1, At, B1); PG8_BAR;
            PG8_LDA(At, 1, 1); PG8_STAGE(PG8_SA(1, 0), a3, voffA);
            PG8_BAR; PG8_WAIT_L(0); PG8_MMA(1, 0, At, B0); PG8_BAR; PG8_SCHED;
            PG8_STAGE(PG8_SB(1, 1), b3 + hstep, voffB);
            PG8_WAIT_V(6); PG8_BAR; PG8_MMA(1, 1, At, B1); PG8_BAR;
        }
        E(acc, cur, wr, wc, fr, fq); S.done(cur);
        if (!has_next) break;
#pragma unroll
        for (int a = 0; a < 2; ++a)
#pragma unroll
            for (int b = 0; b < 2; ++b)
#pragma unroll
                for (int m = 0; m < 4; ++m)
#pragma unroll
                    for (int n = 0; n < 2; ++n) acc[a][b][m][n] = (f32x4){0.f, 0.f, 0.f, 0.f};
        cur = nxt; cA = nA; cB = nB; ++ui;
    }
    PG8_WAIT_V(0);
    if (wr == 0) PG8_BAR;
    PG8_BAR;
#undef PG8_SA
#undef PG8_SB
#undef PG8_STAGE
#undef PG8_LDA
#undef PG8_LDB
#undef PG8_MMA
#undef PG8_WAIT_V
#undef PG8_WAIT_L
#undef PG8_BAR
#undef PG8_SCHED
}
}

namespace att {
constexpr int D = 128;
constexpr float THR = 8.f;
constexpr bool WSKIP = false;
constexpr float SCALE = 0.08838834764831845f;
constexpr int NW = 8, QBLK = 32, KVBLK = 64, QB = NW * QBLK;
constexpr int SHM_V = KVBLK * D * 2, SHM_K = KVBLK * D * 2;
constexpr int LDS_BYTES = 2 * SHM_V + 2 * SHM_K + NW * 64 * 4;
using bf16 = __hip_bfloat16;
template <class A, class Bt> struct same_t { static constexpr bool v = false; };
template <class A> struct same_t<A, A> { static constexpr bool v = true; };
#define KSWZ(row, colB) ((row) * 256 + ((colB) ^ (((row) & 7) << 4)))
#define SBAR() __builtin_amdgcn_sched_barrier(0)
__device__ __forceinline__ int v_st(int k, int c) { const int kk = (k & ~0xC) | ((k & 4) << 1) | ((k & 8) >> 1); return ((kk >> 3) * 4 + (c >> 5)) * 512 + ((kk & 7) * 32 + (c & 31)) * 2; }
__device__ __forceinline__ int v_rd_base(int lane) { return ((lane & 3) << 3) | (((lane >> 2) & 3) << 6) | (((lane >> 4) & 1) << 5) | (((lane >> 5) & 1) << 8); }
constexpr int v_rd_off(int d0, int ks, int half) { return d0 * 512 + ks * 4096 + half * 2048; }
__device__ __forceinline__ int crow(int r, int hi) { return (r & 3) + 8 * (r >> 2) + 4 * hi; }
__device__ __forceinline__ unsigned cvtpk(float lo, float hi) {
    unsigned r; asm volatile("v_cvt_pk_bf16_f32 %0, %1, %2" : "=v"(r) : "v"(lo), "v"(hi)); return r;
}
__device__ __forceinline__ bf16x8 pack8(f32x4 a, f32x4 b) {
    u32x4 w = {cvtpk(a[0], a[1]), cvtpk(a[2], a[3]), cvtpk(b[0], b[1]), cvtpk(b[2], b[3])};
    return *reinterpret_cast<bf16x8*>(&w);
}
template <class T> __device__ __forceinline__ bf16x8 load8(const T* p) {
    if constexpr (same_t<T, float>::v) { return pack8(*(const f32x4*)p, *(const f32x4*)(p + 4)); }
    else { return *reinterpret_cast<const bf16x8*>(p); }
}
__device__ __forceinline__ void mask_tile(f32x16& p0, f32x16& p1, int dq, unsigned W) {
    const float NEG = -__builtin_inff();
#pragma unroll
    for (int r = 0; r < 16; ++r) {
        const int c = (r & 3) + 8 * (r >> 2);
        if ((unsigned)(dq - c) >= W) p0[r] = NEG;
        if ((unsigned)(dq - c - 32) >= W) p1[r] = NEG;
    }
}
__device__ __forceinline__ void partialSM(f32x16& p0, f32x16& p1, float& m_reg, float& mn, float& alpha) {
    float pmax = p0[0]; for (int r = 1; r < 16; ++r) pmax = fmaxf(pmax, p0[r]); for (int r = 0; r < 16; ++r) pmax = fmaxf(pmax, p1[r]);
    { auto rr = __builtin_amdgcn_permlane32_swap(__float_as_uint(pmax), __float_as_uint(pmax), false, false);
      pmax = fmaxf(__uint_as_float(rr[0]), __uint_as_float(rr[1])); }
    constexpr float C2 = 1.4426950408889634f * SCALE;
    if (__builtin_expect(__all((pmax - m_reg) * SCALE <= THR), 1)) { mn = m_reg; alpha = 1.f; }
    else { mn = fmaxf(m_reg, pmax); alpha = __builtin_amdgcn_exp2f((m_reg - mn) * C2); m_reg = mn; }
    const float mnL = -mn * C2;
    for (int r = 0; r < 16; ++r) p0[r] = fmaf(p0[r], C2, mnL); for (int r = 0; r < 16; ++r) p1[r] = fmaf(p1[r], C2, mnL);
    for (int r = 0; r < 16; ++r) p0[r] = __builtin_amdgcn_exp2f(p0[r]);
}
__device__ __forceinline__ void finishSM(f32x16& p0, f32x16& p1, float alpha, float& l_reg, bf16x8& pa0, bf16x8& pa1, bf16x8& pa2, bf16x8& pa3) {
    for (int r = 0; r < 16; ++r) p1[r] = __builtin_amdgcn_exp2f(p1[r]);
    float ps = 0; for (int r = 0; r < 16; ++r) ps += p0[r]; for (int r = 0; r < 16; ++r) ps += p1[r];
    { auto rr = __builtin_amdgcn_permlane32_swap(__float_as_uint(ps), __float_as_uint(ps), false, false);
      ps = __uint_as_float(rr[0]) + __uint_as_float(rr[1]); }
    l_reg = l_reg * alpha + ps;
#define PK4(P, B_, OUT) do { unsigned a0 = cvtpk(P[B_+0], P[B_+1]), a1 = cvtpk(P[B_+2], P[B_+3]);                          \
        unsigned b0 = cvtpk(P[B_+4], P[B_+5]), b1 = cvtpk(P[B_+6], P[B_+7]);                                             \
        auto r0 = __builtin_amdgcn_permlane32_swap(a0, b0, false, false); auto r1 = __builtin_amdgcn_permlane32_swap(a1, b1, false, false); \
        u32x4 w = {r0[0], r1[0], r0[1], r1[1]}; OUT = *reinterpret_cast<bf16x8*>(&w); } while (0)
    PK4(p0, 0, pa0); PK4(p0, 8, pa1); PK4(p1, 0, pa2); PK4(p1, 8, pa3);
#undef PK4
}
template <int KB, bool SK>
__device__ __forceinline__ void qkt(f32x16& p0, f32x16& p1, const char* K_lds, int r32, int hi, const bf16x8* qr, bool act) {
    if (SK && !act) { const float NEG = -__builtin_inff();
#pragma unroll
        for (int r = 0; r < 16; ++r) { p0[r] = NEG; p1[r] = NEG; } return; }
    p0 = f32x16{}; p1 = f32x16{};
    const char* kb[4];
#pragma unroll
    for (int dd = 0; dd < 4; ++dd) kb[dd] = K_lds + KB * SHM_K + KSWZ(r32, (dd * 16 + hi * 8) * 2);
#pragma unroll
    for (int d0 = 0; d0 < 8; ++d0) { const char* a = kb[d0 & 3] + (d0 >> 2) * 128;
        bf16x8 b0 = *reinterpret_cast<const bf16x8*>(a);
        bf16x8 b1 = *reinterpret_cast<const bf16x8*>(a + 32 * 256);
        p0 = __builtin_amdgcn_mfma_f32_32x32x16_bf16(b0, qr[d0], p0, 0, 0, 0);
        p1 = __builtin_amdgcn_mfma_f32_32x32x16_bf16(b1, qr[d0], p1, 0, 0, 0); }
}
template <int VB, bool SK>
__device__ __forceinline__ void pv_tile(f32x16* o, int vb0, bf16x8 pa0, bf16x8 pa1, bf16x8 pa2, bf16x8 pa3, bool act) {
    if (SK && !act) return;
#define TRRD(dst, off) asm volatile("ds_read_b64_tr_b16 %0, %1 offset:%2" : "=&v"(dst) : "v"(vb0), "i"(off) : "memory")
#define PV_D0(d0) do { s16x4 l0, l1, l2, l3, h0, h1, h2, h3; constexpr int b_ = VB * SHM_V + v_rd_off(d0, 0, 0);     \
        TRRD(l0, b_); TRRD(h0, b_ + 2048); TRRD(l1, b_ + 4096); TRRD(h1, b_ + 6144); TRRD(l2, b_ + 8192); TRRD(h2, b_ + 10240); TRRD(l3, b_ + 12288); TRRD(h3, b_ + 14336); \
        asm volatile("s_waitcnt lgkmcnt(0)" ::: "memory"); SBAR();                 \
        o[d0] = __builtin_amdgcn_mfma_f32_32x32x16_bf16(pa0, (bf16x8){l0[0], l0[1], l0[2], l0[3], h0[0], h0[1], h0[2], h0[3]}, o[d0], 0, 0, 0);   \
        o[d0] = __builtin_amdgcn_mfma_f32_32x32x16_bf16(pa1, (bf16x8){l1[0], l1[1], l1[2], l1[3], h1[0], h1[1], h1[2], h1[3]}, o[d0], 0, 0, 0);   \
        o[d0] = __builtin_amdgcn_mfma_f32_32x32x16_bf16(pa2, (bf16x8){l2[0], l2[1], l2[2], l2[3], h2[0], h2[1], h2[2], h2[3]}, o[d0], 0, 0, 0);   \
        o[d0] = __builtin_amdgcn_mfma_f32_32x32x16_bf16(pa3, (bf16x8){l3[0], l3[1], l3[2], l3[3], h3[0], h3[1], h3[2], h3[3]}, o[d0], 0, 0, 0); } while (0)
    PV_D0(0); PV_D0(1); PV_D0(2); PV_D0(3);
#undef PV_D0
#undef TRRD
}

template <class TIn, class TOut> struct BlockRef { const TIn* Q; const TIn* K; const TIn* V; TOut* O; int P0; };
template <class TIn> struct Seam {
    bf16x8 qr[8];
    bf16x8 st_v0, st_v1, st_k0, st_k1; f32x4 sf0, sf1, sf2, sf3;
    f32x4 tq[16];
};
__device__ __forceinline__ int swa_jlo(int P0, int W) { const int lowk = P0 - W + 1; return lowk > 0 ? lowk / KVBLK : 0; }
#define ROW(p, k0, rr) ((p) + (size_t)((k0) + (rr)) * D + sc)
#define VMW() asm volatile("s_waitcnt vmcnt(0)" ::: "memory")
#define VMWN(n) asm volatile("s_waitcnt vmcnt(%0)" :: "i"(n) : "memory")
#define SLOAD_H(Kp, Vp, k0) do { S.st_v0 = load8<TIn>(ROW(Vp, k0, sr)); S.st_v1 = load8<TIn>(ROW(Vp, k0, 32 + sr));              \
                         S.st_k0 = load8<TIn>(ROW(Kp, k0, sr)); S.st_k1 = load8<TIn>(ROW(Kp, k0, 32 + sr)); } while (0)
#define SWRITE_HK(bf) do { *(bf16x8*)(K_lds + (bf) * SHM_K + kws) = S.st_k0; *(bf16x8*)(K_lds + (bf) * SHM_K + kws + 32 * 256) = S.st_k1; } while (0)
#define SWRITE_HV(bf) do { *(bf16x8*)(V_lds + (bf) * SHM_V + vst0) = S.st_v0; *(bf16x8*)(V_lds + (bf) * SHM_V + vst1) = S.st_v1; } while (0)
#define SWRITE_H(bf) do { SWRITE_HV(bf); SWRITE_HK(bf); } while (0)
#define SLOAD_F(p, k0) do { S.sf0 = *(const f32x4*)ROW(p, k0, sr); S.sf1 = *(const f32x4*)(ROW(p, k0, sr) + 4);                \
                            S.sf2 = *(const f32x4*)ROW(p, k0, 32 + sr); S.sf3 = *(const f32x4*)(ROW(p, k0, 32 + sr) + 4); } while (0)
#define SWRITE_KF(bf) do { *(bf16x8*)(K_lds + (bf) * SHM_K + kws) = pack8(S.sf0, S.sf1); *(bf16x8*)(K_lds + (bf) * SHM_K + kws + 32 * 256) = pack8(S.sf2, S.sf3); } while (0)
#define SWRITE_VF(bf) do { *(bf16x8*)(V_lds + (bf) * SHM_V + vst0) = pack8(S.sf0, S.sf1); *(bf16x8*)(V_lds + (bf) * SHM_V + vst1) = pack8(S.sf2, S.sf3); } while (0)
template <class TIn, class TOut>
__device__ __forceinline__ void causal_swa_prime(const BlockRef<TIn, TOut>& cur, int W, char* lds, Seam<TIn>& S, const int wv) {
    constexpr bool F32 = same_t<TIn, float>::v;
    const int tid = ltid(wv), wid = __builtin_amdgcn_readfirstlane(tid >> 6), lane = tid & 63, r32 = lane & 31, hi = lane >> 5;
    const int sr = tid >> 4, sc = (tid & 15) * 8, kws = KSWZ(sr, sc * 2); char* K_lds = lds + 2 * SHM_V;
    const int kb0 = swa_jlo(cur.P0, W) * KVBLK;
    for (int d0 = 0; d0 < 8; ++d0) S.qr[d0] = load8<TIn>(cur.Q + (size_t)(wid * QBLK + r32) * D + d0 * 16 + hi * 8);
    if constexpr (F32) { SLOAD_F((const float*)cur.K, kb0); VMW(); SWRITE_KF(0); SBAR(); SLOAD_F((const float*)cur.V, kb0); }
    else { SLOAD_H(cur.K, cur.V, kb0); VMW(); SWRITE_HK(0); }
    __syncthreads();
}
template <class TIn, class TOut>
__device__ __forceinline__ void causal_swa_block(const BlockRef<TIn, TOut>& cur, const BlockRef<TIn, TOut>& nxt, int skv, int W, char* lds, Seam<TIn>& S, const int wv) {
    constexpr bool F32 = same_t<TIn, float>::v;
    const int tid = ltid(wv), wid = __builtin_amdgcn_readfirstlane(tid >> 6), lane = tid & 63, r32 = lane & 31, hi = lane >> 5;
    const int j_lo = swa_jlo(cur.P0, W);
    int j_hi = (cur.P0 + QB - 1) / KVBLK + 1; if (j_hi > skv / KVBLK) j_hi = skv / KVBLK;
    const int NT = j_hi - j_lo;
    const int kbn = swa_jlo(nxt.P0, W) * KVBLK;
    const int qlo = cur.P0 + wid * QBLK, qm = qlo + r32 - 4 * hi;
    char* V_lds = lds; char* K_lds = lds + 2 * SHM_V;
    float* ws = (float*)(lds + 2 * SHM_V + 2 * SHM_K) + wid * 64; float* li_l = ws, * al_l = ws + 32;
    float m_reg = -1e30f, l_reg = 0; f32x16 o[4] = {};
    const int sr = tid >> 4, sc = (tid & 15) * 8, vst0 = v_st(sr, sc), vst1 = v_st(32 + sr, sc), kws = KSWZ(sr, sc * 2);
    const int vb0 = (int)(uintptr_t)V_lds + v_rd_base(lane);
    const TIn* Kh = cur.K; const TIn* Vh = cur.V;
#define RESC(a) do { if (__any((a) < 1.f)) { if (hi == 0) al_l[r32] = (a); asm volatile("s_waitcnt lgkmcnt(0)" ::: "memory");              \
                     for (int d_ = 0; d_ < 4; ++d_) for (int r = 0; r < 16; ++r) o[d_][r] *= al_l[crow(r, hi)]; } } while (0)
#define KBASE(t) ((j_lo + (t)) * KVBLK)
#define ACT(t) (KBASE(t) <= qlo + QBLK - 1 && KBASE(t) + KVBLK - 1 >= qlo - W + 1)
#define MASKT(P0_, P1_, t) do { const int kb_ = KBASE(t); if ((!SK || ACT(t)) && (kb_ + KVBLK - 1 > qlo || kb_ <= qlo + QBLK - 1 - W)) mask_tile(P0_, P1_, qm - kb_, (unsigned)W); } while (0)
    constexpr int NQL = F32 ? 16 : 8;
    constexpr bool SK = WSKIP && !F32;
#define SEAM_K0() do { VMWN(NQL); if constexpr (F32) { SWRITE_KF(0); SBAR(); SLOAD_F((const float*)nxt.V, kbn); } else { SWRITE_HK(0); } SBAR(); } while (0)
    f32x16 pA0, pA1, pB0, pB1; float mnA, mnB, alA, alB; bf16x8 pa0, pa1, pa2, pa3;
    if constexpr (F32) { VMW(); SWRITE_VF(0); SBAR(); } else { SWRITE_HV(0); SBAR(); }
    if (NT > 1) { if constexpr (F32) SLOAD_F((const float*)Kh, KBASE(1)); else SLOAD_H(Kh, Vh, KBASE(1)); }
    SBAR(); qkt<0, SK>(pA0, pA1, K_lds, r32, hi, S.qr, ACT(0));
    if constexpr (F32) { if (NT > 1) { VMW(); SWRITE_KF(1); SBAR(); SLOAD_F((const float*)Vh, KBASE(1)); } }
    MASKT(pA0, pA1, 0); partialSM(pA0, pA1, m_reg, mnA, alA);
    if (NT > 1) { VMW(); if constexpr (F32) { SWRITE_VF(1); SBAR(); if (NT > 2) SLOAD_F((const float*)Kh, KBASE(2)); } else SWRITE_H(1); }
    __syncthreads();
#define HALF_STEP(PX0, PX1, mnX, alX, PY0, PY1, alY, t, KB, VB, SB) do {                                                      \
        SBAR(); qkt<KB, SK>(PX0, PX1, K_lds, r32, hi, S.qr, ACT(t));                                             \
        finishSM(PY0, PY1, alY, l_reg, pa0, pa1, pa2, pa3); SBAR();                                                           \
        if ((t) + 1 < NT) { if constexpr (F32) { VMW(); SWRITE_KF(SB); SBAR(); SLOAD_F((const float*)Vh, KBASE((t) + 1)); }  \
                            else { SLOAD_H(Kh, Vh, KBASE((t) + 1)); } SBAR(); }                                               \
        pv_tile<VB, SK>(o, vb0, pa0, pa1, pa2, pa3, ACT((t) - 1)); MASKT(PX0, PX1, (t)); partialSM(PX0, PX1, m_reg, mnX, alX);                                        \
        __syncthreads();                                                                                                      \
        if ((t) + 1 < NT) { VMW(); if constexpr (F32) { SWRITE_VF(SB); SBAR(); if ((t) + 2 < NT) SLOAD_F((const float*)Kh, KBASE((t) + 2)); } \
                            else { SWRITE_H(SB); } }                                                                          \
        RESC(alX); __syncthreads(); } while (0)
    for (int t = 1; t + 1 < NT; t += 2) {
        HALF_STEP(pB0, pB1, mnB, alB, pA0, pA1, alA, t, 1, 0, 0);
        HALF_STEP(pA0, pA1, mnA, alA, pB0, pB1, alB, t + 1, 0, 1, 1);
    }
    const bool even = (NT & 1) == 0;
    if (even) { SBAR(); qkt<1, SK>(pB0, pB1, K_lds, r32, hi, S.qr, ACT(NT - 1)); SBAR(); }
#define QROW(e) (nxt.Q + (size_t)(wid * QBLK + r32) * D + ((e) >> 1) * 16 + hi * 8 + ((e) & 1) * 4)
    if constexpr (F32) { SLOAD_F((const float*)nxt.K, kbn); SBAR();
#pragma unroll
        for (int e = 0; e < 8; ++e) S.tq[e] = *(const f32x4*)QROW(e); }
    else { SLOAD_H(nxt.K, nxt.V, kbn); SBAR();
#pragma unroll
        for (int d0 = 0; d0 < 8; ++d0) S.qr[d0] = load8<TIn>(nxt.Q + (size_t)(wid * QBLK + r32) * D + d0 * 16 + hi * 8); }
    SBAR();
    finishSM(pA0, pA1, alA, l_reg, pa0, pa1, pa2, pa3); SBAR();
    if constexpr (F32) {
#pragma unroll
        for (int e = 8; e < 16; ++e) S.tq[e] = *(const f32x4*)QROW(e); SBAR(); }
#undef QROW
    pv_tile<0, SK>(o, vb0, pa0, pa1, pa2, pa3, ACT(even ? NT - 2 : NT - 1));
    if (even) { MASKT(pB0, pB1, NT - 1); partialSM(pB0, pB1, m_reg, mnB, alB); __syncthreads(); RESC(alB);
        finishSM(pB0, pB1, alB, l_reg, pa0, pa1, pa2, pa3); SBAR(); pv_tile<1, SK>(o, vb0, pa0, pa1, pa2, pa3, ACT(NT - 1)); }
    SBAR(); SEAM_K0();
    if (hi == 0) li_l[r32] = l_reg; asm volatile("s_waitcnt lgkmcnt(0)" ::: "memory");
    float rli[16];
#pragma unroll
    for (int r = 0; r < 16; ++r) rli[r] = __builtin_amdgcn_rcpf(li_l[crow(r, hi)]);
    TOut* Ow = cur.O + (size_t)(wid * QBLK) * D;
#pragma unroll
    for (int r = 0; r < 16; ++r) { const int orow = crow(r, hi);
#pragma unroll
        for (int d0 = 0; d0 < 4; ++d0) { const float v = o[d0][r] * rli[r];
            if constexpr (same_t<TOut, float>::v) { Ow[(size_t)orow * D + d0 * 32 + r32] = v; }
            else { const float vn = sw_xor<1>(v);
                   if ((r32 & 1) == 0) *(unsigned*)(Ow + (size_t)orow * D + d0 * 32 + r32) = cvtpk(v, vn); } } }
    if constexpr (F32) {
#pragma unroll
        for (int d0 = 0; d0 < 8; ++d0) S.qr[d0] = pack8(S.tq[2 * d0], S.tq[2 * d0 + 1]); }
    __syncthreads();
#undef RESC
#undef KBASE
#undef ACT
#undef MASKT
#undef SEAM_K0
#undef HALF_STEP
}
#undef ROW
#undef VMW
#undef VMWN
#undef SLOAD_H
#undef SWRITE_HK
#undef SWRITE_HV
#undef SWRITE_H
#undef SLOAD_F
#undef SWRITE_KF
#undef SWRITE_VF
#undef KSWZ
#undef SBAR
}

#define MFMA16(a, b, c) __builtin_amdgcn_mfma_f32_16x16x32_bf16((a), (b), (c), 0, 0, 0)
#define MFMA32(a, b, c) __builtin_amdgcn_mfma_f32_32x32x16_bf16((a), (b), (c), 0, 0, 0)
#define WSP(T_, off) ((T_*)(p->ws + (off)))

DI void sincos_red(double r, float& s, float& c) {
    const double r2 = r * r; double sp = 1.0, cp = 1.0;
#pragma unroll
    for (int k = 13; k >= 1; --k) { sp = 1.0 - sp * r2 * (1.0 / (double)((2 * k) * (2 * k + 1))); cp = 1.0 - cp * r2 * (1.0 / (double)((2 * k - 1) * (2 * k))); }
    s = (float)(r * sp); c = (float)cp;
}

DI void cvt_wt_job(const float* src, bf16_t* dst, int N, int Npad, int nperm, float* tile, const int wv) {
    const int tid = ltid(wv), K = 2048, ntn = Npad / 64, ntiles = ntn * (K / 64);
    for (int tl = blockIdx.x; tl < ntiles; tl += gridDim.x) {
        const int tn = tl % ntn, tk = tl / ntn, k0 = tk * 64, n0 = tn * 64, c = tid & 63;
        int ns = n0 + c;
        if (ns < nperm) { const int p7 = ns & 127, u = p7 >> 3, e = p7 & 7; ns = (ns & ~127) + ((e < 4) ? 4 * u + e : 64 + 4 * u + (e - 4)); }
#pragma unroll
        for (int i = 0; i < 8; ++i) { const int r = (tid >> 6) + 8 * i, n = n0 + c; tile[r * 65 + c] = (n < N) ? src[(size_t)(k0 + r) * N + ns] : 0.f; }
        __syncthreads();
#pragma unroll
        for (int i = 0; i < 4; ++i) { const int id = tid + 512 * i, rr = id >> 5, cp = id & 31;
            ((unsigned*)dst)[((size_t)(n0 + rr) * K + k0) / 2 + cp] = cvt_pk_bf16(tile[(2 * cp) * 65 + rr], tile[(2 * cp + 1) * 65 + rr]); }
        __syncthreads();
    }
}

DI void ph_prologue(PK p, unsigned char* lds, const int wv) {
    PK_FRESH(p);
    const int tid = ltid(wv), lane = tid & 63, wave = __builtin_amdgcn_readfirstlane(tid >> 6);
    float* ldsf = (float*)lds;
    {
        float* sc = ldsf; float* red = ldsf + 4096;
        for (int i = tid; i < 4096; i += 512) sc[i] = silu_f(p->in[1][i]);
        __syncthreads();
        float* mod = WSP(float, WS_MOD);
        for (int item = blockIdx.x; item < MODC / 64; item += gridDim.x) {
            const int col0 = item * 64, col = col0 + lane;
            const float* W; size_t stride;
            if (col0 < 4 * 12288) { const int l = col0 / 12288, j = col - l * 12288; W = p->in[3] + (size_t)l * 2048 * 12288 + j; stride = 12288; }
            else { W = p->in[14] + (col - 4 * 12288); stride = 4096; }
            float a0 = 0.f, a1 = 0.f;
            const int kb = wave * 256;
#pragma unroll 8
            for (int k = 0; k < 256; ++k) { const float wv = W[(size_t)(kb + k) * stride]; a0 += sc[kb + k] * wv; a1 += sc[2048 + kb + k] * wv; }
            red[(wave * 64 + lane) * 2 + 0] = a0; red[(wave * 64 + lane) * 2 + 1] = a1;
            __syncthreads();
            if (tid < 128) { const int ln = tid & 63, b = tid >> 6; float s = 0.f;
#pragma unroll
                for (int w = 0; w < 8; ++w) s += red[(w * 64 + ln) * 2 + b];
                const int cc = col0 + ln; const float bias = (cc < 4 * 12288) ? p->in[4][cc] : p->in[15][cc - 4 * 12288];
                mod[(size_t)b * MODC + cc] = s + bias; }
            __syncthreads();
        }
    }
    for (int job = 0; job < 9; ++job) {
        const float* src; bf16_t* dst; int N = 2048, Npad = 2048, nperm = 0;
        if (job < 2) { src = p->in[7] + (size_t)job * 2048 * GIN; dst = WSP(bf16_t, WS_WIN) + (size_t)job * GINP * 2048; N = GIN; Npad = GINP; }
        else if (job < 4) { src = p->in[12] + (size_t)(job - 2) * 2048 * 2048; dst = WSP(bf16_t, WS_WOUT) + (size_t)(job - 2) * 2048 * 2048; }
        else if (job == 4) { src = p->in[16]; dst = WSP(bf16_t, WS_KVW); N = 4096; Npad = 4096; nperm = 2048; }
        else if (job < 7) { src = p->in[17] + (size_t)(job - 5) * 2048 * 2048; dst = WSP(bf16_t, WS_DWQ) + (size_t)(job - 5) * 2048 * 2048; nperm = 2048; }
        else { src = p->in[20] + (size_t)(job - 7) * 2048 * 2048; dst = WSP(bf16_t, WS_DWO) + (size_t)(job - 7) * 2048 * 2048; }
        cvt_wt_job(src, dst, N, Npad, nperm, ldsf, wv);
    }
    {
        const int lane = tid & 63, r16 = lane & 15, quad = lane >> 4;
        bf16_t* wdst = WSP(bf16_t, WS_PWQ);
        for (int task = (blockIdx.x * 8 + wave); task < 4 * 16 * 128; task += gridDim.x * 8) {
            const int kt = task & 127, pj = (task >> 7) & 15, l = task >> 11, pp = pj >> 1, jh = pj & 1;
            const float* wq = p->in[21] + ((size_t)l * 2048 + kt * 16 + r16) * 2048 + pp * 256 + jh * 128 + quad * 8;
            const float* ky = p->in[22] + ((size_t)(l * 2 + jh) * 128 + r16) * 128 + quad * 8;
            bf16x8 bw[4];
#pragma unroll
            for (int ks = 0; ks < 4; ++ks) { const f32x4 a = *(const f32x4*)(wq + ks * 32), b = *(const f32x4*)(wq + ks * 32 + 4);
                u32x4 w; w.x = cvt_pk_bf16(a[0], a[1]); w.y = cvt_pk_bf16(a[2], a[3]); w.z = cvt_pk_bf16(b[0], b[1]); w.w = cvt_pk_bf16(b[2], b[3]); bw[ks] = __builtin_bit_cast(bf16x8, w); }
#pragma unroll
            for (int nt = 0; nt < 8; ++nt) { f32x4 acc = {0.f, 0.f, 0.f, 0.f};
#pragma unroll
                for (int ks = 0; ks < 4; ++ks) { const f32x4 a = *(const f32x4*)(ky + (size_t)nt * 16 * 128 + ks * 32), b = *(const f32x4*)(ky + (size_t)nt * 16 * 128 + ks * 32 + 4);
                    u32x4 w; w.x = cvt_pk_bf16(a[0], a[1]); w.y = cvt_pk_bf16(a[2], a[3]); w.z = cvt_pk_bf16(b[0], b[1]); w.w = cvt_pk_bf16(b[2], b[3]);
                    acc = MFMA16(bw[ks], __builtin_bit_cast(bf16x8, w), acc); }
                u32x2 wo; wo.x = cvt_pk_bf16(acc[0], acc[1]); wo.y = cvt_pk_bf16(acc[2], acc[3]);
                *(u32x2*)(wdst + ((size_t)l * 2048 + pp * 256 + jh * 128 + nt * 16 + r16) * 2048 + kt * 16 + quad * 4) = wo; }
        }
    }
    {
        float* cosT = WSP(float, WS_COS); float* sinT = WSP(float, WS_SIN); const int* pos = (const int*)p->in[2];
        for (int idx = blockIdx.x * 512 + tid; idx < T * 64; idx += gridDim.x * 512) {
            const int t = idx >> 6, j = idx & 63;
            const double inv = exp(-(double)j * (9.210340371976184 / 64.0));
            const double ang = (double)pos[t] * inv;
            const double n = rint(ang * 0.15915494309189535);
            double r = fma(-n, 6.283185307179586, ang); r = fma(-n, 2.4492935982947064e-16, r);
            float s, c; sincos_red(r, s, c); cosT[idx] = c; sinT[idx] = s;
        }
    }
}

template <int MODE>
DI void ph_norm(const float* x, const bf16_t* xb, const float* g, const float* shift, const float* scale, bf16_t* dstb, float* dstf, const int wv) {
    const int tid = ltid(wv), lane = tid & 63, wave = __builtin_amdgcn_readfirstlane(tid >> 6);
    for (int row = blockIdx.x * 8 + wave; row < T; row += gridDim.x * 8) {
        const int b = row >> 13;
        f32x4 v[8]; float ss = 0.f;
#pragma unroll
        for (int i = 0; i < 8; ++i) {
            if (MODE == 2) { const u32x2 w = *(const u32x2*)(xb + (size_t)row * D + i * 256 + lane * 4); v[i] = (f32x4){bflo(w.x), bfhi(w.x), bflo(w.y), bfhi(w.y)}; }
            else v[i] = *(const f32x4*)(x + (size_t)row * D + i * 256 + lane * 4);
            ss += v[i][0] * v[i][0] + v[i][1] * v[i][1] + v[i][2] * v[i][2] + v[i][3] * v[i][3]; }
        ss = wave_sum(ss);
        const float r = rsqrtf(ss * (1.f / D) + NORM_EPS);
#pragma unroll
        for (int i = 0; i < 8; ++i) { const int col = i * 256 + lane * 4; const f32x4 gv = *(const f32x4*)(g + col);
            if (MODE != 1) { const f32x4 sh = *(const f32x4*)(shift + (size_t)b * MODC + col), sc = *(const f32x4*)(scale + (size_t)b * MODC + col);
                f32x4 y;
#pragma unroll
                for (int e = 0; e < 4; ++e) y[e] = v[i][e] * r * gv[e] * (1.f + sc[e]) + sh[e];
                u32x2 w; w.x = cvt_pk_bf16(y[0], y[1]); w.y = cvt_pk_bf16(y[2], y[3]); *(u32x2*)(dstb + (size_t)row * D + col) = w; }
            else { f32x4 y;
#pragma unroll
                for (int e = 0; e < 4; ++e) y[e] = v[i][e] * r * gv[e];
                *(f32x4*)(dstf + (size_t)row * D + col) = y; } }
    }
}

DI void pc_load(PK p, int l, int row, f32x4 (&v)[8], const int lane) {
    const float* s = ((row >= 16384) ? p->in[24] : p->in[23]) + ((size_t)l * 16384 + (row & 16383)) * 2048;
#pragma unroll
    for (int i = 0; i < 8; ++i) v[i] = *(const f32x4*)(s + lane * 32 + i * 4);
}
DI void pc_store(PK p, int row, const f32x4 (&v)[8], const int lane) {
    const bool second = row >= 16384; const int r = row & 16383;
    unsigned char* dq = WSP(unsigned char, second ? WS_PV : WS_PU); unsigned short* ds = WSP(unsigned short, second ? WS_PVS : WS_PUS);
    float m0 = 0.f;
#pragma unroll
    for (int i = 0; i < 8; ++i) { const float mm = fmaxf(fmaxf(fabsf(v[i][0]), fabsf(v[i][1])), fmaxf(fabsf(v[i][2]), fabsf(v[i][3]))); m0 = fmaxf(m0, mm); }
    const bf16_t sb0 = (m0 > 0.f) ? f2bf(m0 * (1.004f / 6.f)) : (bf16_t)0x3f80;
    const float inv = 1.f / bf2f(sb0);
    u32x4 w;
#pragma unroll
    for (int c = 0; c < 4; ++c) { unsigned x = 0u;
        x = __builtin_amdgcn_cvt_scalef32_pk_fp4_f32(x, v[2 * c][0] * inv, v[2 * c][1] * inv, 1.0f, 0);
        x = __builtin_amdgcn_cvt_scalef32_pk_fp4_f32(x, v[2 * c][2] * inv, v[2 * c][3] * inv, 1.0f, 1);
        x = __builtin_amdgcn_cvt_scalef32_pk_fp4_f32(x, v[2 * c + 1][0] * inv, v[2 * c + 1][1] * inv, 1.0f, 2);
        x = __builtin_amdgcn_cvt_scalef32_pk_fp4_f32(x, v[2 * c + 1][2] * inv, v[2 * c + 1][3] * inv, 1.0f, 3);
        w[c] = x; }
    *(u32x4*)(dq + (size_t)r * 1024 + lane * 16) = w;
    ds[(size_t)r * 64 + lane] = (unsigned short)sb0;
}
DI void ph_peer_cvt(PK p, int l, const int wv) {
    PK_FRESH(p);
    const int tid = ltid(wv), lane = tid & 63, wave = __builtin_amdgcn_readfirstlane(tid >> 6);
    for (int row = blockIdx.x * 8 + wave; row < 2 * 16384; row += gridDim.x * 8) { f32x4 v[8]; pc_load(p, l, row, v, lane); pc_store(p, row, v, lane); }
}


template <int I, int J>
DI void tinv_block(const bf16_t* Lb, bf16_t* Ti, bf16_t* TT, bf16_t* XT, const int r16, const int quad) {
    constexpr int nK = 16 * (I - J);
    const bf16x8 zero8 = {0, 0, 0, 0, 0, 0, 0, 0};
    f32x4 acc = {0.f, 0.f, 0.f, 0.f};
#pragma unroll
    for (int ks = 0; ks < (nK + 31) / 32; ++ks) {
        const int k0 = ks * 32 + quad * 8; const bool valid = k0 < nK;
        const bf16x8 a = valid ? *(const bf16x8*)(Lb + (16 * I + r16) * 72 + 16 * J + k0) : zero8;
        const bf16x8 b = valid ? *(const bf16x8*)(TT + (16 * J + r16) * 72 + 16 * J + k0) : zero8;
        acc = MFMA16(a, b, acc);
    }
    { u32x2 w; w.x = cvt_pk_bf16(acc[0], acc[1]); w.y = cvt_pk_bf16(acc[2], acc[3]); *(u32x2*)(XT + r16 * 24 + quad * 4) = w; }
    asm volatile("s_waitcnt lgkmcnt(0)" ::: "memory");
    const bool v2 = quad < 2;
    const bf16x8 a2 = v2 ? *(const bf16x8*)(Ti + (16 * I + r16) * 72 + 16 * I + quad * 8) : zero8;
    const bf16x8 b2 = v2 ? *(const bf16x8*)(XT + r16 * 24 + quad * 8) : zero8;
    f32x4 m = {0.f, 0.f, 0.f, 0.f};
    m = MFMA16(a2, b2, m);
#pragma unroll
    for (int r = 0; r < 4; ++r) Ti[(16 * I + quad * 4 + r) * 72 + 16 * J + r16] = f2bf(-m[r]);
    { u32x2 w; w.x = cvt_pk_bf16(-m[0], -m[1]); w.y = cvt_pk_bf16(-m[2], -m[3]); *(u32x2*)(TT + (16 * J + r16) * 72 + 16 * I + quad * 4) = w; }
    asm volatile("s_waitcnt lgkmcnt(0)" ::: "memory");
}

DI void ph_gdn_p1(PK p, int l, unsigned char* lds, const int wv) {
    PK_FRESH(p);
    const bf16_t* proj = WSP(const bf16_t, WS_PROJ);
    const float* convw = p->in[8] + (size_t)l * 4 * 6144; const float* alog = p->in[9] + l * 16; const float* dtb = p->in[10] + l * 16;
    bf16_t* Ag = WSP(bf16_t, WS_GA); bf16_t* Bg = WSP(bf16_t, WS_GB); bf16_t* Qg = WSP(bf16_t, WS_GQ); bf16_t* Og = WSP(bf16_t, WS_GO); float* glg = WSP(float, WS_GL);
    bf16_t* qb  = (bf16_t*)(lds + 0);
    bf16_t* kb  = (bf16_t*)(lds + 17408);
    bf16_t* Lb  = (bf16_t*)(lds + 34816);
    bf16_t* wT  = (bf16_t*)(lds + 17408);
    bf16_t* vbT = (bf16_t*)(lds + 44032);
    bf16_t* kdT = (bf16_t*)(lds + 62464);
    bf16_t* kbT = (bf16_t*)(lds + 80896);
    bf16_t* uT  = (bf16_t*)(lds + 80896);
    bf16_t* aqk = (bf16_t*)(lds + 99328);
    bf16_t* Ti  = (bf16_t*)(lds + 108544);
    bf16_t* TT  = (bf16_t*)(lds + 117760);
    float*  Ld  = (float*)(lds + 126976);
    bf16_t* XT  = (bf16_t*)(lds + 132096);
    float*  sc  = (float*)(lds + 133120);
    float*  cw  = (float*)(lds + 134144);
    int cached_bh = -1;
    for (int it = blockIdx.x; it < 4096; it += gridDim.x) {
        const int tid = ltid(wv), lane = tid & 63, wave = __builtin_amdgcn_readfirstlane(tid >> 6), r16 = lane & 15, quad = lane >> 4;
        const int bh = it & 31, n = it >> 5, hd = bh & 15, b = bh >> 4, tok0 = b * SEQ + n * 64, ci = bh * 128 + n;
        if (bh != cached_bh) {
            for (int idx = tid; idx < 1536; idx += 512) { const int part = idx >> 9, tap = (idx >> 7) & 3, c = idx & 127; cw[idx] = convw[tap * 6144 + part * 2048 + hd * 128 + c]; }
            cached_bh = bh;
            lds_barrier();
        }
        float pa_[4] = {0.f, 0.f, 0.f, 0.f}, pb_[4] = {0.f, 0.f, 0.f, 0.f}, dtbv = 0.f, alogv = 0.f;
        if (tid < 64) { const float* pab = WSP(const float, WS_PAB) + (size_t)(tok0 + tid) * 32 + hd; const size_t qs = (size_t)T * 32;
#pragma unroll
            for (int q4 = 0; q4 < 4; ++q4) { pa_[q4] = pab[q4 * qs]; pb_[q4] = pab[q4 * qs + 16]; }
            dtbv = dtb[hd]; alogv = alog[hd]; }
        {
            const int c16 = tid & 15, t0 = (tid >> 4) * 2;
#pragma unroll
            for (int part = 0; part < 3; ++part) {
                const int ch = part * 2048 + hd * 128 + c16 * 8;
                float xr[5][8];
#pragma unroll
                for (int r = 0; r < 5; ++r) {
                    const int sp = n * 64 + t0 - 3 + r;
                    u32x4 raw = {0u, 0u, 0u, 0u};
                    if (sp >= 0) raw = *(const u32x4*)(proj + (size_t)(b * SEQ + sp) * GINP + ch);
                    xr[r][0] = bflo(raw.x); xr[r][1] = bfhi(raw.x); xr[r][2] = bflo(raw.y); xr[r][3] = bfhi(raw.y); xr[r][4] = bflo(raw.z); xr[r][5] = bfhi(raw.z); xr[r][6] = bflo(raw.w); xr[r][7] = bfhi(raw.w);
                }
                float wt[4][8];
#pragma unroll
                for (int tap = 0; tap < 4; ++tap) { const f32x4 w0 = *(const f32x4*)(cw + (part * 4 + tap) * 128 + c16 * 8), w1 = *(const f32x4*)(cw + (part * 4 + tap) * 128 + c16 * 8 + 4);
                    wt[tap][0] = w0[0]; wt[tap][1] = w0[1]; wt[tap][2] = w0[2]; wt[tap][3] = w0[3]; wt[tap][4] = w1[0]; wt[tap][5] = w1[1]; wt[tap][6] = w1[2]; wt[tap][7] = w1[3]; }
                float av[2][8];
#pragma unroll
                for (int u = 0; u < 2; ++u) {
                    float ss = 0.f;
#pragma unroll
                    for (int e = 0; e < 8; ++e) { float a = wt[0][e] * xr[u][e]; a = fmaf(wt[1][e], xr[u + 1][e], a); a = fmaf(wt[2][e], xr[u + 2][e], a); a = fmaf(wt[3][e], xr[u + 3][e], a);
                        a = silu_f(a); av[u][e] = a; ss += a * a; }
                    if (part < 2) {
                        ss += sw_xor<1>(ss); ss += sw_xor<2>(ss); ss += sw_xor<4>(ss); ss += sw_xor<8>(ss);
                        const float r = rsqrtf(ss + NORM_EPS) * (part == 0 ? 0.08838834764831845f : 1.f);
                        u32x4 w; w.x = cvt_pk_bf16(av[u][0] * r, av[u][1] * r); w.y = cvt_pk_bf16(av[u][2] * r, av[u][3] * r); w.z = cvt_pk_bf16(av[u][4] * r, av[u][5] * r); w.w = cvt_pk_bf16(av[u][6] * r, av[u][7] * r);
                        *(u32x4*)((part == 0 ? qb : kb) + (t0 + u) * 136 + c16 * 8) = w;
                    }
                }
                if (part == 2) {
#pragma unroll
                    for (int e = 0; e < 8; ++e) *(unsigned*)(vbT + (c16 * 8 + e) * 72 + t0) = cvt_pk_bf16(av[0][e], av[1][e]);
                }
            }
        }
        if (tid < 64) {
            const int t = tid;
            const float av = (pa_[0] + pa_[1]) + (pa_[2] + pa_[3]), bv = (pb_[0] + pb_[1]) + (pb_[2] + pb_[3]);
            const float xx = av + dtbv;
            const float ex = __expf(xx); const float sp = (xx > 20.f) ? xx : ((xx < -8.f) ? ex * (1.f - 0.5f * ex) : __logf(1.f + ex));
            const float g = -__expf(alogv) * sp;
            const float beta = 1.f / (1.f + __expf(-bv));
            float G = g;
#pragma unroll
            for (int d = 1; d < 64; d <<= 1) { const float o = __int_as_float(__builtin_amdgcn_ds_bpermute(((t - d) & 63) << 2, __float_as_int(G))); if (t >= d) G += o; }
            const float Gl = __int_as_float(__builtin_amdgcn_readlane(__float_as_int(G), 63));
            sc[t] = beta; sc[64 + t] = G; sc[128 + t] = __expf(G); sc[192 + t] = __expf(Gl - G);
            if (t == 63) glg[ci] = __expf(G);
        }
        lds_barrier();
        {
            const int which = wave >> 2, mi = wave & 3;
#pragma unroll
            for (int ni = 0; ni < 4; ++ni) {
                if (which == 0 ? (ni >= mi) : (ni <= mi)) {
                    f32x4 acc = {0.f, 0.f, 0.f, 0.f};
                    const bf16_t* Ab = (which ? qb : kb) + (mi * 16 + r16) * 136 + quad * 8;
                    const bf16_t* Bb = kb + (ni * 16 + r16) * 136 + quad * 8;
#pragma unroll
                    for (int ks = 0; ks < 4; ++ks) acc = MFMA16(*(const bf16x8*)(Ab + ks * 32), *(const bf16x8*)(Bb + ks * 32), acc);
                    const int cidx = ni * 16 + r16; const float Gc = sc[64 + cidx];
                    if (which == 0) {
                        const float bi = sc[cidx]; f32x4 lv;
#pragma unroll
                        for (int r = 0; r < 4; ++r) { const int jj = mi * 16 + quad * 4 + r; lv[r] = (jj < cidx) ? bi * acc[r] * __expf(fminf(Gc - sc[64 + jj], 0.f)) : 0.f; }
                        if (ni == mi) *(f32x4*)(Ld + mi * 320 + r16 * 20 + quad * 4) = lv;
                        else { u32x2 w; w.x = cvt_pk_bf16(lv[0], lv[1]); w.y = cvt_pk_bf16(lv[2], lv[3]); *(u32x2*)(Lb + cidx * 72 + mi * 16 + quad * 4) = w; }
                    } else {
#pragma unroll
                        for (int r = 0; r < 4; ++r) { const int ii = mi * 16 + quad * 4 + r; aqk[ii * 72 + cidx] = f2bf((cidx <= ii) ? acc[r] * __expf(fminf(sc[64 + ii] - Gc, 0.f)) : 0.f); }
                    }
                } else if (which == 1) {
#pragma unroll
                    for (int r = 0; r < 4; ++r) aqk[(mi * 16 + quad * 4 + r) * 72 + ni * 16 + r16] = 0;
                }
            }
        }
        lds_barrier();
        {
            const int a = tid & 127, tq = tid >> 7;
#pragma unroll
            for (int q = 0; q < 2; ++q) { const int t0 = tq * 16 + q * 8; float v[8];
#pragma unroll
                for (int e = 0; e < 8; ++e) v[e] = bf2f(kb[(t0 + e) * 136 + a]);
                u32x4 w; w.x = cvt_pk_bf16(v[0], v[1]); w.y = cvt_pk_bf16(v[2], v[3]); w.z = cvt_pk_bf16(v[4], v[5]); w.w = cvt_pk_bf16(v[6], v[7]);
                *(u32x4*)(kbT + a * 72 + t0) = w;
#pragma unroll
                for (int e = 0; e < 8; ++e) v[e] *= sc[192 + t0 + e];
                w.x = cvt_pk_bf16(v[0], v[1]); w.y = cvt_pk_bf16(v[2], v[3]); w.z = cvt_pk_bf16(v[4], v[5]); w.w = cvt_pk_bf16(v[6], v[7]);
                *(u32x4*)(kdT + a * 72 + t0) = w; }
        }
        if (wave == 0) {
            const float* Lrow = Ld + quad * 320;
            float x[16];
#pragma unroll
            for (int i = 0; i < 16; ++i) { float s = (i == r16) ? 1.f : 0.f;
#pragma unroll
                for (int j = 0; j < i; ++j) s -= Lrow[i * 20 + j] * x[j];
                x[i] = s; }
#pragma unroll
            for (int i = 0; i < 16; ++i) Ti[(16 * quad + i) * 72 + 16 * quad + r16] = f2bf(x[i]);
            { u32x4 w0, w1; w0.x = cvt_pk_bf16(x[0], x[1]); w0.y = cvt_pk_bf16(x[2], x[3]); w0.z = cvt_pk_bf16(x[4], x[5]); w0.w = cvt_pk_bf16(x[6], x[7]);
              w1.x = cvt_pk_bf16(x[8], x[9]); w1.y = cvt_pk_bf16(x[10], x[11]); w1.z = cvt_pk_bf16(x[12], x[13]); w1.w = cvt_pk_bf16(x[14], x[15]);
              *(u32x4*)(TT + (16 * quad + r16) * 72 + 16 * quad) = w0; *(u32x4*)(TT + (16 * quad + r16) * 72 + 16 * quad + 8) = w1; }
            asm volatile("s_waitcnt lgkmcnt(0)" ::: "memory");
            tinv_block<1, 0>(Lb, Ti, TT, XT, r16, quad); tinv_block<2, 1>(Lb, Ti, TT, XT, r16, quad); tinv_block<3, 2>(Lb, Ti, TT, XT, r16, quad);
            tinv_block<2, 0>(Lb, Ti, TT, XT, r16, quad); tinv_block<3, 1>(Lb, Ti, TT, XT, r16, quad);
            tinv_block<3, 0>(Lb, Ti, TT, XT, r16, quad);
        }
        lds_barrier();
        {
            const int i = tid >> 3, t0 = (tid & 7) * 8; const bool low = (t0 >> 4) <= (i >> 4);
            const u32x4 raw = *(const u32x4*)(Ti + i * 72 + t0);
            float v[8] = {bflo(raw.x), bfhi(raw.x), bflo(raw.y), bfhi(raw.y), bflo(raw.z), bfhi(raw.z), bflo(raw.w), bfhi(raw.w)}; float tw[8], tu[8];
#pragma unroll
            for (int e = 0; e < 8; ++e) { const float be = sc[t0 + e]; tu[e] = low ? v[e] * be : 0.f; tw[e] = low ? v[e] * be * sc[128 + t0 + e] : 0.f; }
            u32x4 w; w.x = cvt_pk_bf16(tw[0], tw[1]); w.y = cvt_pk_bf16(tw[2], tw[3]); w.z = cvt_pk_bf16(tw[4], tw[5]); w.w = cvt_pk_bf16(tw[6], tw[7]);
            u32x4 u; u.x = cvt_pk_bf16(tu[0], tu[1]); u.y = cvt_pk_bf16(tu[2], tu[3]); u.z = cvt_pk_bf16(tu[4], tu[5]); u.w = cvt_pk_bf16(tu[6], tu[7]);
            *(u32x4*)(Ti + i * 72 + t0) = w; *(u32x4*)(TT + i * 72 + t0) = u;
        }
        lds_barrier();
#pragma unroll
        for (int pass = 0; pass < 2; ++pass) {
            const bf16_t* Aop = pass ? TT : Ti; const bf16_t* Bop = pass ? vbT : kbT; bf16_t* outT = pass ? uT : wT;
            f32x4 acc4[4];
#pragma unroll
            for (int mi = 0; mi < 4; ++mi) { f32x4 acc = {0.f, 0.f, 0.f, 0.f};
#pragma unroll
                for (int ks = 0; ks < 2; ++ks) acc = MFMA16(*(const bf16x8*)(Aop + (mi * 16 + r16) * 72 + ks * 32 + quad * 8), *(const bf16x8*)(Bop + (wave * 16 + r16) * 72 + ks * 32 + quad * 8), acc);
                acc4[mi] = acc; }
            if (pass == 1) lds_barrier();
#pragma unroll
            for (int mi = 0; mi < 4; ++mi) { u32x2 w; w.x = cvt_pk_bf16(acc4[mi][0], acc4[mi][1]); w.y = cvt_pk_bf16(acc4[mi][2], acc4[mi][3]); *(u32x2*)(outT + (wave * 16 + r16) * 72 + mi * 16 + quad * 4) = w; }
        }
        lds_barrier();
        {
#pragma unroll
            for (int i = 0; i < 24; ++i) {
                const int prod = (i < 8) ? 0 : (i < 16) ? 1 : (i < 20) ? 2 : 3;
                const int mi = (i < 8) ? i : (i < 16) ? (i - 8) : (i < 20) ? (i - 16) : (i - 20), ni = wave;
                const bf16_t* X = ((prod < 2) ? kdT : aqk) + (mi * 16 + r16) * 72 + quad * 8;
                const bf16_t* Y = ((prod & 1) ? uT : wT) + (ni * 16 + r16) * 72 + quad * 8;
                f32x4 acc = {0.f, 0.f, 0.f, 0.f};
                if (prod == 1) {
#pragma unroll
                    for (int ks = 0; ks < 2; ++ks) acc = MFMA16(*(const bf16x8*)(X + ks * 32), *(const bf16x8*)(Y + ks * 32), acc);
                    u32x2 w; w.x = cvt_pk_bf16(acc[0], acc[1]); w.y = cvt_pk_bf16(acc[2], acc[3]);
                    *(u32x2*)(Bg + (size_t)ci * 16384 + (ni * 16 + r16) * 128 + mi * 16 + quad * 4) = w;
                    continue;
                }
#pragma unroll
                for (int ks = 0; ks < 2; ++ks) acc = MFMA16(*(const bf16x8*)(Y + ks * 32), *(const bf16x8*)(X + ks * 32), acc);
                const int m = mi * 16 + r16, n0 = ni * 16 + quad * 4;
                if (prod == 0) acc = -acc;
                if (prod == 2) { const u32x2 qv = *(const u32x2*)(qb + m * 136 + n0); const float eg = sc[128 + m];
                    acc[0] = bflo(qv.x) * eg - acc[0]; acc[1] = bfhi(qv.x) * eg - acc[1]; acc[2] = bflo(qv.y) * eg - acc[2]; acc[3] = bfhi(qv.y) * eg - acc[3]; }
                bf16_t* outp = ((prod == 0) ? (Ag + (size_t)ci * 16384) : (prod == 2) ? (Qg + (size_t)ci * 8192) : (Og + (size_t)ci * 8192)) + m * 128 + n0;
                u32x2 w; w.x = cvt_pk_bf16(acc[0], acc[1]); w.y = cvt_pk_bf16(acc[2], acc[3]); *(u32x2*)outp = w;
            }
        }
        lds_barrier();
    }
}

DI void ph_gdn_p2(PK p, unsigned char* lds, const int wv) {
    PK_FRESH(p);
    const int tid = ltid(wv), lane = tid & 63, wave = __builtin_amdgcn_readfirstlane(tid >> 6), r16 = lane & 15, quad = lane >> 4, a0 = wave * 16;
    const bf16_t* Ag = WSP(const bf16_t, WS_GA); const bf16_t* Bg = WSP(const bf16_t, WS_GB); bf16_t* Sg = WSP(bf16_t, WS_GS); const float* glg = WSP(const float, WS_GL);
    bf16_t* ST = (bf16_t*)lds;
#define P2_LOAD(AF, BM, GL, cidx) do { const size_t c_ = (cidx); _Pragma("unroll") for (int ks = 0; ks < 4; ++ks) AF[ks] = *(const bf16x8*)(Ag + c_ * 16384 + (size_t)(a0 + r16) * 128 + ks * 32 + quad * 8); \
        BM = *(const u32x2*)(Bg + c_ * 16384 + (size_t)(v0 + r16) * 128 + a0 + quad * 4); GL = glg[c_]; } while (0)
    for (int item = blockIdx.x; item < 256; item += gridDim.x) {
        const int bh = (item & 7) * 4 + (item >> 6), v0 = ((item >> 3) & 7) * 16;
        const size_t cb = (size_t)bh * 128;
        f32x4 S = {0.f, 0.f, 0.f, 0.f};
        bf16x8 afA[4], afB[4], afC[4], afD[4]; u32x2 bmA, bmB, bmC, bmD; float glA, glB, glC, glD;
        P2_LOAD(afA, bmA, glA, cb); P2_LOAD(afB, bmB, glB, cb + 1); P2_LOAD(afC, bmC, glC, cb + 2);
#define P2_STEP(AFc, BMc, GLc, AFp, BMp, GLp, nn) do { const int n_ = (nn); const size_t ci = cb + n_; \
            P2_LOAD(AFp, BMp, GLp, cb + ((n_ + 3 < 128) ? n_ + 3 : 127));        \
            u32x2 sp; sp.x = cvt_pk_bf16(S[0], S[1]); sp.y = cvt_pk_bf16(S[2], S[3]); \
            bf16_t* STb = ST + (n_ & 1) * (16 * 136); \
            *(u32x2*)(STb + r16 * 136 + a0 + quad * 4) = sp; \
            *(u32x2*)(Sg + ci * 16384 + (size_t)(v0 + r16) * 128 + a0 + quad * 4) = sp; \
            lds_barrier(); \
            f32x4 acc; acc[0] = GLc * S[0] + bflo(BMc.x); acc[1] = GLc * S[1] + bfhi(BMc.x); acc[2] = GLc * S[2] + bflo(BMc.y); acc[3] = GLc * S[3] + bfhi(BMc.y); \
            bf16x8 bfr_[4]; _Pragma("unroll") for (int ks = 0; ks < 4; ++ks) bfr_[ks] = *(const bf16x8*)(STb + r16 * 136 + ks * 32 + quad * 8);        \
            _Pragma("unroll") for (int ks = 0; ks < 4; ++ks) acc = MFMA16(AFc[ks], bfr_[ks], acc); \
            S = acc; } while (0)
        for (int n = 0; n < 128; n += 4) {
            P2_STEP(afA, bmA, glA, afD, bmD, glD, n);
            P2_STEP(afB, bmB, glB, afA, bmA, glA, n + 1);
            P2_STEP(afC, bmC, glC, afB, bmB, glB, n + 2);
            P2_STEP(afD, bmD, glD, afC, bmC, glC, n + 3);
        }
#undef P2_STEP
        lds_barrier();
    }
#undef P2_LOAD
}

DI void ph_gdn_p3(PK p, int l, const int wv) {
    PK_FRESH(p);
    const int tid = ltid(wv), lane = tid & 63, wave = __builtin_amdgcn_readfirstlane(tid >> 6), r16 = lane & 15, quad = lane >> 4;
    const bf16_t* Qg = WSP(const bf16_t, WS_GQ); const bf16_t* Og = WSP(const bf16_t, WS_GO); const bf16_t* Sg = WSP(const bf16_t, WS_GS);
    const bf16_t* proj = WSP(const bf16_t, WS_PROJ); bf16_t* obuf = WSP(bf16_t, WS_OBUF); const float* ogain = p->in[11] + l * 128;
    for (int it = blockIdx.x; it < 2048; it += gridDim.x) {
        const int ci = it * 2 + (wave >> 2), mi = wave & 3;
        const int n = ci & 127, bh = ci >> 7, hd = bh & 15, b = bh >> 4;
        const int i = mi * 16 + r16; const size_t tok = (size_t)b * SEQ + n * 64 + i;
        bf16x8 qa[4], sf[4][8]; u32x2 ov[8], zv[8];
#pragma unroll
        for (int ks = 0; ks < 4; ++ks) { qa[ks] = *(const bf16x8*)(Qg + (size_t)ci * 8192 + i * 128 + ks * 32 + quad * 8);
#pragma unroll
            for (int ni = 0; ni < 8; ++ni) sf[ks][ni] = *(const bf16x8*)(Sg + (size_t)ci * 16384 + (ni * 16 + r16) * 128 + ks * 32 + quad * 8); }
#pragma unroll
        for (int ni = 0; ni < 8; ++ni) { ov[ni] = *(const u32x2*)(Og + (size_t)ci * 8192 + i * 128 + ni * 16 + quad * 4); zv[ni] = *(const u32x2*)(proj + tok * GINP + 6144 + hd * 128 + ni * 16 + quad * 4); }
        f32x4 acc[8];
#pragma unroll
        for (int ni = 0; ni < 8; ++ni) acc[ni] = (f32x4){0.f, 0.f, 0.f, 0.f};
#pragma unroll
        for (int ks = 0; ks < 4; ++ks)
#pragma unroll
            for (int ni = 0; ni < 8; ++ni) acc[ni] = MFMA16(sf[ks][ni], qa[ks], acc[ni]);
        float ss = 0.f;
#pragma unroll
        for (int ni = 0; ni < 8; ++ni) {
            acc[ni][0] += bflo(ov[ni].x); acc[ni][1] += bfhi(ov[ni].x); acc[ni][2] += bflo(ov[ni].y); acc[ni][3] += bfhi(ov[ni].y);
            ss += acc[ni][0] * acc[ni][0] + acc[ni][1] * acc[ni][1] + acc[ni][2] * acc[ni][2] + acc[ni][3] * acc[ni][3]; }
        ss += sw_xor<16>(ss); ss = sw_xor32_sum(ss);
        const float rms = rsqrtf(ss * (1.f / 128.f) + NORM_EPS);
#pragma unroll
        for (int ni = 0; ni < 8; ++ni) { const int v = ni * 16 + quad * 4; const f32x4 gv = *(const f32x4*)(ogain + v);
            const float y0 = acc[ni][0] * rms * gv[0] * silu_f(bflo(zv[ni].x)), y1 = acc[ni][1] * rms * gv[1] * silu_f(bfhi(zv[ni].x));
            const float y2 = acc[ni][2] * rms * gv[2] * silu_f(bflo(zv[ni].y)), y3 = acc[ni][3] * rms * gv[3] * silu_f(bfhi(zv[ni].y));
            u32x2 w; w.x = cvt_pk_bf16(y0, y1); w.y = cvt_pk_bf16(y2, y3); *(u32x2*)(obuf + tok * D + hd * 128 + v) = w; }
    }
}

DI void ph_rope(PK p, const bf16_t* src, int ld, bf16_t* dst, const int wv) {
    PK_FRESH(p);
    const int tid = ltid(wv); const float* cosT = WSP(const float, WS_COS); const float* sinT = WSP(const float, WS_SIN);
    for (int idx = blockIdx.x * 512 + tid; idx < T * 128; idx += gridDim.x * 512) {
        const int jc = idx & 7, hc = (idx >> 3) & 15, t = idx >> 7;
        const bf16_t* sp = src + (size_t)t * ld + hc * 128 + jc * 8;
        const u32x4 x1 = *(const u32x4*)sp, x2 = *(const u32x4*)(sp + 64);
        const f32x4 c0 = *(const f32x4*)(cosT + t * 64 + jc * 8), c1 = *(const f32x4*)(cosT + t * 64 + jc * 8 + 4);
        const f32x4 s0 = *(const f32x4*)(sinT + t * 64 + jc * 8), s1 = *(const f32x4*)(sinT + t * 64 + jc * 8 + 4);
        float a[8] = {bflo(x1.x), bfhi(x1.x), bflo(x1.y), bfhi(x1.y), bflo(x1.z), bfhi(x1.z), bflo(x1.w), bfhi(x1.w)};
        float bb[8] = {bflo(x2.x), bfhi(x2.x), bflo(x2.y), bfhi(x2.y), bflo(x2.z), bfhi(x2.z), bflo(x2.w), bfhi(x2.w)};
        float cs[8] = {c0[0], c0[1], c0[2], c0[3], c1[0], c1[1], c1[2], c1[3]}, sn[8] = {s0[0], s0[1], s0[2], s0[3], s1[0], s1[1], s1[2], s1[3]};
        float o1[8], o2[8];
#pragma unroll
        for (int e = 0; e < 8; ++e) { o1[e] = a[e] * cs[e] - bb[e] * sn[e]; o2[e] = bb[e] * cs[e] + a[e] * sn[e]; }
        const int b = t >> 13, s = t & 8191;
        bf16_t* dp = dst + ((size_t)(b * 16 + hc) * SEQ + s) * 128 + jc * 8;
        u32x4 w1, w2;
        w1.x = cvt_pk_bf16(o1[0], o1[1]); w1.y = cvt_pk_bf16(o1[2], o1[3]); w1.z = cvt_pk_bf16(o1[4], o1[5]); w1.w = cvt_pk_bf16(o1[6], o1[7]);
        w2.x = cvt_pk_bf16(o2[0], o2[1]); w2.y = cvt_pk_bf16(o2[2], o2[3]); w2.z = cvt_pk_bf16(o2[4], o2[5]); w2.w = cvt_pk_bf16(o2[6], o2[7]);
        *(u32x4*)dp = w1; *(u32x4*)(dp + 64) = w2;
    }
}
DI void ph_vrelayout(const bf16_t* src, bf16_t* dst, const int wv) {
    const int tid = ltid(wv);
    for (int idx = blockIdx.x * 512 + tid; idx < T * 256; idx += gridDim.x * 512) {
        const int ch = idx & 15, hc = (idx >> 4) & 15, t = idx >> 8; const int b = t >> 13, s = t & 8191;
        *(u32x4*)(dst + ((size_t)(b * 16 + hc) * SEQ + s) * 128 + ch * 8) = *(const u32x4*)(src + (size_t)t * 4096 + 2048 + hc * 128 + ch * 8);
    }
}

DI void ph_attn(PK p, unsigned char* lds, const int wv) {
    PK_FRESH(p);
    using att::bf16;
    const bf16* Qd = WSP(const bf16, WS_QD); const bf16* Ksh = WSP(const bf16, WS_KSH); const bf16* Vsh = WSP(const bf16, WS_VSH); bf16* Oat = WSP(bf16, WS_OAT);
    const int total = 64 * 16, stride = gridDim.x, W = SEQ;
    int L = blockIdx.x;
    if (L < total) {
        auto mkref = [&](int Li, int pass) {
            const int xcd = Li & 7, jk = Li >> 3, mm = (jk & 127) >> 4, x = jk & 15, h64 = xcd * 8 + mm, qb = pass ? (31 - x) : x;
            const int vh = h64 & 1, c = (h64 >> 1) & 1, bh = h64 >> 2;
            att::BlockRef<bf16, bf16> r;
            r.Q = Qd + ((size_t)(bh * 2 + c) * SEQ + (size_t)qb * 256) * 128;
            r.K = Ksh + (size_t)(bh * 2 + c) * SEQ * 128;
            r.V = Vsh + (size_t)(bh * 2 + vh) * SEQ * 128;
            r.O = Oat + ((size_t)((bh * 2 + c) * 2 + vh) * SEQ + (size_t)qb * 256) * 128;
            r.P0 = qb * 256; return r; };
        int pass = 0;
        att::BlockRef<bf16, bf16> cur = mkref(L, 0);
        att::Seam<bf16> S;
        att::causal_swa_prime<bf16, bf16>(cur, W, (char*)lds, S, wv);
        for (;;) {
            const bool more_pass = pass == 0, more_item = L + stride < total, last = !more_pass && !more_item;
            int passn = pass + 1, Ln = L;
            if (!more_pass) { passn = 0; Ln = more_item ? L + stride : L; }
            const att::BlockRef<bf16, bf16> nxt = last ? cur : mkref(Ln, passn);
            att::causal_swa_block<bf16, bf16>(cur, nxt, SEQ, W, (char*)lds, S, wv);
            if (last) break;
            cur = nxt; pass = passn; L = Ln;
        }
    }
    __syncthreads();
}

DI void ph_diff_combine(PK p, int j, int l, unsigned char* lds, const int wv) {
    PK_FRESH(p);
    const int tid = ltid(wv), lane = tid & 63, wave = __builtin_amdgcn_readfirstlane(tid >> 6);
    float* ldsf = (float*)lds;
    const float lambda_init = 0.8f - 0.6f * expf(-0.3f * (float)l);
    if (wave == 0) { const float* lp = p->in[18] + j * 512;
        float a = lp[lane] * lp[128 + lane] + lp[64 + lane] * lp[192 + lane], bsum = lp[256 + lane] * lp[384 + lane] + lp[320 + lane] * lp[448 + lane];
        a = wave_sum(a); bsum = wave_sum(bsum);
        if (lane == 0) ldsf[0] = expf(a) - expf(bsum) + lambda_init; }
    __syncthreads();
    const float lam = ldsf[0], om = 1.f - lambda_init;
    const bf16_t* Oat = WSP(const bf16_t, WS_OAT); bf16_t* obuf = WSP(bf16_t, WS_OBUF); const float* sg = p->in[19] + j * 256;
    for (int row = blockIdx.x * 8 + wave; row < T * 8; row += gridDim.x * 8) {
        const int t = row >> 3, h = row & 7, b = t >> 13, s = t & 8191, vh = lane >> 5, d = (lane & 31) * 4;
        const u32x2 o1 = *(const u32x2*)(Oat + ((size_t)(((b * 8 + h) * 2 + 0) * 2 + vh) * SEQ + s) * 128 + d);
        const u32x2 o2 = *(const u32x2*)(Oat + ((size_t)(((b * 8 + h) * 2 + 1) * 2 + vh) * SEQ + s) * 128 + d);
        float v[4] = {bflo(o1.x) - lam * bflo(o2.x), bfhi(o1.x) - lam * bfhi(o2.x), bflo(o1.y) - lam * bflo(o2.y), bfhi(o1.y) - lam * bfhi(o2.y)};
        float ss = v[0] * v[0] + v[1] * v[1] + v[2] * v[2] + v[3] * v[3];
        ss = wave_sum(ss);
        const float rms = rsqrtf(ss * (1.f / 256.f) + NORM_EPS) * om;
        const f32x4 gv = *(const f32x4*)(sg + vh * 128 + d);
        u32x2 w; w.x = cvt_pk_bf16(v[0] * rms * gv[0], v[1] * rms * gv[1]); w.y = cvt_pk_bf16(v[2] * rms * gv[2], v[3] * rms * gv[3]);
        *(u32x2*)(obuf + (size_t)t * D + h * 256 + vh * 128 + d) = w;
    }
    __syncthreads();
}

#define INS16(Lr, vv) do { _Pragma("unroll") for (int k_ = 0; k_ < 16; ++k_) { const float hi_ = fmaxf(Lr[k_], vv); vv = fminf(Lr[k_], vv); Lr[k_] = hi_; } } while (0)
DI void sort16_desc(float (&L)[16]) {
#pragma unroll
    for (int k = 2; k <= 16; k <<= 1)
#pragma unroll
        for (int j = k >> 1; j >= 1; j >>= 1)
#pragma unroll
            for (int i = 0; i < 16; ++i) { const int l = i ^ j;
                if (l > i) { const float hi_ = fmaxf(L[i], L[l]), lo_ = fminf(L[i], L[l]); const bool desc = (i & k) == 0; L[i] = desc ? hi_ : lo_; L[l] = desc ? lo_ : hi_; } }
}
template <int XM> DI void merge16(float (&L)[16]) {
    float P[16];
#pragma unroll
    for (int i = 0; i < 16; ++i) P[i] = sw_xor<XM>(L[15 - i]);
#pragma unroll
    for (int i = 0; i < 16; ++i) L[i] = fmaxf(L[i], P[i]);
#pragma unroll
    for (int s = 8; s >= 1; s >>= 1)
#pragma unroll
        for (int i = 0; i < 16; ++i) if ((i & s) == 0) { const float hi_ = fmaxf(L[i], L[i + s]), lo_ = fminf(L[i], L[i + s]); L[i] = hi_; L[i + s] = lo_; }
}
__constant__ unsigned kStairPk[16] = {0x20100800u, 0xffe07033u, 0x21110901u, 0xfff07140u, 0x22120a02u, 0xffff8041u, 0x23130b03u, 0xffff9042u, 0x24140c04u, 0xffffa050u, 0x30150d05u, 0xffffb051u, 0x31160e06u, 0xffffc060u, 0x32170f07u, 0xffffd061u};
DI void ph_peer_topk(PK p, int l, unsigned char* lds, const int wv) {
    PK_FRESH(p);
    const int tid = ltid(wv);
    float* tops = (float*)lds; float* fin = tops + 64 * 2 * 16;
    const bf16_t* pq = WSP(const bf16_t, WS_PQ);
    int* pidx = WSP(int, WS_PIDX); float* pgate = WSP(float, WS_PGATE);
    const float NEG = -__builtin_inff();
    const int rowl = tid >> 3, half = (tid >> 2) & 1, quarter = tid & 3, l8 = tid & 7;
    const int nitems = T * 8 / 64;
    const int lane = tid & 63, wave = __builtin_amdgcn_readfirstlane(tid >> 6);
    int crow = blockIdx.x * 8 + wave; const int cstep = gridDim.x * 8;
    const u32x2 stw = *(const u32x2*)(kStairPk + l8 * 2);
    u32x4 wn[4];
    if ((int)blockIdx.x < nitems) { const int row = blockIdx.x * 64 + rowl; const bf16_t* sp = pq + (size_t)(row >> 3) * 2048 + (row & 7) * 256 + half * 128 + quarter * 32;
#pragma unroll
        for (int c = 0; c < 4; ++c) wn[c] = *(const u32x4*)(sp + c * 8); }
    for (int item = blockIdx.x; item < nitems; item += gridDim.x) {
        const int row0 = item * 64;
        u32x4 wc[4];
#pragma unroll
        for (int c = 0; c < 4; ++c) wc[c] = wn[c];
        { const int itn = (item + (int)gridDim.x < nitems) ? item + (int)gridDim.x : item; const int row = itn * 64 + rowl;
          const bf16_t* sp = pq + (size_t)(row >> 3) * 2048 + (row & 7) * 256 + half * 128 + quarter * 32;
#pragma unroll
          for (int c = 0; c < 4; ++c) wn[c] = *(const u32x4*)(sp + c * 8); }
        f32x4 cv[8]; const bool cA = crow < 2 * 16384; if (cA) pc_load(p, l, crow, cv, lane);
        float Lr[16], Lq[16];
#pragma unroll
        for (int c = 0; c < 4; ++c)
#pragma unroll
            for (int e = 0; e < 4; ++e) { const unsigned w = wc[c][e];
                const float v0 = __uint_as_float((w << 16) | (unsigned)(quarter * 32 + c * 8 + e * 2)), v1 = __uint_as_float((w & 0xffff0000u) | (unsigned)(quarter * 32 + c * 8 + e * 2 + 1));
                if (c < 2) { Lr[c * 8 + e * 2] = v0; Lr[c * 8 + e * 2 + 1] = v1; } else { Lq[(c - 2) * 8 + e * 2] = v0; Lq[(c - 2) * 8 + e * 2 + 1] = v1; } }
        sort16_desc(Lr); sort16_desc(Lq);
#pragma unroll
        for (int i = 0; i < 16; ++i) Lr[i] = fmaxf(Lr[i], Lq[15 - i]);
#pragma unroll
        for (int s = 8; s >= 1; s >>= 1)
#pragma unroll
            for (int i = 0; i < 16; ++i) if ((i & s) == 0) { const float hi_ = fmaxf(Lr[i], Lr[i + s]), lo_ = fminf(Lr[i], Lr[i + s]); Lr[i] = hi_; Lr[i + s] = lo_; }
        if (cA) { pc_store(p, crow, cv, lane); crow += cstep; }
        const bool cB = crow < 2 * 16384; if (cB) pc_load(p, l, crow, cv, lane);
        merge16<1>(Lr); merge16<2>(Lr);
        if (quarter == 0) {
#pragma unroll
            for (int k = 0; k < 16; ++k) tops[(rowl * 2 + half) * 16 + k] = Lr[k];
        }
        asm volatile("s_waitcnt lgkmcnt(0)" ::: "memory");
        float M[16];
#pragma unroll
        for (int k = 0; k < 16; ++k) M[k] = NEG;
        {
            const float* ta = tops + (rowl * 2) * 16; const float* tb = ta + 16;
#pragma unroll
            for (int m = 0; m < 7; ++m) { const unsigned code = (((m < 4) ? stw.x : stw.y) >> (8 * (m & 3))) & 255u;
                float s = (code < 255u) ? ta[code >> 4] + tb[code & 15u] : NEG;
                s = (code < 255u) ? __uint_as_float((__float_as_uint(s) & ~255u) | code) : NEG; INS16(M, s); }
        }
        merge16<1>(M); merge16<2>(M); merge16<4>(M);
        float sum = 0.f;
#pragma unroll
        for (int k = 0; k < 16; ++k) sum += __expf(M[k] - M[0]);
        if (l8 == 0) {
#pragma unroll
            for (int k = 0; k < 16; ++k) fin[rowl * 16 + k] = M[k];
        }
        asm volatile("s_waitcnt lgkmcnt(0)" ::: "memory");
        {
            const float inv = 1.f / sum, m0 = M[0]; const int row = row0 + rowl; const size_t ob = (size_t)(row >> 3) * 128 + (row & 7) * 16;
#pragma unroll
            for (int u = 0; u < 2; ++u) { const int k = l8 * 2 + u; const float mk = fin[rowl * 16 + k]; const unsigned code = __float_as_uint(mk) & 255u;
                const unsigned i1 = __float_as_uint(tops[(rowl * 2) * 16 + (code >> 4)]) & 127u, i2 = __float_as_uint(tops[(rowl * 2 + 1) * 16 + (code & 15u)]) & 127u;
                pidx[ob + k] = (int)(i1 * 128u + i2); pgate[ob + k] = __expf(mk - m0) * inv; }
        }
        if (cB) { pc_store(p, crow, cv, lane); crow += cstep; }
        asm volatile("s_waitcnt lgkmcnt(0)" ::: "memory");
    }
    for (; crow < 2 * 16384; crow += cstep) { f32x4 cv[8]; pc_load(p, l, crow, cv, lane); pc_store(p, crow, cv, lane); }
}

DI float gelu_f(float v) {
    const float av = fabsf(v), t = __builtin_amdgcn_rcpf(fmaf(av, 0.2316418882f, 1.0f));
    float q = fmaf(t, 0.5307027145f, -0.7265760135f); q = fmaf(q, t, 0.7107068705f); q = fmaf(q, t, -0.142248368f); q = fmaf(q, t, 0.127414796f); q = q * t;
    const float e = __builtin_amdgcn_exp2f(v * v * -0.72134752044f), m = v * (q * e);
    return v < 0.f ? m : v - m;
}
#define FP4X8(w, o) const f32x2 o##0 = __builtin_amdgcn_cvt_scalef32_pk_f32_fp4(w, 1.0f, 0), o##1 = __builtin_amdgcn_cvt_scalef32_pk_f32_fp4(w, 1.0f, 1), \
                                o##2 = __builtin_amdgcn_cvt_scalef32_pk_f32_fp4(w, 1.0f, 2), o##3 = __builtin_amdgcn_cvt_scalef32_pk_f32_fp4(w, 1.0f, 3)
DI void ph_peer_gather(PK p, int l, unsigned char* lds, const int wv, const bool apply = true) {
    PK_FRESH(p);
    const int tid = ltid(wv), lane = tid & 63, wave = __builtin_amdgcn_readfirstlane(tid >> 6);
    const bf16_t* hb = WSP(const bf16_t, WS_HBUF); const unsigned char* ub = WSP(const unsigned char, WS_PU); const unsigned char* vb = WSP(const unsigned char, WS_PV);
    const unsigned* pus = WSP(const unsigned, WS_PUS); const unsigned* pvs = WSP(const unsigned, WS_PVS);
    const int* pidx = WSP(const int, WS_PIDX); const float* pgate = WSP(const float, WS_PGATE); bf16_t* xc = WSP(bf16_t, WS_XCUR);
    const float* gt2 = WSP(const float, WS_MOD) + l * 12288 + 5 * 2048;
    const unsigned l16 = (unsigned)lane * 16u, l2 = (unsigned)(lane >> 1) * 4u, ssh = (unsigned)(lane & 1) * 16u;     const unsigned char* pus8 = (const unsigned char*)pus; const unsigned char* pvs8 = (const unsigned char*)pvs;
    for (int tok = blockIdx.x * 8 + wave; tok < T; tok += gridDim.x * 8) {
        f32x2 hf2[16];
#pragma unroll
        for (int c = 0; c < 4; ++c) { const u32x4 w = *(const u32x4*)(hb + (size_t)tok * D + lane * 32 + c * 8);
            hf2[c * 4 + 0] = (f32x2){bflo(w.x), bfhi(w.x)}; hf2[c * 4 + 1] = (f32x2){bflo(w.y), bfhi(w.y)}; hf2[c * 4 + 2] = (f32x2){bflo(w.z), bfhi(w.z)}; hf2[c * 4 + 3] = (f32x2){bflo(w.w), bfhi(w.w)}; }
        f32x2 acc2[16];
#pragma unroll
        for (int i = 0; i < 16; ++i) acc2[i] = (f32x2){0.f, 0.f};
        u32x2* sraw = (u32x2*)(lds + wave * 2048); u32x2* ssrt = sraw + 128;
        {
            const unsigned k0 = (unsigned)pidx[(size_t)tok * 128 + lane], k1 = (unsigned)pidx[(size_t)tok * 128 + 64 + lane];
            const float g0 = pgate[(size_t)tok * 128 + lane], g1 = pgate[(size_t)tok * 128 + 64 + lane];
            sraw[lane] = (u32x2){k0, __float_as_uint(g0)}; sraw[64 + lane] = (u32x2){k1, __float_as_uint(g1)};
            asm volatile("s_waitcnt lgkmcnt(0)" ::: "memory");
            const unsigned key0 = k0 * 128u + (unsigned)lane, key1 = k1 * 128u + 64u + (unsigned)lane; unsigned r0 = 0, r1 = 0;
            for (int j = 0; j < 128; ++j) { const unsigned kj = sraw[j].x * 128u + (unsigned)j; r0 += (kj < key0) ? 1u : 0u; r1 += (kj < key1) ? 1u : 0u; }
            ssrt[r0] = (u32x2){k0, __float_as_uint(g0)}; ssrt[r1] = (u32x2){k1, __float_as_uint(g1)};
            asm volatile("s_waitcnt lgkmcnt(0)" ::: "memory");
        }
#define G_LOAD(gi, UR, VR, US, VS, GT) do { _Pragma("unroll") for (int q = 0; q < 4; ++q) { const u32x2 pr = ssrt[(gi) * 4 + q]; const unsigned e_ = (unsigned)__builtin_amdgcn_readfirstlane((int)pr.x); GT[q] = __uint_as_float(pr.y); \
            UR[q] = *(const u32x4*)(ub + (size_t)e_ * 1024 + l16); US[q] = *(const unsigned*)(pus8 + (size_t)e_ * 128 + l2); \
            VR[q] = *(const u32x4*)(vb + (size_t)e_ * 1024 + l16); VS[q] = *(const unsigned*)(pvs8 + (size_t)e_ * 128 + l2); } } while (0)
#define G_COMP(UR, VR, US, VS, GT) do { float cf[4]; \
            _Pragma("unroll") for (int q = 0; q < 4; ++q) { f32x2 t2 = {0.f, 0.f}, t3 = {0.f, 0.f}; \
                _Pragma("unroll") for (int c = 0; c < 4; ++c) { FP4X8(UR[q][c], a); \
                    t2 = a0 * hf2[c * 4 + 0] + t2; t3 = a1 * hf2[c * 4 + 1] + t3; t2 = a2 * hf2[c * 4 + 2] + t2; t3 = a3 * hf2[c * 4 + 3] + t3; } \
                t2 = t2 + t3; \
                const float d = wave_sum((t2.x + t2.y) * __uint_as_float((US[q] >> ssh) << 16)); \
                cf[q] = GT[q] * gelu_f(d); } \
            _Pragma("unroll") for (int q = 0; q < 4; ++q) { const float cs = cf[q] * __uint_as_float((VS[q] >> ssh) << 16); const f32x2 cs2 = {cs, cs}; \
                _Pragma("unroll") for (int c = 0; c < 4; ++c) { FP4X8(VR[q][c], b); \
                    acc2[c * 4 + 0] = cs2 * b0 + acc2[c * 4 + 0]; acc2[c * 4 + 1] = cs2 * b1 + acc2[c * 4 + 1]; acc2[c * 4 + 2] = cs2 * b2 + acc2[c * 4 + 2]; acc2[c * 4 + 3] = cs2 * b3 + acc2[c * 4 + 3]; } } } while (0)
        {
            u32x4 urA[4], vrA[4], urB[4], vrB[4]; unsigned usA[4], vsA[4], usB[4], vsB[4]; float gtA[4], gtB[4];
            G_LOAD(0, urA, vrA, usA, vsA, gtA);
            for (int g = 0; g < 32; g += 2) {
                G_LOAD(g + 1, urB, vrB, usB, vsB, gtB);
                G_COMP(urA, vrA, usA, vsA, gtA);
                G_LOAD((g + 2 < 32) ? g + 2 : 31, urA, vrA, usA, vsA, gtA);
                G_COMP(urB, vrB, usB, vsB, gtB);
            }
        }
#undef G_LOAD
#undef G_COMP
        float acc[32];
#pragma unroll
        for (int i = 0; i < 16; ++i) { acc[2 * i] = acc2[i].x; acc[2 * i + 1] = acc2[i].y; }
        if (!apply) { if (p->ph_hi == -12345) { for (int i = 0; i < 32; ++i) xc[i * 64 + lane] = f2bf(acc[i]); } continue; }
        const int b = tok >> 13; const float gm = ((MK_SKIP >> (2 * l + 1)) & 1) ? 0.f : 1.f;
        float ss = 0.f;
#pragma unroll
        for (int c = 0; c < 4; ++c) { const int col = lane * 32 + c * 8; bf16_t* xp = xc + (size_t)tok * D + col;
            const u32x4 xb = *(const u32x4*)xp; const f32x4 g0 = *(const f32x4*)(gt2 + (size_t)b * MODC + col), g1 = *(const f32x4*)(gt2 + (size_t)b * MODC + col + 4);
            const float x8[8] = {bflo(xb.x), bfhi(xb.x), bflo(xb.y), bfhi(xb.y), bflo(xb.z), bfhi(xb.z), bflo(xb.w), bfhi(xb.w)}; float y8[8];
#pragma unroll
            for (int e2 = 0; e2 < 8; ++e2) { y8[e2] = x8[e2] + gm * ((e2 < 4) ? g0[e2] : g1[e2 - 4]) * acc[c * 8 + e2]; acc[c * 8 + e2] = y8[e2]; ss += y8[e2] * y8[e2]; }
            if (l < 3) { u32x4 w; w.x = cvt_pk_bf16(y8[0], y8[1]); w.y = cvt_pk_bf16(y8[2], y8[3]); w.z = cvt_pk_bf16(y8[4], y8[5]); w.w = cvt_pk_bf16(y8[6], y8[7]); *(u32x4*)xp = w; } }
        const float rn = rsqrtf(wave_sum(ss) * (1.f / D) + NORM_EPS);
        const float* modall = WSP(const float, WS_MOD) + (size_t)b * MODC;
        if (l == 3) {
#pragma unroll
            for (int c = 0; c < 8; ++c) { const int col = lane * 32 + c * 4; const f32x4 gv = *(const f32x4*)(p->in[25] + col); f32x4 o;
#pragma unroll
                for (int e2 = 0; e2 < 4; ++e2) o[e2] = acc[c * 4 + e2] * rn * gv[e2];
                *(f32x4*)(p->out + (size_t)tok * D + col) = o; }
        } else {
            const float* g1 = (l == 1) ? p->in[13] : (p->in[5] + (l + 1) * D);
            const float* sh1 = (l == 1) ? (modall + 4 * 12288) : (modall + (l + 1) * 12288);
            const float* sc1 = sh1 + D;
            bf16_t* d1 = WSP(bf16_t, WS_HBUF) + (size_t)tok * D;
#pragma unroll
            for (int c = 0; c < 4; ++c) { u32x4 w;
#pragma unroll
                for (int hh = 0; hh < 2; ++hh) { const int col = lane * 32 + c * 8 + hh * 4; const f32x4 gv = *(const f32x4*)(g1 + col), sv = *(const f32x4*)(sh1 + col), cv = *(const f32x4*)(sc1 + col); float o[4];
#pragma unroll
                    for (int e2 = 0; e2 < 4; ++e2) o[e2] = acc[c * 8 + hh * 4 + e2] * rn * gv[e2] * (1.f + cv[e2]) + sv[e2];
                    w[hh * 2] = cvt_pk_bf16(o[0], o[1]); w[hh * 2 + 1] = cvt_pk_bf16(o[2], o[3]); }
                *(u32x4*)(d1 + lane * 32 + c * 8) = w; }
            if (l == 1) {
                const float* g2 = p->in[5] + 2 * D; const float* sh2 = modall + 2 * 12288; const float* sc2 = sh2 + D;
                bf16_t* d2 = WSP(bf16_t, WS_OBUF) + (size_t)tok * D;
#pragma unroll
                for (int c = 0; c < 4; ++c) { u32x4 w;
#pragma unroll
                    for (int hh = 0; hh < 2; ++hh) { const int col = lane * 32 + c * 8 + hh * 4; const f32x4 gv = *(const f32x4*)(g2 + col), sv = *(const f32x4*)(sh2 + col), cv = *(const f32x4*)(sc2 + col); float o[4];
#pragma unroll
                        for (int e2 = 0; e2 < 4; ++e2) o[e2] = acc[c * 8 + hh * 4 + e2] * rn * gv[e2] * (1.f + cv[e2]) + sv[e2];
                        w[hh * 2] = cvt_pk_bf16(o[0], o[1]); w[hh * 2 + 1] = cvt_pk_bf16(o[2], o[3]); }
                    *(u32x4*)(d2 + lane * 32 + c * 8) = w; }
            }
        }
    }
}
#undef FP4X8

DI void ph_dbg(PK p, int mode, const int wv) {
    PK_FRESH(p);
    const int tid = ltid(wv);
    const bf16_t* Ag = WSP(const bf16_t, WS_GA); const bf16_t* Bg = WSP(const bf16_t, WS_GB); const bf16_t* Qg = WSP(const bf16_t, WS_GQ); const bf16_t* Og = WSP(const bf16_t, WS_GO); const bf16_t* Sg = WSP(const bf16_t, WS_GS);
    const bf16_t* proj = WSP(const bf16_t, WS_PROJ); bf16_t* obuf = WSP(bf16_t, WS_OBUF);
    for (int idx = blockIdx.x * 512 + tid; idx < T * D; idx += gridDim.x * 512) {
        const int tok = idx >> 11, col = idx & 2047, hd = col >> 7, v = col & 127, b = tok >> 13, s = tok & 8191, n = s >> 6, i = s & 63;
        const size_t ci = (size_t)(b * 16 + hd) * 128 + n;
        float r = 0.f;
        if (mode == 1) r = bf2f(Og[ci * 8192 + i * 128 + v]) + bf2f(Qg[ci * 8192 + i * 128 + v]);
        if (mode == 2) r = bf2f(Ag[ci * 16384 + i * 128 + v]) + bf2f(Bg[ci * 16384 + (i + 64) * 128 + v]) + bf2f(Ag[ci * 16384 + (i + 64) * 128 + v]) + bf2f(Bg[ci * 16384 + i * 128 + v]);
        if (mode == 3) r = bf2f(Sg[ci * 16384 + i * 128 + v]) + bf2f(Sg[ci * 16384 + (i + 64) * 128 + v]);
        if (mode == 4) r = bf2f(proj[(size_t)tok * GINP + col]) + bf2f(proj[(size_t)tok * GINP + 2048 + col]) + bf2f(proj[(size_t)tok * GINP + 4096 + col]) + bf2f(proj[(size_t)tok * GINP + 6144 + col]) + ((col < 256) ? bf2f(proj[(size_t)tok * GINP + 8192 + col]) : 0.f);
        obuf[idx] = f2bf(r);
    }
}
#ifndef MK_AOUT
#define MK_AOUT obuf
#endif
constexpr int NPHASES = 1 + 1 + 2 * 9 + 2 * 8 + 1;

__global__ void __launch_bounds__(512, 2) mk_fwd(Params p_arg) {
    extern __shared__ __attribute__((aligned(16))) unsigned char lds[];
    PK p = (PK)__builtin_amdgcn_kernarg_segment_ptr();
    const int lo = p->ph_lo, hi = p->ph_hi;
    const int wv = __builtin_amdgcn_readfirstlane((int)threadIdx.x >> 6);
    volatile LAS unsigned* st = (volatile LAS unsigned*)((LAS unsigned char*)lds + LDS_BARW);
    if (wv == 0 && lane_id() == 0) { st[0] = 0u; st[1] = 0u; }
    __syncthreads();
    XcdBarrier bar; bar.bar = (unsigned*)(p->ws + WS_BAR); bar.x = 0; bar.st = st; bar.wv = wv;
    if (hi - lo > 1) bar = xcd_barrier_post((unsigned*)(p->ws + WS_BAR), st, wv);
    int ph = 0;
#define PH_BEGIN if (lo <= ph && ph < hi) { PK_FRESH(p);
#define PH_END   if (ph + 1 < hi) xcd_barrier(bar); } ++ph;
#define mod  WSP(const float, WS_MOD)
#define xcur WSP(bf16_t, WS_XCUR)
#define hbuf WSP(bf16_t, WS_HBUF)
#define obuf WSP(bf16_t, WS_OBUF)
#define G    ((int)gridDim.x)
#define bx   ((int)blockIdx.x)
#define modl (mod + l * 12288)

    PH_BEGIN ph_prologue(p, lds, wv); if (MK_DUP & 1) { __syncthreads(); ph_prologue(p, lds, wv); } PH_END

    for (int l = 0; l < DEPTH; ++l) {
        if (l == 0) { PH_BEGIN ph_norm<0>(p->in[0], nullptr, p->in[5], modl + 0 * D, modl + 1 * D, hbuf, nullptr, wv); PH_END }
        PH_BEGIN
            pg8::Gemm g; pg8::EpiMk E; E.mode = 0; E.xin = nullptr; E.xinb = nullptr; E.xout = nullptr; E.gate = nullptr; E.gmul = 1.f; E.xoutf = nullptr; E.O2 = nullptr; E.nrope = 0; E.cosT = WSP(const float, WS_COS); E.sinT = WSP(const float, WS_SIN);
            g.A = (l == 2) ? obuf : hbuf; g.M = T; g.K = D; g.ld = D; g.ksplit = 0;
            if (l < 2) { g.Bt = WSP(const bf16_t, WS_WIN) + (size_t)l * GINP * D; g.N = 8192; E.O = WSP(bf16_t, WS_PROJ); E.ldc = GINP; }
            else { g.Bt = WSP(const bf16_t, WS_DWQ) + (size_t)(l - 2) * D * D; g.N = D; E.mode = 2; E.O = WSP(bf16_t, WS_QD); E.nrope = D; }
            pg8::StaticOrder S; S.init(g.M, g.N, G, bx);
            pg8::gemm_phase<pg8::EpiMk, pg8::StaticOrder>((PG8_LAS unsigned char*)lds, g, S, E, wv);
            if (MK_DUP & 2) { __syncthreads(); pg8::gemm_phase<pg8::EpiMk, pg8::StaticOrder>((PG8_LAS unsigned char*)lds, g, S, E, wv); }
            if (l < 2) {
                pg8::Gemm g2; g2.A = hbuf; g2.Bt = WSP(const bf16_t, WS_WIN) + (size_t)l * GINP * D + (size_t)8192 * D; g2.M = T; g2.N = 1024; g2.K = 512; g2.ld = D; g2.ksplit = 1;
                pg8::EpiMk E2 = E; E2.mode = 3; E2.xoutf = WSP(float, WS_PAB);
                pg8::StaticOrder S2; S2.init(g2.M, g2.N, G, bx);
                pg8::gemm_phase<pg8::EpiMk, pg8::StaticOrder>((PG8_LAS unsigned char*)lds, g2, S2, E2, wv);
            }
        PH_END
        if (l < 2) {
            PH_BEGIN ph_gdn_p1(p, l, lds, wv); if (MK_DUP & 8) { __syncthreads(); ph_gdn_p1(p, l, lds, wv); } PH_END
            PH_BEGIN ph_gdn_p2(p, lds, wv); if (MK_DUP & 16) { __syncthreads(); ph_gdn_p2(p, lds, wv); } PH_END
#ifdef MK_DBG
            PH_BEGIN ph_dbg(p, MK_DBG, wv); PH_END
#else
            PH_BEGIN ph_gdn_p3(p, l, wv); if (MK_DUP & 32) { __syncthreads(); ph_gdn_p3(p, l, wv); } PH_END
#endif
        } else {
            PH_BEGIN ph_attn(p, lds, wv); if (MK_DUP & 64) { __syncthreads(); ph_attn(p, lds, wv); } PH_END
            PH_BEGIN ph_diff_combine(p, l - 2, l, lds, wv); PH_END
        }
        PH_BEGIN
            pg8::Gemm g; pg8::EpiMk E; E.mode = 1; E.O = nullptr; E.ldc = 0; E.xoutf = nullptr; E.O2 = nullptr; E.nrope = 0; E.cosT = nullptr; E.sinT = nullptr; E.xin = (l == 0) ? p->in[0] : nullptr; E.xinb = xcur; E.xout = xcur; E.gate = modl + 2 * D; E.gmul = ((MK_SKIP >> (2 * l)) & 1) ? 0.f : 1.f;
            g.A = MK_AOUT; g.M = T; g.K = D; g.N = D; g.ld = D; g.ksplit = 0;
            g.Bt = (l < 2) ? (WSP(const bf16_t, WS_WOUT) + (size_t)l * D * D) : (WSP(const bf16_t, WS_DWO) + (size_t)(l - 2) * D * D);
            pg8::StaticOrder S; S.init(g.M, g.N, G, bx);
            pg8::gemm_phase<pg8::EpiMk, pg8::StaticOrder>((PG8_LAS unsigned char*)lds, g, S, E, wv);
        PH_END
        PH_BEGIN ph_norm<2>(nullptr, xcur, p->in[6] + l * D, modl + 3 * D, modl + 4 * D, hbuf, nullptr, wv); PH_END
        PH_BEGIN
            pg8::Gemm g; pg8::EpiMk E; E.mode = 0; E.xin = nullptr; E.xinb = nullptr; E.xout = nullptr; E.gate = nullptr; E.gmul = 1.f; E.xoutf = nullptr; E.O2 = nullptr; E.nrope = 0; E.cosT = WSP(const float, WS_COS); E.sinT = WSP(const float, WS_SIN); E.O = WSP(bf16_t, WS_PQ); E.ldc = D;
            g.A = hbuf; g.M = T; g.K = D; g.N = D; g.ld = D; g.ksplit = 0; g.Bt = WSP(const bf16_t, WS_PWQ) + (size_t)l * D * D;
            pg8::StaticOrder S; S.init(g.M, g.N, G, bx);
            pg8::gemm_phase<pg8::EpiMk, pg8::StaticOrder>((PG8_LAS unsigned char*)lds, g, S, E, wv);
        PH_END
        PH_BEGIN ph_peer_topk(p, l, lds, wv); if (MK_DUP & 128) { __syncthreads(); ph_peer_topk(p, l, lds, wv); } PH_END
        PH_BEGIN ph_peer_gather(p, l, lds, wv); if (MK_DUP & 256) { __syncthreads(); ph_peer_gather(p, l, lds, wv, false); } PH_END
        if (l == 1) {
            PH_BEGIN
                pg8::Gemm g; pg8::EpiMk E; E.mode = 0; E.xin = nullptr; E.xinb = nullptr; E.xout = nullptr; E.gate = nullptr; E.gmul = 1.f; E.xoutf = nullptr; E.O2 = nullptr; E.nrope = 0; E.cosT = WSP(const float, WS_COS); E.sinT = WSP(const float, WS_SIN); E.mode = 2; E.O = WSP(bf16_t, WS_KSH); E.O2 = WSP(bf16_t, WS_VSH); E.nrope = 2048;
                g.A = hbuf; g.M = T; g.K = D; g.N = 4096; g.ld = D; g.ksplit = 0; g.Bt = WSP(const bf16_t, WS_KVW);
                pg8::StaticOrder S; S.init(g.M, g.N, G, bx);
                pg8::gemm_phase<pg8::EpiMk, pg8::StaticOrder>((PG8_LAS unsigned char*)lds, g, S, E, wv);
            PH_END
        }
    }
#undef PH_BEGIN
#undef PH_END
#undef mod
#undef xcur
#undef hbuf
#undef obuf
#undef G
#undef bx
#undef modl
}

extern "C" void kernel_launch(void* const* d_in, const int* in_sizes, int n_in, void* d_out, int out_size, void* d_ws, size_t ws_size, hipStream_t stream) {
    static int grid = 0;
    if (grid == 0) {
        if (n_in != 26 || in_sizes[0] != T * D || out_size != T * D || ws_size < WS_END) {
            fprintf(stderr, "kernel_launch: unexpected shapes: n_in %d in0 %d out %d ws %zu (need %zu)\n", n_in, n_in > 0 ? in_sizes[0] : -1, out_size, ws_size, (size_t)WS_END); grid = -1; return; }
        int dev = 0, cus = 0;
        if (hipGetDevice(&dev) != hipSuccess || hipDeviceGetAttribute(&cus, hipDeviceAttributeMultiprocessorCount, dev) != hipSuccess || cus <= 0) cus = 256;
        if (hipFuncSetAttribute((const void*)mk_fwd, hipFuncAttributeMaxDynamicSharedMemorySize, LDS_BYTES) != hipSuccess) { fprintf(stderr, "kernel_launch: hipFuncSetAttribute failed\n"); grid = -1; return; }
        int per_cu = 0;
        if (hipOccupancyMaxActiveBlocksPerMultiprocessor(&per_cu, (const void*)mk_fwd, 512, LDS_BYTES) != hipSuccess || per_cu < 1) fprintf(stderr, "kernel_launch: occupancy query says %d\n", per_cu);
        (void)hipGetLastError();
        grid = cus;
    }
    if (grid < 0) return;
    (void)hipMemsetAsync((char*)d_ws + WS_BAR, 0, 16384, stream);
    Params p{};
    for (int i = 0; i < 26; ++i) p.in[i] = (const float*)d_in[i];
    p.out = (float*)d_out; p.ws = (unsigned char*)d_ws;
#if MK_N_LAUNCHES == 1
    p.ph_lo = 0; p.ph_hi = NPHASES;
    hipLaunchKernelGGL(mk_fwd, dim3(grid), dim3(512), LDS_BYTES, stream, p);
#else
#ifndef MK_PHMASK
#define MK_PHMASK 0xffffffffu
#endif
#ifndef MK_STOP
#define MK_STOP NPHASES
#endif
    for (int ph = 0; ph < NPHASES; ++ph) { if (ph >= MK_STOP && ph != NPHASES - 1) continue; if (!(MK_PHMASK >> (ph < 31 ? ph : 31) & 1u) && ph != NPHASES - 1) continue; p.ph_lo = ph; p.ph_hi = ph + 1; hipLaunchKernelGGL(mk_fwd, dim3(grid), dim3(512), LDS_BYTES, stream, p); }
#endif
    const hipError_t le = hipPeekAtLastError();
    if (le != hipSuccess) fprintf(stderr, "kernel_launch: launch failed: %s\n", hipGetErrorName(le));
}
```

```cpp
#include <hip/hip_runtime.h>
#include <hip/hip_bf16.h>
#include <cstdio>
#include <cstdint>

#ifndef MK_N_LAUNCHES
#define MK_N_LAUNCHES 1
#endif
#ifndef MK_DUP
#define MK_DUP 0
#endif
#ifndef MK_SKIP
#define MK_SKIP 0
#endif

constexpr int NB = 2, SEQ = 8192, T = NB * SEQ, D = 2048, DEPTH = 4;
constexpr int GH = 16, GIN = 8224, GINP = 8448;
constexpr int MODC = 4 * 12288 + 4096;
constexpr float NORM_EPS = 1e-6f;

typedef unsigned short bf16_t;
typedef short bf16x8 __attribute__((ext_vector_type(8)));
typedef short s16x4 __attribute__((ext_vector_type(4)));
typedef float f32x4 __attribute__((ext_vector_type(4)));
typedef float f32x2 __attribute__((ext_vector_type(2)));
typedef float f32x16 __attribute__((ext_vector_type(16)));
typedef unsigned u32x4 __attribute__((ext_vector_type(4)));
typedef unsigned u32x2 __attribute__((ext_vector_type(2)));
typedef __bf16 bfx2 __attribute__((ext_vector_type(2)));
#define LAS __attribute__((address_space(3)))
#define DI __device__ __forceinline__

DI float bf2f(bf16_t v) { return __uint_as_float(((unsigned)v) << 16); }
DI float bflo(unsigned w) { return __uint_as_float(w << 16); }
DI float bfhi(unsigned w) { return __uint_as_float(w & 0xffff0000u); }
DI bf16_t f2bf(float f) { unsigned u = __float_as_uint(f); u += 0x7FFFu + ((u >> 16) & 1u); return (bf16_t)(u >> 16); }
DI unsigned cvt_pk_bf16(float lo, float hi) { const f32x2 v = {lo, hi}; return __builtin_bit_cast(unsigned, __builtin_convertvector(v, bfx2)); }
template <int M> DI float sw_xor(float v) { return __int_as_float(__builtin_amdgcn_ds_swizzle(__float_as_int(v), (M << 10) | 0x1f)); }
DI float sw_xor32_sum(float v) { auto rr = __builtin_amdgcn_permlane32_swap(__float_as_uint(v), __float_as_uint(v), false, false); return __uint_as_float(rr[0]) + __uint_as_float(rr[1]); }
DI float wave_max(float v) {
    v = fmaxf(v, sw_xor<1>(v)); v = fmaxf(v, sw_xor<2>(v)); v = fmaxf(v, sw_xor<4>(v)); v = fmaxf(v, sw_xor<8>(v)); v = fmaxf(v, sw_xor<16>(v));
    auto rr = __builtin_amdgcn_permlane32_swap(__float_as_uint(v), __float_as_uint(v), false, false); return fmaxf(__uint_as_float(rr[0]), __uint_as_float(rr[1]));
}
DI float wave_sum(float v) {
    v += sw_xor<1>(v); v += sw_xor<2>(v); v += sw_xor<4>(v); v += sw_xor<8>(v); v += sw_xor<16>(v);
    return sw_xor32_sum(v);
}
DI void lds_barrier() { asm volatile("s_waitcnt lgkmcnt(0)" ::: "memory"); __builtin_amdgcn_s_barrier(); asm volatile("" ::: "memory"); }
DI float silu_f(float v) { return v / (1.f + __expf(-v)); }
DI int lane_id() { int l; asm volatile("v_mbcnt_lo_u32_b32 %0, -1, 0\n\tv_mbcnt_hi_u32_b32 %0, -1, %0" : "=v"(l)); return l; }
DI int ltid(const int wv) { int t = wv * 64 + lane_id(); asm volatile("" : "+v"(t)); return t; }

constexpr size_t al4k(size_t x) { return (x + 4095) & ~(size_t)4095; }
constexpr size_t WS_BAR   = 0;
constexpr size_t WS_MOD   = 16384;
constexpr size_t WS_COS   = al4k(WS_MOD + (size_t)2 * MODC * 4);
constexpr size_t WS_SIN   = WS_COS + (size_t)T * 64 * 4;
constexpr size_t WS_SUBK  = WS_SIN + (size_t)T * 64 * 4;
constexpr size_t WS_WIN   = WS_SUBK + (size_t)4 * 2 * 128 * 128 * 2;
constexpr size_t WS_WOUT  = WS_WIN + (size_t)2 * GINP * D * 2;
constexpr size_t WS_KVW   = WS_WOUT + (size_t)2 * D * D * 2;
constexpr size_t WS_DWQ   = WS_KVW + (size_t)4096 * D * 2;
constexpr size_t WS_DWO   = WS_DWQ + (size_t)2 * D * D * 2;
constexpr size_t WS_PWQ   = WS_DWO + (size_t)2 * D * D * 2;
constexpr size_t WS_PU    = WS_PWQ + (size_t)4 * D * D * 2;
constexpr size_t WS_PUS   = WS_PU + (size_t)16384 * 1024;
constexpr size_t WS_PV    = WS_PU + (size_t)16384 * D * 2;
constexpr size_t WS_PVS   = WS_PV + (size_t)16384 * 1024;
constexpr size_t WS_XCUR  = WS_PV + (size_t)16384 * D * 2;
constexpr size_t WS_HBUF  = WS_XCUR + (size_t)T * D * 4;
constexpr size_t WS_OBUF  = WS_HBUF + (size_t)T * D * 2;
constexpr size_t WS_PROJ  = WS_OBUF + (size_t)T * D * 2;
constexpr size_t WS_PAB   = WS_PROJ + (size_t)T * GINP * 2;
constexpr size_t WS_PQ    = WS_PROJ + (size_t)T * GINP * 2;
constexpr size_t WS_PIDX  = WS_PQ + (size_t)T * D * 2;
constexpr size_t WS_PGATE = WS_PIDX + (size_t)T * 128 * 4;
constexpr size_t WS_GA    = WS_PGATE + (size_t)T * 128 * 4;
constexpr size_t WS_GB    = WS_GA + (size_t)4096 * 128 * 128 * 2;
constexpr size_t WS_GQ    = WS_GB + (size_t)4096 * 128 * 128 * 2;
constexpr size_t WS_GO    = WS_GQ + (size_t)4096 * 64 * 128 * 2;
constexpr size_t WS_GS    = WS_GO + (size_t)4096 * 64 * 128 * 2;
constexpr size_t WS_GL    = WS_GS + (size_t)4096 * 128 * 128 * 2;
constexpr size_t WS_END   = WS_GL + 16384;
constexpr size_t WS_OAT   = WS_GA;
constexpr size_t WS_KSH   = WS_GB;
constexpr size_t WS_VSH   = WS_GB + (size_t)67108864;
constexpr size_t WS_QD    = WS_GQ;

constexpr int LDS_BYTES = 147456;
constexpr int LDS_BARW  = 147456 - 64;

struct Params { const float* in[26]; float* out; unsigned char* ws; int ph_lo, ph_hi; };
typedef const Params __attribute__((address_space(4)))* PK;
#define PK_FRESH(p) asm volatile("" : "+s"(p))

#define XB_TMO      128
#define XB_XCNT(j)  (256  + 64 * (j))
#define XB_XSUB(j)  (1280 + 64 * (j))
#define XB_XGEN(j)  (2304 + 64 * (j))
#define XB_TOP      3328
#define XB_TOPGEN   3392
#define XCD_BAR_WORDS 3456
#define XB_SPIN_CAP (1u << 20)

__device__ __forceinline__ unsigned xb_ld(unsigned* p)              { return __hip_atomic_load(p, __ATOMIC_RELAXED, __HIP_MEMORY_SCOPE_AGENT); }
__device__ __forceinline__ unsigned xb_add(unsigned* p, unsigned v) { return __hip_atomic_fetch_add(p, v, __ATOMIC_RELAXED, __HIP_MEMORY_SCOPE_AGENT); }
__device__ __forceinline__ unsigned xb_xcc_id() { return (unsigned)__builtin_amdgcn_s_getreg((3 << 11) | 20) & 0xFu; }
#define XB_SPIN(cond, bar) do { unsigned _sp = 0; while (cond) { __builtin_amdgcn_s_sleep(1); \
    if ((++_sp & 255u) == 0u) { if (xb_ld(&(bar)[XB_TMO])) break; if (_sp > XB_SPIN_CAP) { atomicAdd(&(bar)[XB_TMO], 1u); break; } } } } while (0)

struct XcdBarrier { unsigned* bar; unsigned x; volatile LAS unsigned* st; int wv; };

__device__ __forceinline__ XcdBarrier xcd_barrier_post(unsigned* bar, volatile LAS unsigned* st, int wv) {
    XcdBarrier b; b.bar = bar; b.x = xb_xcc_id(); b.st = st; b.wv = wv;
    if (wv == 0 && lane_id() == 0) (void)xb_add(&bar[XB_XCNT(b.x)], 1u);
    return b;
}
__device__ __forceinline__ void xcd_barrier_complete(unsigned* bar, unsigned x, unsigned& nloc, unsigned& nx) {
    const unsigned G = gridDim.x * gridDim.y * gridDim.z;
    unsigned sum, cnt, mine, sp = 0u;
    for (;;) {
        sum = 0u; cnt = 0u; mine = 0u;
#pragma unroll
        for (unsigned j = 0; j < 16; ++j) { const unsigned c = xb_ld(&bar[XB_XCNT(j)]); sum += c; cnt += (c > 0u) ? 1u : 0u; mine = (j == x) ? c : mine; }
        if (sum == G) break;
        __builtin_amdgcn_s_sleep(1);
        if ((++sp & 255u) == 0u) { if (xb_ld(&bar[XB_TMO])) break; if (sp > XB_SPIN_CAP) { atomicAdd(&bar[XB_TMO], 1u); break; } }
    }
    nloc = mine > 0u ? mine : 1u; nx = cnt > 0u ? cnt : 1u;
}
__device__ __forceinline__ void xcd_barrier(const XcdBarrier& b) {
    asm volatile("s_waitcnt vmcnt(0)" ::: "memory");
    __syncthreads();
    if (b.wv == 0 && lane_id() == 0) {
        unsigned* bar = b.bar;
        __builtin_amdgcn_s_waitcnt(0);
        unsigned nloc = b.st[0], nx = b.st[1];
        if (nloc == 0u) { xcd_barrier_complete(bar, b.x, nloc, nx); b.st[0] = nloc; b.st[1] = nx; }
        const unsigned old = xb_add(&bar[XB_XSUB(b.x)], 1u);
        const unsigned gen = old / nloc;
        if (old + 1u == (gen + 1u) * nloc) {
            __builtin_amdgcn_fence(__ATOMIC_RELEASE, "agent");
            asm volatile("s_waitcnt vmcnt(0)" ::: "memory");
            const unsigned og = xb_add(&bar[XB_TOP], 1u);
            const unsigned tg = og / nx;
            if (og + 1u == (tg + 1u) * nx) xb_add(&bar[XB_TOPGEN], 1u);
            else XB_SPIN(xb_ld(&bar[XB_TOPGEN]) == tg, bar);
            __builtin_amdgcn_fence(__ATOMIC_ACQUIRE, "agent");
            xb_add(&bar[XB_XGEN(b.x)], 1u);
            asm volatile("s_waitcnt vmcnt(0)" ::: "memory");
        } else {
            XB_SPIN(xb_ld(&bar[XB_XGEN(b.x)]) == gen, bar);
            __builtin_amdgcn_fence(__ATOMIC_ACQUIRE, "agent");
            asm volatile("s_waitcnt vmcnt(0)" ::: "memory");
        }
    }
    __syncthreads();
}

namespace pg8 {
#define PG8_LAS __attribute__((address_space(3)))
constexpr int BM = 256, BK = 64, HALF = 128, HTB = HALF * BK * 2, STAGE_BYTES = 8 * HTB, NXCD = 8, WGM = 8;
__host__ __device__ __forceinline__ int lds_byte(int r, int c) { const int st = (r >> 4) * 2 + (c >> 5), rr = r & 15, cc = c & 31, ob = rr * 64 + cc * 2; return st * 1024 + (ob ^ (((ob >> 9) & 1) << 5)); }
__host__ __device__ __forceinline__ void stage_rc(int b, int& R, int& C) { const int st = b / 1024, sb = b % 1024, swz = sb ^ (((sb >> 9) & 1) << 5); R = (st >> 1) * 16 + swz / 64; C = (st & 1) * 32 + (swz % 64) / 2; }
__host__ __device__ __forceinline__ int perm32(int rho) { const int n = rho >> 4, i = rho & 15; return 8 * (i >> 2) + 4 * n + (i & 3); }
struct Unit { int pm, pn; };
struct Gemm { const bf16_t* A; const bf16_t* Bt; int M, N, K; int ld; int ksplit; };
struct StaticOrder {
    int nM, nN, nwg, G, c;
    __host__ __device__ void init(int M, int N, int G_, int c_) { nM = M / BM; nN = N / BM; nwg = nM * nN; G = G_; c = c_; }
    __host__ __device__ bool next(int i, Unit& u) const {
        const long L = (long)i * G + c; if (L >= nwg) return false;
        int wgid = (int)L; { const int q = nwg / NXCD, r = nwg % NXCD, xcd = wgid % NXCD, off = wgid / NXCD; wgid = (xcd < r ? xcd * (q + 1) : r * (q + 1) + (xcd - r) * q) + off; }
        const int nig = WGM * nN, gid = wgid / nig, fm = gid * WGM, gsz = (nM - fm) < WGM ? (nM - fm) : WGM;
        u.pm = fm + ((wgid % nig) % gsz); u.pn = (wgid % nig) / gsz; return true;
    }
    __device__ __forceinline__ void a_ready(const Unit&) const {}
    __device__ __forceinline__ void done(const Unit&) const {}
};

struct EpiMk {
    static constexpr bool PERM = true, AFTER_DRAIN = false;
    int mode; bf16_t* O; int ldc; const float* xin; const bf16_t* xinb; bf16_t* xout; const float* gate; float gmul;
    bf16_t* O2; int nrope; const float* cosT; const float* sinT;
    float* xoutf;
    __device__ __forceinline__ void operator()(const f32x4 (&acc)[2][2][4][2], const Unit& u, int wr, int wc, int fr, int fq) const {
        const int row0 = u.pm * BM + wr * 64 + fr, col0 = u.pn * BM + wc * 32 + 8 * fq;
        if (mode == 0) {
#pragma unroll
            for (int ai = 0; ai < 2; ++ai)
#pragma unroll
                for (int m = 0; m < 4; ++m) { bf16_t* rowp = O + (size_t)(row0 + ai * HALF + m * 16) * ldc + col0;
#pragma unroll
                    for (int bj = 0; bj < 2; ++bj) { const f32x4 v0 = acc[ai][bj][m][0], v1 = acc[ai][bj][m][1];
                        u32x4 w; w.x = cvt_pk_bf16(v0[0], v0[1]); w.y = cvt_pk_bf16(v0[2], v0[3]); w.z = cvt_pk_bf16(v1[0], v1[1]); w.w = cvt_pk_bf16(v1[2], v1[3]);
                        *(u32x4*)(rowp + bj * HALF) = w; } }
        } else if (mode == 3) {
            if (wc == 0) {
#pragma unroll
                for (int ai = 0; ai < 2; ++ai)
#pragma unroll
                    for (int m = 0; m < 4; ++m) { const int row = row0 + ai * HALF + m * 16; float* dp = xoutf + ((size_t)u.pn * T + row) * 32 + 8 * fq;
                        *(f32x4*)dp = acc[ai][0][m][0]; *(f32x4*)(dp + 4) = acc[ai][0][m][1]; }
            }
        } else if (mode == 2) {
#pragma unroll
            for (int ai = 0; ai < 2; ++ai)
#pragma unroll
                for (int m = 0; m < 4; ++m) { const int row = row0 + ai * HALF + m * 16, bb = row >> 13, ss = row & 8191;
#pragma unroll
                    for (int bj = 0; bj < 2; ++bj) { const int col = col0 + bj * HALF; const f32x4 v0 = acc[ai][bj][m][0], v1 = acc[ai][bj][m][1];
                        if (col < nrope) { const int hc = col >> 7, j0 = ((col & 127) >> 3) * 4;
                            const f32x4 cs = *(const f32x4*)(cosT + (size_t)row * 64 + j0), sn = *(const f32x4*)(sinT + (size_t)row * 64 + j0);
                            bf16_t* dp = O + ((size_t)(bb * 16 + hc) * SEQ + ss) * 128 + j0;
                            u32x2 w1, w2; w1.x = cvt_pk_bf16(v0[0] * cs[0] - v1[0] * sn[0], v0[1] * cs[1] - v1[1] * sn[1]); w1.y = cvt_pk_bf16(v0[2] * cs[2] - v1[2] * sn[2], v0[3] * cs[3] - v1[3] * sn[3]);
                            w2.x = cvt_pk_bf16(v1[0] * cs[0] + v0[0] * sn[0], v1[1] * cs[1] + v0[1] * sn[1]); w2.y = cvt_pk_bf16(v1[2] * cs[2] + v0[2] * sn[2], v1[3] * cs[3] + v0[3] * sn[3]);
                            *(u32x2*)dp = w1; *(u32x2*)(dp + 64) = w2;
                        } else { const int cv = col - nrope, hc = cv >> 7;
                            u32x4 w; w.x = cvt_pk_bf16(v0[0], v0[1]); w.y = cvt_pk_bf16(v0[2], v0[3]); w.z = cvt_pk_bf16(v1[0], v1[1]); w.w = cvt_pk_bf16(v1[2], v1[3]);
                            *(u32x4*)(O2 + ((size_t)(bb * 16 + hc) * SEQ + ss) * 128 + (cv & 127)) = w; } } }
        } else {
#pragma unroll
            for (int ai = 0; ai < 2; ++ai)
#pragma unroll
                for (int m = 0; m < 4; ++m) { const int row = row0 + ai * HALF + m * 16; const float* gp = gate + (size_t)(row >> 13) * MODC + col0;
                    bf16_t* xo = xout + (size_t)row * D + col0;
#pragma unroll
                    for (int bj = 0; bj < 2; ++bj) {
                        const f32x4 g0 = *(const f32x4*)(gp + bj * HALF), g1 = *(const f32x4*)(gp + bj * HALF + 4);
                        f32x4 x0, x1;
                        if (xin) { x0 = *(const f32x4*)(xin + (size_t)row * D + col0 + bj * HALF); x1 = *(const f32x4*)(xin + (size_t)row * D + col0 + bj * HALF + 4); }
                        else { const u32x4 xb = *(const u32x4*)(xinb + (size_t)row * D + col0 + bj * HALF);
                            x0 = (f32x4){bflo(xb.x), bfhi(xb.x), bflo(xb.y), bfhi(xb.y)}; x1 = (f32x4){bflo(xb.z), bfhi(xb.z), bflo(xb.w), bfhi(xb.w)}; }
                        const f32x4 y0 = x0 + gmul * g0 * acc[ai][bj][m][0], y1 = x1 + gmul * g1 * acc[ai][bj][m][1];
                        u32x4 w; w.x = cvt_pk_bf16(y0[0], y0[1]); w.y = cvt_pk_bf16(y0[2], y0[3]); w.z = cvt_pk_bf16(y1[0], y1[1]); w.w = cvt_pk_bf16(y1[2], y1[3]);
                        *(u32x4*)(xo + bj * HALF) = w; } }
        }
    }
};

template <class Epi, class Sched>
__device__ __forceinline__ void gemm_phase(PG8_LAS unsigned char* lds, const Gemm g, const Sched& S, const Epi& E, const int wv) {
    const int tid = ltid(wv), wid = __builtin_amdgcn_readfirstlane(tid >> 6), lane = tid & 63, wr = wid >> 2, wc = wid & 3, fr = lane & 15, fq = lane >> 4;
    const int K = g.K, nt = K / BK, ld = g.ld;
    unsigned voffA[2], voffB[2];
#pragma unroll
    for (int i = 0; i < 2; ++i) { int R, C; stage_rc(tid * 16 + i * 8192, R, C); const int Rb = Epi::PERM ? ((R & ~31) + perm32(R & 31)) : R;
        voffA[i] = (unsigned)(R * ld + C) * 2u; voffB[i] = (unsigned)(Rb * ld + C) * 2u; }
    const size_t kstep = (size_t)(BK * 2);
    const size_t hstep = (size_t)HALF * ld * 2;
    const size_t tstep = 2 * hstep;
    const unsigned ldsw = (unsigned)wid * 1024u;
    const int aoff = lds_byte(wr * 64 + fr, fq * 8), boff = lds_byte(wc * 32 + fr, fq * 8);
#define PG8_SA(b, h) (((b) * 2 + (h)) * HTB)
#define PG8_SB(b, h) ((4 + (b) * 2 + (h)) * HTB)
#define PG8_STAGE(bufoff, gbase, voff) do { _Pragma("unroll") for (int _i = 0; _i < 2; ++_i) \
        __builtin_amdgcn_global_load_lds((const unsigned*)((const char*)(gbase) + (voff)[_i]), (PG8_LAS unsigned*)(lds + (bufoff) + ldsw + _i * 8192), 16, 0, 0); } while (0)
#define PG8_LDA(dst, b, h) do { _Pragma("unroll") for (int m = 0; m < 4; ++m) _Pragma("unroll") for (int k = 0; k < 2; ++k) dst[m][k] = *(const PG8_LAS bf16x8*)(lds + PG8_SA(b, h) + aoff + m * 2048 + k * 1024); } while (0)
#define PG8_LDB(dst, b, h) do { _Pragma("unroll") for (int n = 0; n < 2; ++n) _Pragma("unroll") for (int k = 0; k < 2; ++k) dst[n][k] = *(const PG8_LAS bf16x8*)(lds + PG8_SB(b, h) + boff + n * 2048 + k * 1024); } while (0)
#define PG8_MMA(ai, bj, At, Bt) do { __builtin_amdgcn_s_setprio(1); _Pragma("unroll") for (int m = 0; m < 4; ++m) _Pragma("unroll") for (int n = 0; n < 2; ++n) _Pragma("unroll") for (int k = 0; k < 2; ++k) \
        acc[ai][bj][m][n] = __builtin_amdgcn_mfma_f32_16x16x32_bf16(Bt[n][k], At[m][k], acc[ai][bj][m][n], 0, 0, 0); __builtin_amdgcn_s_setprio(0); } while (0)
#define PG8_WAIT_V(n) asm volatile("s_waitcnt vmcnt(" #n ")" ::: "memory")
#define PG8_WAIT_L(n) asm volatile("s_waitcnt lgkmcnt(" #n ")" ::: "memory")
#define PG8_BAR __builtin_amdgcn_s_barrier()
#define PG8_SCHED __builtin_amdgcn_sched_barrier(0)
    Unit cur, nxt; int ui = 0;
    if (!S.next(0, cur)) return;
    f32x4 acc[2][2][4][2];
#pragma unroll
    for (int a = 0; a < 2; ++a)
#pragma unroll
        for (int b = 0; b < 2; ++b)
#pragma unroll
            for (int m = 0; m < 4; ++m)
#pragma unroll
                for (int n = 0; n < 2; ++n) acc[a][b][m][n] = (f32x4){0.f, 0.f, 0.f, 0.f};
    bf16x8 At[4][2], B0[2][2], B1[2][2];
    const size_t bstep = g.ksplit ? (size_t)K * 2 : tstep, astep = g.ksplit ? (size_t)K * 2 : 0;
    const char* cA = (const char*)g.A + (size_t)cur.pm * tstep + (size_t)cur.pn * astep; const char* cB = (const char*)g.Bt + (size_t)cur.pn * bstep;
    S.a_ready(cur);
    PG8_STAGE(PG8_SB(0, 0), cB, voffB); PG8_STAGE(PG8_SA(0, 0), cA, voffA); PG8_STAGE(PG8_SB(0, 1), cB + hstep, voffB); PG8_STAGE(PG8_SA(0, 1), cA + hstep, voffA);
    if (wr == 1) PG8_BAR;
    PG8_WAIT_V(4); PG8_BAR;
    PG8_STAGE(PG8_SB(1, 0), cB + kstep, voffB); PG8_STAGE(PG8_SA(1, 0), cA + kstep, voffA); PG8_STAGE(PG8_SB(1, 1), cB + hstep + kstep, voffB);
    PG8_WAIT_V(6); PG8_BAR;
    for (;;) {
        const bool has_next = S.next(ui + 1, nxt);
        const char* nA = has_next ? (const char*)g.A + (size_t)nxt.pm * tstep + (size_t)nxt.pn * astep : cA; const char* nB = has_next ? (const char*)g.Bt + (size_t)nxt.pn * bstep : cB;
        for (int t = 0; t < nt; t += 2) {
            const bool last = (t == nt - 2);
            const char* a1 = cA + (size_t)(t + 1) * kstep;
            const char* a2 = last ? nA : cA + (size_t)(t + 2) * kstep; const char* b2 = last ? nB : cB + (size_t)(t + 2) * kstep;
            const char* a3 = a2 + kstep; const char* b3 = b2 + kstep;
            if (last && has_next) S.a_ready(nxt);
            PG8_LDB(B0, 0, 0); PG8_SCHED; PG8_LDA(At, 0, 0); PG8_STAGE(PG8_SA(1, 1), a1 + hstep, voffA);
            PG8_WAIT_L(8); PG8_BAR; PG8_WAIT_L(0); PG8_MMA(0, 0, At, B0); PG8_BAR; PG8_SCHED;
            PG8_LDB(B1, 0, 1); PG8_STAGE(PG8_SB(0, 0), b2, voffB);
            PG8_BAR; PG8_WAIT_L(0); PG8_MMA(0, 1, At, B1); PG8_BAR;
            PG8_LDA(At, 0, 1); PG8_STAGE(PG8_SA(0, 0), a2, voffA);
            PG8_BAR; PG8_WAIT_L(0); PG8_MMA(1, 0, At, B0); PG8_BAR; PG8_SCHED;
            PG8_STAGE(PG8_SB(0, 1), b2 + hstep, voffB);
            PG8_WAIT_V(6); PG8_BAR; PG8_MMA(1, 1, At, B1); PG8_BAR;
            PG8_LDB(B0, 1, 0); PG8_SCHED; PG8_LDA(At, 1, 0); PG8_STAGE(PG8_SA(0, 1), a2 + hstep, voffA);
            PG8_WAIT_L(8); PG8_BAR; PG8_WAIT_L(0); PG8_MMA(0, 0, At, B0); PG8_BAR; PG8_SCHED;
            PG8_LDB(B1, 1, 1); PG8_STAGE(PG8_SB(1, 0), b3, voffB);
            PG8_BAR; PG8_WAIT_L(0); PG8_MMA(0, 1, At, B1); PG8_BAR;
            PG8_LDA(At, 1, 1); PG8_STAGE(PG8_SA(1, 0), a3, voffA);
            PG8_BAR; PG8_WAIT_L(0); PG8_MMA(1, 0, At, B0); PG8_BAR; PG8_SCHED;
            PG8_STAGE(PG8_SB(1, 1), b3 + hstep, voffB);
            PG8_WAIT_V(6); PG8_BAR; PG8_MMA(1, 1, At, B1); PG8_BAR;
        }
        E(acc, cur, wr, wc, fr, fq); S.done(cur);
        if (!has_next) break;
#pragma unroll
        for (int a = 0; a < 2; ++a)
#pragma unroll
            for (int b = 0; b < 2; ++b)
#pragma unroll
                for (int m = 0; m < 4; ++m)
#pragma unroll
                    for (int n = 0; n < 2; ++n) acc[a][b][m][n] = (f32x4){0.f, 0.f, 0.f, 0.f};
        cur = nxt; cA = nA; cB = nB; ++ui;
    }
    PG8_WAIT_V(0);
    if (wr == 0) PG8_BAR;
    PG8_BAR;
#undef PG8_SA
#undef PG8_SB
#undef PG8_STAGE
#undef PG8_LDA
#undef PG8_LDB
#undef PG8_MMA
#undef PG8_WAIT_V
#undef PG8_WAIT_L
#undef PG8_BAR
#undef PG8_SCHED
}
}

namespace att {
constexpr int D = 128;
constexpr float THR = 8.f;
constexpr bool WSKIP = false;
constexpr float SCALE = 0.08838834764831845f;
constexpr int NW = 8, QBLK = 32, KVBLK = 64, QB = NW * QBLK;
constexpr int SHM_V = KVBLK * D * 2, SHM_K = KVBLK * D * 2;
constexpr int LDS_BYTES = 2 * SHM_V + 2 * SHM_K + NW * 64 * 4;
using bf16 = __hip_bfloat16;
template <class A, class Bt> struct same_t { static constexpr bool v = false; };
template <class A> struct same_t<A, A> { static constexpr bool v = true; };
#define KSWZ(row, colB) ((row) * 256 + ((colB) ^ (((row) & 7) << 4)))
#define SBAR() __builtin_amdgcn_sched_barrier(0)
__device__ __forceinline__ int v_st(int k, int c) { const int kk = (k & ~0xC) | ((k & 4) << 1) | ((k & 8) >> 1); return ((kk >> 3) * 4 + (c >> 5)) * 512 + ((kk & 7) * 32 + (c & 31)) * 2; }
__device__ __forceinline__ int v_rd_base(int lane) { return ((lane & 3) << 3) | (((lane >> 2) & 3) << 6) | (((lane >> 4) & 1) << 5) | (((lane >> 5) & 1) << 8); }
constexpr int v_rd_off(int d0, int ks, int half) { return d0 * 512 + ks * 4096 + half * 2048; }
__device__ __forceinline__ int crow(int r, int hi) { return (r & 3) + 8 * (r >> 2) + 4 * hi; }
__device__ __forceinline__ unsigned cvtpk(float lo, float hi) {
    unsigned r; asm volatile("v_cvt_pk_bf16_f32 %0, %1, %2" : "=v"(r) : "v"(lo), "v"(hi)); return r;
}
__device__ __forceinline__ bf16x8 pack8(f32x4 a, f32x4 b) {
    u32x4 w = {cvtpk(a[0], a[1]), cvtpk(a[2], a[3]), cvtpk(b[0], b[1]), cvtpk(b[2], b[3])};
    return *reinterpret_cast<bf16x8*>(&w);
}
template <class T> __device__ __forceinline__ bf16x8 load8(const T* p) {
    if constexpr (same_t<T, float>::v) { return pack8(*(const f32x4*)p, *(const f32x4*)(p + 4)); }
    else { return *reinterpret_cast<const bf16x8*>(p); }
}
__device__ __forceinline__ void mask_tile(f32x16& p0, f32x16& p1, int dq, unsigned W) {
    const float NEG = -__builtin_inff();
#pragma unroll
    for (int r = 0; r < 16; ++r) {
        const int c = (r & 3) + 8 * (r >> 2);
        if ((unsigned)(dq - c) >= W) p0[r] = NEG;
        if ((unsigned)(dq - c - 32) >= W) p1[r] = NEG;
    }
}
__device__ __forceinline__ void partialSM(f32x16& p0, f32x16& p1, float& m_reg, float& mn, float& alpha) {
    float pmax = p0[0]; for (int r = 1; r < 16; ++r) pmax = fmaxf(pmax, p0[r]); for (int r = 0; r < 16; ++r) pmax = fmaxf(pmax, p1[r]);
    { auto rr = __builtin_amdgcn_permlane32_swap(__float_as_uint(pmax), __float_as_uint(pmax), false, false);
      pmax = fmaxf(__uint_as_float(rr[0]), __uint_as_float(rr[1])); }
    constexpr float C2 = 1.4426950408889634f * SCALE;
    if (__builtin_expect(__all((pmax - m_reg) * SCALE <= THR), 1)) { mn = m_reg; alpha = 1.f; }
    else { mn = fmaxf(m_reg, pmax); alpha = __builtin_amdgcn_exp2f((m_reg - mn) * C2); m_reg = mn; }
    const float mnL = -mn * C2;
    for (int r = 0; r < 16; ++r) p0[r] = fmaf(p0[r], C2, mnL); for (int r = 0; r < 16; ++r) p1[r] = fmaf(p1[r], C2, mnL);
    for (int r = 0; r < 16; ++r) p0[r] = __builtin_amdgcn_exp2f(p0[r]);
}
__device__ __forceinline__ void finishSM(f32x16& p0, f32x16& p1, float alpha, float& l_reg, bf16x8& pa0, bf16x8& pa1, bf16x8& pa2, bf16x8& pa3) {
    for (int r = 0; r < 16; ++r) p1[r] = __builtin_amdgcn_exp2f(p1[r]);
    float ps = 0; for (int r = 0; r < 16; ++r) ps += p0[r]; for (int r = 0; r < 16; ++r) ps += p1[r];
    { auto rr = __builtin_amdgcn_permlane32_swap(__float_as_uint(ps), __float_as_uint(ps), false, false);
      ps = __uint_as_float(rr[0]) + __uint_as_float(rr[1]); }
    l_reg = l_reg * alpha + ps;
#define PK4(P, B_, OUT) do { unsigned a0 = cvtpk(P[B_+0], P[B_+1]), a1 = cvtpk(P[B_+2], P[B_+3]);                          \
        unsigned b0 = cvtpk(P[B_+4], P[B_+5]), b1 = cvtpk(P[B_+6], P[B_+7]);                                             \
        auto r0 = __builtin_amdgcn_permlane32_swap(a0, b0, false, false); auto r1 = __builtin_amdgcn_permlane32_swap(a1, b1, false, false); \
        u32x4 w = {r0[0], r1[0], r0[1], r1[1]}; OUT = *reinterpret_cast<bf16x8*>(&w); } while (0)
    PK4(p0, 0, pa0); PK4(p0, 8, pa1); PK4(p1, 0, pa2); PK4(p1, 8, pa3);
#undef PK4
}
template <int KB, bool SK>
__device__ __forceinline__ void qkt(f32x16& p0, f32x16& p1, const char* K_lds, int r32, int hi, const bf16x8* qr, bool act) {
    if (SK && !act) { const float NEG = -__builtin_inff();
#pragma unroll
        for (int r = 0; r < 16; ++r) { p0[r] = NEG; p1[r] = NEG; } return; }
    p0 = f32x16{}; p1 = f32x16{};
    const char* kb[4];
#pragma unroll
    for (int dd = 0; dd < 4; ++dd) kb[dd] = K_lds + KB * SHM_K + KSWZ(r32, (dd * 16 + hi * 8) * 2);
#pragma unroll
    for (int d0 = 0; d0 < 8; ++d0) { const char* a = kb[d0 & 3] + (d0 >> 2) * 128;
        bf16x8 b0 = *reinterpret_cast<const bf16x8*>(a);
        bf16x8 b1 = *reinterpret_cast<const bf16x8*>(a + 32 * 256);
        p0 = __builtin_amdgcn_mfma_f32_32x32x16_bf16(b0, qr[d0], p0, 0, 0, 0);
        p1 = __builtin_amdgcn_mfma_f32_32x32x16_bf16(b1, qr[d0], p1, 0, 0, 0); }
}
template <int VB, bool SK>
__device__ __forceinline__ void pv_tile(f32x16* o, int vb0, bf16x8 pa0, bf16x8 pa1, bf16x8 pa2, bf16x8 pa3, bool act) {
    if (SK && !act) return;
#define TRRD(dst, off) asm volatile("ds_read_b64_tr_b16 %0, %1 offset:%2" : "=&v"(dst) : "v"(vb0), "i"(off) : "memory")
#define PV_D0(d0) do { s16x4 l0, l1, l2, l3, h0, h1, h2, h3; constexpr int b_ = VB * SHM_V + v_rd_off(d0, 0, 0);     \
        TRRD(l0, b_); TRRD(h0, b_ + 2048); TRRD(l1, b_ + 4096); TRRD(h1, b_ + 6144); TRRD(l2, b_ + 8192); TRRD(h2, b_ + 10240); TRRD(l3, b_ + 12288); TRRD(h3, b_ + 14336); \
        asm volatile("s_waitcnt lgkmcnt(0)" ::: "memory"); SBAR();                 \
        o[d0] = __builtin_amdgcn_mfma_f32_32x32x16_bf16(pa0, (bf16x8){l0[0], l0[1], l0[2], l0[3], h0[0], h0[1], h0[2], h0[3]}, o[d0], 0, 0, 0);   \
        o[d0] = __builtin_amdgcn_mfma_f32_32x32x16_bf16(pa1, (bf16x8){l1[0], l1[1], l1[2], l1[3], h1[0], h1[1], h1[2], h1[3]}, o[d0], 0, 0, 0);   \
        o[d0] = __builtin_amdgcn_mfma_f32_32x32x16_bf16(pa2, (bf16x8){l2[0], l2[1], l2[2], l2[3], h2[0], h2[1], h2[2], h2[3]}, o[d0], 0, 0, 0);   \
        o[d0] = __builtin_amdgcn_mfma_f32_32x32x16_bf16(pa3, (bf16x8){l3[0], l3[1], l3[2], l3[3], h3[0], h3[1], h3[2], h3[3]}, o[d0], 0, 0, 0); } while (0)
    PV_D0(0); PV_D0(1); PV_D0(2); PV_D0(3);
#undef PV_D0
#undef TRRD
}

template <class TIn, class TOut> struct BlockRef { const TIn* Q; const TIn* K; const TIn* V; TOut* O; int P0; };
template <class TIn> struct Seam {
    bf16x8 qr[8];
    bf16x8 st_v0, st_v1, st_k0, st_k1; f32x4 sf0, sf1, sf2, sf3;
    f32x4 tq[16];
};
__device__ __forceinline__ int swa_jlo(int P0, int W) { const int lowk = P0 - W + 1; return lowk > 0 ? lowk / KVBLK : 0; }
#define ROW(p, k0, rr) ((p) + (size_t)((k0) + (rr)) * D + sc)
#define VMW() asm volatile("s_waitcnt vmcnt(0)" ::: "memory")
#define VMWN(n) asm volatile("s_waitcnt vmcnt(%0)" :: "i"(n) : "memory")
#define SLOAD_H(Kp, Vp, k0) do { S.st_v0 = load8<TIn>(ROW(Vp, k0, sr)); S.st_v1 = load8<TIn>(ROW(Vp, k0, 32 + sr));              \
                         S.st_k0 = load8<TIn>(ROW(Kp, k0, sr)); S.st_k1 = load8<TIn>(ROW(Kp, k0, 32 + sr)); } while (0)
#define SWRITE_HK(bf) do { *(bf16x8*)(K_lds + (bf) * SHM_K + kws) = S.st_k0; *(bf16x8*)(K_lds + (bf) * SHM_K + kws + 32 * 256) = S.st_k1; } while (0)
#define SWRITE_HV(bf) do { *(bf16x8*)(V_lds + (bf) * SHM_V + vst0) = S.st_v0; *(bf16x8*)(V_lds + (bf) * SHM_V + vst1) = S.st_v1; } while (0)
#define SWRITE_H(bf) do { SWRITE_HV(bf); SWRITE_HK(bf); } while (0)
#define SLOAD_F(p, k0) do { S.sf0 = *(const f32x4*)ROW(p, k0, sr); S.sf1 = *(const f32x4*)(ROW(p, k0, sr) + 4);                \
                            S.sf2 = *(const f32x4*)ROW(p, k0, 32 + sr); S.sf3 = *(const f32x4*)(ROW(p, k0, 32 + sr) + 4); } while (0)
#define SWRITE_KF(bf) do { *(bf16x8*)(K_lds + (bf) * SHM_K + kws) = pack8(S.sf0, S.sf1); *(bf16x8*)(K_lds + (bf) * SHM_K + kws + 32 * 256) = pack8(S.sf2, S.sf3); } while (0)
#define SWRITE_VF(bf) do { *(bf16x8*)(V_lds + (bf) * SHM_V + vst0) = pack8(S.sf0, S.sf1); *(bf16x8*)(V_lds + (bf) * SHM_V + vst1) = pack8(S.sf2, S.sf3); } while (0)
template <class TIn, class TOut>
__device__ __forceinline__ void causal_swa_prime(const BlockRef<TIn, TOut>& cur, int W, char* lds, Seam<TIn>& S, const int wv) {
    constexpr bool F32 = same_t<TIn, float>::v;
    const int tid = ltid(wv), wid = __builtin_amdgcn_readfirstlane(tid >> 6), lane = tid & 63, r32 = lane & 31, hi = lane >> 5;
    const int sr = tid >> 4, sc = (tid & 15) * 8, kws = KSWZ(sr, sc * 2); char* K_lds = lds + 2 * SHM_V;
    const int kb0 = swa_jlo(cur.P0, W) * KVBLK;
    for (int d0 = 0; d0 < 8; ++d0) S.qr[d0] = load8<TIn>(cur.Q + (size_t)(wid * QBLK + r32) * D + d0 * 16 + hi * 8);
    if constexpr (F32) { SLOAD_F((const float*)cur.K, kb0); VMW(); SWRITE_KF(0); SBAR(); SLOAD_F((const float*)cur.V, kb0); }
    else { SLOAD_H(cur.K, cur.V, kb0); VMW(); SWRITE_HK(0); }
    __syncthreads();
}
template <class TIn, class TOut>
__device__ __forceinline__ void causal_swa_block(const BlockRef<TIn, TOut>& cur, const BlockRef<TIn, TOut>& nxt, int skv, int W, char* lds, Seam<TIn>& S, const int wv) {
    constexpr bool F32 = same_t<TIn, float>::v;
    const int tid = ltid(wv), wid = __builtin_amdgcn_readfirstlane(tid >> 6), lane = tid & 63, r32 = lane & 31, hi = lane >> 5;
    const int j_lo = swa_jlo(cur.P0, W);
    int j_hi = (cur.P0 + QB - 1) / KVBLK + 1; if (j_hi > skv / KVBLK) j_hi = skv / KVBLK;
    const int NT = j_hi - j_lo;
    const int kbn = swa_jlo(nxt.P0, W) * KVBLK;
    const int qlo = cur.P0 + wid * QBLK, qm = qlo + r32 - 4 * hi;
    char* V_lds = lds; char* K_lds = lds + 2 * SHM_V;
    float* ws = (float*)(lds + 2 * SHM_V + 2 * SHM_K) + wid * 64; float* li_l = ws, * al_l = ws + 32;
    float m_reg = -1e30f, l_reg = 0; f32x16 o[4] = {};
    const int sr = tid >> 4, sc = (tid & 15) * 8, vst0 = v_st(sr, sc), vst1 = v_st(32 + sr, sc), kws = KSWZ(sr, sc * 2);
    const int vb0 = (int)(uintptr_t)V_lds + v_rd_base(lane);
    const TIn* Kh = cur.K; const TIn* Vh = cur.V;
#define RESC(a) do { if (__any((a) < 1.f)) { if (hi == 0) al_l[r32] = (a); asm volatile("s_waitcnt lgkmcnt(0)" ::: "memory");              \
                     for (int d_ = 0; d_ < 4; ++d_) for (int r = 0; r < 16; ++r) o[d_][r] *= al_l[crow(r, hi)]; } } while (0)
#define KBASE(t) ((j_lo + (t)) * KVBLK)
#define ACT(t) (KBASE(t) <= qlo + QBLK - 1 && KBASE(t) + KVBLK - 1 >= qlo - W + 1)
#define MASKT(P0_, P1_, t) do { const int kb_ = KBASE(t); if ((!SK || ACT(t)) && (kb_ + KVBLK - 1 > qlo || kb_ <= qlo + QBLK - 1 - W)) mask_tile(P0_, P1_, qm - kb_, (unsigned)W); } while (0)
    constexpr int NQL = F32 ? 16 : 8;
    constexpr bool SK = WSKIP && !F32;
#define SEAM_K0() do { VMWN(NQL); if constexpr (F32) { SWRITE_KF(0); SBAR(); SLOAD_F((const float*)nxt.V, kbn); } else { SWRITE_HK(0); } SBAR(); } while (0)
    f32x16 pA0, pA1, pB0, pB1; float mnA, mnB, alA, alB; bf16x8 pa0, pa1, pa2, pa3;
    if constexpr (F32) { VMW(); SWRITE_VF(0); SBAR(); } else { SWRITE_HV(0); SBAR(); }
    if (NT > 1) { if constexpr (F32) SLOAD_F((const float*)Kh, KBASE(1)); else SLOAD_H(Kh, Vh, KBASE(1)); }
    SBAR(); qkt<0, SK>(pA0, pA1, K_lds, r32, hi, S.qr, ACT(0));
    if constexpr (F32) { if (NT > 1) { VMW(); SWRITE_KF(1); SBAR(); SLOAD_F((const float*)Vh, KBASE(1)); } }
    MASKT(pA0, pA1, 0); partialSM(pA0, pA1, m_reg, mnA, alA);
    if (NT > 1) { VMW(); if constexpr (F32) { SWRITE_VF(1); SBAR(); if (NT > 2) SLOAD_F((const float*)Kh, KBASE(2)); } else SWRITE_H(1); }
    __syncthreads();
#define HALF_STEP(PX0, PX1, mnX, alX, PY0, PY1, alY, t, KB, VB, SB) do {                                                      \
        SBAR(); qkt<KB, SK>(PX0, PX1, K_lds, r32, hi, S.qr, ACT(t));                                             \
        finishSM(PY0, PY1, alY, l_reg, pa0, pa1, pa2, pa3); SBAR();                                                           \
        if ((t) + 1 < NT) { if constexpr (F32) { VMW(); SWRITE_KF(SB); SBAR(); SLOAD_F((const float*)Vh, KBASE((t) + 1)); }  \
                            else { SLOAD_H(Kh, Vh, KBASE((t) + 1)); } SBAR(); }                                               \
        pv_tile<VB, SK>(o, vb0, pa0, pa1, pa2, pa3, ACT((t) - 1)); MASKT(PX0, PX1, (t)); partialSM(PX0, PX1, m_reg, mnX, alX);                                        \
        __syncthreads();                                                                                                      \
        if ((t) + 1 < NT) { VMW(); if constexpr (F32) { SWRITE_VF(SB); SBAR(); if ((t) + 2 < NT) SLOAD_F((const float*)Kh, KBASE((t) + 2)); } \
                            else { SWRITE_H(SB); } }                                                                          \
        RESC(alX); __syncthreads(); } while (0)
    for (int t = 1; t + 1 < NT; t += 2) {
        HALF_STEP(pB0, pB1, mnB, alB, pA0, pA1, alA, t, 1, 0, 0);
        HALF_STEP(pA0, pA1, mnA, alA, pB0, pB1, alB, t + 1, 0, 1, 1);
    }
    const bool even = (NT & 1) == 0;
    if (even) { SBAR(); qkt<1, SK>(pB0, pB1, K_lds, r32, hi, S.qr, ACT(NT - 1)); SBAR(); }
#define QROW(e) (nxt.Q + (size_t)(wid * QBLK + r32) * D + ((e) >> 1) * 16 + hi * 8 + ((e) & 1) * 4)
    if constexpr (F32) { SLOAD_F((const float*)nxt.K, kbn); SBAR();
#pragma unroll
        for (int e = 0; e < 8; ++e) S.tq[e] = *(const f32x4*)QROW(e); }
    else { SLOAD_H(nxt.K, nxt.V, kbn); SBAR();
#pragma unroll
        for (int d0 = 0; d0 < 8; ++d0) S.qr[d0] = load8<TIn>(nxt.Q + (size_t)(wid * QBLK + r32) * D + d0 * 16 + hi * 8); }
    SBAR();
    finishSM(pA0, pA1, alA, l_reg, pa0, pa1, pa2, pa3); SBAR();
    if constexpr (F32) {
#pragma unroll
        for (int e = 8; e < 16; ++e) S.tq[e] = *(const f32x4*)QROW(e); SBAR(); }
#undef QROW
    pv_tile<0, SK>(o, vb0, pa0, pa1, pa2, pa3, ACT(even ? NT - 2 : NT - 1));
    if (even) { MASKT(pB0, pB1, NT - 1); partialSM(pB0, pB1, m_reg, mnB, alB); __syncthreads(); RESC(alB);
        finishSM(pB0, pB1, alB, l_reg, pa0, pa1, pa2, pa3); SBAR(); pv_tile<1, SK>(o, vb0, pa0, pa1, pa2, pa3, ACT(NT - 1)); }
    SBAR(); SEAM_K0();
    if (hi == 0) li_l[r32] = l_reg; asm volatile("s_waitcnt lgkmcnt(0)" ::: "memory");
    float rli[16];
#pragma unroll
    for (int r = 0; r < 16; ++r) rli[r] = __builtin_amdgcn_rcpf(li_l[crow(r, hi)]);
    TOut* Ow = cur.O + (size_t)(wid * QBLK) * D;
#pragma unroll
    for (int r = 0; r < 16; ++r) { const int orow = crow(r, hi);
#pragma unroll
        for (int d0 = 0; d0 < 4; ++d0) { const float v = o[d0][r] * rli[r];
            if constexpr (same_t<TOut, float>::v) { Ow[(size_t)orow * D + d0 * 32 + r32] = v; }
            else { const float vn = sw_xor<1>(v);
                   if ((r32 & 1) == 0) *(unsigned*)(Ow + (size_t)orow * D + d0 * 32 + r32) = cvtpk(v, vn); } } }
    if constexpr (F32) {
#pragma unroll
        for (int d0 = 0; d0 < 8; ++d0) S.qr[d0] = pack8(S.tq[2 * d0], S.tq[2 * d0 + 1]); }
    __syncthreads();
#undef RESC
#undef KBASE
#undef ACT
#undef MASKT
#undef SEAM_K0
#undef HALF_STEP
}
#undef ROW
#undef VMW
#undef VMWN
#undef SLOAD_H
#undef SWRITE_HK
#undef SWRITE_HV
#undef SWRITE_H
#undef SLOAD_F
#undef SWRITE_KF
#undef SWRITE_VF
#undef KSWZ
#undef SBAR
}

#define MFMA16(a, b, c) __builtin_amdgcn_mfma_f32_16x16x32_bf16((a), (b), (c), 0, 0, 0)
#define MFMA32(a, b, c) __builtin_amdgcn_mfma_f32_32x32x16_bf16((a), (b), (c), 0, 0, 0)
#define WSP(T_, off) ((T_*)(p->ws + (off)))

DI void sincos_red(double r, float& s, float& c) {
    const double r2 = r * r; double sp = 1.0, cp = 1.0;
#pragma unroll
    for (int k = 13; k >= 1; --k) { sp = 1.0 - sp * r2 * (1.0 / (double)((2 * k) * (2 * k + 1))); cp = 1.0 - cp * r2 * (1.0 / (double)((2 * k - 1) * (2 * k))); }
    s = (float)(r * sp); c = (float)cp;
}

DI void cvt_wt_job(const float* src, bf16_t* dst, int N, int Npad, int nperm, float* tile, const int wv) {
    const int tid = ltid(wv), K = 2048, ntn = Npad / 64, ntiles = ntn * (K / 64);
    for (int tl = blockIdx.x; tl < ntiles; tl += gridDim.x) {
        const int tn = tl % ntn, tk = tl / ntn, k0 = tk * 64, n0 = tn * 64, c = tid & 63;
        int ns = n0 + c;
        if (ns < nperm) { const int p7 = ns & 127, u = p7 >> 3, e = p7 & 7; ns = (ns & ~127) + ((e < 4) ? 4 * u + e : 64 + 4 * u + (e - 4)); }
#pragma unroll
        for (int i = 0; i < 8; ++i) { const int r = (tid >> 6) + 8 * i, n = n0 + c; tile[r * 65 + c] = (n < N) ? src[(size_t)(k0 + r) * N + ns] : 0.f; }
        __syncthreads();
#pragma unroll
        for (int i = 0; i < 4; ++i) { const int id = tid + 512 * i, rr = id >> 5, cp = id & 31;
            ((unsigned*)dst)[((size_t)(n0 + rr) * K + k0) / 2 + cp] = cvt_pk_bf16(tile[(2 * cp) * 65 + rr], tile[(2 * cp + 1) * 65 + rr]); }
        __syncthreads();
    }
}

DI void ph_prologue(PK p, unsigned char* lds, const int wv) {
    PK_FRESH(p);
    const int tid = ltid(wv), lane = tid & 63, wave = __builtin_amdgcn_readfirstlane(tid >> 6);
    float* ldsf = (float*)lds;
    {
        float* sc = ldsf; float* red = ldsf + 4096;
        for (int i = tid; i < 4096; i += 512) sc[i] = silu_f(p->in[1][i]);
        __syncthreads();
        float* mod = WSP(float, WS_MOD);
        for (int item = blockIdx.x; item < MODC / 64; item += gridDim.x) {
            const int col0 = item * 64, col = col0 + lane;
            const float* W; size_t stride;
            if (col0 < 4 * 12288) { const int l = col0 / 12288, j = col - l * 12288; W = p->in[3] + (size_t)l * 2048 * 12288 + j; stride = 12288; }
            else { W = p->in[14] + (col - 4 * 12288); stride = 4096; }
            float a0 = 0.f, a1 = 0.f;
            const int kb = wave * 256;
#pragma unroll 8
            for (int k = 0; k < 256; ++k) { const float wv = W[(size_t)(kb + k) * stride]; a0 += sc[kb + k] * wv; a1 += sc[2048 + kb + k] * wv; }
            red[(wave * 64 + lane) * 2 + 0] = a0; red[(wave * 64 + lane) * 2 + 1] = a1;
            __syncthreads();
            if (tid < 128) { const int ln = tid & 63, b = tid >> 6; float s = 0.f;
#pragma unroll
                for (int w = 0; w < 8; ++w) s += red[(w * 64 + ln) * 2 + b];
                const int cc = col0 + ln; const float bias = (cc < 4 * 12288) ? p->in[4][cc] : p->in[15][cc - 4 * 12288];
                mod[(size_t)b * MODC + cc] = s + bias; }
            __syncthreads();
        }
    }
    for (int job = 0; job < 9; ++job) {
        const float* src; bf16_t* dst; int N = 2048, Npad = 2048, nperm = 0;
        if (job < 2) { src = p->in[7] + (size_t)job * 2048 * GIN; dst = WSP(bf16_t, WS_WIN) + (size_t)job * GINP * 2048; N = GIN; Npad = GINP; }
        else if (job < 4) { src = p->in[12] + (size_t)(job - 2) * 2048 * 2048; dst = WSP(bf16_t, WS_WOUT) + (size_t)(job - 2) * 2048 * 2048; }
        else if (job == 4) { src = p->in[16]; dst = WSP(bf16_t, WS_KVW); N = 4096; Npad = 4096; nperm = 2048; }
        else if (job < 7) { src = p->in[17] + (size_t)(job - 5) * 2048 * 2048; dst = WSP(bf16_t, WS_DWQ) + (size_t)(job - 5) * 2048 * 2048; nperm = 2048; }
        else { src = p->in[20] + (size_t)(job - 7) * 2048 * 2048; dst = WSP(bf16_t, WS_DWO) + (size_t)(job - 7) * 2048 * 2048; }
        cvt_wt_job(src, dst, N, Npad, nperm, ldsf, wv);
    }
    {
        const int lane = tid & 63, r16 = lane & 15, quad = lane >> 4;
        bf16_t* wdst = WSP(bf16_t, WS_PWQ);
        for (int task = (blockIdx.x * 8 + wave); task < 4 * 16 * 128; task += gridDim.x * 8) {
            const int kt = task & 127, pj = (task >> 7) & 15, l = task >> 11, pp = pj >> 1, jh = pj & 1;
            const float* wq = p->in[21] + ((size_t)l * 2048 + kt * 16 + r16) * 2048 + pp * 256 + jh * 128 + quad * 8;
            const float* ky = p->in[22] + ((size_t)(l * 2 + jh) * 128 + r16) * 128 + quad * 8;
            bf16x8 bw[4];
#pragma unroll
            for (int ks = 0; ks < 4; ++ks) { const f32x4 a = *(const f32x4*)(wq + ks * 32), b = *(const f32x4*)(wq + ks * 32 + 4);
                u32x4 w; w.x = cvt_pk_bf16(a[0], a[1]); w.y = cvt_pk_bf16(a[2], a[3]); w.z = cvt_pk_bf16(b[0], b[1]); w.w = cvt_pk_bf16(b[2], b[3]); bw[ks] = __builtin_bit_cast(bf16x8, w); }
#pragma unroll
            for (int nt = 0; nt < 8; ++nt) { f32x4 acc = {0.f, 0.f, 0.f, 0.f};
#pragma unroll
                for (int ks = 0; ks < 4; ++ks) { const f32x4 a = *(const f32x4*)(ky + (size_t)nt * 16 * 128 + ks * 32), b = *(const f32x4*)(ky + (size_t)nt * 16 * 128 + ks * 32 + 4);
                    u32x4 w; w.x = cvt_pk_bf16(a[0], a[1]); w.y = cvt_pk_bf16(a[2], a[3]); w.z = cvt_pk_bf16(b[0], b[1]); w.w = cvt_pk_bf16(b[2], b[3]);
                    acc = MFMA16(bw[ks], __builtin_bit_cast(bf16x8, w), acc); }
                u32x2 wo; wo.x = cvt_pk_bf16(acc[0], acc[1]); wo.y = cvt_pk_bf16(acc[2], acc[3]);
                *(u32x2*)(wdst + ((size_t)l * 2048 + pp * 256 + jh * 128 + nt * 16 + r16) * 2048 + kt * 16 + quad * 4) = wo; }
        }
    }
    {
        float* cosT = WSP(float, WS_COS); float* sinT = WSP(float, WS_SIN); const int* pos = (const int*)p->in[2];
        for (int idx = blockIdx.x * 512 + tid; idx < T * 64; idx += gridDim.x * 512) {
            const int t = idx >> 6, j = idx & 63;
            const double inv = exp(-(double)j * (9.210340371976184 / 64.0));
            const double ang = (double)pos[t] * inv;
            const double n = rint(ang * 0.15915494309189535);
            double r = fma(-n, 6.283185307179586, ang); r = fma(-n, 2.4492935982947064e-16, r);
            float s, c; sincos_red(r, s, c); cosT[idx] = c; sinT[idx] = s;
        }
    }
}

template <int MODE>
DI void ph_norm(const float* x, const bf16_t* xb, const float* g, const float* shift, const float* scale, bf16_t* dstb, float* dstf, const int wv) {
    const int tid = ltid(wv), lane = tid & 63, wave = __builtin_amdgcn_readfirstlane(tid >> 6);
    for (int row = blockIdx.x * 8 + wave; row < T; row += gridDim.x * 8) {
        const int b = row >> 13;
        f32x4 v[8]; float ss = 0.f;
#pragma unroll
        for (int i = 0; i < 8; ++i) {
            if (MODE == 2) { const u32x2 w = *(const u32x2*)(xb + (size_t)row * D + i * 256 + lane * 4); v[i] = (f32x4){bflo(w.x), bfhi(w.x), bflo(w.y), bfhi(w.y)}; }
            else v[i] = *(const f32x4*)(x + (size_t)row * D + i * 256 + lane * 4);
            ss += v[i][0] * v[i][0] + v[i][1] * v[i][1] + v[i][2] * v[i][2] + v[i][3] * v[i][3]; }
        ss = wave_sum(ss);
        const float r = rsqrtf(ss * (1.f / D) + NORM_EPS);
#pragma unroll
        for (int i = 0; i < 8; ++i) { const int col = i * 256 + lane * 4; const f32x4 gv = *(const f32x4*)(g + col);
            if (MODE != 1) { const f32x4 sh = *(const f32x4*)(shift + (size_t)b * MODC + col), sc = *(const f32x4*)(scale + (size_t)b * MODC + col);
                f32x4 y;
#pragma unroll
                for (int e = 0; e < 4; ++e) y[e] = v[i][e] * r * gv[e] * (1.f + sc[e]) + sh[e];
                u32x2 w; w.x = cvt_pk_bf16(y[0], y[1]); w.y = cvt_pk_bf16(y[2], y[3]); *(u32x2*)(dstb + (size_t)row * D + col) = w; }
            else { f32x4 y;
#pragma unroll
                for (int e = 0; e < 4; ++e) y[e] = v[i][e] * r * gv[e];
                *(f32x4*)(dstf + (size_t)row * D + col) = y; } }
    }
}

DI void pc_load(PK p, int l, int row, f32x4 (&v)[8], const int lane) {
    const float* s = ((row >= 16384) ? p->in[24] : p->in[23]) + ((size_t)l * 16384 + (row & 16383)) * 2048;
#pragma unroll
    for (int i = 0; i < 8; ++i) v[i] = *(const f32x4*)(s + lane * 32 + i * 4);
}
DI void pc_store(PK p, int row, const f32x4 (&v)[8], const int lane) {
    const bool second = row >= 16384; const int r = row & 16383;
    unsigned char* dq = WSP(unsigned char, second ? WS_PV : WS_PU); unsigned short* ds = WSP(unsigned short, WS_PUS);
    float m0 = 0.f;
#pragma unroll
    for (int i = 0; i < 8; ++i) { const float mm = fmaxf(fmaxf(fabsf(v[i][0]), fabsf(v[i][1])), fmaxf(fabsf(v[i][2]), fabsf(v[i][3]))); m0 = fmaxf(m0, mm); }
    m0 = fmaxf(m0, sw_xor<1>(m0)); m0 = fmaxf(m0, sw_xor<2>(m0));
    const bf16_t sb0 = (m0 > 0.f) ? f2bf(m0 * (1.004f / 6.f)) : (bf16_t)0x3f80;
    const float inv = 1.f / bf2f(sb0);
    u32x4 w;
#pragma unroll
    for (int c = 0; c < 4; ++c) { unsigned x = 0u;
        x = __builtin_amdgcn_cvt_scalef32_pk_fp4_f32(x, v[2 * c][0] * inv, v[2 * c][1] * inv, 1.0f, 0);
        x = __builtin_amdgcn_cvt_scalef32_pk_fp4_f32(x, v[2 * c][2] * inv, v[2 * c][3] * inv, 1.0f, 1);
        x = __builtin_amdgcn_cvt_scalef32_pk_fp4_f32(x, v[2 * c + 1][0] * inv, v[2 * c + 1][1] * inv, 1.0f, 2);
        x = __builtin_amdgcn_cvt_scalef32_pk_fp4_f32(x, v[2 * c + 1][2] * inv, v[2 * c + 1][3] * inv, 1.0f, 3);
        w[c] = x; }
    *(u32x4*)(dq + (size_t)r * 1024 + lane * 16) = w;
    if ((lane & 3) == 0) ds[((size_t)r * 16 + (lane >> 2)) * 2 + (second ? 1 : 0)] = (unsigned short)sb0;
}
DI void ph_peer_cvt(PK p, int l, const int wv) {
    PK_FRESH(p);
    const int tid = ltid(wv), lane = tid & 63, wave = __builtin_amdgcn_readfirstlane(tid >> 6);
    for (int row = blockIdx.x * 8 + wave; row < 2 * 16384; row += gridDim.x * 8) { f32x4 v[8]; pc_load(p, l, row, v, lane); pc_store(p, row, v, lane); }
}


template <int I, int J>
DI void tinv_block(const bf16_t* Lb, bf16_t* Ti, bf16_t* TT, bf16_t* XT, const int r16, const int quad) {
    constexpr int nK = 16 * (I - J);
    const bf16x8 zero8 = {0, 0, 0, 0, 0, 0, 0, 0};
    f32x4 acc = {0.f, 0.f, 0.f, 0.f};
#pragma unroll
    for (int ks = 0; ks < (nK + 31) / 32; ++ks) {
        const int k0 = ks * 32 + quad * 8; const bool valid = k0 < nK;
        const bf16x8 a = valid ? *(const bf16x8*)(Lb + (16 * I + r16) * 72 + 16 * J + k0) : zero8;
        const bf16x8 b = valid ? *(const bf16x8*)(TT + (16 * J + r16) * 72 + 16 * J + k0) : zero8;
        acc = MFMA16(a, b, acc);
    }
    { u32x2 w; w.x = cvt_pk_bf16(acc[0], acc[1]); w.y = cvt_pk_bf16(acc[2], acc[3]); *(u32x2*)(XT + r16 * 24 + quad * 4) = w; }
    asm volatile("s_waitcnt lgkmcnt(0)" ::: "memory");
    const bool v2 = quad < 2;
    const bf16x8 a2 = v2 ? *(const bf16x8*)(Ti + (16 * I + r16) * 72 + 16 * I + quad * 8) : zero8;
    const bf16x8 b2 = v2 ? *(const bf16x8*)(XT + r16 * 24 + quad * 8) : zero8;
    f32x4 m = {0.f, 0.f, 0.f, 0.f};
    m = MFMA16(a2, b2, m);
#pragma unroll
    for (int r = 0; r < 4; ++r) Ti[(16 * I + quad * 4 + r) * 72 + 16 * J + r16] = f2bf(-m[r]);
    { u32x2 w; w.x = cvt_pk_bf16(-m[0], -m[1]); w.y = cvt_pk_bf16(-m[2], -m[3]); *(u32x2*)(TT + (16 * J + r16) * 72 + 16 * I + quad * 4) = w; }
    asm volatile("s_waitcnt lgkmcnt(0)" ::: "memory");
}

DI void ph_gdn_p1(PK p, int l, unsigned char* lds, const int wv) {
    PK_FRESH(p);
    const bf16_t* proj = WSP(const bf16_t, WS_PROJ);
    const float* convw = p->in[8] + (size_t)l * 4 * 6144; const float* alog = p->in[9] + l * 16; const float* dtb = p->in[10] + l * 16;
    bf16_t* Ag = WSP(bf16_t, WS_GA); bf16_t* Bg = WSP(bf16_t, WS_GB); bf16_t* Qg = WSP(bf16_t, WS_GQ); bf16_t* Og = WSP(bf16_t, WS_GO); float* glg = WSP(float, WS_GL);
    bf16_t* qb  = (bf16_t*)(lds + 0);
    bf16_t* kb  = (bf16_t*)(lds + 17408);
    bf16_t* Lb  = (bf16_t*)(lds + 34816);
    bf16_t* wT  = (bf16_t*)(lds + 17408);
    bf16_t* vbT = (bf16_t*)(lds + 44032);
    bf16_t* kdT = (bf16_t*)(lds + 62464);
    bf16_t* kbT = (bf16_t*)(lds + 80896);
    bf16_t* uT  = (bf16_t*)(lds + 80896);
    bf16_t* aqk = (bf16_t*)(lds + 99328);
    bf16_t* Ti  = (bf16_t*)(lds + 108544);
    bf16_t* TT  = (bf16_t*)(lds + 117760);
    float*  Ld  = (float*)(lds + 126976);
    bf16_t* XT  = (bf16_t*)(lds + 132096);
    float*  sc  = (float*)(lds + 133120);
    float*  cw  = (float*)(lds + 134144);
    int cached_bh = -1;
    for (int it = blockIdx.x; it < 4096; it += gridDim.x) {
        const int tid = ltid(wv), lane = tid & 63, wave = __builtin_amdgcn_readfirstlane(tid >> 6), r16 = lane & 15, quad = lane >> 4;
        const int bh = it & 31, n = it >> 5, hd = bh & 15, b = bh >> 4, tok0 = b * SEQ + n * 64, ci = bh * 128 + n;
        if (bh != cached_bh) {
            for (int idx = tid; idx < 1536; idx += 512) { const int part = idx >> 9, tap = (idx >> 7) & 3, c = idx & 127; cw[idx] = convw[tap * 6144 + part * 2048 + hd * 128 + c]; }
            cached_bh = bh;
            lds_barrier();
        }
        float pa_[4] = {0.f, 0.f, 0.f, 0.f}, pb_[4] = {0.f, 0.f, 0.f, 0.f}, dtbv = 0.f, alogv = 0.f;
        if (tid < 64) { const float* pab = WSP(const float, WS_PAB) + (size_t)(tok0 + tid) * 32 + hd; const size_t qs = (size_t)T * 32;
#pragma unroll
            for (int q4 = 0; q4 < 4; ++q4) { pa_[q4] = pab[q4 * qs]; pb_[q4] = pab[q4 * qs + 16]; }
            dtbv = dtb[hd]; alogv = alog[hd]; }
        {
            const int c16 = tid & 15, t0 = (tid >> 4) * 2;
#pragma unroll
            for (int part = 0; part < 3; ++part) {
                const int ch = part * 2048 + hd * 128 + c16 * 8;
                float xr[5][8];
#pragma unroll
                for (int r = 0; r < 5; ++r) {
                    const int sp = n * 64 + t0 - 3 + r;
                    u32x4 raw = {0u, 0u, 0u, 0u};
                    if (sp >= 0) raw = *(const u32x4*)(proj + (size_t)(b * SEQ + sp) * GINP + ch);
                    xr[r][0] = bflo(raw.x); xr[r][1] = bfhi(raw.x); xr[r][2] = bflo(raw.y); xr[r][3] = bfhi(raw.y); xr[r][4] = bflo(raw.z); xr[r][5] = bfhi(raw.z); xr[r][6] = bflo(raw.w); xr[r][7] = bfhi(raw.w);
                }
                float wt[4][8];
#pragma unroll
                for (int tap = 0; tap < 4; ++tap) { const f32x4 w0 = *(const f32x4*)(cw + (part * 4 + tap) * 128 + c16 * 8), w1 = *(const f32x4*)(cw + (part * 4 + tap) * 128 + c16 * 8 + 4);
                    wt[tap][0] = w0[0]; wt[tap][1] = w0[1]; wt[tap][2] = w0[2]; wt[tap][3] = w0[3]; wt[tap][4] = w1[0]; wt[tap][5] = w1[1]; wt[tap][6] = w1[2]; wt[tap][7] = w1[3]; }
                float av[2][8];
#pragma unroll
                for (int u = 0; u < 2; ++u) {
                    float ss = 0.f;
#pragma unroll
                    for (int e = 0; e < 8; ++e) { float a = wt[0][e] * xr[u][e]; a = fmaf(wt[1][e], xr[u + 1][e], a); a = fmaf(wt[2][e], xr[u + 2][e], a); a = fmaf(wt[3][e], xr[u + 3][e], a);
                        a = silu_f(a); av[u][e] = a; ss += a * a; }
                    if (part < 2) {
                        ss += sw_xor<1>(ss); ss += sw_xor<2>(ss); ss += sw_xor<4>(ss); ss += sw_xor<8>(ss);
                        const float r = rsqrtf(ss + NORM_EPS) * (part == 0 ? 0.08838834764831845f : 1.f);
                        u32x4 w; w.x = cvt_pk_bf16(av[u][0] * r, av[u][1] * r); w.y = cvt_pk_bf16(av[u][2] * r, av[u][3] * r); w.z = cvt_pk_bf16(av[u][4] * r, av[u][5] * r); w.w = cvt_pk_bf16(av[u][6] * r, av[u][7] * r);
                        *(u32x4*)((part == 0 ? qb : kb) + (t0 + u) * 136 + c16 * 8) = w;
                    }
                }
                if (part == 2) {
#pragma unroll
                    for (int e = 0; e < 8; ++e) *(unsigned*)(vbT + (c16 * 8 + e) * 72 + t0) = cvt_pk_bf16(av[0][e], av[1][e]);
                }
            }
        }
        if (tid < 64) {
            const int t = tid;
            const float av = (pa_[0] + pa_[1]) + (pa_[2] + pa_[3]), bv = (pb_[0] + pb_[1]) + (pb_[2] + pb_[3]);
            const float xx = av + dtbv;
            const float ex = __expf(xx); const float sp = (xx > 20.f) ? xx : ((xx < -8.f) ? ex * (1.f - 0.5f * ex) : __logf(1.f + ex));
            const float g = -__expf(alogv) * sp;
            const float beta = 1.f / (1.f + __expf(-bv));
            float G = g;
#pragma unroll
            for (int d = 1; d < 64; d <<= 1) { const float o = __int_as_float(__builtin_amdgcn_ds_bpermute(((t - d) & 63) << 2, __float_as_int(G))); if (t >= d) G += o; }
            const float Gl = __int_as_float(__builtin_amdgcn_readlane(__float_as_int(G), 63));
            sc[t] = beta; sc[64 + t] = G; sc[128 + t] = __expf(G); sc[192 + t] = __expf(Gl - G);
            if (t == 63) glg[ci] = __expf(G);
        }
        lds_barrier();
        {
            const int which = wave >> 2, mi = wave & 3;
#pragma unroll
            for (int ni = 0; ni < 4; ++ni) {
                if (which == 0 ? (ni >= mi) : (ni <= mi)) {
                    f32x4 acc = {0.f, 0.f, 0.f, 0.f};
                    const bf16_t* Ab = (which ? qb : kb) + (mi * 16 + r16) * 136 + quad * 8;
                    const bf16_t* Bb = kb + (ni * 16 + r16) * 136 + quad * 8;
#pragma unroll
                    for (int ks = 0; ks < 4; ++ks) acc = MFMA16(*(const bf16x8*)(Ab + ks * 32), *(const bf16x8*)(Bb + ks * 32), acc);
                    const int cidx = ni * 16 + r16; const float Gc = sc[64 + cidx];
                    if (which == 0) {
                        const float bi = sc[cidx]; f32x4 lv;
#pragma unroll
                        for (int r = 0; r < 4; ++r) { const int jj = mi * 16 + quad * 4 + r; lv[r] = (jj < cidx) ? bi * acc[r] * __expf(fminf(Gc - sc[64 + jj], 0.f)) : 0.f; }
                        if (ni == mi) *(f32x4*)(Ld + mi * 320 + r16 * 20 + quad * 4) = lv;
                        else { u32x2 w; w.x = cvt_pk_bf16(lv[0], lv[1]); w.y = cvt_pk_bf16(lv[2], lv[3]); *(u32x2*)(Lb + cidx * 72 + mi * 16 + quad * 4) = w; }
                    } else {
#pragma unroll
                        for (int r = 0; r < 4; ++r) { const int ii = mi * 16 + quad * 4 + r; aqk[ii * 72 + cidx] = f2bf((cidx <= ii) ? acc[r] * __expf(fminf(sc[64 + ii] - Gc, 0.f)) : 0.f); }
                    }
                } else if (which == 1) {
#pragma unroll
                    for (int r = 0; r < 4; ++r) aqk[(mi * 16 + quad * 4 + r) * 72 + ni * 16 + r16] = 0;
                }
            }
        }
        lds_barrier();
        {
            const int a = tid & 127, tq = tid >> 7;
#pragma unroll
            for (int q = 0; q < 2; ++q) { const int t0 = tq * 16 + q * 8; float v[8];
#pragma unroll
                for (int e = 0; e < 8; ++e) v[e] = bf2f(kb[(t0 + e) * 136 + a]);
                u32x4 w; w.x = cvt_pk_bf16(v[0], v[1]); w.y = cvt_pk_bf16(v[2], v[3]); w.z = cvt_pk_bf16(v[4], v[5]); w.w = cvt_pk_bf16(v[6], v[7]);
                *(u32x4*)(kbT + a * 72 + t0) = w;
#pragma unroll
                for (int e = 0; e < 8; ++e) v[e] *= sc[192 + t0 + e];
                w.x = cvt_pk_bf16(v[0], v[1]); w.y = cvt_pk_bf16(v[2], v[3]); w.z = cvt_pk_bf16(v[4], v[5]); w.w = cvt_pk_bf16(v[6], v[7]);
                *(u32x4*)(kdT + a * 72 + t0) = w; }
        }
        if (wave == 0) {
            const float* Lrow = Ld + quad * 320;
            float x[16];
#pragma unroll
            for (int i = 0; i < 16; ++i) { float s = (i == r16) ? 1.f : 0.f;
#pragma unroll
                for (int j = 0; j < i; ++j) s -= Lrow[i * 20 + j] * x[j];
                x[i] = s; }
#pragma unroll
            for (int i = 0; i < 16; ++i) Ti[(16 * quad + i) * 72 + 16 * quad + r16] = f2bf(x[i]);
            { u32x4 w0, w1; w0.x = cvt_pk_bf16(x[0], x[1]); w0.y = cvt_pk_bf16(x[2], x[3]); w0.z = cvt_pk_bf16(x[4], x[5]); w0.w = cvt_pk_bf16(x[6], x[7]);
              w1.x = cvt_pk_bf16(x[8], x[9]); w1.y = cvt_pk_bf16(x[10], x[11]); w1.z = cvt_pk_bf16(x[12], x[13]); w1.w = cvt_pk_bf16(x[14], x[15]);
              *(u32x4*)(TT + (16 * quad + r16) * 72 + 16 * quad) = w0; *(u32x4*)(TT + (16 * quad + r16) * 72 + 16 * quad + 8) = w1; }
            asm volatile("s_waitcnt lgkmcnt(0)" ::: "memory");
            tinv_block<1, 0>(Lb, Ti, TT, XT, r16, quad); tinv_block<2, 1>(Lb, Ti, TT, XT, r16, quad); tinv_block<3, 2>(Lb, Ti, TT, XT, r16, quad);
            tinv_block<2, 0>(Lb, Ti, TT, XT, r16, quad); tinv_block<3, 1>(Lb, Ti, TT, XT, r16, quad);
            tinv_block<3, 0>(Lb, Ti, TT, XT, r16, quad);
        }
        lds_barrier();
        {
            const int i = tid >> 3, t0 = (tid & 7) * 8; const bool low = (t0 >> 4) <= (i >> 4);
            const u32x4 raw = *(const u32x4*)(Ti + i * 72 + t0);
            float v[8] = {bflo(raw.x), bfhi(raw.x), bflo(raw.y), bfhi(raw.y), bflo(raw.z), bfhi(raw.z), bflo(raw.w), bfhi(raw.w)}; float tw[8], tu[8];
#pragma unroll
            for (int e = 0; e < 8; ++e) { const float be = sc[t0 + e]; tu[e] = low ? v[e] * be : 0.f; tw[e] = low ? v[e] * be * sc[128 + t0 + e] : 0.f; }
            u32x4 w; w.x = cvt_pk_bf16(tw[0], tw[1]); w.y = cvt_pk_bf16(tw[2], tw[3]); w.z = cvt_pk_bf16(tw[4], tw[5]); w.w = cvt_pk_bf16(tw[6], tw[7]);
            u32x4 u; u.x = cvt_pk_bf16(tu[0], tu[1]); u.y = cvt_pk_bf16(tu[2], tu[3]); u.z = cvt_pk_bf16(tu[4], tu[5]); u.w = cvt_pk_bf16(tu[6], tu[7]);
            *(u32x4*)(Ti + i * 72 + t0) = w; *(u32x4*)(TT + i * 72 + t0) = u;
        }
        lds_barrier();
#pragma unroll
        for (int pass = 0; pass < 2; ++pass) {
            const bf16_t* Aop = pass ? TT : Ti; const bf16_t* Bop = pass ? vbT : kbT; bf16_t* outT = pass ? uT : wT;
            f32x4 acc4[4];
#pragma unroll
            for (int mi = 0; mi < 4; ++mi) { f32x4 acc = {0.f, 0.f, 0.f, 0.f};
#pragma unroll
                for (int ks = 0; ks < 2; ++ks) acc = MFMA16(*(const bf16x8*)(Aop + (mi * 16 + r16) * 72 + ks * 32 + quad * 8), *(const bf16x8*)(Bop + (wave * 16 + r16) * 72 + ks * 32 + quad * 8), acc);
                acc4[mi] = acc; }
            if (pass == 1) lds_barrier();
#pragma unroll
            for (int mi = 0; mi < 4; ++mi) { u32x2 w; w.x = cvt_pk_bf16(acc4[mi][0], acc4[mi][1]); w.y = cvt_pk_bf16(acc4[mi][2], acc4[mi][3]); *(u32x2*)(outT + (wave * 16 + r16) * 72 + mi * 16 + quad * 4) = w; }
        }
        lds_barrier();
        {
#pragma unroll
            for (int i = 0; i < 24; ++i) {
                const int prod = (i < 8) ? 0 : (i < 16) ? 1 : (i < 20) ? 2 : 3;
                const int mi = (i < 8) ? i : (i < 16) ? (i - 8) : (i < 20) ? (i - 16) : (i - 20), ni = wave;
                const bf16_t* X = ((prod < 2) ? kdT : aqk) + (mi * 16 + r16) * 72 + quad * 8;
                const bf16_t* Y = ((prod & 1) ? uT : wT) + (ni * 16 + r16) * 72 + quad * 8;
                f32x4 acc = {0.f, 0.f, 0.f, 0.f};
                if (prod == 1) {
#pragma unroll
                    for (int ks = 0; ks < 2; ++ks) acc = MFMA16(*(const bf16x8*)(X + ks * 32), *(const bf16x8*)(Y + ks * 32), acc);
                    u32x2 w; w.x = cvt_pk_bf16(acc[0], acc[1]); w.y = cvt_pk_bf16(acc[2], acc[3]);
                    *(u32x2*)(Bg + (size_t)ci * 16384 + (ni * 16 + r16) * 128 + mi * 16 + quad * 4) = w;
                    continue;
                }
#pragma unroll
                for (int ks = 0; ks < 2; ++ks) acc = MFMA16(*(const bf16x8*)(Y + ks * 32), *(const bf16x8*)(X + ks * 32), acc);
                const int m = mi * 16 + r16, n0 = ni * 16 + quad * 4;
                if (prod == 0) acc = -acc;
                if (prod == 2) { const u32x2 qv = *(const u32x2*)(qb + m * 136 + n0); const float eg = sc[128 + m];
                    acc[0] = bflo(qv.x) * eg - acc[0]; acc[1] = bfhi(qv.x) * eg - acc[1]; acc[2] = bflo(qv.y) * eg - acc[2]; acc[3] = bfhi(qv.y) * eg - acc[3]; }
                bf16_t* outp = ((prod == 0) ? (Ag + (size_t)ci * 16384) : (prod == 2) ? (Qg + (size_t)ci * 8192) : (Og + (size_t)ci * 8192)) + m * 128 + n0;
                u32x2 w; w.x = cvt_pk_bf16(acc[0], acc[1]); w.y = cvt_pk_bf16(acc[2], acc[3]); *(u32x2*)outp = w;
            }
        }
        lds_barrier();
    }
}

DI void ph_gdn_p2(PK p, unsigned char* lds, const int wv) {
    PK_FRESH(p);
    const int tid = ltid(wv), lane = tid & 63, wave = __builtin_amdgcn_readfirstlane(tid >> 6), r16 = lane & 15, quad = lane >> 4, a0 = wave * 16;
    const bf16_t* Ag = WSP(const bf16_t, WS_GA); const bf16_t* Bg = WSP(const bf16_t, WS_GB); bf16_t* Sg = WSP(bf16_t, WS_GS); const float* glg = WSP(const float, WS_GL);
    bf16_t* ST = (bf16_t*)lds;
#define P2_LOAD(AF, BM, GL, cidx) do { const size_t c_ = (cidx); _Pragma("unroll") for (int ks = 0; ks < 4; ++ks) AF[ks] = *(const bf16x8*)(Ag + c_ * 16384 + (size_t)(a0 + r16) * 128 + ks * 32 + quad * 8); \
        BM = *(const u32x2*)(Bg + c_ * 16384 + (size_t)(v0 + r16) * 128 + a0 + quad * 4); GL = glg[c_]; } while (0)
    for (int item = blockIdx.x; item < 256; item += gridDim.x) {
        const int bh = (item & 7) * 4 + (item >> 6), v0 = ((item >> 3) & 7) * 16;
        const size_t cb = (size_t)bh * 128;
        f32x4 S = {0.f, 0.f, 0.f, 0.f};
        bf16x8 afA[4], afB[4], afC[4], afD[4]; u32x2 bmA, bmB, bmC, bmD; float glA, glB, glC, glD;
        P2_LOAD(afA, bmA, glA, cb); P2_LOAD(afB, bmB, glB, cb + 1); P2_LOAD(afC, bmC, glC, cb + 2);
#define P2_STEP(AFc, BMc, GLc, AFp, BMp, GLp, nn) do { const int n_ = (nn); const size_t ci = cb + n_; \
            P2_LOAD(AFp, BMp, GLp, cb + ((n_ + 3 < 128) ? n_ + 3 : 127));        \
            u32x2 sp; sp.x = cvt_pk_bf16(S[0], S[1]); sp.y = cvt_pk_bf16(S[2], S[3]); \
            bf16_t* STb = ST + (n_ & 1) * (16 * 136); \
            *(u32x2*)(STb + r16 * 136 + a0 + quad * 4) = sp; \
            *(u32x2*)(Sg + ci * 16384 + (size_t)(v0 + r16) * 128 + a0 + quad * 4) = sp; \
            lds_barrier(); \
            f32x4 acc; acc[0] = GLc * S[0] + bflo(BMc.x); acc[1] = GLc * S[1] + bfhi(BMc.x); acc[2] = GLc * S[2] + bflo(BMc.y); acc[3] = GLc * S[3] + bfhi(BMc.y); \
            bf16x8 bfr_[4]; _Pragma("unroll") for (int ks = 0; ks < 4; ++ks) bfr_[ks] = *(const bf16x8*)(STb + r16 * 136 + ks * 32 + quad * 8);        \
            _Pragma("unroll") for (int ks = 0; ks < 4; ++ks) acc = MFMA16(AFc[ks], bfr_[ks], acc); \
            S = acc; } while (0)
        for (int n = 0; n < 128; n += 4) {
            P2_STEP(afA, bmA, glA, afD, bmD, glD, n);
            P2_STEP(afB, bmB, glB, afA, bmA, glA, n + 1);
            P2_STEP(afC, bmC, glC, afB, bmB, glB, n + 2);
            P2_STEP(afD, bmD, glD, afC, bmC, glC, n + 3);
        }
#undef P2_STEP
        lds_barrier();
    }
#undef P2_LOAD
}

DI void ph_gdn_p3(PK p, int l, const int wv) {
    PK_FRESH(p);
    const int tid = ltid(wv), lane = tid & 63, wave = __builtin_amdgcn_readfirstlane(tid >> 6), r16 = lane & 15, quad = lane >> 4;
    const bf16_t* Qg = WSP(const bf16_t, WS_GQ); const bf16_t* Og = WSP(const bf16_t, WS_GO); const bf16_t* Sg = WSP(const bf16_t, WS_GS);
    const bf16_t* proj = WSP(const bf16_t, WS_PROJ); bf16_t* obuf = WSP(bf16_t, WS_OBUF); const float* ogain = p->in[11] + l * 128;
    for (int it = blockIdx.x; it < 2048; it += gridDim.x) {
        const int ci = it * 2 + (wave >> 2), mi = wave & 3;
        const int n = ci & 127, bh = ci >> 7, hd = bh & 15, b = bh >> 4;
        const int i = mi * 16 + r16; const size_t tok = (size_t)b * SEQ + n * 64 + i;
        bf16x8 qa[4], sf[4][8]; u32x2 ov[8], zv[8];
#pragma unroll
        for (int ks = 0; ks < 4; ++ks) { qa[ks] = *(const bf16x8*)(Qg + (size_t)ci * 8192 + i * 128 + ks * 32 + quad * 8);
#pragma unroll
            for (int ni = 0; ni < 8; ++ni) sf[ks][ni] = *(const bf16x8*)(Sg + (size_t)ci * 16384 + (ni * 16 + r16) * 128 + ks * 32 + quad * 8); }
#pragma unroll
        for (int ni = 0; ni < 8; ++ni) { ov[ni] = *(const u32x2*)(Og + (size_t)ci * 8192 + i * 128 + ni * 16 + quad * 4); zv[ni] = *(const u32x2*)(proj + tok * GINP + 6144 + hd * 128 + ni * 16 + quad * 4); }
        f32x4 acc[8];
#pragma unroll
        for (int ni = 0; ni < 8; ++ni) acc[ni] = (f32x4){0.f, 0.f, 0.f, 0.f};
#pragma unroll
        for (int ks = 0; ks < 4; ++ks)
#pragma unroll
            for (int ni = 0; ni < 8; ++ni) acc[ni] = MFMA16(sf[ks][ni], qa[ks], acc[ni]);
        float ss = 0.f;
#pragma unroll
        for (int ni = 0; ni < 8; ++ni) {
            acc[ni][0] += bflo(ov[ni].x); acc[ni][1] += bfhi(ov[ni].x); acc[ni][2] += bflo(ov[ni].y); acc[ni][3] += bfhi(ov[ni].y);
            ss += acc[ni][0] * acc[ni][0] + acc[ni][1] * acc[ni][1] + acc[ni][2] * acc[ni][2] + acc[ni][3] * acc[ni][3]; }
        ss += sw_xor<16>(ss); ss = sw_xor32_sum(ss);
        const float rms = rsqrtf(ss * (1.f / 128.f) + NORM_EPS);
#pragma unroll
        for (int ni = 0; ni < 8; ++ni) { const int v = ni * 16 + quad * 4; const f32x4 gv = *(const f32x4*)(ogain + v);
            const float y0 = acc[ni][0] * rms * gv[0] * silu_f(bflo(zv[ni].x)), y1 = acc[ni][1] * rms * gv[1] * silu_f(bfhi(zv[ni].x));
            const float y2 = acc[ni][2] * rms * gv[2] * silu_f(bflo(zv[ni].y)), y3 = acc[ni][3] * rms * gv[3] * silu_f(bfhi(zv[ni].y));
            u32x2 w; w.x = cvt_pk_bf16(y0, y1); w.y = cvt_pk_bf16(y2, y3); *(u32x2*)(obuf + tok * D + hd * 128 + v) = w; }
    }
}

DI void ph_rope(PK p, const bf16_t* src, int ld, bf16_t* dst, const int wv) {
    PK_FRESH(p);
    const int tid = ltid(wv); const float* cosT = WSP(const float, WS_COS); const float* sinT = WSP(const float, WS_SIN);
    for (int idx = blockIdx.x * 512 + tid; idx < T * 128; idx += gridDim.x * 512) {
        const int jc = idx & 7, hc = (idx >> 3) & 15, t = idx >> 7;
        const bf16_t* sp = src + (size_t)t * ld + hc * 128 + jc * 8;
        const u32x4 x1 = *(const u32x4*)sp, x2 = *(const u32x4*)(sp + 64);
        const f32x4 c0 = *(const f32x4*)(cosT + t * 64 + jc * 8), c1 = *(const f32x4*)(cosT + t * 64 + jc * 8 + 4);
        const f32x4 s0 = *(const f32x4*)(sinT + t * 64 + jc * 8), s1 = *(const f32x4*)(sinT + t * 64 + jc * 8 + 4);
        float a[8] = {bflo(x1.x), bfhi(x1.x), bflo(x1.y), bfhi(x1.y), bflo(x1.z), bfhi(x1.z), bflo(x1.w), bfhi(x1.w)};
        float bb[8] = {bflo(x2.x), bfhi(x2.x), bflo(x2.y), bfhi(x2.y), bflo(x2.z), bfhi(x2.z), bflo(x2.w), bfhi(x2.w)};
        float cs[8] = {c0[0], c0[1], c0[2], c0[3], c1[0], c1[1], c1[2], c1[3]}, sn[8] = {s0[0], s0[1], s0[2], s0[3], s1[0], s1[1], s1[2], s1[3]};
        float o1[8], o2[8];
#pragma unroll
        for (int e = 0; e < 8; ++e) { o1[e] = a[e] * cs[e] - bb[e] * sn[e]; o2[e] = bb[e] * cs[e] + a[e] * sn[e]; }
        const int b = t >> 13, s = t & 8191;
        bf16_t* dp = dst + ((size_t)(b * 16 + hc) * SEQ + s) * 128 + jc * 8;
        u32x4 w1, w2;
        w1.x = cvt_pk_bf16(o1[0], o1[1]); w1.y = cvt_pk_bf16(o1[2], o1[3]); w1.z = cvt_pk_bf16(o1[4], o1[5]); w1.w = cvt_pk_bf16(o1[6], o1[7]);
        w2.x = cvt_pk_bf16(o2[0], o2[1]); w2.y = cvt_pk_bf16(o2[2], o2[3]); w2.z = cvt_pk_bf16(o2[4], o2[5]); w2.w = cvt_pk_bf16(o2[6], o2[7]);
        *(u32x4*)dp = w1; *(u32x4*)(dp + 64) = w2;
    }
}
DI void ph_vrelayout(const bf16_t* src, bf16_t* dst, const int wv) {
    const int tid = ltid(wv);
    for (int idx = blockIdx.x * 512 + tid; idx < T * 256; idx += gridDim.x * 512) {
        const int ch = idx & 15, hc = (idx >> 4) & 15, t = idx >> 8; const int b = t >> 13, s = t & 8191;
        *(u32x4*)(dst + ((size_t)(b * 16 + hc) * SEQ + s) * 128 + ch * 8) = *(const u32x4*)(src + (size_t)t * 4096 + 2048 + hc * 128 + ch * 8);
    }
}

DI void ph_attn(PK p, unsigned char* lds, const int wv) {
    PK_FRESH(p);
    using att::bf16;
    const bf16* Qd = WSP(const bf16, WS_QD); const bf16* Ksh = WSP(const bf16, WS_KSH); const bf16* Vsh = WSP(const bf16, WS_VSH); bf16* Oat = WSP(bf16, WS_OAT);
    const int total = 64 * 16, stride = gridDim.x, W = SEQ;
    int L = blockIdx.x;
    if (L < total) {
        auto mkref = [&](int Li, int pass) {
            const int xcd = Li & 7, jk = Li >> 3, mm = (jk & 127) >> 4, x = jk & 15, h64 = xcd * 8 + mm, qb = pass ? (31 - x) : x;
            const int vh = h64 & 1, c = (h64 >> 1) & 1, bh = h64 >> 2;
            att::BlockRef<bf16, bf16> r;
            r.Q = Qd + ((size_t)(bh * 2 + c) * SEQ + (size_t)qb * 256) * 128;
            r.K = Ksh + (size_t)(bh * 2 + c) * SEQ * 128;
            r.V = Vsh + (size_t)(bh * 2 + vh) * SEQ * 128;
            r.O = Oat + ((size_t)((bh * 2 + c) * 2 + vh) * SEQ + (size_t)qb * 256) * 128;
            r.P0 = qb * 256; return r; };
        int pass = 0;
        att::BlockRef<bf16, bf16> cur = mkref(L, 0);
        att::Seam<bf16> S;
        att::causal_swa_prime<bf16, bf16>(cur, W, (char*)lds, S, wv);
        for (;;) {
            const bool more_pass = pass == 0, more_item = L + stride < total, last = !more_pass && !more_item;
            int passn = pass + 1, Ln = L;
            if (!more_pass) { passn = 0; Ln = more_item ? L + stride : L; }
            const att::BlockRef<bf16, bf16> nxt = last ? cur : mkref(Ln, passn);
            att::causal_swa_block<bf16, bf16>(cur, nxt, SEQ, W, (char*)lds, S, wv);
            if (last) break;
            cur = nxt; pass = passn; L = Ln;
        }
    }
    __syncthreads();
}

DI void ph_diff_combine(PK p, int j, int l, unsigned char* lds, const int wv) {
    PK_FRESH(p);
    const int tid = ltid(wv), lane = tid & 63, wave = __builtin_amdgcn_readfirstlane(tid >> 6);
    float* ldsf = (float*)lds;
    const float lambda_init = 0.8f - 0.6f * expf(-0.3f * (float)l);
    if (wave == 0) { const float* lp = p->in[18] + j * 512;
        float a = lp[lane] * lp[128 + lane] + lp[64 + lane] * lp[192 + lane], bsum = lp[256 + lane] * lp[384 + lane] + lp[320 + lane] * lp[448 + lane];
        a = wave_sum(a); bsum = wave_sum(bsum);
        if (lane == 0) ldsf[0] = expf(a) - expf(bsum) + lambda_init; }
    __syncthreads();
    const float lam = ldsf[0], om = 1.f - lambda_init;
    const bf16_t* Oat = WSP(const bf16_t, WS_OAT); bf16_t* obuf = WSP(bf16_t, WS_OBUF); const float* sg = p->in[19] + j * 256;
    for (int row = blockIdx.x * 8 + wave; row < T * 8; row += gridDim.x * 8) {
        const int t = row >> 3, h = row & 7, b = t >> 13, s = t & 8191, vh = lane >> 5, d = (lane & 31) * 4;
        const u32x2 o1 = *(const u32x2*)(Oat + ((size_t)(((b * 8 + h) * 2 + 0) * 2 + vh) * SEQ + s) * 128 + d);
        const u32x2 o2 = *(const u32x2*)(Oat + ((size_t)(((b * 8 + h) * 2 + 1) * 2 + vh) * SEQ + s) * 128 + d);
        float v[4] = {bflo(o1.x) - lam * bflo(o2.x), bfhi(o1.x) - lam * bfhi(o2.x), bflo(o1.y) - lam * bflo(o2.y), bfhi(o1.y) - lam * bfhi(o2.y)};
        float ss = v[0] * v[0] + v[1] * v[1] + v[2] * v[2] + v[3] * v[3];
        ss = wave_sum(ss);
        const float rms = rsqrtf(ss * (1.f / 256.f) + NORM_EPS) * om;
        const f32x4 gv = *(const f32x4*)(sg + vh * 128 + d);
        u32x2 w; w.x = cvt_pk_bf16(v[0] * rms * gv[0], v[1] * rms * gv[1]); w.y = cvt_pk_bf16(v[2] * rms * gv[2], v[3] * rms * gv[3]);
        *(u32x2*)(obuf + (size_t)t * D + h * 256 + vh * 128 + d) = w;
    }
    __syncthreads();
}

#define INS16(Lr, vv) do { _Pragma("unroll") for (int k_ = 0; k_ < 16; ++k_) { const float hi_ = fmaxf(Lr[k_], vv); vv = fminf(Lr[k_], vv); Lr[k_] = hi_; } } while (0)
DI void sort16_desc(float (&L)[16]) {
#pragma unroll
    for (int k = 2; k <= 16; k <<= 1)
#pragma unroll
        for (int j = k >> 1; j >= 1; j >>= 1)
#pragma unroll
            for (int i = 0; i < 16; ++i) { const int l = i ^ j;
                if (l > i) { const float hi_ = fmaxf(L[i], L[l]), lo_ = fminf(L[i], L[l]); const bool desc = (i & k) == 0; L[i] = desc ? hi_ : lo_; L[l] = desc ? lo_ : hi_; } }
}
template <int XM> DI void merge16(float (&L)[16]) {
    float P[16];
#pragma unroll
    for (int i = 0; i < 16; ++i) P[i] = sw_xor<XM>(L[15 - i]);
#pragma unroll
    for (int i = 0; i < 16; ++i) L[i] = fmaxf(L[i], P[i]);
#pragma unroll
    for (int s = 8; s >= 1; s >>= 1)
#pragma unroll
        for (int i = 0; i < 16; ++i) if ((i & s) == 0) { const float hi_ = fmaxf(L[i], L[i + s]), lo_ = fminf(L[i], L[i + s]); L[i] = hi_; L[i + s] = lo_; }
}
__constant__ unsigned kStairPk[16] = {0x20100800u, 0xffe07033u, 0x21110901u, 0xfff07140u, 0x22120a02u, 0xffff8041u, 0x23130b03u, 0xffff9042u, 0x24140c04u, 0xffffa050u, 0x30150d05u, 0xffffb051u, 0x31160e06u, 0xffffc060u, 0x32170f07u, 0xffffd061u};
DI void ph_peer_topk(PK p, int l, unsigned char* lds, const int wv) {
    PK_FRESH(p);
    const int tid = ltid(wv);
    float* tops = (float*)lds; float* fin = tops + 64 * 2 * 16;
    const bf16_t* pq = WSP(const bf16_t, WS_PQ);
    int* pidx = WSP(int, WS_PIDX); float* pgate = WSP(float, WS_PGATE);
    const float NEG = -__builtin_inff();
    const int rowl = tid >> 3, half = (tid >> 2) & 1, quarter = tid & 3, l8 = tid & 7;
    const int nitems = T * 8 / 64;
    const int lane = tid & 63, wave = __builtin_amdgcn_readfirstlane(tid >> 6);
    int crow = blockIdx.x * 8 + wave; const int cstep = gridDim.x * 8;
    const u32x2 stw = *(const u32x2*)(kStairPk + l8 * 2);
    u32x4 wn[4];
    if ((int)blockIdx.x < nitems) { const int row = blockIdx.x * 64 + rowl; const bf16_t* sp = pq + (size_t)(row >> 3) * 2048 + (row & 7) * 256 + half * 128 + quarter * 32;
#pragma unroll
        for (int c = 0; c < 4; ++c) wn[c] = *(const u32x4*)(sp + c * 8); }
    for (int item = blockIdx.x; item < nitems; item += gridDim.x) {
        const int row0 = item * 64;
        u32x4 wc[4];
#pragma unroll
        for (int c = 0; c < 4; ++c) wc[c] = wn[c];
        { const int itn = (item + (int)gridDim.x < nitems) ? item + (int)gridDim.x : item; const int row = itn * 64 + rowl;
          const bf16_t* sp = pq + (size_t)(row >> 3) * 2048 + (row & 7) * 256 + half * 128 + quarter * 32;
#pragma unroll
          for (int c = 0; c < 4; ++c) wn[c] = *(const u32x4*)(sp + c * 8); }
        f32x4 cv[8]; const bool cA = crow < 2 * 16384; if (cA) pc_load(p, l, crow, cv, lane);
        float Lr[16], Lq[16];
#pragma unroll
        for (int c = 0; c < 4; ++c)
#pragma unroll
            for (int e = 0; e < 4; ++e) { const unsigned w = wc[c][e];
                const float v0 = __uint_as_float((w << 16) | (unsigned)(quarter * 32 + c * 8 + e * 2)), v1 = __uint_as_float((w & 0xffff0000u) | (unsigned)(quarter * 32 + c * 8 + e * 2 + 1));
                if (c < 2) { Lr[c * 8 + e * 2] = v0; Lr[c * 8 + e * 2 + 1] = v1; } else { Lq[(c - 2) * 8 + e * 2] = v0; Lq[(c - 2) * 8 + e * 2 + 1] = v1; } }
        sort16_desc(Lr); sort16_desc(Lq);
#pragma unroll
        for (int i = 0; i < 16; ++i) Lr[i] = fmaxf(Lr[i], Lq[15 - i]);
#pragma unroll
        for (int s = 8; s >= 1; s >>= 1)
#pragma unroll
            for (int i = 0; i < 16; ++i) if ((i & s) == 0) { const float hi_ = fmaxf(Lr[i], Lr[i + s]), lo_ = fminf(Lr[i], Lr[i + s]); Lr[i] = hi_; Lr[i + s] = lo_; }
        if (cA) { pc_store(p, crow, cv, lane); crow += cstep; }
        const bool cB = crow < 2 * 16384; if (cB) pc_load(p, l, crow, cv, lane);
        merge16<1>(Lr); merge16<2>(Lr);
        if (quarter == 0) {
#pragma unroll
            for (int k = 0; k < 16; ++k) tops[(rowl * 2 + half) * 16 + k] = Lr[k];
        }
        asm volatile("s_waitcnt lgkmcnt(0)" ::: "memory");
        float M[16];
#pragma unroll
        for (int k = 0; k < 16; ++k) M[k] = NEG;
        {
            const float* ta = tops + (rowl * 2) * 16; const float* tb = ta + 16;
#pragma unroll
            for (int m = 0; m < 7; ++m) { const unsigned code = (((m < 4) ? stw.x : stw.y) >> (8 * (m & 3))) & 255u;
                float s = (code < 255u) ? ta[code >> 4] + tb[code & 15u] : NEG;
                s = (code < 255u) ? __uint_as_float((__float_as_uint(s) & ~255u) | code) : NEG; INS16(M, s); }
        }
        merge16<1>(M); merge16<2>(M); merge16<4>(M);
        float sum = 0.f;
#pragma unroll
        for (int k = 0; k < 16; ++k) sum += __expf(M[k] - M[0]);
        if (l8 == 0) {
#pragma unroll
            for (int k = 0; k < 16; ++k) fin[rowl * 16 + k] = M[k];
        }
        asm volatile("s_waitcnt lgkmcnt(0)" ::: "memory");
        {
            const float inv = 1.f / sum, m0 = M[0]; const int row = row0 + rowl; const size_t ob = (size_t)(row >> 3) * 128 + (row & 7) * 16;
#pragma unroll
            for (int u = 0; u < 2; ++u) { const int k = l8 * 2 + u; const float mk = fin[rowl * 16 + k]; const unsigned code = __float_as_uint(mk) & 255u;
                const unsigned i1 = __float_as_uint(tops[(rowl * 2) * 16 + (code >> 4)]) & 127u, i2 = __float_as_uint(tops[(rowl * 2 + 1) * 16 + (code & 15u)]) & 127u;
                pidx[ob + k] = (int)(i1 * 128u + i2); pgate[ob + k] = __expf(mk - m0) * inv; }
        }
        if (cB) { pc_store(p, crow, cv, lane); crow += cstep; }
        asm volatile("s_waitcnt lgkmcnt(0)" ::: "memory");
    }
    for (; crow < 2 * 16384; crow += cstep) { f32x4 cv[8]; pc_load(p, l, crow, cv, lane); pc_store(p, crow, cv, lane); }
}

DI float gelu_f(float v) {
    const float av = fabsf(v), t = __builtin_amdgcn_rcpf(fmaf(av, 0.2316418882f, 1.0f));
    float q = fmaf(t, 0.5307027145f, -0.7265760135f); q = fmaf(q, t, 0.7107068705f); q = fmaf(q, t, -0.142248368f); q = fmaf(q, t, 0.127414796f); q = q * t;
    const float e = __builtin_amdgcn_exp2f(v * v * -0.72134752044f), m = v * (q * e);
    return v < 0.f ? m : v - m;
}
#define FP4X8(w, o) const f32x2 o##0 = __builtin_amdgcn_cvt_scalef32_pk_f32_fp4(w, 1.0f, 0), o##1 = __builtin_amdgcn_cvt_scalef32_pk_f32_fp4(w, 1.0f, 1), \
                                o##2 = __builtin_amdgcn_cvt_scalef32_pk_f32_fp4(w, 1.0f, 2), o##3 = __builtin_amdgcn_cvt_scalef32_pk_f32_fp4(w, 1.0f, 3)
DI void ph_peer_gather(PK p, int l, unsigned char* lds, const int wv, const bool apply = true) {
    PK_FRESH(p);
    const int tid = ltid(wv), lane = tid & 63, wave = __builtin_amdgcn_readfirstlane(tid >> 6);
    const bf16_t* hb = WSP(const bf16_t, WS_HBUF); const unsigned char* ub = WSP(const unsigned char, WS_PU); const unsigned char* vb = WSP(const unsigned char, WS_PV);
    const unsigned char* psc8 = WSP(const unsigned char, WS_PUS);
    const int* pidx = WSP(const int, WS_PIDX); const float* pgate = WSP(const float, WS_PGATE); bf16_t* xc = WSP(bf16_t, WS_XCUR);
    const float* gt2 = WSP(const float, WS_MOD) + l * 12288 + 5 * 2048;
    const unsigned l16 = (unsigned)lane * 16u, l2 = (unsigned)(lane >> 2) * 4u;
    for (int tok = blockIdx.x * 8 + wave; tok < T; tok += gridDim.x * 8) {
        f32x2 hf2[16];
#pragma unroll
        for (int c = 0; c < 4; ++c) { const u32x4 w = *(const u32x4*)(hb + (size_t)tok * D + lane * 32 + c * 8);
            hf2[c * 4 + 0] = (f32x2){bflo(w.x), bfhi(w.x)}; hf2[c * 4 + 1] = (f32x2){bflo(w.y), bfhi(w.y)}; hf2[c * 4 + 2] = (f32x2){bflo(w.z), bfhi(w.z)}; hf2[c * 4 + 3] = (f32x2){bflo(w.w), bfhi(w.w)}; }
        f32x2 acc2[16];
#pragma unroll
        for (int i = 0; i < 16; ++i) acc2[i] = (f32x2){0.f, 0.f};
        u32x2* sraw = (u32x2*)(lds + wave * 2048); u32x2* ssrt = sraw + 128;
        {
            const unsigned k0 = (unsigned)pidx[(size_t)tok * 128 + lane], k1 = (unsigned)pidx[(size_t)tok * 128 + 64 + lane];
            const float g0 = pgate[(size_t)tok * 128 + lane], g1 = pgate[(size_t)tok * 128 + 64 + lane];
            sraw[lane] = (u32x2){k0, __float_as_uint(g0)}; sraw[64 + lane] = (u32x2){k1, __float_as_uint(g1)};
            asm volatile("s_waitcnt lgkmcnt(0)" ::: "memory");
            const unsigned key0 = k0 * 128u + (unsigned)lane, key1 = k1 * 128u + 64u + (unsigned)lane; unsigned r0 = 0, r1 = 0;
            for (int j = 0; j < 128; ++j) { const unsigned kj = sraw[j].x * 128u + (unsigned)j; r0 += (kj < key0) ? 1u : 0u; r1 += (kj < key1) ? 1u : 0u; }
            ssrt[r0] = (u32x2){k0, __float_as_uint(g0)}; ssrt[r1] = (u32x2){k1, __float_as_uint(g1)};
            asm volatile("s_waitcnt lgkmcnt(0)" ::: "memory");
        }
#define G_LOAD(gi, UR, VR, US, GT) do { _Pragma("unroll") for (int q = 0; q < 4; ++q) { const u32x2 pr = ssrt[(gi) * 4 + q]; const unsigned e_ = (unsigned)__builtin_amdgcn_readfirstlane((int)pr.x); GT[q] = __uint_as_float(pr.y); \
            UR[q] = *(const u32x4*)(ub + (size_t)e_ * 1024 + l16); US[q] = *(const unsigned*)(psc8 + (size_t)e_ * 64 + l2); \
            VR[q] = *(const u32x4*)(vb + (size_t)e_ * 1024 + l16); } } while (0)
#define G_COMP(UR, VR, US, GT) do { float cf[4]; \
            _Pragma("unroll") for (int q = 0; q < 4; ++q) { f32x2 t2 = {0.f, 0.f}, t3 = {0.f, 0.f}; \
                _Pragma("unroll") for (int c = 0; c < 4; ++c) { FP4X8(UR[q][c], a); \
                    t2 = a0 * hf2[c * 4 + 0] + t2; t3 = a1 * hf2[c * 4 + 1] + t3; t2 = a2 * hf2[c * 4 + 2] + t2; t3 = a3 * hf2[c * 4 + 3] + t3; } \
                t2 = t2 + t3; \
                const float d = wave_sum((t2.x + t2.y) * __uint_as_float(US[q] << 16)); \
                cf[q] = GT[q] * gelu_f(d); } \
            _Pragma("unroll") for (int q = 0; q < 4; ++q) { const float cs = cf[q] * __uint_as_float(US[q] & 0xffff0000u); const f32x2 cs2 = {cs, cs}; \
                _Pragma("unroll") for (int c = 0; c < 4; ++c) { FP4X8(VR[q][c], b); \
                    acc2[c * 4 + 0] = cs2 * b0 + acc2[c * 4 + 0]; acc2[c * 4 + 1] = cs2 * b1 + acc2[c * 4 + 1]; acc2[c * 4 + 2] = cs2 * b2 + acc2[c * 4 + 2]; acc2[c * 4 + 3] = cs2 * b3 + acc2[c * 4 + 3]; } } } while (0)
        {
            u32x4 urA[4], vrA[4], urB[4], vrB[4]; unsigned usA[4], usB[4]; float gtA[4], gtB[4];
            G_LOAD(0, urA, vrA, usA, gtA);
            for (int g = 0; g < 32; g += 2) {
                G_LOAD(g + 1, urB, vrB, usB, gtB);
                G_COMP(urA, vrA, usA, gtA);
                G_LOAD((g + 2 < 32) ? g + 2 : 31, urA, vrA, usA, gtA);
                G_COMP(urB, vrB, usB, gtB);
            }
        }
#undef G_LOAD
#undef G_COMP
        float acc[32];
#pragma unroll
        for (int i = 0; i < 16; ++i) { acc[2 * i] = acc2[i].x; acc[2 * i + 1] = acc2[i].y; }
        if (!apply) { if (p->ph_hi == -12345) { for (int i = 0; i < 32; ++i) xc[i * 64 + lane] = f2bf(acc[i]); } continue; }
        const int b = tok >> 13; const float gm = ((MK_SKIP >> (2 * l + 1)) & 1) ? 0.f : 1.f;
        float ss = 0.f;
#pragma unroll
        for (int c = 0; c < 4; ++c) { const int col = lane * 32 + c * 8; bf16_t* xp = xc + (size_t)tok * D + col;
            const u32x4 xb = *(const u32x4*)xp; const f32x4 g0 = *(const f32x4*)(gt2 + (size_t)b * MODC + col), g1 = *(const f32x4*)(gt2 + (size_t)b * MODC + col + 4);
            const float x8[8] = {bflo(xb.x), bfhi(xb.x), bflo(xb.y), bfhi(xb.y), bflo(xb.z), bfhi(xb.z), bflo(xb.w), bfhi(xb.w)}; float y8[8];
#pragma unroll
            for (int e2 = 0; e2 < 8; ++e2) { y8[e2] = x8[e2] + gm * ((e2 < 4) ? g0[e2] : g1[e2 - 4]) * acc[c * 8 + e2]; acc[c * 8 + e2] = y8[e2]; ss += y8[e2] * y8[e2]; }
            if (l < 3) { u32x4 w; w.x = cvt_pk_bf16(y8[0], y8[1]); w.y = cvt_pk_bf16(y8[2], y8[3]); w.z = cvt_pk_bf16(y8[4], y8[5]); w.w = cvt_pk_bf16(y8[6], y8[7]); *(u32x4*)xp = w; } }
        const float rn = rsqrtf(wave_sum(ss) * (1.f / D) + NORM_EPS);
        const float* modall = WSP(const float, WS_MOD) + (size_t)b * MODC;
        if (l == 3) {
#pragma unroll
            for (int c = 0; c < 8; ++c) { const int col = lane * 32 + c * 4; const f32x4 gv = *(const f32x4*)(p->in[25] + col); f32x4 o;
#pragma unroll
                for (int e2 = 0; e2 < 4; ++e2) o[e2] = acc[c * 4 + e2] * rn * gv[e2];
                *(f32x4*)(p->out + (size_t)tok * D + col) = o; }
        } else {
            const float* g1 = (l == 1) ? p->in[13] : (p->in[5] + (l + 1) * D);
            const float* sh1 = (l == 1) ? (modall + 4 * 12288) : (modall + (l + 1) * 12288);
            const float* sc1 = sh1 + D;
            bf16_t* d1 = WSP(bf16_t, WS_HBUF) + (size_t)tok * D;
#pragma unroll
            for (int c = 0; c < 4; ++c) { u32x4 w;
#pragma unroll
                for (int hh = 0; hh < 2; ++hh) { const int col = lane * 32 + c * 8 + hh * 4; const f32x4 gv = *(const f32x4*)(g1 + col), sv = *(const f32x4*)(sh1 + col), cv = *(const f32x4*)(sc1 + col); float o[4];
#pragma unroll
                    for (int e2 = 0; e2 < 4; ++e2) o[e2] = acc[c * 8 + hh * 4 + e2] * rn * gv[e2] * (1.f + cv[e2]) + sv[e2];
                    w[hh * 2] = cvt_pk_bf16(o[0], o[1]); w[hh * 2 + 1] = cvt_pk_bf16(o[2], o[3]); }
                *(u32x4*)(d1 + lane * 32 + c * 8) = w; }
            if (l == 1) {
                const float* g2 = p->in[5] + 2 * D; const float* sh2 = modall + 2 * 12288; const float* sc2 = sh2 + D;
                bf16_t* d2 = WSP(bf16_t, WS_OBUF) + (size_t)tok * D;
#pragma unroll
                for (int c = 0; c < 4; ++c) { u32x4 w;
#pragma unroll
                    for (int hh = 0; hh < 2; ++hh) { const int col = lane * 32 + c * 8 + hh * 4; const f32x4 gv = *(const f32x4*)(g2 + col), sv = *(const f32x4*)(sh2 + col), cv = *(const f32x4*)(sc2 + col); float o[4];
#pragma unroll
                        for (int e2 = 0; e2 < 4; ++e2) o[e2] = acc[c * 8 + hh * 4 + e2] * rn * gv[e2] * (1.f + cv[e2]) + sv[e2];
                        w[hh * 2] = cvt_pk_bf16(o[0], o[1]); w[hh * 2 + 1] = cvt_pk_bf16(o[2], o[3]); }
                    *(u32x4*)(d2 + lane * 32 + c * 8) = w; }
            }
        }
    }
}
#undef FP4X8

DI void ph_dbg(PK p, int mode, const int wv) {
    PK_FRESH(p);
    const int tid = ltid(wv);
    const bf16_t* Ag = WSP(const bf16_t, WS_GA); const bf16_t* Bg = WSP(const bf16_t, WS_GB); const bf16_t* Qg = WSP(const bf16_t, WS_GQ); const bf16_t* Og = WSP(const bf16_t, WS_GO); const bf16_t* Sg = WSP(const bf16_t, WS_GS);
    const bf16_t* proj = WSP(const bf16_t, WS_PROJ); bf16_t* obuf = WSP(bf16_t, WS_OBUF);
    for (int idx = blockIdx.x * 512 + tid; idx < T * D; idx += gridDim.x * 512) {
        const int tok = idx >> 11, col = idx & 2047, hd = col >> 7, v = col & 127, b = tok >> 13, s = tok & 8191, n = s >> 6, i = s & 63;
        const size_t ci = (size_t)(b * 16 + hd) * 128 + n;
        float r = 0.f;
        if (mode == 1) r = bf2f(Og[ci * 8192 + i * 128 + v]) + bf2f(Qg[ci * 8192 + i * 128 + v]);
        if (mode == 2) r = bf2f(Ag[ci * 16384 + i * 128 + v]) + bf2f(Bg[ci * 16384 + (i + 64) * 128 + v]) + bf2f(Ag[ci * 16384 + (i + 64) * 128 + v]) + bf2f(Bg[ci * 16384 + i * 128 + v]);
        if (mode == 3) r = bf2f(Sg[ci * 16384 + i * 128 + v]) + bf2f(Sg[ci * 16384 + (i + 64) * 128 + v]);
        if (mode == 4) r = bf2f(proj[(size_t)tok * GINP + col]) + bf2f(proj[(size_t)tok * GINP + 2048 + col]) + bf2f(proj[(size_t)tok * GINP + 4096 + col]) + bf2f(proj[(size_t)tok * GINP + 6144 + col]) + ((col < 256) ? bf2f(proj[(size_t)tok * GINP + 8192 + col]) : 0.f);
        obuf[idx] = f2bf(r);
    }
}
#ifndef MK_AOUT
#define MK_AOUT obuf
#endif
constexpr int NPHASES = 1 + 1 + 2 * 9 + 2 * 8 + 1;

__global__ void __launch_bounds__(512, 2) mk_fwd(Params p_arg) {
    extern __shared__ __attribute__((aligned(16))) unsigned char lds[];
    PK p = (PK)__builtin_amdgcn_kernarg_segment_ptr();
    const int lo = p->ph_lo, hi = p->ph_hi;
    const int wv = __builtin_amdgcn_readfirstlane((int)threadIdx.x >> 6);
    volatile LAS unsigned* st = (volatile LAS unsigned*)((LAS unsigned char*)lds + LDS_BARW);
    if (wv == 0 && lane_id() == 0) { st[0] = 0u; st[1] = 0u; }
    __syncthreads();
    XcdBarrier bar; bar.bar = (unsigned*)(p->ws + WS_BAR); bar.x = 0; bar.st = st; bar.wv = wv;
    if (hi - lo > 1) bar = xcd_barrier_post((unsigned*)(p->ws + WS_BAR), st, wv);
    int ph = 0;
#define PH_BEGIN if (lo <= ph && ph < hi) { PK_FRESH(p);
#define PH_END   if (ph + 1 < hi) xcd_barrier(bar); } ++ph;
#define mod  WSP(const float, WS_MOD)
#define xcur WSP(bf16_t, WS_XCUR)
#define hbuf WSP(bf16_t, WS_HBUF)
#define obuf WSP(bf16_t, WS_OBUF)
#define G    ((int)gridDim.x)
#define bx   ((int)blockIdx.x)
#define modl (mod + l * 12288)

    PH_BEGIN ph_prologue(p, lds, wv); if (MK_DUP & 1) { __syncthreads(); ph_prologue(p, lds, wv); } PH_END

    for (int l = 0; l < DEPTH; ++l) {
        if (l == 0) { PH_BEGIN ph_norm<0>(p->in[0], nullptr, p->in[5], modl + 0 * D, modl + 1 * D, hbuf, nullptr, wv); PH_END }
        PH_BEGIN
            pg8::Gemm g; pg8::EpiMk E; E.mode = 0; E.xin = nullptr; E.xinb = nullptr; E.xout = nullptr; E.gate = nullptr; E.gmul = 1.f; E.xoutf = nullptr; E.O2 = nullptr; E.nrope = 0; E.cosT = WSP(const float, WS_COS); E.sinT = WSP(const float, WS_SIN);
            g.A = (l == 2) ? obuf : hbuf; g.M = T; g.K = D; g.ld = D; g.ksplit = 0;
            if (l < 2) { g.Bt = WSP(const bf16_t, WS_WIN) + (size_t)l * GINP * D; g.N = 8192; E.O = WSP(bf16_t, WS_PROJ); E.ldc = GINP; }
            else { g.Bt = WSP(const bf16_t, WS_DWQ) + (size_t)(l - 2) * D * D; g.N = D; E.mode = 2; E.O = WSP(bf16_t, WS_QD); E.nrope = D; }
            pg8::StaticOrder S; S.init(g.M, g.N, G, bx);
            pg8::gemm_phase<pg8::EpiMk, pg8::StaticOrder>((PG8_LAS unsigned char*)lds, g, S, E, wv);
            if (MK_DUP & 2) { __syncthreads(); pg8::gemm_phase<pg8::EpiMk, pg8::StaticOrder>((PG8_LAS unsigned char*)lds, g, S, E, wv); }
            if (l < 2) {
                pg8::Gemm g2; g2.A = hbuf; g2.Bt = WSP(const bf16_t, WS_WIN) + (size_t)l * GINP * D + (size_t)8192 * D; g2.M = T; g2.N = 1024; g2.K = 512; g2.ld = D; g2.ksplit = 1;
                pg8::EpiMk E2 = E; E2.mode = 3; E2.xoutf = WSP(float, WS_PAB);
                pg8::StaticOrder S2; S2.init(g2.M, g2.N, G, bx);
                pg8::gemm_phase<pg8::EpiMk, pg8::StaticOrder>((PG8_LAS unsigned char*)lds, g2, S2, E2, wv);
            }
        PH_END
        if (l < 2) {
            PH_BEGIN ph_gdn_p1(p, l, lds, wv); if (MK_DUP & 8) { __syncthreads(); ph_gdn_p1(p, l, lds, wv); } PH_END
            PH_BEGIN ph_gdn_p2(p, lds, wv); if (MK_DUP & 16) { __syncthreads(); ph_gdn_p2(p, lds, wv); } PH_END
#ifdef MK_DBG
            PH_BEGIN ph_dbg(p, MK_DBG, wv); PH_END
#else
            PH_BEGIN ph_gdn_p3(p, l, wv); if (MK_DUP & 32) { __syncthreads(); ph_gdn_p3(p, l, wv); } PH_END
#endif
        } else {
            PH_BEGIN ph_attn(p, lds, wv); if (MK_DUP & 64) { __syncthreads(); ph_attn(p, lds, wv); } PH_END
            PH_BEGIN ph_diff_combine(p, l - 2, l, lds, wv); PH_END
        }
        PH_BEGIN
            pg8::Gemm g; pg8::EpiMk E; E.mode = 1; E.O = nullptr; E.ldc = 0; E.xoutf = nullptr; E.O2 = nullptr; E.nrope = 0; E.cosT = nullptr; E.sinT = nullptr; E.xin = (l == 0) ? p->in[0] : nullptr; E.xinb = xcur; E.xout = xcur; E.gate = modl + 2 * D; E.gmul = ((MK_SKIP >> (2 * l)) & 1) ? 0.f : 1.f;
            g.A = MK_AOUT; g.M = T; g.K = D; g.N = D; g.ld = D; g.ksplit = 0;
            g.Bt = (l < 2) ? (WSP(const bf16_t, WS_WOUT) + (size_t)l * D * D) : (WSP(const bf16_t, WS_DWO) + (size_t)(l - 2) * D * D);
            pg8::StaticOrder S; S.init(g.M, g.N, G, bx);
            pg8::gemm_phase<pg8::EpiMk, pg8::StaticOrder>((PG8_LAS unsigned char*)lds, g, S, E, wv);
        PH_END
        PH_BEGIN ph_norm<2>(nullptr, xcur, p->in[6] + l * D, modl + 3 * D, modl + 4 * D, hbuf, nullptr, wv); PH_END
        PH_BEGIN
            pg8::Gemm g; pg8::EpiMk E; E.mode = 0; E.xin = nullptr; E.xinb = nullptr; E.xout = nullptr; E.gate = nullptr; E.gmul = 1.f; E.xoutf = nullptr; E.O2 = nullptr; E.nrope = 0; E.cosT = WSP(const float, WS_COS); E.sinT = WSP(const float, WS_SIN); E.O = WSP(bf16_t, WS_PQ); E.ldc = D;
            g.A = hbuf; g.M = T; g.K = D; g.N = D; g.ld = D; g.ksplit = 0; g.Bt = WSP(const bf16_t, WS_PWQ) + (size_t)l * D * D;
            pg8::StaticOrder S; S.init(g.M, g.N, G, bx);
            pg8::gemm_phase<pg8::EpiMk, pg8::StaticOrder>((PG8_LAS unsigned char*)lds, g, S, E, wv);
        PH_END
        PH_BEGIN ph_peer_topk(p, l, lds, wv); if (MK_DUP & 128) { __syncthreads(); ph_peer_topk(p, l, lds, wv); } PH_END
        PH_BEGIN ph_peer_gather(p, l, lds, wv); if (MK_DUP & 256) { __syncthreads(); ph_peer_gather(p, l, lds, wv, false); } PH_END
        if (l == 1) {
            PH_BEGIN
                pg8::Gemm g; pg8::EpiMk E; E.mode = 0; E.xin = nullptr; E.xinb = nullptr; E.xout = nullptr; E.gate = nullptr; E.gmul = 1.f; E.xoutf = nullptr; E.O2 = nullptr; E.nrope = 0; E.cosT = WSP(const float, WS_COS); E.sinT = WSP(const float, WS_SIN); E.mode = 2; E.O = WSP(bf16_t, WS_KSH); E.O2 = WSP(bf16_t, WS_VSH); E.nrope = 2048;
                g.A = hbuf; g.M = T; g.K = D; g.N = 4096; g.ld = D; g.ksplit = 0; g.Bt = WSP(const bf16_t, WS_KVW);
                pg8::StaticOrder S; S.init(g.M, g.N, G, bx);
                pg8::gemm_phase<pg8::EpiMk, pg8::StaticOrder>((PG8_LAS unsigned char*)lds, g, S, E, wv);
            PH_END
        }
    }
#undef PH_BEGIN
#undef PH_END
#undef mod
#undef xcur
#undef hbuf
#undef obuf
#undef G
#undef bx
#undef modl
}

extern "C" void kernel_launch(void* const* d_in, const int* in_sizes, int n_in, void* d_out, int out_size, void* d_ws, size_t ws_size, hipStream_t stream) {
    static int grid = 0;
    if (grid == 0) {
        if (n_in != 26 || in_sizes[0] != T * D || out_size != T * D || ws_size < WS_END) {
            fprintf(stderr, "kernel_launch: unexpected shapes: n_in %d in0 %d out %d ws %zu (need %zu)\n", n_in, n_in > 0 ? in_sizes[0] : -1, out_size, ws_size, (size_t)WS_END); grid = -1; return; }
        int dev = 0, cus = 0;
        if (hipGetDevice(&dev) != hipSuccess || hipDeviceGetAttribute(&cus, hipDeviceAttributeMultiprocessorCount, dev) != hipSuccess || cus <= 0) cus = 256;
        if (hipFuncSetAttribute((const void*)mk_fwd, hipFuncAttributeMaxDynamicSharedMemorySize, LDS_BYTES) != hipSuccess) { fprintf(stderr, "kernel_launch: hipFuncSetAttribute failed\n"); grid = -1; return; }
        int per_cu = 0;
        if (hipOccupancyMaxActiveBlocksPerMultiprocessor(&per_cu, (const void*)mk_fwd, 512, LDS_BYTES) != hipSuccess || per_cu < 1) fprintf(stderr, "kernel_launch: occupancy query says %d\n", per_cu);
        (void)hipGetLastError();
        grid = cus;
    }
    if (grid < 0) return;
    (void)hipMemsetAsync((char*)d_ws + WS_BAR, 0, 16384, stream);
    Params p{};
    for (int i = 0; i < 26; ++i) p.in[i] = (const float*)d_in[i];
    p.out = (float*)d_out; p.ws = (unsigned char*)d_ws;
#if MK_N_LAUNCHES == 1
    p.ph_lo = 0; p.ph_hi = NPHASES;
    hipLaunchKernelGGL(mk_fwd, dim3(grid), dim3(512), LDS_BYTES, stream, p);
#else
#ifndef MK_PHMASK
#define MK_PHMASK 0xffffffffu
#endif
#ifndef MK_STOP
#define MK_STOP NPHASES
#endif
    for (int ph = 0; ph < NPHASES; ++ph) { if (ph >= MK_STOP && ph != NPHASES - 1) continue; if (!(MK_PHMASK >> (ph < 31 ? ph : 31) & 1u) && ph != NPHASES - 1) continue; p.ph_lo = ph; p.ph_hi = ph + 1; hipLaunchKernelGGL(mk_fwd, dim3(grid), dim3(512), LDS_BYTES, stream, p); }
#endif
    const hipError_t le = hipPeekAtLastError();
    if (le != hipSuccess) fprintf(stderr, "kernel_launch: launch failed: %s\n", hipGetErrorName(le));
}
```

```cpp
#include <hip/hip_runtime.h>
#include <hip/hip_bf16.h>
#include <cstdio>
#include <cstdint>

#ifndef MK_N_LAUNCHES
#define MK_N_LAUNCHES 1
#endif
#ifndef MK_DUP
#define MK_DUP 0
#endif
#ifndef MK_SKIP
#define MK_SKIP 0
#endif

constexpr int NB = 2, SEQ = 8192, T = NB * SEQ, D = 2048, DEPTH = 4;
constexpr int GH = 16, GIN = 8224, GINP = 8448;
constexpr int MODC = 4 * 12288 + 4096;
constexpr float NORM_EPS = 1e-6f;

typedef unsigned short bf16_t;
typedef short bf16x8 __attribute__((ext_vector_type(8)));
typedef short s16x4 __attribute__((ext_vector_type(4)));
typedef float f32x4 __attribute__((ext_vector_type(4)));
typedef float f32x2 __attribute__((ext_vector_type(2)));
typedef float f32x16 __attribute__((ext_vector_type(16)));
typedef unsigned u32x4 __attribute__((ext_vector_type(4)));
typedef unsigned u32x2 __attribute__((ext_vector_type(2)));
typedef __bf16 bfx2 __attribute__((ext_vector_type(2)));
#define LAS __attribute__((address_space(3)))
#define DI __device__ __forceinline__

DI float bf2f(bf16_t v) { return __uint_as_float(((unsigned)v) << 16); }
DI float bflo(unsigned w) { return __uint_as_float(w << 16); }
DI float bfhi(unsigned w) { return __uint_as_float(w & 0xffff0000u); }
DI bf16_t f2bf(float f) { unsigned u = __float_as_uint(f); u += 0x7FFFu + ((u >> 16) & 1u); return (bf16_t)(u >> 16); }
DI unsigned cvt_pk_bf16(float lo, float hi) { const f32x2 v = {lo, hi}; return __builtin_bit_cast(unsigned, __builtin_convertvector(v, bfx2)); }
template <int M> DI float sw_xor(float v) { return __int_as_float(__builtin_amdgcn_ds_swizzle(__float_as_int(v), (M << 10) | 0x1f)); }
DI float sw_xor32_sum(float v) { auto rr = __builtin_amdgcn_permlane32_swap(__float_as_uint(v), __float_as_uint(v), false, false); return __uint_as_float(rr[0]) + __uint_as_float(rr[1]); }
DI float wave_max(float v) {
    v = fmaxf(v, sw_xor<1>(v)); v = fmaxf(v, sw_xor<2>(v)); v = fmaxf(v, sw_xor<4>(v)); v = fmaxf(v, sw_xor<8>(v)); v = fmaxf(v, sw_xor<16>(v));
    auto rr = __builtin_amdgcn_permlane32_swap(__float_as_uint(v), __float_as_uint(v), false, false); return fmaxf(__uint_as_float(rr[0]), __uint_as_float(rr[1]));
}
DI float wave_sum(float v) {
    v += sw_xor<1>(v); v += sw_xor<2>(v); v += sw_xor<4>(v); v += sw_xor<8>(v); v += sw_xor<16>(v);
    return sw_xor32_sum(v);
}
template <int CTRL, int RMASK> DI float dpp_mov(float v) { return __int_as_float(__builtin_amdgcn_update_dpp(0, __float_as_int(v), CTRL, RMASK, 0xF, false)); }
DI float wave_sum_dpp(float v) {
    v += dpp_mov<0xB1, 0xF>(v); v += dpp_mov<0x4E, 0xF>(v); v += dpp_mov<0x141, 0xF>(v); v += dpp_mov<0x140, 0xF>(v);
    v += dpp_mov<0x142, 0xA>(v); v += dpp_mov<0x143, 0xC>(v);
    return __int_as_float(__builtin_amdgcn_readlane(__float_as_int(v), 63));
}
DI void lds_barrier() { asm volatile("s_waitcnt lgkmcnt(0)" ::: "memory"); __builtin_amdgcn_s_barrier(); asm volatile("" ::: "memory"); }
DI float silu_f(float v) { return v / (1.f + __expf(-v)); }
DI int lane_id() { int l; asm volatile("v_mbcnt_lo_u32_b32 %0, -1, 0\n\tv_mbcnt_hi_u32_b32 %0, -1, %0" : "=v"(l)); return l; }
DI int ltid(const int wv) { int t = wv * 64 + lane_id(); asm volatile("" : "+v"(t)); return t; }

constexpr size_t al4k(size_t x) { return (x + 4095) & ~(size_t)4095; }
constexpr size_t WS_BAR   = 0;
constexpr size_t WS_MOD   = 16384;
constexpr size_t WS_COS   = al4k(WS_MOD + (size_t)2 * MODC * 4);
constexpr size_t WS_SIN   = WS_COS + (size_t)T * 64 * 4;
constexpr size_t WS_SUBK  = WS_SIN + (size_t)T * 64 * 4;
constexpr size_t WS_WIN   = WS_SUBK + (size_t)4 * 2 * 128 * 128 * 2;
constexpr size_t WS_WOUT  = WS_WIN + (size_t)2 * GINP * D * 2;
constexpr size_t WS_KVW   = WS_WOUT + (size_t)2 * D * D * 2;
constexpr size_t WS_DWQ   = WS_KVW + (size_t)4096 * D * 2;
constexpr size_t WS_DWO   = WS_DWQ + (size_t)2 * D * D * 2;
constexpr size_t WS_PWQ   = WS_DWO + (size_t)2 * D * D * 2;
constexpr size_t WS_PU    = WS_PWQ + (size_t)4 * D * D * 2;
constexpr size_t WS_PUS   = WS_PU + (size_t)16384 * 1024;
constexpr size_t WS_PV    = WS_PU + (size_t)16384 * D * 2;
constexpr size_t WS_PVS   = WS_PV + (size_t)16384 * 1024;
constexpr size_t WS_XCUR  = WS_PV + (size_t)16384 * D * 2;
constexpr size_t WS_HBUF  = WS_XCUR + (size_t)T * D * 4;
constexpr size_t WS_OBUF  = WS_HBUF + (size_t)T * D * 2;
constexpr size_t WS_PROJ  = WS_OBUF + (size_t)T * D * 2;
constexpr size_t WS_PAB   = WS_PROJ + (size_t)T * GINP * 2;
constexpr size_t WS_PQ    = WS_PROJ + (size_t)T * GINP * 2;
constexpr size_t WS_PIDX  = WS_PQ + (size_t)T * D * 2;
constexpr size_t WS_PGATE = WS_PIDX + (size_t)T * 128 * 4;
constexpr size_t WS_GA    = WS_PGATE + (size_t)T * 128 * 4;
constexpr size_t WS_GB    = WS_GA + (size_t)4096 * 128 * 128 * 2;
constexpr size_t WS_GQ    = WS_GB + (size_t)4096 * 128 * 128 * 2;
constexpr size_t WS_GO    = WS_GQ + (size_t)4096 * 64 * 128 * 2;
constexpr size_t WS_GS    = WS_GO + (size_t)4096 * 64 * 128 * 2;
constexpr size_t WS_GL    = WS_GS + (size_t)4096 * 128 * 128 * 2;
constexpr size_t WS_END   = WS_GL + 16384;
constexpr size_t WS_OAT   = WS_GA;
constexpr size_t WS_KSH   = WS_GB;
constexpr size_t WS_VSH   = WS_GB + (size_t)67108864;
constexpr size_t WS_QD    = WS_GQ;

constexpr int LDS_BYTES = 147456;
constexpr int LDS_BARW  = 147456 - 64;

struct Params { const float* in[26]; float* out; unsigned char* ws; int ph_lo, ph_hi; };
typedef const Params __attribute__((address_space(4)))* PK;
#define PK_FRESH(p) asm volatile("" : "+s"(p))

#define XB_TMO      128
#define XB_XCNT(j)  (256  + 64 * (j))
#define XB_XSUB(j)  (1280 + 64 * (j))
#define XB_XGEN(j)  (2304 + 64 * (j))
#define XB_TOP      3328
#define XB_TOPGEN   3392
#define XCD_BAR_WORDS 3456
#define XB_SPIN_CAP (1u << 20)

__device__ __forceinline__ unsigned xb_ld(unsigned* p)              { return __hip_atomic_load(p, __ATOMIC_RELAXED, __HIP_MEMORY_SCOPE_AGENT); }
__device__ __forceinline__ unsigned xb_add(unsigned* p, unsigned v) { return __hip_atomic_fetch_add(p, v, __ATOMIC_RELAXED, __HIP_MEMORY_SCOPE_AGENT); }
__device__ __forceinline__ unsigned xb_xcc_id() { return (unsigned)__builtin_amdgcn_s_getreg((3 << 11) | 20) & 0xFu; }
#define XB_SPIN(cond, bar) do { unsigned _sp = 0; while (cond) { __builtin_amdgcn_s_sleep(1); \
    if ((++_sp & 255u) == 0u) { if (xb_ld(&(bar)[XB_TMO])) break; if (_sp > XB_SPIN_CAP) { atomicAdd(&(bar)[XB_TMO], 1u); break; } } } } while (0)

struct XcdBarrier { unsigned* bar; unsigned x; volatile LAS unsigned* st; int wv; };

__device__ __forceinline__ XcdBarrier xcd_barrier_post(unsigned* bar, volatile LAS unsigned* st, int wv) {
    XcdBarrier b; b.bar = bar; b.x = xb_xcc_id(); b.st = st; b.wv = wv;
    if (wv == 0 && lane_id() == 0) (void)xb_add(&bar[XB_XCNT(b.x)], 1u);
    return b;
}
__device__ __forceinline__ void xcd_barrier_complete(unsigned* bar, unsigned x, unsigned& nloc, unsigned& nx) {
    const unsigned G = gridDim.x * gridDim.y * gridDim.z;
    unsigned sum, cnt, mine, sp = 0u;
    for (;;) {
        sum = 0u; cnt = 0u; mine = 0u;
#pragma unroll
        for (unsigned j = 0; j < 16; ++j) { const unsigned c = xb_ld(&bar[XB_XCNT(j)]); sum += c; cnt += (c > 0u) ? 1u : 0u; mine = (j == x) ? c : mine; }
        if (sum == G) break;
        __builtin_amdgcn_s_sleep(1);
        if ((++sp & 255u) == 0u) { if (xb_ld(&bar[XB_TMO])) break; if (sp > XB_SPIN_CAP) { atomicAdd(&bar[XB_TMO], 1u); break; } }
    }
    nloc = mine > 0u ? mine : 1u; nx = cnt > 0u ? cnt : 1u;
}
__device__ __forceinline__ void xcd_barrier(const XcdBarrier& b) {
    asm volatile("s_waitcnt vmcnt(0)" ::: "memory");
    __syncthreads();
    if (b.wv == 0 && lane_id() == 0) {
        unsigned* bar = b.bar;
        __builtin_amdgcn_s_waitcnt(0);
        unsigned nloc = b.st[0], nx = b.st[1];
        if (nloc == 0u) { xcd_barrier_complete(bar, b.x, nloc, nx); b.st[0] = nloc; b.st[1] = nx; }
        const unsigned old = xb_add(&bar[XB_XSUB(b.x)], 1u);
        const unsigned gen = old / nloc;
        if (old + 1u == (gen + 1u) * nloc) {
            __builtin_amdgcn_fence(__ATOMIC_RELEASE, "agent");
            asm volatile("s_waitcnt vmcnt(0)" ::: "memory");
            const unsigned og = xb_add(&bar[XB_TOP], 1u);
            const unsigned tg = og / nx;
            if (og + 1u == (tg + 1u) * nx) xb_add(&bar[XB_TOPGEN], 1u);
            else XB_SPIN(xb_ld(&bar[XB_TOPGEN]) == tg, bar);
            __builtin_amdgcn_fence(__ATOMIC_ACQUIRE, "agent");
            xb_add(&bar[XB_XGEN(b.x)], 1u);
            asm volatile("s_waitcnt vmcnt(0)" ::: "memory");
        } else {
            XB_SPIN(xb_ld(&bar[XB_XGEN(b.x)]) == gen, bar);
            __builtin_amdgcn_fence(__ATOMIC_ACQUIRE, "agent");
            asm volatile("s_waitcnt vmcnt(0)" ::: "memory");
        }
    }
    __syncthreads();
}

namespace pg8 {
#define PG8_LAS __attribute__((address_space(3)))
constexpr int BM = 256, BK = 64, HALF = 128, HTB = HALF * BK * 2, STAGE_BYTES = 8 * HTB, NXCD = 8, WGM = 8;
__host__ __device__ __forceinline__ int lds_byte(int r, int c) { const int st = (r >> 4) * 2 + (c >> 5), rr = r & 15, cc = c & 31, ob = rr * 64 + cc * 2; return st * 1024 + (ob ^ (((ob >> 9) & 1) << 5)); }
__host__ __device__ __forceinline__ void stage_rc(int b, int& R, int& C) { const int st = b / 1024, sb = b % 1024, swz = sb ^ (((sb >> 9) & 1) << 5); R = (st >> 1) * 16 + swz / 64; C = (st & 1) * 32 + (swz % 64) / 2; }
__host__ __device__ __forceinline__ int perm32(int rho) { const int n = rho >> 4, i = rho & 15; return 8 * (i >> 2) + 4 * n + (i & 3); }
struct Unit { int pm, pn; };
struct Gemm { const bf16_t* A; const bf16_t* Bt; int M, N, K; int ld; int ksplit; };
struct StaticOrder {
    int nM, nN, nwg, G, c;
    __host__ __device__ void init(int M, int N, int G_, int c_) { nM = M / BM; nN = N / BM; nwg = nM * nN; G = G_; c = c_; }
    __host__ __device__ bool next(int i, Unit& u) const {
        const long L = (long)i * G + c; if (L >= nwg) return false;
        int wgid = (int)L; { const int q = nwg / NXCD, r = nwg % NXCD, xcd = wgid % NXCD, off = wgid / NXCD; wgid = (xcd < r ? xcd * (q + 1) : r * (q + 1) + (xcd - r) * q) + off; }
        const int nig = WGM * nN, gid = wgid / nig, fm = gid * WGM, gsz = (nM - fm) < WGM ? (nM - fm) : WGM;
        u.pm = fm + ((wgid % nig) % gsz); u.pn = (wgid % nig) / gsz; return true;
    }
    __device__ __forceinline__ void a_ready(const Unit&) const {}
    __device__ __forceinline__ void done(const Unit&) const {}
};

struct EpiMk {
    static constexpr bool PERM = true, AFTER_DRAIN = false;
    int mode; bf16_t* O; int ldc; const float* xin; const bf16_t* xinb; bf16_t* xout; const float* gate; float gmul;
    bf16_t* O2; int nrope; const float* cosT; const float* sinT;
    float* xoutf;
    __device__ __forceinline__ void operator()(const f32x4 (&acc)[2][2][4][2], const Unit& u, int wr, int wc, int fr, int fq) const {
        const int row0 = u.pm * BM + wr * 64 + fr, col0 = u.pn * BM + wc * 32 + 8 * fq;
        if (mode == 0) {
#pragma unroll
            for (int ai = 0; ai < 2; ++ai)
#pragma unroll
                for (int m = 0; m < 4; ++m) { bf16_t* rowp = O + (size_t)(row0 + ai * HALF + m * 16) * ldc + col0;
#pragma unroll
                    for (int bj = 0; bj < 2; ++bj) { const f32x4 v0 = acc[ai][bj][m][0], v1 = acc[ai][bj][m][1];
                        u32x4 w; w.x = cvt_pk_bf16(v0[0], v0[1]); w.y = cvt_pk_bf16(v0[2], v0[3]); w.z = cvt_pk_bf16(v1[0], v1[1]); w.w = cvt_pk_bf16(v1[2], v1[3]);
                        *(u32x4*)(rowp + bj * HALF) = w; } }
        } else if (mode == 3) {
            if (wc == 0) {
#pragma unroll
                for (int ai = 0; ai < 2; ++ai)
#pragma unroll
                    for (int m = 0; m < 4; ++m) { const int row = row0 + ai * HALF + m * 16; float* dp = xoutf + ((size_t)u.pn * T + row) * 32 + 8 * fq;
                        *(f32x4*)dp = acc[ai][0][m][0]; *(f32x4*)(dp + 4) = acc[ai][0][m][1]; }
            }
        } else if (mode == 2) {
#pragma unroll
            for (int ai = 0; ai < 2; ++ai)
#pragma unroll
                for (int m = 0; m < 4; ++m) { const int row = row0 + ai * HALF + m * 16, bb = row >> 13, ss = row & 8191;
#pragma unroll
                    for (int bj = 0; bj < 2; ++bj) { const int col = col0 + bj * HALF; const f32x4 v0 = acc[ai][bj][m][0], v1 = acc[ai][bj][m][1];
                        if (col < nrope) { const int hc = col >> 7, j0 = ((col & 127) >> 3) * 4;
                            const f32x4 cs = *(const f32x4*)(cosT + (size_t)row * 64 + j0), sn = *(const f32x4*)(sinT + (size_t)row * 64 + j0);
                            bf16_t* dp = O + ((size_t)(bb * 16 + hc) * SEQ + ss) * 128 + j0;
                            u32x2 w1, w2; w1.x = cvt_pk_bf16(v0[0] * cs[0] - v1[0] * sn[0], v0[1] * cs[1] - v1[1] * sn[1]); w1.y = cvt_pk_bf16(v0[2] * cs[2] - v1[2] * sn[2], v0[3] * cs[3] - v1[3] * sn[3]);
                            w2.x = cvt_pk_bf16(v1[0] * cs[0] + v0[0] * sn[0], v1[1] * cs[1] + v0[1] * sn[1]); w2.y = cvt_pk_bf16(v1[2] * cs[2] + v0[2] * sn[2], v1[3] * cs[3] + v0[3] * sn[3]);
                            *(u32x2*)dp = w1; *(u32x2*)(dp + 64) = w2;
                        } else { const int cv = col - nrope, hc = cv >> 7;
                            u32x4 w; w.x = cvt_pk_bf16(v0[0], v0[1]); w.y = cvt_pk_bf16(v0[2], v0[3]); w.z = cvt_pk_bf16(v1[0], v1[1]); w.w = cvt_pk_bf16(v1[2], v1[3]);
                            *(u32x4*)(O2 + ((size_t)(bb * 16 + hc) * SEQ + ss) * 128 + (cv & 127)) = w; } } }
        } else {
#pragma unroll
            for (int ai = 0; ai < 2; ++ai)
#pragma unroll
                for (int m = 0; m < 4; ++m) { const int row = row0 + ai * HALF + m * 16; const float* gp = gate + (size_t)(row >> 13) * MODC + col0;
                    bf16_t* xo = xout + (size_t)row * D + col0;
#pragma unroll
                    for (int bj = 0; bj < 2; ++bj) {
                        const f32x4 g0 = *(const f32x4*)(gp + bj * HALF), g1 = *(const f32x4*)(gp + bj * HALF + 4);
                        f32x4 x0, x1;
                        if (xin) { x0 = *(const f32x4*)(xin + (size_t)row * D + col0 + bj * HALF); x1 = *(const f32x4*)(xin + (size_t)row * D + col0 + bj * HALF + 4); }
                        else { const u32x4 xb = *(const u32x4*)(xinb + (size_t)row * D + col0 + bj * HALF);
                            x0 = (f32x4){bflo(xb.x), bfhi(xb.x), bflo(xb.y), bfhi(xb.y)}; x1 = (f32x4){bflo(xb.z), bfhi(xb.z), bflo(xb.w), bfhi(xb.w)}; }
                        const f32x4 y0 = x0 + gmul * g0 * acc[ai][bj][m][0], y1 = x1 + gmul * g1 * acc[ai][bj][m][1];
                        u32x4 w; w.x = cvt_pk_bf16(y0[0], y0[1]); w.y = cvt_pk_bf16(y0[2], y0[3]); w.z = cvt_pk_bf16(y1[0], y1[1]); w.w = cvt_pk_bf16(y1[2], y1[3]);
                        *(u32x4*)(xo + bj * HALF) = w; } }
        }
    }
};

template <class Epi, class Sched>
__device__ __forceinline__ void gemm_phase(PG8_LAS unsigned char* lds, const Gemm g, const Sched& S, const Epi& E, const int wv) {
    const int tid = ltid(wv), wid = __builtin_amdgcn_readfirstlane(tid >> 6), lane = tid & 63, wr = wid >> 2, wc = wid & 3, fr = lane & 15, fq = lane >> 4;
    const int K = g.K, nt = K / BK, ld = g.ld;
    unsigned voffA[2], voffB[2];
#pragma unroll
    for (int i = 0; i < 2; ++i) { int R, C; stage_rc(tid * 16 + i * 8192, R, C); const int Rb = Epi::PERM ? ((R & ~31) + perm32(R & 31)) : R;
        voffA[i] = (unsigned)(R * ld + C) * 2u; voffB[i] = (unsigned)(Rb * ld + C) * 2u; }
    const size_t kstep = (size_t)(BK * 2);
    const size_t hstep = (size_t)HALF * ld * 2;
    const size_t tstep = 2 * hstep;
    const unsigned ldsw = (unsigned)wid * 1024u;
    const int aoff = lds_byte(wr * 64 + fr, fq * 8), boff = lds_byte(wc * 32 + fr, fq * 8);
#define PG8_SA(b, h) (((b) * 2 + (h)) * HTB)
#define PG8_SB(b, h) ((4 + (b) * 2 + (h)) * HTB)
#define PG8_STAGE(bufoff, gbase, voff) do { _Pragma("unroll") for (int _i = 0; _i < 2; ++_i) \
        __builtin_amdgcn_global_load_lds((const unsigned*)((const char*)(gbase) + (voff)[_i]), (PG8_LAS unsigned*)(lds + (bufoff) + ldsw + _i * 8192), 16, 0, 0); } while (0)
#define PG8_LDA(dst, b, h) do { _Pragma("unroll") for (int m = 0; m < 4; ++m) _Pragma("unroll") for (int k = 0; k < 2; ++k) dst[m][k] = *(const PG8_LAS bf16x8*)(lds + PG8_SA(b, h) + aoff + m * 2048 + k * 1024); } while (0)
#define PG8_LDB(dst, b, h) do { _Pragma("unroll") for (int n = 0; n < 2; ++n) _Pragma("unroll") for (int k = 0; k < 2; ++k) dst[n][k] = *(const PG8_LAS bf16x8*)(lds + PG8_SB(b, h) + boff + n * 2048 + k * 1024); } while (0)
#define PG8_MMA(ai, bj, At, Bt) do { __builtin_amdgcn_s_setprio(1); _Pragma("unroll") for (int m = 0; m < 4; ++m) _Pragma("unroll") for (int n = 0; n < 2; ++n) _Pragma("unroll") for (int k = 0; k < 2; ++k) \
        acc[ai][bj][m][n] = __builtin_amdgcn_mfma_f32_16x16x32_bf16(Bt[n][k], At[m][k], acc[ai][bj][m][n], 0, 0, 0); __builtin_amdgcn_s_setprio(0); } while (0)
#define PG8_WAIT_V(n) asm volatile("s_waitcnt vmcnt(" #n ")" ::: "memory")
#define PG8_WAIT_L(n) asm volatile("s_waitcnt lgkmcnt(" #n ")" ::: "memory")
#define PG8_BAR __builtin_amdgcn_s_barrier()
#define PG8_SCHED __builtin_amdgcn_sched_barrier(0)
    Unit cur, nxt; int ui = 0;
    if (!S.next(0, cur)) return;
    f32x4 acc[2][2][4][2];
#pragma unroll
    for (int a = 0; a < 2; ++a)
#pragma unroll
        for (int b = 0; b < 2; ++b)
#pragma unroll
            for (int m = 0; m < 4; ++m)
#pragma unroll
                for (int n = 0; n < 2; ++n) acc[a][b][m][n] = (f32x4){0.f, 0.f, 0.f, 0.f};
    bf16x8 At[4][2], B0[2][2], B1[2][2];
    const size_t bstep = g.ksplit ? (size_t)K * 2 : tstep, astep = g.ksplit ? (size_t)K * 2 : 0;
    const char* cA = (const char*)g.A + (size_t)cur.pm * tstep + (size_t)cur.pn * astep; const char* cB = (const char*)g.Bt + (size_t)cur.pn * bstep;
    S.a_ready(cur);
    PG8_STAGE(PG8_SB(0, 0), cB, voffB); PG8_STAGE(PG8_SA(0, 0), cA, voffA); PG8_STAGE(PG8_SB(0, 1), cB + hstep, voffB); PG8_STAGE(PG8_SA(0, 1), cA + hstep, voffA);
    if (wr == 1) PG8_BAR;
    PG8_WAIT_V(4); PG8_BAR;
    PG8_STAGE(PG8_SB(1, 0), cB + kstep, voffB); PG8_STAGE(PG8_SA(1, 0), cA + kstep, voffA); PG8_STAGE(PG8_SB(1, 1), cB + hstep + kstep, voffB);
    PG8_WAIT_V(6); PG8_BAR;
    for (;;) {
        const bool has_next = S.next(ui + 1, nxt);
        const char* nA = has_next ? (const char*)g.A + (size_t)nxt.pm * tstep + (size_t)nxt.pn * astep : cA; const char* nB = has_next ? (const char*)g.Bt + (size_t)nxt.pn * bstep : cB;
        for (int t = 0; t < nt; t += 2) {
            const bool last = (t == nt - 2);
            const char* a1 = cA + (size_t)(t + 1) * kstep;
            const char* a2 = last ? nA : cA + (size_t)(t + 2) * kstep; const char* b2 = last ? nB : cB + (size_t)(t + 2) * kstep;
            const char* a3 = a2 + kstep; const char* b3 = b2 + kstep;
            if (last && has_next) S.a_ready(nxt);
            PG8_LDB(B0, 0, 0); PG8_SCHED; PG8_LDA(At, 0, 0); PG8_STAGE(PG8_SA(1, 1), a1 + hstep, voffA);
            PG8_WAIT_L(8); PG8_BAR; PG8_WAIT_L(0); PG8_MMA(0, 0, At, B0); PG8_BAR; PG8_SCHED;
            PG8_LDB(B1, 0, 1); PG8_STAGE(PG8_SB(0, 0), b2, voffB);
            PG8_BAR; PG8_WAIT_L(0); PG8_MMA(0, 1, At, B1); PG8_BAR;
            PG8_LDA(At, 0, 1); PG8_STAGE(PG8_SA(0, 0), a2, voffA);
            PG8_BAR; PG8_WAIT_L(0); PG8_MMA(1, 0, At, B0); PG8_BAR; PG8_SCHED;
            PG8_STAGE(PG8_SB(0, 1), b2 + hstep, voffB);
            PG8_WAIT_V(6); PG8_BAR; PG8_MMA(1, 1, At, B1); PG8_BAR;
            PG8_LDB(B0, 1, 0); PG8_SCHED; PG8_LDA(At, 1, 0); PG8_STAGE(PG8_SA(0, 1), a2 + hstep, voffA);
            PG8_WAIT_L(8); PG8_BAR; PG8_WAIT_L(0); PG8_MMA(0, 0, At, B0); PG8_BAR; PG8_SCHED;
            PG8_LDB(B1, 1, 1); PG8_STAGE(PG8_SB(1, 0), b3, voffB);
            PG8_BAR; PG8_WAIT_L(0); PG8_MMA(0, 1, At, B1); PG8_BAR;
            PG8_LDA(At, 1, 1); PG8_STAGE(PG8_SA(1, 0), a3, voffA);
            PG8_BAR; PG8_WAIT_L(0); PG8_MMA(1, 0, At, B0); PG8_BAR; PG8_SCHED;
            PG8_STAGE(PG8_SB(1, 1), b3 + hstep, voffB);
            PG8_WAIT_V(6); PG8_BAR; PG8_MMA(1, 1, At, B1); PG8_BAR;
        }
        E(acc, cur, wr, wc, fr, fq); S.done(cur);
        if (!has_next) break;
#pragma unroll
        for (int a = 0; a < 2; ++a)
#pragma unroll
            for (int b = 0; b < 2; ++b)
#pragma unroll
                for (int m = 0; m < 4; ++m)
#pragma unroll
                    for (int n = 0; n < 2; ++n) acc[a][b][m][n] = (f32x4){0.f, 0.f, 0.f, 0.f};
        cur = nxt; cA = nA; cB = nB; ++ui;
    }
    PG8_WAIT_V(0);
    if (wr == 0) PG8_BAR;
    PG8_BAR;
#undef PG8_SA
#undef PG8_SB
#undef PG8_STAGE
#undef PG8_LDA
#undef PG8_LDB
#undef PG8_MMA
#undef PG8_WAIT_V
#undef PG8_WAIT_L
#undef PG8_BAR
#undef PG8_SCHED
}
}

namespace att {
constexpr int D = 128;
constexpr float THR = 8.f;
constexpr bool WSKIP = false;
constexpr float SCALE = 0.08838834764831845f;
constexpr int NW = 8, QBLK = 32, KVBLK = 64, QB = NW * QBLK;
constexpr int SHM_V = KVBLK * D * 2, SHM_K = KVBLK * D * 2;
constexpr int LDS_BYTES = 2 * SHM_V + 2 * SHM_K + NW * 64 * 4;
using bf16 = __hip_bfloat16;
template <class A, class Bt> struct same_t { static constexpr bool v = false; };
template <class A> struct same_t<A, A> { static constexpr bool v = true; };
#define KSWZ(row, colB) ((row) * 256 + ((colB) ^ (((row) & 7) << 4)))
#define SBAR() __builtin_amdgcn_sched_barrier(0)
__device__ __forceinline__ int v_st(int k, int c) { const int kk = (k & ~0xC) | ((k & 4) << 1) | ((k & 8) >> 1); return ((kk >> 3) * 4 + (c >> 5)) * 512 + ((kk & 7) * 32 + (c & 31)) * 2; }
__device__ __forceinline__ int v_rd_base(int lane) { return ((lane & 3) << 3) | (((lane >> 2) & 3) << 6) | (((lane >> 4) & 1) << 5) | (((lane >> 5) & 1) << 8); }
constexpr int v_rd_off(int d0, int ks, int half) { return d0 * 512 + ks * 4096 + half * 2048; }
__device__ __forceinline__ int crow(int r, int hi) { return (r & 3) + 8 * (r >> 2) + 4 * hi; }
__device__ __forceinline__ unsigned cvtpk(float lo, float hi) {
    unsigned r; asm volatile("v_cvt_pk_bf16_f32 %0, %1, %2" : "=v"(r) : "v"(lo), "v"(hi)); return r;
}
__device__ __forceinline__ bf16x8 pack8(f32x4 a, f32x4 b) {
    u32x4 w = {cvtpk(a[0], a[1]), cvtpk(a[2], a[3]), cvtpk(b[0], b[1]), cvtpk(b[2], b[3])};
    return *reinterpret_cast<bf16x8*>(&w);
}
template <class T> __device__ __forceinline__ bf16x8 load8(const T* p) {
    if constexpr (same_t<T, float>::v) { return pack8(*(const f32x4*)p, *(const f32x4*)(p + 4)); }
    else { return *reinterpret_cast<const bf16x8*>(p); }
}
__device__ __forceinline__ void mask_tile(f32x16& p0, f32x16& p1, int dq, unsigned W) {
    const float NEG = -__builtin_inff();
#pragma unroll
    for (int r = 0; r < 16; ++r) {
        const int c = (r & 3) + 8 * (r >> 2);
        if ((unsigned)(dq - c) >= W) p0[r] = NEG;
        if ((unsigned)(dq - c - 32) >= W) p1[r] = NEG;
    }
}
__device__ __forceinline__ void partialSM(f32x16& p0, f32x16& p1, float& m_reg, float& mn, float& alpha) {
    float pmax = p0[0]; for (int r = 1; r < 16; ++r) pmax = fmaxf(pmax, p0[r]); for (int r = 0; r < 16; ++r) pmax = fmaxf(pmax, p1[r]);
    { auto rr = __builtin_amdgcn_permlane32_swap(__float_as_uint(pmax), __float_as_uint(pmax), false, false);
      pmax = fmaxf(__uint_as_float(rr[0]), __uint_as_float(rr[1])); }
    constexpr float C2 = 1.4426950408889634f * SCALE;
    if (__builtin_expect(__all((pmax - m_reg) * SCALE <= THR), 1)) { mn = m_reg; alpha = 1.f; }
    else { mn = fmaxf(m_reg, pmax); alpha = __builtin_amdgcn_exp2f((m_reg - mn) * C2); m_reg = mn; }
    const float mnL = -mn * C2;
    for (int r = 0; r < 16; ++r) p0[r] = fmaf(p0[r], C2, mnL); for (int r = 0; r < 16; ++r) p1[r] = fmaf(p1[r], C2, mnL);
    for (int r = 0; r < 16; ++r) p0[r] = __builtin_amdgcn_exp2f(p0[r]);
}
__device__ __forceinline__ void finishSM(f32x16& p0, f32x16& p1, float alpha, float& l_reg, bf16x8& pa0, bf16x8& pa1, bf16x8& pa2, bf16x8& pa3) {
    for (int r = 0; r < 16; ++r) p1[r] = __builtin_amdgcn_exp2f(p1[r]);
    float ps = 0; for (int r = 0; r < 16; ++r) ps += p0[r]; for (int r = 0; r < 16; ++r) ps += p1[r];
    { auto rr = __builtin_amdgcn_permlane32_swap(__float_as_uint(ps), __float_as_uint(ps), false, false);
      ps = __uint_as_float(rr[0]) + __uint_as_float(rr[1]); }
    l_reg = l_reg * alpha + ps;
#define PK4(P, B_, OUT) do { unsigned a0 = cvtpk(P[B_+0], P[B_+1]), a1 = cvtpk(P[B_+2], P[B_+3]);                          \
        unsigned b0 = cvtpk(P[B_+4], P[B_+5]), b1 = cvtpk(P[B_+6], P[B_+7]);                                             \
        auto r0 = __builtin_amdgcn_permlane32_swap(a0, b0, false, false); auto r1 = __builtin_amdgcn_permlane32_swap(a1, b1, false, false); \
        u32x4 w = {r0[0], r1[0], r0[1], r1[1]}; OUT = *reinterpret_cast<bf16x8*>(&w); } while (0)
    PK4(p0, 0, pa0); PK4(p0, 8, pa1); PK4(p1, 0, pa2); PK4(p1, 8, pa3);
#undef PK4
}
template <int KB, bool SK>
__device__ __forceinline__ void qkt(f32x16& p0, f32x16& p1, const char* K_lds, int r32, int hi, const bf16x8* qr, bool act) {
    if (SK && !act) { const float NEG = -__builtin_inff();
#pragma unroll
        for (int r = 0; r < 16; ++r) { p0[r] = NEG; p1[r] = NEG; } return; }
    p0 = f32x16{}; p1 = f32x16{};
    const char* kb[4];
#pragma unroll
    for (int dd = 0; dd < 4; ++dd) kb[dd] = K_lds + KB * SHM_K + KSWZ(r32, (dd * 16 + hi * 8) * 2);
#pragma unroll
    for (int d0 = 0; d0 < 8; ++d0) { const char* a = kb[d0 & 3] + (d0 >> 2) * 128;
        bf16x8 b0 = *reinterpret_cast<const bf16x8*>(a);
        bf16x8 b1 = *reinterpret_cast<const bf16x8*>(a + 32 * 256);
        p0 = __builtin_amdgcn_mfma_f32_32x32x16_bf16(b0, qr[d0], p0, 0, 0, 0);
        p1 = __builtin_amdgcn_mfma_f32_32x32x16_bf16(b1, qr[d0], p1, 0, 0, 0); }
}
template <int VB, bool SK>
__device__ __forceinline__ void pv_tile(f32x16* o, int vb0, bf16x8 pa0, bf16x8 pa1, bf16x8 pa2, bf16x8 pa3, bool act) {
    if (SK && !act) return;
#define TRRD(dst, off) asm volatile("ds_read_b64_tr_b16 %0, %1 offset:%2" : "=&v"(dst) : "v"(vb0), "i"(off) : "memory")
#define PV_D0(d0) do { s16x4 l0, l1, l2, l3, h0, h1, h2, h3; constexpr int b_ = VB * SHM_V + v_rd_off(d0, 0, 0);     \
        TRRD(l0, b_); TRRD(h0, b_ + 2048); TRRD(l1, b_ + 4096); TRRD(h1, b_ + 6144); TRRD(l2, b_ + 8192); TRRD(h2, b_ + 10240); TRRD(l3, b_ + 12288); TRRD(h3, b_ + 14336); \
        asm volatile("s_waitcnt lgkmcnt(0)" ::: "memory"); SBAR();                 \
        o[d0] = __builtin_amdgcn_mfma_f32_32x32x16_bf16(pa0, (bf16x8){l0[0], l0[1], l0[2], l0[3], h0[0], h0[1], h0[2], h0[3]}, o[d0], 0, 0, 0);   \
        o[d0] = __builtin_amdgcn_mfma_f32_32x32x16_bf16(pa1, (bf16x8){l1[0], l1[1], l1[2], l1[3], h1[0], h1[1], h1[2], h1[3]}, o[d0], 0, 0, 0);   \
        o[d0] = __builtin_amdgcn_mfma_f32_32x32x16_bf16(pa2, (bf16x8){l2[0], l2[1], l2[2], l2[3], h2[0], h2[1], h2[2], h2[3]}, o[d0], 0, 0, 0);   \
        o[d0] = __builtin_amdgcn_mfma_f32_32x32x16_bf16(pa3, (bf16x8){l3[0], l3[1], l3[2], l3[3], h3[0], h3[1], h3[2], h3[3]}, o[d0], 0, 0, 0); } while (0)
    PV_D0(0); PV_D0(1); PV_D0(2); PV_D0(3);
#undef PV_D0
#undef TRRD
}

template <class TIn, class TOut> struct BlockRef { const TIn* Q; const TIn* K; const TIn* V; TOut* O; int P0; };
template <class TIn> struct Seam {
    bf16x8 qr[8];
    bf16x8 st_v0, st_v1, st_k0, st_k1; f32x4 sf0, sf1, sf2, sf3;
    f32x4 tq[16];
};
__device__ __forceinline__ int swa_jlo(int P0, int W) { const int lowk = P0 - W + 1; return lowk > 0 ? lowk / KVBLK : 0; }
#define ROW(p, k0, rr) ((p) + (size_t)((k0) + (rr)) * D + sc)
#define VMW() asm volatile("s_waitcnt vmcnt(0)" ::: "memory")
#define VMWN(n) asm volatile("s_waitcnt vmcnt(%0)" :: "i"(n) : "memory")
#define SLOAD_H(Kp, Vp, k0) do { S.st_v0 = load8<TIn>(ROW(Vp, k0, sr)); S.st_v1 = load8<TIn>(ROW(Vp, k0, 32 + sr));              \
                         S.st_k0 = load8<TIn>(ROW(Kp, k0, sr)); S.st_k1 = load8<TIn>(ROW(Kp, k0, 32 + sr)); } while (0)
#define SWRITE_HK(bf) do { *(bf16x8*)(K_lds + (bf) * SHM_K + kws) = S.st_k0; *(bf16x8*)(K_lds + (bf) * SHM_K + kws + 32 * 256) = S.st_k1; } while (0)
#define SWRITE_HV(bf) do { *(bf16x8*)(V_lds + (bf) * SHM_V + vst0) = S.st_v0; *(bf16x8*)(V_lds + (bf) * SHM_V + vst1) = S.st_v1; } while (0)
#define SWRITE_H(bf) do { SWRITE_HV(bf); SWRITE_HK(bf); } while (0)
#define SLOAD_F(p, k0) do { S.sf0 = *(const f32x4*)ROW(p, k0, sr); S.sf1 = *(const f32x4*)(ROW(p, k0, sr) + 4);                \
                            S.sf2 = *(const f32x4*)ROW(p, k0, 32 + sr); S.sf3 = *(const f32x4*)(ROW(p, k0, 32 + sr) + 4); } while (0)
#define SWRITE_KF(bf) do { *(bf16x8*)(K_lds + (bf) * SHM_K + kws) = pack8(S.sf0, S.sf1); *(bf16x8*)(K_lds + (bf) * SHM_K + kws + 32 * 256) = pack8(S.sf2, S.sf3); } while (0)
#define SWRITE_VF(bf) do { *(bf16x8*)(V_lds + (bf) * SHM_V + vst0) = pack8(S.sf0, S.sf1); *(bf16x8*)(V_lds + (bf) * SHM_V + vst1) = pack8(S.sf2, S.sf3); } while (0)
template <class TIn, class TOut>
__device__ __forceinline__ void causal_swa_prime(const BlockRef<TIn, TOut>& cur, int W, char* lds, Seam<TIn>& S, const int wv) {
    constexpr bool F32 = same_t<TIn, float>::v;
    const int tid = ltid(wv), wid = __builtin_amdgcn_readfirstlane(tid >> 6), lane = tid & 63, r32 = lane & 31, hi = lane >> 5;
    const int sr = tid >> 4, sc = (tid & 15) * 8, kws = KSWZ(sr, sc * 2); char* K_lds = lds + 2 * SHM_V;
    const int kb0 = swa_jlo(cur.P0, W) * KVBLK;
    for (int d0 = 0; d0 < 8; ++d0) S.qr[d0] = load8<TIn>(cur.Q + (size_t)(wid * QBLK + r32) * D + d0 * 16 + hi * 8);
    if constexpr (F32) { SLOAD_F((const float*)cur.K, kb0); VMW(); SWRITE_KF(0); SBAR(); SLOAD_F((const float*)cur.V, kb0); }
    else { SLOAD_H(cur.K, cur.V, kb0); VMW(); SWRITE_HK(0); }
    __syncthreads();
}
template <class TIn, class TOut>
__device__ __forceinline__ void causal_swa_block(const BlockRef<TIn, TOut>& cur, const BlockRef<TIn, TOut>& nxt, int skv, int W, char* lds, Seam<TIn>& S, const int wv) {
    constexpr bool F32 = same_t<TIn, float>::v;
    const int tid = ltid(wv), wid = __builtin_amdgcn_readfirstlane(tid >> 6), lane = tid & 63, r32 = lane & 31, hi = lane >> 5;
    const int j_lo = swa_jlo(cur.P0, W);
    int j_hi = (cur.P0 + QB - 1) / KVBLK + 1; if (j_hi > skv / KVBLK) j_hi = skv / KVBLK;
    const int NT = j_hi - j_lo;
    const int kbn = swa_jlo(nxt.P0, W) * KVBLK;
    const int qlo = cur.P0 + wid * QBLK, qm = qlo + r32 - 4 * hi;
    char* V_lds = lds; char* K_lds = lds + 2 * SHM_V;
    float* ws = (float*)(lds + 2 * SHM_V + 2 * SHM_K) + wid * 64; float* li_l = ws, * al_l = ws + 32;
    float m_reg = -1e30f, l_reg = 0; f32x16 o[4] = {};
    const int sr = tid >> 4, sc = (tid & 15) * 8, vst0 = v_st(sr, sc), vst1 = v_st(32 + sr, sc), kws = KSWZ(sr, sc * 2);
    const int vb0 = (int)(uintptr_t)V_lds + v_rd_base(lane);
    const TIn* Kh = cur.K; const TIn* Vh = cur.V;
#define RESC(a) do { if (__any((a) < 1.f)) { if (hi == 0) al_l[r32] = (a); asm volatile("s_waitcnt lgkmcnt(0)" ::: "memory");              \
                     for (int d_ = 0; d_ < 4; ++d_) for (int r = 0; r < 16; ++r) o[d_][r] *= al_l[crow(r, hi)]; } } while (0)
#define KBASE(t) ((j_lo + (t)) * KVBLK)
#define ACT(t) (KBASE(t) <= qlo + QBLK - 1 && KBASE(t) + KVBLK - 1 >= qlo - W + 1)
#define MASKT(P0_, P1_, t) do { const int kb_ = KBASE(t); if ((!SK || ACT(t)) && (kb_ + KVBLK - 1 > qlo || kb_ <= qlo + QBLK - 1 - W)) mask_tile(P0_, P1_, qm - kb_, (unsigned)W); } while (0)
    constexpr int NQL = F32 ? 16 : 8;
    constexpr bool SK = WSKIP && !F32;
#define SEAM_K0() do { VMWN(NQL); if constexpr (F32) { SWRITE_KF(0); SBAR(); SLOAD_F((const float*)nxt.V, kbn); } else { SWRITE_HK(0); } SBAR(); } while (0)
    f32x16 pA0, pA1, pB0, pB1; float mnA, mnB, alA, alB; bf16x8 pa0, pa1, pa2, pa3;
    if constexpr (F32) { VMW(); SWRITE_VF(0); SBAR(); } else { SWRITE_HV(0); SBAR(); }
    if (NT > 1) { if constexpr (F32) SLOAD_F((const float*)Kh, KBASE(1)); else SLOAD_H(Kh, Vh, KBASE(1)); }
    SBAR(); qkt<0, SK>(pA0, pA1, K_lds, r32, hi, S.qr, ACT(0));
    if constexpr (F32) { if (NT > 1) { VMW(); SWRITE_KF(1); SBAR(); SLOAD_F((const float*)Vh, KBASE(1)); } }
    MASKT(pA0, pA1, 0); partialSM(pA0, pA1, m_reg, mnA, alA);
    if (NT > 1) { VMW(); if constexpr (F32) { SWRITE_VF(1); SBAR(); if (NT > 2) SLOAD_F((const float*)Kh, KBASE(2)); } else SWRITE_H(1); }
    __syncthreads();
#define HALF_STEP(PX0, PX1, mnX, alX, PY0, PY1, alY, t, KB, VB, SB) do {                                                      \
        SBAR(); qkt<KB, SK>(PX0, PX1, K_lds, r32, hi, S.qr, ACT(t));                                             \
        finishSM(PY0, PY1, alY, l_reg, pa0, pa1, pa2, pa3); SBAR();                                                           \
        if ((t) + 1 < NT) { if constexpr (F32) { VMW(); SWRITE_KF(SB); SBAR(); SLOAD_F((const float*)Vh, KBASE((t) + 1)); }  \
                            else { SLOAD_H(Kh, Vh, KBASE((t) + 1)); } SBAR(); }                                               \
        pv_tile<VB, SK>(o, vb0, pa0, pa1, pa2, pa3, ACT((t) - 1)); MASKT(PX0, PX1, (t)); partialSM(PX0, PX1, m_reg, mnX, alX);                                        \
        __syncthreads();                                                                                                      \
        if ((t) + 1 < NT) { VMW(); if constexpr (F32) { SWRITE_VF(SB); SBAR(); if ((t) + 2 < NT) SLOAD_F((const float*)Kh, KBASE((t) + 2)); } \
                            else { SWRITE_H(SB); } }                                                                          \
        RESC(alX); __syncthreads(); } while (0)
    for (int t = 1; t + 1 < NT; t += 2) {
        HALF_STEP(pB0, pB1, mnB, alB, pA0, pA1, alA, t, 1, 0, 0);
        HALF_STEP(pA0, pA1, mnA, alA, pB0, pB1, alB, t + 1, 0, 1, 1);
    }
    const bool even = (NT & 1) == 0;
    if (even) { SBAR(); qkt<1, SK>(pB0, pB1, K_lds, r32, hi, S.qr, ACT(NT - 1)); SBAR(); }
#define QROW(e) (nxt.Q + (size_t)(wid * QBLK + r32) * D + ((e) >> 1) * 16 + hi * 8 + ((e) & 1) * 4)
    if constexpr (F32) { SLOAD_F((const float*)nxt.K, kbn); SBAR();
#pragma unroll
        for (int e = 0; e < 8; ++e) S.tq[e] = *(const f32x4*)QROW(e); }
    else { SLOAD_H(nxt.K, nxt.V, kbn); SBAR();
#pragma unroll
        for (int d0 = 0; d0 < 8; ++d0) S.qr[d0] = load8<TIn>(nxt.Q + (size_t)(wid * QBLK + r32) * D + d0 * 16 + hi * 8); }
    SBAR();
    finishSM(pA0, pA1, alA, l_reg, pa0, pa1, pa2, pa3); SBAR();
    if constexpr (F32) {
#pragma unroll
        for (int e = 8; e < 16; ++e) S.tq[e] = *(const f32x4*)QROW(e); SBAR(); }
#undef QROW
    pv_tile<0, SK>(o, vb0, pa0, pa1, pa2, pa3, ACT(even ? NT - 2 : NT - 1));
    if (even) { MASKT(pB0, pB1, NT - 1); partialSM(pB0, pB1, m_reg, mnB, alB); __syncthreads(); RESC(alB);
        finishSM(pB0, pB1, alB, l_reg, pa0, pa1, pa2, pa3); SBAR(); pv_tile<1, SK>(o, vb0, pa0, pa1, pa2, pa3, ACT(NT - 1)); }
    SBAR(); SEAM_K0();
    if (hi == 0) li_l[r32] = l_reg; asm volatile("s_waitcnt lgkmcnt(0)" ::: "memory");
    float rli[16];
#pragma unroll
    for (int r = 0; r < 16; ++r) rli[r] = __builtin_amdgcn_rcpf(li_l[crow(r, hi)]);
    TOut* Ow = cur.O + (size_t)(wid * QBLK) * D;
#pragma unroll
    for (int r = 0; r < 16; ++r) { const int orow = crow(r, hi);
#pragma unroll
        for (int d0 = 0; d0 < 4; ++d0) { const float v = o[d0][r] * rli[r];
            if constexpr (same_t<TOut, float>::v) { Ow[(size_t)orow * D + d0 * 32 + r32] = v; }
            else { const float vn = sw_xor<1>(v);
                   if ((r32 & 1) == 0) *(unsigned*)(Ow + (size_t)orow * D + d0 * 32 + r32) = cvtpk(v, vn); } } }
    if constexpr (F32) {
#pragma unroll
        for (int d0 = 0; d0 < 8; ++d0) S.qr[d0] = pack8(S.tq[2 * d0], S.tq[2 * d0 + 1]); }
    __syncthreads();
#undef RESC
#undef KBASE
#undef ACT
#undef MASKT
#undef SEAM_K0
#undef HALF_STEP
}
#undef ROW
#undef VMW
#undef VMWN
#undef SLOAD_H
#undef SWRITE_HK
#undef SWRITE_HV
#undef SWRITE_H
#undef SLOAD_F
#undef SWRITE_KF
#undef SWRITE_VF
#undef KSWZ
#undef SBAR
}

#define MFMA16(a, b, c) __builtin_amdgcn_mfma_f32_16x16x32_bf16((a), (b), (c), 0, 0, 0)
#define MFMA32(a, b, c) __builtin_amdgcn_mfma_f32_32x32x16_bf16((a), (b), (c), 0, 0, 0)
#define WSP(T_, off) ((T_*)(p->ws + (off)))

DI void sincos_red(double r, float& s, float& c) {
    const double r2 = r * r; double sp = 1.0, cp = 1.0;
#pragma unroll
    for (int k = 13; k >= 1; --k) { sp = 1.0 - sp * r2 * (1.0 / (double)((2 * k) * (2 * k + 1))); cp = 1.0 - cp * r2 * (1.0 / (double)((2 * k - 1) * (2 * k))); }
    s = (float)(r * sp); c = (float)cp;
}

DI void cvt_wt_job(const float* src, bf16_t* dst, int N, int Npad, int nperm, float* tile, const int wv) {
    const int tid = ltid(wv), K = 2048, ntn = Npad / 64, ntiles = ntn * (K / 64);
    for (int tl = blockIdx.x; tl < ntiles; tl += gridDim.x) {
        const int tn = tl % ntn, tk = tl / ntn, k0 = tk * 64, n0 = tn * 64, c = tid & 63;
        int ns = n0 + c;
        if (ns < nperm) { const int p7 = ns & 127, u = p7 >> 3, e = p7 & 7; ns = (ns & ~127) + ((e < 4) ? 4 * u + e : 64 + 4 * u + (e - 4)); }
#pragma unroll
        for (int i = 0; i < 8; ++i) { const int r = (tid >> 6) + 8 * i, n = n0 + c; tile[r * 65 + c] = (n < N) ? src[(size_t)(k0 + r) * N + ns] : 0.f; }
        __syncthreads();
#pragma unroll
        for (int i = 0; i < 4; ++i) { const int id = tid + 512 * i, rr = id >> 5, cp = id & 31;
            ((unsigned*)dst)[((size_t)(n0 + rr) * K + k0) / 2 + cp] = cvt_pk_bf16(tile[(2 * cp) * 65 + rr], tile[(2 * cp + 1) * 65 + rr]); }
        __syncthreads();
    }
}

DI void ph_prologue(PK p, unsigned char* lds, const int wv) {
    PK_FRESH(p);
    const int tid = ltid(wv), lane = tid & 63, wave = __builtin_amdgcn_readfirstlane(tid >> 6);
    float* ldsf = (float*)lds;
    {
        float* sc = ldsf; float* red = ldsf + 4096;
        for (int i = tid; i < 4096; i += 512) sc[i] = silu_f(p->in[1][i]);
        __syncthreads();
        float* mod = WSP(float, WS_MOD);
        for (int item = blockIdx.x; item < MODC / 64; item += gridDim.x) {
            const int col0 = item * 64, col = col0 + lane;
            const float* W; size_t stride;
            if (col0 < 4 * 12288) { const int l = col0 / 12288, j = col - l * 12288; W = p->in[3] + (size_t)l * 2048 * 12288 + j; stride = 12288; }
            else { W = p->in[14] + (col - 4 * 12288); stride = 4096; }
            float a0 = 0.f, a1 = 0.f;
            const int kb = wave * 256;
#pragma unroll 8
            for (int k = 0; k < 256; ++k) { const float wv = W[(size_t)(kb + k) * stride]; a0 += sc[kb + k] * wv; a1 += sc[2048 + kb + k] * wv; }
            red[(wave * 64 + lane) * 2 + 0] = a0; red[(wave * 64 + lane) * 2 + 1] = a1;
            __syncthreads();
            if (tid < 128) { const int ln = tid & 63, b = tid >> 6; float s = 0.f;
#pragma unroll
                for (int w = 0; w < 8; ++w) s += red[(w * 64 + ln) * 2 + b];
                const int cc = col0 + ln; const float bias = (cc < 4 * 12288) ? p->in[4][cc] : p->in[15][cc - 4 * 12288];
                mod[(size_t)b * MODC + cc] = s + bias; }
            __syncthreads();
        }
    }
    for (int job = 0; job < 9; ++job) {
        const float* src; bf16_t* dst; int N = 2048, Npad = 2048, nperm = 0;
        if (job < 2) { src = p->in[7] + (size_t)job * 2048 * GIN; dst = WSP(bf16_t, WS_WIN) + (size_t)job * GINP * 2048; N = GIN; Npad = GINP; }
        else if (job < 4) { src = p->in[12] + (size_t)(job - 2) * 2048 * 2048; dst = WSP(bf16_t, WS_WOUT) + (size_t)(job - 2) * 2048 * 2048; }
        else if (job == 4) { src = p->in[16]; dst = WSP(bf16_t, WS_KVW); N = 4096; Npad = 4096; nperm = 2048; }
        else if (job < 7) { src = p->in[17] + (size_t)(job - 5) * 2048 * 2048; dst = WSP(bf16_t, WS_DWQ) + (size_t)(job - 5) * 2048 * 2048; nperm = 2048; }
        else { src = p->in[20] + (size_t)(job - 7) * 2048 * 2048; dst = WSP(bf16_t, WS_DWO) + (size_t)(job - 7) * 2048 * 2048; }
        cvt_wt_job(src, dst, N, Npad, nperm, ldsf, wv);
    }
    {
        const int lane = tid & 63, r16 = lane & 15, quad = lane >> 4;
        bf16_t* wdst = WSP(bf16_t, WS_PWQ);
        for (int task = (blockIdx.x * 8 + wave); task < 4 * 16 * 128; task += gridDim.x * 8) {
            const int kt = task & 127, pj = (task >> 7) & 15, l = task >> 11, pp = pj >> 1, jh = pj & 1;
            const float* wq = p->in[21] + ((size_t)l * 2048 + kt * 16 + r16) * 2048 + pp * 256 + jh * 128 + quad * 8;
            const float* ky = p->in[22] + ((size_t)(l * 2 + jh) * 128 + r16) * 128 + quad * 8;
            bf16x8 bw[4];
#pragma unroll
            for (int ks = 0; ks < 4; ++ks) { const f32x4 a = *(const f32x4*)(wq + ks * 32), b = *(const f32x4*)(wq + ks * 32 + 4);
                u32x4 w; w.x = cvt_pk_bf16(a[0], a[1]); w.y = cvt_pk_bf16(a[2], a[3]); w.z = cvt_pk_bf16(b[0], b[1]); w.w = cvt_pk_bf16(b[2], b[3]); bw[ks] = __builtin_bit_cast(bf16x8, w); }
#pragma unroll
            for (int nt = 0; nt < 8; ++nt) { f32x4 acc = {0.f, 0.f, 0.f, 0.f};
#pragma unroll
                for (int ks = 0; ks < 4; ++ks) { const f32x4 a = *(const f32x4*)(ky + (size_t)nt * 16 * 128 + ks * 32), b = *(const f32x4*)(ky + (size_t)nt * 16 * 128 + ks * 32 + 4);
                    u32x4 w; w.x = cvt_pk_bf16(a[0], a[1]); w.y = cvt_pk_bf16(a[2], a[3]); w.z = cvt_pk_bf16(b[0], b[1]); w.w = cvt_pk_bf16(b[2], b[3]);
                    acc = MFMA16(bw[ks], __builtin_bit_cast(bf16x8, w), acc); }
                u32x2 wo; wo.x = cvt_pk_bf16(acc[0], acc[1]); wo.y = cvt_pk_bf16(acc[2], acc[3]);
                *(u32x2*)(wdst + ((size_t)l * 2048 + pp * 256 + jh * 128 + nt * 16 + r16) * 2048 + kt * 16 + quad * 4) = wo; }
        }
    }
    {
        float* cosT = WSP(float, WS_COS); float* sinT = WSP(float, WS_SIN); const int* pos = (const int*)p->in[2];
        for (int idx = blockIdx.x * 512 + tid; idx < T * 64; idx += gridDim.x * 512) {
            const int t = idx >> 6, j = idx & 63;
            const double inv = exp(-(double)j * (9.210340371976184 / 64.0));
            const double ang = (double)pos[t] * inv;
            const double n = rint(ang * 0.15915494309189535);
            double r = fma(-n, 6.283185307179586, ang); r = fma(-n, 2.4492935982947064e-16, r);
            float s, c; sincos_red(r, s, c); cosT[idx] = c; sinT[idx] = s;
        }
    }
}

template <int MODE>
DI void ph_norm(const float* x, const bf16_t* xb, const float* g, const float* shift, const float* scale, bf16_t* dstb, float* dstf, const int wv) {
    const int tid = ltid(wv), lane = tid & 63, wave = __builtin_amdgcn_readfirstlane(tid >> 6);
    for (int row = blockIdx.x * 8 + wave; row < T; row += gridDim.x * 8) {
        const int b = row >> 13;
        f32x4 v[8]; float ss = 0.f;
#pragma unroll
        for (int i = 0; i < 8; ++i) {
            if (MODE == 2) { const u32x2 w = *(const u32x2*)(xb + (size_t)row * D + i * 256 + lane * 4); v[i] = (f32x4){bflo(w.x), bfhi(w.x), bflo(w.y), bfhi(w.y)}; }
            else v[i] = *(const f32x4*)(x + (size_t)row * D + i * 256 + lane * 4);
            ss += v[i][0] * v[i][0] + v[i][1] * v[i][1] + v[i][2] * v[i][2] + v[i][3] * v[i][3]; }
        ss = wave_sum(ss);
        const float r = rsqrtf(ss * (1.f / D) + NORM_EPS);
#pragma unroll
        for (int i = 0; i < 8; ++i) { const int col = i * 256 + lane * 4; const f32x4 gv = *(const f32x4*)(g + col);
            if (MODE != 1) { const f32x4 sh = *(const f32x4*)(shift + (size_t)b * MODC + col), sc = *(const f32x4*)(scale + (size_t)b * MODC + col);
                f32x4 y;
#pragma unroll
                for (int e = 0; e < 4; ++e) y[e] = v[i][e] * r * gv[e] * (1.f + sc[e]) + sh[e];
                u32x2 w; w.x = cvt_pk_bf16(y[0], y[1]); w.y = cvt_pk_bf16(y[2], y[3]); *(u32x2*)(dstb + (size_t)row * D + col) = w; }
            else { f32x4 y;
#pragma unroll
                for (int e = 0; e < 4; ++e) y[e] = v[i][e] * r * gv[e];
                *(f32x4*)(dstf + (size_t)row * D + col) = y; } }
    }
}

DI void pc_load(PK p, int l, int row, f32x4 (&v)[8], const int lane) {
    const float* s = ((row >= 16384) ? p->in[24] : p->in[23]) + ((size_t)l * 16384 + (row & 16383)) * 2048;
#pragma unroll
    for (int i = 0; i < 8; ++i) v[i] = *(const f32x4*)(s + lane * 32 + i * 4);
}
DI void pc_store(PK p, int row, const f32x4 (&v)[8], const int lane) {
    const bool second = row >= 16384; const int r = row & 16383;
    unsigned char* dq = WSP(unsigned char, second ? WS_PV : WS_PU); unsigned short* ds = WSP(unsigned short, WS_PUS);
    float m0 = 0.f;
#pragma unroll
    for (int i = 0; i < 8; ++i) { const float mm = fmaxf(fmaxf(fabsf(v[i][0]), fabsf(v[i][1])), fmaxf(fabsf(v[i][2]), fabsf(v[i][3]))); m0 = fmaxf(m0, mm); }
    m0 = fmaxf(m0, sw_xor<1>(m0)); m0 = fmaxf(m0, sw_xor<2>(m0));
    const bf16_t sb0 = (m0 > 0.f) ? f2bf(m0 * (1.004f / 6.f)) : (bf16_t)0x3f80;
    const float inv = 1.f / bf2f(sb0);
    u32x4 w;
#pragma unroll
    for (int c = 0; c < 4; ++c) { unsigned x = 0u;
        x = __builtin_amdgcn_cvt_scalef32_pk_fp4_f32(x, v[2 * c][0] * inv, v[2 * c][1] * inv, 1.0f, 0);
        x = __builtin_amdgcn_cvt_scalef32_pk_fp4_f32(x, v[2 * c][2] * inv, v[2 * c][3] * inv, 1.0f, 1);
        x = __builtin_amdgcn_cvt_scalef32_pk_fp4_f32(x, v[2 * c + 1][0] * inv, v[2 * c + 1][1] * inv, 1.0f, 2);
        x = __builtin_amdgcn_cvt_scalef32_pk_fp4_f32(x, v[2 * c + 1][2] * inv, v[2 * c + 1][3] * inv, 1.0f, 3);
        w[c] = x; }
    *(u32x4*)(dq + (size_t)r * 1024 + lane * 16) = w;
    if ((lane & 3) == 0) ds[((size_t)r * 16 + (lane >> 2)) * 2 + (second ? 1 : 0)] = (unsigned short)sb0;
}
DI void ph_peer_cvt(PK p, int l, const int wv) {
    PK_FRESH(p);
    const int tid = ltid(wv), lane = tid & 63, wave = __builtin_amdgcn_readfirstlane(tid >> 6);
    for (int row = blockIdx.x * 8 + wave; row < 2 * 16384; row += gridDim.x * 8) { f32x4 v[8]; pc_load(p, l, row, v, lane); pc_store(p, row, v, lane); }
}


template <int I, int J>
DI void tinv_block(const bf16_t* Lb, bf16_t* Ti, bf16_t* TT, bf16_t* XT, const int r16, const int quad) {
    constexpr int nK = 16 * (I - J);
    const bf16x8 zero8 = {0, 0, 0, 0, 0, 0, 0, 0};
    f32x4 acc = {0.f, 0.f, 0.f, 0.f};
#pragma unroll
    for (int ks = 0; ks < (nK + 31) / 32; ++ks) {
        const int k0 = ks * 32 + quad * 8; const bool valid = k0 < nK;
        const bf16x8 a = valid ? *(const bf16x8*)(Lb + (16 * I + r16) * 72 + 16 * J + k0) : zero8;
        const bf16x8 b = valid ? *(const bf16x8*)(TT + (16 * J + r16) * 72 + 16 * J + k0) : zero8;
        acc = MFMA16(a, b, acc);
    }
    { u32x2 w; w.x = cvt_pk_bf16(acc[0], acc[1]); w.y = cvt_pk_bf16(acc[2], acc[3]); *(u32x2*)(XT + r16 * 24 + quad * 4) = w; }
    asm volatile("s_waitcnt lgkmcnt(0)" ::: "memory");
    const bool v2 = quad < 2;
    const bf16x8 a2 = v2 ? *(const bf16x8*)(Ti + (16 * I + r16) * 72 + 16 * I + quad * 8) : zero8;
    const bf16x8 b2 = v2 ? *(const bf16x8*)(XT + r16 * 24 + quad * 8) : zero8;
    f32x4 m = {0.f, 0.f, 0.f, 0.f};
    m = MFMA16(a2, b2, m);
#pragma unroll
    for (int r = 0; r < 4; ++r) Ti[(16 * I + quad * 4 + r) * 72 + 16 * J + r16] = f2bf(-m[r]);
    { u32x2 w; w.x = cvt_pk_bf16(-m[0], -m[1]); w.y = cvt_pk_bf16(-m[2], -m[3]); *(u32x2*)(TT + (16 * J + r16) * 72 + 16 * I + quad * 4) = w; }
    asm volatile("s_waitcnt lgkmcnt(0)" ::: "memory");
}

DI void ph_gdn_p1(PK p, int l, unsigned char* lds, const int wv) {
    PK_FRESH(p);
    const bf16_t* proj = WSP(const bf16_t, WS_PROJ);
    const float* convw = p->in[8] + (size_t)l * 4 * 6144; const float* alog = p->in[9] + l * 16; const float* dtb = p->in[10] + l * 16;
    bf16_t* Ag = WSP(bf16_t, WS_GA); bf16_t* Bg = WSP(bf16_t, WS_GB); bf16_t* Qg = WSP(bf16_t, WS_GQ); bf16_t* Og = WSP(bf16_t, WS_GO); float* glg = WSP(float, WS_GL);
    bf16_t* qb  = (bf16_t*)(lds + 0);
    bf16_t* kb  = (bf16_t*)(lds + 17408);
    bf16_t* Lb  = (bf16_t*)(lds + 34816);
    bf16_t* wT  = (bf16_t*)(lds + 17408);
    bf16_t* vbT = (bf16_t*)(lds + 44032);
    bf16_t* kdT = (bf16_t*)(lds + 62464);
    bf16_t* kbT = (bf16_t*)(lds + 80896);
    bf16_t* uT  = (bf16_t*)(lds + 80896);
    bf16_t* aqk = (bf16_t*)(lds + 99328);
    bf16_t* Ti  = (bf16_t*)(lds + 108544);
    bf16_t* TT  = (bf16_t*)(lds + 117760);
    float*  Ld  = (float*)(lds + 126976);
    bf16_t* XT  = (bf16_t*)(lds + 132096);
    float*  sc  = (float*)(lds + 133120);
    float*  cw  = (float*)(lds + 134144);
    int cached_bh = -1;
    for (int it = blockIdx.x; it < 4096; it += gridDim.x) {
        const int tid = ltid(wv), lane = tid & 63, wave = __builtin_amdgcn_readfirstlane(tid >> 6), r16 = lane & 15, quad = lane >> 4;
        const int bh = it & 31, n = it >> 5, hd = bh & 15, b = bh >> 4, tok0 = b * SEQ + n * 64, ci = bh * 128 + n;
        if (bh != cached_bh) {
            for (int idx = tid; idx < 1536; idx += 512) { const int part = idx >> 9, tap = (idx >> 7) & 3, c = idx & 127; cw[idx] = convw[tap * 6144 + part * 2048 + hd * 128 + c]; }
            cached_bh = bh;
            lds_barrier();
        }
        float pa_[4] = {0.f, 0.f, 0.f, 0.f}, pb_[4] = {0.f, 0.f, 0.f, 0.f}, dtbv = 0.f, alogv = 0.f;
        if (tid < 64) { const float* pab = WSP(const float, WS_PAB) + (size_t)(tok0 + tid) * 32 + hd; const size_t qs = (size_t)T * 32;
#pragma unroll
            for (int q4 = 0; q4 < 4; ++q4) { pa_[q4] = pab[q4 * qs]; pb_[q4] = pab[q4 * qs + 16]; }
            dtbv = dtb[hd]; alogv = alog[hd]; }
        {
            const int c16 = tid & 15, t0 = (tid >> 4) * 2;
#pragma unroll
            for (int part = 0; part < 3; ++part) {
                const int ch = part * 2048 + hd * 128 + c16 * 8;
                float xr[5][8];
#pragma unroll
                for (int r = 0; r < 5; ++r) {
                    const int sp = n * 64 + t0 - 3 + r;
                    u32x4 raw = {0u, 0u, 0u, 0u};
                    if (sp >= 0) raw = *(const u32x4*)(proj + (size_t)(b * SEQ + sp) * GINP + ch);
                    xr[r][0] = bflo(raw.x); xr[r][1] = bfhi(raw.x); xr[r][2] = bflo(raw.y); xr[r][3] = bfhi(raw.y); xr[r][4] = bflo(raw.z); xr[r][5] = bfhi(raw.z); xr[r][6] = bflo(raw.w); xr[r][7] = bfhi(raw.w);
                }
                float wt[4][8];
#pragma unroll
                for (int tap = 0; tap < 4; ++tap) { const f32x4 w0 = *(const f32x4*)(cw + (part * 4 + tap) * 128 + c16 * 8), w1 = *(const f32x4*)(cw + (part * 4 + tap) * 128 + c16 * 8 + 4);
                    wt[tap][0] = w0[0]; wt[tap][1] = w0[1]; wt[tap][2] = w0[2]; wt[tap][3] = w0[3]; wt[tap][4] = w1[0]; wt[tap][5] = w1[1]; wt[tap][6] = w1[2]; wt[tap][7] = w1[3]; }
                float av[2][8];
#pragma unroll
                for (int u = 0; u < 2; ++u) {
                    float ss = 0.f;
#pragma unroll
                    for (int e = 0; e < 8; ++e) { float a = wt[0][e] * xr[u][e]; a = fmaf(wt[1][e], xr[u + 1][e], a); a = fmaf(wt[2][e], xr[u + 2][e], a); a = fmaf(wt[3][e], xr[u + 3][e], a);
                        a = silu_f(a); av[u][e] = a; ss += a * a; }
                    if (part < 2) {
                        ss += sw_xor<1>(ss); ss += sw_xor<2>(ss); ss += sw_xor<4>(ss); ss += sw_xor<8>(ss);
                        const float r = rsqrtf(ss + NORM_EPS) * (part == 0 ? 0.08838834764831845f : 1.f);
                        u32x4 w; w.x = cvt_pk_bf16(av[u][0] * r, av[u][1] * r); w.y = cvt_pk_bf16(av[u][2] * r, av[u][3] * r); w.z = cvt_pk_bf16(av[u][4] * r, av[u][5] * r); w.w = cvt_pk_bf16(av[u][6] * r, av[u][7] * r);
                        *(u32x4*)((part == 0 ? qb : kb) + (t0 + u) * 136 + c16 * 8) = w;
                    }
                }
                if (part == 2) {
#pragma unroll
                    for (int e = 0; e < 8; ++e) *(unsigned*)(vbT + (c16 * 8 + e) * 72 + t0) = cvt_pk_bf16(av[0][e], av[1][e]);
                }
            }
        }
        if (tid < 64) {
            const int t = tid;
            const float av = (pa_[0] + pa_[1]) + (pa_[2] + pa_[3]), bv = (pb_[0] + pb_[1]) + (pb_[2] + pb_[3]);
            const float xx = av + dtbv;
            const float ex = __expf(xx); const float sp = (xx > 20.f) ? xx : ((xx < -8.f) ? ex * (1.f - 0.5f * ex) : __logf(1.f + ex));
            const float g = -__expf(alogv) * sp;
            const float beta = 1.f / (1.f + __expf(-bv));
            float G = g;
#pragma unroll
            for (int d = 1; d < 64; d <<= 1) { const float o = __int_as_float(__builtin_amdgcn_ds_bpermute(((t - d) & 63) << 2, __float_as_int(G))); if (t >= d) G += o; }
            const float Gl = __int_as_float(__builtin_amdgcn_readlane(__float_as_int(G), 63));
            sc[t] = beta; sc[64 + t] = G; sc[128 + t] = __expf(G); sc[192 + t] = __expf(Gl - G);
            if (t == 63) glg[ci] = __expf(G);
        }
        lds_barrier();
        {
            const int which = wave >> 2, mi = wave & 3;
#pragma unroll
            for (int ni = 0; ni < 4; ++ni) {
                if (which == 0 ? (ni >= mi) : (ni <= mi)) {
                    f32x4 acc = {0.f, 0.f, 0.f, 0.f};
                    const bf16_t* Ab = (which ? qb : kb) + (mi * 16 + r16) * 136 + quad * 8;
                    const bf16_t* Bb = kb + (ni * 16 + r16) * 136 + quad * 8;
#pragma unroll
                    for (int ks = 0; ks < 4; ++ks) acc = MFMA16(*(const bf16x8*)(Ab + ks * 32), *(const bf16x8*)(Bb + ks * 32), acc);
                    const int cidx = ni * 16 + r16; const float Gc = sc[64 + cidx];
                    if (which == 0) {
                        const float bi = sc[cidx]; f32x4 lv;
#pragma unroll
                        for (int r = 0; r < 4; ++r) { const int jj = mi * 16 + quad * 4 + r; lv[r] = (jj < cidx) ? bi * acc[r] * __expf(fminf(Gc - sc[64 + jj], 0.f)) : 0.f; }
                        if (ni == mi) *(f32x4*)(Ld + mi * 320 + r16 * 20 + quad * 4) = lv;
                        else { u32x2 w; w.x = cvt_pk_bf16(lv[0], lv[1]); w.y = cvt_pk_bf16(lv[2], lv[3]); *(u32x2*)(Lb + cidx * 72 + mi * 16 + quad * 4) = w; }
                    } else {
#pragma unroll
                        for (int r = 0; r < 4; ++r) { const int ii = mi * 16 + quad * 4 + r; aqk[ii * 72 + cidx] = f2bf((cidx <= ii) ? acc[r] * __expf(fminf(sc[64 + ii] - Gc, 0.f)) : 0.f); }
                    }
                } else if (which == 1) {
#pragma unroll
                    for (int r = 0; r < 4; ++r) aqk[(mi * 16 + quad * 4 + r) * 72 + ni * 16 + r16] = 0;
                }
            }
        }
        lds_barrier();
        {
            const int a = tid & 127, tq = tid >> 7;
#pragma unroll
            for (int q = 0; q < 2; ++q) { const int t0 = tq * 16 + q * 8; float v[8];
#pragma unroll
                for (int e = 0; e < 8; ++e) v[e] = bf2f(kb[(t0 + e) * 136 + a]);
                u32x4 w; w.x = cvt_pk_bf16(v[0], v[1]); w.y = cvt_pk_bf16(v[2], v[3]); w.z = cvt_pk_bf16(v[4], v[5]); w.w = cvt_pk_bf16(v[6], v[7]);
                *(u32x4*)(kbT + a * 72 + t0) = w;
#pragma unroll
                for (int e = 0; e < 8; ++e) v[e] *= sc[192 + t0 + e];
                w.x = cvt_pk_bf16(v[0], v[1]); w.y = cvt_pk_bf16(v[2], v[3]); w.z = cvt_pk_bf16(v[4], v[5]); w.w = cvt_pk_bf16(v[6], v[7]);
                *(u32x4*)(kdT + a * 72 + t0) = w; }
        }
        if (wave == 0) {
            const float* Lrow = Ld + quad * 320;
            float x[16];
#pragma unroll
            for (int i = 0; i < 16; ++i) { float s = (i == r16) ? 1.f : 0.f;
#pragma unroll
                for (int j = 0; j < i; ++j) s -= Lrow[i * 20 + j] * x[j];
                x[i] = s; }
#pragma unroll
            for (int i = 0; i < 16; ++i) Ti[(16 * quad + i) * 72 + 16 * quad + r16] = f2bf(x[i]);
            { u32x4 w0, w1; w0.x = cvt_pk_bf16(x[0], x[1]); w0.y = cvt_pk_bf16(x[2], x[3]); w0.z = cvt_pk_bf16(x[4], x[5]); w0.w = cvt_pk_bf16(x[6], x[7]);
              w1.x = cvt_pk_bf16(x[8], x[9]); w1.y = cvt_pk_bf16(x[10], x[11]); w1.z = cvt_pk_bf16(x[12], x[13]); w1.w = cvt_pk_bf16(x[14], x[15]);
              *(u32x4*)(TT + (16 * quad + r16) * 72 + 16 * quad) = w0; *(u32x4*)(TT + (16 * quad + r16) * 72 + 16 * quad + 8) = w1; }
            asm volatile("s_waitcnt lgkmcnt(0)" ::: "memory");
            tinv_block<1, 0>(Lb, Ti, TT, XT, r16, quad); tinv_block<2, 1>(Lb, Ti, TT, XT, r16, quad); tinv_block<3, 2>(Lb, Ti, TT, XT, r16, quad);
            tinv_block<2, 0>(Lb, Ti, TT, XT, r16, quad); tinv_block<3, 1>(Lb, Ti, TT, XT, r16, quad);
            tinv_block<3, 0>(Lb, Ti, TT, XT, r16, quad);
        }
        lds_barrier();
        {
            const int i = tid >> 3, t0 = (tid & 7) * 8; const bool low = (t0 >> 4) <= (i >> 4);
            const u32x4 raw = *(const u32x4*)(Ti + i * 72 + t0);
            float v[8] = {bflo(raw.x), bfhi(raw.x), bflo(raw.y), bfhi(raw.y), bflo(raw.z), bfhi(raw.z), bflo(raw.w), bfhi(raw.w)}; float tw[8], tu[8];
#pragma unroll
            for (int e = 0; e < 8; ++e) { const float be = sc[t0 + e]; tu[e] = low ? v[e] * be : 0.f; tw[e] = low ? v[e] * be * sc[128 + t0 + e] : 0.f; }
            u32x4 w; w.x = cvt_pk_bf16(tw[0], tw[1]); w.y = cvt_pk_bf16(tw[2], tw[3]); w.z = cvt_pk_bf16(tw[4], tw[5]); w.w = cvt_pk_bf16(tw[6], tw[7]);
            u32x4 u; u.x = cvt_pk_bf16(tu[0], tu[1]); u.y = cvt_pk_bf16(tu[2], tu[3]); u.z = cvt_pk_bf16(tu[4], tu[5]); u.w = cvt_pk_bf16(tu[6], tu[7]);
            *(u32x4*)(Ti + i * 72 + t0) = w; *(u32x4*)(TT + i * 72 + t0) = u;
        }
        lds_barrier();
#pragma unroll
        for (int pass = 0; pass < 2; ++pass) {
            const bf16_t* Aop = pass ? TT : Ti; const bf16_t* Bop = pass ? vbT : kbT; bf16_t* outT = pass ? uT : wT;
            f32x4 acc4[4];
#pragma unroll
            for (int mi = 0; mi < 4; ++mi) { f32x4 acc = {0.f, 0.f, 0.f, 0.f};
#pragma unroll
                for (int ks = 0; ks < 2; ++ks) acc = MFMA16(*(const bf16x8*)(Aop + (mi * 16 + r16) * 72 + ks * 32 + quad * 8), *(const bf16x8*)(Bop + (wave * 16 + r16) * 72 + ks * 32 + quad * 8), acc);
                acc4[mi] = acc; }
            if (pass == 1) lds_barrier();
#pragma unroll
            for (int mi = 0; mi < 4; ++mi) { u32x2 w; w.x = cvt_pk_bf16(acc4[mi][0], acc4[mi][1]); w.y = cvt_pk_bf16(acc4[mi][2], acc4[mi][3]); *(u32x2*)(outT + (wave * 16 + r16) * 72 + mi * 16 + quad * 4) = w; }
        }
        lds_barrier();
        {
#pragma unroll
            for (int i = 0; i < 24; ++i) {
                const int prod = (i < 8) ? 0 : (i < 16) ? 1 : (i < 20) ? 2 : 3;
                const int mi = (i < 8) ? i : (i < 16) ? (i - 8) : (i < 20) ? (i - 16) : (i - 20), ni = wave;
                const bf16_t* X = ((prod < 2) ? kdT : aqk) + (mi * 16 + r16) * 72 + quad * 8;
                const bf16_t* Y = ((prod & 1) ? uT : wT) + (ni * 16 + r16) * 72 + quad * 8;
                f32x4 acc = {0.f, 0.f, 0.f, 0.f};
                if (prod == 1) {
#pragma unroll
                    for (int ks = 0; ks < 2; ++ks) acc = MFMA16(*(const bf16x8*)(X + ks * 32), *(const bf16x8*)(Y + ks * 32), acc);
                    u32x2 w; w.x = cvt_pk_bf16(acc[0], acc[1]); w.y = cvt_pk_bf16(acc[2], acc[3]);
                    *(u32x2*)(Bg + (size_t)ci * 16384 + (ni * 16 + r16) * 128 + mi * 16 + quad * 4) = w;
                    continue;
                }
#pragma unroll
                for (int ks = 0; ks < 2; ++ks) acc = MFMA16(*(const bf16x8*)(Y + ks * 32), *(const bf16x8*)(X + ks * 32), acc);
                const int m = mi * 16 + r16, n0 = ni * 16 + quad * 4;
                if (prod == 0) acc = -acc;
                if (prod == 2) { const u32x2 qv = *(const u32x2*)(qb + m * 136 + n0); const float eg = sc[128 + m];
                    acc[0] = bflo(qv.x) * eg - acc[0]; acc[1] = bfhi(qv.x) * eg - acc[1]; acc[2] = bflo(qv.y) * eg - acc[2]; acc[3] = bfhi(qv.y) * eg - acc[3]; }
                bf16_t* outp = ((prod == 0) ? (Ag + (size_t)ci * 16384) : (prod == 2) ? (Qg + (size_t)ci * 8192) : (Og + (size_t)ci * 8192)) + m * 128 + n0;
                u32x2 w; w.x = cvt_pk_bf16(acc[0], acc[1]); w.y = cvt_pk_bf16(acc[2], acc[3]); *(u32x2*)outp = w;
            }
        }
        lds_barrier();
    }
}

DI void ph_gdn_p2(PK p, unsigned char* lds, const int wv) {
    PK_FRESH(p);
    const int tid = ltid(wv), lane = tid & 63, wave = __builtin_amdgcn_readfirstlane(tid >> 6), r16 = lane & 15, quad = lane >> 4, a0 = wave * 16;
    const bf16_t* Ag = WSP(const bf16_t, WS_GA); const bf16_t* Bg = WSP(const bf16_t, WS_GB); bf16_t* Sg = WSP(bf16_t, WS_GS); const float* glg = WSP(const float, WS_GL);
    bf16_t* ST = (bf16_t*)lds;
#define P2_LOAD(AF, BM, GL, cidx) do { const size_t c_ = (cidx); _Pragma("unroll") for (int ks = 0; ks < 4; ++ks) AF[ks] = *(const bf16x8*)(Ag + c_ * 16384 + (size_t)(a0 + r16) * 128 + ks * 32 + quad * 8); \
        BM = *(const u32x2*)(Bg + c_ * 16384 + (size_t)(v0 + r16) * 128 + a0 + quad * 4); GL = glg[c_]; } while (0)
    for (int item = blockIdx.x; item < 256; item += gridDim.x) {
        const int bh = (item & 7) * 4 + (item >> 6), v0 = ((item >> 3) & 7) * 16;
        const size_t cb = (size_t)bh * 128;
        f32x4 S = {0.f, 0.f, 0.f, 0.f};
        bf16x8 afA[4], afB[4], afC[4], afD[4]; u32x2 bmA, bmB, bmC, bmD; float glA, glB, glC, glD;
        P2_LOAD(afA, bmA, glA, cb); P2_LOAD(afB, bmB, glB, cb + 1); P2_LOAD(afC, bmC, glC, cb + 2);
#define P2_STEP(AFc, BMc, GLc, AFp, BMp, GLp, nn) do { const int n_ = (nn); const size_t ci = cb + n_; \
            P2_LOAD(AFp, BMp, GLp, cb + ((n_ + 3 < 128) ? n_ + 3 : 127));        \
            u32x2 sp; sp.x = cvt_pk_bf16(S[0], S[1]); sp.y = cvt_pk_bf16(S[2], S[3]); \
            bf16_t* STb = ST + (n_ & 1) * (16 * 136); \
            *(u32x2*)(STb + r16 * 136 + a0 + quad * 4) = sp; \
            *(u32x2*)(Sg + ci * 16384 + (size_t)(v0 + r16) * 128 + a0 + quad * 4) = sp; \
            lds_barrier(); \
            f32x4 acc; acc[0] = GLc * S[0] + bflo(BMc.x); acc[1] = GLc * S[1] + bfhi(BMc.x); acc[2] = GLc * S[2] + bflo(BMc.y); acc[3] = GLc * S[3] + bfhi(BMc.y); \
            bf16x8 bfr_[4]; _Pragma("unroll") for (int ks = 0; ks < 4; ++ks) bfr_[ks] = *(const bf16x8*)(STb + r16 * 136 + ks * 32 + quad * 8);        \
            _Pragma("unroll") for (int ks = 0; ks < 4; ++ks) acc = MFMA16(AFc[ks], bfr_[ks], acc); \
            S = acc; } while (0)
        for (int n = 0; n < 128; n += 4) {
            P2_STEP(afA, bmA, glA, afD, bmD, glD, n);
            P2_STEP(afB, bmB, glB, afA, bmA, glA, n + 1);
            P2_STEP(afC, bmC, glC, afB, bmB, glB, n + 2);
            P2_STEP(afD, bmD, glD, afC, bmC, glC, n + 3);
        }
#undef P2_STEP
        lds_barrier();
    }
#undef P2_LOAD
}

DI void ph_gdn_p3(PK p, int l, const int wv) {
    PK_FRESH(p);
    const int tid = ltid(wv), lane = tid & 63, wave = __builtin_amdgcn_readfirstlane(tid >> 6), r16 = lane & 15, quad = lane >> 4;
    const bf16_t* Qg = WSP(const bf16_t, WS_GQ); const bf16_t* Og = WSP(const bf16_t, WS_GO); const bf16_t* Sg = WSP(const bf16_t, WS_GS);
    const bf16_t* proj = WSP(const bf16_t, WS_PROJ); bf16_t* obuf = WSP(bf16_t, WS_OBUF); const float* ogain = p->in[11] + l * 128;
    for (int it = blockIdx.x; it < 2048; it += gridDim.x) {
        const int ci = it * 2 + (wave >> 2), mi = wave & 3;
        const int n = ci & 127, bh = ci >> 7, hd = bh & 15, b = bh >> 4;
        const int i = mi * 16 + r16; const size_t tok = (size_t)b * SEQ + n * 64 + i;
        bf16x8 qa[4], sf[4][8]; u32x2 ov[8], zv[8];
#pragma unroll
        for (int ks = 0; ks < 4; ++ks) { qa[ks] = *(const bf16x8*)(Qg + (size_t)ci * 8192 + i * 128 + ks * 32 + quad * 8);
#pragma unroll
            for (int ni = 0; ni < 8; ++ni) sf[ks][ni] = *(const bf16x8*)(Sg + (size_t)ci * 16384 + (ni * 16 + r16) * 128 + ks * 32 + quad * 8); }
#pragma unroll
        for (int ni = 0; ni < 8; ++ni) { ov[ni] = *(const u32x2*)(Og + (size_t)ci * 8192 + i * 128 + ni * 16 + quad * 4); zv[ni] = *(const u32x2*)(proj + tok * GINP + 6144 + hd * 128 + ni * 16 + quad * 4); }
        f32x4 acc[8];
#pragma unroll
        for (int ni = 0; ni < 8; ++ni) acc[ni] = (f32x4){0.f, 0.f, 0.f, 0.f};
#pragma unroll
        for (int ks = 0; ks < 4; ++ks)
#pragma unroll
            for (int ni = 0; ni < 8; ++ni) acc[ni] = MFMA16(sf[ks][ni], qa[ks], acc[ni]);
        float ss = 0.f;
#pragma unroll
        for (int ni = 0; ni < 8; ++ni) {
            acc[ni][0] += bflo(ov[ni].x); acc[ni][1] += bfhi(ov[ni].x); acc[ni][2] += bflo(ov[ni].y); acc[ni][3] += bfhi(ov[ni].y);
            ss += acc[ni][0] * acc[ni][0] + acc[ni][1] * acc[ni][1] + acc[ni][2] * acc[ni][2] + acc[ni][3] * acc[ni][3]; }
        ss += sw_xor<16>(ss); ss = sw_xor32_sum(ss);
        const float rms = rsqrtf(ss * (1.f / 128.f) + NORM_EPS);
#pragma unroll
        for (int ni = 0; ni < 8; ++ni) { const int v = ni * 16 + quad * 4; const f32x4 gv = *(const f32x4*)(ogain + v);
            const float y0 = acc[ni][0] * rms * gv[0] * silu_f(bflo(zv[ni].x)), y1 = acc[ni][1] * rms * gv[1] * silu_f(bfhi(zv[ni].x));
            const float y2 = acc[ni][2] * rms * gv[2] * silu_f(bflo(zv[ni].y)), y3 = acc[ni][3] * rms * gv[3] * silu_f(bfhi(zv[ni].y));
            u32x2 w; w.x = cvt_pk_bf16(y0, y1); w.y = cvt_pk_bf16(y2, y3); *(u32x2*)(obuf + tok * D + hd * 128 + v) = w; }
    }
}

DI void ph_rope(PK p, const bf16_t* src, int ld, bf16_t* dst, const int wv) {
    PK_FRESH(p);
    const int tid = ltid(wv); const float* cosT = WSP(const float, WS_COS); const float* sinT = WSP(const float, WS_SIN);
    for (int idx = blockIdx.x * 512 + tid; idx < T * 128; idx += gridDim.x * 512) {
        const int jc = idx & 7, hc = (idx >> 3) & 15, t = idx >> 7;
        const bf16_t* sp = src + (size_t)t * ld + hc * 128 + jc * 8;
        const u32x4 x1 = *(const u32x4*)sp, x2 = *(const u32x4*)(sp + 64);
        const f32x4 c0 = *(const f32x4*)(cosT + t * 64 + jc * 8), c1 = *(const f32x4*)(cosT + t * 64 + jc * 8 + 4);
        const f32x4 s0 = *(const f32x4*)(sinT + t * 64 + jc * 8), s1 = *(const f32x4*)(sinT + t * 64 + jc * 8 + 4);
        float a[8] = {bflo(x1.x), bfhi(x1.x), bflo(x1.y), bfhi(x1.y), bflo(x1.z), bfhi(x1.z), bflo(x1.w), bfhi(x1.w)};
        float bb[8] = {bflo(x2.x), bfhi(x2.x), bflo(x2.y), bfhi(x2.y), bflo(x2.z), bfhi(x2.z), bflo(x2.w), bfhi(x2.w)};
        float cs[8] = {c0[0], c0[1], c0[2], c0[3], c1[0], c1[1], c1[2], c1[3]}, sn[8] = {s0[0], s0[1], s0[2], s0[3], s1[0], s1[1], s1[2], s1[3]};
        float o1[8], o2[8];
#pragma unroll
        for (int e = 0; e < 8; ++e) { o1[e] = a[e] * cs[e] - bb[e] * sn[e]; o2[e] = bb[e] * cs[e] + a[e] * sn[e]; }
        const int b = t >> 13, s = t & 8191;
        bf16_t* dp = dst + ((size_t)(b * 16 + hc) * SEQ + s) * 128 + jc * 8;
        u32x4 w1, w2;
        w1.x = cvt_pk_bf16(o1[0], o1[1]); w1.y = cvt_pk_bf16(o1[2], o1[3]); w1.z = cvt_pk_bf16(o1[4], o1[5]); w1.w = cvt_pk_bf16(o1[6], o1[7]);
        w2.x = cvt_pk_bf16(o2[0], o2[1]); w2.y = cvt_pk_bf16(o2[2], o2[3]); w2.z = cvt_pk_bf16(o2[4], o2[5]); w2.w = cvt_pk_bf16(o2[6], o2[7]);
        *(u32x4*)dp = w1; *(u32x4*)(dp + 64) = w2;
    }
}
DI void ph_vrelayout(const bf16_t* src, bf16_t* dst, const int wv) {
    const int tid = ltid(wv);
    for (int idx = blockIdx.x * 512 + tid; idx < T * 256; idx += gridDim.x * 512) {
        const int ch = idx & 15, hc = (idx >> 4) & 15, t = idx >> 8; const int b = t >> 13, s = t & 8191;
        *(u32x4*)(dst + ((size_t)(b * 16 + hc) * SEQ + s) * 128 + ch * 8) = *(const u32x4*)(src + (size_t)t * 4096 + 2048 + hc * 128 + ch * 8);
    }
}

DI void ph_attn(PK p, unsigned char* lds, const int wv) {
    PK_FRESH(p);
    using att::bf16;
    const bf16* Qd = WSP(const bf16, WS_QD); const bf16* Ksh = WSP(const bf16, WS_KSH); const bf16* Vsh = WSP(const bf16, WS_VSH); bf16* Oat = WSP(bf16, WS_OAT);
    const int total = 64 * 16, stride = gridDim.x, W = SEQ;
    int L = blockIdx.x;
    if (L < total) {
        auto mkref = [&](int Li, int pass) {
            const int xcd = Li & 7, jk = Li >> 3, mm = (jk & 127) >> 4, x = jk & 15, h64 = xcd * 8 + mm, qb = pass ? (31 - x) : x;
            const int vh = h64 & 1, c = (h64 >> 1) & 1, bh = h64 >> 2;
            att::BlockRef<bf16, bf16> r;
            r.Q = Qd + ((size_t)(bh * 2 + c) * SEQ + (size_t)qb * 256) * 128;
            r.K = Ksh + (size_t)(bh * 2 + c) * SEQ * 128;
            r.V = Vsh + (size_t)(bh * 2 + vh) * SEQ * 128;
            r.O = Oat + ((size_t)((bh * 2 + c) * 2 + vh) * SEQ + (size_t)qb * 256) * 128;
            r.P0 = qb * 256; return r; };
        int pass = 0;
        att::BlockRef<bf16, bf16> cur = mkref(L, 0);
        att::Seam<bf16> S;
        att::causal_swa_prime<bf16, bf16>(cur, W, (char*)lds, S, wv);
        for (;;) {
            const bool more_pass = pass == 0, more_item = L + stride < total, last = !more_pass && !more_item;
            int passn = pass + 1, Ln = L;
            if (!more_pass) { passn = 0; Ln = more_item ? L + stride : L; }
            const att::BlockRef<bf16, bf16> nxt = last ? cur : mkref(Ln, passn);
            att::causal_swa_block<bf16, bf16>(cur, nxt, SEQ, W, (char*)lds, S, wv);
            if (last) break;
            cur = nxt; pass = passn; L = Ln;
        }
    }
    __syncthreads();
}

DI void ph_diff_combine(PK p, int j, int l, unsigned char* lds, const int wv) {
    PK_FRESH(p);
    const int tid = ltid(wv), lane = tid & 63, wave = __builtin_amdgcn_readfirstlane(tid >> 6);
    float* ldsf = (float*)lds;
    const float lambda_init = 0.8f - 0.6f * expf(-0.3f * (float)l);
    if (wave == 0) { const float* lp = p->in[18] + j * 512;
        float a = lp[lane] * lp[128 + lane] + lp[64 + lane] * lp[192 + lane], bsum = lp[256 + lane] * lp[384 + lane] + lp[320 + lane] * lp[448 + lane];
        a = wave_sum(a); bsum = wave_sum(bsum);
        if (lane == 0) ldsf[0] = expf(a) - expf(bsum) + lambda_init; }
    __syncthreads();
    const float lam = ldsf[0], om = 1.f - lambda_init;
    const bf16_t* Oat = WSP(const bf16_t, WS_OAT); bf16_t* obuf = WSP(bf16_t, WS_OBUF); const float* sg = p->in[19] + j * 256;
    for (int row = blockIdx.x * 8 + wave; row < T * 8; row += gridDim.x * 8) {
        const int t = row >> 3, h = row & 7, b = t >> 13, s = t & 8191, vh = lane >> 5, d = (lane & 31) * 4;
        const u32x2 o1 = *(const u32x2*)(Oat + ((size_t)(((b * 8 + h) * 2 + 0) * 2 + vh) * SEQ + s) * 128 + d);
        const u32x2 o2 = *(const u32x2*)(Oat + ((size_t)(((b * 8 + h) * 2 + 1) * 2 + vh) * SEQ + s) * 128 + d);
        float v[4] = {bflo(o1.x) - lam * bflo(o2.x), bfhi(o1.x) - lam * bfhi(o2.x), bflo(o1.y) - lam * bflo(o2.y), bfhi(o1.y) - lam * bfhi(o2.y)};
        float ss = v[0] * v[0] + v[1] * v[1] + v[2] * v[2] + v[3] * v[3];
        ss = wave_sum(ss);
        const float rms = rsqrtf(ss * (1.f / 256.f) + NORM_EPS) * om;
        const f32x4 gv = *(const f32x4*)(sg + vh * 128 + d);
        u32x2 w; w.x = cvt_pk_bf16(v[0] * rms * gv[0], v[1] * rms * gv[1]); w.y = cvt_pk_bf16(v[2] * rms * gv[2], v[3] * rms * gv[3]);
        *(u32x2*)(obuf + (size_t)t * D + h * 256 + vh * 128 + d) = w;
    }
    __syncthreads();
}

#define INS16(Lr, vv) do { _Pragma("unroll") for (int k_ = 0; k_ < 16; ++k_) { const float hi_ = fmaxf(Lr[k_], vv); vv = fminf(Lr[k_], vv); Lr[k_] = hi_; } } while (0)
DI void sort16_desc(float (&L)[16]) {
#pragma unroll
    for (int k = 2; k <= 16; k <<= 1)
#pragma unroll
        for (int j = k >> 1; j >= 1; j >>= 1)
#pragma unroll
            for (int i = 0; i < 16; ++i) { const int l = i ^ j;
                if (l > i) { const float hi_ = fmaxf(L[i], L[l]), lo_ = fminf(L[i], L[l]); const bool desc = (i & k) == 0; L[i] = desc ? hi_ : lo_; L[l] = desc ? lo_ : hi_; } }
}
template <int XM> DI void merge16(float (&L)[16]) {
    float P[16];
#pragma unroll
    for (int i = 0; i < 16; ++i) P[i] = sw_xor<XM>(L[15 - i]);
#pragma unroll
    for (int i = 0; i < 16; ++i) L[i] = fmaxf(L[i], P[i]);
#pragma unroll
    for (int s = 8; s >= 1; s >>= 1)
#pragma unroll
        for (int i = 0; i < 16; ++i) if ((i & s) == 0) { const float hi_ = fmaxf(L[i], L[i + s]), lo_ = fminf(L[i], L[i + s]); L[i] = hi_; L[i + s] = lo_; }
}
__constant__ unsigned kStairPk[16] = {0x20100800u, 0xffe07033u, 0x21110901u, 0xfff07140u, 0x22120a02u, 0xffff8041u, 0x23130b03u, 0xffff9042u, 0x24140c04u, 0xffffa050u, 0x30150d05u, 0xffffb051u, 0x31160e06u, 0xffffc060u, 0x32170f07u, 0xffffd061u};
DI void ph_peer_topk(PK p, int l, unsigned char* lds, const int wv) {
    PK_FRESH(p);
    const int tid = ltid(wv);
    float* tops = (float*)lds; float* fin = tops + 64 * 2 * 16;
    const bf16_t* pq = WSP(const bf16_t, WS_PQ);
    int* pidx = WSP(int, WS_PIDX); float* pgate = WSP(float, WS_PGATE);
    const float NEG = -__builtin_inff();
    const int rowl = tid >> 3, half = (tid >> 2) & 1, quarter = tid & 3, l8 = tid & 7;
    const int nitems = T * 8 / 64;
    const int lane = tid & 63, wave = __builtin_amdgcn_readfirstlane(tid >> 6);
    int crow = blockIdx.x * 8 + wave; const int cstep = gridDim.x * 8;
    const u32x2 stw = *(const u32x2*)(kStairPk + l8 * 2);
    u32x4 wn[4];
    if ((int)blockIdx.x < nitems) { const int row = blockIdx.x * 64 + rowl; const bf16_t* sp = pq + (size_t)(row >> 3) * 2048 + (row & 7) * 256 + half * 128 + quarter * 32;
#pragma unroll
        for (int c = 0; c < 4; ++c) wn[c] = *(const u32x4*)(sp + c * 8); }
    for (int item = blockIdx.x; item < nitems; item += gridDim.x) {
        const int row0 = item * 64;
        u32x4 wc[4];
#pragma unroll
        for (int c = 0; c < 4; ++c) wc[c] = wn[c];
        { const int itn = (item + (int)gridDim.x < nitems) ? item + (int)gridDim.x : item; const int row = itn * 64 + rowl;
          const bf16_t* sp = pq + (size_t)(row >> 3) * 2048 + (row & 7) * 256 + half * 128 + quarter * 32;
#pragma unroll
          for (int c = 0; c < 4; ++c) wn[c] = *(const u32x4*)(sp + c * 8); }
        f32x4 cv[8]; const bool cA = crow < 2 * 16384; if (cA) pc_load(p, l, crow, cv, lane);
        float Lr[16], Lq[16];
#pragma unroll
        for (int c = 0; c < 4; ++c)
#pragma unroll
            for (int e = 0; e < 4; ++e) { const unsigned w = wc[c][e];
                const float v0 = __uint_as_float((w << 16) | (unsigned)(quarter * 32 + c * 8 + e * 2)), v1 = __uint_as_float((w & 0xffff0000u) | (unsigned)(quarter * 32 + c * 8 + e * 2 + 1));
                if (c < 2) { Lr[c * 8 + e * 2] = v0; Lr[c * 8 + e * 2 + 1] = v1; } else { Lq[(c - 2) * 8 + e * 2] = v0; Lq[(c - 2) * 8 + e * 2 + 1] = v1; } }
        sort16_desc(Lr); sort16_desc(Lq);
#pragma unroll
        for (int i = 0; i < 16; ++i) Lr[i] = fmaxf(Lr[i], Lq[15 - i]);
#pragma unroll
        for (int s = 8; s >= 1; s >>= 1)
#pragma unroll
            for (int i = 0; i < 16; ++i) if ((i & s) == 0) { const float hi_ = fmaxf(Lr[i], Lr[i + s]), lo_ = fminf(Lr[i], Lr[i + s]); Lr[i] = hi_; Lr[i + s] = lo_; }
        if (cA) { pc_store(p, crow, cv, lane); crow += cstep; }
        const bool cB = crow < 2 * 16384; if (cB) pc_load(p, l, crow, cv, lane);
        merge16<1>(Lr); merge16<2>(Lr);
        if (quarter == 0) {
#pragma unroll
            for (int k = 0; k < 16; ++k) tops[(rowl * 2 + half) * 16 + k] = Lr[k];
        }
        asm volatile("s_waitcnt lgkmcnt(0)" ::: "memory");
        float M[16];
#pragma unroll
        for (int k = 0; k < 16; ++k) M[k] = NEG;
        {
            const float* ta = tops + (rowl * 2) * 16; const float* tb = ta + 16;
#pragma unroll
            for (int m = 0; m < 7; ++m) { const unsigned code = (((m < 4) ? stw.x : stw.y) >> (8 * (m & 3))) & 255u;
                float s = (code < 255u) ? ta[code >> 4] + tb[code & 15u] : NEG;
                s = (code < 255u) ? __uint_as_float((__float_as_uint(s) & ~255u) | code) : NEG; INS16(M, s); }
        }
        merge16<1>(M); merge16<2>(M); merge16<4>(M);
        float sum = 0.f;
#pragma unroll
        for (int k = 0; k < 16; ++k) sum += __expf(M[k] - M[0]);
        if (l8 == 0) {
#pragma unroll
            for (int k = 0; k < 16; ++k) fin[rowl * 16 + k] = M[k];
        }
        asm volatile("s_waitcnt lgkmcnt(0)" ::: "memory");
        {
            const float inv = 1.f / sum, m0 = M[0]; const int row = row0 + rowl; const size_t ob = (size_t)(row >> 3) * 128 + (row & 7) * 16;
#pragma unroll
            for (int u = 0; u < 2; ++u) { const int k = l8 * 2 + u; const float mk = fin[rowl * 16 + k]; const unsigned code = __float_as_uint(mk) & 255u;
                const unsigned i1 = __float_as_uint(tops[(rowl * 2) * 16 + (code >> 4)]) & 127u, i2 = __float_as_uint(tops[(rowl * 2 + 1) * 16 + (code & 15u)]) & 127u;
                pidx[ob + k] = (int)(i1 * 128u + i2); pgate[ob + k] = __expf(mk - m0) * inv; }
        }
        if (cB) { pc_store(p, crow, cv, lane); crow += cstep; }
        asm volatile("s_waitcnt lgkmcnt(0)" ::: "memory");
    }
    for (; crow < 2 * 16384; crow += cstep) { f32x4 cv[8]; pc_load(p, l, crow, cv, lane); pc_store(p, crow, cv, lane); }
}

DI float gelu_f(float v) {
    const float av = fabsf(v), t = __builtin_amdgcn_rcpf(fmaf(av, 0.2316418882f, 1.0f));
    float q = fmaf(t, 0.5307027145f, -0.7265760135f); q = fmaf(q, t, 0.7107068705f); q = fmaf(q, t, -0.142248368f); q = fmaf(q, t, 0.127414796f); q = q * t;
    const float e = __builtin_amdgcn_exp2f(v * v * -0.72134752044f), m = v * (q * e);
    return v < 0.f ? m : v - m;
}
#define FP4X8(w, o) const f32x2 o##0 = __builtin_amdgcn_cvt_scalef32_pk_f32_fp4(w, 1.0f, 0), o##1 = __builtin_amdgcn_cvt_scalef32_pk_f32_fp4(w, 1.0f, 1), \
                                o##2 = __builtin_amdgcn_cvt_scalef32_pk_f32_fp4(w, 1.0f, 2), o##3 = __builtin_amdgcn_cvt_scalef32_pk_f32_fp4(w, 1.0f, 3)
DI void ph_peer_gather(PK p, int l, unsigned char* lds, const int wv, const bool apply = true) {
    PK_FRESH(p);
    const int tid = ltid(wv), lane = tid & 63, wave = __builtin_amdgcn_readfirstlane(tid >> 6);
    const bf16_t* hb = WSP(const bf16_t, WS_HBUF); const unsigned char* ub = WSP(const unsigned char, WS_PU); const unsigned char* vb = WSP(const unsigned char, WS_PV);
    const unsigned char* psc8 = WSP(const unsigned char, WS_PUS);
    const int* pidx = WSP(const int, WS_PIDX); const float* pgate = WSP(const float, WS_PGATE); bf16_t* xc = WSP(bf16_t, WS_XCUR);
    const float* gt2 = WSP(const float, WS_MOD) + l * 12288 + 5 * 2048;
    const unsigned l16 = (unsigned)lane * 16u, l2 = (unsigned)(lane >> 2) * 4u;
    for (int tok = blockIdx.x * 8 + wave; tok < T; tok += gridDim.x * 8) {
        f32x2 hf2[16];
#pragma unroll
        for (int c = 0; c < 4; ++c) { const u32x4 w = *(const u32x4*)(hb + (size_t)tok * D + lane * 32 + c * 8);
            hf2[c * 4 + 0] = (f32x2){bflo(w.x), bfhi(w.x)}; hf2[c * 4 + 1] = (f32x2){bflo(w.y), bfhi(w.y)}; hf2[c * 4 + 2] = (f32x2){bflo(w.z), bfhi(w.z)}; hf2[c * 4 + 3] = (f32x2){bflo(w.w), bfhi(w.w)}; }
        f32x2 acc2[16];
#pragma unroll
        for (int i = 0; i < 16; ++i) acc2[i] = (f32x2){0.f, 0.f};
        u32x2* sraw = (u32x2*)(lds + wave * 2048); u32x2* ssrt = sraw + 128;
        {
            const unsigned k0 = (unsigned)pidx[(size_t)tok * 128 + lane], k1 = (unsigned)pidx[(size_t)tok * 128 + 64 + lane];
            const float g0 = pgate[(size_t)tok * 128 + lane], g1 = pgate[(size_t)tok * 128 + 64 + lane];
            sraw[lane] = (u32x2){k0, __float_as_uint(g0)}; sraw[64 + lane] = (u32x2){k1, __float_as_uint(g1)};
            asm volatile("s_waitcnt lgkmcnt(0)" ::: "memory");
            const unsigned key0 = k0 * 128u + (unsigned)lane, key1 = k1 * 128u + 64u + (unsigned)lane; unsigned r0 = 0, r1 = 0;
            for (int j = 0; j < 128; ++j) { const unsigned kj = sraw[j].x * 128u + (unsigned)j; r0 += (kj < key0) ? 1u : 0u; r1 += (kj < key1) ? 1u : 0u; }
            ssrt[r0] = (u32x2){k0, __float_as_uint(g0)}; ssrt[r1] = (u32x2){k1, __float_as_uint(g1)};
            asm volatile("s_waitcnt lgkmcnt(0)" ::: "memory");
        }
#define G_LOAD(gi, UR, VR, US, GT) do { _Pragma("unroll") for (int q = 0; q < 4; ++q) { const u32x2 pr = ssrt[(gi) * 4 + q]; const unsigned e_ = (unsigned)__builtin_amdgcn_readfirstlane((int)pr.x); GT[q] = __uint_as_float(pr.y); \
            UR[q] = *(const u32x4*)(ub + (size_t)e_ * 1024 + l16); US[q] = *(const unsigned*)(psc8 + (size_t)e_ * 64 + l2); \
            VR[q] = *(const u32x4*)(vb + (size_t)e_ * 1024 + l16); } } while (0)
#define G_COMP(UR, VR, US, GT) do { float cf[4]; \
            _Pragma("unroll") for (int q = 0; q < 4; ++q) { f32x2 t2 = {0.f, 0.f}, t3 = {0.f, 0.f}; \
                _Pragma("unroll") for (int c = 0; c < 4; ++c) { FP4X8(UR[q][c], a); \
                    t2 = a0 * hf2[c * 4 + 0] + t2; t3 = a1 * hf2[c * 4 + 1] + t3; t2 = a2 * hf2[c * 4 + 2] + t2; t3 = a3 * hf2[c * 4 + 3] + t3; } \
                t2 = t2 + t3; \
                const float d = wave_sum_dpp((t2.x + t2.y) * __uint_as_float(US[q] << 16)); \
                cf[q] = GT[q] * gelu_f(d); } \
            _Pragma("unroll") for (int q = 0; q < 4; ++q) { const float cs = cf[q] * __uint_as_float(US[q] & 0xffff0000u); const f32x2 cs2 = {cs, cs}; \
                _Pragma("unroll") for (int c = 0; c < 4; ++c) { FP4X8(VR[q][c], b); \
                    acc2[c * 4 + 0] = cs2 * b0 + acc2[c * 4 + 0]; acc2[c * 4 + 1] = cs2 * b1 + acc2[c * 4 + 1]; acc2[c * 4 + 2] = cs2 * b2 + acc2[c * 4 + 2]; acc2[c * 4 + 3] = cs2 * b3 + acc2[c * 4 + 3]; } } } while (0)
        {
            u32x4 urA[4], vrA[4], urB[4], vrB[4]; unsigned usA[4], usB[4]; float gtA[4], gtB[4];
            G_LOAD(0, urA, vrA, usA, gtA);
            for (int g = 0; g < 32; g += 2) {
                G_LOAD(g + 1, urB, vrB, usB, gtB);
                G_COMP(urA, vrA, usA, gtA);
                G_LOAD((g + 2 < 32) ? g + 2 : 31, urA, vrA, usA, gtA);
                G_COMP(urB, vrB, usB, gtB);
            }
        }
#undef G_LOAD
#undef G_COMP
        float acc[32];
#pragma unroll
        for (int i = 0; i < 16; ++i) { acc[2 * i] = acc2[i].x; acc[2 * i + 1] = acc2[i].y; }
        if (!apply) { if (p->ph_hi == -12345) { for (int i = 0; i < 32; ++i) xc[i * 64 + lane] = f2bf(acc[i]); } continue; }
        const int b = tok >> 13; const float gm = ((MK_SKIP >> (2 * l + 1)) & 1) ? 0.f : 1.f;
        float ss = 0.f;
#pragma unroll
        for (int c = 0; c < 4; ++c) { const int col = lane * 32 + c * 8; bf16_t* xp = xc + (size_t)tok * D + col;
            const u32x4 xb = *(const u32x4*)xp; const f32x4 g0 = *(const f32x4*)(gt2 + (size_t)b * MODC + col), g1 = *(const f32x4*)(gt2 + (size_t)b * MODC + col + 4);
            const float x8[8] = {bflo(xb.x), bfhi(xb.x), bflo(xb.y), bfhi(xb.y), bflo(xb.z), bfhi(xb.z), bflo(xb.w), bfhi(xb.w)}; float y8[8];
#pragma unroll
            for (int e2 = 0; e2 < 8; ++e2) { y8[e2] = x8[e2] + gm * ((e2 < 4) ? g0[e2] : g1[e2 - 4]) * acc[c * 8 + e2]; acc[c * 8 + e2] = y8[e2]; ss += y8[e2] * y8[e2]; }
            if (l < 3) { u32x4 w; w.x = cvt_pk_bf16(y8[0], y8[1]); w.y = cvt_pk_bf16(y8[2], y8[3]); w.z = cvt_pk_bf16(y8[4], y8[5]); w.w = cvt_pk_bf16(y8[6], y8[7]); *(u32x4*)xp = w; } }
        const float rn = rsqrtf(wave_sum(ss) * (1.f / D) + NORM_EPS);
        const float* modall = WSP(const float, WS_MOD) + (size_t)b * MODC;
        if (l == 3) {
#pragma unroll
            for (int c = 0; c < 8; ++c) { const int col = lane * 32 + c * 4; const f32x4 gv = *(const f32x4*)(p->in[25] + col); f32x4 o;
#pragma unroll
                for (int e2 = 0; e2 < 4; ++e2) o[e2] = acc[c * 4 + e2] * rn * gv[e2];
                *(f32x4*)(p->out + (size_t)tok * D + col) = o; }
        } else {
            const float* g1 = (l == 1) ? p->in[13] : (p->in[5] + (l + 1) * D);
            const float* sh1 = (l == 1) ? (modall + 4 * 12288) : (modall + (l + 1) * 12288);
            const float* sc1 = sh1 + D;
            bf16_t* d1 = WSP(bf16_t, WS_HBUF) + (size_t)tok * D;
#pragma unroll
            for (int c = 0; c < 4; ++c) { u32x4 w;
#pragma unroll
                for (int hh = 0; hh < 2; ++hh) { const int col = lane * 32 + c * 8 + hh * 4; const f32x4 gv = *(const f32x4*)(g1 + col), sv = *(const f32x4*)(sh1 + col), cv = *(const f32x4*)(sc1 + col); float o[4];
#pragma unroll
                    for (int e2 = 0; e2 < 4; ++e2) o[e2] = acc[c * 8 + hh * 4 + e2] * rn * gv[e2] * (1.f + cv[e2]) + sv[e2];
                    w[hh * 2] = cvt_pk_bf16(o[0], o[1]); w[hh * 2 + 1] = cvt_pk_bf16(o[2], o[3]); }
                *(u32x4*)(d1 + lane * 32 + c * 8) = w; }
            if (l == 1) {
                const float* g2 = p->in[5] + 2 * D; const float* sh2 = modall + 2 * 12288; const float* sc2 = sh2 + D;
                bf16_t* d2 = WSP(bf16_t, WS_OBUF) + (size_t)tok * D;
#pragma unroll
                for (int c = 0; c < 4; ++c) { u32x4 w;
#pragma unroll
                    for (int hh = 0; hh < 2; ++hh) { const int col = lane * 32 + c * 8 + hh * 4; const f32x4 gv = *(const f32x4*)(g2 + col), sv = *(const f32x4*)(sh2 + col), cv = *(const f32x4*)(sc2 + col); float o[4];
#pragma unroll
                        for (int e2 = 0; e2 < 4; ++e2) o[e2] = acc[c * 8 + hh * 4 + e2] * rn * gv[e2] * (1.f + cv[e2]) + sv[e2];
                        w[hh * 2] = cvt_pk_bf16(o[0], o[1]); w[hh * 2 + 1] = cvt_pk_bf16(o[2], o[3]); }
                    *(u32x4*)(d2 + lane * 32 + c * 8) = w; }
            }
        }
    }
}
#undef FP4X8

DI void ph_dbg(PK p, int mode, const int wv) {
    PK_FRESH(p);
    const int tid = ltid(wv);
    const bf16_t* Ag = WSP(const bf16_t, WS_GA); const bf16_t* Bg = WSP(const bf16_t, WS_GB); const bf16_t* Qg = WSP(const bf16_t, WS_GQ); const bf16_t* Og = WSP(const bf16_t, WS_GO); const bf16_t* Sg = WSP(const bf16_t, WS_GS);
    const bf16_t* proj = WSP(const bf16_t, WS_PROJ); bf16_t* obuf = WSP(bf16_t, WS_OBUF);
    for (int idx = blockIdx.x * 512 + tid; idx < T * D; idx += gridDim.x * 512) {
        const int tok = idx >> 11, col = idx & 2047, hd = col >> 7, v = col & 127, b = tok >> 13, s = tok & 8191, n = s >> 6, i = s & 63;
        const size_t ci = (size_t)(b * 16 + hd) * 128 + n;
        float r = 0.f;
        if (mode == 1) r = bf2f(Og[ci * 8192 + i * 128 + v]) + bf2f(Qg[ci * 8192 + i * 128 + v]);
        if (mode == 2) r = bf2f(Ag[ci * 16384 + i * 128 + v]) + bf2f(Bg[ci * 16384 + (i + 64) * 128 + v]) + bf2f(Ag[ci * 16384 + (i + 64) * 128 + v]) + bf2f(Bg[ci * 16384 + i * 128 + v]);
        if (mode == 3) r = bf2f(Sg[ci * 16384 + i * 128 + v]) + bf2f(Sg[ci * 16384 + (i + 64) * 128 + v]);
        if (mode == 4) r = bf2f(proj[(size_t)tok * GINP + col]) + bf2f(proj[(size_t)tok * GINP + 2048 + col]) + bf2f(proj[(size_t)tok * GINP + 4096 + col]) + bf2f(proj[(size_t)tok * GINP + 6144 + col]) + ((col < 256) ? bf2f(proj[(size_t)tok * GINP + 8192 + col]) : 0.f);
        obuf[idx] = f2bf(r);
    }
}
#ifndef MK_AOUT
#define MK_AOUT obuf
#endif
constexpr int NPHASES = 1 + 1 + 2 * 9 + 2 * 8 + 1;

__global__ void __launch_bounds__(512, 2) mk_fwd(Params p_arg) {
    extern __shared__ __attribute__((aligned(16))) unsigned char lds[];
    PK p = (PK)__builtin_amdgcn_kernarg_segment_ptr();
    const int lo = p->ph_lo, hi = p->ph_hi;
    const int wv = __builtin_amdgcn_readfirstlane((int)threadIdx.x >> 6);
    volatile LAS unsigned* st = (volatile LAS unsigned*)((LAS unsigned char*)lds + LDS_BARW);
    if (wv == 0 && lane_id() == 0) { st[0] = 0u; st[1] = 0u; }
    __syncthreads();
    XcdBarrier bar; bar.bar = (unsigned*)(p->ws + WS_BAR); bar.x = 0; bar.st = st; bar.wv = wv;
    if (hi - lo > 1) bar = xcd_barrier_post((unsigned*)(p->ws + WS_BAR), st, wv);
    int ph = 0;
#define PH_BEGIN if (lo <= ph && ph < hi) { PK_FRESH(p);
#define PH_END   if (ph + 1 < hi) xcd_barrier(bar); } ++ph;
#define mod  WSP(const float, WS_MOD)
#define xcur WSP(bf16_t, WS_XCUR)
#define hbuf WSP(bf16_t, WS_HBUF)
#define obuf WSP(bf16_t, WS_OBUF)
#define G    ((int)gridDim.x)
#define bx   ((int)blockIdx.x)
#define modl (mod + l * 12288)

    PH_BEGIN ph_prologue(p, lds, wv); if (MK_DUP & 1) { __syncthreads(); ph_prologue(p, lds, wv); } PH_END

    for (int l = 0; l < DEPTH; ++l) {
        if (l == 0) { PH_BEGIN ph_norm<0>(p->in[0], nullptr, p->in[5], modl + 0 * D, modl + 1 * D, hbuf, nullptr, wv); PH_END }
        PH_BEGIN
            pg8::Gemm g; pg8::EpiMk E; E.mode = 0; E.xin = nullptr; E.xinb = nullptr; E.xout = nullptr; E.gate = nullptr; E.gmul = 1.f; E.xoutf = nullptr; E.O2 = nullptr; E.nrope = 0; E.cosT = WSP(const float, WS_COS); E.sinT = WSP(const float, WS_SIN);
            g.A = (l == 2) ? obuf : hbuf; g.M = T; g.K = D; g.ld = D; g.ksplit = 0;
            if (l < 2) { g.Bt = WSP(const bf16_t, WS_WIN) + (size_t)l * GINP * D; g.N = 8192; E.O = WSP(bf16_t, WS_PROJ); E.ldc = GINP; }
            else { g.Bt = WSP(const bf16_t, WS_DWQ) + (size_t)(l - 2) * D * D; g.N = D; E.mode = 2; E.O = WSP(bf16_t, WS_QD); E.nrope = D; }
            pg8::StaticOrder S; S.init(g.M, g.N, G, bx);
            pg8::gemm_phase<pg8::EpiMk, pg8::StaticOrder>((PG8_LAS unsigned char*)lds, g, S, E, wv);
            if (MK_DUP & 2) { __syncthreads(); pg8::gemm_phase<pg8::EpiMk, pg8::StaticOrder>((PG8_LAS unsigned char*)lds, g, S, E, wv); }
            if (l < 2) {
                pg8::Gemm g2; g2.A = hbuf; g2.Bt = WSP(const bf16_t, WS_WIN) + (size_t)l * GINP * D + (size_t)8192 * D; g2.M = T; g2.N = 1024; g2.K = 512; g2.ld = D; g2.ksplit = 1;
                pg8::EpiMk E2 = E; E2.mode = 3; E2.xoutf = WSP(float, WS_PAB);
                pg8::StaticOrder S2; S2.init(g2.M, g2.N, G, bx);
                pg8::gemm_phase<pg8::EpiMk, pg8::StaticOrder>((PG8_LAS unsigned char*)lds, g2, S2, E2, wv);
            }
        PH_END
        if (l < 2) {
            PH_BEGIN ph_gdn_p1(p, l, lds, wv); if (MK_DUP & 8) { __syncthreads(); ph_gdn_p1(p, l, lds, wv); } PH_END
            PH_BEGIN ph_gdn_p2(p, lds, wv); if (MK_DUP & 16) { __syncthreads(); ph_gdn_p2(p, lds, wv); } PH_END
#ifdef MK_DBG
            PH_BEGIN ph_dbg(p, MK_DBG, wv); PH_END
#else
            PH_BEGIN ph_gdn_p3(p, l, wv); if (MK_DUP & 32) { __syncthreads(); ph_gdn_p3(p, l, wv); } PH_END
#endif
        } else {
            PH_BEGIN ph_attn(p, lds, wv); if (MK_DUP & 64) { __syncthreads(); ph_attn(p, lds, wv); } PH_END
            PH_BEGIN ph_diff_combine(p, l - 2, l, lds, wv); PH_END
        }
        PH_BEGIN
            pg8::Gemm g; pg8::EpiMk E; E.mode = 1; E.O = nullptr; E.ldc = 0; E.xoutf = nullptr; E.O2 = nullptr; E.nrope = 0; E.cosT = nullptr; E.sinT = nullptr; E.xin = (l == 0) ? p->in[0] : nullptr; E.xinb = xcur; E.xout = xcur; E.gate = modl + 2 * D; E.gmul = ((MK_SKIP >> (2 * l)) & 1) ? 0.f : 1.f;
            g.A = MK_AOUT; g.M = T; g.K = D; g.N = D; g.ld = D; g.ksplit = 0;
            g.Bt = (l < 2) ? (WSP(const bf16_t, WS_WOUT) + (size_t)l * D * D) : (WSP(const bf16_t, WS_DWO) + (size_t)(l - 2) * D * D);
            pg8::StaticOrder S; S.init(g.M, g.N, G, bx);
            pg8::gemm_phase<pg8::EpiMk, pg8::StaticOrder>((PG8_LAS unsigned char*)lds, g, S, E, wv);
        PH_END
        PH_BEGIN ph_norm<2>(nullptr, xcur, p->in[6] + l * D, modl + 3 * D, modl + 4 * D, hbuf, nullptr, wv); PH_END
        PH_BEGIN
            pg8::Gemm g; pg8::EpiMk E; E.mode = 0; E.xin = nullptr; E.xinb = nullptr; E.xout = nullptr; E.gate = nullptr; E.gmul = 1.f; E.xoutf = nullptr; E.O2 = nullptr; E.nrope = 0; E.cosT = WSP(const float, WS_COS); E.sinT = WSP(const float, WS_SIN); E.O = WSP(bf16_t, WS_PQ); E.ldc = D;
            g.A = hbuf; g.M = T; g.K = D; g.N = D; g.ld = D; g.ksplit = 0; g.Bt = WSP(const bf16_t, WS_PWQ) + (size_t)l * D * D;
            pg8::StaticOrder S; S.init(g.M, g.N, G, bx);
            pg8::gemm_phase<pg8::EpiMk, pg8::StaticOrder>((PG8_LAS unsigned char*)lds, g, S, E, wv);
        PH_END
        PH_BEGIN ph_peer_topk(p, l, lds, wv); if (MK_DUP & 128) { __syncthreads(); ph_peer_topk(p, l, lds, wv); } PH_END
        PH_BEGIN ph_peer_gather(p, l, lds, wv); if (MK_DUP & 256) { __syncthreads(); ph_peer_gather(p, l, lds, wv, false); } PH_END
        if (l == 1) {
            PH_BEGIN
                pg8::Gemm g; pg8::EpiMk E; E.mode = 0; E.xin = nullptr; E.xinb = nullptr; E.xout = nullptr; E.gate = nullptr; E.gmul = 1.f; E.xoutf = nullptr; E.O2 = nullptr; E.nrope = 0; E.cosT = WSP(const float, WS_COS); E.sinT = WSP(const float, WS_SIN); E.mode = 2; E.O = WSP(bf16_t, WS_KSH); E.O2 = WSP(bf16_t, WS_VSH); E.nrope = 2048;
                g.A = hbuf; g.M = T; g.K = D; g.N = 4096; g.ld = D; g.ksplit = 0; g.Bt = WSP(const bf16_t, WS_KVW);
                pg8::StaticOrder S; S.init(g.M, g.N, G, bx);
                pg8::gemm_phase<pg8::EpiMk, pg8::StaticOrder>((PG8_LAS unsigned char*)lds, g, S, E, wv);
            PH_END
        }
    }
#undef PH_BEGIN
#undef PH_END
#undef mod
#undef xcur
#undef hbuf
#undef obuf
#undef G
#undef bx
#undef modl
}

extern "C" void kernel_launch(void* const* d_in, const int* in_sizes, int n_in, void* d_out, int out_size, void* d_ws, size_t ws_size, hipStream_t stream) {
    static int grid = 0;
    if (grid == 0) {
        if (n_in != 26 || in_sizes[0] != T * D || out_size != T * D || ws_size < WS_END) {
            fprintf(stderr, "kernel_launch: unexpected shapes: n_in %d in0 %d out %d ws %zu (need %zu)\n", n_in, n_in > 0 ? in_sizes[0] : -1, out_size, ws_size, (size_t)WS_END); grid = -1; return; }
        int dev = 0, cus = 0;
        if (hipGetDevice(&dev) != hipSuccess || hipDeviceGetAttribute(&cus, hipDeviceAttributeMultiprocessorCount, dev) != hipSuccess || cus <= 0) cus = 256;
        if (hipFuncSetAttribute((const void*)mk_fwd, hipFuncAttributeMaxDynamicSharedMemorySize, LDS_BYTES) != hipSuccess) { fprintf(stderr, "kernel_launch: hipFuncSetAttribute failed\n"); grid = -1; return; }
        int per_cu = 0;
        if (hipOccupancyMaxActiveBlocksPerMultiprocessor(&per_cu, (const void*)mk_fwd, 512, LDS_BYTES) != hipSuccess || per_cu < 1) fprintf(stderr, "kernel_launch: occupancy query says %d\n", per_cu);
        (void)hipGetLastError();
        grid = cus;
    }
    if (grid < 0) return;
    (void)hipMemsetAsync((char*)d_ws + WS_BAR, 0, 16384, stream);
    Params p{};
    for (int i = 0; i < 26; ++i) p.in[i] = (const float*)d_in[i];
    p.out = (float*)d_out; p.ws = (unsigned char*)d_ws;
#if MK_N_LAUNCHES == 1
    p.ph_lo = 0; p.ph_hi = NPHASES;
    hipLaunchKernelGGL(mk_fwd, dim3(grid), dim3(512), LDS_BYTES, stream, p);
#else
#ifndef MK_PHMASK
#define MK_PHMASK 0xffffffffu
#endif
#ifndef MK_STOP
#define MK_STOP NPHASES
#endif
    for (int ph = 0; ph < NPHASES; ++ph) { if (ph >= MK_STOP && ph != NPHASES - 1) continue; if (!(MK_PHMASK >> (ph < 31 ? ph : 31) & 1u) && ph != NPHASES - 1) continue; p.ph_lo = ph; p.ph_hi = ph + 1; hipLaunchKernelGGL(mk_fwd, dim3(grid), dim3(512), LDS_BYTES, stream, p); }
#endif
    const hipError_t le = hipPeekAtLastError();
    if (le != hipSuccess) fprintf(stderr, "kernel_launch: launch failed: %s\n", hipGetErrorName(le));
}
```

```cpp
#include <hip/hip_runtime.h>
#include <hip/hip_bf16.h>
#include <cstdio>
#include <cstdint>

#ifndef MK_N_LAUNCHES
#define MK_N_LAUNCHES 1
#endif
#ifndef MK_DUP
#define MK_DUP 0
#endif
#ifndef MK_SKIP
#define MK_SKIP 0
#endif

constexpr int NB = 2, SEQ = 8192, T = NB * SEQ, D = 2048, DEPTH = 4;
constexpr int GH = 16, GIN = 8224, GINP = 8448;
constexpr int MODC = 4 * 12288 + 4096;
constexpr float NORM_EPS = 1e-6f;

typedef unsigned short bf16_t;
typedef short bf16x8 __attribute__((ext_vector_type(8)));
typedef short s16x4 __attribute__((ext_vector_type(4)));
typedef float f32x4 __attribute__((ext_vector_type(4)));
typedef float f32x2 __attribute__((ext_vector_type(2)));
typedef float f32x16 __attribute__((ext_vector_type(16)));
typedef unsigned u32x4 __attribute__((ext_vector_type(4)));
typedef unsigned u32x2 __attribute__((ext_vector_type(2)));
typedef __bf16 bfx2 __attribute__((ext_vector_type(2)));
#define LAS __attribute__((address_space(3)))
#define DI __device__ __forceinline__

DI float bf2f(bf16_t v) { return __uint_as_float(((unsigned)v) << 16); }
DI float bflo(unsigned w) { return __uint_as_float(w << 16); }
DI float bfhi(unsigned w) { return __uint_as_float(w & 0xffff0000u); }
DI bf16_t f2bf(float f) { unsigned u = __float_as_uint(f); u += 0x7FFFu + ((u >> 16) & 1u); return (bf16_t)(u >> 16); }
DI unsigned cvt_pk_bf16(float lo, float hi) { const f32x2 v = {lo, hi}; return __builtin_bit_cast(unsigned, __builtin_convertvector(v, bfx2)); }
template <int M> DI float sw_xor(float v) { return __int_as_float(__builtin_amdgcn_ds_swizzle(__float_as_int(v), (M << 10) | 0x1f)); }
DI float sw_xor32_sum(float v) { auto rr = __builtin_amdgcn_permlane32_swap(__float_as_uint(v), __float_as_uint(v), false, false); return __uint_as_float(rr[0]) + __uint_as_float(rr[1]); }
DI float wave_max(float v) {
    v = fmaxf(v, sw_xor<1>(v)); v = fmaxf(v, sw_xor<2>(v)); v = fmaxf(v, sw_xor<4>(v)); v = fmaxf(v, sw_xor<8>(v)); v = fmaxf(v, sw_xor<16>(v));
    auto rr = __builtin_amdgcn_permlane32_swap(__float_as_uint(v), __float_as_uint(v), false, false); return fmaxf(__uint_as_float(rr[0]), __uint_as_float(rr[1]));
}
DI float wave_sum(float v) {
    v += sw_xor<1>(v); v += sw_xor<2>(v); v += sw_xor<4>(v); v += sw_xor<8>(v); v += sw_xor<16>(v);
    return sw_xor32_sum(v);
}
template <int CTRL, int RMASK> DI float dpp_mov(float v) { return __int_as_float(__builtin_amdgcn_update_dpp(0, __float_as_int(v), CTRL, RMASK, 0xF, false)); }
DI float wave_sum_dpp(float v) {
    v += dpp_mov<0xB1, 0xF>(v); v += dpp_mov<0x4E, 0xF>(v); v += dpp_mov<0x141, 0xF>(v); v += dpp_mov<0x140, 0xF>(v);
    v += dpp_mov<0x142, 0xA>(v); v += dpp_mov<0x143, 0xC>(v);
    return __int_as_float(__builtin_amdgcn_readlane(__float_as_int(v), 63));
}
DI void lds_barrier() { asm volatile("s_waitcnt lgkmcnt(0)" ::: "memory"); __builtin_amdgcn_s_barrier(); asm volatile("" ::: "memory"); }
DI float silu_f(float v) { return v / (1.f + __expf(-v)); }
DI int lane_id() { int l; asm volatile("v_mbcnt_lo_u32_b32 %0, -1, 0\n\tv_mbcnt_hi_u32_b32 %0, -1, %0" : "=v"(l)); return l; }
DI int ltid(const int wv) { int t = wv * 64 + lane_id(); asm volatile("" : "+v"(t)); return t; }

constexpr size_t al4k(size_t x) { return (x + 4095) & ~(size_t)4095; }
constexpr size_t WS_BAR   = 0;
constexpr size_t WS_MOD   = 16384;
constexpr size_t WS_COS   = al4k(WS_MOD + (size_t)2 * MODC * 4);
constexpr size_t WS_SIN   = WS_COS + (size_t)T * 64 * 4;
constexpr size_t WS_SUBK  = WS_SIN + (size_t)T * 64 * 4;
constexpr size_t WS_WIN   = WS_SUBK + (size_t)4 * 2 * 128 * 128 * 2;
constexpr size_t WS_WOUT  = WS_WIN + (size_t)2 * GINP * D * 2;
constexpr size_t WS_KVW   = WS_WOUT + (size_t)2 * D * D * 2;
constexpr size_t WS_DWQ   = WS_KVW + (size_t)4096 * D * 2;
constexpr size_t WS_DWO   = WS_DWQ + (size_t)2 * D * D * 2;
constexpr size_t WS_PWQ   = WS_DWO + (size_t)2 * D * D * 2;
constexpr size_t WS_PU    = WS_PWQ + (size_t)4 * D * D * 2;
constexpr size_t WS_PUS   = WS_PU + (size_t)16384 * 1024;
constexpr size_t WS_PV    = WS_PU + (size_t)16384 * D * 2;
constexpr size_t WS_PVS   = WS_PV + (size_t)16384 * 1024;
constexpr size_t WS_XCUR  = WS_PV + (size_t)16384 * D * 2;
constexpr size_t WS_HBUF  = WS_XCUR + (size_t)T * D * 4;
constexpr size_t WS_OBUF  = WS_HBUF + (size_t)T * D * 2;
constexpr size_t WS_PROJ  = WS_OBUF + (size_t)T * D * 2;
constexpr size_t WS_PAB   = WS_PROJ + (size_t)T * GINP * 2;
constexpr size_t WS_PQ    = WS_PROJ + (size_t)T * GINP * 2;
constexpr size_t WS_PIDX  = WS_PQ + (size_t)T * D * 2;
constexpr size_t WS_PGATE = WS_PIDX + (size_t)T * 128 * 4;
constexpr size_t WS_GA    = WS_PGATE + (size_t)T * 128 * 4;
constexpr size_t WS_GB    = WS_GA + (size_t)4096 * 128 * 128 * 2;
constexpr size_t WS_GQ    = WS_GB + (size_t)4096 * 128 * 128 * 2;
constexpr size_t WS_GO    = WS_GQ + (size_t)4096 * 64 * 128 * 2;
constexpr size_t WS_GS    = WS_GO + (size_t)4096 * 64 * 128 * 2;
constexpr size_t WS_GL    = WS_GS + (size_t)4096 * 128 * 128 * 2;
constexpr size_t WS_END   = WS_GL + 16384;
constexpr size_t WS_OAT   = WS_GA;
constexpr size_t WS_KSH   = WS_GB;
constexpr size_t WS_VSH   = WS_GB + (size_t)67108864;
constexpr size_t WS_QD    = WS_GQ;

constexpr int LDS_BYTES = 147456;
constexpr int LDS_BARW  = 147456 - 64;

struct Params { const float* in[26]; float* out; unsigned char* ws; int ph_lo, ph_hi; };
typedef const Params __attribute__((address_space(4)))* PK;
#define PK_FRESH(p) asm volatile("" : "+s"(p))

#define XB_TMO      128
#define XB_XCNT(j)  (256  + 64 * (j))
#define XB_XSUB(j)  (1280 + 64 * (j))
#define XB_XGEN(j)  (2304 + 64 * (j))
#define XB_TOP      3328
#define XB_TOPGEN   3392
#define XCD_BAR_WORDS 3456
#define XB_SPIN_CAP (1u << 20)

__device__ __forceinline__ unsigned xb_ld(unsigned* p)              { return __hip_atomic_load(p, __ATOMIC_RELAXED, __HIP_MEMORY_SCOPE_AGENT); }
__device__ __forceinline__ unsigned xb_add(unsigned* p, unsigned v) { return __hip_atomic_fetch_add(p, v, __ATOMIC_RELAXED, __HIP_MEMORY_SCOPE_AGENT); }
__device__ __forceinline__ unsigned xb_xcc_id() { return (unsigned)__builtin_amdgcn_s_getreg((3 << 11) | 20) & 0xFu; }
#define XB_SPIN(cond, bar) do { unsigned _sp = 0; while (cond) { __builtin_amdgcn_s_sleep(1); \
    if ((++_sp & 255u) == 0u) { if (xb_ld(&(bar)[XB_TMO])) break; if (_sp > XB_SPIN_CAP) { atomicAdd(&(bar)[XB_TMO], 1u); break; } } } } while (0)

struct XcdBarrier { unsigned* bar; unsigned x; volatile LAS unsigned* st; int wv; };

__device__ __forceinline__ XcdBarrier xcd_barrier_post(unsigned* bar, volatile LAS unsigned* st, int wv) {
    XcdBarrier b; b.bar = bar; b.x = xb_xcc_id(); b.st = st; b.wv = wv;
    if (wv == 0 && lane_id() == 0) (void)xb_add(&bar[XB_XCNT(b.x)], 1u);
    return b;
}
__device__ __forceinline__ void xcd_barrier_complete(unsigned* bar, unsigned x, unsigned& nloc, unsigned& nx) {
    const unsigned G = gridDim.x * gridDim.y * gridDim.z;
    unsigned sum, cnt, mine, sp = 0u;
    for (;;) {
        sum = 0u; cnt = 0u; mine = 0u;
#pragma unroll
        for (unsigned j = 0; j < 16; ++j) { const unsigned c = xb_ld(&bar[XB_XCNT(j)]); sum += c; cnt += (c > 0u) ? 1u : 0u; mine = (j == x) ? c : mine; }
        if (sum == G) break;
        __builtin_amdgcn_s_sleep(1);
        if ((++sp & 255u) == 0u) { if (xb_ld(&bar[XB_TMO])) break; if (sp > XB_SPIN_CAP) { atomicAdd(&bar[XB_TMO], 1u); break; } }
    }
    nloc = mine > 0u ? mine : 1u; nx = cnt > 0u ? cnt : 1u;
}
__device__ __forceinline__ void xcd_barrier(const XcdBarrier& b) {
    asm volatile("s_waitcnt vmcnt(0)" ::: "memory");
    __syncthreads();
    if (b.wv == 0 && lane_id() == 0) {
        unsigned* bar = b.bar;
        __builtin_amdgcn_s_waitcnt(0);
        unsigned nloc = b.st[0], nx = b.st[1];
        if (nloc == 0u) { xcd_barrier_complete(bar, b.x, nloc, nx); b.st[0] = nloc; b.st[1] = nx; }
        const unsigned old = xb_add(&bar[XB_XSUB(b.x)], 1u);
        const unsigned gen = old / nloc;
        if (old + 1u == (gen + 1u) * nloc) {
            __builtin_amdgcn_fence(__ATOMIC_RELEASE, "agent");
            asm volatile("s_waitcnt vmcnt(0)" ::: "memory");
            const unsigned og = xb_add(&bar[XB_TOP], 1u);
            const unsigned tg = og / nx;
            if (og + 1u == (tg + 1u) * nx) xb_add(&bar[XB_TOPGEN], 1u);
            else XB_SPIN(xb_ld(&bar[XB_TOPGEN]) == tg, bar);
            __builtin_amdgcn_fence(__ATOMIC_ACQUIRE, "agent");
            xb_add(&bar[XB_XGEN(b.x)], 1u);
            asm volatile("s_waitcnt vmcnt(0)" ::: "memory");
        } else {
            XB_SPIN(xb_ld(&bar[XB_XGEN(b.x)]) == gen, bar);
            __builtin_amdgcn_fence(__ATOMIC_ACQUIRE, "agent");
            asm volatile("s_waitcnt vmcnt(0)" ::: "memory");
        }
    }
    __syncthreads();
}

namespace pg8 {
#define PG8_LAS __attribute__((address_space(3)))
constexpr int BM = 256, BK = 64, HALF = 128, HTB = HALF * BK * 2, STAGE_BYTES = 8 * HTB, NXCD = 8, WGM = 8;
__host__ __device__ __forceinline__ int lds_byte(int r, int c) { const int st = (r >> 4) * 2 + (c >> 5), rr = r & 15, cc = c & 31, ob = rr * 64 + cc * 2; return st * 1024 + (ob ^ (((ob >> 9) & 1) << 5)); }
__host__ __device__ __forceinline__ void stage_rc(int b, int& R, int& C) { const int st = b / 1024, sb = b % 1024, swz = sb ^ (((sb >> 9) & 1) << 5); R = (st >> 1) * 16 + swz / 64; C = (st & 1) * 32 + (swz % 64) / 2; }
__host__ __device__ __forceinline__ int perm32(int rho) { const int n = rho >> 4, i = rho & 15; return 8 * (i >> 2) + 4 * n + (i & 3); }
struct Unit { int pm, pn; };
struct Gemm { const bf16_t* A; const bf16_t* Bt; int M, N, K; int ld; int ksplit; };
struct StaticOrder {
    int nM, nN, nwg, G, c;
    __host__ __device__ void init(int M, int N, int G_, int c_) { nM = M / BM; nN = N / BM; nwg = nM * nN; G = G_; c = c_; }
    __host__ __device__ bool next(int i, Unit& u) const {
        const long L = (long)i * G + c; if (L >= nwg) return false;
        int wgid = (int)L; { const int q = nwg / NXCD, r = nwg % NXCD, xcd = wgid % NXCD, off = wgid / NXCD; wgid = (xcd < r ? xcd * (q + 1) : r * (q + 1) + (xcd - r) * q) + off; }
        const int nig = WGM * nN, gid = wgid / nig, fm = gid * WGM, gsz = (nM - fm) < WGM ? (nM - fm) : WGM;
        u.pm = fm + ((wgid % nig) % gsz); u.pn = (wgid % nig) / gsz; return true;
    }
    __device__ __forceinline__ void a_ready(const Unit&) const {}
    __device__ __forceinline__ void done(const Unit&) const {}
};

struct EpiMk {
    static constexpr bool PERM = true, AFTER_DRAIN = false;
    int mode; bf16_t* O; int ldc; const float* xin; const bf16_t* xinb; bf16_t* xout; const float* gate; float gmul;
    bf16_t* O2; int nrope; const float* cosT; const float* sinT;
    float* xoutf;
    __device__ __forceinline__ void operator()(const f32x4 (&acc)[2][2][4][2], const Unit& u, int wr, int wc, int fr, int fq) const {
        const int row0 = u.pm * BM + wr * 64 + fr, col0 = u.pn * BM + wc * 32 + 8 * fq;
        if (mode == 0) {
#pragma unroll
            for (int ai = 0; ai < 2; ++ai)
#pragma unroll
                for (int m = 0; m < 4; ++m) { bf16_t* rowp = O + (size_t)(row0 + ai * HALF + m * 16) * ldc + col0;
#pragma unroll
                    for (int bj = 0; bj < 2; ++bj) { const f32x4 v0 = acc[ai][bj][m][0], v1 = acc[ai][bj][m][1];
                        u32x4 w; w.x = cvt_pk_bf16(v0[0], v0[1]); w.y = cvt_pk_bf16(v0[2], v0[3]); w.z = cvt_pk_bf16(v1[0], v1[1]); w.w = cvt_pk_bf16(v1[2], v1[3]);
                        *(u32x4*)(rowp + bj * HALF) = w; } }
        } else if (mode == 3) {
            if (wc == 0) {
#pragma unroll
                for (int ai = 0; ai < 2; ++ai)
#pragma unroll
                    for (int m = 0; m < 4; ++m) { const int row = row0 + ai * HALF + m * 16; float* dp = xoutf + ((size_t)u.pn * T + row) * 32 + 8 * fq;
                        *(f32x4*)dp = acc[ai][0][m][0]; *(f32x4*)(dp + 4) = acc[ai][0][m][1]; }
            }
        } else if (mode == 2) {
#pragma unroll
            for (int ai = 0; ai < 2; ++ai)
#pragma unroll
                for (int m = 0; m < 4; ++m) { const int row = row0 + ai * HALF + m * 16, bb = row >> 13, ss = row & 8191;
#pragma unroll
                    for (int bj = 0; bj < 2; ++bj) { const int col = col0 + bj * HALF; const f32x4 v0 = acc[ai][bj][m][0], v1 = acc[ai][bj][m][1];
                        if (col < nrope) { const int hc = col >> 7, j0 = ((col & 127) >> 3) * 4;
                            const f32x4 cs = *(const f32x4*)(cosT + (size_t)row * 64 + j0), sn = *(const f32x4*)(sinT + (size_t)row * 64 + j0);
                            bf16_t* dp = O + ((size_t)(bb * 16 + hc) * SEQ + ss) * 128 + j0;
                            u32x2 w1, w2; w1.x = cvt_pk_bf16(v0[0] * cs[0] - v1[0] * sn[0], v0[1] * cs[1] - v1[1] * sn[1]); w1.y = cvt_pk_bf16(v0[2] * cs[2] - v1[2] * sn[2], v0[3] * cs[3] - v1[3] * sn[3]);
                            w2.x = cvt_pk_bf16(v1[0] * cs[0] + v0[0] * sn[0], v1[1] * cs[1] + v0[1] * sn[1]); w2.y = cvt_pk_bf16(v1[2] * cs[2] + v0[2] * sn[2], v1[3] * cs[3] + v0[3] * sn[3]);
                            *(u32x2*)dp = w1; *(u32x2*)(dp + 64) = w2;
                        } else { const int cv = col - nrope, hc = cv >> 7;
                            u32x4 w; w.x = cvt_pk_bf16(v0[0], v0[1]); w.y = cvt_pk_bf16(v0[2], v0[3]); w.z = cvt_pk_bf16(v1[0], v1[1]); w.w = cvt_pk_bf16(v1[2], v1[3]);
                            *(u32x4*)(O2 + ((size_t)(bb * 16 + hc) * SEQ + ss) * 128 + (cv & 127)) = w; } } }
        } else {
#pragma unroll
            for (int ai = 0; ai < 2; ++ai)
#pragma unroll
                for (int m = 0; m < 4; ++m) { const int row = row0 + ai * HALF + m * 16; const float* gp = gate + (size_t)(row >> 13) * MODC + col0;
                    bf16_t* xo = xout + (size_t)row * D + col0;
#pragma unroll
                    for (int bj = 0; bj < 2; ++bj) {
                        const f32x4 g0 = *(const f32x4*)(gp + bj * HALF), g1 = *(const f32x4*)(gp + bj * HALF + 4);
                        f32x4 x0, x1;
                        if (xin) { x0 = *(const f32x4*)(xin + (size_t)row * D + col0 + bj * HALF); x1 = *(const f32x4*)(xin + (size_t)row * D + col0 + bj * HALF + 4); }
                        else { const u32x4 xb = *(const u32x4*)(xinb + (size_t)row * D + col0 + bj * HALF);
                            x0 = (f32x4){bflo(xb.x), bfhi(xb.x), bflo(xb.y), bfhi(xb.y)}; x1 = (f32x4){bflo(xb.z), bfhi(xb.z), bflo(xb.w), bfhi(xb.w)}; }
                        const f32x4 y0 = x0 + gmul * g0 * acc[ai][bj][m][0], y1 = x1 + gmul * g1 * acc[ai][bj][m][1];
                        u32x4 w; w.x = cvt_pk_bf16(y0[0], y0[1]); w.y = cvt_pk_bf16(y0[2], y0[3]); w.z = cvt_pk_bf16(y1[0], y1[1]); w.w = cvt_pk_bf16(y1[2], y1[3]);
                        *(u32x4*)(xo + bj * HALF) = w; } }
        }
    }
};

template <class Epi, class Sched>
__device__ __forceinline__ void gemm_phase(PG8_LAS unsigned char* lds, const Gemm g, const Sched& S, const Epi& E, const int wv) {
    const int tid = ltid(wv), wid = __builtin_amdgcn_readfirstlane(tid >> 6), lane = tid & 63, wr = wid >> 2, wc = wid & 3, fr = lane & 15, fq = lane >> 4;
    const int K = g.K, nt = K / BK, ld = g.ld;
    unsigned voffA[2], voffB[2];
#pragma unroll
    for (int i = 0; i < 2; ++i) { int R, C; stage_rc(tid * 16 + i * 8192, R, C); const int Rb = Epi::PERM ? ((R & ~31) + perm32(R & 31)) : R;
        voffA[i] = (unsigned)(R * ld + C) * 2u; voffB[i] = (unsigned)(Rb * ld + C) * 2u; }
    const size_t kstep = (size_t)(BK * 2);
    const size_t hstep = (size_t)HALF * ld * 2;
    const size_t tstep = 2 * hstep;
    const unsigned ldsw = (unsigned)wid * 1024u;
    const int aoff = lds_byte(wr * 64 + fr, fq * 8), boff = lds_byte(wc * 32 + fr, fq * 8);
#define PG8_SA(b, h) (((b) * 2 + (h)) * HTB)
#define PG8_SB(b, h) ((4 + (b) * 2 + (h)) * HTB)
#define PG8_STAGE(bufoff, gbase, voff) do { _Pragma("unroll") for (int _i = 0; _i < 2; ++_i) \
        __builtin_amdgcn_global_load_lds((const unsigned*)((const char*)(gbase) + (voff)[_i]), (PG8_LAS unsigned*)(lds + (bufoff) + ldsw + _i * 8192), 16, 0, 0); } while (0)
#define PG8_LDA(dst, b, h) do { _Pragma("unroll") for (int m = 0; m < 4; ++m) _Pragma("unroll") for (int k = 0; k < 2; ++k) dst[m][k] = *(const PG8_LAS bf16x8*)(lds + PG8_SA(b, h) + aoff + m * 2048 + k * 1024); } while (0)
#define PG8_LDB(dst, b, h) do { _Pragma("unroll") for (int n = 0; n < 2; ++n) _Pragma("unroll") for (int k = 0; k < 2; ++k) dst[n][k] = *(const PG8_LAS bf16x8*)(lds + PG8_SB(b, h) + boff + n * 2048 + k * 1024); } while (0)
#define PG8_MMA(ai, bj, At, Bt) do { __builtin_amdgcn_s_setprio(1); _Pragma("unroll") for (int m = 0; m < 4; ++m) _Pragma("unroll") for (int n = 0; n < 2; ++n) _Pragma("unroll") for (int k = 0; k < 2; ++k) \
        acc[ai][bj][m][n] = __builtin_amdgcn_mfma_f32_16x16x32_bf16(Bt[n][k], At[m][k], acc[ai][bj][m][n], 0, 0, 0); __builtin_amdgcn_s_setprio(0); } while (0)
#define PG8_WAIT_V(n) asm volatile("s_waitcnt vmcnt(" #n ")" ::: "memory")
#define PG8_WAIT_L(n) asm volatile("s_waitcnt lgkmcnt(" #n ")" ::: "memory")
#define PG8_BAR __builtin_amdgcn_s_barrier()
#define PG8_SCHED __builtin_amdgcn_sched_barrier(0)
    Unit cur, nxt; int ui = 0;
    if (!S.next(0, cur)) return;
    f32x4 acc[2][2][4][2];
#pragma unroll
    for (int a = 0; a < 2; ++a)
#pragma unroll
        for (int b = 0; b < 2; ++b)
#pragma unroll
            for (int m = 0; m < 4; ++m)
#pragma unroll
                for (int n = 0; n < 2; ++n) acc[a][b][m][n] = (f32x4){0.f, 0.f, 0.f, 0.f};
    bf16x8 At[4][2], B0[2][2], B1[2][2];
    const size_t bstep = g.ksplit ? (size_t)K * 2 : tstep, astep = g.ksplit ? (size_t)K * 2 : 0;
    const char* cA = (const char*)g.A + (size_t)cur.pm * tstep + (size_t)cur.pn * astep; const char* cB = (const char*)g.Bt + (size_t)cur.pn * bstep;
    S.a_ready(cur);
    PG8_STAGE(PG8_SB(0, 0), cB, voffB); PG8_STAGE(PG8_SA(0, 0), cA, voffA); PG8_STAGE(PG8_SB(0, 1), cB + hstep, voffB); PG8_STAGE(PG8_SA(0, 1), cA + hstep, voffA);
    if (wr == 1) PG8_BAR;
    PG8_WAIT_V(4); PG8_BAR;
    PG8_STAGE(PG8_SB(1, 0), cB + kstep, voffB); PG8_STAGE(PG8_SA(1, 0), cA + kstep, voffA); PG8_STAGE(PG8_SB(1, 1), cB + hstep + kstep, voffB);
    PG8_WAIT_V(6); PG8_BAR;
    for (;;) {
        const bool has_next = S.next(ui + 1, nxt);
        const char* nA = has_next ? (const char*)g.A + (size_t)nxt.pm * tstep + (size_t)nxt.pn * astep : cA; const char* nB = has_next ? (const char*)g.Bt + (size_t)nxt.pn * bstep : cB;
        for (int t = 0; t < nt; t += 2) {
            const bool last = (t == nt - 2);
            const char* a1 = cA + (size_t)(t + 1) * kstep;
            const char* a2 = last ? nA : cA + (size_t)(t + 2) * kstep; const char* b2 = last ? nB : cB + (size_t)(t + 2) * kstep;
            const char* a3 = a2 + kstep; const char* b3 = b2 + kstep;
            if (last && has_next) S.a_ready(nxt);
            PG8_LDB(B0, 0, 0); PG8_SCHED; PG8_LDA(At, 0, 0); PG8_STAGE(PG8_SA(1, 1), a1 + hstep, voffA);
            PG8_WAIT_L(8); PG8_BAR; PG8_WAIT_L(0); PG8_MMA(0, 0, At, B0); PG8_BAR; PG8_SCHED;
            PG8_LDB(B1, 0, 1); PG8_STAGE(PG8_SB(0, 0), b2, voffB);
            PG8_BAR; PG8_WAIT_L(0); PG8_MMA(0, 1, At, B1); PG8_BAR;
            PG8_LDA(At, 0, 1); PG8_STAGE(PG8_SA(0, 0), a2, voffA);
            PG8_BAR; PG8_WAIT_L(0); PG8_MMA(1, 0, At, B0); PG8_BAR; PG8_SCHED;
            PG8_STAGE(PG8_SB(0, 1), b2 + hstep, voffB);
            PG8_WAIT_V(6); PG8_BAR; PG8_MMA(1, 1, At, B1); PG8_BAR;
            PG8_LDB(B0, 1, 0); PG8_SCHED; PG8_LDA(At, 1, 0); PG8_STAGE(PG8_SA(0, 1), a2 + hstep, voffA);
            PG8_WAIT_L(8); PG8_BAR; PG8_WAIT_L(0); PG8_MMA(0, 0, At, B0); PG8_BAR; PG8_SCHED;
            PG8_LDB(B1, 1, 1); PG8_STAGE(PG8_SB(1, 0), b3, voffB);
            PG8_BAR; PG8_WAIT_L(0); PG8_MMA(0, 1, At, B1); PG8_BAR;
            PG8_LDA(At, 1, 1); PG8_STAGE(PG8_SA(1, 0), a3, voffA);
            PG8_BAR; PG8_WAIT_L(0); PG8_MMA(1, 0, At, B0); PG8_BAR; PG8_SCHED;
            PG8_STAGE(PG8_SB(1, 1), b3 + hstep, voffB);
            PG8_WAIT_V(6); PG8_BAR; PG8_MMA(1, 1, At, B1); PG8_BAR;
        }
        E(acc, cur, wr, wc, fr, fq); S.done(cur);
        if (!has_next) break;
#pragma unroll
        for (int a = 0; a < 2; ++a)
#pragma unroll
            for (int b = 0; b < 2; ++b)
#pragma unroll
                for (int m = 0; m < 4; ++m)
#pragma unroll
                    for (int n = 0; n < 2; ++n) acc[a][b][m][n] = (f32x4){0.f, 0.f, 0.f, 0.f};
        cur = nxt; cA = nA; cB = nB; ++ui;
    }
    PG8_WAIT_V(0);
    if (wr == 0) PG8_BAR;
    PG8_BAR;
#undef PG8_SA
#undef PG8_SB
#undef PG8_STAGE
#undef PG8_LDA
#undef PG8_LDB
#undef PG8_MMA
#undef PG8_WAIT_V
#undef PG8_WAIT_L
#undef PG8_BAR
#undef PG8_SCHED
}
}

namespace att {
constexpr int D = 128;
constexpr float THR = 8.f;
constexpr bool WSKIP = false;
constexpr float SCALE = 0.08838834764831845f;
constexpr int NW = 8, QBLK = 32, KVBLK = 64, QB = NW * QBLK;
constexpr int SHM_V = KVBLK * D * 2, SHM_K = KVBLK * D * 2;
constexpr int LDS_BYTES = 2 * SHM_V + 2 * SHM_K + NW * 64 * 4;
using bf16 = __hip_bfloat16;
template <class A, class Bt> struct same_t { static constexpr bool v = false; };
template <class A> struct same_t<A, A> { static constexpr bool v = true; };
#define KSWZ(row, colB) ((row) * 256 + ((colB) ^ (((row) & 7) << 4)))
#define SBAR() __builtin_amdgcn_sched_barrier(0)
__device__ __forceinline__ int v_st(int k, int c) { const int kk = (k & ~0xC) | ((k & 4) << 1) | ((k & 8) >> 1); return ((kk >> 3) * 4 + (c >> 5)) * 512 + ((kk & 7) * 32 + (c & 31)) * 2; }
__device__ __forceinline__ int v_rd_base(int lane) { return ((lane & 3) << 3) | (((lane >> 2) & 3) << 6) | (((lane >> 4) & 1) << 5) | (((lane >> 5) & 1) << 8); }
constexpr int v_rd_off(int d0, int ks, int half) { return d0 * 512 + ks * 4096 + half * 2048; }
__device__ __forceinline__ int crow(int r, int hi) { return (r & 3) + 8 * (r >> 2) + 4 * hi; }
__device__ __forceinline__ unsigned cvtpk(float lo, float hi) {
    unsigned r; asm volatile("v_cvt_pk_bf16_f32 %0, %1, %2" : "=v"(r) : "v"(lo), "v"(hi)); return r;
}
__device__ __forceinline__ bf16x8 pack8(f32x4 a, f32x4 b) {
    u32x4 w = {cvtpk(a[0], a[1]), cvtpk(a[2], a[3]), cvtpk(b[0], b[1]), cvtpk(b[2], b[3])};
    return *reinterpret_cast<bf16x8*>(&w);
}
template <class T> __device__ __forceinline__ bf16x8 load8(const T* p) {
    if constexpr (same_t<T, float>::v) { return pack8(*(const f32x4*)p, *(const f32x4*)(p + 4)); }
    else { return *reinterpret_cast<const bf16x8*>(p); }
}
__device__ __forceinline__ void mask_tile(f32x16& p0, f32x16& p1, int dq, unsigned W) {
    const float NEG = -__builtin_inff();
#pragma unroll
    for (int r = 0; r < 16; ++r) {
        const int c = (r & 3) + 8 * (r >> 2);
        if ((unsigned)(dq - c) >= W) p0[r] = NEG;
        if ((unsigned)(dq - c - 32) >= W) p1[r] = NEG;
    }
}
__device__ __forceinline__ void partialSM(f32x16& p0, f32x16& p1, float& m_reg, float& mn, float& alpha) {
    float pmax = p0[0]; for (int r = 1; r < 16; ++r) pmax = fmaxf(pmax, p0[r]); for (int r = 0; r < 16; ++r) pmax = fmaxf(pmax, p1[r]);
    { auto rr = __builtin_amdgcn_permlane32_swap(__float_as_uint(pmax), __float_as_uint(pmax), false, false);
      pmax = fmaxf(__uint_as_float(rr[0]), __uint_as_float(rr[1])); }
    constexpr float C2 = 1.4426950408889634f * SCALE;
    if (__builtin_expect(__all((pmax - m_reg) * SCALE <= THR), 1)) { mn = m_reg; alpha = 1.f; }
    else { mn = fmaxf(m_reg, pmax); alpha = __builtin_amdgcn_exp2f((m_reg - mn) * C2); m_reg = mn; }
    const float mnL = -mn * C2;
    for (int r = 0; r < 16; ++r) p0[r] = fmaf(p0[r], C2, mnL); for (int r = 0; r < 16; ++r) p1[r] = fmaf(p1[r], C2, mnL);
    for (int r = 0; r < 16; ++r) p0[r] = __builtin_amdgcn_exp2f(p0[r]);
}
__device__ __forceinline__ void finishSM(f32x16& p0, f32x16& p1, float alpha, float& l_reg, bf16x8& pa0, bf16x8& pa1, bf16x8& pa2, bf16x8& pa3) {
    for (int r = 0; r < 16; ++r) p1[r] = __builtin_amdgcn_exp2f(p1[r]);
    float ps = 0; for (int r = 0; r < 16; ++r) ps += p0[r]; for (int r = 0; r < 16; ++r) ps += p1[r];
    { auto rr = __builtin_amdgcn_permlane32_swap(__float_as_uint(ps), __float_as_uint(ps), false, false);
      ps = __uint_as_float(rr[0]) + __uint_as_float(rr[1]); }
    l_reg = l_reg * alpha + ps;
#define PK4(P, B_, OUT) do { unsigned a0 = cvtpk(P[B_+0], P[B_+1]), a1 = cvtpk(P[B_+2], P[B_+3]);                          \
        unsigned b0 = cvtpk(P[B_+4], P[B_+5]), b1 = cvtpk(P[B_+6], P[B_+7]);                                             \
        auto r0 = __builtin_amdgcn_permlane32_swap(a0, b0, false, false); auto r1 = __builtin_amdgcn_permlane32_swap(a1, b1, false, false); \
        u32x4 w = {r0[0], r1[0], r0[1], r1[1]}; OUT = *reinterpret_cast<bf16x8*>(&w); } while (0)
    PK4(p0, 0, pa0); PK4(p0, 8, pa1); PK4(p1, 0, pa2); PK4(p1, 8, pa3);
#undef PK4
}
template <int KB, bool SK>
__device__ __forceinline__ void qkt(f32x16& p0, f32x16& p1, const char* K_lds, int r32, int hi, const bf16x8* qr, bool act) {
    if (SK && !act) { const float NEG = -__builtin_inff();
#pragma unroll
        for (int r = 0; r < 16; ++r) { p0[r] = NEG; p1[r] = NEG; } return; }
    p0 = f32x16{}; p1 = f32x16{};
    const char* kb[4];
#pragma unroll
    for (int dd = 0; dd < 4; ++dd) kb[dd] = K_lds + KB * SHM_K + KSWZ(r32, (dd * 16 + hi * 8) * 2);
#pragma unroll
    for (int d0 = 0; d0 < 8; ++d0) { const char* a = kb[d0 & 3] + (d0 >> 2) * 128;
        bf16x8 b0 = *reinterpret_cast<const bf16x8*>(a);
        bf16x8 b1 = *reinterpret_cast<const bf16x8*>(a + 32 * 256);
        p0 = __builtin_amdgcn_mfma_f32_32x32x16_bf16(b0, qr[d0], p0, 0, 0, 0);
        p1 = __builtin_amdgcn_mfma_f32_32x32x16_bf16(b1, qr[d0], p1, 0, 0, 0); }
}
template <int VB, bool SK>
__device__ __forceinline__ void pv_tile(f32x16* o, int vb0, bf16x8 pa0, bf16x8 pa1, bf16x8 pa2, bf16x8 pa3, bool act) {
    if (SK && !act) return;
#define TRRD(dst, off) asm volatile("ds_read_b64_tr_b16 %0, %1 offset:%2" : "=&v"(dst) : "v"(vb0), "i"(off) : "memory")
#define PV_D0(d0) do { s16x4 l0, l1, l2, l3, h0, h1, h2, h3; constexpr int b_ = VB * SHM_V + v_rd_off(d0, 0, 0);     \
        TRRD(l0, b_); TRRD(h0, b_ + 2048); TRRD(l1, b_ + 4096); TRRD(h1, b_ + 6144); TRRD(l2, b_ + 8192); TRRD(h2, b_ + 10240); TRRD(l3, b_ + 12288); TRRD(h3, b_ + 14336); \
        asm volatile("s_waitcnt lgkmcnt(0)" ::: "memory"); SBAR();                 \
        o[d0] = __builtin_amdgcn_mfma_f32_32x32x16_bf16(pa0, (bf16x8){l0[0], l0[1], l0[2], l0[3], h0[0], h0[1], h0[2], h0[3]}, o[d0], 0, 0, 0);   \
        o[d0] = __builtin_amdgcn_mfma_f32_32x32x16_bf16(pa1, (bf16x8){l1[0], l1[1], l1[2], l1[3], h1[0], h1[1], h1[2], h1[3]}, o[d0], 0, 0, 0);   \
        o[d0] = __builtin_amdgcn_mfma_f32_32x32x16_bf16(pa2, (bf16x8){l2[0], l2[1], l2[2], l2[3], h2[0], h2[1], h2[2], h2[3]}, o[d0], 0, 0, 0);   \
        o[d0] = __builtin_amdgcn_mfma_f32_32x32x16_bf16(pa3, (bf16x8){l3[0], l3[1], l3[2], l3[3], h3[0], h3[1], h3[2], h3[3]}, o[d0], 0, 0, 0); } while (0)
    PV_D0(0); PV_D0(1); PV_D0(2); PV_D0(3);
#undef PV_D0
#undef TRRD
}

template <class TIn, class TOut> struct BlockRef { const TIn* Q; const TIn* K; const TIn* V; TOut* O; int P0; };
template <class TIn> struct Seam {
    bf16x8 qr[8];
    bf16x8 st_v0, st_v1, st_k0, st_k1; f32x4 sf0, sf1, sf2, sf3;
    f32x4 tq[16];
};
__device__ __forceinline__ int swa_jlo(int P0, int W) { const int lowk = P0 - W + 1; return lowk > 0 ? lowk / KVBLK : 0; }
#define ROW(p, k0, rr) ((p) + (size_t)((k0) + (rr)) * D + sc)
#define VMW() asm volatile("s_waitcnt vmcnt(0)" ::: "memory")
#define VMWN(n) asm volatile("s_waitcnt vmcnt(%0)" :: "i"(n) : "memory")
#define SLOAD_H(Kp, Vp, k0) do { S.st_v0 = load8<TIn>(ROW(Vp, k0, sr)); S.st_v1 = load8<TIn>(ROW(Vp, k0, 32 + sr));              \
                         S.st_k0 = load8<TIn>(ROW(Kp, k0, sr)); S.st_k1 = load8<TIn>(ROW(Kp, k0, 32 + sr)); } while (0)
#define SWRITE_HK(bf) do { *(bf16x8*)(K_lds + (bf) * SHM_K + kws) = S.st_k0; *(bf16x8*)(K_lds + (bf) * SHM_K + kws + 32 * 256) = S.st_k1; } while (0)
#define SWRITE_HV(bf) do { *(bf16x8*)(V_lds + (bf) * SHM_V + vst0) = S.st_v0; *(bf16x8*)(V_lds + (bf) * SHM_V + vst1) = S.st_v1; } while (0)
#define SWRITE_H(bf) do { SWRITE_HV(bf); SWRITE_HK(bf); } while (0)
#define SLOAD_F(p, k0) do { S.sf0 = *(const f32x4*)ROW(p, k0, sr); S.sf1 = *(const f32x4*)(ROW(p, k0, sr) + 4);                \
                            S.sf2 = *(const f32x4*)ROW(p, k0, 32 + sr); S.sf3 = *(const f32x4*)(ROW(p, k0, 32 + sr) + 4); } while (0)
#define SWRITE_KF(bf) do { *(bf16x8*)(K_lds + (bf) * SHM_K + kws) = pack8(S.sf0, S.sf1); *(bf16x8*)(K_lds + (bf) * SHM_K + kws + 32 * 256) = pack8(S.sf2, S.sf3); } while (0)
#define SWRITE_VF(bf) do { *(bf16x8*)(V_lds + (bf) * SHM_V + vst0) = pack8(S.sf0, S.sf1); *(bf16x8*)(V_lds + (bf) * SHM_V + vst1) = pack8(S.sf2, S.sf3); } while (0)
template <class TIn, class TOut>
__device__ __forceinline__ void causal_swa_prime(const BlockRef<TIn, TOut>& cur, int W, char* lds, Seam<TIn>& S, const int wv) {
    constexpr bool F32 = same_t<TIn, float>::v;
    const int tid = ltid(wv), wid = __builtin_amdgcn_readfirstlane(tid >> 6), lane = tid & 63, r32 = lane & 31, hi = lane >> 5;
    const int sr = tid >> 4, sc = (tid & 15) * 8, kws = KSWZ(sr, sc * 2); char* K_lds = lds + 2 * SHM_V;
    const int kb0 = swa_jlo(cur.P0, W) * KVBLK;
    for (int d0 = 0; d0 < 8; ++d0) S.qr[d0] = load8<TIn>(cur.Q + (size_t)(wid * QBLK + r32) * D + d0 * 16 + hi * 8);
    if constexpr (F32) { SLOAD_F((const float*)cur.K, kb0); VMW(); SWRITE_KF(0); SBAR(); SLOAD_F((const float*)cur.V, kb0); }
    else { SLOAD_H(cur.K, cur.V, kb0); VMW(); SWRITE_HK(0); }
    __syncthreads();
}
template <class TIn, class TOut>
__device__ __forceinline__ void causal_swa_block(const BlockRef<TIn, TOut>& cur, const BlockRef<TIn, TOut>& nxt, int skv, int W, char* lds, Seam<TIn>& S, const int wv) {
    constexpr bool F32 = same_t<TIn, float>::v;
    const int tid = ltid(wv), wid = __builtin_amdgcn_readfirstlane(tid >> 6), lane = tid & 63, r32 = lane & 31, hi = lane >> 5;
    const int j_lo = swa_jlo(cur.P0, W);
    int j_hi = (cur.P0 + QB - 1) / KVBLK + 1; if (j_hi > skv / KVBLK) j_hi = skv / KVBLK;
    const int NT = j_hi - j_lo;
    const int kbn = swa_jlo(nxt.P0, W) * KVBLK;
    const int qlo = cur.P0 + wid * QBLK, qm = qlo + r32 - 4 * hi;
    char* V_lds = lds; char* K_lds = lds + 2 * SHM_V;
    float* ws = (float*)(lds + 2 * SHM_V + 2 * SHM_K) + wid * 64; float* li_l = ws, * al_l = ws + 32;
    float m_reg = -1e30f, l_reg = 0; f32x16 o[4] = {};
    const int sr = tid >> 4, sc = (tid & 15) * 8, vst0 = v_st(sr, sc), vst1 = v_st(32 + sr, sc), kws = KSWZ(sr, sc * 2);
    const int vb0 = (int)(uintptr_t)V_lds + v_rd_base(lane);
    const TIn* Kh = cur.K; const TIn* Vh = cur.V;
#define RESC(a) do { if (__any((a) < 1.f)) { if (hi == 0) al_l[r32] = (a); asm volatile("s_waitcnt lgkmcnt(0)" ::: "memory");              \
                     for (int d_ = 0; d_ < 4; ++d_) for (int r = 0; r < 16; ++r) o[d_][r] *= al_l[crow(r, hi)]; } } while (0)
#define KBASE(t) ((j_lo + (t)) * KVBLK)
#define ACT(t) (KBASE(t) <= qlo + QBLK - 1 && KBASE(t) + KVBLK - 1 >= qlo - W + 1)
#define MASKT(P0_, P1_, t) do { const int kb_ = KBASE(t); if ((!SK || ACT(t)) && (kb_ + KVBLK - 1 > qlo || kb_ <= qlo + QBLK - 1 - W)) mask_tile(P0_, P1_, qm - kb_, (unsigned)W); } while (0)
    constexpr int NQL = F32 ? 16 : 8;
    constexpr bool SK = WSKIP && !F32;
#define SEAM_K0() do { VMWN(NQL); if constexpr (F32) { SWRITE_KF(0); SBAR(); SLOAD_F((const float*)nxt.V, kbn); } else { SWRITE_HK(0); } SBAR(); } while (0)
    f32x16 pA0, pA1, pB0, pB1; float mnA, mnB, alA, alB; bf16x8 pa0, pa1, pa2, pa3;
    if constexpr (F32) { VMW(); SWRITE_VF(0); SBAR(); } else { SWRITE_HV(0); SBAR(); }
    if (NT > 1) { if constexpr (F32) SLOAD_F((const float*)Kh, KBASE(1)); else SLOAD_H(Kh, Vh, KBASE(1)); }
    SBAR(); qkt<0, SK>(pA0, pA1, K_lds, r32, hi, S.qr, ACT(0));
    if constexpr (F32) { if (NT > 1) { VMW(); SWRITE_KF(1); SBAR(); SLOAD_F((const float*)Vh, KBASE(1)); } }
    MASKT(pA0, pA1, 0); partialSM(pA0, pA1, m_reg, mnA, alA);
    if (NT > 1) { VMW(); if constexpr (F32) { SWRITE_VF(1); SBAR(); if (NT > 2) SLOAD_F((const float*)Kh, KBASE(2)); } else SWRITE_H(1); }
    __syncthreads();
#define HALF_STEP(PX0, PX1, mnX, alX, PY0, PY1, alY, t, KB, VB, SB) do {                                                      \
        SBAR(); qkt<KB, SK>(PX0, PX1, K_lds, r32, hi, S.qr, ACT(t));                                             \
        finishSM(PY0, PY1, alY, l_reg, pa0, pa1, pa2, pa3); SBAR();                                                           \
        if ((t) + 1 < NT) { if constexpr (F32) { VMW(); SWRITE_KF(SB); SBAR(); SLOAD_F((const float*)Vh, KBASE((t) + 1)); }  \
                            else { SLOAD_H(Kh, Vh, KBASE((t) + 1)); } SBAR(); }                                               \
        pv_tile<VB, SK>(o, vb0, pa0, pa1, pa2, pa3, ACT((t) - 1)); MASKT(PX0, PX1, (t)); partialSM(PX0, PX1, m_reg, mnX, alX);                                        \
        __syncthreads();                                                                                                      \
        if ((t) + 1 < NT) { VMW(); if constexpr (F32) { SWRITE_VF(SB); SBAR(); if ((t) + 2 < NT) SLOAD_F((const float*)Kh, KBASE((t) + 2)); } \
                            else { SWRITE_H(SB); } }                                                                          \
        RESC(alX); __syncthreads(); } while (0)
    for (int t = 1; t + 1 < NT; t += 2) {
        HALF_STEP(pB0, pB1, mnB, alB, pA0, pA1, alA, t, 1, 0, 0);
        HALF_STEP(pA0, pA1, mnA, alA, pB0, pB1, alB, t + 1, 0, 1, 1);
    }
    const bool even = (NT & 1) == 0;
    if (even) { SBAR(); qkt<1, SK>(pB0, pB1, K_lds, r32, hi, S.qr, ACT(NT - 1)); SBAR(); }
#define QROW(e) (nxt.Q + (size_t)(wid * QBLK + r32) * D + ((e) >> 1) * 16 + hi * 8 + ((e) & 1) * 4)
    if constexpr (F32) { SLOAD_F((const float*)nxt.K, kbn); SBAR();
#pragma unroll
        for (int e = 0; e < 8; ++e) S.tq[e] = *(const f32x4*)QROW(e); }
    else { SLOAD_H(nxt.K, nxt.V, kbn); SBAR();
#pragma unroll
        for (int d0 = 0; d0 < 8; ++d0) S.qr[d0] = load8<TIn>(nxt.Q + (size_t)(wid * QBLK + r32) * D + d0 * 16 + hi * 8); }
    SBAR();
    finishSM(pA0, pA1, alA, l_reg, pa0, pa1, pa2, pa3); SBAR();
    if constexpr (F32) {
#pragma unroll
        for (int e = 8; e < 16; ++e) S.tq[e] = *(const f32x4*)QROW(e); SBAR(); }
#undef QROW
    pv_tile<0, SK>(o, vb0, pa0, pa1, pa2, pa3, ACT(even ? NT - 2 : NT - 1));
    if (even) { MASKT(pB0, pB1, NT - 1); partialSM(pB0, pB1, m_reg, mnB, alB); __syncthreads(); RESC(alB);
        finishSM(pB0, pB1, alB, l_reg, pa0, pa1, pa2, pa3); SBAR(); pv_tile<1, SK>(o, vb0, pa0, pa1, pa2, pa3, ACT(NT - 1)); }
    SBAR(); SEAM_K0();
    if (hi == 0) li_l[r32] = l_reg; asm volatile("s_waitcnt lgkmcnt(0)" ::: "memory");
    float rli[16];
#pragma unroll
    for (int r = 0; r < 16; ++r) rli[r] = __builtin_amdgcn_rcpf(li_l[crow(r, hi)]);
    TOut* Ow = cur.O + (size_t)(wid * QBLK) * D;
#pragma unroll
    for (int r = 0; r < 16; ++r) { const int orow = crow(r, hi);
#pragma unroll
        for (int d0 = 0; d0 < 4; ++d0) { const float v = o[d0][r] * rli[r];
            if constexpr (same_t<TOut, float>::v) { Ow[(size_t)orow * D + d0 * 32 + r32] = v; }
            else { const float vn = sw_xor<1>(v);
                   if ((r32 & 1) == 0) *(unsigned*)(Ow + (size_t)orow * D + d0 * 32 + r32) = cvtpk(v, vn); } } }
    if constexpr (F32) {
#pragma unroll
        for (int d0 = 0; d0 < 8; ++d0) S.qr[d0] = pack8(S.tq[2 * d0], S.tq[2 * d0 + 1]); }
    __syncthreads();
#undef RESC
#undef KBASE
#undef ACT
#undef MASKT
#undef SEAM_K0
#undef HALF_STEP
}
#undef ROW
#undef VMW
#undef VMWN
#undef SLOAD_H
#undef SWRITE_HK
#undef SWRITE_HV
#undef SWRITE_H
#undef SLOAD_F
#undef SWRITE_KF
#undef SWRITE_VF
#undef KSWZ
#undef SBAR
}

#define MFMA16(a, b, c) __builtin_amdgcn_mfma_f32_16x16x32_bf16((a), (b), (c), 0, 0, 0)
#define MFMA32(a, b, c) __builtin_amdgcn_mfma_f32_32x32x16_bf16((a), (b), (c), 0, 0, 0)
#define WSP(T_, off) ((T_*)(p->ws + (off)))

DI void sincos_red(double r, float& s, float& c) {
    const double r2 = r * r; double sp = 1.0, cp = 1.0;
#pragma unroll
    for (int k = 13; k >= 1; --k) { sp = 1.0 - sp * r2 * (1.0 / (double)((2 * k) * (2 * k + 1))); cp = 1.0 - cp * r2 * (1.0 / (double)((2 * k - 1) * (2 * k))); }
    s = (float)(r * sp); c = (float)cp;
}

DI void cvt_wt_job(const float* src, bf16_t* dst, int N, int Npad, int nperm, float* tile, const int wv) {
    const int tid = ltid(wv), K = 2048, ntn = Npad / 64, ntiles = ntn * (K / 64);
    for (int tl = blockIdx.x; tl < ntiles; tl += gridDim.x) {
        const int tn = tl % ntn, tk = tl / ntn, k0 = tk * 64, n0 = tn * 64, c = tid & 63;
        int ns = n0 + c;
        if (ns < nperm) { const int p7 = ns & 127, u = p7 >> 3, e = p7 & 7; ns = (ns & ~127) + ((e < 4) ? 4 * u + e : 64 + 4 * u + (e - 4)); }
#pragma unroll
        for (int i = 0; i < 8; ++i) { const int r = (tid >> 6) + 8 * i, n = n0 + c; tile[r * 65 + c] = (n < N) ? src[(size_t)(k0 + r) * N + ns] : 0.f; }
        __syncthreads();
#pragma unroll
        for (int i = 0; i < 4; ++i) { const int id = tid + 512 * i, rr = id >> 5, cp = id & 31;
            ((unsigned*)dst)[((size_t)(n0 + rr) * K + k0) / 2 + cp] = cvt_pk_bf16(tile[(2 * cp) * 65 + rr], tile[(2 * cp + 1) * 65 + rr]); }
        __syncthreads();
    }
}

DI void ph_prologue(PK p, unsigned char* lds, const int wv) {
    PK_FRESH(p);
    const int tid = ltid(wv), lane = tid & 63, wave = __builtin_amdgcn_readfirstlane(tid >> 6);
    float* ldsf = (float*)lds;
    {
        float* sc = ldsf; float* red = ldsf + 4096;
        for (int i = tid; i < 4096; i += 512) sc[i] = silu_f(p->in[1][i]);
        __syncthreads();
        float* mod = WSP(float, WS_MOD);
        for (int item = blockIdx.x; item < MODC / 64; item += gridDim.x) {
            const int col0 = item * 64, col = col0 + lane;
            const float* W; size_t stride;
            if (col0 < 4 * 12288) { const int l = col0 / 12288, j = col - l * 12288; W = p->in[3] + (size_t)l * 2048 * 12288 + j; stride = 12288; }
            else { W = p->in[14] + (col - 4 * 12288); stride = 4096; }
            float a0 = 0.f, a1 = 0.f;
            const int kb = wave * 256;
#pragma unroll 8
            for (int k = 0; k < 256; ++k) { const float wv = W[(size_t)(kb + k) * stride]; a0 += sc[kb + k] * wv; a1 += sc[2048 + kb + k] * wv; }
            red[(wave * 64 + lane) * 2 + 0] = a0; red[(wave * 64 + lane) * 2 + 1] = a1;
            __syncthreads();
            if (tid < 128) { const int ln = tid & 63, b = tid >> 6; float s = 0.f;
#pragma unroll
                for (int w = 0; w < 8; ++w) s += red[(w * 64 + ln) * 2 + b];
                const int cc = col0 + ln; const float bias = (cc < 4 * 12288) ? p->in[4][cc] : p->in[15][cc - 4 * 12288];
                mod[(size_t)b * MODC + cc] = s + bias; }
            __syncthreads();
        }
    }
    for (int job = 0; job < 9; ++job) {
        const float* src; bf16_t* dst; int N = 2048, Npad = 2048, nperm = 0;
        if (job < 2) { src = p->in[7] + (size_t)job * 2048 * GIN; dst = WSP(bf16_t, WS_WIN) + (size_t)job * GINP * 2048; N = GIN; Npad = GINP; }
        else if (job < 4) { src = p->in[12] + (size_t)(job - 2) * 2048 * 2048; dst = WSP(bf16_t, WS_WOUT) + (size_t)(job - 2) * 2048 * 2048; }
        else if (job == 4) { src = p->in[16]; dst = WSP(bf16_t, WS_KVW); N = 4096; Npad = 4096; nperm = 2048; }
        else if (job < 7) { src = p->in[17] + (size_t)(job - 5) * 2048 * 2048; dst = WSP(bf16_t, WS_DWQ) + (size_t)(job - 5) * 2048 * 2048; nperm = 2048; }
        else { src = p->in[20] + (size_t)(job - 7) * 2048 * 2048; dst = WSP(bf16_t, WS_DWO) + (size_t)(job - 7) * 2048 * 2048; }
        cvt_wt_job(src, dst, N, Npad, nperm, ldsf, wv);
    }
    {
        const int lane = tid & 63, r16 = lane & 15, quad = lane >> 4;
        bf16_t* wdst = WSP(bf16_t, WS_PWQ);
        for (int task = (blockIdx.x * 8 + wave); task < 4 * 16 * 128; task += gridDim.x * 8) {
            const int kt = task & 127, pj = (task >> 7) & 15, l = task >> 11, pp = pj >> 1, jh = pj & 1;
            const float* wq = p->in[21] + ((size_t)l * 2048 + kt * 16 + r16) * 2048 + pp * 256 + jh * 128 + quad * 8;
            const float* ky = p->in[22] + ((size_t)(l * 2 + jh) * 128 + r16) * 128 + quad * 8;
            bf16x8 bw[4];
#pragma unroll
            for (int ks = 0; ks < 4; ++ks) { const f32x4 a = *(const f32x4*)(wq + ks * 32), b = *(const f32x4*)(wq + ks * 32 + 4);
                u32x4 w; w.x = cvt_pk_bf16(a[0], a[1]); w.y = cvt_pk_bf16(a[2], a[3]); w.z = cvt_pk_bf16(b[0], b[1]); w.w = cvt_pk_bf16(b[2], b[3]); bw[ks] = __builtin_bit_cast(bf16x8, w); }
#pragma unroll
            for (int nt = 0; nt < 8; ++nt) { f32x4 acc = {0.f, 0.f, 0.f, 0.f};
#pragma unroll
                for (int ks = 0; ks < 4; ++ks) { const f32x4 a = *(const f32x4*)(ky + (size_t)nt * 16 * 128 + ks * 32), b = *(const f32x4*)(ky + (size_t)nt * 16 * 128 + ks * 32 + 4);
                    u32x4 w; w.x = cvt_pk_bf16(a[0], a[1]); w.y = cvt_pk_bf16(a[2], a[3]); w.z = cvt_pk_bf16(b[0], b[1]); w.w = cvt_pk_bf16(b[2], b[3]);
                    acc = MFMA16(bw[ks], __builtin_bit_cast(bf16x8, w), acc); }
                u32x2 wo; wo.x = cvt_pk_bf16(acc[0], acc[1]); wo.y = cvt_pk_bf16(acc[2], acc[3]);
                *(u32x2*)(wdst + ((size_t)l * 2048 + pp * 256 + jh * 128 + nt * 16 + r16) * 2048 + kt * 16 + quad * 4) = wo; }
        }
    }
    {
        float* cosT = WSP(float, WS_COS); float* sinT = WSP(float, WS_SIN); const int* pos = (const int*)p->in[2];
        for (int idx = blockIdx.x * 512 + tid; idx < T * 64; idx += gridDim.x * 512) {
            const int t = idx >> 6, j = idx & 63;
            const double inv = exp(-(double)j * (9.210340371976184 / 64.0));
            const double ang = (double)pos[t] * inv;
            const double n = rint(ang * 0.15915494309189535);
            double r = fma(-n, 6.283185307179586, ang); r = fma(-n, 2.4492935982947064e-16, r);
            float s, c; sincos_red(r, s, c); cosT[idx] = c; sinT[idx] = s;
        }
    }
}

template <int MODE>
DI void ph_norm(const float* x, const bf16_t* xb, const float* g, const float* shift, const float* scale, bf16_t* dstb, float* dstf, const int wv) {
    const int tid = ltid(wv), lane = tid & 63, wave = __builtin_amdgcn_readfirstlane(tid >> 6);
    for (int row = blockIdx.x * 8 + wave; row < T; row += gridDim.x * 8) {
        const int b = row >> 13;
        f32x4 v[8]; float ss = 0.f;
#pragma unroll
        for (int i = 0; i < 8; ++i) {
            if (MODE == 2) { const u32x2 w = *(const u32x2*)(xb + (size_t)row * D + i * 256 + lane * 4); v[i] = (f32x4){bflo(w.x), bfhi(w.x), bflo(w.y), bfhi(w.y)}; }
            else v[i] = *(const f32x4*)(x + (size_t)row * D + i * 256 + lane * 4);
            ss += v[i][0] * v[i][0] + v[i][1] * v[i][1] + v[i][2] * v[i][2] + v[i][3] * v[i][3]; }
        ss = wave_sum(ss);
        const float r = rsqrtf(ss * (1.f / D) + NORM_EPS);
#pragma unroll
        for (int i = 0; i < 8; ++i) { const int col = i * 256 + lane * 4; const f32x4 gv = *(const f32x4*)(g + col);
            if (MODE != 1) { const f32x4 sh = *(const f32x4*)(shift + (size_t)b * MODC + col), sc = *(const f32x4*)(scale + (size_t)b * MODC + col);
                f32x4 y;
#pragma unroll
                for (int e = 0; e < 4; ++e) y[e] = v[i][e] * r * gv[e] * (1.f + sc[e]) + sh[e];
                u32x2 w; w.x = cvt_pk_bf16(y[0], y[1]); w.y = cvt_pk_bf16(y[2], y[3]); *(u32x2*)(dstb + (size_t)row * D + col) = w; }
            else { f32x4 y;
#pragma unroll
                for (int e = 0; e < 4; ++e) y[e] = v[i][e] * r * gv[e];
                *(f32x4*)(dstf + (size_t)row * D + col) = y; } }
    }
}

DI void pc_load(PK p, int l, int row, f32x4 (&v)[8], const int lane) {
    const float* s = ((row >= 16384) ? p->in[24] : p->in[23]) + ((size_t)l * 16384 + (row & 16383)) * 2048;
#pragma unroll
    for (int i = 0; i < 8; ++i) v[i] = *(const f32x4*)(s + lane * 32 + i * 4);
}
DI void pc_store(PK p, int row, const f32x4 (&v)[8], const int lane) {
    const bool second = row >= 16384; const int r = row & 16383;
    unsigned char* dq = WSP(unsigned char, second ? WS_PV : WS_PU); unsigned short* ds = WSP(unsigned short, WS_PUS);
    float m0 = 0.f;
#pragma unroll
    for (int i = 0; i < 8; ++i) { const float mm = fmaxf(fmaxf(fabsf(v[i][0]), fabsf(v[i][1])), fmaxf(fabsf(v[i][2]), fabsf(v[i][3]))); m0 = fmaxf(m0, mm); }
    m0 = fmaxf(m0, sw_xor<1>(m0)); m0 = fmaxf(m0, sw_xor<2>(m0));
    const bf16_t sb0 = (m0 > 0.f) ? f2bf(m0 * (1.004f / 6.f)) : (bf16_t)0x3f80;
    const float inv = 1.f / bf2f(sb0);
    u32x4 w;
#pragma unroll
    for (int c = 0; c < 4; ++c) { unsigned x = 0u;
        x = __builtin_amdgcn_cvt_scalef32_pk_fp4_f32(x, v[2 * c][0] * inv, v[2 * c][1] * inv, 1.0f, 0);
        x = __builtin_amdgcn_cvt_scalef32_pk_fp4_f32(x, v[2 * c][2] * inv, v[2 * c][3] * inv, 1.0f, 1);
        x = __builtin_amdgcn_cvt_scalef32_pk_fp4_f32(x, v[2 * c + 1][0] * inv, v[2 * c + 1][1] * inv, 1.0f, 2);
        x = __builtin_amdgcn_cvt_scalef32_pk_fp4_f32(x, v[2 * c + 1][2] * inv, v[2 * c + 1][3] * inv, 1.0f, 3);
        w[c] = x; }
    *(u32x4*)(dq + (size_t)r * 1024 + lane * 16) = w;
    if ((lane & 3) == 0) ds[((size_t)r * 16 + (lane >> 2)) * 2 + (second ? 1 : 0)] = (unsigned short)sb0;
}
DI void ph_peer_cvt(PK p, int l, const int wv) {
    PK_FRESH(p);
    const int tid = ltid(wv), lane = tid & 63, wave = __builtin_amdgcn_readfirstlane(tid >> 6);
    for (int row = blockIdx.x * 8 + wave; row < 2 * 16384; row += gridDim.x * 8) { f32x4 v[8]; pc_load(p, l, row, v, lane); pc_store(p, row, v, lane); }
}


template <int I, int J>
DI void tinv_block(const bf16_t* Lb, bf16_t* Ti, bf16_t* TT, bf16_t* XT, const int r16, const int quad) {
    constexpr int nK = 16 * (I - J);
    const bf16x8 zero8 = {0, 0, 0, 0, 0, 0, 0, 0};
    f32x4 acc = {0.f, 0.f, 0.f, 0.f};
#pragma unroll
    for (int ks = 0; ks < (nK + 31) / 32; ++ks) {
        const int k0 = ks * 32 + quad * 8; const bool valid = k0 < nK;
        const bf16x8 a = valid ? *(const bf16x8*)(Lb + (16 * I + r16) * 72 + 16 * J + k0) : zero8;
        const bf16x8 b = valid ? *(const bf16x8*)(TT + (16 * J + r16) * 72 + 16 * J + k0) : zero8;
        acc = MFMA16(a, b, acc);
    }
    { u32x2 w; w.x = cvt_pk_bf16(acc[0], acc[1]); w.y = cvt_pk_bf16(acc[2], acc[3]); *(u32x2*)(XT + r16 * 24 + quad * 4) = w; }
    asm volatile("s_waitcnt lgkmcnt(0)" ::: "memory");
    const bool v2 = quad < 2;
    const bf16x8 a2 = v2 ? *(const bf16x8*)(Ti + (16 * I + r16) * 72 + 16 * I + quad * 8) : zero8;
    const bf16x8 b2 = v2 ? *(const bf16x8*)(XT + r16 * 24 + quad * 8) : zero8;
    f32x4 m = {0.f, 0.f, 0.f, 0.f};
    m = MFMA16(a2, b2, m);
#pragma unroll
    for (int r = 0; r < 4; ++r) Ti[(16 * I + quad * 4 + r) * 72 + 16 * J + r16] = f2bf(-m[r]);
    { u32x2 w; w.x = cvt_pk_bf16(-m[0], -m[1]); w.y = cvt_pk_bf16(-m[2], -m[3]); *(u32x2*)(TT + (16 * J + r16) * 72 + 16 * I + quad * 4) = w; }
    asm volatile("s_waitcnt lgkmcnt(0)" ::: "memory");
}

DI void ph_gdn_p1(PK p, int l, unsigned char* lds, const int wv) {
    PK_FRESH(p);
    const bf16_t* proj = WSP(const bf16_t, WS_PROJ);
    const float* convw = p->in[8] + (size_t)l * 4 * 6144; const float* alog = p->in[9] + l * 16; const float* dtb = p->in[10] + l * 16;
    bf16_t* Ag = WSP(bf16_t, WS_GA); bf16_t* Bg = WSP(bf16_t, WS_GB); bf16_t* Qg = WSP(bf16_t, WS_GQ); bf16_t* Og = WSP(bf16_t, WS_GO); float* glg = WSP(float, WS_GL);
    bf16_t* qb  = (bf16_t*)(lds + 0);
    bf16_t* kb  = (bf16_t*)(lds + 17408);
    bf16_t* Lb  = (bf16_t*)(lds + 34816);
    bf16_t* wT  = (bf16_t*)(lds + 17408);
    bf16_t* vbT = (bf16_t*)(lds + 44032);
    bf16_t* kdT = (bf16_t*)(lds + 62464);
    bf16_t* kbT = (bf16_t*)(lds + 80896);
    bf16_t* uT  = (bf16_t*)(lds + 80896);
    bf16_t* aqk = (bf16_t*)(lds + 99328);
    bf16_t* Ti  = (bf16_t*)(lds + 108544);
    bf16_t* TT  = (bf16_t*)(lds + 117760);
    float*  Ld  = (float*)(lds + 126976);
    bf16_t* XT  = (bf16_t*)(lds + 132096);
    float*  sc  = (float*)(lds + 133120);
    float*  cw  = (float*)(lds + 134144);
    int cached_bh = -1;
    for (int it = blockIdx.x; it < 4096; it += gridDim.x) {
        const int tid = ltid(wv), lane = tid & 63, wave = __builtin_amdgcn_readfirstlane(tid >> 6), r16 = lane & 15, quad = lane >> 4;
        const int bh = it & 31, n = it >> 5, hd = bh & 15, b = bh >> 4, tok0 = b * SEQ + n * 64, ci = bh * 128 + n;
        if (bh != cached_bh) {
            for (int idx = tid; idx < 1536; idx += 512) { const int part = idx >> 9, tap = (idx >> 7) & 3, c = idx & 127; cw[idx] = convw[tap * 6144 + part * 2048 + hd * 128 + c]; }
            cached_bh = bh;
            lds_barrier();
        }
        float pa_[4] = {0.f, 0.f, 0.f, 0.f}, pb_[4] = {0.f, 0.f, 0.f, 0.f}, dtbv = 0.f, alogv = 0.f;
        if (tid < 64) { const float* pab = WSP(const float, WS_PAB) + (size_t)(tok0 + tid) * 32 + hd; const size_t qs = (size_t)T * 32;
#pragma unroll
            for (int q4 = 0; q4 < 4; ++q4) { pa_[q4] = pab[q4 * qs]; pb_[q4] = pab[q4 * qs + 16]; }
            dtbv = dtb[hd]; alogv = alog[hd]; }
        {
            const int c16 = tid & 15, t0 = (tid >> 4) * 2;
#pragma unroll
            for (int part = 0; part < 3; ++part) {
                const int ch = part * 2048 + hd * 128 + c16 * 8;
                float xr[5][8];
#pragma unroll
                for (int r = 0; r < 5; ++r) {
                    const int sp = n * 64 + t0 - 3 + r;
                    u32x4 raw = {0u, 0u, 0u, 0u};
                    if (sp >= 0) raw = *(const u32x4*)(proj + (size_t)(b * SEQ + sp) * GINP + ch);
                    xr[r][0] = bflo(raw.x); xr[r][1] = bfhi(raw.x); xr[r][2] = bflo(raw.y); xr[r][3] = bfhi(raw.y); xr[r][4] = bflo(raw.z); xr[r][5] = bfhi(raw.z); xr[r][6] = bflo(raw.w); xr[r][7] = bfhi(raw.w);
                }
                float wt[4][8];
#pragma unroll
                for (int tap = 0; tap < 4; ++tap) { const f32x4 w0 = *(const f32x4*)(cw + (part * 4 + tap) * 128 + c16 * 8), w1 = *(const f32x4*)(cw + (part * 4 + tap) * 128 + c16 * 8 + 4);
                    wt[tap][0] = w0[0]; wt[tap][1] = w0[1]; wt[tap][2] = w0[2]; wt[tap][3] = w0[3]; wt[tap][4] = w1[0]; wt[tap][5] = w1[1]; wt[tap][6] = w1[2]; wt[tap][7] = w1[3]; }
                float av[2][8];
#pragma unroll
                for (int u = 0; u < 2; ++u) {
                    float ss = 0.f;
#pragma unroll
                    for (int e = 0; e < 8; ++e) { float a = wt[0][e] * xr[u][e]; a = fmaf(wt[1][e], xr[u + 1][e], a); a = fmaf(wt[2][e], xr[u + 2][e], a); a = fmaf(wt[3][e], xr[u + 3][e], a);
                        a = silu_f(a); av[u][e] = a; ss += a * a; }
                    if (part < 2) {
                        ss += sw_xor<1>(ss); ss += sw_xor<2>(ss); ss += sw_xor<4>(ss); ss += sw_xor<8>(ss);
                        const float r = rsqrtf(ss + NORM_EPS) * (part == 0 ? 0.08838834764831845f : 1.f);
                        u32x4 w; w.x = cvt_pk_bf16(av[u][0] * r, av[u][1] * r); w.y = cvt_pk_bf16(av[u][2] * r, av[u][3] * r); w.z = cvt_pk_bf16(av[u][4] * r, av[u][5] * r); w.w = cvt_pk_bf16(av[u][6] * r, av[u][7] * r);
                        *(u32x4*)((part == 0 ? qb : kb) + (t0 + u) * 136 + c16 * 8) = w;
                    }
                }
                if (part == 2) {
#pragma unroll
                    for (int e = 0; e < 8; ++e) *(unsigned*)(vbT + (c16 * 8 + e) * 72 + t0) = cvt_pk_bf16(av[0][e], av[1][e]);
                }
            }
        }
        if (tid < 64) {
            const int t = tid;
            const float av = (pa_[0] + pa_[1]) + (pa_[2] + pa_[3]), bv = (pb_[0] + pb_[1]) + (pb_[2] + pb_[3]);
            const float xx = av + dtbv;
            const float ex = __expf(xx); const float sp = (xx > 20.f) ? xx : ((xx < -8.f) ? ex * (1.f - 0.5f * ex) : __logf(1.f + ex));
            const float g = -__expf(alogv) * sp;
            const float beta = 1.f / (1.f + __expf(-bv));
            float G = g;
#pragma unroll
            for (int d = 1; d < 64; d <<= 1) { const float o = __int_as_float(__builtin_amdgcn_ds_bpermute(((t - d) & 63) << 2, __float_as_int(G))); if (t >= d) G += o; }
            const float Gl = __int_as_float(__builtin_amdgcn_readlane(__float_as_int(G), 63));
            sc[t] = beta; sc[64 + t] = G; sc[128 + t] = __expf(G); sc[192 + t] = __expf(Gl - G);
            if (t == 63) glg[ci] = __expf(G);
        }
        lds_barrier();
        {
            const int which = wave >> 2, mi = wave & 3;
#pragma unroll
            for (int ni = 0; ni < 4; ++ni) {
                if (which == 0 ? (ni >= mi) : (ni <= mi)) {
                    f32x4 acc = {0.f, 0.f, 0.f, 0.f};
                    const bf16_t* Ab = (which ? qb : kb) + (mi * 16 + r16) * 136 + quad * 8;
                    const bf16_t* Bb = kb + (ni * 16 + r16) * 136 + quad * 8;
#pragma unroll
                    for (int ks = 0; ks < 4; ++ks) acc = MFMA16(*(const bf16x8*)(Ab + ks * 32), *(const bf16x8*)(Bb + ks * 32), acc);
                    const int cidx = ni * 16 + r16; const float Gc = sc[64 + cidx];
                    if (which == 0) {
                        const float bi = sc[cidx]; f32x4 lv;
#pragma unroll
                        for (int r = 0; r < 4; ++r) { const int jj = mi * 16 + quad * 4 + r; lv[r] = (jj < cidx) ? bi * acc[r] * __expf(fminf(Gc - sc[64 + jj], 0.f)) : 0.f; }
                        if (ni == mi) *(f32x4*)(Ld + mi * 320 + r16 * 20 + quad * 4) = lv;
                        else { u32x2 w; w.x = cvt_pk_bf16(lv[0], lv[1]); w.y = cvt_pk_bf16(lv[2], lv[3]); *(u32x2*)(Lb + cidx * 72 + mi * 16 + quad * 4) = w; }
                    } else {
#pragma unroll
                        for (int r = 0; r < 4; ++r) { const int ii = mi * 16 + quad * 4 + r; aqk[ii * 72 + cidx] = f2bf((cidx <= ii) ? acc[r] * __expf(fminf(sc[64 + ii] - Gc, 0.f)) : 0.f); }
                    }
                } else if (which == 1) {
#pragma unroll
                    for (int r = 0; r < 4; ++r) aqk[(mi * 16 + quad * 4 + r) * 72 + ni * 16 + r16] = 0;
                }
            }
        }
        lds_barrier();
        {
            const int a = tid & 127, tq = tid >> 7;
#pragma unroll
            for (int q = 0; q < 2; ++q) { const int t0 = tq * 16 + q * 8; float v[8];
#pragma unroll
                for (int e = 0; e < 8; ++e) v[e] = bf2f(kb[(t0 + e) * 136 + a]);
                u32x4 w; w.x = cvt_pk_bf16(v[0], v[1]); w.y = cvt_pk_bf16(v[2], v[3]); w.z = cvt_pk_bf16(v[4], v[5]); w.w = cvt_pk_bf16(v[6], v[7]);
                *(u32x4*)(kbT + a * 72 + t0) = w;
#pragma unroll
                for (int e = 0; e < 8; ++e) v[e] *= sc[192 + t0 + e];
                w.x = cvt_pk_bf16(v[0], v[1]); w.y = cvt_pk_bf16(v[2], v[3]); w.z = cvt_pk_bf16(v[4], v[5]); w.w = cvt_pk_bf16(v[6], v[7]);
                *(u32x4*)(kdT + a * 72 + t0) = w; }
        }
        if (wave == 0) {
            const float* Lrow = Ld + quad * 320;
            float x[16];
#pragma unroll
            for (int i = 0; i < 16; ++i) { float s = (i == r16) ? 1.f : 0.f;
#pragma unroll
                for (int j = 0; j < i; ++j) s -= Lrow[i * 20 + j] * x[j];
                x[i] = s; }
#pragma unroll
            for (int i = 0; i < 16; ++i) Ti[(16 * quad + i) * 72 + 16 * quad + r16] = f2bf(x[i]);
            { u32x4 w0, w1; w0.x = cvt_pk_bf16(x[0], x[1]); w0.y = cvt_pk_bf16(x[2], x[3]); w0.z = cvt_pk_bf16(x[4], x[5]); w0.w = cvt_pk_bf16(x[6], x[7]);
              w1.x = cvt_pk_bf16(x[8], x[9]); w1.y = cvt_pk_bf16(x[10], x[11]); w1.z = cvt_pk_bf16(x[12], x[13]); w1.w = cvt_pk_bf16(x[14], x[15]);
              *(u32x4*)(TT + (16 * quad + r16) * 72 + 16 * quad) = w0; *(u32x4*)(TT + (16 * quad + r16) * 72 + 16 * quad + 8) = w1; }
            asm volatile("s_waitcnt lgkmcnt(0)" ::: "memory");
            tinv_block<1, 0>(Lb, Ti, TT, XT, r16, quad); tinv_block<2, 1>(Lb, Ti, TT, XT, r16, quad); tinv_block<3, 2>(Lb, Ti, TT, XT, r16, quad);
            tinv_block<2, 0>(Lb, Ti, TT, XT, r16, quad); tinv_block<3, 1>(Lb, Ti, TT, XT, r16, quad);
            tinv_block<3, 0>(Lb, Ti, TT, XT, r16, quad);
        }
        lds_barrier();
        {
            const int i = tid >> 3, t0 = (tid & 7) * 8; const bool low = (t0 >> 4) <= (i >> 4);
            const u32x4 raw = *(const u32x4*)(Ti + i * 72 + t0);
            float v[8] = {bflo(raw.x), bfhi(raw.x), bflo(raw.y), bfhi(raw.y), bflo(raw.z), bfhi(raw.z), bflo(raw.w), bfhi(raw.w)}; float tw[8], tu[8];
#pragma unroll
            for (int e = 0; e < 8; ++e) { const float be = sc[t0 + e]; tu[e] = low ? v[e] * be : 0.f; tw[e] = low ? v[e] * be * sc[128 + t0 + e] : 0.f; }
            u32x4 w; w.x = cvt_pk_bf16(tw[0], tw[1]); w.y = cvt_pk_bf16(tw[2], tw[3]); w.z = cvt_pk_bf16(tw[4], tw[5]); w.w = cvt_pk_bf16(tw[6], tw[7]);
            u32x4 u; u.x = cvt_pk_bf16(tu[0], tu[1]); u.y = cvt_pk_bf16(tu[2], tu[3]); u.z = cvt_pk_bf16(tu[4], tu[5]); u.w = cvt_pk_bf16(tu[6], tu[7]);
            *(u32x4*)(Ti + i * 72 + t0) = w; *(u32x4*)(TT + i * 72 + t0) = u;
        }
        lds_barrier();
#pragma unroll
        for (int pass = 0; pass < 2; ++pass) {
            const bf16_t* Aop = pass ? TT : Ti; const bf16_t* Bop = pass ? vbT : kbT; bf16_t* outT = pass ? uT : wT;
            f32x4 acc4[4];
#pragma unroll
            for (int mi = 0; mi < 4; ++mi) { f32x4 acc = {0.f, 0.f, 0.f, 0.f};
#pragma unroll
                for (int ks = 0; ks < 2; ++ks) acc = MFMA16(*(const bf16x8*)(Aop + (mi * 16 + r16) * 72 + ks * 32 + quad * 8), *(const bf16x8*)(Bop + (wave * 16 + r16) * 72 + ks * 32 + quad * 8), acc);
                acc4[mi] = acc; }
            if (pass == 1) lds_barrier();
#pragma unroll
            for (int mi = 0; mi < 4; ++mi) { u32x2 w; w.x = cvt_pk_bf16(acc4[mi][0], acc4[mi][1]); w.y = cvt_pk_bf16(acc4[mi][2], acc4[mi][3]); *(u32x2*)(outT + (wave * 16 + r16) * 72 + mi * 16 + quad * 4) = w; }
        }
        lds_barrier();
        {
#pragma unroll
            for (int i = 0; i < 24; ++i) {
                const int prod = (i < 8) ? 0 : (i < 16) ? 1 : (i < 20) ? 2 : 3;
                const int mi = (i < 8) ? i : (i < 16) ? (i - 8) : (i < 20) ? (i - 16) : (i - 20), ni = wave;
                const bf16_t* X = ((prod < 2) ? kdT : aqk) + (mi * 16 + r16) * 72 + quad * 8;
                const bf16_t* Y = ((prod & 1) ? uT : wT) + (ni * 16 + r16) * 72 + quad * 8;
                f32x4 acc = {0.f, 0.f, 0.f, 0.f};
                if (prod == 1) {
#pragma unroll
                    for (int ks = 0; ks < 2; ++ks) acc = MFMA16(*(const bf16x8*)(X + ks * 32), *(const bf16x8*)(Y + ks * 32), acc);
                    u32x2 w; w.x = cvt_pk_bf16(acc[0], acc[1]); w.y = cvt_pk_bf16(acc[2], acc[3]);
                    *(u32x2*)(Bg + (size_t)ci * 16384 + (ni * 16 + r16) * 128 + mi * 16 + quad * 4) = w;
                    continue;
                }
#pragma unroll
                for (int ks = 0; ks < 2; ++ks) acc = MFMA16(*(const bf16x8*)(Y + ks * 32), *(const bf16x8*)(X + ks * 32), acc);
                const int m = mi * 16 + r16, n0 = ni * 16 + quad * 4;
                if (prod == 0) acc = -acc;
                if (prod == 2) { const u32x2 qv = *(const u32x2*)(qb + m * 136 + n0); const float eg = sc[128 + m];
                    acc[0] = bflo(qv.x) * eg - acc[0]; acc[1] = bfhi(qv.x) * eg - acc[1]; acc[2] = bflo(qv.y) * eg - acc[2]; acc[3] = bfhi(qv.y) * eg - acc[3]; }
                bf16_t* outp = ((prod == 0) ? (Ag + (size_t)ci * 16384) : (prod == 2) ? (Qg + (size_t)ci * 8192) : (Og + (size_t)ci * 8192)) + m * 128 + n0;
                u32x2 w; w.x = cvt_pk_bf16(acc[0], acc[1]); w.y = cvt_pk_bf16(acc[2], acc[3]); *(u32x2*)outp = w;
            }
        }
        lds_barrier();
    }
}

DI void ph_gdn_p2(PK p, unsigned char* lds, const int wv) {
    PK_FRESH(p);
    const int tid = ltid(wv), lane = tid & 63, wave = __builtin_amdgcn_readfirstlane(tid >> 6), r16 = lane & 15, quad = lane >> 4, a0 = wave * 16;
    const bf16_t* Ag = WSP(const bf16_t, WS_GA); const bf16_t* Bg = WSP(const bf16_t, WS_GB); bf16_t* Sg = WSP(bf16_t, WS_GS); const float* glg = WSP(const float, WS_GL);
    bf16_t* ST = (bf16_t*)lds;
#define P2_LOAD(AF, BM, GL, cidx) do { const size_t c_ = (cidx); _Pragma("unroll") for (int ks = 0; ks < 4; ++ks) AF[ks] = *(const bf16x8*)(Ag + c_ * 16384 + (size_t)(a0 + r16) * 128 + ks * 32 + quad * 8); \
        BM = *(const u32x2*)(Bg + c_ * 16384 + (size_t)(v0 + r16) * 128 + a0 + quad * 4); GL = glg[c_]; } while (0)
    for (int item = blockIdx.x; item < 256; item += gridDim.x) {
        const int bh = (item & 7) * 4 + (item >> 6), v0 = ((item >> 3) & 7) * 16;
        const size_t cb = (size_t)bh * 128;
        f32x4 S = {0.f, 0.f, 0.f, 0.f};
        bf16x8 afA[4], afB[4], afC[4], afD[4]; u32x2 bmA, bmB, bmC, bmD; float glA, glB, glC, glD;
        P2_LOAD(afA, bmA, glA, cb); P2_LOAD(afB, bmB, glB, cb + 1); P2_LOAD(afC, bmC, glC, cb + 2);
#define P2_STEP(AFc, BMc, GLc, AFp, BMp, GLp, nn) do { const int n_ = (nn); const size_t ci = cb + n_; \
            P2_LOAD(AFp, BMp, GLp, cb + ((n_ + 3 < 128) ? n_ + 3 : 127));        \
            u32x2 sp; sp.x = cvt_pk_bf16(S[0], S[1]); sp.y = cvt_pk_bf16(S[2], S[3]); \
            bf16_t* STb = ST + (n_ & 1) * (16 * 136); \
            *(u32x2*)(STb + r16 * 136 + a0 + quad * 4) = sp; \
            *(u32x2*)(Sg + ci * 16384 + (size_t)(v0 + r16) * 128 + a0 + quad * 4) = sp; \
            lds_barrier(); \
            f32x4 acc; acc[0] = GLc * S[0] + bflo(BMc.x); acc[1] = GLc * S[1] + bfhi(BMc.x); acc[2] = GLc * S[2] + bflo(BMc.y); acc[3] = GLc * S[3] + bfhi(BMc.y); \
            bf16x8 bfr_[4]; _Pragma("unroll") for (int ks = 0; ks < 4; ++ks) bfr_[ks] = *(const bf16x8*)(STb + r16 * 136 + ks * 32 + quad * 8);        \
            _Pragma("unroll") for (int ks = 0; ks < 4; ++ks) acc = MFMA16(AFc[ks], bfr_[ks], acc); \
            S = acc; } while (0)
        for (int n = 0; n < 128; n += 4) {
            P2_STEP(afA, bmA, glA, afD, bmD, glD, n);
            P2_STEP(afB, bmB, glB, afA, bmA, glA, n + 1);
            P2_STEP(afC, bmC, glC, afB, bmB, glB, n + 2);
            P2_STEP(afD, bmD, glD, afC, bmC, glC, n + 3);
        }
#undef P2_STEP
        lds_barrier();
    }
#undef P2_LOAD
}

DI void ph_gdn_p3(PK p, int l, const int wv) {
    PK_FRESH(p);
    const int tid = ltid(wv), lane = tid & 63, wave = __builtin_amdgcn_readfirstlane(tid >> 6), r16 = lane & 15, quad = lane >> 4;
    const bf16_t* Qg = WSP(const bf16_t, WS_GQ); const bf16_t* Og = WSP(const bf16_t, WS_GO); const bf16_t* Sg = WSP(const bf16_t, WS_GS);
    const bf16_t* proj = WSP(const bf16_t, WS_PROJ); bf16_t* obuf = WSP(bf16_t, WS_OBUF); const float* ogain = p->in[11] + l * 128;
    for (int it = blockIdx.x; it < 2048; it += gridDim.x) {
        const int ci = it * 2 + (wave >> 2), mi = wave & 3;
        const int n = ci & 127, bh = ci >> 7, hd = bh & 15, b = bh >> 4;
        const int i = mi * 16 + r16; const size_t tok = (size_t)b * SEQ + n * 64 + i;
        bf16x8 qa[4], sf[4][8]; u32x2 ov[8], zv[8];
#pragma unroll
        for (int ks = 0; ks < 4; ++ks) { qa[ks] = *(const bf16x8*)(Qg + (size_t)ci * 8192 + i * 128 + ks * 32 + quad * 8);
#pragma unroll
            for (int ni = 0; ni < 8; ++ni) sf[ks][ni] = *(const bf16x8*)(Sg + (size_t)ci * 16384 + (ni * 16 + r16) * 128 + ks * 32 + quad * 8); }
#pragma unroll
        for (int ni = 0; ni < 8; ++ni) { ov[ni] = *(const u32x2*)(Og + (size_t)ci * 8192 + i * 128 + ni * 16 + quad * 4); zv[ni] = *(const u32x2*)(proj + tok * GINP + 6144 + hd * 128 + ni * 16 + quad * 4); }
        f32x4 acc[8];
#pragma unroll
        for (int ni = 0; ni < 8; ++ni) acc[ni] = (f32x4){0.f, 0.f, 0.f, 0.f};
#pragma unroll
        for (int ks = 0; ks < 4; ++ks)
#pragma unroll
            for (int ni = 0; ni < 8; ++ni) acc[ni] = MFMA16(sf[ks][ni], qa[ks], acc[ni]);
        float ss = 0.f;
#pragma unroll
        for (int ni = 0; ni < 8; ++ni) {
            acc[ni][0] += bflo(ov[ni].x); acc[ni][1] += bfhi(ov[ni].x); acc[ni][2] += bflo(ov[ni].y); acc[ni][3] += bfhi(ov[ni].y);
            ss += acc[ni][0] * acc[ni][0] + acc[ni][1] * acc[ni][1] + acc[ni][2] * acc[ni][2] + acc[ni][3] * acc[ni][3]; }
        ss += sw_xor<16>(ss); ss = sw_xor32_sum(ss);
        const float rms = rsqrtf(ss * (1.f / 128.f) + NORM_EPS);
#pragma unroll
        for (int ni = 0; ni < 8; ++ni) { const int v = ni * 16 + quad * 4; const f32x4 gv = *(const f32x4*)(ogain + v);
            const float y0 = acc[ni][0] * rms * gv[0] * silu_f(bflo(zv[ni].x)), y1 = acc[ni][1] * rms * gv[1] * silu_f(bfhi(zv[ni].x));
            const float y2 = acc[ni][2] * rms * gv[2] * silu_f(bflo(zv[ni].y)), y3 = acc[ni][3] * rms * gv[3] * silu_f(bfhi(zv[ni].y));
            u32x2 w; w.x = cvt_pk_bf16(y0, y1); w.y = cvt_pk_bf16(y2, y3); *(u32x2*)(obuf + tok * D + hd * 128 + v) = w; }
    }
}

DI void ph_rope(PK p, const bf16_t* src, int ld, bf16_t* dst, const int wv) {
    PK_FRESH(p);
    const int tid = ltid(wv); const float* cosT = WSP(const float, WS_COS); const float* sinT = WSP(const float, WS_SIN);
    for (int idx = blockIdx.x * 512 + tid; idx < T * 128; idx += gridDim.x * 512) {
        const int jc = idx & 7, hc = (idx >> 3) & 15, t = idx >> 7;
        const bf16_t* sp = src + (size_t)t * ld + hc * 128 + jc * 8;
        const u32x4 x1 = *(const u32x4*)sp, x2 = *(const u32x4*)(sp + 64);
        const f32x4 c0 = *(const f32x4*)(cosT + t * 64 + jc * 8), c1 = *(const f32x4*)(cosT + t * 64 + jc * 8 + 4);
        const f32x4 s0 = *(const f32x4*)(sinT + t * 64 + jc * 8), s1 = *(const f32x4*)(sinT + t * 64 + jc * 8 + 4);
        float a[8] = {bflo(x1.x), bfhi(x1.x), bflo(x1.y), bfhi(x1.y), bflo(x1.z), bfhi(x1.z), bflo(x1.w), bfhi(x1.w)};
        float bb[8] = {bflo(x2.x), bfhi(x2.x), bflo(x2.y), bfhi(x2.y), bflo(x2.z), bfhi(x2.z), bflo(x2.w), bfhi(x2.w)};
        float cs[8] = {c0[0], c0[1], c0[2], c0[3], c1[0], c1[1], c1[2], c1[3]}, sn[8] = {s0[0], s0[1], s0[2], s0[3], s1[0], s1[1], s1[2], s1[3]};
        float o1[8], o2[8];
#pragma unroll
        for (int e = 0; e < 8; ++e) { o1[e] = a[e] * cs[e] - bb[e] * sn[e]; o2[e] = bb[e] * cs[e] + a[e] * sn[e]; }
        const int b = t >> 13, s = t & 8191;
        bf16_t* dp = dst + ((size_t)(b * 16 + hc) * SEQ + s) * 128 + jc * 8;
        u32x4 w1, w2;
        w1.x = cvt_pk_bf16(o1[0], o1[1]); w1.y = cvt_pk_bf16(o1[2], o1[3]); w1.z = cvt_pk_bf16(o1[4], o1[5]); w1.w = cvt_pk_bf16(o1[6], o1[7]);
        w2.x = cvt_pk_bf16(o2[0], o2[1]); w2.y = cvt_pk_bf16(o2[2], o2[3]); w2.z = cvt_pk_bf16(o2[4], o2[5]); w2.w = cvt_pk_bf16(o2[6], o2[7]);
        *(u32x4*)dp = w1; *(u32x4*)(dp + 64) = w2;
    }
}
DI void ph_vrelayout(const bf16_t* src, bf16_t* dst, const int wv) {
    const int tid = ltid(wv);
    for (int idx = blockIdx.x * 512 + tid; idx < T * 256; idx += gridDim.x * 512) {
        const int ch = idx & 15, hc = (idx >> 4) & 15, t = idx >> 8; const int b = t >> 13, s = t & 8191;
        *(u32x4*)(dst + ((size_t)(b * 16 + hc) * SEQ + s) * 128 + ch * 8) = *(const u32x4*)(src + (size_t)t * 4096 + 2048 + hc * 128 + ch * 8);
    }
}

DI void ph_attn(PK p, unsigned char* lds, const int wv) {
    PK_FRESH(p);
    using att::bf16;
    const bf16* Qd = WSP(const bf16, WS_QD); const bf16* Ksh = WSP(const bf16, WS_KSH); const bf16* Vsh = WSP(const bf16, WS_VSH); bf16* Oat = WSP(bf16, WS_OAT);
    const int total = 64 * 16, stride = gridDim.x, W = SEQ;
    int L = blockIdx.x;
    if (L < total) {
        auto mkref = [&](int Li, int pass) {
            const int xcd = Li & 7, jk = Li >> 3, mm = (jk & 127) >> 4, x = jk & 15, h64 = xcd * 8 + mm, qb = pass ? (31 - x) : x;
            const int vh = h64 & 1, c = (h64 >> 1) & 1, bh = h64 >> 2;
            att::BlockRef<bf16, bf16> r;
            r.Q = Qd + ((size_t)(bh * 2 + c) * SEQ + (size_t)qb * 256) * 128;
            r.K = Ksh + (size_t)(bh * 2 + c) * SEQ * 128;
            r.V = Vsh + (size_t)(bh * 2 + vh) * SEQ * 128;
            r.O = Oat + ((size_t)((bh * 2 + c) * 2 + vh) * SEQ + (size_t)qb * 256) * 128;
            r.P0 = qb * 256; return r; };
        int pass = 0;
        att::BlockRef<bf16, bf16> cur = mkref(L, 0);
        att::Seam<bf16> S;
        att::causal_swa_prime<bf16, bf16>(cur, W, (char*)lds, S, wv);
        for (;;) {
            const bool more_pass = pass == 0, more_item = L + stride < total, last = !more_pass && !more_item;
            int passn = pass + 1, Ln = L;
            if (!more_pass) { passn = 0; Ln = more_item ? L + stride : L; }
            const att::BlockRef<bf16, bf16> nxt = last ? cur : mkref(Ln, passn);
            att::causal_swa_block<bf16, bf16>(cur, nxt, SEQ, W, (char*)lds, S, wv);
            if (last) break;
            cur = nxt; pass = passn; L = Ln;
        }
    }
    __syncthreads();
}

DI void ph_diff_combine(PK p, int j, int l, unsigned char* lds, const int wv) {
    PK_FRESH(p);
    const int tid = ltid(wv), lane = tid & 63, wave = __builtin_amdgcn_readfirstlane(tid >> 6);
    float* ldsf = (float*)lds;
    const float lambda_init = 0.8f - 0.6f * expf(-0.3f * (float)l);
    if (wave == 0) { const float* lp = p->in[18] + j * 512;
        float a = lp[lane] * lp[128 + lane] + lp[64 + lane] * lp[192 + lane], bsum = lp[256 + lane] * lp[384 + lane] + lp[320 + lane] * lp[448 + lane];
        a = wave_sum(a); bsum = wave_sum(bsum);
        if (lane == 0) ldsf[0] = expf(a) - expf(bsum) + lambda_init; }
    __syncthreads();
    const float lam = ldsf[0], om = 1.f - lambda_init;
    const bf16_t* Oat = WSP(const bf16_t, WS_OAT); bf16_t* obuf = WSP(bf16_t, WS_OBUF); const float* sg = p->in[19] + j * 256;
    for (int row = blockIdx.x * 8 + wave; row < T * 8; row += gridDim.x * 8) {
        const int t = row >> 3, h = row & 7, b = t >> 13, s = t & 8191, vh = lane >> 5, d = (lane & 31) * 4;
        const u32x2 o1 = *(const u32x2*)(Oat + ((size_t)(((b * 8 + h) * 2 + 0) * 2 + vh) * SEQ + s) * 128 + d);
        const u32x2 o2 = *(const u32x2*)(Oat + ((size_t)(((b * 8 + h) * 2 + 1) * 2 + vh) * SEQ + s) * 128 + d);
        float v[4] = {bflo(o1.x) - lam * bflo(o2.x), bfhi(o1.x) - lam * bfhi(o2.x), bflo(o1.y) - lam * bflo(o2.y), bfhi(o1.y) - lam * bfhi(o2.y)};
        float ss = v[0] * v[0] + v[1] * v[1] + v[2] * v[2] + v[3] * v[3];
        ss = wave_sum(ss);
        const float rms = rsqrtf(ss * (1.f / 256.f) + NORM_EPS) * om;
        const f32x4 gv = *(const f32x4*)(sg + vh * 128 + d);
        u32x2 w; w.x = cvt_pk_bf16(v[0] * rms * gv[0], v[1] * rms * gv[1]); w.y = cvt_pk_bf16(v[2] * rms * gv[2], v[3] * rms * gv[3]);
        *(u32x2*)(obuf + (size_t)t * D + h * 256 + vh * 128 + d) = w;
    }
    __syncthreads();
}

#define INS16(Lr, vv) do { _Pragma("unroll") for (int k_ = 0; k_ < 16; ++k_) { const float hi_ = fmaxf(Lr[k_], vv); vv = fminf(Lr[k_], vv); Lr[k_] = hi_; } } while (0)
DI void sort16_desc(float (&L)[16]) {
#pragma unroll
    for (int k = 2; k <= 16; k <<= 1)
#pragma unroll
        for (int j = k >> 1; j >= 1; j >>= 1)
#pragma unroll
            for (int i = 0; i < 16; ++i) { const int l = i ^ j;
                if (l > i) { const float hi_ = fmaxf(L[i], L[l]), lo_ = fminf(L[i], L[l]); const bool desc = (i & k) == 0; L[i] = desc ? hi_ : lo_; L[l] = desc ? lo_ : hi_; } }
}
template <int XM> DI void merge16(float (&L)[16]) {
    float P[16];
#pragma unroll
    for (int i = 0; i < 16; ++i) P[i] = sw_xor<XM>(L[15 - i]);
#pragma unroll
    for (int i = 0; i < 16; ++i) L[i] = fmaxf(L[i], P[i]);
#pragma unroll
    for (int s = 8; s >= 1; s >>= 1)
#pragma unroll
        for (int i = 0; i < 16; ++i) if ((i & s) == 0) { const float hi_ = fmaxf(L[i], L[i + s]), lo_ = fminf(L[i], L[i + s]); L[i] = hi_; L[i + s] = lo_; }
}
__constant__ unsigned kStairPk[16] = {0x20100800u, 0xffe07033u, 0x21110901u, 0xfff07140u, 0x22120a02u, 0xffff8041u, 0x23130b03u, 0xffff9042u, 0x24140c04u, 0xffffa050u, 0x30150d05u, 0xffffb051u, 0x31160e06u, 0xffffc060u, 0x32170f07u, 0xffffd061u};
DI void ph_peer_topk(PK p, int l, unsigned char* lds, const int wv) {
    PK_FRESH(p);
    const int tid = ltid(wv);
    float* tops = (float*)lds; float* fin = tops + 64 * 2 * 16;
    const bf16_t* pq = WSP(const bf16_t, WS_PQ);
    int* pidx = WSP(int, WS_PIDX); float* pgate = WSP(float, WS_PGATE);
    const float NEG = -__builtin_inff();
    const int rowl = tid >> 3, half = (tid >> 2) & 1, quarter = tid & 3, l8 = tid & 7;
    const int nitems = T * 8 / 64;
    const int lane = tid & 63, wave = __builtin_amdgcn_readfirstlane(tid >> 6);
    int crow = blockIdx.x * 8 + wave; const int cstep = gridDim.x * 8;
    const u32x2 stw = *(const u32x2*)(kStairPk + l8 * 2);
    u32x4 wn[4];
    if ((int)blockIdx.x < nitems) { const int row = blockIdx.x * 64 + rowl; const bf16_t* sp = pq + (size_t)(row >> 3) * 2048 + (row & 7) * 256 + half * 128 + quarter * 32;
#pragma unroll
        for (int c = 0; c < 4; ++c) wn[c] = *(const u32x4*)(sp + c * 8); }
    for (int item = blockIdx.x; item < nitems; item += gridDim.x) {
        const int row0 = item * 64;
        u32x4 wc[4];
#pragma unroll
        for (int c = 0; c < 4; ++c) wc[c] = wn[c];
        { const int itn = (item + (int)gridDim.x < nitems) ? item + (int)gridDim.x : item; const int row = itn * 64 + rowl;
          const bf16_t* sp = pq + (size_t)(row >> 3) * 2048 + (row & 7) * 256 + half * 128 + quarter * 32;
#pragma unroll
          for (int c = 0; c < 4; ++c) wn[c] = *(const u32x4*)(sp + c * 8); }
        f32x4 cv[8]; const bool cA = crow < 2 * 16384; if (cA) pc_load(p, l, crow, cv, lane);
        float Lr[16], Lq[16];
#pragma unroll
        for (int c = 0; c < 4; ++c)
#pragma unroll
            for (int e = 0; e < 4; ++e) { const unsigned w = wc[c][e];
                const float v0 = __uint_as_float((w << 16) | (unsigned)(quarter * 32 + c * 8 + e * 2)), v1 = __uint_as_float((w & 0xffff0000u) | (unsigned)(quarter * 32 + c * 8 + e * 2 + 1));
                if (c < 2) { Lr[c * 8 + e * 2] = v0; Lr[c * 8 + e * 2 + 1] = v1; } else { Lq[(c - 2) * 8 + e * 2] = v0; Lq[(c - 2) * 8 + e * 2 + 1] = v1; } }
        sort16_desc(Lr); sort16_desc(Lq);
#pragma unroll
        for (int i = 0; i < 16; ++i) Lr[i] = fmaxf(Lr[i], Lq[15 - i]);
#pragma unroll
        for (int s = 8; s >= 1; s >>= 1)
#pragma unroll
            for (int i = 0; i < 16; ++i) if ((i & s) == 0) { const float hi_ = fmaxf(Lr[i], Lr[i + s]), lo_ = fminf(Lr[i], Lr[i + s]); Lr[i] = hi_; Lr[i + s] = lo_; }
        if (cA) { pc_store(p, crow, cv, lane); crow += cstep; }
        const bool cB = crow < 2 * 16384; if (cB) pc_load(p, l, crow, cv, lane);
        merge16<1>(Lr); merge16<2>(Lr);
        if (quarter == 0) {
#pragma unroll
            for (int k = 0; k < 16; ++k) tops[(rowl * 2 + half) * 16 + k] = Lr[k];
        }
        asm volatile("s_waitcnt lgkmcnt(0)" ::: "memory");
        float M[16];
#pragma unroll
        for (int k = 0; k < 16; ++k) M[k] = NEG;
        {
            const float* ta = tops + (rowl * 2) * 16; const float* tb = ta + 16;
#pragma unroll
            for (int m = 0; m < 7; ++m) { const unsigned code = (((m < 4) ? stw.x : stw.y) >> (8 * (m & 3))) & 255u;
                float s = (code < 255u) ? ta[code >> 4] + tb[code & 15u] : NEG;
                s = (code < 255u) ? __uint_as_float((__float_as_uint(s) & ~255u) | code) : NEG; INS16(M, s); }
        }
        merge16<1>(M); merge16<2>(M); merge16<4>(M);
        float sum = 0.f;
#pragma unroll
        for (int k = 0; k < 16; ++k) sum += __expf(M[k] - M[0]);
        if (l8 == 0) {
#pragma unroll
            for (int k = 0; k < 16; ++k) fin[rowl * 16 + k] = M[k];
        }
        asm volatile("s_waitcnt lgkmcnt(0)" ::: "memory");
        {
            const float inv = 1.f / sum, m0 = M[0]; const int row = row0 + rowl; const size_t ob = (size_t)(row >> 3) * 128 + (row & 7) * 16;
#pragma unroll
            for (int u = 0; u < 2; ++u) { const int k = l8 * 2 + u; const float mk = fin[rowl * 16 + k]; const unsigned code = __float_as_uint(mk) & 255u;
                const unsigned i1 = __float_as_uint(tops[(rowl * 2) * 16 + (code >> 4)]) & 127u, i2 = __float_as_uint(tops[(rowl * 2 + 1) * 16 + (code & 15u)]) & 127u;
                pidx[ob + k] = (int)(i1 * 128u + i2); pgate[ob + k] = __expf(mk - m0) * inv; }
        }
        if (cB) { pc_store(p, crow, cv, lane); crow += cstep; }
        asm volatile("s_waitcnt lgkmcnt(0)" ::: "memory");
    }
    for (; crow < 2 * 16384; crow += cstep) { f32x4 cv[8]; pc_load(p, l, crow, cv, lane); pc_store(p, crow, cv, lane); }
}

DI float gelu_f(float v) {
    const float av = fabsf(v), t = __builtin_amdgcn_rcpf(fmaf(av, 0.2316418882f, 1.0f));
    float q = fmaf(t, 0.5307027145f, -0.7265760135f); q = fmaf(q, t, 0.7107068705f); q = fmaf(q, t, -0.142248368f); q = fmaf(q, t, 0.127414796f); q = q * t;
    const float e = __builtin_amdgcn_exp2f(v * v * -0.72134752044f), m = v * (q * e);
    return v < 0.f ? m : v - m;
}
#define FP4X8(w, o) const f32x2 o##0 = __builtin_amdgcn_cvt_scalef32_pk_f32_fp4(w, 1.0f, 0), o##1 = __builtin_amdgcn_cvt_scalef32_pk_f32_fp4(w, 1.0f, 1), \
                                o##2 = __builtin_amdgcn_cvt_scalef32_pk_f32_fp4(w, 1.0f, 2), o##3 = __builtin_amdgcn_cvt_scalef32_pk_f32_fp4(w, 1.0f, 3)
DI void ph_peer_gather(PK p, int l, unsigned char* lds, const int wv, const bool apply = true) {
    PK_FRESH(p);
    const int tid = ltid(wv), lane = tid & 63, wave = __builtin_amdgcn_readfirstlane(tid >> 6);
    const bf16_t* hb = WSP(const bf16_t, WS_HBUF); const unsigned char* ub = WSP(const unsigned char, WS_PU); const unsigned char* vb = WSP(const unsigned char, WS_PV);
    const unsigned char* psc8 = WSP(const unsigned char, WS_PUS);
    const int* pidx = WSP(const int, WS_PIDX); const float* pgate = WSP(const float, WS_PGATE); bf16_t* xc = WSP(bf16_t, WS_XCUR);
    const float* gt2 = WSP(const float, WS_MOD) + l * 12288 + 5 * 2048;
    const unsigned l16 = (unsigned)lane * 16u, l2 = (unsigned)(lane >> 2) * 4u;
    for (int tok = blockIdx.x * 8 + wave; tok < T; tok += gridDim.x * 8) {
        f32x2 hf2[16];
#pragma unroll
        for (int c = 0; c < 4; ++c) { const u32x4 w = *(const u32x4*)(hb + (size_t)tok * D + lane * 32 + c * 8);
            hf2[c * 4 + 0] = (f32x2){bflo(w.x), bfhi(w.x)}; hf2[c * 4 + 1] = (f32x2){bflo(w.y), bfhi(w.y)}; hf2[c * 4 + 2] = (f32x2){bflo(w.z), bfhi(w.z)}; hf2[c * 4 + 3] = (f32x2){bflo(w.w), bfhi(w.w)}; }
        f32x2 acc2[16];
#pragma unroll
        for (int i = 0; i < 16; ++i) acc2[i] = (f32x2){0.f, 0.f};
        u32x2* sraw = (u32x2*)(lds + wave * 2048); u32x2* ssrt = sraw + 128;
        {
            const unsigned k0 = (unsigned)pidx[(size_t)tok * 128 + lane], k1 = (unsigned)pidx[(size_t)tok * 128 + 64 + lane];
            const float g0 = pgate[(size_t)tok * 128 + lane], g1 = pgate[(size_t)tok * 128 + 64 + lane];
            sraw[lane] = (u32x2){k0, __float_as_uint(g0)}; sraw[64 + lane] = (u32x2){k1, __float_as_uint(g1)};
            asm volatile("s_waitcnt lgkmcnt(0)" ::: "memory");
            const unsigned key0 = k0 * 128u + (unsigned)lane, key1 = k1 * 128u + 64u + (unsigned)lane; unsigned r0 = 0, r1 = 0;
            for (int j = 0; j < 128; ++j) { const unsigned kj = sraw[j].x * 128u + (unsigned)j; r0 += (kj < key0) ? 1u : 0u; r1 += (kj < key1) ? 1u : 0u; }
            ssrt[r0] = (u32x2){k0, __float_as_uint(g0)}; ssrt[r1] = (u32x2){k1, __float_as_uint(g1)};
            asm volatile("s_waitcnt lgkmcnt(0)" ::: "memory");
        }
#define G_LOAD(gi, UR, VR, US, GT) do { _Pragma("unroll") for (int q = 0; q < 4; ++q) { const u32x2 pr = ssrt[(gi) * 4 + q]; const unsigned e_ = (unsigned)__builtin_amdgcn_readfirstlane((int)pr.x); GT[q] = __uint_as_float(pr.y); \
            UR[q] = *(const u32x4*)(ub + (size_t)e_ * 1024 + l16); US[q] = *(const unsigned*)(psc8 + (size_t)e_ * 64 + l2); \
            VR[q] = *(const u32x4*)(vb + (size_t)e_ * 1024 + l16); } } while (0)
#define G_COMP(UR, VR, US, GT) do { float cf[4]; \
            _Pragma("unroll") for (int q = 0; q < 4; ++q) { f32x2 t2 = {0.f, 0.f}, t3 = {0.f, 0.f}; \
                _Pragma("unroll") for (int c = 0; c < 4; ++c) { FP4X8(UR[q][c], a); \
                    t2 = a0 * hf2[c * 4 + 0] + t2; t3 = a1 * hf2[c * 4 + 1] + t3; t2 = a2 * hf2[c * 4 + 2] + t2; t3 = a3 * hf2[c * 4 + 3] + t3; } \
                t2 = t2 + t3; \
                cf[q] = wave_sum_dpp((t2.x + t2.y) * __uint_as_float(US[q] << 16)); } \
            { float xg_ = 0.f;        \
              _Pragma("unroll") for (int q = 0; q < 4; ++q) asm("v_writelane_b32 %0, %1, %2" : "+v"(xg_) : "s"(cf[q]), "n"(q)); \
              const float yg_ = gelu_f(xg_); \
              _Pragma("unroll") for (int q = 0; q < 4; ++q) cf[q] = GT[q] * __int_as_float(__builtin_amdgcn_readlane(__float_as_int(yg_), q)); } \
            _Pragma("unroll") for (int q = 0; q < 4; ++q) { const float cs = cf[q] * __uint_as_float(US[q] & 0xffff0000u); const f32x2 cs2 = {cs, cs}; \
                _Pragma("unroll") for (int c = 0; c < 4; ++c) { FP4X8(VR[q][c], b); \
                    acc2[c * 4 + 0] = cs2 * b0 + acc2[c * 4 + 0]; acc2[c * 4 + 1] = cs2 * b1 + acc2[c * 4 + 1]; acc2[c * 4 + 2] = cs2 * b2 + acc2[c * 4 + 2]; acc2[c * 4 + 3] = cs2 * b3 + acc2[c * 4 + 3]; } } } while (0)
        {
            u32x4 urA[4], vrA[4], urB[4], vrB[4]; unsigned usA[4], usB[4]; float gtA[4], gtB[4];
            G_LOAD(0, urA, vrA, usA, gtA);
            for (int g = 0; g < 32; g += 2) {
                G_LOAD(g + 1, urB, vrB, usB, gtB);
                G_COMP(urA, vrA, usA, gtA);
                G_LOAD((g + 2 < 32) ? g + 2 : 31, urA, vrA, usA, gtA);
                G_COMP(urB, vrB, usB, gtB);
            }
        }
#undef G_LOAD
#undef G_COMP
        float acc[32];
#pragma unroll
        for (int i = 0; i < 16; ++i) { acc[2 * i] = acc2[i].x; acc[2 * i + 1] = acc2[i].y; }
        if (!apply) { if (p->ph_hi == -12345) { for (int i = 0; i < 32; ++i) xc[i * 64 + lane] = f2bf(acc[i]); } continue; }
        const int b = tok >> 13; const float gm = ((MK_SKIP >> (2 * l + 1)) & 1) ? 0.f : 1.f;
        float ss = 0.f;
#pragma unroll
        for (int c = 0; c < 4; ++c) { const int col = lane * 32 + c * 8; bf16_t* xp = xc + (size_t)tok * D + col;
            const u32x4 xb = *(const u32x4*)xp; const f32x4 g0 = *(const f32x4*)(gt2 + (size_t)b * MODC + col), g1 = *(const f32x4*)(gt2 + (size_t)b * MODC + col + 4);
            const float x8[8] = {bflo(xb.x), bfhi(xb.x), bflo(xb.y), bfhi(xb.y), bflo(xb.z), bfhi(xb.z), bflo(xb.w), bfhi(xb.w)}; float y8[8];
#pragma unroll
            for (int e2 = 0; e2 < 8; ++e2) { y8[e2] = x8[e2] + gm * ((e2 < 4) ? g0[e2] : g1[e2 - 4]) * acc[c * 8 + e2]; acc[c * 8 + e2] = y8[e2]; ss += y8[e2] * y8[e2]; }
            if (l < 3) { u32x4 w; w.x = cvt_pk_bf16(y8[0], y8[1]); w.y = cvt_pk_bf16(y8[2], y8[3]); w.z = cvt_pk_bf16(y8[4], y8[5]); w.w = cvt_pk_bf16(y8[6], y8[7]); *(u32x4*)xp = w; } }
        const float rn = rsqrtf(wave_sum(ss) * (1.f / D) + NORM_EPS);
        const float* modall = WSP(const float, WS_MOD) + (size_t)b * MODC;
        if (l == 3) {
#pragma unroll
            for (int c = 0; c < 8; ++c) { const int col = lane * 32 + c * 4; const f32x4 gv = *(const f32x4*)(p->in[25] + col); f32x4 o;
#pragma unroll
                for (int e2 = 0; e2 < 4; ++e2) o[e2] = acc[c * 4 + e2] * rn * gv[e2];
                *(f32x4*)(p->out + (size_t)tok * D + col) = o; }
        } else {
            const float* g1 = (l == 1) ? p->in[13] : (p->in[5] + (l + 1) * D);
            const float* sh1 = (l == 1) ? (modall + 4 * 12288) : (modall + (l + 1) * 12288);
            const float* sc1 = sh1 + D;
            bf16_t* d1 = WSP(bf16_t, WS_HBUF) + (size_t)tok * D;
#pragma unroll
            for (int c = 0; c < 4; ++c) { u32x4 w;
#pragma unroll
                for (int hh = 0; hh < 2; ++hh) { const int col = lane * 32 + c * 8 + hh * 4; const f32x4 gv = *(const f32x4*)(g1 + col), sv = *(const f32x4*)(sh1 + col), cv = *(const f32x4*)(sc1 + col); float o[4];
#pragma unroll
                    for (int e2 = 0; e2 < 4; ++e2) o[e2] = acc[c * 8 + hh * 4 + e2] * rn * gv[e2] * (1.f + cv[e2]) + sv[e2];
                    w[hh * 2] = cvt_pk_bf16(o[0], o[1]); w[hh * 2 + 1] = cvt_pk_bf16(o[2], o[3]); }
                *(u32x4*)(d1 + lane * 32 + c * 8) = w; }
            if (l == 1) {
                const float* g2 = p->in[5] + 2 * D; const float* sh2 = modall + 2 * 12288; const float* sc2 = sh2 + D;
                bf16_t* d2 = WSP(bf16_t, WS_OBUF) + (size_t)tok * D;
#pragma unroll
                for (int c = 0; c < 4; ++c) { u32x4 w;
#pragma unroll
                    for (int hh = 0; hh < 2; ++hh) { const int col = lane * 32 + c * 8 + hh * 4; const f32x4 gv = *(const f32x4*)(g2 + col), sv = *(const f32x4*)(sh2 + col), cv = *(const f32x4*)(sc2 + col); float o[4];
#pragma unroll
                        for (int e2 = 0; e2 < 4; ++e2) o[e2] = acc[c * 8 + hh * 4 + e2] * rn * gv[e2] * (1.f + cv[e2]) + sv[e2];
                        w[hh * 2] = cvt_pk_bf16(o[0], o[1]); w[hh * 2 + 1] = cvt_pk_bf16(o[2], o[3]); }
                    *(u32x4*)(d2 + lane * 32 + c * 8) = w; }
            }
        }
    }
}
#undef FP4X8

DI void ph_dbg(PK p, int mode, const int wv) {
    PK_FRESH(p);
    const int tid = ltid(wv);
    const bf16_t* Ag = WSP(const bf16_t, WS_GA); const bf16_t* Bg = WSP(const bf16_t, WS_GB); const bf16_t* Qg = WSP(const bf16_t, WS_GQ); const bf16_t* Og = WSP(const bf16_t, WS_GO); const bf16_t* Sg = WSP(const bf16_t, WS_GS);
    const bf16_t* proj = WSP(const bf16_t, WS_PROJ); bf16_t* obuf = WSP(bf16_t, WS_OBUF);
    for (int idx = blockIdx.x * 512 + tid; idx < T * D; idx += gridDim.x * 512) {
        const int tok = idx >> 11, col = idx & 2047, hd = col >> 7, v = col & 127, b = tok >> 13, s = tok & 8191, n = s >> 6, i = s & 63;
        const size_t ci = (size_t)(b * 16 + hd) * 128 + n;
        float r = 0.f;
        if (mode == 1) r = bf2f(Og[ci * 8192 + i * 128 + v]) + bf2f(Qg[ci * 8192 + i * 128 + v]);
        if (mode == 2) r = bf2f(Ag[ci * 16384 + i * 128 + v]) + bf2f(Bg[ci * 16384 + (i + 64) * 128 + v]) + bf2f(Ag[ci * 16384 + (i + 64) * 128 + v]) + bf2f(Bg[ci * 16384 + i * 128 + v]);
        if (mode == 3) r = bf2f(Sg[ci * 16384 + i * 128 + v]) + bf2f(Sg[ci * 16384 + (i + 64) * 128 + v]);
        if (mode == 4) r = bf2f(proj[(size_t)tok * GINP + col]) + bf2f(proj[(size_t)tok * GINP + 2048 + col]) + bf2f(proj[(size_t)tok * GINP + 4096 + col]) + bf2f(proj[(size_t)tok * GINP + 6144 + col]) + ((col < 256) ? bf2f(proj[(size_t)tok * GINP + 8192 + col]) : 0.f);
        obuf[idx] = f2bf(r);
    }
}
#ifndef MK_AOUT
#define MK_AOUT obuf
#endif
constexpr int NPHASES = 1 + 1 + 2 * 9 + 2 * 8 + 1;

__global__ void __launch_bounds__(512, 2) mk_fwd(Params p_arg) {
    extern __shared__ __attribute__((aligned(16))) unsigned char lds[];
    PK p = (PK)__builtin_amdgcn_kernarg_segment_ptr();
    const int lo = p->ph_lo, hi = p->ph_hi;
    const int wv = __builtin_amdgcn_readfirstlane((int)threadIdx.x >> 6);
    volatile LAS unsigned* st = (volatile LAS unsigned*)((LAS unsigned char*)lds + LDS_BARW);
    if (wv == 0 && lane_id() == 0) { st[0] = 0u; st[1] = 0u; }
    __syncthreads();
    XcdBarrier bar; bar.bar = (unsigned*)(p->ws + WS_BAR); bar.x = 0; bar.st = st; bar.wv = wv;
    if (hi - lo > 1) bar = xcd_barrier_post((unsigned*)(p->ws + WS_BAR), st, wv);
    int ph = 0;
#define PH_BEGIN if (lo <= ph && ph < hi) { PK_FRESH(p);
#define PH_END   if (ph + 1 < hi) xcd_barrier(bar); } ++ph;
#define mod  WSP(const float, WS_MOD)
#define xcur WSP(bf16_t, WS_XCUR)
#define hbuf WSP(bf16_t, WS_HBUF)
#define obuf WSP(bf16_t, WS_OBUF)
#define G    ((int)gridDim.x)
#define bx   ((int)blockIdx.x)
#define modl (mod + l * 12288)

    PH_BEGIN ph_prologue(p, lds, wv); if (MK_DUP & 1) { __syncthreads(); ph_prologue(p, lds, wv); } PH_END

    for (int l = 0; l < DEPTH; ++l) {
        if (l == 0) { PH_BEGIN ph_norm<0>(p->in[0], nullptr, p->in[5], modl + 0 * D, modl + 1 * D, hbuf, nullptr, wv); PH_END }
        PH_BEGIN
            pg8::Gemm g; pg8::EpiMk E; E.mode = 0; E.xin = nullptr; E.xinb = nullptr; E.xout = nullptr; E.gate = nullptr; E.gmul = 1.f; E.xoutf = nullptr; E.O2 = nullptr; E.nrope = 0; E.cosT = WSP(const float, WS_COS); E.sinT = WSP(const float, WS_SIN);
            g.A = (l == 2) ? obuf : hbuf; g.M = T; g.K = D; g.ld = D; g.ksplit = 0;
            if (l < 2) { g.Bt = WSP(const bf16_t, WS_WIN) + (size_t)l * GINP * D; g.N = 8192; E.O = WSP(bf16_t, WS_PROJ); E.ldc = GINP; }
            else { g.Bt = WSP(const bf16_t, WS_DWQ) + (size_t)(l - 2) * D * D; g.N = D; E.mode = 2; E.O = WSP(bf16_t, WS_QD); E.nrope = D; }
            pg8::StaticOrder S; S.init(g.M, g.N, G, bx);
            pg8::gemm_phase<pg8::EpiMk, pg8::StaticOrder>((PG8_LAS unsigned char*)lds, g, S, E, wv);
            if (MK_DUP & 2) { __syncthreads(); pg8::gemm_phase<pg8::EpiMk, pg8::StaticOrder>((PG8_LAS unsigned char*)lds, g, S, E, wv); }
            if (l < 2) {
                pg8::Gemm g2; g2.A = hbuf; g2.Bt = WSP(const bf16_t, WS_WIN) + (size_t)l * GINP * D + (size_t)8192 * D; g2.M = T; g2.N = 1024; g2.K = 512; g2.ld = D; g2.ksplit = 1;
                pg8::EpiMk E2 = E; E2.mode = 3; E2.xoutf = WSP(float, WS_PAB);
                pg8::StaticOrder S2; S2.init(g2.M, g2.N, G, bx);
                pg8::gemm_phase<pg8::EpiMk, pg8::StaticOrder>((PG8_LAS unsigned char*)lds, g2, S2, E2, wv);
            }
        PH_END
        if (l < 2) {
            PH_BEGIN ph_gdn_p1(p, l, lds, wv); if (MK_DUP & 8) { __syncthreads(); ph_gdn_p1(p, l, lds, wv); } PH_END
            PH_BEGIN ph_gdn_p2(p, lds, wv); if (MK_DUP & 16) { __syncthreads(); ph_gdn_p2(p, lds, wv); } PH_END
#ifdef MK_DBG
            PH_BEGIN ph_dbg(p, MK_DBG, wv); PH_END
#else
            PH_BEGIN ph_gdn_p3(p, l, wv); if (MK_DUP & 32) { __syncthreads(); ph_gdn_p3(p, l, wv); } PH_END
#endif
        } else {
            PH_BEGIN ph_attn(p, lds, wv); if (MK_DUP & 64) { __syncthreads(); ph_attn(p, lds, wv); } PH_END
            PH_BEGIN ph_diff_combine(p, l - 2, l, lds, wv); PH_END
        }
        PH_BEGIN
            pg8::Gemm g; pg8::EpiMk E; E.mode = 1; E.O = nullptr; E.ldc = 0; E.xoutf = nullptr; E.O2 = nullptr; E.nrope = 0; E.cosT = nullptr; E.sinT = nullptr; E.xin = (l == 0) ? p->in[0] : nullptr; E.xinb = xcur; E.xout = xcur; E.gate = modl + 2 * D; E.gmul = ((MK_SKIP >> (2 * l)) & 1) ? 0.f : 1.f;
            g.A = MK_AOUT; g.M = T; g.K = D; g.N = D; g.ld = D; g.ksplit = 0;
            g.Bt = (l < 2) ? (WSP(const bf16_t, WS_WOUT) + (size_t)l * D * D) : (WSP(const bf16_t, WS_DWO) + (size_t)(l - 2) * D * D);
            pg8::StaticOrder S; S.init(g.M, g.N, G, bx);
            pg8::gemm_phase<pg8::EpiMk, pg8::StaticOrder>((PG8_LAS unsigned char*)lds, g, S, E, wv);
        PH_END
        PH_BEGIN ph_norm<2>(nullptr, xcur, p->in[6] + l * D, modl + 3 * D, modl + 4 * D, hbuf, nullptr, wv); PH_END
        PH_BEGIN
            pg8::Gemm g; pg8::EpiMk E; E.mode = 0; E.xin = nullptr; E.xinb = nullptr; E.xout = nullptr; E.gate = nullptr; E.gmul = 1.f; E.xoutf = nullptr; E.O2 = nullptr; E.nrope = 0; E.cosT = WSP(const float, WS_COS); E.sinT = WSP(const float, WS_SIN); E.O = WSP(bf16_t, WS_PQ); E.ldc = D;
            g.A = hbuf; g.M = T; g.K = D; g.N = D; g.ld = D; g.ksplit = 0; g.Bt = WSP(const bf16_t, WS_PWQ) + (size_t)l * D * D;
            pg8::StaticOrder S; S.init(g.M, g.N, G, bx);
            pg8::gemm_phase<pg8::EpiMk, pg8::StaticOrder>((PG8_LAS unsigned char*)lds, g, S, E, wv);
        PH_END
        PH_BEGIN ph_peer_topk(p, l, lds, wv); if (MK_DUP & 128) { __syncthreads(); ph_peer_topk(p, l, lds, wv); } PH_END
        PH_BEGIN ph_peer_gather(p, l, lds, wv); if (MK_DUP & 256) { __syncthreads(); ph_peer_gather(p, l, lds, wv, false); } PH_END
        if (l == 1) {
            PH_BEGIN
                pg8::Gemm g; pg8::EpiMk E; E.mode = 0; E.xin = nullptr; E.xinb = nullptr; E.xout = nullptr; E.gate = nullptr; E.gmul = 1.f; E.xoutf = nullptr; E.O2 = nullptr; E.nrope = 0; E.cosT = WSP(const float, WS_COS); E.sinT = WSP(const float, WS_SIN); E.mode = 2; E.O = WSP(bf16_t, WS_KSH); E.O2 = WSP(bf16_t, WS_VSH); E.nrope = 2048;
                g.A = hbuf; g.M = T; g.K = D; g.N = 4096; g.ld = D; g.ksplit = 0; g.Bt = WSP(const bf16_t, WS_KVW);
                pg8::StaticOrder S; S.init(g.M, g.N, G, bx);
                pg8::gemm_phase<pg8::EpiMk, pg8::StaticOrder>((PG8_LAS unsigned char*)lds, g, S, E, wv);
            PH_END
        }
    }
#undef PH_BEGIN
#undef PH_END
#undef mod
#undef xcur
#undef hbuf
#undef obuf
#undef G
#undef bx
#undef modl
}

extern "C" void kernel_launch(void* const* d_in, const int* in_sizes, int n_in, void* d_out, int out_size, void* d_ws, size_t ws_size, hipStream_t stream) {
    static int grid = 0;
    if (grid == 0) {
        if (n_in != 26 || in_sizes[0] != T * D || out_size != T * D || ws_size < WS_END) {
            fprintf(stderr, "kernel_launch: unexpected shapes: n_in %d in0 %d out %d ws %zu (need %zu)\n", n_in, n_in > 0 ? in_sizes[0] : -1, out_size, ws_size, (size_t)WS_END); grid = -1; return; }
        int dev = 0, cus = 0;
        if (hipGetDevice(&dev) != hipSuccess || hipDeviceGetAttribute(&cus, hipDeviceAttributeMultiprocessorCount, dev) != hipSuccess || cus <= 0) cus = 256;
        if (hipFuncSetAttribute((const void*)mk_fwd, hipFuncAttributeMaxDynamicSharedMemorySize, LDS_BYTES) != hipSuccess) { fprintf(stderr, "kernel_launch: hipFuncSetAttribute failed\n"); grid = -1; return; }
        int per_cu = 0;
        if (hipOccupancyMaxActiveBlocksPerMultiprocessor(&per_cu, (const void*)mk_fwd, 512, LDS_BYTES) != hipSuccess || per_cu < 1) fprintf(stderr, "kernel_launch: occupancy query says %d\n", per_cu);
        (void)hipGetLastError();
        grid = cus;
    }
    if (grid < 0) return;
    (void)hipMemsetAsync((char*)d_ws + WS_BAR, 0, 16384, stream);
    Params p{};
    for (int i = 0; i < 26; ++i) p.in[i] = (const float*)d_in[i];
    p.out = (float*)d_out; p.ws = (unsigned char*)d_ws;
#if MK_N_LAUNCHES == 1
    p.ph_lo = 0; p.ph_hi = NPHASES;
    hipLaunchKernelGGL(mk_fwd, dim3(grid), dim3(512), LDS_BYTES, stream, p);
#else
#ifndef MK_PHMASK
#define MK_PHMASK 0xffffffffu
#endif
#ifndef MK_STOP
#define MK_STOP NPHASES
#endif
    for (int ph = 0; ph < NPHASES; ++ph) { if (ph >= MK_STOP && ph != NPHASES - 1) continue; if (!(MK_PHMASK >> (ph < 31 ? ph : 31) & 1u) && ph != NPHASES - 1) continue; p.ph_lo = ph; p.ph_hi = ph + 1; hipLaunchKernelGGL(mk_fwd, dim3(grid), dim3(512), LDS_BYTES, stream, p); }
#endif
    const hipError_t le = hipPeekAtLastError();
    if (le != hipSuccess) fprintf(stderr, "kernel_launch: launch failed: %s\n", hipGetErrorName(le));
}
```

```cpp
#include <hip/hip_runtime.h>
#include <hip/hip_bf16.h>
#include <cstdio>
#include <cstdint>

#ifndef MK_N_LAUNCHES
#define MK_N_LAUNCHES 1
#endif
#ifndef MK_DUP
#define MK_DUP 0
#endif
#ifndef MK_SKIP
#define MK_SKIP 0
#endif

constexpr int NB = 2, SEQ = 8192, T = NB * SEQ, D = 2048, DEPTH = 4;
constexpr int GH = 16, GIN = 8224, GINP = 8448;
constexpr int MODC = 4 * 12288 + 4096;
constexpr float NORM_EPS = 1e-6f;

typedef unsigned short bf16_t;
typedef short bf16x8 __attribute__((ext_vector_type(8)));
typedef short s16x4 __attribute__((ext_vector_type(4)));
typedef float f32x4 __attribute__((ext_vector_type(4)));
typedef float f32x2 __attribute__((ext_vector_type(2)));
typedef float f32x16 __attribute__((ext_vector_type(16)));
typedef unsigned u32x4 __attribute__((ext_vector_type(4)));
typedef unsigned u32x2 __attribute__((ext_vector_type(2)));
typedef __bf16 bfx2 __attribute__((ext_vector_type(2)));
#define LAS __attribute__((address_space(3)))
#define DI __device__ __forceinline__

DI float bf2f(bf16_t v) { return __uint_as_float(((unsigned)v) << 16); }
DI float bflo(unsigned w) { return __uint_as_float(w << 16); }
DI float bfhi(unsigned w) { return __uint_as_float(w & 0xffff0000u); }
DI bf16_t f2bf(float f) { unsigned u = __float_as_uint(f); u += 0x7FFFu + ((u >> 16) & 1u); return (bf16_t)(u >> 16); }
DI unsigned cvt_pk_bf16(float lo, float hi) { const f32x2 v = {lo, hi}; return __builtin_bit_cast(unsigned, __builtin_convertvector(v, bfx2)); }
template <int CTRL, int RMASK> DI float dpp_mov(float v) { return __int_as_float(__builtin_amdgcn_update_dpp(0, __float_as_int(v), CTRL, RMASK, 0xF, false)); }
template <int CTRL> DI float dpp_full(float v) { return __int_as_float(__builtin_amdgcn_update_dpp(0, __float_as_int(v), CTRL, 0xF, 0xF, true)); }
template <int M> DI float sw_xor(float v) {
    if constexpr (M == 1) return dpp_full<0xB1>(v);
    else if constexpr (M == 2) return dpp_full<0x4E>(v);
    else if constexpr (M == 8) return dpp_full<0x128>(v);
    else return __int_as_float(__builtin_amdgcn_ds_swizzle(__float_as_int(v), (M << 10) | 0x1f));
}
DI float row_sum16(float v) { v += dpp_full<0xB1>(v); v += dpp_full<0x4E>(v); v += dpp_full<0x141>(v); v += dpp_full<0x140>(v); return v; }
DI float sw_xor32_sum(float v) { auto rr = __builtin_amdgcn_permlane32_swap(__float_as_uint(v), __float_as_uint(v), false, false); return __uint_as_float(rr[0]) + __uint_as_float(rr[1]); }
DI float wave_max(float v) {
    v = fmaxf(v, sw_xor<1>(v)); v = fmaxf(v, sw_xor<2>(v)); v = fmaxf(v, sw_xor<4>(v)); v = fmaxf(v, sw_xor<8>(v)); v = fmaxf(v, sw_xor<16>(v));
    auto rr = __builtin_amdgcn_permlane32_swap(__float_as_uint(v), __float_as_uint(v), false, false); return fmaxf(__uint_as_float(rr[0]), __uint_as_float(rr[1]));
}
DI float wave_sum(float v) {
    v = row_sum16(v); v += dpp_mov<0x142, 0xA>(v); v += dpp_mov<0x143, 0xC>(v);
    return __int_as_float(__builtin_amdgcn_readlane(__float_as_int(v), 63));
}
DI float wave_sum_dpp(float v) {
    v += dpp_mov<0xB1, 0xF>(v); v += dpp_mov<0x4E, 0xF>(v); v += dpp_mov<0x141, 0xF>(v); v += dpp_mov<0x140, 0xF>(v);
    v += dpp_mov<0x142, 0xA>(v); v += dpp_mov<0x143, 0xC>(v);
    return __int_as_float(__builtin_amdgcn_readlane(__float_as_int(v), 63));
}
DI void wave_sum4_dpp(float& a, float& b, float& c, float& d) {
#define WS4_STEP(ctl) "v_add_f32_dpp %0, %0, %0 " ctl "\n v_add_f32_dpp %1, %1, %1 " ctl "\n v_add_f32_dpp %2, %2, %2 " ctl "\n v_add_f32_dpp %3, %3, %3 " ctl "\n"
    asm("s_nop 1\n"
        WS4_STEP("quad_perm:[1,0,3,2] row_mask:0xf bank_mask:0xf")
        WS4_STEP("quad_perm:[2,3,0,1] row_mask:0xf bank_mask:0xf")
        WS4_STEP("row_half_mirror row_mask:0xf bank_mask:0xf")
        WS4_STEP("row_mirror row_mask:0xf bank_mask:0xf")
        WS4_STEP("row_bcast:15 row_mask:0xa bank_mask:0xf")
        WS4_STEP("row_bcast:31 row_mask:0xc bank_mask:0xf")
        : "+v"(a), "+v"(b), "+v"(c), "+v"(d));
#undef WS4_STEP
}
DI void lds_barrier() { asm volatile("s_waitcnt lgkmcnt(0)" ::: "memory"); __builtin_amdgcn_s_barrier(); asm volatile("" ::: "memory"); }
DI float silu_f(float v) { return v * __builtin_amdgcn_rcpf(1.f + __expf(-v)); }
DI int lane_id() { int l; asm volatile("v_mbcnt_lo_u32_b32 %0, -1, 0\n\tv_mbcnt_hi_u32_b32 %0, -1, %0" : "=v"(l)); return l; }
DI int ltid(const int wv) { int t = wv * 64 + lane_id(); asm volatile("" : "+v"(t)); return t; }

constexpr size_t al4k(size_t x) { return (x + 4095) & ~(size_t)4095; }
constexpr size_t WS_BAR   = 0;
constexpr size_t WS_MOD   = 16384;
constexpr size_t WS_COS   = al4k(WS_MOD + (size_t)2 * MODC * 4);
constexpr size_t WS_SIN   = WS_COS + (size_t)T * 64 * 4;
constexpr size_t WS_SUBK  = WS_SIN + (size_t)T * 64 * 4;
constexpr size_t WS_WIN   = WS_SUBK + (size_t)4 * 2 * 128 * 128 * 2;
constexpr size_t WS_WOUT  = WS_WIN + (size_t)2 * GINP * D * 2;
constexpr size_t WS_KVW   = WS_WOUT + (size_t)2 * D * D * 2;
constexpr size_t WS_DWQ   = WS_KVW + (size_t)4096 * D * 2;
constexpr size_t WS_DWO   = WS_DWQ + (size_t)2 * D * D * 2;
constexpr size_t WS_PWQ   = WS_DWO + (size_t)2 * D * D * 2;
constexpr size_t WS_PU    = WS_PWQ + (size_t)4 * D * D * 2;
constexpr size_t WS_PUS   = WS_PU + (size_t)16384 * 1024;
constexpr size_t WS_PV    = WS_PU + (size_t)16384 * D * 2;
constexpr size_t WS_PVS   = WS_PV + (size_t)16384 * 1024;
constexpr size_t WS_XCUR  = WS_PV + (size_t)16384 * D * 2;
constexpr size_t WS_HBUF  = WS_XCUR + (size_t)T * D * 4;
constexpr size_t WS_OBUF  = WS_HBUF + (size_t)T * D * 2;
constexpr size_t WS_PROJ  = WS_OBUF + (size_t)T * D * 2;
constexpr size_t WS_PAB   = WS_PROJ + (size_t)T * GINP * 2;
constexpr size_t WS_PQ    = WS_PROJ + (size_t)T * GINP * 2;
constexpr size_t WS_PIDX  = WS_PQ + (size_t)T * D * 2;
constexpr size_t WS_PGATE = WS_PIDX + (size_t)T * 128 * 4;
constexpr size_t WS_GA    = WS_PGATE + (size_t)T * 128 * 4;
constexpr size_t WS_GB    = WS_GA + (size_t)4096 * 128 * 128 * 2;
constexpr size_t WS_GQ    = WS_GB + (size_t)4096 * 128 * 128 * 2;
constexpr size_t WS_GO    = WS_GQ + (size_t)4096 * 64 * 128 * 2;
constexpr size_t WS_GS    = WS_GO + (size_t)4096 * 64 * 128 * 2;
constexpr size_t WS_GL    = WS_GS + (size_t)4096 * 128 * 128 * 2;
constexpr size_t WS_END   = WS_GL + 16384;
constexpr size_t WS_OAT   = WS_GA;
constexpr size_t WS_KSH   = WS_GB;
constexpr size_t WS_VSH   = WS_GB + (size_t)67108864;
constexpr size_t WS_QD    = WS_GQ;

constexpr int LDS_BYTES = 147456;
constexpr int LDS_BARW  = 147456 - 64;

struct Params { const float* in[26]; float* out; unsigned char* ws; int ph_lo, ph_hi; };
typedef const Params __attribute__((address_space(4)))* PK;
#define PK_FRESH(p) asm volatile("" : "+s"(p))

#define XB_TMO      128
#define XB_XCNT(j)  (256  + 64 * (j))
#define XB_XSUB(j)  (1280 + 64 * (j))
#define XB_XGEN(j)  (2304 + 64 * (j))
#define XB_TOP      3328
#define XB_TOPGEN   3392
#define XCD_BAR_WORDS 3456
#define XB_SPIN_CAP (1u << 20)

__device__ __forceinline__ unsigned xb_ld(unsigned* p)              { return __hip_atomic_load(p, __ATOMIC_RELAXED, __HIP_MEMORY_SCOPE_AGENT); }
__device__ __forceinline__ unsigned xb_add(unsigned* p, unsigned v) { return __hip_atomic_fetch_add(p, v, __ATOMIC_RELAXED, __HIP_MEMORY_SCOPE_AGENT); }
__device__ __forceinline__ unsigned xb_xcc_id() { return (unsigned)__builtin_amdgcn_s_getreg((3 << 11) | 20) & 0xFu; }
#define XB_SPIN(cond, bar) do { unsigned _sp = 0; while (cond) { __builtin_amdgcn_s_sleep(1); \
    if ((++_sp & 255u) == 0u) { if (xb_ld(&(bar)[XB_TMO])) break; if (_sp > XB_SPIN_CAP) { atomicAdd(&(bar)[XB_TMO], 1u); break; } } } } while (0)

struct XcdBarrier { unsigned* bar; unsigned x; volatile LAS unsigned* st; int wv; };

__device__ __forceinline__ XcdBarrier xcd_barrier_post(unsigned* bar, volatile LAS unsigned* st, int wv) {
    XcdBarrier b; b.bar = bar; b.x = xb_xcc_id(); b.st = st; b.wv = wv;
    if (wv == 0 && lane_id() == 0) (void)xb_add(&bar[XB_XCNT(b.x)], 1u);
    return b;
}
__device__ __forceinline__ void xcd_barrier_complete(unsigned* bar, unsigned x, unsigned& nloc, unsigned& nx) {
    const unsigned G = gridDim.x * gridDim.y * gridDim.z;
    unsigned sum, cnt, mine, sp = 0u;
    for (;;) {
        sum = 0u; cnt = 0u; mine = 0u;
#pragma unroll
        for (unsigned j = 0; j < 16; ++j) { const unsigned c = xb_ld(&bar[XB_XCNT(j)]); sum += c; cnt += (c > 0u) ? 1u : 0u; mine = (j == x) ? c : mine; }
        if (sum == G) break;
        __builtin_amdgcn_s_sleep(1);
        if ((++sp & 255u) == 0u) { if (xb_ld(&bar[XB_TMO])) break; if (sp > XB_SPIN_CAP) { atomicAdd(&bar[XB_TMO], 1u); break; } }
    }
    nloc = mine > 0u ? mine : 1u; nx = cnt > 0u ? cnt : 1u;
}
__device__ __forceinline__ void xcd_barrier(const XcdBarrier& b) {
    asm volatile("s_waitcnt vmcnt(0)" ::: "memory");
    __syncthreads();
    if (b.wv == 0 && lane_id() == 0) {
        unsigned* bar = b.bar;
        __builtin_amdgcn_s_waitcnt(0);
        unsigned nloc = b.st[0], nx = b.st[1];
        if (nloc == 0u) { xcd_barrier_complete(bar, b.x, nloc, nx); b.st[0] = nloc; b.st[1] = nx; }
        const unsigned old = xb_add(&bar[XB_XSUB(b.x)], 1u);
        const unsigned gen = old / nloc;
        if (old + 1u == (gen + 1u) * nloc) {
            __builtin_amdgcn_fence(__ATOMIC_RELEASE, "agent");
            asm volatile("s_waitcnt vmcnt(0)" ::: "memory");
            const unsigned og = xb_add(&bar[XB_TOP], 1u);
            const unsigned tg = og / nx;
            if (og + 1u == (tg + 1u) * nx) xb_add(&bar[XB_TOPGEN], 1u);
            else XB_SPIN(xb_ld(&bar[XB_TOPGEN]) == tg, bar);
            __builtin_amdgcn_fence(__ATOMIC_ACQUIRE, "agent");
            xb_add(&bar[XB_XGEN(b.x)], 1u);
            asm volatile("s_waitcnt vmcnt(0)" ::: "memory");
        } else {
            XB_SPIN(xb_ld(&bar[XB_XGEN(b.x)]) == gen, bar);
            __builtin_amdgcn_fence(__ATOMIC_ACQUIRE, "agent");
            asm volatile("s_waitcnt vmcnt(0)" ::: "memory");
        }
    }
    __syncthreads();
}

namespace pg8 {
#define PG8_LAS __attribute__((address_space(3)))
constexpr int BM = 256, BK = 64, HALF = 128, HTB = HALF * BK * 2, STAGE_BYTES = 8 * HTB, NXCD = 8, WGM = 8;
__host__ __device__ __forceinline__ int lds_byte(int r, int c) { const int st = (r >> 4) * 2 + (c >> 5), rr = r & 15, cc = c & 31, ob = rr * 64 + cc * 2; return st * 1024 + (ob ^ (((ob >> 9) & 1) << 5)); }
__host__ __device__ __forceinline__ void stage_rc(int b, int& R, int& C) { const int st = b / 1024, sb = b % 1024, swz = sb ^ (((sb >> 9) & 1) << 5); R = (st >> 1) * 16 + swz / 64; C = (st & 1) * 32 + (swz % 64) / 2; }
__host__ __device__ __forceinline__ int perm32(int rho) { const int n = rho >> 4, i = rho & 15; return 8 * (i >> 2) + 4 * n + (i & 3); }
struct Unit { int pm, pn; };
struct Gemm { const bf16_t* A; const bf16_t* Bt; int M, N, K; int ld; int ksplit; };
struct StaticOrder {
    int nM, nN, nwg, G, c;
    __host__ __device__ void init(int M, int N, int G_, int c_) { nM = M / BM; nN = N / BM; nwg = nM * nN; G = G_; c = c_; }
    __host__ __device__ bool next(int i, Unit& u) const {
        const long L = (long)i * G + c; if (L >= nwg) return false;
        int wgid = (int)L; { const int q = nwg / NXCD, r = nwg % NXCD, xcd = wgid % NXCD, off = wgid / NXCD; wgid = (xcd < r ? xcd * (q + 1) : r * (q + 1) + (xcd - r) * q) + off; }
        const int nig = WGM * nN, gid = wgid / nig, fm = gid * WGM, gsz = (nM - fm) < WGM ? (nM - fm) : WGM;
        u.pm = fm + ((wgid % nig) % gsz); u.pn = (wgid % nig) / gsz; return true;
    }
    __device__ __forceinline__ void a_ready(const Unit&) const {}
    __device__ __forceinline__ void done(const Unit&) const {}
};

struct EpiMk {
    static constexpr bool PERM = true, AFTER_DRAIN = false;
    int mode; bf16_t* O; int ldc; const float* xin; const bf16_t* xinb; bf16_t* xout; const float* gate; float gmul;
    bf16_t* O2; int nrope; const float* cosT; const float* sinT;
    float* xoutf;
    __device__ __forceinline__ void operator()(const f32x4 (&acc)[2][2][4][2], const Unit& u, int wr, int wc, int fr, int fq) const {
        const int row0 = u.pm * BM + wr * 64 + fr, col0 = u.pn * BM + wc * 32 + 8 * fq;
        if (mode == 0) {
#pragma unroll
            for (int ai = 0; ai < 2; ++ai)
#pragma unroll
                for (int m = 0; m < 4; ++m) { bf16_t* rowp = O + (size_t)(row0 + ai * HALF + m * 16) * ldc + col0;
#pragma unroll
                    for (int bj = 0; bj < 2; ++bj) { const f32x4 v0 = acc[ai][bj][m][0], v1 = acc[ai][bj][m][1];
                        u32x4 w; w.x = cvt_pk_bf16(v0[0], v0[1]); w.y = cvt_pk_bf16(v0[2], v0[3]); w.z = cvt_pk_bf16(v1[0], v1[1]); w.w = cvt_pk_bf16(v1[2], v1[3]);
                        *(u32x4*)(rowp + bj * HALF) = w; } }
        } else if (mode == 3) {
            if (wc == 0) {
#pragma unroll
                for (int ai = 0; ai < 2; ++ai)
#pragma unroll
                    for (int m = 0; m < 4; ++m) { const int row = row0 + ai * HALF + m * 16; float* dp = xoutf + ((size_t)u.pn * T + row) * 32 + 8 * fq;
                        *(f32x4*)dp = acc[ai][0][m][0]; *(f32x4*)(dp + 4) = acc[ai][0][m][1]; }
            }
        } else if (mode == 2) {
#pragma unroll
            for (int ai = 0; ai < 2; ++ai)
#pragma unroll
                for (int m = 0; m < 4; ++m) { const int row = row0 + ai * HALF + m * 16, bb = row >> 13, ss = row & 8191;
#pragma unroll
                    for (int bj = 0; bj < 2; ++bj) { const int col = col0 + bj * HALF; const f32x4 v0 = acc[ai][bj][m][0], v1 = acc[ai][bj][m][1];
                        if (col < nrope) { const int hc = col >> 7, j0 = ((col & 127) >> 3) * 4;
                            const f32x4 cs = *(const f32x4*)(cosT + (size_t)row * 64 + j0), sn = *(const f32x4*)(sinT + (size_t)row * 64 + j0);
                            bf16_t* dp = O + ((size_t)(bb * 16 + hc) * SEQ + ss) * 128 + j0;
                            u32x2 w1, w2; w1.x = cvt_pk_bf16(v0[0] * cs[0] - v1[0] * sn[0], v0[1] * cs[1] - v1[1] * sn[1]); w1.y = cvt_pk_bf16(v0[2] * cs[2] - v1[2] * sn[2], v0[3] * cs[3] - v1[3] * sn[3]);
                            w2.x = cvt_pk_bf16(v1[0] * cs[0] + v0[0] * sn[0], v1[1] * cs[1] + v0[1] * sn[1]); w2.y = cvt_pk_bf16(v1[2] * cs[2] + v0[2] * sn[2], v1[3] * cs[3] + v0[3] * sn[3]);
                            *(u32x2*)dp = w1; *(u32x2*)(dp + 64) = w2;
                        } else { const int cv = col - nrope, hc = cv >> 7;
                            u32x4 w; w.x = cvt_pk_bf16(v0[0], v0[1]); w.y = cvt_pk_bf16(v0[2], v0[3]); w.z = cvt_pk_bf16(v1[0], v1[1]); w.w = cvt_pk_bf16(v1[2], v1[3]);
                            *(u32x4*)(O2 + ((size_t)(bb * 16 + hc) * SEQ + ss) * 128 + (cv & 127)) = w; } } }
        } else {
#pragma unroll
            for (int ai = 0; ai < 2; ++ai)
#pragma unroll
                for (int m = 0; m < 4; ++m) { const int row = row0 + ai * HALF + m * 16; const float* gp = gate + (size_t)(row >> 13) * MODC + col0;
                    bf16_t* xo = xout + (size_t)row * D + col0;
#pragma unroll
                    for (int bj = 0; bj < 2; ++bj) {
                        const f32x4 g0 = *(const f32x4*)(gp + bj * HALF), g1 = *(const f32x4*)(gp + bj * HALF + 4);
                        f32x4 x0, x1;
                        if (xin) { x0 = *(const f32x4*)(xin + (size_t)row * D + col0 + bj * HALF); x1 = *(const f32x4*)(xin + (size_t)row * D + col0 + bj * HALF + 4); }
                        else { const u32x4 xb = *(const u32x4*)(xinb + (size_t)row * D + col0 + bj * HALF);
                            x0 = (f32x4){bflo(xb.x), bfhi(xb.x), bflo(xb.y), bfhi(xb.y)}; x1 = (f32x4){bflo(xb.z), bfhi(xb.z), bflo(xb.w), bfhi(xb.w)}; }
                        const f32x4 y0 = x0 + gmul * g0 * acc[ai][bj][m][0], y1 = x1 + gmul * g1 * acc[ai][bj][m][1];
                        u32x4 w; w.x = cvt_pk_bf16(y0[0], y0[1]); w.y = cvt_pk_bf16(y0[2], y0[3]); w.z = cvt_pk_bf16(y1[0], y1[1]); w.w = cvt_pk_bf16(y1[2], y1[3]);
                        *(u32x4*)(xo + bj * HALF) = w; } }
        }
    }
};

template <class Epi, class Sched>
__device__ __forceinline__ void gemm_phase(PG8_LAS unsigned char* lds, const Gemm g, const Sched& S, const Epi& E, const int wv) {
    const int tid = ltid(wv), wid = __builtin_amdgcn_readfirstlane(tid >> 6), lane = tid & 63, wr = wid >> 2, wc = wid & 3, fr = lane & 15, fq = lane >> 4;
    const int K = g.K, nt = K / BK, ld = g.ld;
    unsigned voffA[2], voffB[2];
#pragma unroll
    for (int i = 0; i < 2; ++i) { int R, C; stage_rc(tid * 16 + i * 8192, R, C); const int Rb = Epi::PERM ? ((R & ~31) + perm32(R & 31)) : R;
        voffA[i] = (unsigned)(R * ld + C) * 2u; voffB[i] = (unsigned)(Rb * ld + C) * 2u; }
    const size_t kstep = (size_t)(BK * 2);
    const size_t hstep = (size_t)HALF * ld * 2;
    const size_t tstep = 2 * hstep;
    const unsigned ldsw = (unsigned)wid * 1024u;
    const int aoff = lds_byte(wr * 64 + fr, fq * 8), boff = lds_byte(wc * 32 + fr, fq * 8);
#define PG8_SA(b, h) (((b) * 2 + (h)) * HTB)
#define PG8_SB(b, h) ((4 + (b) * 2 + (h)) * HTB)
#define PG8_STAGE(bufoff, gbase, voff) do { _Pragma("unroll") for (int _i = 0; _i < 2; ++_i) \
        __builtin_amdgcn_global_load_lds((const unsigned*)((const char*)(gbase) + (voff)[_i]), (PG8_LAS unsigned*)(lds + (bufoff) + ldsw + _i * 8192), 16, 0, 0); } while (0)
#define PG8_LDA(dst, b, h) do { _Pragma("unroll") for (int m = 0; m < 4; ++m) _Pragma("unroll") for (int k = 0; k < 2; ++k) dst[m][k] = *(const PG8_LAS bf16x8*)(lds + PG8_SA(b, h) + aoff + m * 2048 + k * 1024); } while (0)
#define PG8_LDB(dst, b, h) do { _Pragma("unroll") for (int n = 0; n < 2; ++n) _Pragma("unroll") for (int k = 0; k < 2; ++k) dst[n][k] = *(const PG8_LAS bf16x8*)(lds + PG8_SB(b, h) + boff + n * 2048 + k * 1024); } while (0)
#define PG8_MMA(ai, bj, At, Bt) do { __builtin_amdgcn_s_setprio(1); _Pragma("unroll") for (int m = 0; m < 4; ++m) _Pragma("unroll") for (int n = 0; n < 2; ++n) _Pragma("unroll") for (int k = 0; k < 2; ++k) \
        acc[ai][bj][m][n] = __builtin_amdgcn_mfma_f32_16x16x32_bf16(Bt[n][k], At[m][k], acc[ai][bj][m][n], 0, 0, 0); __builtin_amdgcn_s_setprio(0); } while (0)
#define PG8_WAIT_V(n) asm volatile("s_waitcnt vmcnt(" #n ")" ::: "memory")
#define PG8_WAIT_L(n) asm volatile("s_waitcnt lgkmcnt(" #n ")" ::: "memory")
#define PG8_BAR __builtin_amdgcn_s_barrier()
#define PG8_SCHED __builtin_amdgcn_sched_barrier(0)
    Unit cur, nxt; int ui = 0;
    if (!S.next(0, cur)) return;
    f32x4 acc[2][2][4][2];
#pragma unroll
    for (int a = 0; a < 2; ++a)
#pragma unroll
        for (int b = 0; b < 2; ++b)
#pragma unroll
            for (int m = 0; m < 4; ++m)
#pragma unroll
                for (int n = 0; n < 2; ++n) acc[a][b][m][n] = (f32x4){0.f, 0.f, 0.f, 0.f};
    bf16x8 At[4][2], B0[2][2], B1[2][2];
    const size_t bstep = g.ksplit ? (size_t)K * 2 : tstep, astep = g.ksplit ? (size_t)K * 2 : 0;
    const char* cA = (const char*)g.A + (size_t)cur.pm * tstep + (size_t)cur.pn * astep; const char* cB = (const char*)g.Bt + (size_t)cur.pn * bstep;
    S.a_ready(cur);
    PG8_STAGE(PG8_SB(0, 0), cB, voffB); PG8_STAGE(PG8_SA(0, 0), cA, voffA); PG8_STAGE(PG8_SB(0, 1), cB + hstep, voffB); PG8_STAGE(PG8_SA(0, 1), cA + hstep, voffA);
    if (wr == 1) PG8_BAR;
    PG8_WAIT_V(4); PG8_BAR;
    PG8_STAGE(PG8_SB(1, 0), cB + kstep, voffB); PG8_STAGE(PG8_SA(1, 0), cA + kstep, voffA); PG8_STAGE(PG8_SB(1, 1), cB + hstep + kstep, voffB);
    PG8_WAIT_V(6); PG8_BAR;
    for (;;) {
        const bool has_next = S.next(ui + 1, nxt);
        const char* nA = has_next ? (const char*)g.A + (size_t)nxt.pm * tstep + (size_t)nxt.pn * astep : cA; const char* nB = has_next ? (const char*)g.Bt + (size_t)nxt.pn * bstep : cB;
        for (int t = 0; t < nt; t += 2) {
            const bool last = (t == nt - 2);
            const char* a1 = cA + (size_t)(t + 1) * kstep;
            const char* a2 = last ? nA : cA + (size_t)(t + 2) * kstep; const char* b2 = last ? nB : cB + (size_t)(t + 2) * kstep;
            const char* a3 = a2 + kstep; const char* b3 = b2 + kstep;
            if (last && has_next) S.a_ready(nxt);
            PG8_LDB(B0, 0, 0); PG8_SCHED; PG8_LDA(At, 0, 0); PG8_STAGE(PG8_SA(1, 1), a1 + hstep, voffA);
            PG8_WAIT_L(8); PG8_BAR; PG8_WAIT_L(0); PG8_MMA(0, 0, At, B0); PG8_BAR; PG8_SCHED;
            PG8_LDB(B1, 0, 1); PG8_STAGE(PG8_SB(0, 0), b2, voffB);
            PG8_BAR; PG8_WAIT_L(0); PG8_MMA(0, 1, At, B1); PG8_BAR;
            PG8_LDA(At, 0, 1); PG8_STAGE(PG8_SA(0, 0), a2, voffA);
            PG8_BAR; PG8_WAIT_L(0); PG8_MMA(1, 0, At, B0); PG8_BAR; PG8_SCHED;
            PG8_STAGE(PG8_SB(0, 1), b2 + hstep, voffB);
            PG8_WAIT_V(6); PG8_BAR; PG8_MMA(1, 1, At, B1); PG8_BAR;
            PG8_LDB(B0, 1, 0); PG8_SCHED; PG8_LDA(At, 1, 0); PG8_STAGE(PG8_SA(0, 1), a2 + hstep, voffA);
            PG8_WAIT_L(8); PG8_BAR; PG8_WAIT_L(0); PG8_MMA(0, 0, At, B0); PG8_BAR; PG8_SCHED;
            PG8_LDB(B1, 1, 1); PG8_STAGE(PG8_SB(1, 0), b3, voffB);
            PG8_BAR; PG8_WAIT_L(0); PG8_MMA(0, 1, At, B1); PG8_BAR;
            PG8_LDA(At, 1, 1); PG8_STAGE(PG8_SA(1, 0), a3, voffA);
            PG8_BAR; PG8_WAIT_L(0); PG8_MMA(1, 0, At, B0); PG8_BAR; PG8_SCHED;
            PG8_STAGE(PG8_SB(1, 1), b3 + hstep, voffB);
            PG8_WAIT_V(6); PG8_BAR; PG8_MMA(1, 1, At, B1); PG8_BAR;
        }
        E(acc, cur, wr, wc, fr, fq); S.done(cur);
        if (!has_next) break;
#pragma unroll
        for (int a = 0; a < 2; ++a)
#pragma unroll
            for (int b = 0; b < 2; ++b)
#pragma unroll
                for (int m = 0; m < 4; ++m)
#pragma unroll
                    for (int n = 0; n < 2; ++n) acc[a][b][m][n] = (f32x4){0.f, 0.f, 0.f, 0.f};
        cur = nxt; cA = nA; cB = nB; ++ui;
    }
    PG8_WAIT_V(0);
    if (wr == 0) PG8_BAR;
    PG8_BAR;
#undef PG8_SA
#undef PG8_SB
#undef PG8_STAGE
#undef PG8_LDA
#undef PG8_LDB
#undef PG8_MMA
#undef PG8_WAIT_V
#undef PG8_WAIT_L
#undef PG8_BAR
#undef PG8_SCHED
}
}

namespace att {
constexpr int D = 128;
constexpr float THR = 8.f;
constexpr bool WSKIP = false;
constexpr float SCALE = 0.08838834764831845f;
constexpr int NW = 8, QBLK = 32, KVBLK = 64, QB = NW * QBLK;
constexpr int SHM_V = KVBLK * D * 2, SHM_K = KVBLK * D * 2;
constexpr int LDS_BYTES = 2 * SHM_V + 2 * SHM_K + NW * 64 * 4;
using bf16 = __hip_bfloat16;
template <class A, class Bt> struct same_t { static constexpr bool v = false; };
template <class A> struct same_t<A, A> { static constexpr bool v = true; };
#define KSWZ(row, colB) ((row) * 256 + ((colB) ^ (((row) & 7) << 4)))
#define SBAR() __builtin_amdgcn_sched_barrier(0)
__device__ __forceinline__ int v_st(int k, int c) { const int kk = (k & ~0xC) | ((k & 4) << 1) | ((k & 8) >> 1); return ((kk >> 3) * 4 + (c >> 5)) * 512 + ((kk & 7) * 32 + (c & 31)) * 2; }
__device__ __forceinline__ int v_rd_base(int lane) { return ((lane & 3) << 3) | (((lane >> 2) & 3) << 6) | (((lane >> 4) & 1) << 5) | (((lane >> 5) & 1) << 8); }
constexpr int v_rd_off(int d0, int ks, int half) { return d0 * 512 + ks * 4096 + half * 2048; }
__device__ __forceinline__ int crow(int r, int hi) { return (r & 3) + 8 * (r >> 2) + 4 * hi; }
__device__ __forceinline__ unsigned cvtpk(float lo, float hi) {
    unsigned r; asm volatile("v_cvt_pk_bf16_f32 %0, %1, %2" : "=v"(r) : "v"(lo), "v"(hi)); return r;
}
__device__ __forceinline__ bf16x8 pack8(f32x4 a, f32x4 b) {
    u32x4 w = {cvtpk(a[0], a[1]), cvtpk(a[2], a[3]), cvtpk(b[0], b[1]), cvtpk(b[2], b[3])};
    return *reinterpret_cast<bf16x8*>(&w);
}
template <class T> __device__ __forceinline__ bf16x8 load8(const T* p) {
    if constexpr (same_t<T, float>::v) { return pack8(*(const f32x4*)p, *(const f32x4*)(p + 4)); }
    else { return *reinterpret_cast<const bf16x8*>(p); }
}
__device__ __forceinline__ void mask_tile(f32x16& p0, f32x16& p1, int dq, unsigned W) {
    const float NEG = -__builtin_inff();
#pragma unroll
    for (int r = 0; r < 16; ++r) {
        const int c = (r & 3) + 8 * (r >> 2);
        if ((unsigned)(dq - c) >= W) p0[r] = NEG;
        if ((unsigned)(dq - c - 32) >= W) p1[r] = NEG;
    }
}
__device__ __forceinline__ void partialSM(f32x16& p0, f32x16& p1, float& m_reg, float& mn, float& alpha) {
    float pmax = p0[0]; for (int r = 1; r < 16; ++r) pmax = fmaxf(pmax, p0[r]); for (int r = 0; r < 16; ++r) pmax = fmaxf(pmax, p1[r]);
    { auto rr = __builtin_amdgcn_permlane32_swap(__float_as_uint(pmax), __float_as_uint(pmax), false, false);
      pmax = fmaxf(__uint_as_float(rr[0]), __uint_as_float(rr[1])); }
    constexpr float C2 = 1.4426950408889634f * SCALE;
    if (__builtin_expect(__all((pmax - m_reg) * SCALE <= THR), 1)) { mn = m_reg; alpha = 1.f; }
    else { mn = fmaxf(m_reg, pmax); alpha = __builtin_amdgcn_exp2f((m_reg - mn) * C2); m_reg = mn; }
    const float mnL = -mn * C2;
    for (int r = 0; r < 16; ++r) p0[r] = fmaf(p0[r], C2, mnL); for (int r = 0; r < 16; ++r) p1[r] = fmaf(p1[r], C2, mnL);
    for (int r = 0; r < 16; ++r) p0[r] = __builtin_amdgcn_exp2f(p0[r]);
}
__device__ __forceinline__ void finishSM(f32x16& p0, f32x16& p1, float alpha, float& l_reg, bf16x8& pa0, bf16x8& pa1, bf16x8& pa2, bf16x8& pa3) {
    for (int r = 0; r < 16; ++r) p1[r] = __builtin_amdgcn_exp2f(p1[r]);
    float ps = 0; for (int r = 0; r < 16; ++r) ps += p0[r]; for (int r = 0; r < 16; ++r) ps += p1[r];
    { auto rr = __builtin_amdgcn_permlane32_swap(__float_as_uint(ps), __float_as_uint(ps), false, false);
      ps = __uint_as_float(rr[0]) + __uint_as_float(rr[1]); }
    l_reg = l_reg * alpha + ps;
#define PK4(P, B_, OUT) do { unsigned a0 = cvtpk(P[B_+0], P[B_+1]), a1 = cvtpk(P[B_+2], P[B_+3]);                          \
        unsigned b0 = cvtpk(P[B_+4], P[B_+5]), b1 = cvtpk(P[B_+6], P[B_+7]);                                             \
        auto r0 = __builtin_amdgcn_permlane32_swap(a0, b0, false, false); auto r1 = __builtin_amdgcn_permlane32_swap(a1, b1, false, false); \
        u32x4 w = {r0[0], r1[0], r0[1], r1[1]}; OUT = *reinterpret_cast<bf16x8*>(&w); } while (0)
    PK4(p0, 0, pa0); PK4(p0, 8, pa1); PK4(p1, 0, pa2); PK4(p1, 8, pa3);
#undef PK4
}
template <int KB, bool SK>
__device__ __forceinline__ void qkt(f32x16& p0, f32x16& p1, const char* K_lds, int r32, int hi, const bf16x8* qr, bool act) {
    if (SK && !act) { const float NEG = -__builtin_inff();
#pragma unroll
        for (int r = 0; r < 16; ++r) { p0[r] = NEG; p1[r] = NEG; } return; }
    p0 = f32x16{}; p1 = f32x16{};
    const char* kb[4];
#pragma unroll
    for (int dd = 0; dd < 4; ++dd) kb[dd] = K_lds + KB * SHM_K + KSWZ(r32, (dd * 16 + hi * 8) * 2);
#pragma unroll
    for (int d0 = 0; d0 < 8; ++d0) { const char* a = kb[d0 & 3] + (d0 >> 2) * 128;
        bf16x8 b0 = *reinterpret_cast<const bf16x8*>(a);
        bf16x8 b1 = *reinterpret_cast<const bf16x8*>(a + 32 * 256);
        p0 = __builtin_amdgcn_mfma_f32_32x32x16_bf16(b0, qr[d0], p0, 0, 0, 0);
        p1 = __builtin_amdgcn_mfma_f32_32x32x16_bf16(b1, qr[d0], p1, 0, 0, 0); }
}
template <int VB, bool SK>
__device__ __forceinline__ void pv_tile(f32x16* o, int vb0, bf16x8 pa0, bf16x8 pa1, bf16x8 pa2, bf16x8 pa3, bool act) {
    if (SK && !act) return;
#define TRRD(dst, off) asm volatile("ds_read_b64_tr_b16 %0, %1 offset:%2" : "=&v"(dst) : "v"(vb0), "i"(off) : "memory")
#define PV_D0(d0) do { s16x4 l0, l1, l2, l3, h0, h1, h2, h3; constexpr int b_ = VB * SHM_V + v_rd_off(d0, 0, 0);     \
        TRRD(l0, b_); TRRD(h0, b_ + 2048); TRRD(l1, b_ + 4096); TRRD(h1, b_ + 6144); TRRD(l2, b_ + 8192); TRRD(h2, b_ + 10240); TRRD(l3, b_ + 12288); TRRD(h3, b_ + 14336); \
        asm volatile("s_waitcnt lgkmcnt(0)" ::: "memory"); SBAR();                 \
        o[d0] = __builtin_amdgcn_mfma_f32_32x32x16_bf16(pa0, (bf16x8){l0[0], l0[1], l0[2], l0[3], h0[0], h0[1], h0[2], h0[3]}, o[d0], 0, 0, 0);   \
        o[d0] = __builtin_amdgcn_mfma_f32_32x32x16_bf16(pa1, (bf16x8){l1[0], l1[1], l1[2], l1[3], h1[0], h1[1], h1[2], h1[3]}, o[d0], 0, 0, 0);   \
        o[d0] = __builtin_amdgcn_mfma_f32_32x32x16_bf16(pa2, (bf16x8){l2[0], l2[1], l2[2], l2[3], h2[0], h2[1], h2[2], h2[3]}, o[d0], 0, 0, 0);   \
        o[d0] = __builtin_amdgcn_mfma_f32_32x32x16_bf16(pa3, (bf16x8){l3[0], l3[1], l3[2], l3[3], h3[0], h3[1], h3[2], h3[3]}, o[d0], 0, 0, 0); } while (0)
    PV_D0(0); PV_D0(1); PV_D0(2); PV_D0(3);
#undef PV_D0
#undef TRRD
}

template <class TIn, class TOut> struct BlockRef { const TIn* Q; const TIn* K; const TIn* V; TOut* O; int P0; };
template <class TIn> struct Seam {
    bf16x8 qr[8];
    bf16x8 st_v0, st_v1, st_k0, st_k1; f32x4 sf0, sf1, sf2, sf3;
    f32x4 tq[16];
};
__device__ __forceinline__ int swa_jlo(int P0, int W) { const int lowk = P0 - W + 1; return lowk > 0 ? lowk / KVBLK : 0; }
#define ROW(p, k0, rr) ((p) + (size_t)((k0) + (rr)) * D + sc)
#define VMW() asm volatile("s_waitcnt vmcnt(0)" ::: "memory")
#define VMWN(n) asm volatile("s_waitcnt vmcnt(%0)" :: "i"(n) : "memory")
#define SLOAD_H(Kp, Vp, k0) do { S.st_v0 = load8<TIn>(ROW(Vp, k0, sr)); S.st_v1 = load8<TIn>(ROW(Vp, k0, 32 + sr));              \
                         S.st_k0 = load8<TIn>(ROW(Kp, k0, sr)); S.st_k1 = load8<TIn>(ROW(Kp, k0, 32 + sr)); } while (0)
#define SWRITE_HK(bf) do { *(bf16x8*)(K_lds + (bf) * SHM_K + kws) = S.st_k0; *(bf16x8*)(K_lds + (bf) * SHM_K + kws + 32 * 256) = S.st_k1; } while (0)
#define SWRITE_HV(bf) do { *(bf16x8*)(V_lds + (bf) * SHM_V + vst0) = S.st_v0; *(bf16x8*)(V_lds + (bf) * SHM_V + vst1) = S.st_v1; } while (0)
#define SWRITE_H(bf) do { SWRITE_HV(bf); SWRITE_HK(bf); } while (0)
#define SLOAD_F(p, k0) do { S.sf0 = *(const f32x4*)ROW(p, k0, sr); S.sf1 = *(const f32x4*)(ROW(p, k0, sr) + 4);                \
                            S.sf2 = *(const f32x4*)ROW(p, k0, 32 + sr); S.sf3 = *(const f32x4*)(ROW(p, k0, 32 + sr) + 4); } while (0)
#define SWRITE_KF(bf) do { *(bf16x8*)(K_lds + (bf) * SHM_K + kws) = pack8(S.sf0, S.sf1); *(bf16x8*)(K_lds + (bf) * SHM_K + kws + 32 * 256) = pack8(S.sf2, S.sf3); } while (0)
#define SWRITE_VF(bf) do { *(bf16x8*)(V_lds + (bf) * SHM_V + vst0) = pack8(S.sf0, S.sf1); *(bf16x8*)(V_lds + (bf) * SHM_V + vst1) = pack8(S.sf2, S.sf3); } while (0)
template <class TIn, class TOut>
__device__ __forceinline__ void causal_swa_prime(const BlockRef<TIn, TOut>& cur, int W, char* lds, Seam<TIn>& S, const int wv) {
    constexpr bool F32 = same_t<TIn, float>::v;
    const int tid = ltid(wv), wid = __builtin_amdgcn_readfirstlane(tid >> 6), lane = tid & 63, r32 = lane & 31, hi = lane >> 5;
    const int sr = tid >> 4, sc = (tid & 15) * 8, kws = KSWZ(sr, sc * 2); char* K_lds = lds + 2 * SHM_V;
    const int kb0 = swa_jlo(cur.P0, W) * KVBLK;
    for (int d0 = 0; d0 < 8; ++d0) S.qr[d0] = load8<TIn>(cur.Q + (size_t)(wid * QBLK + r32) * D + d0 * 16 + hi * 8);
    if constexpr (F32) { SLOAD_F((const float*)cur.K, kb0); VMW(); SWRITE_KF(0); SBAR(); SLOAD_F((const float*)cur.V, kb0); }
    else { SLOAD_H(cur.K, cur.V, kb0); VMW(); SWRITE_HK(0); }
    __syncthreads();
}
template <class TIn, class TOut>
__device__ __forceinline__ void causal_swa_block(const BlockRef<TIn, TOut>& cur, const BlockRef<TIn, TOut>& nxt, int skv, int W, char* lds, Seam<TIn>& S, const int wv) {
    constexpr bool F32 = same_t<TIn, float>::v;
    const int tid = ltid(wv), wid = __builtin_amdgcn_readfirstlane(tid >> 6), lane = tid & 63, r32 = lane & 31, hi = lane >> 5;
    const int j_lo = swa_jlo(cur.P0, W);
    int j_hi = (cur.P0 + QB - 1) / KVBLK + 1; if (j_hi > skv / KVBLK) j_hi = skv / KVBLK;
    const int NT = j_hi - j_lo;
    const int kbn = swa_jlo(nxt.P0, W) * KVBLK;
    const int qlo = cur.P0 + wid * QBLK, qm = qlo + r32 - 4 * hi;
    char* V_lds = lds; char* K_lds = lds + 2 * SHM_V;
    float* ws = (float*)(lds + 2 * SHM_V + 2 * SHM_K) + wid * 64; float* li_l = ws, * al_l = ws + 32;
    float m_reg = -1e30f, l_reg = 0; f32x16 o[4] = {};
    const int sr = tid >> 4, sc = (tid & 15) * 8, vst0 = v_st(sr, sc), vst1 = v_st(32 + sr, sc), kws = KSWZ(sr, sc * 2);
    const int vb0 = (int)(uintptr_t)V_lds + v_rd_base(lane);
    const TIn* Kh = cur.K; const TIn* Vh = cur.V;
#define RESC(a) do { if (__any((a) < 1.f)) { if (hi == 0) al_l[r32] = (a); asm volatile("s_waitcnt lgkmcnt(0)" ::: "memory");              \
                     for (int d_ = 0; d_ < 4; ++d_) for (int r = 0; r < 16; ++r) o[d_][r] *= al_l[crow(r, hi)]; } } while (0)
#define KBASE(t) ((j_lo + (t)) * KVBLK)
#define ACT(t) (KBASE(t) <= qlo + QBLK - 1 && KBASE(t) + KVBLK - 1 >= qlo - W + 1)
#define MASKT(P0_, P1_, t) do { const int kb_ = KBASE(t); if ((!SK || ACT(t)) && (kb_ + KVBLK - 1 > qlo || kb_ <= qlo + QBLK - 1 - W)) mask_tile(P0_, P1_, qm - kb_, (unsigned)W); } while (0)
    constexpr int NQL = F32 ? 16 : 8;
    constexpr bool SK = WSKIP && !F32;
#define SEAM_K0() do { VMWN(NQL); if constexpr (F32) { SWRITE_KF(0); SBAR(); SLOAD_F((const float*)nxt.V, kbn); } else { SWRITE_HK(0); } SBAR(); } while (0)
    f32x16 pA0, pA1, pB0, pB1; float mnA, mnB, alA, alB; bf16x8 pa0, pa1, pa2, pa3;
    if constexpr (F32) { VMW(); SWRITE_VF(0); SBAR(); } else { SWRITE_HV(0); SBAR(); }
    if (NT > 1) { if constexpr (F32) SLOAD_F((const float*)Kh, KBASE(1)); else SLOAD_H(Kh, Vh, KBASE(1)); }
    SBAR(); qkt<0, SK>(pA0, pA1, K_lds, r32, hi, S.qr, ACT(0));
    if constexpr (F32) { if (NT > 1) { VMW(); SWRITE_KF(1); SBAR(); SLOAD_F((const float*)Vh, KBASE(1)); } }
    MASKT(pA0, pA1, 0); partialSM(pA0, pA1, m_reg, mnA, alA);
    if (NT > 1) { VMW(); if constexpr (F32) { SWRITE_VF(1); SBAR(); if (NT > 2) SLOAD_F((const float*)Kh, KBASE(2)); } else SWRITE_H(1); }
    __syncthreads();
#define HALF_STEP(PX0, PX1, mnX, alX, PY0, PY1, alY, t, KB, VB, SB) do {                                                      \
        SBAR(); qkt<KB, SK>(PX0, PX1, K_lds, r32, hi, S.qr, ACT(t));                                             \
        finishSM(PY0, PY1, alY, l_reg, pa0, pa1, pa2, pa3); SBAR();                                                           \
        if ((t) + 1 < NT) { if constexpr (F32) { VMW(); SWRITE_KF(SB); SBAR(); SLOAD_F((const float*)Vh, KBASE((t) + 1)); }  \
                            else { SLOAD_H(Kh, Vh, KBASE((t) + 1)); } SBAR(); }                                               \
        pv_tile<VB, SK>(o, vb0, pa0, pa1, pa2, pa3, ACT((t) - 1)); MASKT(PX0, PX1, (t)); partialSM(PX0, PX1, m_reg, mnX, alX);                                        \
        __syncthreads();                                                                                                      \
        if ((t) + 1 < NT) { VMW(); if constexpr (F32) { SWRITE_VF(SB); SBAR(); if ((t) + 2 < NT) SLOAD_F((const float*)Kh, KBASE((t) + 2)); } \
                            else { SWRITE_H(SB); } }                                                                          \
        RESC(alX); __syncthreads(); } while (0)
    for (int t = 1; t + 1 < NT; t += 2) {
        HALF_STEP(pB0, pB1, mnB, alB, pA0, pA1, alA, t, 1, 0, 0);
        HALF_STEP(pA0, pA1, mnA, alA, pB0, pB1, alB, t + 1, 0, 1, 1);
    }
    const bool even = (NT & 1) == 0;
    if (even) { SBAR(); qkt<1, SK>(pB0, pB1, K_lds, r32, hi, S.qr, ACT(NT - 1)); SBAR(); }
#define QROW(e) (nxt.Q + (size_t)(wid * QBLK + r32) * D + ((e) >> 1) * 16 + hi * 8 + ((e) & 1) * 4)
    if constexpr (F32) { SLOAD_F((const float*)nxt.K, kbn); SBAR();
#pragma unroll
        for (int e = 0; e < 8; ++e) S.tq[e] = *(const f32x4*)QROW(e); }
    else { SLOAD_H(nxt.K, nxt.V, kbn); SBAR();
#pragma unroll
        for (int d0 = 0; d0 < 8; ++d0) S.qr[d0] = load8<TIn>(nxt.Q + (size_t)(wid * QBLK + r32) * D + d0 * 16 + hi * 8); }
    SBAR();
    finishSM(pA0, pA1, alA, l_reg, pa0, pa1, pa2, pa3); SBAR();
    if constexpr (F32) {
#pragma unroll
        for (int e = 8; e < 16; ++e) S.tq[e] = *(const f32x4*)QROW(e); SBAR(); }
#undef QROW
    pv_tile<0, SK>(o, vb0, pa0, pa1, pa2, pa3, ACT(even ? NT - 2 : NT - 1));
    if (even) { MASKT(pB0, pB1, NT - 1); partialSM(pB0, pB1, m_reg, mnB, alB); __syncthreads(); RESC(alB);
        finishSM(pB0, pB1, alB, l_reg, pa0, pa1, pa2, pa3); SBAR(); pv_tile<1, SK>(o, vb0, pa0, pa1, pa2, pa3, ACT(NT - 1)); }
    SBAR(); SEAM_K0();
    if (hi == 0) li_l[r32] = l_reg; asm volatile("s_waitcnt lgkmcnt(0)" ::: "memory");
    float rli[16];
#pragma unroll
    for (int r = 0; r < 16; ++r) rli[r] = __builtin_amdgcn_rcpf(li_l[crow(r, hi)]);
    TOut* Ow = cur.O + (size_t)(wid * QBLK) * D;
#pragma unroll
    for (int r = 0; r < 16; ++r) { const int orow = crow(r, hi);
#pragma unroll
        for (int d0 = 0; d0 < 4; ++d0) { const float v = o[d0][r] * rli[r];
            if constexpr (same_t<TOut, float>::v) { Ow[(size_t)orow * D + d0 * 32 + r32] = v; }
            else { const float vn = sw_xor<1>(v);
                   if ((r32 & 1) == 0) *(unsigned*)(Ow + (size_t)orow * D + d0 * 32 + r32) = cvtpk(v, vn); } } }
    if constexpr (F32) {
#pragma unroll
        for (int d0 = 0; d0 < 8; ++d0) S.qr[d0] = pack8(S.tq[2 * d0], S.tq[2 * d0 + 1]); }
    __syncthreads();
#undef RESC
#undef KBASE
#undef ACT
#undef MASKT
#undef SEAM_K0
#undef HALF_STEP
}
#undef ROW
#undef VMW
#undef VMWN
#undef SLOAD_H
#undef SWRITE_HK
#undef SWRITE_HV
#undef SWRITE_H
#undef SLOAD_F
#undef SWRITE_KF
#undef SWRITE_VF
#undef KSWZ
#undef SBAR
}

#define MFMA16(a, b, c) __builtin_amdgcn_mfma_f32_16x16x32_bf16((a), (b), (c), 0, 0, 0)
#define MFMA32(a, b, c) __builtin_amdgcn_mfma_f32_32x32x16_bf16((a), (b), (c), 0, 0, 0)
#define WSP(T_, off) ((T_*)(p->ws + (off)))

DI void sincos_red(double r, float& s, float& c) {
    const double r2 = r * r; double sp = 1.0, cp = 1.0;
#pragma unroll
    for (int k = 13; k >= 1; --k) { sp = 1.0 - sp * r2 * (1.0 / (double)((2 * k) * (2 * k + 1))); cp = 1.0 - cp * r2 * (1.0 / (double)((2 * k - 1) * (2 * k))); }
    s = (float)(r * sp); c = (float)cp;
}

DI void cvt_wt_job(const float* src, bf16_t* dst, int N, int Npad, int nperm, float* tile, const int wv) {
    const int tid = ltid(wv), K = 2048, ntn = Npad / 64, ntiles = ntn * (K / 64), c = tid & 63, r0 = tid >> 6;
#define CW_LOAD(V, tl_) do { const int tn_ = (tl_) % ntn, tk_ = (tl_) / ntn, k0_ = tk_ * 64, n_ = tn_ * 64 + c; int ns_ = n_; \
        if (ns_ < nperm) { const int p7 = ns_ & 127, u = p7 >> 3, e = p7 & 7; ns_ = (ns_ & ~127) + ((e < 4) ? 4 * u + e : 64 + 4 * u + (e - 4)); } \
        _Pragma("unroll") for (int i = 0; i < 8; ++i) V[i] = (n_ < N) ? src[(size_t)(k0_ + r0 + 8 * i) * N + ns_] : 0.f; } while (0)
    float cur[8];
    if ((int)blockIdx.x < ntiles) CW_LOAD(cur, (int)blockIdx.x);
    for (int tl = blockIdx.x; tl < ntiles; tl += gridDim.x) {
        const int tn = tl % ntn, tk = tl / ntn, k0 = tk * 64, n0 = tn * 64;
        float nxt[8];
        const int tl2 = (tl + (int)gridDim.x < ntiles) ? tl + (int)gridDim.x : tl;
        CW_LOAD(nxt, tl2);
#pragma unroll
        for (int i = 0; i < 8; ++i) tile[(r0 + 8 * i) * 65 + c] = cur[i];
        lds_barrier();
#pragma unroll
        for (int i = 0; i < 4; ++i) { const int id = tid + 512 * i, rr = id >> 5, cp = id & 31;
            ((unsigned*)dst)[((size_t)(n0 + rr) * K + k0) / 2 + cp] = cvt_pk_bf16(tile[(2 * cp) * 65 + rr], tile[(2 * cp + 1) * 65 + rr]); }
        lds_barrier();
#pragma unroll
        for (int i = 0; i < 8; ++i) cur[i] = nxt[i];
    }
#undef CW_LOAD
}

DI void ph_prologue(PK p, unsigned char* lds, const int wv) {
    PK_FRESH(p);
    const int tid = ltid(wv), lane = tid & 63, wave = __builtin_amdgcn_readfirstlane(tid >> 6);
    float* ldsf = (float*)lds;
    {
        float* sc = ldsf; float* red = ldsf + 4096;
        for (int i = tid; i < 4096; i += 512) sc[i] = silu_f(p->in[1][i]);
        __syncthreads();
        float* mod = WSP(float, WS_MOD);
        for (int item = blockIdx.x; item < MODC / 64; item += gridDim.x) {
            const int col0 = item * 64, col = col0 + lane;
            const float* W; size_t stride;
            if (col0 < 4 * 12288) { const int l = col0 / 12288, j = col - l * 12288; W = p->in[3] + (size_t)l * 2048 * 12288 + j; stride = 12288; }
            else { W = p->in[14] + (col - 4 * 12288); stride = 4096; }
            float a0 = 0.f, a1 = 0.f;
            const int kb = wave * 256;
            float wa[16], wb[16];
#pragma unroll
            for (int u = 0; u < 16; ++u) wa[u] = W[(size_t)(kb + u) * stride];
            for (int k = 0; k < 256; k += 32) {
#pragma unroll
                for (int u = 0; u < 16; ++u) wb[u] = W[(size_t)(kb + k + 16 + u) * stride];
#pragma unroll
                for (int u = 0; u < 16; ++u) { a0 += sc[kb + k + u] * wa[u]; a1 += sc[2048 + kb + k + u] * wa[u]; }
                const int kn = (k + 32 < 256) ? k + 32 : k;
#pragma unroll
                for (int u = 0; u < 16; ++u) wa[u] = W[(size_t)(kb + kn + u) * stride];
#pragma unroll
                for (int u = 0; u < 16; ++u) { a0 += sc[kb + k + 16 + u] * wb[u]; a1 += sc[2048 + kb + k + 16 + u] * wb[u]; }
            }
            red[(wave * 64 + lane) * 2 + 0] = a0; red[(wave * 64 + lane) * 2 + 1] = a1;
            __syncthreads();
            if (tid < 128) { const int ln = tid & 63, b = tid >> 6; float s = 0.f;
#pragma unroll
                for (int w = 0; w < 8; ++w) s += red[(w * 64 + ln) * 2 + b];
                const int cc = col0 + ln; const float bias = (cc < 4 * 12288) ? p->in[4][cc] : p->in[15][cc - 4 * 12288];
                mod[(size_t)b * MODC + cc] = s + bias; }
            __syncthreads();
        }
    }
    for (int job = 0; job < 9; ++job) {
        const float* src; bf16_t* dst; int N = 2048, Npad = 2048, nperm = 0;
        if (job < 2) { src = p->in[7] + (size_t)job * 2048 * GIN; dst = WSP(bf16_t, WS_WIN) + (size_t)job * GINP * 2048; N = GIN; Npad = GINP; }
        else if (job < 4) { src = p->in[12] + (size_t)(job - 2) * 2048 * 2048; dst = WSP(bf16_t, WS_WOUT) + (size_t)(job - 2) * 2048 * 2048; }
        else if (job == 4) { src = p->in[16]; dst = WSP(bf16_t, WS_KVW); N = 4096; Npad = 4096; nperm = 2048; }
        else if (job < 7) { src = p->in[17] + (size_t)(job - 5) * 2048 * 2048; dst = WSP(bf16_t, WS_DWQ) + (size_t)(job - 5) * 2048 * 2048; nperm = 2048; }
        else { src = p->in[20] + (size_t)(job - 7) * 2048 * 2048; dst = WSP(bf16_t, WS_DWO) + (size_t)(job - 7) * 2048 * 2048; }
        cvt_wt_job(src, dst, N, Npad, nperm, ldsf, wv);
    }
    {
        const int lane = tid & 63, r16 = lane & 15, quad = lane >> 4;
        bf16_t* wdst = WSP(bf16_t, WS_PWQ);
        for (int task = (blockIdx.x * 8 + wave); task < 4 * 16 * 128; task += gridDim.x * 8) {
            const int kt = task & 127, pj = (task >> 7) & 15, l = task >> 11, pp = pj >> 1, jh = pj & 1;
            const float* wq = p->in[21] + ((size_t)l * 2048 + kt * 16 + r16) * 2048 + pp * 256 + jh * 128 + quad * 8;
            const float* ky = p->in[22] + ((size_t)(l * 2 + jh) * 128 + r16) * 128 + quad * 8;
            bf16x8 bw[4];
#pragma unroll
            for (int ks = 0; ks < 4; ++ks) { const f32x4 a = *(const f32x4*)(wq + ks * 32), b = *(const f32x4*)(wq + ks * 32 + 4);
                u32x4 w; w.x = cvt_pk_bf16(a[0], a[1]); w.y = cvt_pk_bf16(a[2], a[3]); w.z = cvt_pk_bf16(b[0], b[1]); w.w = cvt_pk_bf16(b[2], b[3]); bw[ks] = __builtin_bit_cast(bf16x8, w); }
#pragma unroll
            for (int nt = 0; nt < 8; ++nt) { f32x4 acc = {0.f, 0.f, 0.f, 0.f};
#pragma unroll
                for (int ks = 0; ks < 4; ++ks) { const f32x4 a = *(const f32x4*)(ky + (size_t)nt * 16 * 128 + ks * 32), b = *(const f32x4*)(ky + (size_t)nt * 16 * 128 + ks * 32 + 4);
                    u32x4 w; w.x = cvt_pk_bf16(a[0], a[1]); w.y = cvt_pk_bf16(a[2], a[3]); w.z = cvt_pk_bf16(b[0], b[1]); w.w = cvt_pk_bf16(b[2], b[3]);
                    acc = MFMA16(bw[ks], __builtin_bit_cast(bf16x8, w), acc); }
                u32x2 wo; wo.x = cvt_pk_bf16(acc[0], acc[1]); wo.y = cvt_pk_bf16(acc[2], acc[3]);
                *(u32x2*)(wdst + ((size_t)l * 2048 + pp * 256 + jh * 128 + nt * 16 + r16) * 2048 + kt * 16 + quad * 4) = wo; }
        }
    }
    {
        float* cosT = WSP(float, WS_COS); float* sinT = WSP(float, WS_SIN); const int* pos = (const int*)p->in[2];
        for (int idx = blockIdx.x * 512 + tid; idx < T * 64; idx += gridDim.x * 512) {
            const int t = idx >> 6, j = idx & 63;
            const double inv = exp(-(double)j * (9.210340371976184 / 64.0));
            const double ang = (double)pos[t] * inv;
            const double n = rint(ang * 0.15915494309189535);
            double r = fma(-n, 6.283185307179586, ang); r = fma(-n, 2.4492935982947064e-16, r);
            float s, c; sincos_red(r, s, c); cosT[idx] = c; sinT[idx] = s;
        }
    }
}

template <int MODE>
DI void ph_norm(const float* x, const bf16_t* xb, const float* g, const float* shift, const float* scale, bf16_t* dstb, float* dstf, const int wv) {
    const int tid = ltid(wv), lane = tid & 63, wave = __builtin_amdgcn_readfirstlane(tid >> 6);
    for (int row = blockIdx.x * 8 + wave; row < T; row += gridDim.x * 8) {
        const int b = row >> 13;
        f32x4 v[8]; float ss = 0.f;
#pragma unroll
        for (int i = 0; i < 8; ++i) {
            if (MODE == 2) { const u32x2 w = *(const u32x2*)(xb + (size_t)row * D + i * 256 + lane * 4); v[i] = (f32x4){bflo(w.x), bfhi(w.x), bflo(w.y), bfhi(w.y)}; }
            else v[i] = *(const f32x4*)(x + (size_t)row * D + i * 256 + lane * 4);
            ss += v[i][0] * v[i][0] + v[i][1] * v[i][1] + v[i][2] * v[i][2] + v[i][3] * v[i][3]; }
        ss = wave_sum(ss);
        const float r = rsqrtf(ss * (1.f / D) + NORM_EPS);
#pragma unroll
        for (int i = 0; i < 8; ++i) { const int col = i * 256 + lane * 4; const f32x4 gv = *(const f32x4*)(g + col);
            if (MODE != 1) { const f32x4 sh = *(const f32x4*)(shift + (size_t)b * MODC + col), sc = *(const f32x4*)(scale + (size_t)b * MODC + col);
                f32x4 y;
#pragma unroll
                for (int e = 0; e < 4; ++e) y[e] = v[i][e] * r * gv[e] * (1.f + sc[e]) + sh[e];
                u32x2 w; w.x = cvt_pk_bf16(y[0], y[1]); w.y = cvt_pk_bf16(y[2], y[3]); *(u32x2*)(dstb + (size_t)row * D + col) = w; }
            else { f32x4 y;
#pragma unroll
                for (int e = 0; e < 4; ++e) y[e] = v[i][e] * r * gv[e];
                *(f32x4*)(dstf + (size_t)row * D + col) = y; } }
    }
}

DI void pc_load(PK p, int l, int row, f32x4 (&v)[8], const int lane) {
    const float* s = ((row >= 16384) ? p->in[24] : p->in[23]) + ((size_t)l * 16384 + (row & 16383)) * 2048;
#pragma unroll
    for (int i = 0; i < 8; ++i) v[i] = *(const f32x4*)(s + lane * 32 + i * 4);
}
DI void pc_store(PK p, int row, const f32x4 (&v)[8], const int lane) {
    const bool second = row >= 16384; const int r = row & 16383;
    unsigned char* dq = WSP(unsigned char, second ? WS_PV : WS_PU); unsigned short* ds = WSP(unsigned short, WS_PUS);
    float m0 = 0.f;
#pragma unroll
    for (int i = 0; i < 8; ++i) { const float mm = fmaxf(fmaxf(fabsf(v[i][0]), fabsf(v[i][1])), fmaxf(fabsf(v[i][2]), fabsf(v[i][3]))); m0 = fmaxf(m0, mm); }
    m0 = fmaxf(m0, sw_xor<1>(m0)); m0 = fmaxf(m0, sw_xor<2>(m0));
    const bf16_t sb0 = (m0 > 0.f) ? f2bf(m0 * (1.004f / 6.f)) : (bf16_t)0x3f80;
    const float inv = 1.f / bf2f(sb0);
    u32x4 w;
#pragma unroll
    for (int c = 0; c < 4; ++c) { unsigned x = 0u;
        x = __builtin_amdgcn_cvt_scalef32_pk_fp4_f32(x, v[2 * c][0] * inv, v[2 * c][1] * inv, 1.0f, 0);
        x = __builtin_amdgcn_cvt_scalef32_pk_fp4_f32(x, v[2 * c][2] * inv, v[2 * c][3] * inv, 1.0f, 1);
        x = __builtin_amdgcn_cvt_scalef32_pk_fp4_f32(x, v[2 * c + 1][0] * inv, v[2 * c + 1][1] * inv, 1.0f, 2);
        x = __builtin_amdgcn_cvt_scalef32_pk_fp4_f32(x, v[2 * c + 1][2] * inv, v[2 * c + 1][3] * inv, 1.0f, 3);
        w[c] = x; }
    *(u32x4*)(dq + (size_t)r * 1024 + lane * 16) = w;
    if ((lane & 3) == 0) ds[((size_t)r * 16 + (lane >> 2)) * 2 + (second ? 1 : 0)] = (unsigned short)sb0;
}
DI void ph_peer_cvt(PK p, int l, const int wv) {
    PK_FRESH(p);
    const int tid = ltid(wv), lane = tid & 63, wave = __builtin_amdgcn_readfirstlane(tid >> 6);
    for (int row = blockIdx.x * 8 + wave; row < 2 * 16384; row += gridDim.x * 8) { f32x4 v[8]; pc_load(p, l, row, v, lane); pc_store(p, row, v, lane); }
}


template <int I, int J>
DI void tinv_block(const bf16_t* Lb, bf16_t* Ti, bf16_t* TT, bf16_t* XT, const int r16, const int quad) {
    constexpr int nK = 16 * (I - J);
    const bf16x8 zero8 = {0, 0, 0, 0, 0, 0, 0, 0};
    f32x4 acc = {0.f, 0.f, 0.f, 0.f};
#pragma unroll
    for (int ks = 0; ks < (nK + 31) / 32; ++ks) {
        const int k0 = ks * 32 + quad * 8; const bool valid = k0 < nK;
        const bf16x8 a = valid ? *(const bf16x8*)(Lb + (16 * I + r16) * 72 + 16 * J + k0) : zero8;
        const bf16x8 b = valid ? *(const bf16x8*)(TT + (16 * J + r16) * 72 + 16 * J + k0) : zero8;
        acc = MFMA16(a, b, acc);
    }
    { u32x2 w; w.x = cvt_pk_bf16(acc[0], acc[1]); w.y = cvt_pk_bf16(acc[2], acc[3]); *(u32x2*)(XT + r16 * 24 + quad * 4) = w; }
    asm volatile("s_waitcnt lgkmcnt(0)" ::: "memory");
    const bool v2 = quad < 2;
    const bf16x8 a2 = v2 ? *(const bf16x8*)(Ti + (16 * I + r16) * 72 + 16 * I + quad * 8) : zero8;
    const bf16x8 b2 = v2 ? *(const bf16x8*)(XT + r16 * 24 + quad * 8) : zero8;
    f32x4 m = {0.f, 0.f, 0.f, 0.f};
    m = MFMA16(a2, b2, m);
#pragma unroll
    for (int r = 0; r < 4; ++r) Ti[(16 * I + quad * 4 + r) * 72 + 16 * J + r16] = f2bf(-m[r]);
    { u32x2 w; w.x = cvt_pk_bf16(-m[0], -m[1]); w.y = cvt_pk_bf16(-m[2], -m[3]); *(u32x2*)(TT + (16 * J + r16) * 72 + 16 * I + quad * 4) = w; }
    asm volatile("s_waitcnt lgkmcnt(0)" ::: "memory");
}

DI void ph_gdn_p1(PK p, int l, unsigned char* lds, const int wv) {
    PK_FRESH(p);
    const bf16_t* proj = WSP(const bf16_t, WS_PROJ);
    const float* convw = p->in[8] + (size_t)l * 4 * 6144; const float* alog = p->in[9] + l * 16; const float* dtb = p->in[10] + l * 16;
    bf16_t* Ag = WSP(bf16_t, WS_GA); bf16_t* Bg = WSP(bf16_t, WS_GB); bf16_t* Qg = WSP(bf16_t, WS_GQ); bf16_t* Og = WSP(bf16_t, WS_GO); float* glg = WSP(float, WS_GL);
    bf16_t* qb  = (bf16_t*)(lds + 0);
    bf16_t* kb  = (bf16_t*)(lds + 17408);
    bf16_t* Lb  = (bf16_t*)(lds + 34816);
    bf16_t* wT  = (bf16_t*)(lds + 17408);
    bf16_t* vbT = (bf16_t*)(lds + 44032);
    bf16_t* kdT = (bf16_t*)(lds + 62464);
    bf16_t* kbT = (bf16_t*)(lds + 80896);
    bf16_t* uT  = (bf16_t*)(lds + 80896);
    bf16_t* aqk = (bf16_t*)(lds + 99328);
    bf16_t* Ti  = (bf16_t*)(lds + 108544);
    bf16_t* TT  = (bf16_t*)(lds + 117760);
    float*  Ld  = (float*)(lds + 126976);
    bf16_t* XT  = (bf16_t*)(lds + 132096);
    float*  sc  = (float*)(lds + 133120);
    float*  cw  = (float*)(lds + 134144);
    int cached_bh = -1;
    u32x4 rawp[3][5]; float pa_[4] = {0.f, 0.f, 0.f, 0.f}, pb_[4] = {0.f, 0.f, 0.f, 0.f};
#define P1_PREFETCH(itx) do { const int tid_ = ltid(wv), bh_ = (itx) & 31, n_ = (itx) >> 5, hd_ = bh_ & 15, b_ = bh_ >> 4, c16_ = tid_ & 15, t0_ = (tid_ >> 4) * 2; \
        _Pragma("unroll") for (int part = 0; part < 3; ++part) _Pragma("unroll") for (int r = 0; r < 5; ++r) { const int sp = n_ * 64 + t0_ - 3 + r; u32x4 raw = {0u, 0u, 0u, 0u}; \
            if (sp >= 0) raw = *(const u32x4*)(proj + (size_t)(b_ * SEQ + sp) * GINP + part * 2048 + hd_ * 128 + c16_ * 8); rawp[part][r] = raw; } \
        if (tid_ < 64) { const float* pab = WSP(const float, WS_PAB) + (size_t)(b_ * SEQ + n_ * 64 + tid_) * 32 + hd_; const size_t qs = (size_t)T * 32; \
            _Pragma("unroll") for (int q4 = 0; q4 < 4; ++q4) { pa_[q4] = pab[q4 * qs]; pb_[q4] = pab[q4 * qs + 16]; } } } while (0)
    if ((int)blockIdx.x < 4096) P1_PREFETCH((int)blockIdx.x);
    for (int it = blockIdx.x; it < 4096; it += gridDim.x) {
        const int tid = ltid(wv), lane = tid & 63, wave = __builtin_amdgcn_readfirstlane(tid >> 6), r16 = lane & 15, quad = lane >> 4;
        const int bh = it & 31, n = it >> 5, hd = bh & 15, b = bh >> 4, tok0 = b * SEQ + n * 64, ci = bh * 128 + n;
        if (bh != cached_bh) {
            for (int idx = tid; idx < 1536; idx += 512) { const int part = idx >> 9, tap = (idx >> 7) & 3, c = idx & 127; cw[idx] = convw[tap * 6144 + part * 2048 + hd * 128 + c]; }
            cached_bh = bh;
            lds_barrier();
        }
        float dtbv = 0.f, alogv = 0.f;
        if (tid < 64) { dtbv = dtb[hd]; alogv = alog[hd]; }
        {
            const int c16 = tid & 15, t0 = (tid >> 4) * 2;
#pragma unroll
            for (int part = 0; part < 3; ++part) {
                const int ch = part * 2048 + hd * 128 + c16 * 8;
                float xr[5][8];
#pragma unroll
                for (int r = 0; r < 5; ++r) {
                    const u32x4 raw = rawp[part][r];
                    xr[r][0] = bflo(raw.x); xr[r][1] = bfhi(raw.x); xr[r][2] = bflo(raw.y); xr[r][3] = bfhi(raw.y); xr[r][4] = bflo(raw.z); xr[r][5] = bfhi(raw.z); xr[r][6] = bflo(raw.w); xr[r][7] = bfhi(raw.w);
                }
                float wt[4][8];
#pragma unroll
                for (int tap = 0; tap < 4; ++tap) { const f32x4 w0 = *(const f32x4*)(cw + (part * 4 + tap) * 128 + c16 * 8), w1 = *(const f32x4*)(cw + (part * 4 + tap) * 128 + c16 * 8 + 4);
                    wt[tap][0] = w0[0]; wt[tap][1] = w0[1]; wt[tap][2] = w0[2]; wt[tap][3] = w0[3]; wt[tap][4] = w1[0]; wt[tap][5] = w1[1]; wt[tap][6] = w1[2]; wt[tap][7] = w1[3]; }
                float av[2][8];
#pragma unroll
                for (int u = 0; u < 2; ++u) {
                    float ss = 0.f;
#pragma unroll
                    for (int e = 0; e < 8; ++e) { float a = wt[0][e] * xr[u][e]; a = fmaf(wt[1][e], xr[u + 1][e], a); a = fmaf(wt[2][e], xr[u + 2][e], a); a = fmaf(wt[3][e], xr[u + 3][e], a);
                        a = silu_f(a); av[u][e] = a; ss += a * a; }
                    if (part < 2) {
                        ss = row_sum16(ss);
                        const float r = rsqrtf(ss + NORM_EPS) * (part == 0 ? 0.08838834764831845f : 1.f);
                        u32x4 w; w.x = cvt_pk_bf16(av[u][0] * r, av[u][1] * r); w.y = cvt_pk_bf16(av[u][2] * r, av[u][3] * r); w.z = cvt_pk_bf16(av[u][4] * r, av[u][5] * r); w.w = cvt_pk_bf16(av[u][6] * r, av[u][7] * r);
                        *(u32x4*)((part == 0 ? qb : kb) + (t0 + u) * 136 + c16 * 8) = w;
                    }
                }
                if (part == 2) {
#pragma unroll
                    for (int e = 0; e < 8; ++e) *(unsigned*)(vbT + (c16 * 8 + e) * 72 + t0) = cvt_pk_bf16(av[0][e], av[1][e]);
                }
            }
        }
        if (tid < 64) {
            const int t = tid;
            const float av = (pa_[0] + pa_[1]) + (pa_[2] + pa_[3]), bv = (pb_[0] + pb_[1]) + (pb_[2] + pb_[3]);
            const float xx = av + dtbv;
            const float ex = __expf(xx); const float sp = (xx > 20.f) ? xx : ((xx < -8.f) ? ex * (1.f - 0.5f * ex) : __logf(1.f + ex));
            const float g = -__expf(alogv) * sp;
            const float beta = __builtin_amdgcn_rcpf(1.f + __expf(-bv));
            float G = g;
            G += __int_as_float(__builtin_amdgcn_update_dpp(0, __float_as_int(G), 0x111, 0xF, 0xF, true)); G += __int_as_float(__builtin_amdgcn_update_dpp(0, __float_as_int(G), 0x112, 0xF, 0xF, true));
            G += __int_as_float(__builtin_amdgcn_update_dpp(0, __float_as_int(G), 0x114, 0xF, 0xF, true)); G += __int_as_float(__builtin_amdgcn_update_dpp(0, __float_as_int(G), 0x118, 0xF, 0xF, true));
            G += dpp_mov<0x142, 0xA>(G); G += dpp_mov<0x143, 0xC>(G);
            const float Gl = __int_as_float(__builtin_amdgcn_readlane(__float_as_int(G), 63));
            sc[t] = beta; sc[64 + t] = G; sc[128 + t] = __expf(G); sc[192 + t] = __expf(Gl - G);
            if (t == 63) glg[ci] = __expf(G);
        }
        lds_barrier();
        {
            const int which = wave >> 2, mi = wave & 3;
#pragma unroll
            for (int ni = 0; ni < 4; ++ni) {
                if (which == 0 ? (ni >= mi) : (ni <= mi)) {
                    f32x4 acc = {0.f, 0.f, 0.f, 0.f};
                    const bf16_t* Ab = (which ? qb : kb) + (mi * 16 + r16) * 136 + quad * 8;
                    const bf16_t* Bb = kb + (ni * 16 + r16) * 136 + quad * 8;
#pragma unroll
                    for (int ks = 0; ks < 4; ++ks) acc = MFMA16(*(const bf16x8*)(Ab + ks * 32), *(const bf16x8*)(Bb + ks * 32), acc);
                    const int cidx = ni * 16 + r16; const float Gc = sc[64 + cidx];
                    if (which == 0) {
                        const float bi = sc[cidx]; f32x4 lv;
#pragma unroll
                        for (int r = 0; r < 4; ++r) { const int jj = mi * 16 + quad * 4 + r; lv[r] = (jj < cidx) ? bi * acc[r] * __expf(fminf(Gc - sc[64 + jj], 0.f)) : 0.f; }
                        if (ni == mi) *(f32x4*)(Ld + mi * 320 + r16 * 20 + quad * 4) = lv;
                        else { u32x2 w; w.x = cvt_pk_bf16(lv[0], lv[1]); w.y = cvt_pk_bf16(lv[2], lv[3]); *(u32x2*)(Lb + cidx * 72 + mi * 16 + quad * 4) = w; }
                    } else {
#pragma unroll
                        for (int r = 0; r < 4; ++r) { const int ii = mi * 16 + quad * 4 + r; aqk[ii * 72 + cidx] = f2bf((cidx <= ii) ? acc[r] * __expf(fminf(sc[64 + ii] - Gc, 0.f)) : 0.f); }
                    }
                } else if (which == 1) {
#pragma unroll
                    for (int r = 0; r < 4; ++r) aqk[(mi * 16 + quad * 4 + r) * 72 + ni * 16 + r16] = 0;
                }
            }
        }
        lds_barrier();
        if (wave != 0) {
            for (int it3 = tid - 64; it3 < 1024; it3 += 448) { const int a = it3 & 127, t0 = (it3 >> 7) * 8; float v[8];
#pragma unroll
                for (int e = 0; e < 8; ++e) v[e] = bf2f(kb[(t0 + e) * 136 + a]);
                u32x4 w; w.x = cvt_pk_bf16(v[0], v[1]); w.y = cvt_pk_bf16(v[2], v[3]); w.z = cvt_pk_bf16(v[4], v[5]); w.w = cvt_pk_bf16(v[6], v[7]);
                *(u32x4*)(kbT + a * 72 + t0) = w;
#pragma unroll
                for (int e = 0; e < 8; ++e) v[e] *= sc[192 + t0 + e];
                w.x = cvt_pk_bf16(v[0], v[1]); w.y = cvt_pk_bf16(v[2], v[3]); w.z = cvt_pk_bf16(v[4], v[5]); w.w = cvt_pk_bf16(v[6], v[7]);
                *(u32x4*)(kdT + a * 72 + t0) = w; }
        }
        if (wave == 0) {
            const float* Lrow = Ld + quad * 320;
            float x[16];
#pragma unroll
            for (int i = 0; i < 16; ++i) { float s = (i == r16) ? 1.f : 0.f;
#pragma unroll
                for (int j = 0; j < i; ++j) s -= Lrow[i * 20 + j] * x[j];
                x[i] = s; }
#pragma unroll
            for (int i = 0; i < 16; ++i) Ti[(16 * quad + i) * 72 + 16 * quad + r16] = f2bf(x[i]);
            { u32x4 w0, w1; w0.x = cvt_pk_bf16(x[0], x[1]); w0.y = cvt_pk_bf16(x[2], x[3]); w0.z = cvt_pk_bf16(x[4], x[5]); w0.w = cvt_pk_bf16(x[6], x[7]);
              w1.x = cvt_pk_bf16(x[8], x[9]); w1.y = cvt_pk_bf16(x[10], x[11]); w1.z = cvt_pk_bf16(x[12], x[13]); w1.w = cvt_pk_bf16(x[14], x[15]);
              *(u32x4*)(TT + (16 * quad + r16) * 72 + 16 * quad) = w0; *(u32x4*)(TT + (16 * quad + r16) * 72 + 16 * quad + 8) = w1; }
            asm volatile("s_waitcnt lgkmcnt(0)" ::: "memory");
            tinv_block<1, 0>(Lb, Ti, TT, XT, r16, quad); tinv_block<2, 1>(Lb, Ti, TT, XT, r16, quad); tinv_block<3, 2>(Lb, Ti, TT, XT, r16, quad);
            tinv_block<2, 0>(Lb, Ti, TT, XT, r16, quad); tinv_block<3, 1>(Lb, Ti, TT, XT, r16, quad);
            tinv_block<3, 0>(Lb, Ti, TT, XT, r16, quad);
        }
        lds_barrier();
        {
            const int i = tid >> 3, t0 = (tid & 7) * 8; const bool low = (t0 >> 4) <= (i >> 4);
            const u32x4 raw = *(const u32x4*)(Ti + i * 72 + t0);
            float v[8] = {bflo(raw.x), bfhi(raw.x), bflo(raw.y), bfhi(raw.y), bflo(raw.z), bfhi(raw.z), bflo(raw.w), bfhi(raw.w)}; float tw[8], tu[8];
#pragma unroll
            for (int e = 0; e < 8; ++e) { const float be = sc[t0 + e]; tu[e] = low ? v[e] * be : 0.f; tw[e] = low ? v[e] * be * sc[128 + t0 + e] : 0.f; }
            u32x4 w; w.x = cvt_pk_bf16(tw[0], tw[1]); w.y = cvt_pk_bf16(tw[2], tw[3]); w.z = cvt_pk_bf16(tw[4], tw[5]); w.w = cvt_pk_bf16(tw[6], tw[7]);
            u32x4 u; u.x = cvt_pk_bf16(tu[0], tu[1]); u.y = cvt_pk_bf16(tu[2], tu[3]); u.z = cvt_pk_bf16(tu[4], tu[5]); u.w = cvt_pk_bf16(tu[6], tu[7]);
            *(u32x4*)(Ti + i * 72 + t0) = w; *(u32x4*)(TT + i * 72 + t0) = u;
        }
        lds_barrier();
#pragma unroll
        for (int pass = 0; pass < 2; ++pass) {
            const bf16_t* Aop = pass ? TT : Ti; const bf16_t* Bop = pass ? vbT : kbT; bf16_t* outT = pass ? uT : wT;
            f32x4 acc4[4];
#pragma unroll
            for (int mi = 0; mi < 4; ++mi) { f32x4 acc = {0.f, 0.f, 0.f, 0.f};
#pragma unroll
                for (int ks = 0; ks < 2; ++ks) acc = MFMA16(*(const bf16x8*)(Aop + (mi * 16 + r16) * 72 + ks * 32 + quad * 8), *(const bf16x8*)(Bop + (wave * 16 + r16) * 72 + ks * 32 + quad * 8), acc);
                acc4[mi] = acc; }
            if (pass == 1) lds_barrier();
#pragma unroll
            for (int mi = 0; mi < 4; ++mi) { u32x2 w; w.x = cvt_pk_bf16(acc4[mi][0], acc4[mi][1]); w.y = cvt_pk_bf16(acc4[mi][2], acc4[mi][3]); *(u32x2*)(outT + (wave * 16 + r16) * 72 + mi * 16 + quad * 4) = w; }
        }
        lds_barrier();
        if (it + (int)gridDim.x < 4096) P1_PREFETCH(it + (int)gridDim.x);
        {
#pragma unroll
            for (int i = 0; i < 24; ++i) {
                const int prod = (i < 8) ? 0 : (i < 16) ? 1 : (i < 20) ? 2 : 3;
                const int mi = (i < 8) ? i : (i < 16) ? (i - 8) : (i < 20) ? (i - 16) : (i - 20), ni = wave;
                const bf16_t* X = ((prod < 2) ? kdT : aqk) + (mi * 16 + r16) * 72 + quad * 8;
                const bf16_t* Y = ((prod & 1) ? uT : wT) + (ni * 16 + r16) * 72 + quad * 8;
                f32x4 acc = {0.f, 0.f, 0.f, 0.f};
                if (prod == 1) {
#pragma unroll
                    for (int ks = 0; ks < 2; ++ks) acc = MFMA16(*(const bf16x8*)(X + ks * 32), *(const bf16x8*)(Y + ks * 32), acc);
                    u32x2 w; w.x = cvt_pk_bf16(acc[0], acc[1]); w.y = cvt_pk_bf16(acc[2], acc[3]);
                    *(u32x2*)(Bg + (size_t)ci * 16384 + (ni * 16 + r16) * 128 + mi * 16 + quad * 4) = w;
                    continue;
                }
#pragma unroll
                for (int ks = 0; ks < 2; ++ks) acc = MFMA16(*(const bf16x8*)(Y + ks * 32), *(const bf16x8*)(X + ks * 32), acc);
                const int m = mi * 16 + r16, n0 = ni * 16 + quad * 4;
                if (prod == 0) acc = -acc;
                if (prod == 2) { const u32x2 qv = *(const u32x2*)(qb + m * 136 + n0); const float eg = sc[128 + m];
                    acc[0] = bflo(qv.x) * eg - acc[0]; acc[1] = bfhi(qv.x) * eg - acc[1]; acc[2] = bflo(qv.y) * eg - acc[2]; acc[3] = bfhi(qv.y) * eg - acc[3]; }
                bf16_t* outp = ((prod == 0) ? (Ag + (size_t)ci * 16384) : (prod == 2) ? (Qg + (size_t)ci * 8192) : (Og + (size_t)ci * 8192)) + m * 128 + n0;
                u32x2 w; w.x = cvt_pk_bf16(acc[0], acc[1]); w.y = cvt_pk_bf16(acc[2], acc[3]); *(u32x2*)outp = w;
            }
        }
        lds_barrier();
    }
#undef P1_PREFETCH
}

DI void ph_gdn_p2(PK p, unsigned char* lds, const int wv) {
    PK_FRESH(p);
    const int tid = ltid(wv), lane = tid & 63, wave = __builtin_amdgcn_readfirstlane(tid >> 6), r16 = lane & 15, quad = lane >> 4, a0 = wave * 16;
    const bf16_t* Ag = WSP(const bf16_t, WS_GA); const bf16_t* Bg = WSP(const bf16_t, WS_GB); bf16_t* Sg = WSP(bf16_t, WS_GS); const float* glg = WSP(const float, WS_GL);
    bf16_t* ST = (bf16_t*)lds;
#define P2_LOAD(AF, BM, GL, cidx) do { const size_t c_ = (cidx); _Pragma("unroll") for (int ks = 0; ks < 4; ++ks) AF[ks] = *(const bf16x8*)(Ag + c_ * 16384 + (size_t)(a0 + r16) * 128 + ks * 32 + quad * 8); \
        BM = *(const u32x2*)(Bg + c_ * 16384 + (size_t)(v0 + r16) * 128 + a0 + quad * 4); GL = glg[c_]; } while (0)
    for (int item = blockIdx.x; item < 256; item += gridDim.x) {
        const int bh = (item & 7) * 4 + (item >> 6), v0 = ((item >> 3) & 7) * 16;
        const size_t cb = (size_t)bh * 128;
        f32x4 S = {0.f, 0.f, 0.f, 0.f};
        bf16x8 afA[4], afB[4], afC[4], afD[4], afE[4], afF[4], afG[4], afH[4]; u32x2 bmA, bmB, bmC, bmD, bmE, bmF, bmG, bmH; float glA, glB, glC, glD, glE, glF, glG, glH;
        P2_LOAD(afA, bmA, glA, cb); P2_LOAD(afB, bmB, glB, cb + 1); P2_LOAD(afC, bmC, glC, cb + 2); P2_LOAD(afD, bmD, glD, cb + 3); P2_LOAD(afE, bmE, glE, cb + 4); P2_LOAD(afF, bmF, glF, cb + 5); P2_LOAD(afG, bmG, glG, cb + 6);
#define P2_STEP(AFc, BMc, GLc, AFp, BMp, GLp, nn) do { const int n_ = (nn); const size_t ci = cb + n_; \
            u32x2 sp; sp.x = cvt_pk_bf16(S[0], S[1]); sp.y = cvt_pk_bf16(S[2], S[3]); \
            bf16_t* STb = ST + (n_ & 1) * (16 * 136); \
            *(u32x2*)(STb + r16 * 136 + a0 + quad * 4) = sp; \
            lds_barrier(); \
            f32x4 acc; acc[0] = GLc * S[0] + bflo(BMc.x); acc[1] = GLc * S[1] + bfhi(BMc.x); acc[2] = GLc * S[2] + bflo(BMc.y); acc[3] = GLc * S[3] + bfhi(BMc.y); \
            bf16x8 bfr_[4]; _Pragma("unroll") for (int ks = 0; ks < 4; ++ks) bfr_[ks] = *(const bf16x8*)(STb + r16 * 136 + ks * 32 + quad * 8);        \
            P2_LOAD(AFp, BMp, GLp, cb + ((n_ + 7 < 128) ? n_ + 7 : 127));        \
            *(u32x2*)(Sg + ci * 16384 + (size_t)(v0 + r16) * 128 + a0 + quad * 4) = sp;        \
            _Pragma("unroll") for (int ks = 0; ks < 4; ++ks) acc = MFMA16(AFc[ks], bfr_[ks], acc); \
            S = acc; } while (0)
        for (int n = 0; n < 128; n += 8) {
            P2_STEP(afA, bmA, glA, afH, bmH, glH, n);
            P2_STEP(afB, bmB, glB, afA, bmA, glA, n + 1);
            P2_STEP(afC, bmC, glC, afB, bmB, glB, n + 2);
            P2_STEP(afD, bmD, glD, afC, bmC, glC, n + 3);
            P2_STEP(afE, bmE, glE, afD, bmD, glD, n + 4);
            P2_STEP(afF, bmF, glF, afE, bmE, glE, n + 5);
            P2_STEP(afG, bmG, glG, afF, bmF, glF, n + 6);
            P2_STEP(afH, bmH, glH, afG, bmG, glG, n + 7);
        }
#undef P2_STEP
        lds_barrier();
    }
#undef P2_LOAD
}

DI void ph_gdn_p3(PK p, int l, const int wv) {
    PK_FRESH(p);
    const int tid = ltid(wv), lane = tid & 63, wave = __builtin_amdgcn_readfirstlane(tid >> 6), r16 = lane & 15, quad = lane >> 4;
    const bf16_t* Qg = WSP(const bf16_t, WS_GQ); const bf16_t* Og = WSP(const bf16_t, WS_GO); const bf16_t* Sg = WSP(const bf16_t, WS_GS);
    const bf16_t* proj = WSP(const bf16_t, WS_PROJ); bf16_t* obuf = WSP(bf16_t, WS_OBUF); const float* ogain = p->in[11] + l * 128;
    for (int it = blockIdx.x; it < 2048; it += gridDim.x) {
        const int ci = it * 2 + (wave >> 2), mi = wave & 3;
        const int n = ci & 127, bh = ci >> 7, hd = bh & 15, b = bh >> 4;
        const int i = mi * 16 + r16; const size_t tok = (size_t)b * SEQ + n * 64 + i;
        bf16x8 qa[4], sf[4][8]; u32x2 ov[8], zv[8];
#pragma unroll
        for (int ks = 0; ks < 4; ++ks) { qa[ks] = *(const bf16x8*)(Qg + (size_t)ci * 8192 + i * 128 + ks * 32 + quad * 8);
#pragma unroll
            for (int ni = 0; ni < 8; ++ni) sf[ks][ni] = *(const bf16x8*)(Sg + (size_t)ci * 16384 + (ni * 16 + r16) * 128 + ks * 32 + quad * 8); }
#pragma unroll
        for (int ni = 0; ni < 8; ++ni) { ov[ni] = *(const u32x2*)(Og + (size_t)ci * 8192 + i * 128 + ni * 16 + quad * 4); zv[ni] = *(const u32x2*)(proj + tok * GINP + 6144 + hd * 128 + ni * 16 + quad * 4); }
        f32x4 acc[8];
#pragma unroll
        for (int ni = 0; ni < 8; ++ni) acc[ni] = (f32x4){0.f, 0.f, 0.f, 0.f};
#pragma unroll
        for (int ks = 0; ks < 4; ++ks)
#pragma unroll
            for (int ni = 0; ni < 8; ++ni) acc[ni] = MFMA16(sf[ks][ni], qa[ks], acc[ni]);
        float ss = 0.f;
#pragma unroll
        for (int ni = 0; ni < 8; ++ni) {
            acc[ni][0] += bflo(ov[ni].x); acc[ni][1] += bfhi(ov[ni].x); acc[ni][2] += bflo(ov[ni].y); acc[ni][3] += bfhi(ov[ni].y);
            ss += acc[ni][0] * acc[ni][0] + acc[ni][1] * acc[ni][1] + acc[ni][2] * acc[ni][2] + acc[ni][3] * acc[ni][3]; }
        ss += sw_xor<16>(ss); ss = sw_xor32_sum(ss);
        const float rms = rsqrtf(ss * (1.f / 128.f) + NORM_EPS);
#pragma unroll
        for (int ni = 0; ni < 8; ++ni) { const int v = ni * 16 + quad * 4; const f32x4 gv = *(const f32x4*)(ogain + v);
            const float y0 = acc[ni][0] * rms * gv[0] * silu_f(bflo(zv[ni].x)), y1 = acc[ni][1] * rms * gv[1] * silu_f(bfhi(zv[ni].x));
            const float y2 = acc[ni][2] * rms * gv[2] * silu_f(bflo(zv[ni].y)), y3 = acc[ni][3] * rms * gv[3] * silu_f(bfhi(zv[ni].y));
            u32x2 w; w.x = cvt_pk_bf16(y0, y1); w.y = cvt_pk_bf16(y2, y3); *(u32x2*)(obuf + tok * D + hd * 128 + v) = w; }
    }
}

DI void ph_rope(PK p, const bf16_t* src, int ld, bf16_t* dst, const int wv) {
    PK_FRESH(p);
    const int tid = ltid(wv); const float* cosT = WSP(const float, WS_COS); const float* sinT = WSP(const float, WS_SIN);
    for (int idx = blockIdx.x * 512 + tid; idx < T * 128; idx += gridDim.x * 512) {
        const int jc = idx & 7, hc = (idx >> 3) & 15, t = idx >> 7;
        const bf16_t* sp = src + (size_t)t * ld + hc * 128 + jc * 8;
        const u32x4 x1 = *(const u32x4*)sp, x2 = *(const u32x4*)(sp + 64);
        const f32x4 c0 = *(const f32x4*)(cosT + t * 64 + jc * 8), c1 = *(const f32x4*)(cosT + t * 64 + jc * 8 + 4);
        const f32x4 s0 = *(const f32x4*)(sinT + t * 64 + jc * 8), s1 = *(const f32x4*)(sinT + t * 64 + jc * 8 + 4);
        float a[8] = {bflo(x1.x), bfhi(x1.x), bflo(x1.y), bfhi(x1.y), bflo(x1.z), bfhi(x1.z), bflo(x1.w), bfhi(x1.w)};
        float bb[8] = {bflo(x2.x), bfhi(x2.x), bflo(x2.y), bfhi(x2.y), bflo(x2.z), bfhi(x2.z), bflo(x2.w), bfhi(x2.w)};
        float cs[8] = {c0[0], c0[1], c0[2], c0[3], c1[0], c1[1], c1[2], c1[3]}, sn[8] = {s0[0], s0[1], s0[2], s0[3], s1[0], s1[1], s1[2], s1[3]};
        float o1[8], o2[8];
#pragma unroll
        for (int e = 0; e < 8; ++e) { o1[e] = a[e] * cs[e] - bb[e] * sn[e]; o2[e] = bb[e] * cs[e] + a[e] * sn[e]; }
        const int b = t >> 13, s = t & 8191;
        bf16_t* dp = dst + ((size_t)(b * 16 + hc) * SEQ + s) * 128 + jc * 8;
        u32x4 w1, w2;
        w1.x = cvt_pk_bf16(o1[0], o1[1]); w1.y = cvt_pk_bf16(o1[2], o1[3]); w1.z = cvt_pk_bf16(o1[4], o1[5]); w1.w = cvt_pk_bf16(o1[6], o1[7]);
        w2.x = cvt_pk_bf16(o2[0], o2[1]); w2.y = cvt_pk_bf16(o2[2], o2[3]); w2.z = cvt_pk_bf16(o2[4], o2[5]); w2.w = cvt_pk_bf16(o2[6], o2[7]);
        *(u32x4*)dp = w1; *(u32x4*)(dp + 64) = w2;
    }
}
DI void ph_vrelayout(const bf16_t* src, bf16_t* dst, const int wv) {
    const int tid = ltid(wv);
    for (int idx = blockIdx.x * 512 + tid; idx < T * 256; idx += gridDim.x * 512) {
        const int ch = idx & 15, hc = (idx >> 4) & 15, t = idx >> 8; const int b = t >> 13, s = t & 8191;
        *(u32x4*)(dst + ((size_t)(b * 16 + hc) * SEQ + s) * 128 + ch * 8) = *(const u32x4*)(src + (size_t)t * 4096 + 2048 + hc * 128 + ch * 8);
    }
}

DI void ph_attn(PK p, unsigned char* lds, const int wv) {
    PK_FRESH(p);
    using att::bf16;
    const bf16* Qd = WSP(const bf16, WS_QD); const bf16* Ksh = WSP(const bf16, WS_KSH); const bf16* Vsh = WSP(const bf16, WS_VSH); bf16* Oat = WSP(bf16, WS_OAT);
    const int total = 64 * 16, stride = gridDim.x, W = SEQ;
    int L = blockIdx.x;
    if (L < total) {
        auto mkref = [&](int Li, int pass) {
            const int xcd = Li & 7, jk = Li >> 3, mm = (jk & 127) >> 4, x = jk & 15, h64 = xcd * 8 + mm, qb = pass ? (31 - x) : x;
            const int vh = h64 & 1, c = (h64 >> 1) & 1, bh = h64 >> 2;
            att::BlockRef<bf16, bf16> r;
            r.Q = Qd + ((size_t)(bh * 2 + c) * SEQ + (size_t)qb * 256) * 128;
            r.K = Ksh + (size_t)(bh * 2 + c) * SEQ * 128;
            r.V = Vsh + (size_t)(bh * 2 + vh) * SEQ * 128;
            r.O = Oat + ((size_t)((bh * 2 + c) * 2 + vh) * SEQ + (size_t)qb * 256) * 128;
            r.P0 = qb * 256; return r; };
        int pass = 0;
        att::BlockRef<bf16, bf16> cur = mkref(L, 0);
        att::Seam<bf16> S;
        att::causal_swa_prime<bf16, bf16>(cur, W, (char*)lds, S, wv);
        for (;;) {
            const bool more_pass = pass == 0, more_item = L + stride < total, last = !more_pass && !more_item;
            int passn = pass + 1, Ln = L;
            if (!more_pass) { passn = 0; Ln = more_item ? L + stride : L; }
            const att::BlockRef<bf16, bf16> nxt = last ? cur : mkref(Ln, passn);
            att::causal_swa_block<bf16, bf16>(cur, nxt, SEQ, W, (char*)lds, S, wv);
            if (last) break;
            cur = nxt; pass = passn; L = Ln;
        }
    }
    __syncthreads();
}

DI void ph_diff_combine(PK p, int j, int l, unsigned char* lds, const int wv) {
    PK_FRESH(p);
    const int tid = ltid(wv), lane = tid & 63, wave = __builtin_amdgcn_readfirstlane(tid >> 6);
    float* ldsf = (float*)lds;
    const float lambda_init = 0.8f - 0.6f * expf(-0.3f * (float)l);
    if (wave == 0) { const float* lp = p->in[18] + j * 512;
        float a = lp[lane] * lp[128 + lane] + lp[64 + lane] * lp[192 + lane], bsum = lp[256 + lane] * lp[384 + lane] + lp[320 + lane] * lp[448 + lane];
        a = wave_sum(a); bsum = wave_sum(bsum);
        if (lane == 0) ldsf[0] = expf(a) - expf(bsum) + lambda_init; }
    __syncthreads();
    const float lam = ldsf[0], om = 1.f - lambda_init;
    const bf16_t* Oat = WSP(const bf16_t, WS_OAT); bf16_t* obuf = WSP(bf16_t, WS_OBUF); const float* sg = p->in[19] + j * 256;
    for (int row = blockIdx.x * 8 + wave; row < T * 8; row += gridDim.x * 8) {
        const int t = row >> 3, h = row & 7, b = t >> 13, s = t & 8191, vh = lane >> 5, d = (lane & 31) * 4;
        const u32x2 o1 = *(const u32x2*)(Oat + ((size_t)(((b * 8 + h) * 2 + 0) * 2 + vh) * SEQ + s) * 128 + d);
        const u32x2 o2 = *(const u32x2*)(Oat + ((size_t)(((b * 8 + h) * 2 + 1) * 2 + vh) * SEQ + s) * 128 + d);
        float v[4] = {bflo(o1.x) - lam * bflo(o2.x), bfhi(o1.x) - lam * bfhi(o2.x), bflo(o1.y) - lam * bflo(o2.y), bfhi(o1.y) - lam * bfhi(o2.y)};
        float ss = v[0] * v[0] + v[1] * v[1] + v[2] * v[2] + v[3] * v[3];
        ss = wave_sum(ss);
        const float rms = rsqrtf(ss * (1.f / 256.f) + NORM_EPS) * om;
        const f32x4 gv = *(const f32x4*)(sg + vh * 128 + d);
        u32x2 w; w.x = cvt_pk_bf16(v[0] * rms * gv[0], v[1] * rms * gv[1]); w.y = cvt_pk_bf16(v[2] * rms * gv[2], v[3] * rms * gv[3]);
        *(u32x2*)(obuf + (size_t)t * D + h * 256 + vh * 128 + d) = w;
    }
    __syncthreads();
}

#define INS16(Lr, vv) do { _Pragma("unroll") for (int k_ = 0; k_ < 16; ++k_) { const float hi_ = fmaxf(Lr[k_], vv); vv = fminf(Lr[k_], vv); Lr[k_] = hi_; } } while (0)
DI void sort16_desc(float (&L)[16]) {
#pragma unroll
    for (int k = 2; k <= 16; k <<= 1)
#pragma unroll
        for (int j = k >> 1; j >= 1; j >>= 1)
#pragma unroll
            for (int i = 0; i < 16; ++i) { const int l = i ^ j;
                if (l > i) { const float hi_ = fmaxf(L[i], L[l]), lo_ = fminf(L[i], L[l]); const bool desc = (i & k) == 0; L[i] = desc ? hi_ : lo_; L[l] = desc ? lo_ : hi_; } }
}
template <int XM> DI void merge16(float (&L)[16]) {
    float P[16];
#pragma unroll
    for (int i = 0; i < 16; ++i) P[i] = (XM == 4) ? dpp_full<0x141>(L[15 - i]) : sw_xor<XM>(L[15 - i]);
#pragma unroll
    for (int i = 0; i < 16; ++i) L[i] = fmaxf(L[i], P[i]);
#pragma unroll
    for (int s = 8; s >= 1; s >>= 1)
#pragma unroll
        for (int i = 0; i < 16; ++i) if ((i & s) == 0) { const float hi_ = fmaxf(L[i], L[i + s]), lo_ = fminf(L[i], L[i + s]); L[i] = hi_; L[i + s] = lo_; }
}
__constant__ unsigned kStairPk[16] = {0x20100800u, 0xffe07033u, 0x21110901u, 0xfff07140u, 0x22120a02u, 0xffff8041u, 0x23130b03u, 0xffff9042u, 0x24140c04u, 0xffffa050u, 0x30150d05u, 0xffffb051u, 0x31160e06u, 0xffffc060u, 0x32170f07u, 0xffffd061u};
DI void ph_peer_topk(PK p, int l, unsigned char* lds, const int wv) {
    PK_FRESH(p);
    const int tid = ltid(wv);
    float* tops = (float*)lds; float* fin = tops + 64 * 2 * 16;
    const bf16_t* pq = WSP(const bf16_t, WS_PQ);
    int* pidx = WSP(int, WS_PIDX); float* pgate = WSP(float, WS_PGATE);
    const float NEG = -__builtin_inff();
    const int rowl = (tid & 255) >> 3, half = (tid >> 2) & 1, quarter = tid & 3, l8 = tid & 7;
    const int nitems = T * 8 / 32;
    const int lane = tid & 63, wave = __builtin_amdgcn_readfirstlane(tid >> 6);
    if (wave >= 4) {
        const int cstep = gridDim.x * 4, R = 2 * 16384; int r = blockIdx.x * 4 + (wave - 4);
        f32x4 ca[8], cb[8];
        if (r < R) pc_load(p, l, r, ca, lane);
        for (; r < R; r += 2 * cstep) {
            const int r2 = r + cstep, r3 = r + 2 * cstep;
            if (r2 < R) pc_load(p, l, r2, cb, lane);
            pc_store(p, r, ca, lane);
            if (r3 < R) pc_load(p, l, r3, ca, lane);
            if (r2 < R) pc_store(p, r2, cb, lane);
        }
        return;
    }
    const u32x2 stw = *(const u32x2*)(kStairPk + l8 * 2);
    u32x4 wn[4];
    if ((int)blockIdx.x < nitems) { const int row = blockIdx.x * 32 + rowl; const bf16_t* sp = pq + (size_t)(row >> 3) * 2048 + (row & 7) * 256 + half * 128 + quarter * 32;
#pragma unroll
        for (int c = 0; c < 4; ++c) wn[c] = *(const u32x4*)(sp + c * 8); }
    for (int item = blockIdx.x; item < nitems; item += gridDim.x) {
        const int row0 = item * 32;
        u32x4 wc[4];
#pragma unroll
        for (int c = 0; c < 4; ++c) wc[c] = wn[c];
        { const int itn = (item + (int)gridDim.x < nitems) ? item + (int)gridDim.x : item; const int row = itn * 32 + rowl;
          const bf16_t* sp = pq + (size_t)(row >> 3) * 2048 + (row & 7) * 256 + half * 128 + quarter * 32;
#pragma unroll
          for (int c = 0; c < 4; ++c) wn[c] = *(const u32x4*)(sp + c * 8); }
        float Lr[16], Lq[16];
#pragma unroll
        for (int c = 0; c < 4; ++c)
#pragma unroll
            for (int e = 0; e < 4; ++e) { const unsigned w = wc[c][e];
                const float v0 = __uint_as_float((w << 16) | (unsigned)(quarter * 32 + c * 8 + e * 2)), v1 = __uint_as_float((w & 0xffff0000u) | (unsigned)(quarter * 32 + c * 8 + e * 2 + 1));
                if (c < 2) { Lr[c * 8 + e * 2] = v0; Lr[c * 8 + e * 2 + 1] = v1; } else { Lq[(c - 2) * 8 + e * 2] = v0; Lq[(c - 2) * 8 + e * 2 + 1] = v1; } }
        sort16_desc(Lr); sort16_desc(Lq);
#pragma unroll
        for (int i = 0; i < 16; ++i) Lr[i] = fmaxf(Lr[i], Lq[15 - i]);
#pragma unroll
        for (int s = 8; s >= 1; s >>= 1)
#pragma unroll
            for (int i = 0; i < 16; ++i) if ((i & s) == 0) { const float hi_ = fmaxf(Lr[i], Lr[i + s]), lo_ = fminf(Lr[i], Lr[i + s]); Lr[i] = hi_; Lr[i + s] = lo_; }
        merge16<1>(Lr); merge16<2>(Lr);
        if (quarter == 0) {
#pragma unroll
            for (int k = 0; k < 16; ++k) tops[(rowl * 2 + half) * 16 + k] = Lr[k];
        }
        asm volatile("s_waitcnt lgkmcnt(0)" ::: "memory");
        float M[16];
#pragma unroll
        for (int k = 0; k < 16; ++k) M[k] = NEG;
        {
            const float* ta = tops + (rowl * 2) * 16; const float* tb = ta + 16;
#pragma unroll
            for (int m = 0; m < 7; ++m) { const unsigned code = (((m < 4) ? stw.x : stw.y) >> (8 * (m & 3))) & 255u;
                float s = (code < 255u) ? ta[code >> 4] + tb[code & 15u] : NEG;
                s = (code < 255u) ? __uint_as_float((__float_as_uint(s) & ~255u) | code) : NEG; INS16(M, s); }
        }
        merge16<1>(M); merge16<2>(M); merge16<4>(M);
        float sum = 0.f;
#pragma unroll
        for (int k = 0; k < 16; ++k) sum += __expf(M[k] - M[0]);
        if (l8 == 0) {
#pragma unroll
            for (int k = 0; k < 16; ++k) fin[rowl * 16 + k] = M[k];
        }
        asm volatile("s_waitcnt lgkmcnt(0)" ::: "memory");
        {
            const float inv = __builtin_amdgcn_rcpf(sum), m0 = M[0]; const int row = row0 + rowl; const size_t ob = (size_t)(row >> 3) * 128 + (row & 7) * 16;
#pragma unroll
            for (int u = 0; u < 2; ++u) { const int k = l8 * 2 + u; const float mk = fin[rowl * 16 + k]; const unsigned code = __float_as_uint(mk) & 255u;
                const unsigned i1 = __float_as_uint(tops[(rowl * 2) * 16 + (code >> 4)]) & 127u, i2 = __float_as_uint(tops[(rowl * 2 + 1) * 16 + (code & 15u)]) & 127u;
                pidx[ob + k] = (int)(i1 * 128u + i2); pgate[ob + k] = __expf(mk - m0) * inv; }
        }
        asm volatile("s_waitcnt lgkmcnt(0)" ::: "memory");
    }
}

DI float gelu_f(float v) {
    const float av = fabsf(v), t = __builtin_amdgcn_rcpf(fmaf(av, 0.2316418882f, 1.0f));
    float q = fmaf(t, 0.5307027145f, -0.7265760135f); q = fmaf(q, t, 0.7107068705f); q = fmaf(q, t, -0.142248368f); q = fmaf(q, t, 0.127414796f); q = q * t;
    const float e = __builtin_amdgcn_exp2f(v * v * -0.72134752044f), m = v * (q * e);
    return v < 0.f ? m : v - m;
}
#define FP4X8(w, o) const f32x2 o##0 = __builtin_amdgcn_cvt_scalef32_pk_f32_fp4(w, 1.0f, 0), o##1 = __builtin_amdgcn_cvt_scalef32_pk_f32_fp4(w, 1.0f, 1), \
                                o##2 = __builtin_amdgcn_cvt_scalef32_pk_f32_fp4(w, 1.0f, 2), o##3 = __builtin_amdgcn_cvt_scalef32_pk_f32_fp4(w, 1.0f, 3)
DI void ph_peer_gather(PK p, int l, unsigned char* lds, const int wv, const bool apply = true) {
    PK_FRESH(p);
    const int tid = ltid(wv), lane = tid & 63, wave = __builtin_amdgcn_readfirstlane(tid >> 6);
    const bf16_t* hb = WSP(const bf16_t, WS_HBUF); const unsigned char* ub = WSP(const unsigned char, WS_PU); const unsigned char* vb = WSP(const unsigned char, WS_PV);
    const unsigned char* psc8 = WSP(const unsigned char, WS_PUS);
    const int* pidx = WSP(const int, WS_PIDX); const float* pgate = WSP(const float, WS_PGATE); bf16_t* xc = WSP(bf16_t, WS_XCUR);
    const float* gt2 = WSP(const float, WS_MOD) + l * 12288 + 5 * 2048;
    const unsigned l16 = (unsigned)lane * 16u, l2 = (unsigned)(lane >> 2) * 4u;
    for (int tok = blockIdx.x * 8 + wave; tok < T; tok += gridDim.x * 8) {
        f32x2 hf2[16];
#pragma unroll
        for (int c = 0; c < 4; ++c) { const u32x4 w = *(const u32x4*)(hb + (size_t)tok * D + lane * 32 + c * 8);
            hf2[c * 4 + 0] = (f32x2){bflo(w.x), bfhi(w.x)}; hf2[c * 4 + 1] = (f32x2){bflo(w.y), bfhi(w.y)}; hf2[c * 4 + 2] = (f32x2){bflo(w.z), bfhi(w.z)}; hf2[c * 4 + 3] = (f32x2){bflo(w.w), bfhi(w.w)}; }
        f32x2 acc2[16];
#pragma unroll
        for (int i = 0; i < 16; ++i) acc2[i] = (f32x2){0.f, 0.f};
        u32x2* sraw = (u32x2*)(lds + wave * 2048); u32x2* ssrt = sraw + 128;
        {
            const unsigned k0 = (unsigned)pidx[(size_t)tok * 128 + lane], k1 = (unsigned)pidx[(size_t)tok * 128 + 64 + lane];
            const float g0 = pgate[(size_t)tok * 128 + lane], g1 = pgate[(size_t)tok * 128 + 64 + lane];
            sraw[lane] = (u32x2){k0, __float_as_uint(g0)}; sraw[64 + lane] = (u32x2){k1, __float_as_uint(g1)};
            asm volatile("s_waitcnt lgkmcnt(0)" ::: "memory");
            const unsigned key0 = k0 * 128u + (unsigned)lane, key1 = k1 * 128u + 64u + (unsigned)lane; unsigned r0 = 0, r1 = 0;
            for (int j = 0; j < 128; ++j) { const unsigned kj = sraw[j].x * 128u + (unsigned)j; r0 += (kj < key0) ? 1u : 0u; r1 += (kj < key1) ? 1u : 0u; }
            ssrt[r0] = (u32x2){k0, __float_as_uint(g0)}; ssrt[r1] = (u32x2){k1, __float_as_uint(g1)};
            asm volatile("s_waitcnt lgkmcnt(0)" ::: "memory");
        }
#define G_LOAD(gi, UR, VR, US, GT) do { unsigned o16_ = l16, o2_ = l2; asm("" : "+v"(o16_)); asm("" : "+v"(o2_));        \
        _Pragma("unroll") for (int q = 0; q < 4; ++q) { const u32x2 pr = ssrt[(gi) * 4 + q]; const unsigned e_ = (unsigned)__builtin_amdgcn_readfirstlane((int)pr.x); GT[q] = __uint_as_float(pr.y); \
            unsigned long long ue_ = (unsigned long long)ub + (unsigned long long)e_ * 1024ull, ve_ = (unsigned long long)vb + (unsigned long long)e_ * 1024ull, se_ = (unsigned long long)psc8 + (unsigned long long)e_ * 64ull; \
            asm("" : "+s"(ue_)); asm("" : "+s"(ve_)); asm("" : "+s"(se_));        \
            UR[q] = *(const __attribute__((address_space(1))) u32x4*)(ue_ + (unsigned long long)o16_); US[q] = *(const __attribute__((address_space(1))) unsigned*)(se_ + (unsigned long long)o2_); \
            VR[q] = *(const __attribute__((address_space(1))) u32x4*)(ve_ + (unsigned long long)o16_); } } while (0)
#define G_COMP(UR, VR, US, GT) do { float cf[4]; \
            _Pragma("unroll") for (int q = 0; q < 4; ++q) { f32x2 t2 = {0.f, 0.f}, t3 = {0.f, 0.f}; \
                _Pragma("unroll") for (int c = 0; c < 4; ++c) { FP4X8(UR[q][c], a); \
                    t2 = a0 * hf2[c * 4 + 0] + t2; t3 = a1 * hf2[c * 4 + 1] + t3; t2 = a2 * hf2[c * 4 + 2] + t2; t3 = a3 * hf2[c * 4 + 3] + t3; } \
                t2 = t2 + t3; \
                cf[q] = (t2.x + t2.y) * __uint_as_float(US[q] << 16); } \
            wave_sum4_dpp(cf[0], cf[1], cf[2], cf[3]); \
            _Pragma("unroll") for (int q = 0; q < 4; ++q) cf[q] = __int_as_float(__builtin_amdgcn_readlane(__float_as_int(cf[q]), 63)); \
            { float xg_ = 0.f;        \
              _Pragma("unroll") for (int q = 0; q < 4; ++q) asm("v_writelane_b32 %0, %1, %2" : "+v"(xg_) : "s"(cf[q]), "n"(q)); \
              const float yg_ = gelu_f(xg_); \
              _Pragma("unroll") for (int q = 0; q < 4; ++q) cf[q] = GT[q] * __int_as_float(__builtin_amdgcn_readlane(__float_as_int(yg_), q)); } \
            _Pragma("unroll") for (int q = 0; q < 4; ++q) { const float cs = cf[q] * __uint_as_float(US[q] & 0xffff0000u); const f32x2 cs2 = {cs, cs}; \
                _Pragma("unroll") for (int c = 0; c < 4; ++c) { FP4X8(VR[q][c], b); \
                    acc2[c * 4 + 0] = cs2 * b0 + acc2[c * 4 + 0]; acc2[c * 4 + 1] = cs2 * b1 + acc2[c * 4 + 1]; acc2[c * 4 + 2] = cs2 * b2 + acc2[c * 4 + 2]; acc2[c * 4 + 3] = cs2 * b3 + acc2[c * 4 + 3]; } } } while (0)
        {
            u32x4 urA[4], vrA[4], urB[4], vrB[4]; unsigned usA[4], usB[4]; float gtA[4], gtB[4];
            G_LOAD(0, urA, vrA, usA, gtA);
            for (int g = 0; g < 32; g += 2) {
                G_LOAD(g + 1, urB, vrB, usB, gtB);
                G_COMP(urA, vrA, usA, gtA);
                G_LOAD((g + 2 < 32) ? g + 2 : 31, urA, vrA, usA, gtA);
                G_COMP(urB, vrB, usB, gtB);
            }
        }
#undef G_LOAD
#undef G_COMP
        float acc[32];
#pragma unroll
        for (int i = 0; i < 16; ++i) { acc[2 * i] = acc2[i].x; acc[2 * i + 1] = acc2[i].y; }
        if (!apply) { if (p->ph_hi == -12345) { for (int i = 0; i < 32; ++i) xc[i * 64 + lane] = f2bf(acc[i]); } continue; }
        const int b = tok >> 13; const float gm = ((MK_SKIP >> (2 * l + 1)) & 1) ? 0.f : 1.f;
        float ss = 0.f;
#pragma unroll
        for (int c = 0; c < 4; ++c) { const int col = lane * 32 + c * 8; bf16_t* xp = xc + (size_t)tok * D + col;
            const u32x4 xb = *(const u32x4*)xp; const f32x4 g0 = *(const f32x4*)(gt2 + (size_t)b * MODC + col), g1 = *(const f32x4*)(gt2 + (size_t)b * MODC + col + 4);
            const float x8[8] = {bflo(xb.x), bfhi(xb.x), bflo(xb.y), bfhi(xb.y), bflo(xb.z), bfhi(xb.z), bflo(xb.w), bfhi(xb.w)}; float y8[8];
#pragma unroll
            for (int e2 = 0; e2 < 8; ++e2) { y8[e2] = x8[e2] + gm * ((e2 < 4) ? g0[e2] : g1[e2 - 4]) * acc[c * 8 + e2]; acc[c * 8 + e2] = y8[e2]; ss += y8[e2] * y8[e2]; }
            if (l < 3) { u32x4 w; w.x = cvt_pk_bf16(y8[0], y8[1]); w.y = cvt_pk_bf16(y8[2], y8[3]); w.z = cvt_pk_bf16(y8[4], y8[5]); w.w = cvt_pk_bf16(y8[6], y8[7]); *(u32x4*)xp = w; } }
        const float rn = rsqrtf(wave_sum(ss) * (1.f / D) + NORM_EPS);
        const float* modall = WSP(const float, WS_MOD) + (size_t)b * MODC;
        if (l == 3) {
#pragma unroll
            for (int c = 0; c < 8; ++c) { const int col = lane * 32 + c * 4; const f32x4 gv = *(const f32x4*)(p->in[25] + col); f32x4 o;
#pragma unroll
                for (int e2 = 0; e2 < 4; ++e2) o[e2] = acc[c * 4 + e2] * rn * gv[e2];
                *(f32x4*)(p->out + (size_t)tok * D + col) = o; }
        } else {
            const float* g1 = (l == 1) ? p->in[13] : (p->in[5] + (l + 1) * D);
            const float* sh1 = (l == 1) ? (modall + 4 * 12288) : (modall + (l + 1) * 12288);
            const float* sc1 = sh1 + D;
            bf16_t* d1 = WSP(bf16_t, WS_HBUF) + (size_t)tok * D;
#pragma unroll
            for (int c = 0; c < 4; ++c) { u32x4 w;
#pragma unroll
                for (int hh = 0; hh < 2; ++hh) { const int col = lane * 32 + c * 8 + hh * 4; const f32x4 gv = *(const f32x4*)(g1 + col), sv = *(const f32x4*)(sh1 + col), cv = *(const f32x4*)(sc1 + col); float o[4];
#pragma unroll
                    for (int e2 = 0; e2 < 4; ++e2) o[e2] = acc[c * 8 + hh * 4 + e2] * rn * gv[e2] * (1.f + cv[e2]) + sv[e2];
                    w[hh * 2] = cvt_pk_bf16(o[0], o[1]); w[hh * 2 + 1] = cvt_pk_bf16(o[2], o[3]); }
                *(u32x4*)(d1 + lane * 32 + c * 8) = w; }
            if (l == 1) {
                const float* g2 = p->in[5] + 2 * D; const float* sh2 = modall + 2 * 12288; const float* sc2 = sh2 + D;
                bf16_t* d2 = WSP(bf16_t, WS_OBUF) + (size_t)tok * D;
#pragma unroll
                for (int c = 0; c < 4; ++c) { u32x4 w;
#pragma unroll
                    for (int hh = 0; hh < 2; ++hh) { const int col = lane * 32 + c * 8 + hh * 4; const f32x4 gv = *(const f32x4*)(g2 + col), sv = *(const f32x4*)(sh2 + col), cv = *(const f32x4*)(sc2 + col); float o[4];
#pragma unroll
                        for (int e2 = 0; e2 < 4; ++e2) o[e2] = acc[c * 8 + hh * 4 + e2] * rn * gv[e2] * (1.f + cv[e2]) + sv[e2];
                        w[hh * 2] = cvt_pk_bf16(o[0], o[1]); w[hh * 2 + 1] = cvt_pk_bf16(o[2], o[3]); }
                    *(u32x4*)(d2 + lane * 32 + c * 8) = w; }
            }
        }
    }
}
#undef FP4X8

DI void ph_dbg(PK p, int mode, const int wv) {
    PK_FRESH(p);
    const int tid = ltid(wv);
    const bf16_t* Ag = WSP(const bf16_t, WS_GA); const bf16_t* Bg = WSP(const bf16_t, WS_GB); const bf16_t* Qg = WSP(const bf16_t, WS_GQ); const bf16_t* Og = WSP(const bf16_t, WS_GO); const bf16_t* Sg = WSP(const bf16_t, WS_GS);
    const bf16_t* proj = WSP(const bf16_t, WS_PROJ); bf16_t* obuf = WSP(bf16_t, WS_OBUF);
    for (int idx = blockIdx.x * 512 + tid; idx < T * D; idx += gridDim.x * 512) {
        const int tok = idx >> 11, col = idx & 2047, hd = col >> 7, v = col & 127, b = tok >> 13, s = tok & 8191, n = s >> 6, i = s & 63;
        const size_t ci = (size_t)(b * 16 + hd) * 128 + n;
        float r = 0.f;
        if (mode == 1) r = bf2f(Og[ci * 8192 + i * 128 + v]) + bf2f(Qg[ci * 8192 + i * 128 + v]);
        if (mode == 2) r = bf2f(Ag[ci * 16384 + i * 128 + v]) + bf2f(Bg[ci * 16384 + (i + 64) * 128 + v]) + bf2f(Ag[ci * 16384 + (i + 64) * 128 + v]) + bf2f(Bg[ci * 16384 + i * 128 + v]);
        if (mode == 3) r = bf2f(Sg[ci * 16384 + i * 128 + v]) + bf2f(Sg[ci * 16384 + (i + 64) * 128 + v]);
        if (mode == 4) r = bf2f(proj[(size_t)tok * GINP + col]) + bf2f(proj[(size_t)tok * GINP + 2048 + col]) + bf2f(proj[(size_t)tok * GINP + 4096 + col]) + bf2f(proj[(size_t)tok * GINP + 6144 + col]) + ((col < 256) ? bf2f(proj[(size_t)tok * GINP + 8192 + col]) : 0.f);
        obuf[idx] = f2bf(r);
    }
}
#ifndef MK_AOUT
#define MK_AOUT obuf
#endif
constexpr int NPHASES = 1 + 1 + 2 * 9 + 2 * 8 + 1;

__global__ void __launch_bounds__(512, 2) mk_fwd(Params p_arg) {
    extern __shared__ __attribute__((aligned(16))) unsigned char lds[];
    PK p = (PK)__builtin_amdgcn_kernarg_segment_ptr();
    const int lo = p->ph_lo, hi = p->ph_hi;
    const int wv = __builtin_amdgcn_readfirstlane((int)threadIdx.x >> 6);
    volatile LAS unsigned* st = (volatile LAS unsigned*)((LAS unsigned char*)lds + LDS_BARW);
    if (wv == 0 && lane_id() == 0) { st[0] = 0u; st[1] = 0u; }
    __syncthreads();
    XcdBarrier bar; bar.bar = (unsigned*)(p->ws + WS_BAR); bar.x = 0; bar.st = st; bar.wv = wv;
    if (hi - lo > 1) bar = xcd_barrier_post((unsigned*)(p->ws + WS_BAR), st, wv);
    int ph = 0;
#define PH_BEGIN if (lo <= ph && ph < hi) { PK_FRESH(p);
#define PH_END   if (ph + 1 < hi) xcd_barrier(bar); } ++ph;
#define mod  WSP(const float, WS_MOD)
#define xcur WSP(bf16_t, WS_XCUR)
#define hbuf WSP(bf16_t, WS_HBUF)
#define obuf WSP(bf16_t, WS_OBUF)
#define G    ((int)gridDim.x)
#define bx   ((int)blockIdx.x)
#define modl (mod + l * 12288)

    PH_BEGIN ph_prologue(p, lds, wv); if (MK_DUP & 1) { __syncthreads(); ph_prologue(p, lds, wv); } PH_END

    for (int l = 0; l < DEPTH; ++l) {
        if (l == 0) { PH_BEGIN ph_norm<0>(p->in[0], nullptr, p->in[5], modl + 0 * D, modl + 1 * D, hbuf, nullptr, wv); PH_END }
        PH_BEGIN
            pg8::Gemm g; pg8::EpiMk E; E.mode = 0; E.xin = nullptr; E.xinb = nullptr; E.xout = nullptr; E.gate = nullptr; E.gmul = 1.f; E.xoutf = nullptr; E.O2 = nullptr; E.nrope = 0; E.cosT = WSP(const float, WS_COS); E.sinT = WSP(const float, WS_SIN);
            g.A = (l == 2) ? obuf : hbuf; g.M = T; g.K = D; g.ld = D; g.ksplit = 0;
            if (l < 2) { g.Bt = WSP(const bf16_t, WS_WIN) + (size_t)l * GINP * D; g.N = 8192; E.O = WSP(bf16_t, WS_PROJ); E.ldc = GINP; }
            else { g.Bt = WSP(const bf16_t, WS_DWQ) + (size_t)(l - 2) * D * D; g.N = D; E.mode = 2; E.O = WSP(bf16_t, WS_QD); E.nrope = D; }
            pg8::StaticOrder S; S.init(g.M, g.N, G, bx);
            pg8::gemm_phase<pg8::EpiMk, pg8::StaticOrder>((PG8_LAS unsigned char*)lds, g, S, E, wv);
            if (MK_DUP & 2) { __syncthreads(); pg8::gemm_phase<pg8::EpiMk, pg8::StaticOrder>((PG8_LAS unsigned char*)lds, g, S, E, wv); }
            if (l < 2) {
                pg8::Gemm g2; g2.A = hbuf; g2.Bt = WSP(const bf16_t, WS_WIN) + (size_t)l * GINP * D + (size_t)8192 * D; g2.M = T; g2.N = 1024; g2.K = 512; g2.ld = D; g2.ksplit = 1;
                pg8::EpiMk E2 = E; E2.mode = 3; E2.xoutf = WSP(float, WS_PAB);
                pg8::StaticOrder S2; S2.init(g2.M, g2.N, G, bx);
                pg8::gemm_phase<pg8::EpiMk, pg8::StaticOrder>((PG8_LAS unsigned char*)lds, g2, S2, E2, wv);
            }
        PH_END
        if (l < 2) {
            PH_BEGIN ph_gdn_p1(p, l, lds, wv); if (MK_DUP & 8) { __syncthreads(); ph_gdn_p1(p, l, lds, wv); } PH_END
            PH_BEGIN ph_gdn_p2(p, lds, wv); if (MK_DUP & 16) { __syncthreads(); ph_gdn_p2(p, lds, wv); } PH_END
#ifdef MK_DBG
            PH_BEGIN ph_dbg(p, MK_DBG, wv); PH_END
#else
            PH_BEGIN ph_gdn_p3(p, l, wv); if (MK_DUP & 32) { __syncthreads(); ph_gdn_p3(p, l, wv); } PH_END
#endif
        } else {
            PH_BEGIN ph_attn(p, lds, wv); if (MK_DUP & 64) { __syncthreads(); ph_attn(p, lds, wv); } PH_END
            PH_BEGIN ph_diff_combine(p, l - 2, l, lds, wv); PH_END
        }
        PH_BEGIN
            pg8::Gemm g; pg8::EpiMk E; E.mode = 1; E.O = nullptr; E.ldc = 0; E.xoutf = nullptr; E.O2 = nullptr; E.nrope = 0; E.cosT = nullptr; E.sinT = nullptr; E.xin = (l == 0) ? p->in[0] : nullptr; E.xinb = xcur; E.xout = xcur; E.gate = modl + 2 * D; E.gmul = ((MK_SKIP >> (2 * l)) & 1) ? 0.f : 1.f;
            g.A = MK_AOUT; g.M = T; g.K = D; g.N = D; g.ld = D; g.ksplit = 0;
            g.Bt = (l < 2) ? (WSP(const bf16_t, WS_WOUT) + (size_t)l * D * D) : (WSP(const bf16_t, WS_DWO) + (size_t)(l - 2) * D * D);
            pg8::StaticOrder S; S.init(g.M, g.N, G, bx);
            pg8::gemm_phase<pg8::EpiMk, pg8::StaticOrder>((PG8_LAS unsigned char*)lds, g, S, E, wv);
        PH_END
        PH_BEGIN ph_norm<2>(nullptr, xcur, p->in[6] + l * D, modl + 3 * D, modl + 4 * D, hbuf, nullptr, wv); PH_END
        PH_BEGIN
            pg8::Gemm g; pg8::EpiMk E; E.mode = 0; E.xin = nullptr; E.xinb = nullptr; E.xout = nullptr; E.gate = nullptr; E.gmul = 1.f; E.xoutf = nullptr; E.O2 = nullptr; E.nrope = 0; E.cosT = WSP(const float, WS_COS); E.sinT = WSP(const float, WS_SIN); E.O = WSP(bf16_t, WS_PQ); E.ldc = D;
            g.A = hbuf; g.M = T; g.K = D; g.N = D; g.ld = D; g.ksplit = 0; g.Bt = WSP(const bf16_t, WS_PWQ) + (size_t)l * D * D;
            pg8::StaticOrder S; S.init(g.M, g.N, G, bx);
            pg8::gemm_phase<pg8::EpiMk, pg8::StaticOrder>((PG8_LAS unsigned char*)lds, g, S, E, wv);
        PH_END
        PH_BEGIN ph_peer_topk(p, l, lds, wv); if (MK_DUP & 128) { __syncthreads(); ph_peer_topk(p, l, lds, wv); } PH_END
        PH_BEGIN ph_peer_gather(p, l, lds, wv); if (MK_DUP & 256) { __syncthreads(); ph_peer_gather(p, l, lds, wv, false); } PH_END
        if (l == 1) {
            PH_BEGIN
                pg8::Gemm g; pg8::EpiMk E; E.mode = 0; E.xin = nullptr; E.xinb = nullptr; E.xout = nullptr; E.gate = nullptr; E.gmul = 1.f; E.xoutf = nullptr; E.O2 = nullptr; E.nrope = 0; E.cosT = WSP(const float, WS_COS); E.sinT = WSP(const float, WS_SIN); E.mode = 2; E.O = WSP(bf16_t, WS_KSH); E.O2 = WSP(bf16_t, WS_VSH); E.nrope = 2048;
                g.A = hbuf; g.M = T; g.K = D; g.N = 4096; g.ld = D; g.ksplit = 0; g.Bt = WSP(const bf16_t, WS_KVW);
                pg8::StaticOrder S; S.init(g.M, g.N, G, bx);
                pg8::gemm_phase<pg8::EpiMk, pg8::StaticOrder>((PG8_LAS unsigned char*)lds, g, S, E, wv);
            PH_END
        }
    }
#undef PH_BEGIN
#undef PH_END
#undef mod
#undef xcur
#undef hbuf
#undef obuf
#undef G
#undef bx
#undef modl
}

extern "C" void kernel_launch(void* const* d_in, const int* in_sizes, int n_in, void* d_out, int out_size, void* d_ws, size_t ws_size, hipStream_t stream) {
    static int grid = 0;
    if (grid == 0) {
        if (n_in != 26 || in_sizes[0] != T * D || out_size != T * D || ws_size < WS_END) {
            fprintf(stderr, "kernel_launch: unexpected shapes: n_in %d in0 %d out %d ws %zu (need %zu)\n", n_in, n_in > 0 ? in_sizes[0] : -1, out_size, ws_size, (size_t)WS_END); grid = -1; return; }
        int dev = 0, cus = 0;
        if (hipGetDevice(&dev) != hipSuccess || hipDeviceGetAttribute(&cus, hipDeviceAttributeMultiprocessorCount, dev) != hipSuccess || cus <= 0) cus = 256;
        if (hipFuncSetAttribute((const void*)mk_fwd, hipFuncAttributeMaxDynamicSharedMemorySize, LDS_BYTES) != hipSuccess) { fprintf(stderr, "kernel_launch: hipFuncSetAttribute failed\n"); grid = -1; return; }
        int per_cu = 0;
        if (hipOccupancyMaxActiveBlocksPerMultiprocessor(&per_cu, (const void*)mk_fwd, 512, LDS_BYTES) != hipSuccess || per_cu < 1) fprintf(stderr, "kernel_launch: occupancy query says %d\n", per_cu);
        (void)hipGetLastError();
        grid = cus;
    }
    if (grid < 0) return;
    (void)hipMemsetAsync((char*)d_ws + WS_BAR, 0, 16384, stream);
    Params p{};
    for (int i = 0; i < 26; ++i) p.in[i] = (const float*)d_in[i];
    p.out = (float*)d_out; p.ws = (unsigned char*)d_ws;
#if MK_N_LAUNCHES == 1
    p.ph_lo = 0; p.ph_hi = NPHASES;
    hipLaunchKernelGGL(mk_fwd, dim3(grid), dim3(512), LDS_BYTES, stream, p);
#else
#ifndef MK_PHMASK
#define MK_PHMASK 0xffffffffu
#endif
#ifndef MK_STOP
#define MK_STOP NPHASES
#endif
    for (int ph = 0; ph < NPHASES; ++ph) { if (ph >= MK_STOP && ph != NPHASES - 1) continue; if (!(MK_PHMASK >> (ph < 31 ? ph : 31) & 1u) && ph != NPHASES - 1) continue; p.ph_lo = ph; p.ph_hi = ph + 1; hipLaunchKernelGGL(mk_fwd, dim3(grid), dim3(512), LDS_BYTES, stream, p); }
#endif
    const hipError_t le = hipPeekAtLastError();
    if (le != hipSuccess) fprintf(stderr, "kernel_launch: launch failed: %s\n", hipGetErrorName(le));
}
```

```cpp
#include <hip/hip_runtime.h>
#include <hip/hip_bf16.h>
#include <cstdio>
#include <cstdint>

#ifndef MK_N_LAUNCHES
#define MK_N_LAUNCHES 1
#endif
#ifndef MK_DUP
#define MK_DUP 0
#endif
#ifndef MK_SKIP
#define MK_SKIP 0
#endif

constexpr int NB = 2, SEQ = 8192, T = NB * SEQ, D = 2048, DEPTH = 4;
constexpr int GH = 16, GIN = 8224, GINP = 8448;
constexpr int MODC = 4 * 12288 + 4096;
constexpr float NORM_EPS = 1e-6f;

typedef unsigned short bf16_t;
typedef short bf16x8 __attribute__((ext_vector_type(8)));
typedef short s16x4 __attribute__((ext_vector_type(4)));
typedef float f32x4 __attribute__((ext_vector_type(4)));
typedef float f32x2 __attribute__((ext_vector_type(2)));
typedef float f32x16 __attribute__((ext_vector_type(16)));
typedef unsigned u32x4 __attribute__((ext_vector_type(4)));
typedef unsigned u32x2 __attribute__((ext_vector_type(2)));
typedef __bf16 bfx2 __attribute__((ext_vector_type(2)));
#define LAS __attribute__((address_space(3)))
#define DI __device__ __forceinline__

DI float bf2f(bf16_t v) { return __uint_as_float(((unsigned)v) << 16); }
DI float bflo(unsigned w) { return __uint_as_float(w << 16); }
DI float bfhi(unsigned w) { return __uint_as_float(w & 0xffff0000u); }
DI bf16_t f2bf(float f) { unsigned u = __float_as_uint(f); u += 0x7FFFu + ((u >> 16) & 1u); return (bf16_t)(u >> 16); }
DI unsigned cvt_pk_bf16(float lo, float hi) { const f32x2 v = {lo, hi}; return __builtin_bit_cast(unsigned, __builtin_convertvector(v, bfx2)); }
template <int CTRL, int RMASK> DI float dpp_mov(float v) { return __int_as_float(__builtin_amdgcn_update_dpp(0, __float_as_int(v), CTRL, RMASK, 0xF, false)); }
template <int CTRL> DI float dpp_full(float v) { return __int_as_float(__builtin_amdgcn_update_dpp(0, __float_as_int(v), CTRL, 0xF, 0xF, true)); }
template <int M> DI float sw_xor(float v) {
    if constexpr (M == 1) return dpp_full<0xB1>(v);
    else if constexpr (M == 2) return dpp_full<0x4E>(v);
    else if constexpr (M == 8) return dpp_full<0x128>(v);
    else return __int_as_float(__builtin_amdgcn_ds_swizzle(__float_as_int(v), (M << 10) | 0x1f));
}
DI float row_sum16(float v) { v += dpp_full<0xB1>(v); v += dpp_full<0x4E>(v); v += dpp_full<0x141>(v); v += dpp_full<0x140>(v); return v; }
DI float sw_xor32_sum(float v) { auto rr = __builtin_amdgcn_permlane32_swap(__float_as_uint(v), __float_as_uint(v), false, false); return __uint_as_float(rr[0]) + __uint_as_float(rr[1]); }
DI float wave_max(float v) {
    v = fmaxf(v, sw_xor<1>(v)); v = fmaxf(v, sw_xor<2>(v)); v = fmaxf(v, sw_xor<4>(v)); v = fmaxf(v, sw_xor<8>(v)); v = fmaxf(v, sw_xor<16>(v));
    auto rr = __builtin_amdgcn_permlane32_swap(__float_as_uint(v), __float_as_uint(v), false, false); return fmaxf(__uint_as_float(rr[0]), __uint_as_float(rr[1]));
}
DI float wave_sum(float v) {
    v = row_sum16(v); v += dpp_mov<0x142, 0xA>(v); v += dpp_mov<0x143, 0xC>(v);
    return __int_as_float(__builtin_amdgcn_readlane(__float_as_int(v), 63));
}
DI float wave_sum_dpp(float v) {
    v += dpp_mov<0xB1, 0xF>(v); v += dpp_mov<0x4E, 0xF>(v); v += dpp_mov<0x141, 0xF>(v); v += dpp_mov<0x140, 0xF>(v);
    v += dpp_mov<0x142, 0xA>(v); v += dpp_mov<0x143, 0xC>(v);
    return __int_as_float(__builtin_amdgcn_readlane(__float_as_int(v), 63));
}
DI void wave_sum4_dpp(float& a, float& b, float& c, float& d) {
#define WS4_STEP(ctl) "v_add_f32_dpp %0, %0, %0 " ctl "\n v_add_f32_dpp %1, %1, %1 " ctl "\n v_add_f32_dpp %2, %2, %2 " ctl "\n v_add_f32_dpp %3, %3, %3 " ctl "\n"
    asm("s_nop 1\n"
        WS4_STEP("quad_perm:[1,0,3,2] row_mask:0xf bank_mask:0xf")
        WS4_STEP("quad_perm:[2,3,0,1] row_mask:0xf bank_mask:0xf")
        WS4_STEP("row_half_mirror row_mask:0xf bank_mask:0xf")
        WS4_STEP("row_mirror row_mask:0xf bank_mask:0xf")
        WS4_STEP("row_bcast:15 row_mask:0xa bank_mask:0xf")
        WS4_STEP("row_bcast:31 row_mask:0xc bank_mask:0xf")
        : "+v"(a), "+v"(b), "+v"(c), "+v"(d));
#undef WS4_STEP
}
DI void lds_barrier() { asm volatile("s_waitcnt lgkmcnt(0)" ::: "memory"); __builtin_amdgcn_s_barrier(); asm volatile("" ::: "memory"); }
DI float silu_f(float v) { return v * __builtin_amdgcn_rcpf(1.f + __expf(-v)); }
DI int lane_id() { int l; asm volatile("v_mbcnt_lo_u32_b32 %0, -1, 0\n\tv_mbcnt_hi_u32_b32 %0, -1, %0" : "=v"(l)); return l; }
DI int ltid(const int wv) { int t = wv * 64 + lane_id(); asm volatile("" : "+v"(t)); return t; }

constexpr size_t al4k(size_t x) { return (x + 4095) & ~(size_t)4095; }
constexpr size_t WS_BAR   = 0;
constexpr size_t WS_MOD   = 16384;
constexpr size_t WS_COS   = al4k(WS_MOD + (size_t)2 * MODC * 4);
constexpr size_t WS_SIN   = WS_COS + (size_t)T * 64 * 4;
constexpr size_t WS_SUBK  = WS_SIN + (size_t)T * 64 * 4;
constexpr size_t WS_WIN   = WS_SUBK + (size_t)4 * 2 * 128 * 128 * 2;
constexpr size_t WS_WOUT  = WS_WIN + (size_t)2 * GINP * D * 2;
constexpr size_t WS_KVW   = WS_WOUT + (size_t)2 * D * D * 2;
constexpr size_t WS_DWQ   = WS_KVW + (size_t)4096 * D * 2;
constexpr size_t WS_DWO   = WS_DWQ + (size_t)2 * D * D * 2;
constexpr size_t WS_PWQ   = WS_DWO + (size_t)2 * D * D * 2;
constexpr size_t WS_PU    = WS_PWQ + (size_t)4 * D * D * 2;
constexpr size_t WS_PUS   = WS_PU + (size_t)16384 * 1024;
constexpr size_t WS_PV    = WS_PU + (size_t)16384 * D * 2;
constexpr size_t WS_PVS   = WS_PV + (size_t)16384 * 1024;
constexpr size_t WS_XCUR  = WS_PV + (size_t)16384 * D * 2;
constexpr size_t WS_HBUF  = WS_XCUR + (size_t)T * D * 4;
constexpr size_t WS_OBUF  = WS_HBUF + (size_t)T * D * 2;
constexpr size_t WS_PROJ  = WS_OBUF + (size_t)T * D * 2;
constexpr size_t WS_PAB   = WS_PROJ + (size_t)T * GINP * 2;
constexpr size_t WS_PQ    = WS_PROJ + (size_t)T * GINP * 2;
constexpr size_t WS_PIDX  = WS_PQ + (size_t)T * D * 2;
constexpr size_t WS_PGATE = WS_PIDX + (size_t)T * 128 * 4;
constexpr size_t WS_GA    = WS_PGATE + (size_t)T * 128 * 4;
constexpr size_t WS_GB    = WS_GA + (size_t)4096 * 128 * 128 * 2;
constexpr size_t WS_GQ    = WS_GB + (size_t)4096 * 128 * 128 * 2;
constexpr size_t WS_GO    = WS_GQ + (size_t)4096 * 64 * 128 * 2;
constexpr size_t WS_GS    = WS_GO + (size_t)4096 * 64 * 128 * 2;
constexpr size_t WS_GL    = WS_GS + (size_t)4096 * 128 * 128 * 2;
constexpr size_t WS_END   = WS_GL + 16384;
constexpr size_t WS_OAT   = WS_GA;
constexpr size_t WS_KSH   = WS_GB;
constexpr size_t WS_VSH   = WS_GB + (size_t)67108864;
constexpr size_t WS_QD    = WS_GQ;

constexpr int LDS_BYTES = 147456;
constexpr int LDS_BARW  = 147456 - 64;

struct Params { const float* in[26]; float* out; unsigned char* ws; int ph_lo, ph_hi; };
typedef const Params __attribute__((address_space(4)))* PK;
#define PK_FRESH(p) asm volatile("" : "+s"(p))

#define XB_TMO      128
#define XB_XCNT(j)  (256  + 64 * (j))
#define XB_XSUB(j)  (1280 + 64 * (j))
#define XB_XGEN(j)  (2304 + 64 * (j))
#define XB_TOP      3328
#define XB_TOPGEN   3392
#define XCD_BAR_WORDS 3456
#define XB_SPIN_CAP (1u << 20)

__device__ __forceinline__ unsigned xb_ld(unsigned* p)              { return __hip_atomic_load(p, __ATOMIC_RELAXED, __HIP_MEMORY_SCOPE_AGENT); }
__device__ __forceinline__ unsigned xb_add(unsigned* p, unsigned v) { return __hip_atomic_fetch_add(p, v, __ATOMIC_RELAXED, __HIP_MEMORY_SCOPE_AGENT); }
__device__ __forceinline__ unsigned xb_xcc_id() { return (unsigned)__builtin_amdgcn_s_getreg((3 << 11) | 20) & 0xFu; }
#define XB_SPIN(cond, bar) do { unsigned _sp = 0; while (cond) { __builtin_amdgcn_s_sleep(1); \
    if ((++_sp & 255u) == 0u) { if (xb_ld(&(bar)[XB_TMO])) break; if (_sp > XB_SPIN_CAP) { atomicAdd(&(bar)[XB_TMO], 1u); break; } } } } while (0)

struct XcdBarrier { unsigned* bar; unsigned x; volatile LAS unsigned* st; int wv; };

__device__ __forceinline__ XcdBarrier xcd_barrier_post(unsigned* bar, volatile LAS unsigned* st, int wv) {
    XcdBarrier b; b.bar = bar; b.x = xb_xcc_id(); b.st = st; b.wv = wv;
    if (wv == 0 && lane_id() == 0) (void)xb_add(&bar[XB_XCNT(b.x)], 1u);
    return b;
}
__device__ __forceinline__ void xcd_barrier_complete(unsigned* bar, unsigned x, unsigned& nloc, unsigned& nx) {
    const unsigned G = gridDim.x * gridDim.y * gridDim.z;
    unsigned sum, cnt, mine, sp = 0u;
    for (;;) {
        sum = 0u; cnt = 0u; mine = 0u;
#pragma unroll
        for (unsigned j = 0; j < 16; ++j) { const unsigned c = xb_ld(&bar[XB_XCNT(j)]); sum += c; cnt += (c > 0u) ? 1u : 0u; mine = (j == x) ? c : mine; }
        if (sum == G) break;
        __builtin_amdgcn_s_sleep(1);
        if ((++sp & 255u) == 0u) { if (xb_ld(&bar[XB_TMO])) break; if (sp > XB_SPIN_CAP) { atomicAdd(&bar[XB_TMO], 1u); break; } }
    }
    nloc = mine > 0u ? mine : 1u; nx = cnt > 0u ? cnt : 1u;
}
__device__ __forceinline__ void xcd_barrier(const XcdBarrier& b) {
    asm volatile("s_waitcnt vmcnt(0)" ::: "memory");
    __syncthreads();
    if (b.wv == 0 && lane_id() == 0) {
        unsigned* bar = b.bar;
        __builtin_amdgcn_s_waitcnt(0);
        unsigned nloc = b.st[0], nx = b.st[1];
        if (nloc == 0u) { xcd_barrier_complete(bar, b.x, nloc, nx); b.st[0] = nloc; b.st[1] = nx; }
        const unsigned old = xb_add(&bar[XB_XSUB(b.x)], 1u);
        const unsigned gen = old / nloc;
        if (old + 1u == (gen + 1u) * nloc) {
            __builtin_amdgcn_fence(__ATOMIC_RELEASE, "agent");
            asm volatile("s_waitcnt vmcnt(0)" ::: "memory");
            const unsigned og = xb_add(&bar[XB_TOP], 1u);
            const unsigned tg = og / nx;
            if (og + 1u == (tg + 1u) * nx) xb_add(&bar[XB_TOPGEN], 1u);
            else XB_SPIN(xb_ld(&bar[XB_TOPGEN]) == tg, bar);
            __builtin_amdgcn_fence(__ATOMIC_ACQUIRE, "agent");
            xb_add(&bar[XB_XGEN(b.x)], 1u);
            asm volatile("s_waitcnt vmcnt(0)" ::: "memory");
        } else {
            XB_SPIN(xb_ld(&bar[XB_XGEN(b.x)]) == gen, bar);
            __builtin_amdgcn_fence(__ATOMIC_ACQUIRE, "agent");
            asm volatile("s_waitcnt vmcnt(0)" ::: "memory");
        }
    }
    __syncthreads();
}

namespace pg8 {
#define PG8_LAS __attribute__((address_space(3)))
constexpr int BM = 256, BK = 64, HALF = 128, HTB = HALF * BK * 2, STAGE_BYTES = 8 * HTB, NXCD = 8, WGM = 8;
__host__ __device__ __forceinline__ int lds_byte(int r, int c) { const int st = (r >> 4) * 2 + (c >> 5), rr = r & 15, cc = c & 31, ob = rr * 64 + cc * 2; return st * 1024 + (ob ^ (((ob >> 9) & 1) << 5)); }
__host__ __device__ __forceinline__ void stage_rc(int b, int& R, int& C) { const int st = b / 1024, sb = b % 1024, swz = sb ^ (((sb >> 9) & 1) << 5); R = (st >> 1) * 16 + swz / 64; C = (st & 1) * 32 + (swz % 64) / 2; }
__host__ __device__ __forceinline__ int perm32(int rho) { const int n = rho >> 4, i = rho & 15; return 8 * (i >> 2) + 4 * n + (i & 3); }
struct Unit { int pm, pn; };
struct Gemm { const bf16_t* A; const bf16_t* Bt; int M, N, K; int ld; int ksplit; };
struct StaticOrder {
    int nM, nN, nwg, G, c;
    __host__ __device__ void init(int M, int N, int G_, int c_) { nM = M / BM; nN = N / BM; nwg = nM * nN; G = G_; c = c_; }
    __host__ __device__ bool next(int i, Unit& u) const {
        const long L = (long)i * G + c; if (L >= nwg) return false;
        int wgid = (int)L; { const int q = nwg / NXCD, r = nwg % NXCD, xcd = wgid % NXCD, off = wgid / NXCD; wgid = (xcd < r ? xcd * (q + 1) : r * (q + 1) + (xcd - r) * q) + off; }
        const int nig = WGM * nN, gid = wgid / nig, fm = gid * WGM, gsz = (nM - fm) < WGM ? (nM - fm) : WGM;
        u.pm = fm + ((wgid % nig) % gsz); u.pn = (wgid % nig) / gsz; return true;
    }
    __device__ __forceinline__ void a_ready(const Unit&) const {}
    __device__ __forceinline__ void done(const Unit&) const {}
};

struct EpiMk {
    static constexpr bool PERM = true, AFTER_DRAIN = false;
    int mode; bf16_t* O; int ldc; const float* xin; const bf16_t* xinb; bf16_t* xout; const float* gate; float gmul;
    bf16_t* O2; int nrope; const float* cosT; const float* sinT;
    float* xoutf;
    __device__ __forceinline__ void operator()(const f32x4 (&acc)[2][2][4][2], const Unit& u, int wr, int wc, int fr, int fq) const {
        const int row0 = u.pm * BM + wr * 64 + fr, col0 = u.pn * BM + wc * 32 + 8 * fq;
        if (mode == 0) {
#pragma unroll
            for (int ai = 0; ai < 2; ++ai)
#pragma unroll
                for (int m = 0; m < 4; ++m) { bf16_t* rowp = O + (size_t)(row0 + ai * HALF + m * 16) * ldc + col0;
#pragma unroll
                    for (int bj = 0; bj < 2; ++bj) { const f32x4 v0 = acc[ai][bj][m][0], v1 = acc[ai][bj][m][1];
                        u32x4 w; w.x = cvt_pk_bf16(v0[0], v0[1]); w.y = cvt_pk_bf16(v0[2], v0[3]); w.z = cvt_pk_bf16(v1[0], v1[1]); w.w = cvt_pk_bf16(v1[2], v1[3]);
                        *(u32x4*)(rowp + bj * HALF) = w; } }
        } else if (mode == 3) {
            if (wc == 0) {
#pragma unroll
                for (int ai = 0; ai < 2; ++ai)
#pragma unroll
                    for (int m = 0; m < 4; ++m) { const int row = row0 + ai * HALF + m * 16; float* dp = xoutf + ((size_t)u.pn * T + row) * 32 + 8 * fq;
                        *(f32x4*)dp = acc[ai][0][m][0]; *(f32x4*)(dp + 4) = acc[ai][0][m][1]; }
            }
        } else if (mode == 2) {
#pragma unroll
            for (int ai = 0; ai < 2; ++ai)
#pragma unroll
                for (int m = 0; m < 4; ++m) { const int row = row0 + ai * HALF + m * 16, bb = row >> 13, ss = row & 8191;
#pragma unroll
                    for (int bj = 0; bj < 2; ++bj) { const int col = col0 + bj * HALF; const f32x4 v0 = acc[ai][bj][m][0], v1 = acc[ai][bj][m][1];
                        if (col < nrope) { const int hc = col >> 7, j0 = ((col & 127) >> 3) * 4;
                            const f32x4 cs = *(const f32x4*)(cosT + (size_t)row * 64 + j0), sn = *(const f32x4*)(sinT + (size_t)row * 64 + j0);
                            bf16_t* dp = O + ((size_t)(bb * 16 + hc) * SEQ + ss) * 128 + j0;
                            u32x2 w1, w2; w1.x = cvt_pk_bf16(v0[0] * cs[0] - v1[0] * sn[0], v0[1] * cs[1] - v1[1] * sn[1]); w1.y = cvt_pk_bf16(v0[2] * cs[2] - v1[2] * sn[2], v0[3] * cs[3] - v1[3] * sn[3]);
                            w2.x = cvt_pk_bf16(v1[0] * cs[0] + v0[0] * sn[0], v1[1] * cs[1] + v0[1] * sn[1]); w2.y = cvt_pk_bf16(v1[2] * cs[2] + v0[2] * sn[2], v1[3] * cs[3] + v0[3] * sn[3]);
                            *(u32x2*)dp = w1; *(u32x2*)(dp + 64) = w2;
                        } else { const int cv = col - nrope, hc = cv >> 7;
                            u32x4 w; w.x = cvt_pk_bf16(v0[0], v0[1]); w.y = cvt_pk_bf16(v0[2], v0[3]); w.z = cvt_pk_bf16(v1[0], v1[1]); w.w = cvt_pk_bf16(v1[2], v1[3]);
                            *(u32x4*)(O2 + ((size_t)(bb * 16 + hc) * SEQ + ss) * 128 + (cv & 127)) = w; } } }
        } else {
#pragma unroll
            for (int ai = 0; ai < 2; ++ai)
#pragma unroll
                for (int m = 0; m < 4; ++m) { const int row = row0 + ai * HALF + m * 16; const float* gp = gate + (size_t)(row >> 13) * MODC + col0;
                    bf16_t* xo = xout + (size_t)row * D + col0;
#pragma unroll
                    for (int bj = 0; bj < 2; ++bj) {
                        const f32x4 g0 = *(const f32x4*)(gp + bj * HALF), g1 = *(const f32x4*)(gp + bj * HALF + 4);
                        f32x4 x0, x1;
                        if (xin) { x0 = *(const f32x4*)(xin + (size_t)row * D + col0 + bj * HALF); x1 = *(const f32x4*)(xin + (size_t)row * D + col0 + bj * HALF + 4); }
                        else { const u32x4 xb = *(const u32x4*)(xinb + (size_t)row * D + col0 + bj * HALF);
                            x0 = (f32x4){bflo(xb.x), bfhi(xb.x), bflo(xb.y), bfhi(xb.y)}; x1 = (f32x4){bflo(xb.z), bfhi(xb.z), bflo(xb.w), bfhi(xb.w)}; }
                        const f32x4 y0 = x0 + gmul * g0 * acc[ai][bj][m][0], y1 = x1 + gmul * g1 * acc[ai][bj][m][1];
                        u32x4 w; w.x = cvt_pk_bf16(y0[0], y0[1]); w.y = cvt_pk_bf16(y0[2], y0[3]); w.z = cvt_pk_bf16(y1[0], y1[1]); w.w = cvt_pk_bf16(y1[2], y1[3]);
                        *(u32x4*)(xo + bj * HALF) = w; } }
        }
    }
};

template <class Epi, class Sched>
__device__ __forceinline__ void gemm_phase(PG8_LAS unsigned char* lds, const Gemm g, const Sched& S, const Epi& E, const int wv) {
    const int tid = ltid(wv), wid = __builtin_amdgcn_readfirstlane(tid >> 6), lane = tid & 63, wr = wid >> 2, wc = wid & 3, fr = lane & 15, fq = lane >> 4;
    const int K = g.K, nt = K / BK, ld = g.ld;
    unsigned voffA[2], voffB[2];
#pragma unroll
    for (int i = 0; i < 2; ++i) { int R, C; stage_rc(tid * 16 + i * 8192, R, C); const int Rb = Epi::PERM ? ((R & ~31) + perm32(R & 31)) : R;
        voffA[i] = (unsigned)(R * ld + C) * 2u; voffB[i] = (unsigned)(Rb * ld + C) * 2u; }
    const size_t kstep = (size_t)(BK * 2);
    const size_t hstep = (size_t)HALF * ld * 2;
    const size_t tstep = 2 * hstep;
    const unsigned ldsw = (unsigned)wid * 1024u;
    const int aoff = lds_byte(wr * 64 + fr, fq * 8), boff = lds_byte(wc * 32 + fr, fq * 8);
#define PG8_SA(b, h) (((b) * 2 + (h)) * HTB)
#define PG8_SB(b, h) ((4 + (b) * 2 + (h)) * HTB)
#define PG8_STAGE(bufoff, gbase, voff) do { _Pragma("unroll") for (int _i = 0; _i < 2; ++_i) \
        __builtin_amdgcn_global_load_lds((const unsigned*)((const char*)(gbase) + (voff)[_i]), (PG8_LAS unsigned*)(lds + (bufoff) + ldsw + _i * 8192), 16, 0, 0); } while (0)
#define PG8_LDA(dst, b, h) do { _Pragma("unroll") for (int m = 0; m < 4; ++m) _Pragma("unroll") for (int k = 0; k < 2; ++k) dst[m][k] = *(const PG8_LAS bf16x8*)(lds + PG8_SA(b, h) + aoff + m * 2048 + k * 1024); } while (0)
#define PG8_LDB(dst, b, h) do { _Pragma("unroll") for (int n = 0; n < 2; ++n) _Pragma("unroll") for (int k = 0; k < 2; ++k) dst[n][k] = *(const PG8_LAS bf16x8*)(lds + PG8_SB(b, h) + boff + n * 2048 + k * 1024); } while (0)
#define PG8_MMA(ai, bj, At, Bt) do { __builtin_amdgcn_s_setprio(1); _Pragma("unroll") for (int m = 0; m < 4; ++m) _Pragma("unroll") for (int n = 0; n < 2; ++n) _Pragma("unroll") for (int k = 0; k < 2; ++k) \
        acc[ai][bj][m][n] = __builtin_amdgcn_mfma_f32_16x16x32_bf16(Bt[n][k], At[m][k], acc[ai][bj][m][n], 0, 0, 0); __builtin_amdgcn_s_setprio(0); } while (0)
#define PG8_WAIT_V(n) asm volatile("s_waitcnt vmcnt(" #n ")" ::: "memory")
#define PG8_WAIT_L(n) asm volatile("s_waitcnt lgkmcnt(" #n ")" ::: "memory")
#define PG8_BAR __builtin_amdgcn_s_barrier()
#define PG8_SCHED __builtin_amdgcn_sched_barrier(0)
    Unit cur, nxt; int ui = 0;
    if (!S.next(0, cur)) return;
    f32x4 acc[2][2][4][2];
#pragma unroll
    for (int a = 0; a < 2; ++a)
#pragma unroll
        for (int b = 0; b < 2; ++b)
#pragma unroll
            for (int m = 0; m < 4; ++m)
#pragma unroll
                for (int n = 0; n < 2; ++n) acc[a][b][m][n] = (f32x4){0.f, 0.f, 0.f, 0.f};
    bf16x8 At[4][2], B0[2][2], B1[2][2];
    const size_t bstep = g.ksplit ? (size_t)K * 2 : tstep, astep = g.ksplit ? (size_t)K * 2 : 0;
    const char* cA = (const char*)g.A + (size_t)cur.pm * tstep + (size_t)cur.pn * astep; const char* cB = (const char*)g.Bt + (size_t)cur.pn * bstep;
    S.a_ready(cur);
    PG8_STAGE(PG8_SB(0, 0), cB, voffB); PG8_STAGE(PG8_SA(0, 0), cA, voffA); PG8_STAGE(PG8_SB(0, 1), cB + hstep, voffB); PG8_STAGE(PG8_SA(0, 1), cA + hstep, voffA);
    if (wr == 1) PG8_BAR;
    PG8_WAIT_V(4); PG8_BAR;
    PG8_STAGE(PG8_SB(1, 0), cB + kstep, voffB); PG8_STAGE(PG8_SA(1, 0), cA + kstep, voffA); PG8_STAGE(PG8_SB(1, 1), cB + hstep + kstep, voffB);
    PG8_WAIT_V(6); PG8_BAR;
    for (;;) {
        const bool has_next = S.next(ui + 1, nxt);
        const char* nA = has_next ? (const char*)g.A + (size_t)nxt.pm * tstep + (size_t)nxt.pn * astep : cA; const char* nB = has_next ? (const char*)g.Bt + (size_t)nxt.pn * bstep : cB;
        for (int t = 0; t < nt; t += 2) {
            const bool last = (t == nt - 2);
            const char* a1 = cA + (size_t)(t + 1) * kstep;
            const char* a2 = last ? nA : cA + (size_t)(t + 2) * kstep; const char* b2 = last ? nB : cB + (size_t)(t + 2) * kstep;
            const char* a3 = a2 + kstep; const char* b3 = b2 + kstep;
            if (last && has_next) S.a_ready(nxt);
            PG8_LDB(B0, 0, 0); PG8_SCHED; PG8_LDA(At, 0, 0); PG8_STAGE(PG8_SA(1, 1), a1 + hstep, voffA);
            PG8_WAIT_L(8); PG8_BAR; PG8_WAIT_L(0); PG8_MMA(0, 0, At, B0); PG8_BAR; PG8_SCHED;
            PG8_LDB(B1, 0, 1); PG8_STAGE(PG8_SB(0, 0), b2, voffB);
            PG8_BAR; PG8_WAIT_L(0); PG8_MMA(0, 1, At, B1); PG8_BAR;
            PG8_LDA(At, 0, 1); PG8_STAGE(PG8_SA(0, 0), a2, voffA);
            PG8_BAR; PG8_WAIT_L(0); PG8_MMA(1, 0, At, B0); PG8_BAR; PG8_SCHED;
            PG8_STAGE(PG8_SB(0, 1), b2 + hstep, voffB);
            PG8_WAIT_V(6); PG8_BAR; PG8_MMA(1, 1, At, B1); PG8_BAR;
            PG8_LDB(B0, 1, 0); PG8_SCHED; PG8_LDA(At, 1, 0); PG8_STAGE(PG8_SA(0, 1), a2 + hstep, voffA);
            PG8_WAIT_L(8); PG8_BAR; PG8_WAIT_L(0); PG8_MMA(0, 0, At, B0); PG8_BAR; PG8_SCHED;
            PG8_LDB(B1, 1, 1); PG8_STAGE(PG8_SB(1, 0), b3, voffB);
            PG8_BAR; PG8_WAIT_L(0); PG8_MMA(0, 1, At, B1); PG8_BAR;
            PG8_LDA(At, 1, 1); PG8_STAGE(PG8_SA(1, 0), a3, voffA);
            PG8_BAR; PG8_WAIT_L(0); PG8_MMA(1, 0, At, B0); PG8_BAR; PG8_SCHED;
            PG8_STAGE(PG8_SB(1, 1), b3 + hstep, voffB);
            PG8_WAIT_V(6); PG8_BAR; PG8_MMA(1, 1, At, B1); PG8_BAR;
        }
        E(acc, cur, wr, wc, fr, fq); S.done(cur);
        if (!has_next) break;
#pragma unroll
        for (int a = 0; a < 2; ++a)
#pragma unroll
            for (int b = 0; b < 2; ++b)
#pragma unroll
                for (int m = 0; m < 4; ++m)
#pragma unroll
                    for (int n = 0; n < 2; ++n) acc[a][b][m][n] = (f32x4){0.f, 0.f, 0.f, 0.f};
        cur = nxt; cA = nA; cB = nB; ++ui;
    }
    PG8_WAIT_V(0);
    if (wr == 0) PG8_BAR;
    PG8_BAR;
#undef PG8_SA
#undef PG8_SB
#undef PG8_STAGE
#undef PG8_LDA
#undef PG8_LDB
#undef PG8_MMA
#undef PG8_WAIT_V
#undef PG8_WAIT_L
#undef PG8_BAR
#undef PG8_SCHED
}
}

namespace att {
constexpr int D = 128;
constexpr float THR = 8.f;
constexpr bool WSKIP = false;
constexpr float SCALE = 0.08838834764831845f;
constexpr int NW = 8, QBLK = 32, KVBLK = 64, QB = NW * QBLK;
constexpr int SHM_V = KVBLK * D * 2, SHM_K = KVBLK * D * 2;
constexpr int LDS_BYTES = 2 * SHM_V + 2 * SHM_K + NW * 64 * 4;
using bf16 = __hip_bfloat16;
template <class A, class Bt> struct same_t { static constexpr bool v = false; };
template <class A> struct same_t<A, A> { static constexpr bool v = true; };
#define KSWZ(row, colB) ((row) * 256 + ((colB) ^ (((row) & 7) << 4)))
#define SBAR() __builtin_amdgcn_sched_barrier(0)
__device__ __forceinline__ int v_st(int k, int c) { const int kk = (k & ~0xC) | ((k & 4) << 1) | ((k & 8) >> 1); return ((kk >> 3) * 4 + (c >> 5)) * 512 + ((kk & 7) * 32 + (c & 31)) * 2; }
__device__ __forceinline__ int v_rd_base(int lane) { return ((lane & 3) << 3) | (((lane >> 2) & 3) << 6) | (((lane >> 4) & 1) << 5) | (((lane >> 5) & 1) << 8); }
constexpr int v_rd_off(int d0, int ks, int half) { return d0 * 512 + ks * 4096 + half * 2048; }
__device__ __forceinline__ int crow(int r, int hi) { return (r & 3) + 8 * (r >> 2) + 4 * hi; }
__device__ __forceinline__ unsigned cvtpk(float lo, float hi) {
    unsigned r; asm volatile("v_cvt_pk_bf16_f32 %0, %1, %2" : "=v"(r) : "v"(lo), "v"(hi)); return r;
}
__device__ __forceinline__ bf16x8 pack8(f32x4 a, f32x4 b) {
    u32x4 w = {cvtpk(a[0], a[1]), cvtpk(a[2], a[3]), cvtpk(b[0], b[1]), cvtpk(b[2], b[3])};
    return *reinterpret_cast<bf16x8*>(&w);
}
template <class T> __device__ __forceinline__ bf16x8 load8(const T* p) {
    if constexpr (same_t<T, float>::v) { return pack8(*(const f32x4*)p, *(const f32x4*)(p + 4)); }
    else { return *reinterpret_cast<const bf16x8*>(p); }
}
__device__ __forceinline__ void mask_tile(f32x16& p0, f32x16& p1, int dq, unsigned W) {
    const float NEG = -__builtin_inff();
#pragma unroll
    for (int r = 0; r < 16; ++r) {
        const int c = (r & 3) + 8 * (r >> 2);
        if ((unsigned)(dq - c) >= W) p0[r] = NEG;
        if ((unsigned)(dq - c - 32) >= W) p1[r] = NEG;
    }
}
__device__ __forceinline__ void partialSM(f32x16& p0, f32x16& p1, float& m_reg, float& mn, float& alpha) {
    float pmax = p0[0]; for (int r = 1; r < 16; ++r) pmax = fmaxf(pmax, p0[r]); for (int r = 0; r < 16; ++r) pmax = fmaxf(pmax, p1[r]);
    { auto rr = __builtin_amdgcn_permlane32_swap(__float_as_uint(pmax), __float_as_uint(pmax), false, false);
      pmax = fmaxf(__uint_as_float(rr[0]), __uint_as_float(rr[1])); }
    constexpr float C2 = 1.4426950408889634f * SCALE;
    if (__builtin_expect(__all((pmax - m_reg) * SCALE <= THR), 1)) { mn = m_reg; alpha = 1.f; }
    else { mn = fmaxf(m_reg, pmax); alpha = __builtin_amdgcn_exp2f((m_reg - mn) * C2); m_reg = mn; }
    const float mnL = -mn * C2;
    for (int r = 0; r < 16; ++r) p0[r] = fmaf(p0[r], C2, mnL); for (int r = 0; r < 16; ++r) p1[r] = fmaf(p1[r], C2, mnL);
    for (int r = 0; r < 16; ++r) p0[r] = __builtin_amdgcn_exp2f(p0[r]);
}
__device__ __forceinline__ void finishSM(f32x16& p0, f32x16& p1, float alpha, float& l_reg, bf16x8& pa0, bf16x8& pa1, bf16x8& pa2, bf16x8& pa3) {
    for (int r = 0; r < 16; ++r) p1[r] = __builtin_amdgcn_exp2f(p1[r]);
    float ps = 0; for (int r = 0; r < 16; ++r) ps += p0[r]; for (int r = 0; r < 16; ++r) ps += p1[r];
    { auto rr = __builtin_amdgcn_permlane32_swap(__float_as_uint(ps), __float_as_uint(ps), false, false);
      ps = __uint_as_float(rr[0]) + __uint_as_float(rr[1]); }
    l_reg = l_reg * alpha + ps;
#define PK4(P, B_, OUT) do { unsigned a0 = cvtpk(P[B_+0], P[B_+1]), a1 = cvtpk(P[B_+2], P[B_+3]);                          \
        unsigned b0 = cvtpk(P[B_+4], P[B_+5]), b1 = cvtpk(P[B_+6], P[B_+7]);                                             \
        auto r0 = __builtin_amdgcn_permlane32_swap(a0, b0, false, false); auto r1 = __builtin_amdgcn_permlane32_swap(a1, b1, false, false); \
        u32x4 w = {r0[0], r1[0], r0[1], r1[1]}; OUT = *reinterpret_cast<bf16x8*>(&w); } while (0)
    PK4(p0, 0, pa0); PK4(p0, 8, pa1); PK4(p1, 0, pa2); PK4(p1, 8, pa3);
#undef PK4
}
template <int KB, bool SK>
__device__ __forceinline__ void qkt(f32x16& p0, f32x16& p1, const char* K_lds, int r32, int hi, const bf16x8* qr, bool act) {
    if (SK && !act) { const float NEG = -__builtin_inff();
#pragma unroll
        for (int r = 0; r < 16; ++r) { p0[r] = NEG; p1[r] = NEG; } return; }
    p0 = f32x16{}; p1 = f32x16{};
    const char* kb[4];
#pragma unroll
    for (int dd = 0; dd < 4; ++dd) kb[dd] = K_lds + KB * SHM_K + KSWZ(r32, (dd * 16 + hi * 8) * 2);
#pragma unroll
    for (int d0 = 0; d0 < 8; ++d0) { const char* a = kb[d0 & 3] + (d0 >> 2) * 128;
        bf16x8 b0 = *reinterpret_cast<const bf16x8*>(a);
        bf16x8 b1 = *reinterpret_cast<const bf16x8*>(a + 32 * 256);
        p0 = __builtin_amdgcn_mfma_f32_32x32x16_bf16(b0, qr[d0], p0, 0, 0, 0);
        p1 = __builtin_amdgcn_mfma_f32_32x32x16_bf16(b1, qr[d0], p1, 0, 0, 0); }
}
template <int VB, bool SK>
__device__ __forceinline__ void pv_tile(f32x16* o, int vb0, bf16x8 pa0, bf16x8 pa1, bf16x8 pa2, bf16x8 pa3, bool act) {
    if (SK && !act) return;
#define TRRD(dst, off) asm volatile("ds_read_b64_tr_b16 %0, %1 offset:%2" : "=&v"(dst) : "v"(vb0), "i"(off) : "memory")
#define PV_D0(d0) do { s16x4 l0, l1, l2, l3, h0, h1, h2, h3; constexpr int b_ = VB * SHM_V + v_rd_off(d0, 0, 0);     \
        TRRD(l0, b_); TRRD(h0, b_ + 2048); TRRD(l1, b_ + 4096); TRRD(h1, b_ + 6144); TRRD(l2, b_ + 8192); TRRD(h2, b_ + 10240); TRRD(l3, b_ + 12288); TRRD(h3, b_ + 14336); \
        asm volatile("s_waitcnt lgkmcnt(0)" ::: "memory"); SBAR();                 \
        o[d0] = __builtin_amdgcn_mfma_f32_32x32x16_bf16(pa0, (bf16x8){l0[0], l0[1], l0[2], l0[3], h0[0], h0[1], h0[2], h0[3]}, o[d0], 0, 0, 0);   \
        o[d0] = __builtin_amdgcn_mfma_f32_32x32x16_bf16(pa1, (bf16x8){l1[0], l1[1], l1[2], l1[3], h1[0], h1[1], h1[2], h1[3]}, o[d0], 0, 0, 0);   \
        o[d0] = __builtin_amdgcn_mfma_f32_32x32x16_bf16(pa2, (bf16x8){l2[0], l2[1], l2[2], l2[3], h2[0], h2[1], h2[2], h2[3]}, o[d0], 0, 0, 0);   \
        o[d0] = __builtin_amdgcn_mfma_f32_32x32x16_bf16(pa3, (bf16x8){l3[0], l3[1], l3[2], l3[3], h3[0], h3[1], h3[2], h3[3]}, o[d0], 0, 0, 0); } while (0)
    PV_D0(0); PV_D0(1); PV_D0(2); PV_D0(3);
#undef PV_D0
#undef TRRD
}

template <class TIn, class TOut> struct BlockRef { const TIn* Q; const TIn* K; const TIn* V; TOut* O; int P0; };
template <class TIn> struct Seam {
    bf16x8 qr[8];
    bf16x8 st_v0, st_v1, st_k0, st_k1; f32x4 sf0, sf1, sf2, sf3;
    f32x4 tq[16];
};
__device__ __forceinline__ int swa_jlo(int P0, int W) { const int lowk = P0 - W + 1; return lowk > 0 ? lowk / KVBLK : 0; }
#define ROW(p, k0, rr) ((p) + (size_t)((k0) + (rr)) * D + sc)
#define VMW() asm volatile("s_waitcnt vmcnt(0)" ::: "memory")
#define VMWN(n) asm volatile("s_waitcnt vmcnt(%0)" :: "i"(n) : "memory")
#define SLOAD_H(Kp, Vp, k0) do { S.st_v0 = load8<TIn>(ROW(Vp, k0, sr)); S.st_v1 = load8<TIn>(ROW(Vp, k0, 32 + sr));              \
                         S.st_k0 = load8<TIn>(ROW(Kp, k0, sr)); S.st_k1 = load8<TIn>(ROW(Kp, k0, 32 + sr)); } while (0)
#define SWRITE_HK(bf) do { *(bf16x8*)(K_lds + (bf) * SHM_K + kws) = S.st_k0; *(bf16x8*)(K_lds + (bf) * SHM_K + kws + 32 * 256) = S.st_k1; } while (0)
#define SWRITE_HV(bf) do { *(bf16x8*)(V_lds + (bf) * SHM_V + vst0) = S.st_v0; *(bf16x8*)(V_lds + (bf) * SHM_V + vst1) = S.st_v1; } while (0)
#define SWRITE_H(bf) do { SWRITE_HV(bf); SWRITE_HK(bf); } while (0)
#define SLOAD_F(p, k0) do { S.sf0 = *(const f32x4*)ROW(p, k0, sr); S.sf1 = *(const f32x4*)(ROW(p, k0, sr) + 4);                \
                            S.sf2 = *(const f32x4*)ROW(p, k0, 32 + sr); S.sf3 = *(const f32x4*)(ROW(p, k0, 32 + sr) + 4); } while (0)
#define SWRITE_KF(bf) do { *(bf16x8*)(K_lds + (bf) * SHM_K + kws) = pack8(S.sf0, S.sf1); *(bf16x8*)(K_lds + (bf) * SHM_K + kws + 32 * 256) = pack8(S.sf2, S.sf3); } while (0)
#define SWRITE_VF(bf) do { *(bf16x8*)(V_lds + (bf) * SHM_V + vst0) = pack8(S.sf0, S.sf1); *(bf16x8*)(V_lds + (bf) * SHM_V + vst1) = pack8(S.sf2, S.sf3); } while (0)
template <class TIn, class TOut>
__device__ __forceinline__ void causal_swa_prime(const BlockRef<TIn, TOut>& cur, int W, char* lds, Seam<TIn>& S, const int wv) {
    constexpr bool F32 = same_t<TIn, float>::v;
    const int tid = ltid(wv), wid = __builtin_amdgcn_readfirstlane(tid >> 6), lane = tid & 63, r32 = lane & 31, hi = lane >> 5;
    const int sr = tid >> 4, sc = (tid & 15) * 8, kws = KSWZ(sr, sc * 2); char* K_lds = lds + 2 * SHM_V;
    const int kb0 = swa_jlo(cur.P0, W) * KVBLK;
    for (int d0 = 0; d0 < 8; ++d0) S.qr[d0] = load8<TIn>(cur.Q + (size_t)(wid * QBLK + r32) * D + d0 * 16 + hi * 8);
    if constexpr (F32) { SLOAD_F((const float*)cur.K, kb0); VMW(); SWRITE_KF(0); SBAR(); SLOAD_F((const float*)cur.V, kb0); }
    else { SLOAD_H(cur.K, cur.V, kb0); VMW(); SWRITE_HK(0); }
    __syncthreads();
}
template <class TIn, class TOut>
__device__ __forceinline__ void causal_swa_block(const BlockRef<TIn, TOut>& cur, const BlockRef<TIn, TOut>& nxt, int skv, int W, char* lds, Seam<TIn>& S, const int wv) {
    constexpr bool F32 = same_t<TIn, float>::v;
    const int tid = ltid(wv), wid = __builtin_amdgcn_readfirstlane(tid >> 6), lane = tid & 63, r32 = lane & 31, hi = lane >> 5;
    const int j_lo = swa_jlo(cur.P0, W);
    int j_hi = (cur.P0 + QB - 1) / KVBLK + 1; if (j_hi > skv / KVBLK) j_hi = skv / KVBLK;
    const int NT = j_hi - j_lo;
    const int kbn = swa_jlo(nxt.P0, W) * KVBLK;
    const int qlo = cur.P0 + wid * QBLK, qm = qlo + r32 - 4 * hi;
    char* V_lds = lds; char* K_lds = lds + 2 * SHM_V;
    float* ws = (float*)(lds + 2 * SHM_V + 2 * SHM_K) + wid * 64; float* li_l = ws, * al_l = ws + 32;
    float m_reg = -1e30f, l_reg = 0; f32x16 o[4] = {};
    const int sr = tid >> 4, sc = (tid & 15) * 8, vst0 = v_st(sr, sc), vst1 = v_st(32 + sr, sc), kws = KSWZ(sr, sc * 2);
    const int vb0 = (int)(uintptr_t)V_lds + v_rd_base(lane);
    const TIn* Kh = cur.K; const TIn* Vh = cur.V;
#define RESC(a) do { if (__any((a) < 1.f)) { if (hi == 0) al_l[r32] = (a); asm volatile("s_waitcnt lgkmcnt(0)" ::: "memory");              \
                     for (int d_ = 0; d_ < 4; ++d_) for (int r = 0; r < 16; ++r) o[d_][r] *= al_l[crow(r, hi)]; } } while (0)
#define KBASE(t) ((j_lo + (t)) * KVBLK)
#define ACT(t) (KBASE(t) <= qlo + QBLK - 1 && KBASE(t) + KVBLK - 1 >= qlo - W + 1)
#define MASKT(P0_, P1_, t) do { const int kb_ = KBASE(t); if ((!SK || ACT(t)) && (kb_ + KVBLK - 1 > qlo || kb_ <= qlo + QBLK - 1 - W)) mask_tile(P0_, P1_, qm - kb_, (unsigned)W); } while (0)
    constexpr int NQL = F32 ? 16 : 8;
    constexpr bool SK = WSKIP && !F32;
#define SEAM_K0() do { VMWN(NQL); if constexpr (F32) { SWRITE_KF(0); SBAR(); SLOAD_F((const float*)nxt.V, kbn); } else { SWRITE_HK(0); } SBAR(); } while (0)
    f32x16 pA0, pA1, pB0, pB1; float mnA, mnB, alA, alB; bf16x8 pa0, pa1, pa2, pa3;
    if constexpr (F32) { VMW(); SWRITE_VF(0); SBAR(); } else { SWRITE_HV(0); SBAR(); }
    if (NT > 1) { if constexpr (F32) SLOAD_F((const float*)Kh, KBASE(1)); else SLOAD_H(Kh, Vh, KBASE(1)); }
    SBAR(); qkt<0, SK>(pA0, pA1, K_lds, r32, hi, S.qr, ACT(0));
    if constexpr (F32) { if (NT > 1) { VMW(); SWRITE_KF(1); SBAR(); SLOAD_F((const float*)Vh, KBASE(1)); } }
    MASKT(pA0, pA1, 0); partialSM(pA0, pA1, m_reg, mnA, alA);
    if (NT > 1) { VMW(); if constexpr (F32) { SWRITE_VF(1); SBAR(); if (NT > 2) SLOAD_F((const float*)Kh, KBASE(2)); } else SWRITE_H(1); }
    __syncthreads();
#define HALF_STEP(PX0, PX1, mnX, alX, PY0, PY1, alY, t, KB, VB, SB) do {                                                      \
        SBAR(); qkt<KB, SK>(PX0, PX1, K_lds, r32, hi, S.qr, ACT(t));                                             \
        finishSM(PY0, PY1, alY, l_reg, pa0, pa1, pa2, pa3); SBAR();                                                           \
        if ((t) + 1 < NT) { if constexpr (F32) { VMW(); SWRITE_KF(SB); SBAR(); SLOAD_F((const float*)Vh, KBASE((t) + 1)); }  \
                            else { SLOAD_H(Kh, Vh, KBASE((t) + 1)); } SBAR(); }                                               \
        pv_tile<VB, SK>(o, vb0, pa0, pa1, pa2, pa3, ACT((t) - 1)); MASKT(PX0, PX1, (t)); partialSM(PX0, PX1, m_reg, mnX, alX);                                        \
        __syncthreads();                                                                                                      \
        if ((t) + 1 < NT) { VMW(); if constexpr (F32) { SWRITE_VF(SB); SBAR(); if ((t) + 2 < NT) SLOAD_F((const float*)Kh, KBASE((t) + 2)); } \
                            else { SWRITE_H(SB); } }                                                                          \
        RESC(alX); __syncthreads(); } while (0)
    for (int t = 1; t + 1 < NT; t += 2) {
        HALF_STEP(pB0, pB1, mnB, alB, pA0, pA1, alA, t, 1, 0, 0);
        HALF_STEP(pA0, pA1, mnA, alA, pB0, pB1, alB, t + 1, 0, 1, 1);
    }
    const bool even = (NT & 1) == 0;
    if (even) { SBAR(); qkt<1, SK>(pB0, pB1, K_lds, r32, hi, S.qr, ACT(NT - 1)); SBAR(); }
#define QROW(e) (nxt.Q + (size_t)(wid * QBLK + r32) * D + ((e) >> 1) * 16 + hi * 8 + ((e) & 1) * 4)
    if constexpr (F32) { SLOAD_F((const float*)nxt.K, kbn); SBAR();
#pragma unroll
        for (int e = 0; e < 8; ++e) S.tq[e] = *(const f32x4*)QROW(e); }
    else { SLOAD_H(nxt.K, nxt.V, kbn); SBAR();
#pragma unroll
        for (int d0 = 0; d0 < 8; ++d0) S.qr[d0] = load8<TIn>(nxt.Q + (size_t)(wid * QBLK + r32) * D + d0 * 16 + hi * 8); }
    SBAR();
    finishSM(pA0, pA1, alA, l_reg, pa0, pa1, pa2, pa3); SBAR();
    if constexpr (F32) {
#pragma unroll
        for (int e = 8; e < 16; ++e) S.tq[e] = *(const f32x4*)QROW(e); SBAR(); }
#undef QROW
    pv_tile<0, SK>(o, vb0, pa0, pa1, pa2, pa3, ACT(even ? NT - 2 : NT - 1));
    if (even) { MASKT(pB0, pB1, NT - 1); partialSM(pB0, pB1, m_reg, mnB, alB); __syncthreads(); RESC(alB);
        finishSM(pB0, pB1, alB, l_reg, pa0, pa1, pa2, pa3); SBAR(); pv_tile<1, SK>(o, vb0, pa0, pa1, pa2, pa3, ACT(NT - 1)); }
    SBAR(); SEAM_K0();
    if (hi == 0) li_l[r32] = l_reg; asm volatile("s_waitcnt lgkmcnt(0)" ::: "memory");
    float rli[16];
#pragma unroll
    for (int r = 0; r < 16; ++r) rli[r] = __builtin_amdgcn_rcpf(li_l[crow(r, hi)]);
    TOut* Ow = cur.O + (size_t)(wid * QBLK) * D;
#pragma unroll
    for (int r = 0; r < 16; ++r) { const int orow = crow(r, hi);
#pragma unroll
        for (int d0 = 0; d0 < 4; ++d0) { const float v = o[d0][r] * rli[r];
            if constexpr (same_t<TOut, float>::v) { Ow[(size_t)orow * D + d0 * 32 + r32] = v; }
            else { const float vn = sw_xor<1>(v);
                   if ((r32 & 1) == 0) *(unsigned*)(Ow + (size_t)orow * D + d0 * 32 + r32) = cvtpk(v, vn); } } }
    if constexpr (F32) {
#pragma unroll
        for (int d0 = 0; d0 < 8; ++d0) S.qr[d0] = pack8(S.tq[2 * d0], S.tq[2 * d0 + 1]); }
    __syncthreads();
#undef RESC
#undef KBASE
#undef ACT
#undef MASKT
#undef SEAM_K0
#undef HALF_STEP
}
#undef ROW
#undef VMW
#undef VMWN
#undef SLOAD_H
#undef SWRITE_HK
#undef SWRITE_HV
#undef SWRITE_H
#undef SLOAD_F
#undef SWRITE_KF
#undef SWRITE_VF
#undef KSWZ
#undef SBAR
}

#define MFMA16(a, b, c) __builtin_amdgcn_mfma_f32_16x16x32_bf16((a), (b), (c), 0, 0, 0)
#define MFMA32(a, b, c) __builtin_amdgcn_mfma_f32_32x32x16_bf16((a), (b), (c), 0, 0, 0)
#define WSP(T_, off) ((T_*)(p->ws + (off)))

DI void sincos_red(double r, float& s, float& c) {
    const double r2 = r * r; double sp = 1.0, cp = 1.0;
#pragma unroll
    for (int k = 13; k >= 1; --k) { sp = 1.0 - sp * r2 * (1.0 / (double)((2 * k) * (2 * k + 1))); cp = 1.0 - cp * r2 * (1.0 / (double)((2 * k - 1) * (2 * k))); }
    s = (float)(r * sp); c = (float)cp;
}

DI void cvt_wt_job(const float* src, bf16_t* dst, int N, int Npad, int nperm, float* tile, const int wv) {
    const int tid = ltid(wv), K = 2048, ntn = Npad / 64, ntiles = ntn * (K / 64), c = tid & 63, r0 = tid >> 6;
#define CW_LOAD(V, tl_) do { const int tn_ = (tl_) % ntn, tk_ = (tl_) / ntn, k0_ = tk_ * 64, n_ = tn_ * 64 + c; int ns_ = n_; \
        if (ns_ < nperm) { const int p7 = ns_ & 127, u = p7 >> 3, e = p7 & 7; ns_ = (ns_ & ~127) + ((e < 4) ? 4 * u + e : 64 + 4 * u + (e - 4)); } \
        _Pragma("unroll") for (int i = 0; i < 8; ++i) V[i] = (n_ < N) ? src[(size_t)(k0_ + r0 + 8 * i) * N + ns_] : 0.f; } while (0)
    float cur[8];
    if ((int)blockIdx.x < ntiles) CW_LOAD(cur, (int)blockIdx.x);
    for (int tl = blockIdx.x; tl < ntiles; tl += gridDim.x) {
        const int tn = tl % ntn, tk = tl / ntn, k0 = tk * 64, n0 = tn * 64;
        float nxt[8];
        const int tl2 = (tl + (int)gridDim.x < ntiles) ? tl + (int)gridDim.x : tl;
        CW_LOAD(nxt, tl2);
#pragma unroll
        for (int i = 0; i < 8; ++i) tile[(r0 + 8 * i) * 65 + c] = cur[i];
        lds_barrier();
#pragma unroll
        for (int i = 0; i < 4; ++i) { const int id = tid + 512 * i, rr = id >> 5, cp = id & 31;
            ((unsigned*)dst)[((size_t)(n0 + rr) * K + k0) / 2 + cp] = cvt_pk_bf16(tile[(2 * cp) * 65 + rr], tile[(2 * cp + 1) * 65 + rr]); }
        lds_barrier();
#pragma unroll
        for (int i = 0; i < 8; ++i) cur[i] = nxt[i];
    }
#undef CW_LOAD
}

DI void ph_prologue(PK p, unsigned char* lds, const int wv) {
    PK_FRESH(p);
    const int tid = ltid(wv), lane = tid & 63, wave = __builtin_amdgcn_readfirstlane(tid >> 6);
    float* ldsf = (float*)lds;
    {
        float* sc = ldsf; float* red = ldsf + 4096;
        for (int i = tid; i < 4096; i += 512) sc[i] = silu_f(p->in[1][i]);
        __syncthreads();
        float* mod = WSP(float, WS_MOD);
        for (int item = blockIdx.x; item < MODC / 64; item += gridDim.x) {
            const int col0 = item * 64, col = col0 + lane;
            const float* W; size_t stride;
            if (col0 < 4 * 12288) { const int l = col0 / 12288, j = col - l * 12288; W = p->in[3] + (size_t)l * 2048 * 12288 + j; stride = 12288; }
            else { W = p->in[14] + (col - 4 * 12288); stride = 4096; }
            float a0 = 0.f, a1 = 0.f;
            const int kb = wave * 256;
            float wa[16], wb[16];
#pragma unroll
            for (int u = 0; u < 16; ++u) wa[u] = W[(size_t)(kb + u) * stride];
            for (int k = 0; k < 256; k += 32) {
#pragma unroll
                for (int u = 0; u < 16; ++u) wb[u] = W[(size_t)(kb + k + 16 + u) * stride];
#pragma unroll
                for (int u = 0; u < 16; ++u) { a0 += sc[kb + k + u] * wa[u]; a1 += sc[2048 + kb + k + u] * wa[u]; }
                const int kn = (k + 32 < 256) ? k + 32 : k;
#pragma unroll
                for (int u = 0; u < 16; ++u) wa[u] = W[(size_t)(kb + kn + u) * stride];
#pragma unroll
                for (int u = 0; u < 16; ++u) { a0 += sc[kb + k + 16 + u] * wb[u]; a1 += sc[2048 + kb + k + 16 + u] * wb[u]; }
            }
            red[(wave * 64 + lane) * 2 + 0] = a0; red[(wave * 64 + lane) * 2 + 1] = a1;
            __syncthreads();
            if (tid < 128) { const int ln = tid & 63, b = tid >> 6; float s = 0.f;
#pragma unroll
                for (int w = 0; w < 8; ++w) s += red[(w * 64 + ln) * 2 + b];
                const int cc = col0 + ln; const float bias = (cc < 4 * 12288) ? p->in[4][cc] : p->in[15][cc - 4 * 12288];
                mod[(size_t)b * MODC + cc] = s + bias; }
            __syncthreads();
        }
    }
    for (int job = 0; job < 9; ++job) {
        const float* src; bf16_t* dst; int N = 2048, Npad = 2048, nperm = 0;
        if (job < 2) { src = p->in[7] + (size_t)job * 2048 * GIN; dst = WSP(bf16_t, WS_WIN) + (size_t)job * GINP * 2048; N = GIN; Npad = GINP; }
        else if (job < 4) { src = p->in[12] + (size_t)(job - 2) * 2048 * 2048; dst = WSP(bf16_t, WS_WOUT) + (size_t)(job - 2) * 2048 * 2048; }
        else if (job == 4) { src = p->in[16]; dst = WSP(bf16_t, WS_KVW); N = 4096; Npad = 4096; nperm = 2048; }
        else if (job < 7) { src = p->in[17] + (size_t)(job - 5) * 2048 * 2048; dst = WSP(bf16_t, WS_DWQ) + (size_t)(job - 5) * 2048 * 2048; nperm = 2048; }
        else { src = p->in[20] + (size_t)(job - 7) * 2048 * 2048; dst = WSP(bf16_t, WS_DWO) + (size_t)(job - 7) * 2048 * 2048; }
        cvt_wt_job(src, dst, N, Npad, nperm, ldsf, wv);
    }
    {
        const int lane = tid & 63, r16 = lane & 15, quad = lane >> 4;
        bf16_t* wdst = WSP(bf16_t, WS_PWQ);
        for (int task = (blockIdx.x * 8 + wave); task < 4 * 16 * 128; task += gridDim.x * 8) {
            const int kt = task & 127, pj = (task >> 7) & 15, l = task >> 11, pp = pj >> 1, jh = pj & 1;
            const float* wq = p->in[21] + ((size_t)l * 2048 + kt * 16 + r16) * 2048 + pp * 256 + jh * 128 + quad * 8;
            const float* ky = p->in[22] + ((size_t)(l * 2 + jh) * 128 + r16) * 128 + quad * 8;
            bf16x8 bw[4];
#pragma unroll
            for (int ks = 0; ks < 4; ++ks) { const f32x4 a = *(const f32x4*)(wq + ks * 32), b = *(const f32x4*)(wq + ks * 32 + 4);
                u32x4 w; w.x = cvt_pk_bf16(a[0], a[1]); w.y = cvt_pk_bf16(a[2], a[3]); w.z = cvt_pk_bf16(b[0], b[1]); w.w = cvt_pk_bf16(b[2], b[3]); bw[ks] = __builtin_bit_cast(bf16x8, w); }
#pragma unroll
            for (int nt = 0; nt < 8; ++nt) { f32x4 acc = {0.f, 0.f, 0.f, 0.f};
#pragma unroll
                for (int ks = 0; ks < 4; ++ks) { const f32x4 a = *(const f32x4*)(ky + (size_t)nt * 16 * 128 + ks * 32), b = *(const f32x4*)(ky + (size_t)nt * 16 * 128 + ks * 32 + 4);
                    u32x4 w; w.x = cvt_pk_bf16(a[0], a[1]); w.y = cvt_pk_bf16(a[2], a[3]); w.z = cvt_pk_bf16(b[0], b[1]); w.w = cvt_pk_bf16(b[2], b[3]);
                    acc = MFMA16(bw[ks], __builtin_bit_cast(bf16x8, w), acc); }
                u32x2 wo; wo.x = cvt_pk_bf16(acc[0], acc[1]); wo.y = cvt_pk_bf16(acc[2], acc[3]);
                *(u32x2*)(wdst + ((size_t)l * 2048 + pp * 256 + jh * 128 + nt * 16 + r16) * 2048 + kt * 16 + quad * 4) = wo; }
        }
    }
    {
        float* cosT = WSP(float, WS_COS); float* sinT = WSP(float, WS_SIN); const int* pos = (const int*)p->in[2];
        for (int idx = blockIdx.x * 512 + tid; idx < T * 64; idx += gridDim.x * 512) {
            const int t = idx >> 6, j = idx & 63;
            const double inv = exp(-(double)j * (9.210340371976184 / 64.0));
            const double ang = (double)pos[t] * inv;
            const double n = rint(ang * 0.15915494309189535);
            double r = fma(-n, 6.283185307179586, ang); r = fma(-n, 2.4492935982947064e-16, r);
            float s, c; sincos_red(r, s, c); cosT[idx] = c; sinT[idx] = s;
        }
    }
}

template <int MODE>
DI void ph_norm(const float* x, const bf16_t* xb, const float* g, const float* shift, const float* scale, bf16_t* dstb, float* dstf, const int wv) {
    const int tid = ltid(wv), lane = tid & 63, wave = __builtin_amdgcn_readfirstlane(tid >> 6);
    for (int row = blockIdx.x * 8 + wave; row < T; row += gridDim.x * 8) {
        const int b = row >> 13;
        f32x4 v[8]; float ss = 0.f;
#pragma unroll
        for (int i = 0; i < 8; ++i) {
            if (MODE == 2) { const u32x2 w = *(const u32x2*)(xb + (size_t)row * D + i * 256 + lane * 4); v[i] = (f32x4){bflo(w.x), bfhi(w.x), bflo(w.y), bfhi(w.y)}; }
            else v[i] = *(const f32x4*)(x + (size_t)row * D + i * 256 + lane * 4);
            ss += v[i][0] * v[i][0] + v[i][1] * v[i][1] + v[i][2] * v[i][2] + v[i][3] * v[i][3]; }
        ss = wave_sum(ss);
        const float r = rsqrtf(ss * (1.f / D) + NORM_EPS);
#pragma unroll
        for (int i = 0; i < 8; ++i) { const int col = i * 256 + lane * 4; const f32x4 gv = *(const f32x4*)(g + col);
            if (MODE != 1) { const f32x4 sh = *(const f32x4*)(shift + (size_t)b * MODC + col), sc = *(const f32x4*)(scale + (size_t)b * MODC + col);
                f32x4 y;
#pragma unroll
                for (int e = 0; e < 4; ++e) y[e] = v[i][e] * r * gv[e] * (1.f + sc[e]) + sh[e];
                u32x2 w; w.x = cvt_pk_bf16(y[0], y[1]); w.y = cvt_pk_bf16(y[2], y[3]); *(u32x2*)(dstb + (size_t)row * D + col) = w; }
            else { f32x4 y;
#pragma unroll
                for (int e = 0; e < 4; ++e) y[e] = v[i][e] * r * gv[e];
                *(f32x4*)(dstf + (size_t)row * D + col) = y; } }
    }
}

DI void pc_load(PK p, int l, int row, f32x4 (&v)[8], const int lane) {
    const float* s = ((row >= 16384) ? p->in[24] : p->in[23]) + ((size_t)l * 16384 + (row & 16383)) * 2048;
#pragma unroll
    for (int i = 0; i < 8; ++i) v[i] = *(const f32x4*)(s + lane * 32 + i * 4);
}
DI void pc_store(PK p, int row, const f32x4 (&v)[8], const int lane) {
    const bool second = row >= 16384; const int r = row & 16383;
    unsigned char* dq = WSP(unsigned char, second ? WS_PV : WS_PU); unsigned short* ds = WSP(unsigned short, WS_PUS);
    float m0 = 0.f;
#pragma unroll
    for (int i = 0; i < 8; ++i) { const float mm = fmaxf(fmaxf(fabsf(v[i][0]), fabsf(v[i][1])), fmaxf(fabsf(v[i][2]), fabsf(v[i][3]))); m0 = fmaxf(m0, mm); }
    m0 = fmaxf(m0, sw_xor<1>(m0)); m0 = fmaxf(m0, sw_xor<2>(m0));
    const bf16_t sb0 = (m0 > 0.f) ? f2bf(m0 * (1.004f / 6.f)) : (bf16_t)0x3f80;
    const float inv = 1.f / bf2f(sb0);
    u32x4 w;
#pragma unroll
    for (int c = 0; c < 4; ++c) { unsigned x = 0u;
        x = __builtin_amdgcn_cvt_scalef32_pk_fp4_f32(x, v[2 * c][0] * inv, v[2 * c][1] * inv, 1.0f, 0);
        x = __builtin_amdgcn_cvt_scalef32_pk_fp4_f32(x, v[2 * c][2] * inv, v[2 * c][3] * inv, 1.0f, 1);
        x = __builtin_amdgcn_cvt_scalef32_pk_fp4_f32(x, v[2 * c + 1][0] * inv, v[2 * c + 1][1] * inv, 1.0f, 2);
        x = __builtin_amdgcn_cvt_scalef32_pk_fp4_f32(x, v[2 * c + 1][2] * inv, v[2 * c + 1][3] * inv, 1.0f, 3);
        w[c] = x; }
    *(u32x4*)(dq + (size_t)r * 1024 + lane * 16) = w;
    if ((lane & 3) == 0) ds[((size_t)r * 16 + (lane >> 2)) * 2 + (second ? 1 : 0)] = (unsigned short)sb0;
}
DI void ph_peer_cvt(PK p, int l, const int wv) {
    PK_FRESH(p);
    const int tid = ltid(wv), lane = tid & 63, wave = __builtin_amdgcn_readfirstlane(tid >> 6);
    for (int row = blockIdx.x * 8 + wave; row < 2 * 16384; row += gridDim.x * 8) { f32x4 v[8]; pc_load(p, l, row, v, lane); pc_store(p, row, v, lane); }
}


template <int I, int J>
DI void tinv_block(const bf16_t* Lb, bf16_t* Ti, bf16_t* TT, bf16_t* XT, const int r16, const int quad) {
    constexpr int nK = 16 * (I - J);
    const bf16x8 zero8 = {0, 0, 0, 0, 0, 0, 0, 0};
    f32x4 acc = {0.f, 0.f, 0.f, 0.f};
#pragma unroll
    for (int ks = 0; ks < (nK + 31) / 32; ++ks) {
        const int k0 = ks * 32 + quad * 8; const bool valid = k0 < nK;
        const bf16x8 a = valid ? *(const bf16x8*)(Lb + (16 * I + r16) * 72 + 16 * J + k0) : zero8;
        const bf16x8 b = valid ? *(const bf16x8*)(TT + (16 * J + r16) * 72 + 16 * J + k0) : zero8;
        acc = MFMA16(a, b, acc);
    }
    { u32x2 w; w.x = cvt_pk_bf16(acc[0], acc[1]); w.y = cvt_pk_bf16(acc[2], acc[3]); *(u32x2*)(XT + r16 * 24 + quad * 4) = w; }
    asm volatile("s_waitcnt lgkmcnt(0)" ::: "memory");
    const bool v2 = quad < 2;
    const bf16x8 a2 = v2 ? *(const bf16x8*)(Ti + (16 * I + r16) * 72 + 16 * I + quad * 8) : zero8;
    const bf16x8 b2 = v2 ? *(const bf16x8*)(XT + r16 * 24 + quad * 8) : zero8;
    f32x4 m = {0.f, 0.f, 0.f, 0.f};
    m = MFMA16(a2, b2, m);
#pragma unroll
    for (int r = 0; r < 4; ++r) Ti[(16 * I + quad * 4 + r) * 72 + 16 * J + r16] = f2bf(-m[r]);
    { u32x2 w; w.x = cvt_pk_bf16(-m[0], -m[1]); w.y = cvt_pk_bf16(-m[2], -m[3]); *(u32x2*)(TT + (16 * J + r16) * 72 + 16 * I + quad * 4) = w; }
    asm volatile("s_waitcnt lgkmcnt(0)" ::: "memory");
}

DI void ph_gdn_p1(PK p, int l, unsigned char* lds, const int wv) {
    PK_FRESH(p);
    const bf16_t* proj = WSP(const bf16_t, WS_PROJ);
    const float* convw = p->in[8] + (size_t)l * 4 * 6144; const float* alog = p->in[9] + l * 16; const float* dtb = p->in[10] + l * 16;
    bf16_t* Ag = WSP(bf16_t, WS_GA); bf16_t* Bg = WSP(bf16_t, WS_GB); bf16_t* Qg = WSP(bf16_t, WS_GQ); bf16_t* Og = WSP(bf16_t, WS_GO); float* glg = WSP(float, WS_GL);
    bf16_t* qb  = (bf16_t*)(lds + 0);
    bf16_t* kb  = (bf16_t*)(lds + 17408);
    bf16_t* Lb  = (bf16_t*)(lds + 34816);
    bf16_t* wT  = (bf16_t*)(lds + 17408);
    bf16_t* vbT = (bf16_t*)(lds + 44032);
    bf16_t* kdT = (bf16_t*)(lds + 62464);
    bf16_t* kbT = (bf16_t*)(lds + 80896);
    bf16_t* uT  = (bf16_t*)(lds + 80896);
    bf16_t* aqk = (bf16_t*)(lds + 99328);
    bf16_t* Ti  = (bf16_t*)(lds + 108544);
    bf16_t* TT  = (bf16_t*)(lds + 117760);
    float*  Ld  = (float*)(lds + 126976);
    bf16_t* XT  = (bf16_t*)(lds + 132096);
    float*  sc  = (float*)(lds + 133120);
    float*  cw  = (float*)(lds + 134144);
    int cached_bh = -1;
    u32x4 rawp[3][5]; float pa_[4] = {0.f, 0.f, 0.f, 0.f}, pb_[4] = {0.f, 0.f, 0.f, 0.f};
#define P1_PREFETCH(itx) do { const int tid_ = ltid(wv), bh_ = (itx) & 31, n_ = (itx) >> 5, hd_ = bh_ & 15, b_ = bh_ >> 4, c16_ = tid_ & 15, t0_ = (tid_ >> 4) * 2; \
        _Pragma("unroll") for (int part = 0; part < 3; ++part) _Pragma("unroll") for (int r = 0; r < 5; ++r) { const int sp = n_ * 64 + t0_ - 3 + r; u32x4 raw = {0u, 0u, 0u, 0u}; \
            if (sp >= 0) raw = *(const u32x4*)(proj + (size_t)(b_ * SEQ + sp) * GINP + part * 2048 + hd_ * 128 + c16_ * 8); rawp[part][r] = raw; } \
        if (tid_ < 64) { const float* pab = WSP(const float, WS_PAB) + (size_t)(b_ * SEQ + n_ * 64 + tid_) * 32 + hd_; const size_t qs = (size_t)T * 32; \
            _Pragma("unroll") for (int q4 = 0; q4 < 4; ++q4) { pa_[q4] = pab[q4 * qs]; pb_[q4] = pab[q4 * qs + 16]; } } } while (0)
    if ((int)blockIdx.x < 4096) P1_PREFETCH((int)blockIdx.x);
    for (int it = blockIdx.x; it < 4096; it += gridDim.x) {
        const int tid = ltid(wv), lane = tid & 63, wave = __builtin_amdgcn_readfirstlane(tid >> 6), r16 = lane & 15, quad = lane >> 4;
        const int bh = it & 31, n = it >> 5, hd = bh & 15, b = bh >> 4, tok0 = b * SEQ + n * 64, ci = bh * 128 + n;
        if (bh != cached_bh) {
            for (int idx = tid; idx < 1536; idx += 512) { const int part = idx >> 9, tap = (idx >> 7) & 3, c = idx & 127; cw[idx] = convw[tap * 6144 + part * 2048 + hd * 128 + c]; }
            cached_bh = bh;
            lds_barrier();
        }
        float dtbv = 0.f, alogv = 0.f;
        if (tid < 64) { dtbv = dtb[hd]; alogv = alog[hd]; }
        {
            const int c16 = tid & 15, t0 = (tid >> 4) * 2;
#pragma unroll
            for (int part = 0; part < 3; ++part) {
                const int ch = part * 2048 + hd * 128 + c16 * 8;
                float xr[5][8];
#pragma unroll
                for (int r = 0; r < 5; ++r) {
                    const u32x4 raw = rawp[part][r];
                    xr[r][0] = bflo(raw.x); xr[r][1] = bfhi(raw.x); xr[r][2] = bflo(raw.y); xr[r][3] = bfhi(raw.y); xr[r][4] = bflo(raw.z); xr[r][5] = bfhi(raw.z); xr[r][6] = bflo(raw.w); xr[r][7] = bfhi(raw.w);
                }
                float wt[4][8];
#pragma unroll
                for (int tap = 0; tap < 4; ++tap) { const f32x4 w0 = *(const f32x4*)(cw + (part * 4 + tap) * 128 + c16 * 8), w1 = *(const f32x4*)(cw + (part * 4 + tap) * 128 + c16 * 8 + 4);
                    wt[tap][0] = w0[0]; wt[tap][1] = w0[1]; wt[tap][2] = w0[2]; wt[tap][3] = w0[3]; wt[tap][4] = w1[0]; wt[tap][5] = w1[1]; wt[tap][6] = w1[2]; wt[tap][7] = w1[3]; }
                float av[2][8];
#pragma unroll
                for (int u = 0; u < 2; ++u) {
                    float ss = 0.f;
#pragma unroll
                    for (int e = 0; e < 8; ++e) { float a = wt[0][e] * xr[u][e]; a = fmaf(wt[1][e], xr[u + 1][e], a); a = fmaf(wt[2][e], xr[u + 2][e], a); a = fmaf(wt[3][e], xr[u + 3][e], a);
                        a = silu_f(a); av[u][e] = a; ss += a * a; }
                    if (part < 2) {
                        ss = row_sum16(ss);
                        const float r = rsqrtf(ss + NORM_EPS) * (part == 0 ? 0.08838834764831845f : 1.f);
                        u32x4 w; w.x = cvt_pk_bf16(av[u][0] * r, av[u][1] * r); w.y = cvt_pk_bf16(av[u][2] * r, av[u][3] * r); w.z = cvt_pk_bf16(av[u][4] * r, av[u][5] * r); w.w = cvt_pk_bf16(av[u][6] * r, av[u][7] * r);
                        *(u32x4*)((part == 0 ? qb : kb) + (t0 + u) * 136 + c16 * 8) = w;
                    }
                }
                if (part == 2) {
#pragma unroll
                    for (int e = 0; e < 8; ++e) *(unsigned*)(vbT + (c16 * 8 + e) * 72 + t0) = cvt_pk_bf16(av[0][e], av[1][e]);
                }
            }
        }
        if (tid < 64) {
            const int t = tid;
            const float av = (pa_[0] + pa_[1]) + (pa_[2] + pa_[3]), bv = (pb_[0] + pb_[1]) + (pb_[2] + pb_[3]);
            const float xx = av + dtbv;
            const float ex = __expf(xx); const float sp = (xx > 20.f) ? xx : ((xx < -8.f) ? ex * (1.f - 0.5f * ex) : __logf(1.f + ex));
            const float g = -__expf(alogv) * sp;
            const float beta = __builtin_amdgcn_rcpf(1.f + __expf(-bv));
            float G = g;
            G += __int_as_float(__builtin_amdgcn_update_dpp(0, __float_as_int(G), 0x111, 0xF, 0xF, true)); G += __int_as_float(__builtin_amdgcn_update_dpp(0, __float_as_int(G), 0x112, 0xF, 0xF, true));
            G += __int_as_float(__builtin_amdgcn_update_dpp(0, __float_as_int(G), 0x114, 0xF, 0xF, true)); G += __int_as_float(__builtin_amdgcn_update_dpp(0, __float_as_int(G), 0x118, 0xF, 0xF, true));
            G += dpp_mov<0x142, 0xA>(G); G += dpp_mov<0x143, 0xC>(G);
            const float Gl = __int_as_float(__builtin_amdgcn_readlane(__float_as_int(G), 63));
            sc[t] = beta; sc[64 + t] = G; sc[128 + t] = __expf(G); sc[192 + t] = __expf(Gl - G);
            if (t == 63) glg[ci] = __expf(G);
        }
        lds_barrier();
        {
            for (int k = wave; k < 20; k += 8) {
                const unsigned code = (unsigned)(((k < 12) ? (0xd1b25c0ea2a0600ull >> (5 * k)) : (0xfbfcbeab87ull >> (5 * (k - 12)))) & 31ull);
                const int which = (int)(code >> 4), mi = (int)((code >> 2) & 3u), ni = (int)(code & 3u);
                f32x4 acc = {0.f, 0.f, 0.f, 0.f};
                const bf16_t* Ab = (which ? qb : kb) + (mi * 16 + r16) * 136 + quad * 8;
                const bf16_t* Bb = kb + (ni * 16 + r16) * 136 + quad * 8;
#pragma unroll
                for (int ks = 0; ks < 4; ++ks) acc = MFMA16(*(const bf16x8*)(Ab + ks * 32), *(const bf16x8*)(Bb + ks * 32), acc);
                const int cidx = ni * 16 + r16; const float Gc = sc[64 + cidx];
                if (which == 0) {
                    const float bi = sc[cidx]; f32x4 lv;
#pragma unroll
                    for (int r = 0; r < 4; ++r) { const int jj = mi * 16 + quad * 4 + r; lv[r] = (jj < cidx) ? bi * acc[r] * __expf(fminf(Gc - sc[64 + jj], 0.f)) : 0.f; }
                    if (ni == mi) *(f32x4*)(Ld + mi * 320 + r16 * 20 + quad * 4) = lv;
                    else { u32x2 w; w.x = cvt_pk_bf16(lv[0], lv[1]); w.y = cvt_pk_bf16(lv[2], lv[3]); *(u32x2*)(Lb + cidx * 72 + mi * 16 + quad * 4) = w; }
                } else {
#pragma unroll
                    for (int r = 0; r < 4; ++r) { const int ii = mi * 16 + quad * 4 + r; aqk[ii * 72 + cidx] = f2bf((cidx <= ii) ? acc[r] * __expf(fminf(sc[64 + ii] - Gc, 0.f)) : 0.f); }
                }
            }
            if (wave >= 4) {
                for (int z = wave - 4; z < 6; z += 4) { const unsigned zc = (0xb76321u >> (4 * z)) & 15u; const int mi = (int)(zc >> 2), ni = (int)(zc & 3u);
#pragma unroll
                    for (int r = 0; r < 4; ++r) aqk[(mi * 16 + quad * 4 + r) * 72 + ni * 16 + r16] = 0; }
            }
        }
        lds_barrier();
        if (wave != 0) {
            for (int it3 = tid - 64; it3 < 1024; it3 += 448) { const int a = it3 & 127, t0 = (it3 >> 7) * 8; float v[8];
#pragma unroll
                for (int e = 0; e < 8; ++e) v[e] = bf2f(kb[(t0 + e) * 136 + a]);
                u32x4 w; w.x = cvt_pk_bf16(v[0], v[1]); w.y = cvt_pk_bf16(v[2], v[3]); w.z = cvt_pk_bf16(v[4], v[5]); w.w = cvt_pk_bf16(v[6], v[7]);
                *(u32x4*)(kbT + a * 72 + t0) = w;
#pragma unroll
                for (int e = 0; e < 8; ++e) v[e] *= sc[192 + t0 + e];
                w.x = cvt_pk_bf16(v[0], v[1]); w.y = cvt_pk_bf16(v[2], v[3]); w.z = cvt_pk_bf16(v[4], v[5]); w.w = cvt_pk_bf16(v[6], v[7]);
                *(u32x4*)(kdT + a * 72 + t0) = w; }
        }
        if (wave == 0) {
            const float* Lrow = Ld + quad * 320;
            float x[16];
#pragma unroll
            for (int i = 0; i < 16; ++i) { float s = (i == r16) ? 1.f : 0.f;
#pragma unroll
                for (int j = 0; j < i; ++j) s -= Lrow[i * 20 + j] * x[j];
                x[i] = s; }
#pragma unroll
            for (int i = 0; i < 16; ++i) Ti[(16 * quad + i) * 72 + 16 * quad + r16] = f2bf(x[i]);
            { u32x4 w0, w1; w0.x = cvt_pk_bf16(x[0], x[1]); w0.y = cvt_pk_bf16(x[2], x[3]); w0.z = cvt_pk_bf16(x[4], x[5]); w0.w = cvt_pk_bf16(x[6], x[7]);
              w1.x = cvt_pk_bf16(x[8], x[9]); w1.y = cvt_pk_bf16(x[10], x[11]); w1.z = cvt_pk_bf16(x[12], x[13]); w1.w = cvt_pk_bf16(x[14], x[15]);
              *(u32x4*)(TT + (16 * quad + r16) * 72 + 16 * quad) = w0; *(u32x4*)(TT + (16 * quad + r16) * 72 + 16 * quad + 8) = w1; }
            asm volatile("s_waitcnt lgkmcnt(0)" ::: "memory");
            tinv_block<1, 0>(Lb, Ti, TT, XT, r16, quad); tinv_block<2, 1>(Lb, Ti, TT, XT, r16, quad); tinv_block<3, 2>(Lb, Ti, TT, XT, r16, quad);
            tinv_block<2, 0>(Lb, Ti, TT, XT, r16, quad); tinv_block<3, 1>(Lb, Ti, TT, XT, r16, quad);
            tinv_block<3, 0>(Lb, Ti, TT, XT, r16, quad);
        }
        lds_barrier();
        {
            const int i = tid >> 3, t0 = (tid & 7) * 8; const bool low = (t0 >> 4) <= (i >> 4);
            const u32x4 raw = *(const u32x4*)(Ti + i * 72 + t0);
            float v[8] = {bflo(raw.x), bfhi(raw.x), bflo(raw.y), bfhi(raw.y), bflo(raw.z), bfhi(raw.z), bflo(raw.w), bfhi(raw.w)}; float tw[8], tu[8];
#pragma unroll
            for (int e = 0; e < 8; ++e) { const float be = sc[t0 + e]; tu[e] = low ? v[e] * be : 0.f; tw[e] = low ? v[e] * be * sc[128 + t0 + e] : 0.f; }
            u32x4 w; w.x = cvt_pk_bf16(tw[0], tw[1]); w.y = cvt_pk_bf16(tw[2], tw[3]); w.z = cvt_pk_bf16(tw[4], tw[5]); w.w = cvt_pk_bf16(tw[6], tw[7]);
            u32x4 u; u.x = cvt_pk_bf16(tu[0], tu[1]); u.y = cvt_pk_bf16(tu[2], tu[3]); u.z = cvt_pk_bf16(tu[4], tu[5]); u.w = cvt_pk_bf16(tu[6], tu[7]);
            *(u32x4*)(Ti + i * 72 + t0) = w; *(u32x4*)(TT + i * 72 + t0) = u;
        }
        lds_barrier();
#pragma unroll
        for (int pass = 0; pass < 2; ++pass) {
            const bf16_t* Aop = pass ? TT : Ti; const bf16_t* Bop = pass ? vbT : kbT; bf16_t* outT = pass ? uT : wT;
            f32x4 acc4[4];
#pragma unroll
            for (int mi = 0; mi < 4; ++mi) { f32x4 acc = {0.f, 0.f, 0.f, 0.f};
#pragma unroll
                for (int ks = 0; ks < 2; ++ks) acc = MFMA16(*(const bf16x8*)(Aop + (mi * 16 + r16) * 72 + ks * 32 + quad * 8), *(const bf16x8*)(Bop + (wave * 16 + r16) * 72 + ks * 32 + quad * 8), acc);
                acc4[mi] = acc; }
            if (pass == 1) lds_barrier();
#pragma unroll
            for (int mi = 0; mi < 4; ++mi) { u32x2 w; w.x = cvt_pk_bf16(acc4[mi][0], acc4[mi][1]); w.y = cvt_pk_bf16(acc4[mi][2], acc4[mi][3]); *(u32x2*)(outT + (wave * 16 + r16) * 72 + mi * 16 + quad * 4) = w; }
        }
        lds_barrier();
        if (it + (int)gridDim.x < 4096) P1_PREFETCH(it + (int)gridDim.x);
        {
            const int cg = wave & 1, rq = wave >> 1;
            const int nrow = 64 * cg + 16 * (r16 >> 2) + (r16 & 3);
#pragma unroll
            for (int prod = 0; prod < 4; ++prod) {
                if (prod == 1) continue;
                const bf16_t* Yb = (prod == 3) ? uT : wT; const bf16_t* Xb = (prod == 0) ? kdT : aqk;
                bf16x8 yf[4][2];
#pragma unroll
                for (int t = 0; t < 4; ++t)
#pragma unroll
                    for (int ks = 0; ks < 2; ++ks) yf[t][ks] = *(const bf16x8*)(Yb + (nrow + 4 * t) * 72 + quad * 8 + ks * 32);
#pragma unroll
                for (int u = 0; u < ((prod == 0) ? 2 : 1); ++u) {
                    const int mi = (prod == 0) ? rq * 2 + u : rq, m = mi * 16 + r16, n0 = 64 * cg + 16 * quad;
                    const bf16x8 xf0 = *(const bf16x8*)(Xb + m * 72 + quad * 8), xf1 = *(const bf16x8*)(Xb + m * 72 + quad * 8 + 32);
                    f32x4 acc[4];
#pragma unroll
                    for (int t = 0; t < 4; ++t) { acc[t] = (f32x4){0.f, 0.f, 0.f, 0.f}; acc[t] = MFMA16(yf[t][0], xf0, acc[t]); acc[t] = MFMA16(yf[t][1], xf1, acc[t]); }
                    if (prod == 0) {
#pragma unroll
                        for (int t = 0; t < 4; ++t) acc[t] = -acc[t];
                    }
                    if (prod == 2) { const u32x4 q0 = *(const u32x4*)(qb + m * 136 + n0), q1 = *(const u32x4*)(qb + m * 136 + n0 + 8); const float eg = sc[128 + m];
                        const unsigned qw[8] = {q0.x, q0.y, q0.z, q0.w, q1.x, q1.y, q1.z, q1.w};
#pragma unroll
                        for (int t = 0; t < 4; ++t) { acc[t][0] = bflo(qw[2 * t]) * eg - acc[t][0]; acc[t][1] = bfhi(qw[2 * t]) * eg - acc[t][1]; acc[t][2] = bflo(qw[2 * t + 1]) * eg - acc[t][2]; acc[t][3] = bfhi(qw[2 * t + 1]) * eg - acc[t][3]; } }
                    bf16_t* outp = ((prod == 0) ? (Ag + (size_t)ci * 16384) : (prod == 2) ? (Qg + (size_t)ci * 8192) : (Og + (size_t)ci * 8192)) + m * 128 + n0;
                    u32x4 w0, w1;
                    w0.x = cvt_pk_bf16(acc[0][0], acc[0][1]); w0.y = cvt_pk_bf16(acc[0][2], acc[0][3]); w0.z = cvt_pk_bf16(acc[1][0], acc[1][1]); w0.w = cvt_pk_bf16(acc[1][2], acc[1][3]);
                    w1.x = cvt_pk_bf16(acc[2][0], acc[2][1]); w1.y = cvt_pk_bf16(acc[2][2], acc[2][3]); w1.z = cvt_pk_bf16(acc[3][0], acc[3][1]); w1.w = cvt_pk_bf16(acc[3][2], acc[3][3]);
                    *(u32x4*)outp = w0; *(u32x4*)(outp + 8) = w1;
                }
            }
            {
                const int ah = wave & 1;
                bf16x8 xf[4][2];
#pragma unroll
                for (int t = 0; t < 4; ++t)
#pragma unroll
                    for (int ks = 0; ks < 2; ++ks) xf[t][ks] = *(const bf16x8*)(kdT + (64 * ah + 16 * (r16 >> 2) + (r16 & 3) + 4 * t) * 72 + quad * 8 + ks * 32);
#pragma unroll
                for (int u = 0; u < 2; ++u) {
                    const int vt = (wave >> 1) * 2 + u;
                    const bf16x8 yf0 = *(const bf16x8*)(uT + (vt * 16 + r16) * 72 + quad * 8), yf1 = *(const bf16x8*)(uT + (vt * 16 + r16) * 72 + quad * 8 + 32);
                    f32x4 acc[4];
#pragma unroll
                    for (int t = 0; t < 4; ++t) { acc[t] = (f32x4){0.f, 0.f, 0.f, 0.f}; acc[t] = MFMA16(xf[t][0], yf0, acc[t]); acc[t] = MFMA16(xf[t][1], yf1, acc[t]); }
                    bf16_t* outp = Bg + (size_t)ci * 16384 + (vt * 16 + r16) * 128 + 64 * ah + 16 * quad;
                    u32x4 w0, w1;
                    w0.x = cvt_pk_bf16(acc[0][0], acc[0][1]); w0.y = cvt_pk_bf16(acc[0][2], acc[0][3]); w0.z = cvt_pk_bf16(acc[1][0], acc[1][1]); w0.w = cvt_pk_bf16(acc[1][2], acc[1][3]);
                    w1.x = cvt_pk_bf16(acc[2][0], acc[2][1]); w1.y = cvt_pk_bf16(acc[2][2], acc[2][3]); w1.z = cvt_pk_bf16(acc[3][0], acc[3][1]); w1.w = cvt_pk_bf16(acc[3][2], acc[3][3]);
                    *(u32x4*)outp = w0; *(u32x4*)(outp + 8) = w1;
                }
            }
        }
        lds_barrier();
    }
#undef P1_PREFETCH
}

DI void ph_gdn_p2(PK p, unsigned char* lds, const int wv) {
    PK_FRESH(p);
    const int tid = ltid(wv), lane = tid & 63, wave = __builtin_amdgcn_readfirstlane(tid >> 6), r16 = lane & 15, quad = lane >> 4, a0 = wave * 16;
    const bf16_t* Ag = WSP(const bf16_t, WS_GA); const bf16_t* Bg = WSP(const bf16_t, WS_GB); bf16_t* Sg = WSP(bf16_t, WS_GS); const float* glg = WSP(const float, WS_GL);
    bf16_t* ST = (bf16_t*)lds;
#define P2_LOAD(AF, BM, GL, cidx) do { const size_t c_ = (cidx); _Pragma("unroll") for (int ks = 0; ks < 4; ++ks) AF[ks] = *(const bf16x8*)(Ag + c_ * 16384 + (size_t)(a0 + r16) * 128 + ks * 32 + quad * 8); \
        BM = *(const u32x2*)(Bg + c_ * 16384 + (size_t)(v0 + r16) * 128 + a0 + quad * 4); GL = glg[c_]; } while (0)
    for (int item = blockIdx.x; item < 256; item += gridDim.x) {
        const int bh = (item & 7) * 4 + (item >> 6), v0 = ((item >> 3) & 7) * 16;
        const size_t cb = (size_t)bh * 128;
        f32x4 S = {0.f, 0.f, 0.f, 0.f};
        bf16x8 afA[4], afB[4], afC[4], afD[4], afE[4], afF[4], afG[4], afH[4]; u32x2 bmA, bmB, bmC, bmD, bmE, bmF, bmG, bmH; float glA, glB, glC, glD, glE, glF, glG, glH;
        P2_LOAD(afA, bmA, glA, cb); P2_LOAD(afB, bmB, glB, cb + 1); P2_LOAD(afC, bmC, glC, cb + 2); P2_LOAD(afD, bmD, glD, cb + 3); P2_LOAD(afE, bmE, glE, cb + 4); P2_LOAD(afF, bmF, glF, cb + 5); P2_LOAD(afG, bmG, glG, cb + 6);
#define P2_STEP(AFc, BMc, GLc, AFp, BMp, GLp, nn) do { const int n_ = (nn); const size_t ci = cb + n_; \
            u32x2 sp; sp.x = cvt_pk_bf16(S[0], S[1]); sp.y = cvt_pk_bf16(S[2], S[3]); \
            bf16_t* STb = ST + (n_ & 1) * (16 * 136); \
            *(u32x2*)(STb + r16 * 136 + a0 + quad * 4) = sp; \
            lds_barrier(); \
            f32x4 acc; acc[0] = GLc * S[0] + bflo(BMc.x); acc[1] = GLc * S[1] + bfhi(BMc.x); acc[2] = GLc * S[2] + bflo(BMc.y); acc[3] = GLc * S[3] + bfhi(BMc.y); \
            bf16x8 bfr_[4]; _Pragma("unroll") for (int ks = 0; ks < 4; ++ks) bfr_[ks] = *(const bf16x8*)(STb + r16 * 136 + ks * 32 + quad * 8);        \
            P2_LOAD(AFp, BMp, GLp, cb + ((n_ + 7 < 128) ? n_ + 7 : 127));        \
            *(u32x2*)(Sg + ci * 16384 + (size_t)(v0 + r16) * 128 + a0 + quad * 4) = sp;        \
            _Pragma("unroll") for (int ks = 0; ks < 4; ++ks) acc = MFMA16(AFc[ks], bfr_[ks], acc); \
            S = acc; } while (0)
        for (int n = 0; n < 128; n += 8) {
            P2_STEP(afA, bmA, glA, afH, bmH, glH, n);
            P2_STEP(afB, bmB, glB, afA, bmA, glA, n + 1);
            P2_STEP(afC, bmC, glC, afB, bmB, glB, n + 2);
            P2_STEP(afD, bmD, glD, afC, bmC, glC, n + 3);
            P2_STEP(afE, bmE, glE, afD, bmD, glD, n + 4);
            P2_STEP(afF, bmF, glF, afE, bmE, glE, n + 5);
            P2_STEP(afG, bmG, glG, afF, bmF, glF, n + 6);
            P2_STEP(afH, bmH, glH, afG, bmG, glG, n + 7);
        }
#undef P2_STEP
        lds_barrier();
    }
#undef P2_LOAD
}

DI void ph_gdn_p3(PK p, int l, const int wv) {
    PK_FRESH(p);
    const int tid = ltid(wv), lane = tid & 63, wave = __builtin_amdgcn_readfirstlane(tid >> 6), r16 = lane & 15, quad = lane >> 4;
    const bf16_t* Qg = WSP(const bf16_t, WS_GQ); const bf16_t* Og = WSP(const bf16_t, WS_GO); const bf16_t* Sg = WSP(const bf16_t, WS_GS);
    const bf16_t* proj = WSP(const bf16_t, WS_PROJ); bf16_t* obuf = WSP(bf16_t, WS_OBUF); const float* ogain = p->in[11] + l * 128;
    for (int it = blockIdx.x; it < 2048; it += gridDim.x) {
        const int ci = it * 2 + (wave >> 2), mi = wave & 3;
        const int n = ci & 127, bh = ci >> 7, hd = bh & 15, b = bh >> 4;
        const int i = mi * 16 + r16; const size_t tok = (size_t)b * SEQ + n * 64 + i;
        bf16x8 qa[4], sf[4][8]; u32x2 ov[8], zv[8];
#pragma unroll
        for (int ks = 0; ks < 4; ++ks) { qa[ks] = *(const bf16x8*)(Qg + (size_t)ci * 8192 + i * 128 + ks * 32 + quad * 8);
#pragma unroll
            for (int ni = 0; ni < 8; ++ni) sf[ks][ni] = *(const bf16x8*)(Sg + (size_t)ci * 16384 + (ni * 16 + r16) * 128 + ks * 32 + quad * 8); }
#pragma unroll
        for (int ni = 0; ni < 8; ++ni) { ov[ni] = *(const u32x2*)(Og + (size_t)ci * 8192 + i * 128 + ni * 16 + quad * 4); zv[ni] = *(const u32x2*)(proj + tok * GINP + 6144 + hd * 128 + ni * 16 + quad * 4); }
        f32x4 acc[8];
#pragma unroll
        for (int ni = 0; ni < 8; ++ni) acc[ni] = (f32x4){0.f, 0.f, 0.f, 0.f};
#pragma unroll
        for (int ks = 0; ks < 4; ++ks)
#pragma unroll
            for (int ni = 0; ni < 8; ++ni) acc[ni] = MFMA16(sf[ks][ni], qa[ks], acc[ni]);
        float ss = 0.f;
#pragma unroll
        for (int ni = 0; ni < 8; ++ni) {
            acc[ni][0] += bflo(ov[ni].x); acc[ni][1] += bfhi(ov[ni].x); acc[ni][2] += bflo(ov[ni].y); acc[ni][3] += bfhi(ov[ni].y);
            ss += acc[ni][0] * acc[ni][0] + acc[ni][1] * acc[ni][1] + acc[ni][2] * acc[ni][2] + acc[ni][3] * acc[ni][3]; }
        ss += sw_xor<16>(ss); ss = sw_xor32_sum(ss);
        const float rms = rsqrtf(ss * (1.f / 128.f) + NORM_EPS);
#pragma unroll
        for (int ni = 0; ni < 8; ++ni) { const int v = ni * 16 + quad * 4; const f32x4 gv = *(const f32x4*)(ogain + v);
            const float y0 = acc[ni][0] * rms * gv[0] * silu_f(bflo(zv[ni].x)), y1 = acc[ni][1] * rms * gv[1] * silu_f(bfhi(zv[ni].x));
            const float y2 = acc[ni][2] * rms * gv[2] * silu_f(bflo(zv[ni].y)), y3 = acc[ni][3] * rms * gv[3] * silu_f(bfhi(zv[ni].y));
            u32x2 w; w.x = cvt_pk_bf16(y0, y1); w.y = cvt_pk_bf16(y2, y3); *(u32x2*)(obuf + tok * D + hd * 128 + v) = w; }
    }
}

DI void ph_rope(PK p, const bf16_t* src, int ld, bf16_t* dst, const int wv) {
    PK_FRESH(p);
    const int tid = ltid(wv); const float* cosT = WSP(const float, WS_COS); const float* sinT = WSP(const float, WS_SIN);
    for (int idx = blockIdx.x * 512 + tid; idx < T * 128; idx += gridDim.x * 512) {
        const int jc = idx & 7, hc = (idx >> 3) & 15, t = idx >> 7;
        const bf16_t* sp = src + (size_t)t * ld + hc * 128 + jc * 8;
        const u32x4 x1 = *(const u32x4*)sp, x2 = *(const u32x4*)(sp + 64);
        const f32x4 c0 = *(const f32x4*)(cosT + t * 64 + jc * 8), c1 = *(const f32x4*)(cosT + t * 64 + jc * 8 + 4);
        const f32x4 s0 = *(const f32x4*)(sinT + t * 64 + jc * 8), s1 = *(const f32x4*)(sinT + t * 64 + jc * 8 + 4);
        float a[8] = {bflo(x1.x), bfhi(x1.x), bflo(x1.y), bfhi(x1.y), bflo(x1.z), bfhi(x1.z), bflo(x1.w), bfhi(x1.w)};
        float bb[8] = {bflo(x2.x), bfhi(x2.x), bflo(x2.y), bfhi(x2.y), bflo(x2.z), bfhi(x2.z), bflo(x2.w), bfhi(x2.w)};
        float cs[8] = {c0[0], c0[1], c0[2], c0[3], c1[0], c1[1], c1[2], c1[3]}, sn[8] = {s0[0], s0[1], s0[2], s0[3], s1[0], s1[1], s1[2], s1[3]};
        float o1[8], o2[8];
#pragma unroll
        for (int e = 0; e < 8; ++e) { o1[e] = a[e] * cs[e] - bb[e] * sn[e]; o2[e] = bb[e] * cs[e] + a[e] * sn[e]; }
        const int b = t >> 13, s = t & 8191;
        bf16_t* dp = dst + ((size_t)(b * 16 + hc) * SEQ + s) * 128 + jc * 8;
        u32x4 w1, w2;
        w1.x = cvt_pk_bf16(o1[0], o1[1]); w1.y = cvt_pk_bf16(o1[2], o1[3]); w1.z = cvt_pk_bf16(o1[4], o1[5]); w1.w = cvt_pk_bf16(o1[6], o1[7]);
        w2.x = cvt_pk_bf16(o2[0], o2[1]); w2.y = cvt_pk_bf16(o2[2], o2[3]); w2.z = cvt_pk_bf16(o2[4], o2[5]); w2.w = cvt_pk_bf16(o2[6], o2[7]);
        *(u32x4*)dp = w1; *(u32x4*)(dp + 64) = w2;
    }
}
DI void ph_vrelayout(const bf16_t* src, bf16_t* dst, const int wv) {
    const int tid = ltid(wv);
    for (int idx = blockIdx.x * 512 + tid; idx < T * 256; idx += gridDim.x * 512) {
        const int ch = idx & 15, hc = (idx >> 4) & 15, t = idx >> 8; const int b = t >> 13, s = t & 8191;
        *(u32x4*)(dst + ((size_t)(b * 16 + hc) * SEQ + s) * 128 + ch * 8) = *(const u32x4*)(src + (size_t)t * 4096 + 2048 + hc * 128 + ch * 8);
    }
}

DI void ph_attn(PK p, unsigned char* lds, const int wv) {
    PK_FRESH(p);
    using att::bf16;
    const bf16* Qd = WSP(const bf16, WS_QD); const bf16* Ksh = WSP(const bf16, WS_KSH); const bf16* Vsh = WSP(const bf16, WS_VSH); bf16* Oat = WSP(bf16, WS_OAT);
    const int total = 64 * 16, stride = gridDim.x, W = SEQ;
    int L = blockIdx.x;
    if (L < total) {
        auto mkref = [&](int Li, int pass) {
            const int xcd = Li & 7, jk = Li >> 3, mm = (jk & 127) >> 4, x = jk & 15, h64 = xcd * 8 + mm, qb = pass ? (31 - x) : x;
            const int vh = h64 & 1, c = (h64 >> 1) & 1, bh = h64 >> 2;
            att::BlockRef<bf16, bf16> r;
            r.Q = Qd + ((size_t)(bh * 2 + c) * SEQ + (size_t)qb * 256) * 128;
            r.K = Ksh + (size_t)(bh * 2 + c) * SEQ * 128;
            r.V = Vsh + (size_t)(bh * 2 + vh) * SEQ * 128;
            r.O = Oat + ((size_t)((bh * 2 + c) * 2 + vh) * SEQ + (size_t)qb * 256) * 128;
            r.P0 = qb * 256; return r; };
        int pass = 0;
        att::BlockRef<bf16, bf16> cur = mkref(L, 0);
        att::Seam<bf16> S;
        att::causal_swa_prime<bf16, bf16>(cur, W, (char*)lds, S, wv);
        for (;;) {
            const bool more_pass = pass == 0, more_item = L + stride < total, last = !more_pass && !more_item;
            int passn = pass + 1, Ln = L;
            if (!more_pass) { passn = 0; Ln = more_item ? L + stride : L; }
            const att::BlockRef<bf16, bf16> nxt = last ? cur : mkref(Ln, passn);
            att::causal_swa_block<bf16, bf16>(cur, nxt, SEQ, W, (char*)lds, S, wv);
            if (last) break;
            cur = nxt; pass = passn; L = Ln;
        }
    }
    __syncthreads();
}

DI void ph_diff_combine(PK p, int j, int l, unsigned char* lds, const int wv) {
    PK_FRESH(p);
    const int tid = ltid(wv), lane = tid & 63, wave = __builtin_amdgcn_readfirstlane(tid >> 6);
    float* ldsf = (float*)lds;
    const float lambda_init = 0.8f - 0.6f * expf(-0.3f * (float)l);
    if (wave == 0) { const float* lp = p->in[18] + j * 512;
        float a = lp[lane] * lp[128 + lane] + lp[64 + lane] * lp[192 + lane], bsum = lp[256 + lane] * lp[384 + lane] + lp[320 + lane] * lp[448 + lane];
        a = wave_sum(a); bsum = wave_sum(bsum);
        if (lane == 0) ldsf[0] = expf(a) - expf(bsum) + lambda_init; }
    __syncthreads();
    const float lam = ldsf[0], om = 1.f - lambda_init;
    const bf16_t* Oat = WSP(const bf16_t, WS_OAT); bf16_t* obuf = WSP(bf16_t, WS_OBUF); const float* sg = p->in[19] + j * 256;
    for (int row = blockIdx.x * 8 + wave; row < T * 8; row += gridDim.x * 8) {
        const int t = row >> 3, h = row & 7, b = t >> 13, s = t & 8191, vh = lane >> 5, d = (lane & 31) * 4;
        const u32x2 o1 = *(const u32x2*)(Oat + ((size_t)(((b * 8 + h) * 2 + 0) * 2 + vh) * SEQ + s) * 128 + d);
        const u32x2 o2 = *(const u32x2*)(Oat + ((size_t)(((b * 8 + h) * 2 + 1) * 2 + vh) * SEQ + s) * 128 + d);
        float v[4] = {bflo(o1.x) - lam * bflo(o2.x), bfhi(o1.x) - lam * bfhi(o2.x), bflo(o1.y) - lam * bflo(o2.y), bfhi(o1.y) - lam * bfhi(o2.y)};
        float ss = v[0] * v[0] + v[1] * v[1] + v[2] * v[2] + v[3] * v[3];
        ss = wave_sum(ss);
        const float rms = rsqrtf(ss * (1.f / 256.f) + NORM_EPS) * om;
        const f32x4 gv = *(const f32x4*)(sg + vh * 128 + d);
        u32x2 w; w.x = cvt_pk_bf16(v[0] * rms * gv[0], v[1] * rms * gv[1]); w.y = cvt_pk_bf16(v[2] * rms * gv[2], v[3] * rms * gv[3]);
        *(u32x2*)(obuf + (size_t)t * D + h * 256 + vh * 128 + d) = w;
    }
    __syncthreads();
}

#define INS16(Lr, vv) do { _Pragma("unroll") for (int k_ = 0; k_ < 16; ++k_) { const float hi_ = fmaxf(Lr[k_], vv); vv = fminf(Lr[k_], vv); Lr[k_] = hi_; } } while (0)
DI void sort16_desc(float (&L)[16]) {
#pragma unroll
    for (int k = 2; k <= 16; k <<= 1)
#pragma unroll
        for (int j = k >> 1; j >= 1; j >>= 1)
#pragma unroll
            for (int i = 0; i < 16; ++i) { const int l = i ^ j;
                if (l > i) { const float hi_ = fmaxf(L[i], L[l]), lo_ = fminf(L[i], L[l]); const bool desc = (i & k) == 0; L[i] = desc ? hi_ : lo_; L[l] = desc ? lo_ : hi_; } }
}
template <int XM> DI void merge16(float (&L)[16]) {
    float P[16];
#pragma unroll
    for (int i = 0; i < 16; ++i) P[i] = (XM == 4) ? dpp_full<0x141>(L[15 - i]) : sw_xor<XM>(L[15 - i]);
#pragma unroll
    for (int i = 0; i < 16; ++i) L[i] = fmaxf(L[i], P[i]);
#pragma unroll
    for (int s = 8; s >= 1; s >>= 1)
#pragma unroll
        for (int i = 0; i < 16; ++i) if ((i & s) == 0) { const float hi_ = fmaxf(L[i], L[i + s]), lo_ = fminf(L[i], L[i + s]); L[i] = hi_; L[i + s] = lo_; }
}
__constant__ unsigned kStairPk[16] = {0x20100800u, 0xffe07033u, 0x21110901u, 0xfff07140u, 0x22120a02u, 0xffff8041u, 0x23130b03u, 0xffff9042u, 0x24140c04u, 0xffffa050u, 0x30150d05u, 0xffffb051u, 0x31160e06u, 0xffffc060u, 0x32170f07u, 0xffffd061u};
DI void ph_peer_topk(PK p, int l, unsigned char* lds, const int wv) {
    PK_FRESH(p);
    const int tid = ltid(wv);
    float* tops = (float*)lds; float* fin = tops + 64 * 2 * 16;
    const bf16_t* pq = WSP(const bf16_t, WS_PQ);
    int* pidx = WSP(int, WS_PIDX); float* pgate = WSP(float, WS_PGATE);
    const float NEG = -__builtin_inff();
    const int rowl = (tid & 255) >> 3, half = (tid >> 2) & 1, quarter = tid & 3, l8 = tid & 7;
    const int nitems = T * 8 / 32;
    const int lane = tid & 63, wave = __builtin_amdgcn_readfirstlane(tid >> 6);
    if (wave >= 4) {
        const int cstep = gridDim.x * 4, R = 2 * 16384; int r = blockIdx.x * 4 + (wave - 4);
        f32x4 ca[8], cb[8];
        if (r < R) pc_load(p, l, r, ca, lane);
        for (; r < R; r += 2 * cstep) {
            const int r2 = r + cstep, r3 = r + 2 * cstep;
            if (r2 < R) pc_load(p, l, r2, cb, lane);
            pc_store(p, r, ca, lane);
            if (r3 < R) pc_load(p, l, r3, ca, lane);
            if (r2 < R) pc_store(p, r2, cb, lane);
        }
        return;
    }
    const u32x2 stw = *(const u32x2*)(kStairPk + l8 * 2);
    u32x4 wn[4];
    if ((int)blockIdx.x < nitems) { const int row = blockIdx.x * 32 + rowl; const bf16_t* sp = pq + (size_t)(row >> 3) * 2048 + (row & 7) * 256 + half * 128 + quarter * 32;
#pragma unroll
        for (int c = 0; c < 4; ++c) wn[c] = *(const u32x4*)(sp + c * 8); }
    for (int item = blockIdx.x; item < nitems; item += gridDim.x) {
        const int row0 = item * 32;
        u32x4 wc[4];
#pragma unroll
        for (int c = 0; c < 4; ++c) wc[c] = wn[c];
        { const int itn = (item + (int)gridDim.x < nitems) ? item + (int)gridDim.x : item; const int row = itn * 32 + rowl;
          const bf16_t* sp = pq + (size_t)(row >> 3) * 2048 + (row & 7) * 256 + half * 128 + quarter * 32;
#pragma unroll
          for (int c = 0; c < 4; ++c) wn[c] = *(const u32x4*)(sp + c * 8); }
        float Lr[16], Lq[16];
#pragma unroll
        for (int c = 0; c < 4; ++c)
#pragma unroll
            for (int e = 0; e < 4; ++e) { const unsigned w = wc[c][e];
                const float v0 = __uint_as_float((w << 16) | (unsigned)(quarter * 32 + c * 8 + e * 2)), v1 = __uint_as_float((w & 0xffff0000u) | (unsigned)(quarter * 32 + c * 8 + e * 2 + 1));
                if (c < 2) { Lr[c * 8 + e * 2] = v0; Lr[c * 8 + e * 2 + 1] = v1; } else { Lq[(c - 2) * 8 + e * 2] = v0; Lq[(c - 2) * 8 + e * 2 + 1] = v1; } }
        sort16_desc(Lr); sort16_desc(Lq);
#pragma unroll
        for (int i = 0; i < 16; ++i) Lr[i] = fmaxf(Lr[i], Lq[15 - i]);
#pragma unroll
        for (int s = 8; s >= 1; s >>= 1)
#pragma unroll
            for (int i = 0; i < 16; ++i) if ((i & s) == 0) { const float hi_ = fmaxf(Lr[i], Lr[i + s]), lo_ = fminf(Lr[i], Lr[i + s]); Lr[i] = hi_; Lr[i + s] = lo_; }
        merge16<1>(Lr); merge16<2>(Lr);
        if (quarter == 0) {
#pragma unroll
            for (int k = 0; k < 16; ++k) tops[(rowl * 2 + half) * 16 + k] = Lr[k];
        }
        asm volatile("s_waitcnt lgkmcnt(0)" ::: "memory");
        float M[16];
#pragma unroll
        for (int k = 0; k < 16; ++k) M[k] = NEG;
        {
            const float* ta = tops + (rowl * 2) * 16; const float* tb = ta + 16;
#pragma unroll
            for (int m = 0; m < 7; ++m) { const unsigned code = (((m < 4) ? stw.x : stw.y) >> (8 * (m & 3))) & 255u;
                float s = (code < 255u) ? ta[code >> 4] + tb[code & 15u] : NEG;
                s = (code < 255u) ? __uint_as_float((__float_as_uint(s) & ~255u) | code) : NEG; INS16(M, s); }
        }
        merge16<1>(M); merge16<2>(M); merge16<4>(M);
        float sum = 0.f;
#pragma unroll
        for (int k = 0; k < 16; ++k) sum += __expf(M[k] - M[0]);
        if (l8 == 0) {
#pragma unroll
            for (int k = 0; k < 16; ++k) fin[rowl * 16 + k] = M[k];
        }
        asm volatile("s_waitcnt lgkmcnt(0)" ::: "memory");
        {
            const float inv = __builtin_amdgcn_rcpf(sum), m0 = M[0]; const int row = row0 + rowl; const size_t ob = (size_t)(row >> 3) * 128 + (row & 7) * 16;
#pragma unroll
            for (int u = 0; u < 2; ++u) { const int k = l8 * 2 + u; const float mk = fin[rowl * 16 + k]; const unsigned code = __float_as_uint(mk) & 255u;
                const unsigned i1 = __float_as_uint(tops[(rowl * 2) * 16 + (code >> 4)]) & 127u, i2 = __float_as_uint(tops[(rowl * 2 + 1) * 16 + (code & 15u)]) & 127u;
                pidx[ob + k] = (int)(i1 * 128u + i2); pgate[ob + k] = __expf(mk - m0) * inv; }
        }
        asm volatile("s_waitcnt lgkmcnt(0)" ::: "memory");
    }
}

DI float gelu_f(float v) {
    const float av = fabsf(v), t = __builtin_amdgcn_rcpf(fmaf(av, 0.2316418882f, 1.0f));
    float q = fmaf(t, 0.5307027145f, -0.7265760135f); q = fmaf(q, t, 0.7107068705f); q = fmaf(q, t, -0.142248368f); q = fmaf(q, t, 0.127414796f); q = q * t;
    const float e = __builtin_amdgcn_exp2f(v * v * -0.72134752044f), m = v * (q * e);
    return v < 0.f ? m : v - m;
}
#define FP4X8(w, o) const f32x2 o##0 = __builtin_amdgcn_cvt_scalef32_pk_f32_fp4(w, 1.0f, 0), o##1 = __builtin_amdgcn_cvt_scalef32_pk_f32_fp4(w, 1.0f, 1), \
                                o##2 = __builtin_amdgcn_cvt_scalef32_pk_f32_fp4(w, 1.0f, 2), o##3 = __builtin_amdgcn_cvt_scalef32_pk_f32_fp4(w, 1.0f, 3)
DI void ph_peer_gather(PK p, int l, unsigned char* lds, const int wv, const bool apply = true) {
    PK_FRESH(p);
    const int tid = ltid(wv), lane = tid & 63, wave = __builtin_amdgcn_readfirstlane(tid >> 6);
    const bf16_t* hb = WSP(const bf16_t, WS_HBUF); const unsigned char* ub = WSP(const unsigned char, WS_PU); const unsigned char* vb = WSP(const unsigned char, WS_PV);
    const unsigned char* psc8 = WSP(const unsigned char, WS_PUS);
    const int* pidx = WSP(const int, WS_PIDX); const float* pgate = WSP(const float, WS_PGATE); bf16_t* xc = WSP(bf16_t, WS_XCUR);
    const float* gt2 = WSP(const float, WS_MOD) + l * 12288 + 5 * 2048;
    const unsigned l16 = (unsigned)lane * 16u, l2 = (unsigned)(lane >> 2) * 4u;
    for (int tok = blockIdx.x * 8 + wave; tok < T; tok += gridDim.x * 8) {
        f32x2 hf2[16];
#pragma unroll
        for (int c = 0; c < 4; ++c) { const u32x4 w = *(const u32x4*)(hb + (size_t)tok * D + lane * 32 + c * 8);
            hf2[c * 4 + 0] = (f32x2){bflo(w.x), bfhi(w.x)}; hf2[c * 4 + 1] = (f32x2){bflo(w.y), bfhi(w.y)}; hf2[c * 4 + 2] = (f32x2){bflo(w.z), bfhi(w.z)}; hf2[c * 4 + 3] = (f32x2){bflo(w.w), bfhi(w.w)}; }
        f32x2 acc2[16];
#pragma unroll
        for (int i = 0; i < 16; ++i) acc2[i] = (f32x2){0.f, 0.f};
        u32x2* sraw = (u32x2*)(lds + wave * 2048); u32x2* ssrt = sraw + 128;
        {
            const unsigned k0 = (unsigned)pidx[(size_t)tok * 128 + lane], k1 = (unsigned)pidx[(size_t)tok * 128 + 64 + lane];
            const float g0 = pgate[(size_t)tok * 128 + lane], g1 = pgate[(size_t)tok * 128 + 64 + lane];
            sraw[lane] = (u32x2){k0, __float_as_uint(g0)}; sraw[64 + lane] = (u32x2){k1, __float_as_uint(g1)};
            asm volatile("s_waitcnt lgkmcnt(0)" ::: "memory");
            const unsigned key0 = k0 * 128u + (unsigned)lane, key1 = k1 * 128u + 64u + (unsigned)lane; unsigned r0 = 0, r1 = 0;
            for (int j = 0; j < 128; ++j) { const unsigned kj = sraw[j].x * 128u + (unsigned)j; r0 += (kj < key0) ? 1u : 0u; r1 += (kj < key1) ? 1u : 0u; }
            ssrt[r0] = (u32x2){k0, __float_as_uint(g0)}; ssrt[r1] = (u32x2){k1, __float_as_uint(g1)};
            asm volatile("s_waitcnt lgkmcnt(0)" ::: "memory");
        }
#define G_LOAD(gi, UR, VR, US, GT) do { unsigned o16_ = l16, o2_ = l2; asm("" : "+v"(o16_)); asm("" : "+v"(o2_));        \
        _Pragma("unroll") for (int q = 0; q < 4; ++q) { const u32x2 pr = ssrt[(gi) * 4 + q]; const unsigned e_ = (unsigned)__builtin_amdgcn_readfirstlane((int)pr.x); GT[q] = __uint_as_float(pr.y); \
            unsigned long long ue_ = (unsigned long long)ub + (unsigned long long)e_ * 1024ull, ve_ = (unsigned long long)vb + (unsigned long long)e_ * 1024ull, se_ = (unsigned long long)psc8 + (unsigned long long)e_ * 64ull; \
            asm("" : "+s"(ue_)); asm("" : "+s"(ve_)); asm("" : "+s"(se_));        \
            UR[q] = *(const __attribute__((address_space(1))) u32x4*)(ue_ + (unsigned long long)o16_); US[q] = *(const __attribute__((address_space(1))) unsigned*)(se_ + (unsigned long long)o2_); \
            VR[q] = *(const __attribute__((address_space(1))) u32x4*)(ve_ + (unsigned long long)o16_); } } while (0)
#define G_COMP(UR, VR, US, GT) do { float cf[4]; \
            _Pragma("unroll") for (int q = 0; q < 4; ++q) { f32x2 t2 = {0.f, 0.f}, t3 = {0.f, 0.f}; \
                _Pragma("unroll") for (int c = 0; c < 4; ++c) { FP4X8(UR[q][c], a); \
                    t2 = a0 * hf2[c * 4 + 0] + t2; t3 = a1 * hf2[c * 4 + 1] + t3; t2 = a2 * hf2[c * 4 + 2] + t2; t3 = a3 * hf2[c * 4 + 3] + t3; } \
                t2 = t2 + t3; \
                cf[q] = (t2.x + t2.y) * __uint_as_float(US[q] << 16); } \
            wave_sum4_dpp(cf[0], cf[1], cf[2], cf[3]); \
            _Pragma("unroll") for (int q = 0; q < 4; ++q) cf[q] = __int_as_float(__builtin_amdgcn_readlane(__float_as_int(cf[q]), 63)); \
            { float xg_ = 0.f;        \
              _Pragma("unroll") for (int q = 0; q < 4; ++q) asm("v_writelane_b32 %0, %1, %2" : "+v"(xg_) : "s"(cf[q]), "n"(q)); \
              const float yg_ = gelu_f(xg_); \
              _Pragma("unroll") for (int q = 0; q < 4; ++q) cf[q] = GT[q] * __int_as_float(__builtin_amdgcn_readlane(__float_as_int(yg_), q)); } \
            _Pragma("unroll") for (int q = 0; q < 4; ++q) { const float cs = cf[q] * __uint_as_float(US[q] & 0xffff0000u); const f32x2 cs2 = {cs, cs}; \
                _Pragma("unroll") for (int c = 0; c < 4; ++c) { FP4X8(VR[q][c], b); \
                    acc2[c * 4 + 0] = cs2 * b0 + acc2[c * 4 + 0]; acc2[c * 4 + 1] = cs2 * b1 + acc2[c * 4 + 1]; acc2[c * 4 + 2] = cs2 * b2 + acc2[c * 4 + 2]; acc2[c * 4 + 3] = cs2 * b3 + acc2[c * 4 + 3]; } } } while (0)
        {
            u32x4 urA[4], vrA[4], urB[4], vrB[4]; unsigned usA[4], usB[4]; float gtA[4], gtB[4];
            G_LOAD(0, urA, vrA, usA, gtA);
            for (int g = 0; g < 32; g += 2) {
                G_LOAD(g + 1, urB, vrB, usB, gtB);
                G_COMP(urA, vrA, usA, gtA);
                G_LOAD((g + 2 < 32) ? g + 2 : 31, urA, vrA, usA, gtA);
                G_COMP(urB, vrB, usB, gtB);
            }
        }
#undef G_LOAD
#undef G_COMP
        float acc[32];
#pragma unroll
        for (int i = 0; i < 16; ++i) { acc[2 * i] = acc2[i].x; acc[2 * i + 1] = acc2[i].y; }
        if (!apply) { if (p->ph_hi == -12345) { for (int i = 0; i < 32; ++i) xc[i * 64 + lane] = f2bf(acc[i]); } continue; }
        const int b = tok >> 13; const float gm = ((MK_SKIP >> (2 * l + 1)) & 1) ? 0.f : 1.f;
        float ss = 0.f;
#pragma unroll
        for (int c = 0; c < 4; ++c) { const int col = lane * 32 + c * 8; bf16_t* xp = xc + (size_t)tok * D + col;
            const u32x4 xb = *(const u32x4*)xp; const f32x4 g0 = *(const f32x4*)(gt2 + (size_t)b * MODC + col), g1 = *(const f32x4*)(gt2 + (size_t)b * MODC + col + 4);
            const float x8[8] = {bflo(xb.x), bfhi(xb.x), bflo(xb.y), bfhi(xb.y), bflo(xb.z), bfhi(xb.z), bflo(xb.w), bfhi(xb.w)}; float y8[8];
#pragma unroll
            for (int e2 = 0; e2 < 8; ++e2) { y8[e2] = x8[e2] + gm * ((e2 < 4) ? g0[e2] : g1[e2 - 4]) * acc[c * 8 + e2]; acc[c * 8 + e2] = y8[e2]; ss += y8[e2] * y8[e2]; }
            if (l < 3) { u32x4 w; w.x = cvt_pk_bf16(y8[0], y8[1]); w.y = cvt_pk_bf16(y8[2], y8[3]); w.z = cvt_pk_bf16(y8[4], y8[5]); w.w = cvt_pk_bf16(y8[6], y8[7]); *(u32x4*)xp = w; } }
        const float rn = rsqrtf(wave_sum(ss) * (1.f / D) + NORM_EPS);
        const float* modall = WSP(const float, WS_MOD) + (size_t)b * MODC;
        if (l == 3) {
#pragma unroll
            for (int c = 0; c < 8; ++c) { const int col = lane * 32 + c * 4; const f32x4 gv = *(const f32x4*)(p->in[25] + col); f32x4 o;
#pragma unroll
                for (int e2 = 0; e2 < 4; ++e2) o[e2] = acc[c * 4 + e2] * rn * gv[e2];
                *(f32x4*)(p->out + (size_t)tok * D + col) = o; }
        } else {
            const float* g1 = (l == 1) ? p->in[13] : (p->in[5] + (l + 1) * D);
            const float* sh1 = (l == 1) ? (modall + 4 * 12288) : (modall + (l + 1) * 12288);
            const float* sc1 = sh1 + D;
            bf16_t* d1 = WSP(bf16_t, WS_HBUF) + (size_t)tok * D;
#pragma unroll
            for (int c = 0; c < 4; ++c) { u32x4 w;
#pragma unroll
                for (int hh = 0; hh < 2; ++hh) { const int col = lane * 32 + c * 8 + hh * 4; const f32x4 gv = *(const f32x4*)(g1 + col), sv = *(const f32x4*)(sh1 + col), cv = *(const f32x4*)(sc1 + col); float o[4];
#pragma unroll
                    for (int e2 = 0; e2 < 4; ++e2) o[e2] = acc[c * 8 + hh * 4 + e2] * rn * gv[e2] * (1.f + cv[e2]) + sv[e2];
                    w[hh * 2] = cvt_pk_bf16(o[0], o[1]); w[hh * 2 + 1] = cvt_pk_bf16(o[2], o[3]); }
                *(u32x4*)(d1 + lane * 32 + c * 8) = w; }
            if (l == 1) {
                const float* g2 = p->in[5] + 2 * D; const float* sh2 = modall + 2 * 12288; const float* sc2 = sh2 + D;
                bf16_t* d2 = WSP(bf16_t, WS_OBUF) + (size_t)tok * D;
#pragma unroll
                for (int c = 0; c < 4; ++c) { u32x4 w;
#pragma unroll
                    for (int hh = 0; hh < 2; ++hh) { const int col = lane * 32 + c * 8 + hh * 4; const f32x4 gv = *(const f32x4*)(g2 + col), sv = *(const f32x4*)(sh2 + col), cv = *(const f32x4*)(sc2 + col); float o[4];
#pragma unroll
                        for (int e2 = 0; e2 < 4; ++e2) o[e2] = acc[c * 8 + hh * 4 + e2] * rn * gv[e2] * (1.f + cv[e2]) + sv[e2];
                        w[hh * 2] = cvt_pk_bf16(o[0], o[1]); w[hh * 2 + 1] = cvt_pk_bf16(o[2], o[3]); }
                    *(u32x4*)(d2 + lane * 32 + c * 8) = w; }
            }
        }
    }
}
#undef FP4X8

DI void ph_dbg(PK p, int mode, const int wv) {
    PK_FRESH(p);
    const int tid = ltid(wv);
    const bf16_t* Ag = WSP(const bf16_t, WS_GA); const bf16_t* Bg = WSP(const bf16_t, WS_GB); const bf16_t* Qg = WSP(const bf16_t, WS_GQ); const bf16_t* Og = WSP(const bf16_t, WS_GO); const bf16_t* Sg = WSP(const bf16_t, WS_GS);
    const bf16_t* proj = WSP(const bf16_t, WS_PROJ); bf16_t* obuf = WSP(bf16_t, WS_OBUF);
    for (int idx = blockIdx.x * 512 + tid; idx < T * D; idx += gridDim.x * 512) {
        const int tok = idx >> 11, col = idx & 2047, hd = col >> 7, v = col & 127, b = tok >> 13, s = tok & 8191, n = s >> 6, i = s & 63;
        const size_t ci = (size_t)(b * 16 + hd) * 128 + n;
        float r = 0.f;
        if (mode == 1) r = bf2f(Og[ci * 8192 + i * 128 + v]) + bf2f(Qg[ci * 8192 + i * 128 + v]);
        if (mode == 2) r = bf2f(Ag[ci * 16384 + i * 128 + v]) + bf2f(Bg[ci * 16384 + (i + 64) * 128 + v]) + bf2f(Ag[ci * 16384 + (i + 64) * 128 + v]) + bf2f(Bg[ci * 16384 + i * 128 + v]);
        if (mode == 3) r = bf2f(Sg[ci * 16384 + i * 128 + v]) + bf2f(Sg[ci * 16384 + (i + 64) * 128 + v]);
        if (mode == 4) r = bf2f(proj[(size_t)tok * GINP + col]) + bf2f(proj[(size_t)tok * GINP + 2048 + col]) + bf2f(proj[(size_t)tok * GINP + 4096 + col]) + bf2f(proj[(size_t)tok * GINP + 6144 + col]) + ((col < 256) ? bf2f(proj[(size_t)tok * GINP + 8192 + col]) : 0.f);
        obuf[idx] = f2bf(r);
    }
}
#ifndef MK_AOUT
#define MK_AOUT obuf
#endif
constexpr int NPHASES = 1 + 1 + 2 * 9 + 2 * 8 + 1;

__global__ void __launch_bounds__(512, 2) mk_fwd(Params p_arg) {
    extern __shared__ __attribute__((aligned(16))) unsigned char lds[];
    PK p = (PK)__builtin_amdgcn_kernarg_segment_ptr();
    const int lo = p->ph_lo, hi = p->ph_hi;
    const int wv = __builtin_amdgcn_readfirstlane((int)threadIdx.x >> 6);
    volatile LAS unsigned* st = (volatile LAS unsigned*)((LAS unsigned char*)lds + LDS_BARW);
    if (wv == 0 && lane_id() == 0) { st[0] = 0u; st[1] = 0u; }
    __syncthreads();
    XcdBarrier bar; bar.bar = (unsigned*)(p->ws + WS_BAR); bar.x = 0; bar.st = st; bar.wv = wv;
    if (hi - lo > 1) bar = xcd_barrier_post((unsigned*)(p->ws + WS_BAR), st, wv);
    int ph = 0;
#define PH_BEGIN if (lo <= ph && ph < hi) { PK_FRESH(p);
#define PH_END   if (ph + 1 < hi) xcd_barrier(bar); } ++ph;
#define mod  WSP(const float, WS_MOD)
#define xcur WSP(bf16_t, WS_XCUR)
#define hbuf WSP(bf16_t, WS_HBUF)
#define obuf WSP(bf16_t, WS_OBUF)
#define G    ((int)gridDim.x)
#define bx   ((int)blockIdx.x)
#define modl (mod + l * 12288)

    PH_BEGIN ph_prologue(p, lds, wv); if (MK_DUP & 1) { __syncthreads(); ph_prologue(p, lds, wv); } PH_END

    for (int l = 0; l < DEPTH; ++l) {
        if (l == 0) { PH_BEGIN ph_norm<0>(p->in[0], nullptr, p->in[5], modl + 0 * D, modl + 1 * D, hbuf, nullptr, wv); PH_END }
        PH_BEGIN
            pg8::Gemm g; pg8::EpiMk E; E.mode = 0; E.xin = nullptr; E.xinb = nullptr; E.xout = nullptr; E.gate = nullptr; E.gmul = 1.f; E.xoutf = nullptr; E.O2 = nullptr; E.nrope = 0; E.cosT = WSP(const float, WS_COS); E.sinT = WSP(const float, WS_SIN);
            g.A = (l == 2) ? obuf : hbuf; g.M = T; g.K = D; g.ld = D; g.ksplit = 0;
            if (l < 2) { g.Bt = WSP(const bf16_t, WS_WIN) + (size_t)l * GINP * D; g.N = 8192; E.O = WSP(bf16_t, WS_PROJ); E.ldc = GINP; }
            else { g.Bt = WSP(const bf16_t, WS_DWQ) + (size_t)(l - 2) * D * D; g.N = D; E.mode = 2; E.O = WSP(bf16_t, WS_QD); E.nrope = D; }
            pg8::StaticOrder S; S.init(g.M, g.N, G, bx);
            pg8::gemm_phase<pg8::EpiMk, pg8::StaticOrder>((PG8_LAS unsigned char*)lds, g, S, E, wv);
            if (MK_DUP & 2) { __syncthreads(); pg8::gemm_phase<pg8::EpiMk, pg8::StaticOrder>((PG8_LAS unsigned char*)lds, g, S, E, wv); }
            if (l < 2) {
                pg8::Gemm g2; g2.A = hbuf; g2.Bt = WSP(const bf16_t, WS_WIN) + (size_t)l * GINP * D + (size_t)8192 * D; g2.M = T; g2.N = 1024; g2.K = 512; g2.ld = D; g2.ksplit = 1;
                pg8::EpiMk E2 = E; E2.mode = 3; E2.xoutf = WSP(float, WS_PAB);
                pg8::StaticOrder S2; S2.init(g2.M, g2.N, G, bx);
                pg8::gemm_phase<pg8::EpiMk, pg8::StaticOrder>((PG8_LAS unsigned char*)lds, g2, S2, E2, wv);
            }
        PH_END
        if (l < 2) {
            PH_BEGIN ph_gdn_p1(p, l, lds, wv); if (MK_DUP & 8) { __syncthreads(); ph_gdn_p1(p, l, lds, wv); } PH_END
            PH_BEGIN ph_gdn_p2(p, lds, wv); if (MK_DUP & 16) { __syncthreads(); ph_gdn_p2(p, lds, wv); } PH_END
#ifdef MK_DBG
            PH_BEGIN ph_dbg(p, MK_DBG, wv); PH_END
#else
            PH_BEGIN ph_gdn_p3(p, l, wv); if (MK_DUP & 32) { __syncthreads(); ph_gdn_p3(p, l, wv); } PH_END
#endif
        } else {
            PH_BEGIN ph_attn(p, lds, wv); if (MK_DUP & 64) { __syncthreads(); ph_attn(p, lds, wv); } PH_END
            PH_BEGIN ph_diff_combine(p, l - 2, l, lds, wv); PH_END
        }
        PH_BEGIN
            pg8::Gemm g; pg8::EpiMk E; E.mode = 1; E.O = nullptr; E.ldc = 0; E.xoutf = nullptr; E.O2 = nullptr; E.nrope = 0; E.cosT = nullptr; E.sinT = nullptr; E.xin = (l == 0) ? p->in[0] : nullptr; E.xinb = xcur; E.xout = xcur; E.gate = modl + 2 * D; E.gmul = ((MK_SKIP >> (2 * l)) & 1) ? 0.f : 1.f;
            g.A = MK_AOUT; g.M = T; g.K = D; g.N = D; g.ld = D; g.ksplit = 0;
            g.Bt = (l < 2) ? (WSP(const bf16_t, WS_WOUT) + (size_t)l * D * D) : (WSP(const bf16_t, WS_DWO) + (size_t)(l - 2) * D * D);
            pg8::StaticOrder S; S.init(g.M, g.N, G, bx);
            pg8::gemm_phase<pg8::EpiMk, pg8::StaticOrder>((PG8_LAS unsigned char*)lds, g, S, E, wv);
        PH_END
        PH_BEGIN ph_norm<2>(nullptr, xcur, p->in[6] + l * D, modl + 3 * D, modl + 4 * D, hbuf, nullptr, wv); PH_END
        PH_BEGIN
            pg8::Gemm g; pg8::EpiMk E; E.mode = 0; E.xin = nullptr; E.xinb = nullptr; E.xout = nullptr; E.gate = nullptr; E.gmul = 1.f; E.xoutf = nullptr; E.O2 = nullptr; E.nrope = 0; E.cosT = WSP(const float, WS_COS); E.sinT = WSP(const float, WS_SIN); E.O = WSP(bf16_t, WS_PQ); E.ldc = D;
            g.A = hbuf; g.M = T; g.K = D; g.N = D; g.ld = D; g.ksplit = 0; g.Bt = WSP(const bf16_t, WS_PWQ) + (size_t)l * D * D;
            pg8::StaticOrder S; S.init(g.M, g.N, G, bx);
            pg8::gemm_phase<pg8::EpiMk, pg8::StaticOrder>((PG8_LAS unsigned char*)lds, g, S, E, wv);
        PH_END
        PH_BEGIN ph_peer_topk(p, l, lds, wv); if (MK_DUP & 128) { __syncthreads(); ph_peer_topk(p, l, lds, wv); } PH_END
        PH_BEGIN ph_peer_gather(p, l, lds, wv); if (MK_DUP & 256) { __syncthreads(); ph_peer_gather(p, l, lds, wv, false); } PH_END
        if (l == 1) {
            PH_BEGIN
                pg8::Gemm g; pg8::EpiMk E; E.mode = 0; E.xin = nullptr; E.xinb = nullptr; E.xout = nullptr; E.gate = nullptr; E.gmul = 1.f; E.xoutf = nullptr; E.O2 = nullptr; E.nrope = 0; E.cosT = WSP(const float, WS_COS); E.sinT = WSP(const float, WS_SIN); E.mode = 2; E.O = WSP(bf16_t, WS_KSH); E.O2 = WSP(bf16_t, WS_VSH); E.nrope = 2048;
                g.A = hbuf; g.M = T; g.K = D; g.N = 4096; g.ld = D; g.ksplit = 0; g.Bt = WSP(const bf16_t, WS_KVW);
                pg8::StaticOrder S; S.init(g.M, g.N, G, bx);
                pg8::gemm_phase<pg8::EpiMk, pg8::StaticOrder>((PG8_LAS unsigned char*)lds, g, S, E, wv);
            PH_END
        }
    }
#undef PH_BEGIN
#undef PH_END
#undef mod
#undef xcur
#undef hbuf
#undef obuf
#undef G
#undef bx
#undef modl
}

extern "C" void kernel_launch(void* const* d_in, const int* in_sizes, int n_in, void* d_out, int out_size, void* d_ws, size_t ws_size, hipStream_t stream) {
    static int grid = 0;
    if (grid == 0) {
        if (n_in != 26 || in_sizes[0] != T * D || out_size != T * D || ws_size < WS_END) {
            fprintf(stderr, "kernel_launch: unexpected shapes: n_in %d in0 %d out %d ws %zu (need %zu)\n", n_in, n_in > 0 ? in_sizes[0] : -1, out_size, ws_size, (size_t)WS_END); grid = -1; return; }
        int dev = 0, cus = 0;
        if (hipGetDevice(&dev) != hipSuccess || hipDeviceGetAttribute(&cus, hipDeviceAttributeMultiprocessorCount, dev) != hipSuccess || cus <= 0) cus = 256;
        if (hipFuncSetAttribute((const void*)mk_fwd, hipFuncAttributeMaxDynamicSharedMemorySize, LDS_BYTES) != hipSuccess) { fprintf(stderr, "kernel_launch: hipFuncSetAttribute failed\n"); grid = -1; return; }
        int per_cu = 0;
        if (hipOccupancyMaxActiveBlocksPerMultiprocessor(&per_cu, (const void*)mk_fwd, 512, LDS_BYTES) != hipSuccess || per_cu < 1) fprintf(stderr, "kernel_launch: occupancy query says %d\n", per_cu);
        (void)hipGetLastError();
        grid = cus;
    }
    if (grid < 0) return;
    (void)hipMemsetAsync((char*)d_ws + WS_BAR, 0, 16384, stream);
    Params p{};
    for (int i = 0; i < 26; ++i) p.in[i] = (const float*)d_in[i];
    p.out = (float*)d_out; p.ws = (unsigned char*)d_ws;
#if MK_N_LAUNCHES == 1
    p.ph_lo = 0; p.ph_hi = NPHASES;
    hipLaunchKernelGGL(mk_fwd, dim3(grid), dim3(512), LDS_BYTES, stream, p);
#else
#ifndef MK_PHMASK
#define MK_PHMASK 0xffffffffu
#endif
#ifndef MK_STOP
#define MK_STOP NPHASES
#endif
    for (int ph = 0; ph < NPHASES; ++ph) { if (ph >= MK_STOP && ph != NPHASES - 1) continue; if (!(MK_PHMASK >> (ph < 31 ? ph : 31) & 1u) && ph != NPHASES - 1) continue; p.ph_lo = ph; p.ph_hi = ph + 1; hipLaunchKernelGGL(mk_fwd, dim3(grid), dim3(512), LDS_BYTES, stream, p); }
#endif
    const hipError_t le = hipPeekAtLastError();
    if (le != hipSuccess) fprintf(stderr, "kernel_launch: launch failed: %s\n", hipGetErrorName(le));
}
```

```cpp
#include <hip/hip_runtime.h>
#include <hip/hip_bf16.h>
#include <cstdio>
#include <cstdint>

#ifndef MK_N_LAUNCHES
#define MK_N_LAUNCHES 1
#endif
#ifndef MK_DUP
#define MK_DUP 0
#endif
#ifndef MK_SKIP
#define MK_SKIP 0
#endif

constexpr int NB = 2, SEQ = 8192, T = NB * SEQ, D = 2048, DEPTH = 4;
constexpr int GH = 16, GIN = 8224, GINP = 8448;
constexpr int MODC = 4 * 12288 + 4096;
constexpr float NORM_EPS = 1e-6f;

typedef unsigned short bf16_t;
typedef short bf16x8 __attribute__((ext_vector_type(8)));
typedef short s16x4 __attribute__((ext_vector_type(4)));
typedef float f32x4 __attribute__((ext_vector_type(4)));
typedef float f32x2 __attribute__((ext_vector_type(2)));
typedef float f32x16 __attribute__((ext_vector_type(16)));
typedef unsigned u32x4 __attribute__((ext_vector_type(4)));
typedef unsigned u32x2 __attribute__((ext_vector_type(2)));
typedef __bf16 bfx2 __attribute__((ext_vector_type(2)));
#define LAS __attribute__((address_space(3)))
#define DI __device__ __forceinline__

DI float bf2f(bf16_t v) { return __uint_as_float(((unsigned)v) << 16); }
DI float bflo(unsigned w) { return __uint_as_float(w << 16); }
DI float bfhi(unsigned w) { return __uint_as_float(w & 0xffff0000u); }
DI bf16_t f2bf(float f) { unsigned u = __float_as_uint(f); u += 0x7FFFu + ((u >> 16) & 1u); return (bf16_t)(u >> 16); }
DI unsigned cvt_pk_bf16(float lo, float hi) { const f32x2 v = {lo, hi}; return __builtin_bit_cast(unsigned, __builtin_convertvector(v, bfx2)); }
template <int CTRL, int RMASK> DI float dpp_mov(float v) { return __int_as_float(__builtin_amdgcn_update_dpp(0, __float_as_int(v), CTRL, RMASK, 0xF, false)); }
template <int CTRL> DI float dpp_full(float v) { return __int_as_float(__builtin_amdgcn_update_dpp(0, __float_as_int(v), CTRL, 0xF, 0xF, true)); }
template <int M> DI float sw_xor(float v) {
    if constexpr (M == 1) return dpp_full<0xB1>(v);
    else if constexpr (M == 2) return dpp_full<0x4E>(v);
    else if constexpr (M == 8) return dpp_full<0x128>(v);
    else return __int_as_float(__builtin_amdgcn_ds_swizzle(__float_as_int(v), (M << 10) | 0x1f));
}
DI float row_sum16(float v) { v += dpp_full<0xB1>(v); v += dpp_full<0x4E>(v); v += dpp_full<0x141>(v); v += dpp_full<0x140>(v); return v; }
DI float sw_xor32_sum(float v) { auto rr = __builtin_amdgcn_permlane32_swap(__float_as_uint(v), __float_as_uint(v), false, false); return __uint_as_float(rr[0]) + __uint_as_float(rr[1]); }
DI float wave_max(float v) {
    v = fmaxf(v, sw_xor<1>(v)); v = fmaxf(v, sw_xor<2>(v)); v = fmaxf(v, sw_xor<4>(v)); v = fmaxf(v, sw_xor<8>(v)); v = fmaxf(v, sw_xor<16>(v));
    auto rr = __builtin_amdgcn_permlane32_swap(__float_as_uint(v), __float_as_uint(v), false, false); return fmaxf(__uint_as_float(rr[0]), __uint_as_float(rr[1]));
}
DI float wave_sum(float v) {
    v = row_sum16(v); v += dpp_mov<0x142, 0xA>(v); v += dpp_mov<0x143, 0xC>(v);
    return __int_as_float(__builtin_amdgcn_readlane(__float_as_int(v), 63));
}
DI float wave_sum_dpp(float v) {
    v += dpp_mov<0xB1, 0xF>(v); v += dpp_mov<0x4E, 0xF>(v); v += dpp_mov<0x141, 0xF>(v); v += dpp_mov<0x140, 0xF>(v);
    v += dpp_mov<0x142, 0xA>(v); v += dpp_mov<0x143, 0xC>(v);
    return __int_as_float(__builtin_amdgcn_readlane(__float_as_int(v), 63));
}
DI void wave_sum4_dpp(float& a, float& b, float& c, float& d) {
#define WS4_STEP(ctl) "v_add_f32_dpp %0, %0, %0 " ctl "\n v_add_f32_dpp %1, %1, %1 " ctl "\n v_add_f32_dpp %2, %2, %2 " ctl "\n v_add_f32_dpp %3, %3, %3 " ctl "\n"
    asm("s_nop 1\n"
        WS4_STEP("quad_perm:[1,0,3,2] row_mask:0xf bank_mask:0xf")
        WS4_STEP("quad_perm:[2,3,0,1] row_mask:0xf bank_mask:0xf")
        WS4_STEP("row_half_mirror row_mask:0xf bank_mask:0xf")
        WS4_STEP("row_mirror row_mask:0xf bank_mask:0xf")
        WS4_STEP("row_bcast:15 row_mask:0xa bank_mask:0xf")
        WS4_STEP("row_bcast:31 row_mask:0xc bank_mask:0xf")
        : "+v"(a), "+v"(b), "+v"(c), "+v"(d));
#undef WS4_STEP
}
DI void lds_barrier() { asm volatile("s_waitcnt lgkmcnt(0)" ::: "memory"); __builtin_amdgcn_s_barrier(); asm volatile("" ::: "memory"); }
DI float silu_f(float v) { return v * __builtin_amdgcn_rcpf(1.f + __expf(-v)); }
DI int lane_id() { int l; asm volatile("v_mbcnt_lo_u32_b32 %0, -1, 0\n\tv_mbcnt_hi_u32_b32 %0, -1, %0" : "=v"(l)); return l; }
DI int ltid(const int wv) { int t = wv * 64 + lane_id(); asm volatile("" : "+v"(t)); return t; }

constexpr size_t al4k(size_t x) { return (x + 4095) & ~(size_t)4095; }
constexpr size_t WS_BAR   = 0;
constexpr size_t WS_MOD   = 16384;
constexpr size_t WS_COS   = al4k(WS_MOD + (size_t)2 * MODC * 4);
constexpr size_t WS_SIN   = WS_COS + (size_t)T * 64 * 4;
constexpr size_t WS_SUBK  = WS_SIN + (size_t)T * 64 * 4;
constexpr size_t WS_WIN   = WS_SUBK + (size_t)4 * 2 * 128 * 128 * 2;
constexpr size_t WS_WOUT  = WS_WIN + (size_t)2 * GINP * D * 2;
constexpr size_t WS_KVW   = WS_WOUT + (size_t)2 * D * D * 2;
constexpr size_t WS_DWQ   = WS_KVW + (size_t)4096 * D * 2;
constexpr size_t WS_DWO   = WS_DWQ + (size_t)2 * D * D * 2;
constexpr size_t WS_PWQ   = WS_DWO + (size_t)2 * D * D * 2;
constexpr size_t WS_PU    = WS_PWQ + (size_t)4 * D * D * 2;
constexpr size_t WS_PUS   = WS_PU + (size_t)16384 * 1024;
constexpr size_t WS_PV    = WS_PU + (size_t)16384 * D * 2;
constexpr size_t WS_PVS   = WS_PV + (size_t)16384 * 1024;
constexpr size_t WS_XCUR  = WS_PV + (size_t)16384 * D * 2;
constexpr size_t WS_HBUF  = WS_XCUR + (size_t)T * D * 4;
constexpr size_t WS_OBUF  = WS_HBUF + (size_t)T * D * 2;
constexpr size_t WS_PROJ  = WS_OBUF + (size_t)T * D * 2;
constexpr size_t WS_PAB   = WS_PROJ + (size_t)T * GINP * 2;
constexpr size_t WS_PQ    = WS_PROJ + (size_t)T * GINP * 2;
constexpr size_t WS_PIDX  = WS_PQ + (size_t)T * D * 2;
constexpr size_t WS_PGATE = WS_PIDX + (size_t)T * 128 * 4;
constexpr size_t WS_GA    = WS_PGATE + (size_t)T * 128 * 4;
constexpr size_t WS_GB    = WS_GA + (size_t)4096 * 128 * 128 * 2;
constexpr size_t WS_GQ    = WS_GB + (size_t)4096 * 128 * 128 * 2;
constexpr size_t WS_GO    = WS_GQ + (size_t)4096 * 64 * 128 * 2;
constexpr size_t WS_GS    = WS_GO + (size_t)4096 * 64 * 128 * 2;
constexpr size_t WS_GL    = WS_GS + (size_t)4096 * 128 * 128 * 2;
constexpr size_t WS_END   = WS_GL + 16384;
constexpr size_t WS_OAT   = WS_GA;
constexpr size_t WS_KSH   = WS_GB;
constexpr size_t WS_VSH   = WS_GB + (size_t)67108864;
constexpr size_t WS_QD    = WS_GQ;

constexpr int LDS_BYTES = 147456;
constexpr int LDS_BARW  = 147456 - 64;

struct Params { const float* in[26]; float* out; unsigned char* ws; int ph_lo, ph_hi; };
typedef const Params __attribute__((address_space(4)))* PK;
#define PK_FRESH(p) asm volatile("" : "+s"(p))

#define XB_TMO      128
#define XB_XCNT(j)  (256  + 64 * (j))
#define XB_XSUB(j)  (1280 + 64 * (j))
#define XB_XGEN(j)  (2304 + 64 * (j))
#define XB_TOP      3328
#define XB_TOPGEN   3392
#define XCD_BAR_WORDS 3456
#define XB_SPIN_CAP (1u << 20)

__device__ __forceinline__ unsigned xb_ld(unsigned* p)              { return __hip_atomic_load(p, __ATOMIC_RELAXED, __HIP_MEMORY_SCOPE_AGENT); }
__device__ __forceinline__ unsigned xb_add(unsigned* p, unsigned v) { return __hip_atomic_fetch_add(p, v, __ATOMIC_RELAXED, __HIP_MEMORY_SCOPE_AGENT); }
__device__ __forceinline__ unsigned xb_xcc_id() { return (unsigned)__builtin_amdgcn_s_getreg((3 << 11) | 20) & 0xFu; }
#define XB_SPIN(cond, bar) do { unsigned _sp = 0; while (cond) { __builtin_amdgcn_s_sleep(1); \
    if ((++_sp & 255u) == 0u) { if (xb_ld(&(bar)[XB_TMO])) break; if (_sp > XB_SPIN_CAP) { atomicAdd(&(bar)[XB_TMO], 1u); break; } } } } while (0)

struct XcdBarrier { unsigned* bar; unsigned x; volatile LAS unsigned* st; int wv; };

__device__ __forceinline__ XcdBarrier xcd_barrier_post(unsigned* bar, volatile LAS unsigned* st, int wv) {
    XcdBarrier b; b.bar = bar; b.x = xb_xcc_id(); b.st = st; b.wv = wv;
    if (wv == 0 && lane_id() == 0) (void)xb_add(&bar[XB_XCNT(b.x)], 1u);
    return b;
}
__device__ __forceinline__ void xcd_barrier_complete(unsigned* bar, unsigned x, unsigned& nloc, unsigned& nx) {
    const unsigned G = gridDim.x * gridDim.y * gridDim.z;
    unsigned sum, cnt, mine, sp = 0u;
    for (;;) {
        sum = 0u; cnt = 0u; mine = 0u;
#pragma unroll
        for (unsigned j = 0; j < 16; ++j) { const unsigned c = xb_ld(&bar[XB_XCNT(j)]); sum += c; cnt += (c > 0u) ? 1u : 0u; mine = (j == x) ? c : mine; }
        if (sum == G) break;
        __builtin_amdgcn_s_sleep(1);
        if ((++sp & 255u) == 0u) { if (xb_ld(&bar[XB_TMO])) break; if (sp > XB_SPIN_CAP) { atomicAdd(&bar[XB_TMO], 1u); break; } }
    }
    nloc = mine > 0u ? mine : 1u; nx = cnt > 0u ? cnt : 1u;
}
__device__ __forceinline__ void xcd_barrier(const XcdBarrier& b) {
    asm volatile("s_waitcnt vmcnt(0)" ::: "memory");
    __syncthreads();
    if (b.wv == 0 && lane_id() == 0) {
        unsigned* bar = b.bar;
        __builtin_amdgcn_s_waitcnt(0);
        unsigned nloc = b.st[0], nx = b.st[1];
        if (nloc == 0u) { xcd_barrier_complete(bar, b.x, nloc, nx); b.st[0] = nloc; b.st[1] = nx; }
        const unsigned old = xb_add(&bar[XB_XSUB(b.x)], 1u);
        const unsigned gen = old / nloc;
        if (old + 1u == (gen + 1u) * nloc) {
            __builtin_amdgcn_fence(__ATOMIC_RELEASE, "agent");
            asm volatile("s_waitcnt vmcnt(0)" ::: "memory");
            const unsigned og = xb_add(&bar[XB_TOP], 1u);
            const unsigned tg = og / nx;
            if (og + 1u == (tg + 1u) * nx) xb_add(&bar[XB_TOPGEN], 1u);
            else XB_SPIN(xb_ld(&bar[XB_TOPGEN]) == tg, bar);
            __builtin_amdgcn_fence(__ATOMIC_ACQUIRE, "agent");
            xb_add(&bar[XB_XGEN(b.x)], 1u);
            asm volatile("s_waitcnt vmcnt(0)" ::: "memory");
        } else {
            XB_SPIN(xb_ld(&bar[XB_XGEN(b.x)]) == gen, bar);
            __builtin_amdgcn_fence(__ATOMIC_ACQUIRE, "agent");
            asm volatile("s_waitcnt vmcnt(0)" ::: "memory");
        }
    }
    __syncthreads();
}

namespace pg8 {
#define PG8_LAS __attribute__((address_space(3)))
constexpr int BM = 256, BK = 64, HALF = 128, HTB = HALF * BK * 2, STAGE_BYTES = 8 * HTB, NXCD = 8, WGM = 8;
__host__ __device__ __forceinline__ int lds_byte(int r, int c) { const int st = (r >> 4) * 2 + (c >> 5), rr = r & 15, cc = c & 31, ob = rr * 64 + cc * 2; return st * 1024 + (ob ^ (((ob >> 9) & 1) << 5)); }
__host__ __device__ __forceinline__ void stage_rc(int b, int& R, int& C) { const int st = b / 1024, sb = b % 1024, swz = sb ^ (((sb >> 9) & 1) << 5); R = (st >> 1) * 16 + swz / 64; C = (st & 1) * 32 + (swz % 64) / 2; }
__host__ __device__ __forceinline__ int perm32(int rho) { const int n = rho >> 4, i = rho & 15; return 8 * (i >> 2) + 4 * n + (i & 3); }
struct Unit { int pm, pn; };
struct Gemm { const bf16_t* A; const bf16_t* Bt; int M, N, K; int ld; int ksplit; };
struct StaticOrder {
    int nM, nN, nwg, G, c;
    __host__ __device__ void init(int M, int N, int G_, int c_) { nM = M / BM; nN = N / BM; nwg = nM * nN; G = G_; c = c_; }
    __host__ __device__ bool next(int i, Unit& u) const {
        const long L = (long)i * G + c; if (L >= nwg) return false;
        int wgid = (int)L; { const int q = nwg / NXCD, r = nwg % NXCD, xcd = wgid % NXCD, off = wgid / NXCD; wgid = (xcd < r ? xcd * (q + 1) : r * (q + 1) + (xcd - r) * q) + off; }
        const int nig = WGM * nN, gid = wgid / nig, fm = gid * WGM, gsz = (nM - fm) < WGM ? (nM - fm) : WGM;
        u.pm = fm + ((wgid % nig) % gsz); u.pn = (wgid % nig) / gsz; return true;
    }
    __device__ __forceinline__ void a_ready(const Unit&) const {}
    __device__ __forceinline__ void done(const Unit&) const {}
};

struct EpiMk {
    static constexpr bool PERM = true, AFTER_DRAIN = false;
    int mode; bf16_t* O; int ldc; const float* xin; const bf16_t* xinb; bf16_t* xout; const float* gate; float gmul;
    bf16_t* O2; int nrope; const float* cosT; const float* sinT;
    float* xoutf;
    __device__ __forceinline__ void operator()(const f32x4 (&acc)[2][2][4][2], const Unit& u, int wr, int wc, int fr, int fq) const {
        const int row0 = u.pm * BM + wr * 64 + fr, col0 = u.pn * BM + wc * 32 + 8 * fq;
        if (mode == 0) {
#pragma unroll
            for (int ai = 0; ai < 2; ++ai)
#pragma unroll
                for (int m = 0; m < 4; ++m) { bf16_t* rowp = O + (size_t)(row0 + ai * HALF + m * 16) * ldc + col0;
#pragma unroll
                    for (int bj = 0; bj < 2; ++bj) { const f32x4 v0 = acc[ai][bj][m][0], v1 = acc[ai][bj][m][1];
                        u32x4 w; w.x = cvt_pk_bf16(v0[0], v0[1]); w.y = cvt_pk_bf16(v0[2], v0[3]); w.z = cvt_pk_bf16(v1[0], v1[1]); w.w = cvt_pk_bf16(v1[2], v1[3]);
                        *(u32x4*)(rowp + bj * HALF) = w; } }
        } else if (mode == 3) {
            if (wc == 0) {
#pragma unroll
                for (int ai = 0; ai < 2; ++ai)
#pragma unroll
                    for (int m = 0; m < 4; ++m) { const int row = row0 + ai * HALF + m * 16; float* dp = xoutf + ((size_t)u.pn * T + row) * 32 + 8 * fq;
                        *(f32x4*)dp = acc[ai][0][m][0]; *(f32x4*)(dp + 4) = acc[ai][0][m][1]; }
            }
        } else if (mode == 2) {
#pragma unroll
            for (int ai = 0; ai < 2; ++ai)
#pragma unroll
                for (int m = 0; m < 4; ++m) { const int row = row0 + ai * HALF + m * 16, bb = row >> 13, ss = row & 8191;
#pragma unroll
                    for (int bj = 0; bj < 2; ++bj) { const int col = col0 + bj * HALF; const f32x4 v0 = acc[ai][bj][m][0], v1 = acc[ai][bj][m][1];
                        if (col < nrope) { const int hc = col >> 7, j0 = ((col & 127) >> 3) * 4;
                            const f32x4 cs = *(const f32x4*)(cosT + (size_t)row * 64 + j0), sn = *(const f32x4*)(sinT + (size_t)row * 64 + j0);
                            bf16_t* dp = O + ((size_t)(bb * 16 + hc) * SEQ + ss) * 128 + j0;
                            u32x2 w1, w2; w1.x = cvt_pk_bf16(v0[0] * cs[0] - v1[0] * sn[0], v0[1] * cs[1] - v1[1] * sn[1]); w1.y = cvt_pk_bf16(v0[2] * cs[2] - v1[2] * sn[2], v0[3] * cs[3] - v1[3] * sn[3]);
                            w2.x = cvt_pk_bf16(v1[0] * cs[0] + v0[0] * sn[0], v1[1] * cs[1] + v0[1] * sn[1]); w2.y = cvt_pk_bf16(v1[2] * cs[2] + v0[2] * sn[2], v1[3] * cs[3] + v0[3] * sn[3]);
                            *(u32x2*)dp = w1; *(u32x2*)(dp + 64) = w2;
                        } else { const int cv = col - nrope, hc = cv >> 7;
                            u32x4 w; w.x = cvt_pk_bf16(v0[0], v0[1]); w.y = cvt_pk_bf16(v0[2], v0[3]); w.z = cvt_pk_bf16(v1[0], v1[1]); w.w = cvt_pk_bf16(v1[2], v1[3]);
                            *(u32x4*)(O2 + ((size_t)(bb * 16 + hc) * SEQ + ss) * 128 + (cv & 127)) = w; } } }
        } else {
#pragma unroll
            for (int ai = 0; ai < 2; ++ai)
#pragma unroll
                for (int m = 0; m < 4; ++m) { const int row = row0 + ai * HALF + m * 16; const float* gp = gate + (size_t)(row >> 13) * MODC + col0;
                    bf16_t* xo = xout + (size_t)row * D + col0;
#pragma unroll
                    for (int bj = 0; bj < 2; ++bj) {
                        const f32x4 g0 = *(const f32x4*)(gp + bj * HALF), g1 = *(const f32x4*)(gp + bj * HALF + 4);
                        f32x4 x0, x1;
                        if (xin) { x0 = *(const f32x4*)(xin + (size_t)row * D + col0 + bj * HALF); x1 = *(const f32x4*)(xin + (size_t)row * D + col0 + bj * HALF + 4); }
                        else { const u32x4 xb = *(const u32x4*)(xinb + (size_t)row * D + col0 + bj * HALF);
                            x0 = (f32x4){bflo(xb.x), bfhi(xb.x), bflo(xb.y), bfhi(xb.y)}; x1 = (f32x4){bflo(xb.z), bfhi(xb.z), bflo(xb.w), bfhi(xb.w)}; }
                        const f32x4 y0 = x0 + gmul * g0 * acc[ai][bj][m][0], y1 = x1 + gmul * g1 * acc[ai][bj][m][1];
                        u32x4 w; w.x = cvt_pk_bf16(y0[0], y0[1]); w.y = cvt_pk_bf16(y0[2], y0[3]); w.z = cvt_pk_bf16(y1[0], y1[1]); w.w = cvt_pk_bf16(y1[2], y1[3]);
                        *(u32x4*)(xo + bj * HALF) = w; } }
        }
    }
};

template <class Epi, class Sched>
__device__ __forceinline__ void gemm_phase(PG8_LAS unsigned char* lds, const Gemm g, const Sched& S, const Epi& E, const int wv) {
    const int tid = ltid(wv), wid = __builtin_amdgcn_readfirstlane(tid >> 6), lane = tid & 63, wr = wid >> 2, wc = wid & 3, fr = lane & 15, fq = lane >> 4;
    const int K = g.K, nt = K / BK, ld = g.ld;
    unsigned voffA[2], voffB[2];
#pragma unroll
    for (int i = 0; i < 2; ++i) { int R, C; stage_rc(tid * 16 + i * 8192, R, C); const int Rb = Epi::PERM ? ((R & ~31) + perm32(R & 31)) : R;
        voffA[i] = (unsigned)(R * ld + C) * 2u; voffB[i] = (unsigned)(Rb * ld + C) * 2u; }
    const size_t kstep = (size_t)(BK * 2);
    const size_t hstep = (size_t)HALF * ld * 2;
    const size_t tstep = 2 * hstep;
    const unsigned ldsw = (unsigned)wid * 1024u;
    const int aoff = lds_byte(wr * 64 + fr, fq * 8), boff = lds_byte(wc * 32 + fr, fq * 8);
#define PG8_SA(b, h) (((b) * 2 + (h)) * HTB)
#define PG8_SB(b, h) ((4 + (b) * 2 + (h)) * HTB)
#define PG8_STAGE(bufoff, gbase, voff) do { _Pragma("unroll") for (int _i = 0; _i < 2; ++_i) \
        __builtin_amdgcn_global_load_lds((const unsigned*)((const char*)(gbase) + (voff)[_i]), (PG8_LAS unsigned*)(lds + (bufoff) + ldsw + _i * 8192), 16, 0, 0); } while (0)
#define PG8_LDA(dst, b, h) do { _Pragma("unroll") for (int m = 0; m < 4; ++m) _Pragma("unroll") for (int k = 0; k < 2; ++k) dst[m][k] = *(const PG8_LAS bf16x8*)(lds + PG8_SA(b, h) + aoff + m * 2048 + k * 1024); } while (0)
#define PG8_LDB(dst, b, h) do { _Pragma("unroll") for (int n = 0; n < 2; ++n) _Pragma("unroll") for (int k = 0; k < 2; ++k) dst[n][k] = *(const PG8_LAS bf16x8*)(lds + PG8_SB(b, h) + boff + n * 2048 + k * 1024); } while (0)
#define PG8_MMA(ai, bj, At, Bt) do { __builtin_amdgcn_s_setprio(1); _Pragma("unroll") for (int m = 0; m < 4; ++m) _Pragma("unroll") for (int n = 0; n < 2; ++n) _Pragma("unroll") for (int k = 0; k < 2; ++k) \
        acc[ai][bj][m][n] = __builtin_amdgcn_mfma_f32_16x16x32_bf16(Bt[n][k], At[m][k], acc[ai][bj][m][n], 0, 0, 0); __builtin_amdgcn_s_setprio(0); } while (0)
#define PG8_WAIT_V(n) asm volatile("s_waitcnt vmcnt(" #n ")" ::: "memory")
#define PG8_WAIT_L(n) asm volatile("s_waitcnt lgkmcnt(" #n ")" ::: "memory")
#define PG8_BAR __builtin_amdgcn_s_barrier()
#define PG8_SCHED __builtin_amdgcn_sched_barrier(0)
    Unit cur, nxt; int ui = 0;
    if (!S.next(0, cur)) return;
    f32x4 acc[2][2][4][2];
#pragma unroll
    for (int a = 0; a < 2; ++a)
#pragma unroll
        for (int b = 0; b < 2; ++b)
#pragma unroll
            for (int m = 0; m < 4; ++m)
#pragma unroll
                for (int n = 0; n < 2; ++n) acc[a][b][m][n] = (f32x4){0.f, 0.f, 0.f, 0.f};
    bf16x8 At[4][2], B0[2][2], B1[2][2];
    const size_t bstep = g.ksplit ? (size_t)K * 2 : tstep, astep = g.ksplit ? (size_t)K * 2 : 0;
    const char* cA = (const char*)g.A + (size_t)cur.pm * tstep + (size_t)cur.pn * astep; const char* cB = (const char*)g.Bt + (size_t)cur.pn * bstep;
    S.a_ready(cur);
    PG8_STAGE(PG8_SB(0, 0), cB, voffB); PG8_STAGE(PG8_SA(0, 0), cA, voffA); PG8_STAGE(PG8_SB(0, 1), cB + hstep, voffB); PG8_STAGE(PG8_SA(0, 1), cA + hstep, voffA);
    if (wr == 1) PG8_BAR;
    PG8_WAIT_V(4); PG8_BAR;
    PG8_STAGE(PG8_SB(1, 0), cB + kstep, voffB); PG8_STAGE(PG8_SA(1, 0), cA + kstep, voffA); PG8_STAGE(PG8_SB(1, 1), cB + hstep + kstep, voffB);
    PG8_WAIT_V(6); PG8_BAR;
    for (;;) {
        const bool has_next = S.next(ui + 1, nxt);
        const char* nA = has_next ? (const char*)g.A + (size_t)nxt.pm * tstep + (size_t)nxt.pn * astep : cA; const char* nB = has_next ? (const char*)g.Bt + (size_t)nxt.pn * bstep : cB;
        for (int t = 0; t < nt; t += 2) {
            const bool last = (t == nt - 2);
            const char* a1 = cA + (size_t)(t + 1) * kstep;
            const char* a2 = last ? nA : cA + (size_t)(t + 2) * kstep; const char* b2 = last ? nB : cB + (size_t)(t + 2) * kstep;
            const char* a3 = a2 + kstep; const char* b3 = b2 + kstep;
            if (last && has_next) S.a_ready(nxt);
            PG8_LDB(B0, 0, 0); PG8_SCHED; PG8_LDA(At, 0, 0); PG8_STAGE(PG8_SA(1, 1), a1 + hstep, voffA);
            PG8_WAIT_L(8); PG8_BAR; PG8_WAIT_L(0); PG8_MMA(0, 0, At, B0); PG8_BAR; PG8_SCHED;
            PG8_LDB(B1, 0, 1); PG8_STAGE(PG8_SB(0, 0), b2, voffB);
            PG8_BAR; PG8_WAIT_L(0); PG8_MMA(0, 1, At, B1); PG8_BAR;
            PG8_LDA(At, 0, 1); PG8_STAGE(PG8_SA(0, 0), a2, voffA);
            PG8_BAR; PG8_WAIT_L(0); PG8_MMA(1, 0, At, B0); PG8_BAR; PG8_SCHED;
            PG8_STAGE(PG8_SB(0, 1), b2 + hstep, voffB);
            PG8_WAIT_V(6); PG8_BAR; PG8_MMA(1, 1, At, B1); PG8_BAR;
            PG8_LDB(B0, 1, 0); PG8_SCHED; PG8_LDA(At, 1, 0); PG8_STAGE(PG8_SA(0, 1), a2 + hstep, voffA);
            PG8_WAIT_L(8); PG8_BAR; PG8_WAIT_L(0); PG8_MMA(0, 0, At, B0); PG8_BAR; PG8_SCHED;
            PG8_LDB(B1, 1, 1); PG8_STAGE(PG8_SB(1, 0), b3, voffB);
            PG8_BAR; PG8_WAIT_L(0); PG8_MMA(0, 1, At, B1); PG8_BAR;
            PG8_LDA(At, 1, 1); PG8_STAGE(PG8_SA(1, 0), a3, voffA);
            PG8_BAR; PG8_WAIT_L(0); PG8_MMA(1, 0, At, B0); PG8_BAR; PG8_SCHED;
            PG8_STAGE(PG8_SB(1, 1), b3 + hstep, voffB);
            PG8_WAIT_V(6); PG8_BAR; PG8_MMA(1, 1, At, B1); PG8_BAR;
        }
        E(acc, cur, wr, wc, fr, fq); S.done(cur);
        if (!has_next) break;
#pragma unroll
        for (int a = 0; a < 2; ++a)
#pragma unroll
            for (int b = 0; b < 2; ++b)
#pragma unroll
                for (int m = 0; m < 4; ++m)
#pragma unroll
                    for (int n = 0; n < 2; ++n) acc[a][b][m][n] = (f32x4){0.f, 0.f, 0.f, 0.f};
        cur = nxt; cA = nA; cB = nB; ++ui;
    }
    PG8_WAIT_V(0);
    if (wr == 0) PG8_BAR;
    PG8_BAR;
#undef PG8_SA
#undef PG8_SB
#undef PG8_STAGE
#undef PG8_LDA
#undef PG8_LDB
#undef PG8_MMA
#undef PG8_WAIT_V
#undef PG8_WAIT_L
#undef PG8_BAR
#undef PG8_SCHED
}
}

namespace att {
constexpr int D = 128;
constexpr float THR = 8.f;
constexpr bool WSKIP = false;
constexpr float SCALE = 0.08838834764831845f;
constexpr int NW = 8, QBLK = 32, KVBLK = 64, QB = NW * QBLK;
constexpr int SHM_V = KVBLK * D * 2, SHM_K = KVBLK * D * 2;
constexpr int LDS_BYTES = 2 * SHM_V + 2 * SHM_K + NW * 64 * 4;
using bf16 = __hip_bfloat16;
template <class A, class Bt> struct same_t { static constexpr bool v = false; };
template <class A> struct same_t<A, A> { static constexpr bool v = true; };
#define KSWZ(row, colB) ((row) * 256 + ((colB) ^ (((row) & 7) << 4)))
#define SBAR() __builtin_amdgcn_sched_barrier(0)
__device__ __forceinline__ int v_st(int k, int c) { const int kk = (k & ~0xC) | ((k & 4) << 1) | ((k & 8) >> 1); return ((kk >> 3) * 4 + (c >> 5)) * 512 + ((kk & 7) * 32 + (c & 31)) * 2; }
__device__ __forceinline__ int v_rd_base(int lane) { return ((lane & 3) << 3) | (((lane >> 2) & 3) << 6) | (((lane >> 4) & 1) << 5) | (((lane >> 5) & 1) << 8); }
constexpr int v_rd_off(int d0, int ks, int half) { return d0 * 512 + ks * 4096 + half * 2048; }
__device__ __forceinline__ int crow(int r, int hi) { return (r & 3) + 8 * (r >> 2) + 4 * hi; }
__device__ __forceinline__ unsigned cvtpk(float lo, float hi) {
    unsigned r; asm volatile("v_cvt_pk_bf16_f32 %0, %1, %2" : "=v"(r) : "v"(lo), "v"(hi)); return r;
}
__device__ __forceinline__ bf16x8 pack8(f32x4 a, f32x4 b) {
    u32x4 w = {cvtpk(a[0], a[1]), cvtpk(a[2], a[3]), cvtpk(b[0], b[1]), cvtpk(b[2], b[3])};
    return *reinterpret_cast<bf16x8*>(&w);
}
template <class T> __device__ __forceinline__ bf16x8 load8(const T* p) {
    if constexpr (same_t<T, float>::v) { return pack8(*(const f32x4*)p, *(const f32x4*)(p + 4)); }
    else { return *reinterpret_cast<const bf16x8*>(p); }
}
__device__ __forceinline__ void mask_tile(f32x16& p0, f32x16& p1, int dq, unsigned W) {
    const float NEG = -__builtin_inff();
#pragma unroll
    for (int r = 0; r < 16; ++r) {
        const int c = (r & 3) + 8 * (r >> 2);
        if ((unsigned)(dq - c) >= W) p0[r] = NEG;
        if ((unsigned)(dq - c - 32) >= W) p1[r] = NEG;
    }
}
__device__ __forceinline__ void partialSM(f32x16& p0, f32x16& p1, float& m_reg, float& mn, float& alpha) {
    float pmax = p0[0]; for (int r = 1; r < 16; ++r) pmax = fmaxf(pmax, p0[r]); for (int r = 0; r < 16; ++r) pmax = fmaxf(pmax, p1[r]);
    { auto rr = __builtin_amdgcn_permlane32_swap(__float_as_uint(pmax), __float_as_uint(pmax), false, false);
      pmax = fmaxf(__uint_as_float(rr[0]), __uint_as_float(rr[1])); }
    constexpr float C2 = 1.4426950408889634f * SCALE;
    if (__builtin_expect(__all((pmax - m_reg) * SCALE <= THR), 1)) { mn = m_reg; alpha = 1.f; }
    else { mn = fmaxf(m_reg, pmax); alpha = __builtin_amdgcn_exp2f((m_reg - mn) * C2); m_reg = mn; }
    const float mnL = -mn * C2;
    for (int r = 0; r < 16; ++r) p0[r] = fmaf(p0[r], C2, mnL); for (int r = 0; r < 16; ++r) p1[r] = fmaf(p1[r], C2, mnL);
    for (int r = 0; r < 16; ++r) p0[r] = __builtin_amdgcn_exp2f(p0[r]);
}
__device__ __forceinline__ void finishSM(f32x16& p0, f32x16& p1, float alpha, float& l_reg, bf16x8& pa0, bf16x8& pa1, bf16x8& pa2, bf16x8& pa3) {
    for (int r = 0; r < 16; ++r) p1[r] = __builtin_amdgcn_exp2f(p1[r]);
    float ps = 0; for (int r = 0; r < 16; ++r) ps += p0[r]; for (int r = 0; r < 16; ++r) ps += p1[r];
    { auto rr = __builtin_amdgcn_permlane32_swap(__float_as_uint(ps), __float_as_uint(ps), false, false);
      ps = __uint_as_float(rr[0]) + __uint_as_float(rr[1]); }
    l_reg = l_reg * alpha + ps;
#define PK4(P, B_, OUT) do { unsigned a0 = cvtpk(P[B_+0], P[B_+1]), a1 = cvtpk(P[B_+2], P[B_+3]);                          \
        unsigned b0 = cvtpk(P[B_+4], P[B_+5]), b1 = cvtpk(P[B_+6], P[B_+7]);                                             \
        auto r0 = __builtin_amdgcn_permlane32_swap(a0, b0, false, false); auto r1 = __builtin_amdgcn_permlane32_swap(a1, b1, false, false); \
        u32x4 w = {r0[0], r1[0], r0[1], r1[1]}; OUT = *reinterpret_cast<bf16x8*>(&w); } while (0)
    PK4(p0, 0, pa0); PK4(p0, 8, pa1); PK4(p1, 0, pa2); PK4(p1, 8, pa3);
#undef PK4
}
template <int KB, bool SK>
__device__ __forceinline__ void qkt(f32x16& p0, f32x16& p1, const char* K_lds, int r32, int hi, const bf16x8* qr, bool act) {
    if (SK && !act) { const float NEG = -__builtin_inff();
#pragma unroll
        for (int r = 0; r < 16; ++r) { p0[r] = NEG; p1[r] = NEG; } return; }
    p0 = f32x16{}; p1 = f32x16{};
    const char* kb[4];
#pragma unroll
    for (int dd = 0; dd < 4; ++dd) kb[dd] = K_lds + KB * SHM_K + KSWZ(r32, (dd * 16 + hi * 8) * 2);
#pragma unroll
    for (int d0 = 0; d0 < 8; ++d0) { const char* a = kb[d0 & 3] + (d0 >> 2) * 128;
        bf16x8 b0 = *reinterpret_cast<const bf16x8*>(a);
        bf16x8 b1 = *reinterpret_cast<const bf16x8*>(a + 32 * 256);
        p0 = __builtin_amdgcn_mfma_f32_32x32x16_bf16(b0, qr[d0], p0, 0, 0, 0);
        p1 = __builtin_amdgcn_mfma_f32_32x32x16_bf16(b1, qr[d0], p1, 0, 0, 0); }
}
template <int VB, bool SK>
__device__ __forceinline__ void pv_tile(f32x16* o, int vb0, bf16x8 pa0, bf16x8 pa1, bf16x8 pa2, bf16x8 pa3, bool act) {
    if (SK && !act) return;
#define TRRD(dst, off) asm volatile("ds_read_b64_tr_b16 %0, %1 offset:%2" : "=&v"(dst) : "v"(vb0), "i"(off) : "memory")
#define PV_D0(d0) do { s16x4 l0, l1, l2, l3, h0, h1, h2, h3; constexpr int b_ = VB * SHM_V + v_rd_off(d0, 0, 0);     \
        TRRD(l0, b_); TRRD(h0, b_ + 2048); TRRD(l1, b_ + 4096); TRRD(h1, b_ + 6144); TRRD(l2, b_ + 8192); TRRD(h2, b_ + 10240); TRRD(l3, b_ + 12288); TRRD(h3, b_ + 14336); \
        asm volatile("s_waitcnt lgkmcnt(0)" ::: "memory"); SBAR();                 \
        o[d0] = __builtin_amdgcn_mfma_f32_32x32x16_bf16(pa0, (bf16x8){l0[0], l0[1], l0[2], l0[3], h0[0], h0[1], h0[2], h0[3]}, o[d0], 0, 0, 0);   \
        o[d0] = __builtin_amdgcn_mfma_f32_32x32x16_bf16(pa1, (bf16x8){l1[0], l1[1], l1[2], l1[3], h1[0], h1[1], h1[2], h1[3]}, o[d0], 0, 0, 0);   \
        o[d0] = __builtin_amdgcn_mfma_f32_32x32x16_bf16(pa2, (bf16x8){l2[0], l2[1], l2[2], l2[3], h2[0], h2[1], h2[2], h2[3]}, o[d0], 0, 0, 0);   \
        o[d0] = __builtin_amdgcn_mfma_f32_32x32x16_bf16(pa3, (bf16x8){l3[0], l3[1], l3[2], l3[3], h3[0], h3[1], h3[2], h3[3]}, o[d0], 0, 0, 0); } while (0)
    PV_D0(0); PV_D0(1); PV_D0(2); PV_D0(3);
#undef PV_D0
#undef TRRD
}

template <class TIn, class TOut> struct BlockRef { const TIn* Q; const TIn* K; const TIn* V; TOut* O; int P0; };
template <class TIn> struct Seam {
    bf16x8 qr[8];
    bf16x8 st_v0, st_v1, st_k0, st_k1; f32x4 sf0, sf1, sf2, sf3;
    f32x4 tq[16];
};
__device__ __forceinline__ int swa_jlo(int P0, int W) { const int lowk = P0 - W + 1; return lowk > 0 ? lowk / KVBLK : 0; }
#define ROW(p, k0, rr) ((p) + (size_t)((k0) + (rr)) * D + sc)
#define VMW() asm volatile("s_waitcnt vmcnt(0)" ::: "memory")
#define VMWN(n) asm volatile("s_waitcnt vmcnt(%0)" :: "i"(n) : "memory")
#define SLOAD_H(Kp, Vp, k0) do { S.st_v0 = load8<TIn>(ROW(Vp, k0, sr)); S.st_v1 = load8<TIn>(ROW(Vp, k0, 32 + sr));              \
                         S.st_k0 = load8<TIn>(ROW(Kp, k0, sr)); S.st_k1 = load8<TIn>(ROW(Kp, k0, 32 + sr)); } while (0)
#define SWRITE_HK(bf) do { *(bf16x8*)(K_lds + (bf) * SHM_K + kws) = S.st_k0; *(bf16x8*)(K_lds + (bf) * SHM_K + kws + 32 * 256) = S.st_k1; } while (0)
#define SWRITE_HV(bf) do { *(bf16x8*)(V_lds + (bf) * SHM_V + vst0) = S.st_v0; *(bf16x8*)(V_lds + (bf) * SHM_V + vst1) = S.st_v1; } while (0)
#define SWRITE_H(bf) do { SWRITE_HV(bf); SWRITE_HK(bf); } while (0)
#define SLOAD_F(p, k0) do { S.sf0 = *(const f32x4*)ROW(p, k0, sr); S.sf1 = *(const f32x4*)(ROW(p, k0, sr) + 4);                \
                            S.sf2 = *(const f32x4*)ROW(p, k0, 32 + sr); S.sf3 = *(const f32x4*)(ROW(p, k0, 32 + sr) + 4); } while (0)
#define SWRITE_KF(bf) do { *(bf16x8*)(K_lds + (bf) * SHM_K + kws) = pack8(S.sf0, S.sf1); *(bf16x8*)(K_lds + (bf) * SHM_K + kws + 32 * 256) = pack8(S.sf2, S.sf3); } while (0)
#define SWRITE_VF(bf) do { *(bf16x8*)(V_lds + (bf) * SHM_V + vst0) = pack8(S.sf0, S.sf1); *(bf16x8*)(V_lds + (bf) * SHM_V + vst1) = pack8(S.sf2, S.sf3); } while (0)
template <class TIn, class TOut>
__device__ __forceinline__ void causal_swa_prime(const BlockRef<TIn, TOut>& cur, int W, char* lds, Seam<TIn>& S, const int wv) {
    constexpr bool F32 = same_t<TIn, float>::v;
    const int tid = ltid(wv), wid = __builtin_amdgcn_readfirstlane(tid >> 6), lane = tid & 63, r32 = lane & 31, hi = lane >> 5;
    const int sr = tid >> 4, sc = (tid & 15) * 8, kws = KSWZ(sr, sc * 2); char* K_lds = lds + 2 * SHM_V;
    const int kb0 = swa_jlo(cur.P0, W) * KVBLK;
    for (int d0 = 0; d0 < 8; ++d0) S.qr[d0] = load8<TIn>(cur.Q + (size_t)(wid * QBLK + r32) * D + d0 * 16 + hi * 8);
    if constexpr (F32) { SLOAD_F((const float*)cur.K, kb0); VMW(); SWRITE_KF(0); SBAR(); SLOAD_F((const float*)cur.V, kb0); }
    else { SLOAD_H(cur.K, cur.V, kb0); VMW(); SWRITE_HK(0); }
    __syncthreads();
}
template <class TIn, class TOut>
__device__ __forceinline__ void causal_swa_block(const BlockRef<TIn, TOut>& cur, const BlockRef<TIn, TOut>& nxt, int skv, int W, char* lds, Seam<TIn>& S, const int wv) {
    constexpr bool F32 = same_t<TIn, float>::v;
    const int tid = ltid(wv), wid = __builtin_amdgcn_readfirstlane(tid >> 6), lane = tid & 63, r32 = lane & 31, hi = lane >> 5;
    const int j_lo = swa_jlo(cur.P0, W);
    int j_hi = (cur.P0 + QB - 1) / KVBLK + 1; if (j_hi > skv / KVBLK) j_hi = skv / KVBLK;
    const int NT = j_hi - j_lo;
    const int kbn = swa_jlo(nxt.P0, W) * KVBLK;
    const int qlo = cur.P0 + wid * QBLK, qm = qlo + r32 - 4 * hi;
    char* V_lds = lds; char* K_lds = lds + 2 * SHM_V;
    float* ws = (float*)(lds + 2 * SHM_V + 2 * SHM_K) + wid * 64; float* li_l = ws, * al_l = ws + 32;
    float m_reg = -1e30f, l_reg = 0; f32x16 o[4] = {};
    const int sr = tid >> 4, sc = (tid & 15) * 8, vst0 = v_st(sr, sc), vst1 = v_st(32 + sr, sc), kws = KSWZ(sr, sc * 2);
    const int vb0 = (int)(uintptr_t)V_lds + v_rd_base(lane);
    const TIn* Kh = cur.K; const TIn* Vh = cur.V;
#define RESC(a) do { if (__any((a) < 1.f)) { if (hi == 0) al_l[r32] = (a); asm volatile("s_waitcnt lgkmcnt(0)" ::: "memory");              \
                     for (int d_ = 0; d_ < 4; ++d_) for (int r = 0; r < 16; ++r) o[d_][r] *= al_l[crow(r, hi)]; } } while (0)
#define KBASE(t) ((j_lo + (t)) * KVBLK)
#define ACT(t) (KBASE(t) <= qlo + QBLK - 1 && KBASE(t) + KVBLK - 1 >= qlo - W + 1)
#define MASKT(P0_, P1_, t) do { const int kb_ = KBASE(t); if ((!SK || ACT(t)) && (kb_ + KVBLK - 1 > qlo || kb_ <= qlo + QBLK - 1 - W)) mask_tile(P0_, P1_, qm - kb_, (unsigned)W); } while (0)
    constexpr int NQL = F32 ? 16 : 8;
    constexpr bool SK = WSKIP && !F32;
#define SEAM_K0() do { VMWN(NQL); if constexpr (F32) { SWRITE_KF(0); SBAR(); SLOAD_F((const float*)nxt.V, kbn); } else { SWRITE_HK(0); } SBAR(); } while (0)
    f32x16 pA0, pA1, pB0, pB1; float mnA, mnB, alA, alB; bf16x8 pa0, pa1, pa2, pa3;
    if constexpr (F32) { VMW(); SWRITE_VF(0); SBAR(); } else { SWRITE_HV(0); SBAR(); }
    if (NT > 1) { if constexpr (F32) SLOAD_F((const float*)Kh, KBASE(1)); else SLOAD_H(Kh, Vh, KBASE(1)); }
    SBAR(); qkt<0, SK>(pA0, pA1, K_lds, r32, hi, S.qr, ACT(0));
    if constexpr (F32) { if (NT > 1) { VMW(); SWRITE_KF(1); SBAR(); SLOAD_F((const float*)Vh, KBASE(1)); } }
    MASKT(pA0, pA1, 0); partialSM(pA0, pA1, m_reg, mnA, alA);
    if (NT > 1) { VMW(); if constexpr (F32) { SWRITE_VF(1); SBAR(); if (NT > 2) SLOAD_F((const float*)Kh, KBASE(2)); } else SWRITE_H(1); }
    __syncthreads();
#define HALF_STEP(PX0, PX1, mnX, alX, PY0, PY1, alY, t, KB, VB, SB) do {                                                      \
        SBAR(); qkt<KB, SK>(PX0, PX1, K_lds, r32, hi, S.qr, ACT(t));                                             \
        finishSM(PY0, PY1, alY, l_reg, pa0, pa1, pa2, pa3); SBAR();                                                           \
        if ((t) + 1 < NT) { if constexpr (F32) { VMW(); SWRITE_KF(SB); SBAR(); SLOAD_F((const float*)Vh, KBASE((t) + 1)); }  \
                            else { SLOAD_H(Kh, Vh, KBASE((t) + 1)); } SBAR(); }                                               \
        pv_tile<VB, SK>(o, vb0, pa0, pa1, pa2, pa3, ACT((t) - 1)); MASKT(PX0, PX1, (t)); partialSM(PX0, PX1, m_reg, mnX, alX);                                        \
        __syncthreads();                                                                                                      \
        if ((t) + 1 < NT) { VMW(); if constexpr (F32) { SWRITE_VF(SB); SBAR(); if ((t) + 2 < NT) SLOAD_F((const float*)Kh, KBASE((t) + 2)); } \
                            else { SWRITE_H(SB); } }                                                                          \
        RESC(alX); __syncthreads(); } while (0)
    for (int t = 1; t + 1 < NT; t += 2) {
        HALF_STEP(pB0, pB1, mnB, alB, pA0, pA1, alA, t, 1, 0, 0);
        HALF_STEP(pA0, pA1, mnA, alA, pB0, pB1, alB, t + 1, 0, 1, 1);
    }
    const bool even = (NT & 1) == 0;
    if (even) { SBAR(); qkt<1, SK>(pB0, pB1, K_lds, r32, hi, S.qr, ACT(NT - 1)); SBAR(); }
#define QROW(e) (nxt.Q + (size_t)(wid * QBLK + r32) * D + ((e) >> 1) * 16 + hi * 8 + ((e) & 1) * 4)
    if constexpr (F32) { SLOAD_F((const float*)nxt.K, kbn); SBAR();
#pragma unroll
        for (int e = 0; e < 8; ++e) S.tq[e] = *(const f32x4*)QROW(e); }
    else { SLOAD_H(nxt.K, nxt.V, kbn); SBAR();
#pragma unroll
        for (int d0 = 0; d0 < 8; ++d0) S.qr[d0] = load8<TIn>(nxt.Q + (size_t)(wid * QBLK + r32) * D + d0 * 16 + hi * 8); }
    SBAR();
    finishSM(pA0, pA1, alA, l_reg, pa0, pa1, pa2, pa3); SBAR();
    if constexpr (F32) {
#pragma unroll
        for (int e = 8; e < 16; ++e) S.tq[e] = *(const f32x4*)QROW(e); SBAR(); }
#undef QROW
    pv_tile<0, SK>(o, vb0, pa0, pa1, pa2, pa3, ACT(even ? NT - 2 : NT - 1));
    if (even) { MASKT(pB0, pB1, NT - 1); partialSM(pB0, pB1, m_reg, mnB, alB); __syncthreads(); RESC(alB);
        finishSM(pB0, pB1, alB, l_reg, pa0, pa1, pa2, pa3); SBAR(); pv_tile<1, SK>(o, vb0, pa0, pa1, pa2, pa3, ACT(NT - 1)); }
    SBAR(); SEAM_K0();
    if (hi == 0) li_l[r32] = l_reg; asm volatile("s_waitcnt lgkmcnt(0)" ::: "memory");
    float rli[16];
#pragma unroll
    for (int r = 0; r < 16; ++r) rli[r] = __builtin_amdgcn_rcpf(li_l[crow(r, hi)]);
    TOut* Ow = cur.O + (size_t)(wid * QBLK) * D;
#pragma unroll
    for (int r = 0; r < 16; ++r) { const int orow = crow(r, hi);
#pragma unroll
        for (int d0 = 0; d0 < 4; ++d0) { const float v = o[d0][r] * rli[r];
            if constexpr (same_t<TOut, float>::v) { Ow[(size_t)orow * D + d0 * 32 + r32] = v; }
            else { const float vn = sw_xor<1>(v);
                   if ((r32 & 1) == 0) *(unsigned*)(Ow + (size_t)orow * D + d0 * 32 + r32) = cvtpk(v, vn); } } }
    if constexpr (F32) {
#pragma unroll
        for (int d0 = 0; d0 < 8; ++d0) S.qr[d0] = pack8(S.tq[2 * d0], S.tq[2 * d0 + 1]); }
    __syncthreads();
#undef RESC
#undef KBASE
#undef ACT
#undef MASKT
#undef SEAM_K0
#undef HALF_STEP
}
#undef ROW
#undef VMW
#undef VMWN
#undef SLOAD_H
#undef SWRITE_HK
#undef SWRITE_HV
#undef SWRITE_H
#undef SLOAD_F
#undef SWRITE_KF
#undef SWRITE_VF
#undef KSWZ
#undef SBAR
}

#define MFMA16(a, b, c) __builtin_amdgcn_mfma_f32_16x16x32_bf16((a), (b), (c), 0, 0, 0)
#define MFMA32(a, b, c) __builtin_amdgcn_mfma_f32_32x32x16_bf16((a), (b), (c), 0, 0, 0)
#define WSP(T_, off) ((T_*)(p->ws + (off)))

DI void sincos_red(double r, float& s, float& c) {
    const double r2 = r * r; double sp = 1.0, cp = 1.0;
#pragma unroll
    for (int k = 13; k >= 1; --k) { sp = 1.0 - sp * r2 * (1.0 / (double)((2 * k) * (2 * k + 1))); cp = 1.0 - cp * r2 * (1.0 / (double)((2 * k - 1) * (2 * k))); }
    s = (float)(r * sp); c = (float)cp;
}

DI void cvt_wt_job(const float* src, bf16_t* dst, int N, int Npad, int nperm, float* tile, const int wv) {
    const int tid = ltid(wv), K = 2048, ntn = Npad / 64, ntiles = ntn * (K / 64), c = tid & 63, r0 = tid >> 6;
#define CW_LOAD(V, tl_) do { const int tn_ = (tl_) % ntn, tk_ = (tl_) / ntn, k0_ = tk_ * 64, n_ = tn_ * 64 + c; int ns_ = n_; \
        if (ns_ < nperm) { const int p7 = ns_ & 127, u = p7 >> 3, e = p7 & 7; ns_ = (ns_ & ~127) + ((e < 4) ? 4 * u + e : 64 + 4 * u + (e - 4)); } \
        _Pragma("unroll") for (int i = 0; i < 8; ++i) V[i] = (n_ < N) ? src[(size_t)(k0_ + r0 + 8 * i) * N + ns_] : 0.f; } while (0)
    float cur[8];
    if ((int)blockIdx.x < ntiles) CW_LOAD(cur, (int)blockIdx.x);
    for (int tl = blockIdx.x; tl < ntiles; tl += gridDim.x) {
        const int tn = tl % ntn, tk = tl / ntn, k0 = tk * 64, n0 = tn * 64;
        float nxt[8];
        const int tl2 = (tl + (int)gridDim.x < ntiles) ? tl + (int)gridDim.x : tl;
        CW_LOAD(nxt, tl2);
#pragma unroll
        for (int i = 0; i < 8; ++i) tile[(r0 + 8 * i) * 65 + c] = cur[i];
        lds_barrier();
#pragma unroll
        for (int i = 0; i < 4; ++i) { const int id = tid + 512 * i, rr = id >> 5, cp = id & 31;
            ((unsigned*)dst)[((size_t)(n0 + rr) * K + k0) / 2 + cp] = cvt_pk_bf16(tile[(2 * cp) * 65 + rr], tile[(2 * cp + 1) * 65 + rr]); }
        lds_barrier();
#pragma unroll
        for (int i = 0; i < 8; ++i) cur[i] = nxt[i];
    }
#undef CW_LOAD
}

DI void ph_prologue(PK p, unsigned char* lds, const int wv) {
    PK_FRESH(p);
    const int tid = ltid(wv), lane = tid & 63, wave = __builtin_amdgcn_readfirstlane(tid >> 6);
    float* ldsf = (float*)lds;
    {
        float* sc = ldsf; float* red = ldsf + 4096;
        for (int i = tid; i < 4096; i += 512) sc[i] = silu_f(p->in[1][i]);
        __syncthreads();
        float* mod = WSP(float, WS_MOD);
        for (int item = blockIdx.x; item < MODC / 64; item += gridDim.x) {
            const int col0 = item * 64, col = col0 + lane;
            const float* W; size_t stride;
            if (col0 < 4 * 12288) { const int l = col0 / 12288, j = col - l * 12288; W = p->in[3] + (size_t)l * 2048 * 12288 + j; stride = 12288; }
            else { W = p->in[14] + (col - 4 * 12288); stride = 4096; }
            float a0 = 0.f, a1 = 0.f;
            const int kb = wave * 256;
            float wa[16], wb[16];
#pragma unroll
            for (int u = 0; u < 16; ++u) wa[u] = W[(size_t)(kb + u) * stride];
            for (int k = 0; k < 256; k += 32) {
#pragma unroll
                for (int u = 0; u < 16; ++u) wb[u] = W[(size_t)(kb + k + 16 + u) * stride];
#pragma unroll
                for (int u = 0; u < 16; ++u) { a0 += sc[kb + k + u] * wa[u]; a1 += sc[2048 + kb + k + u] * wa[u]; }
                const int kn = (k + 32 < 256) ? k + 32 : k;
#pragma unroll
                for (int u = 0; u < 16; ++u) wa[u] = W[(size_t)(kb + kn + u) * stride];
#pragma unroll
                for (int u = 0; u < 16; ++u) { a0 += sc[kb + k + 16 + u] * wb[u]; a1 += sc[2048 + kb + k + 16 + u] * wb[u]; }
            }
            red[(wave * 64 + lane) * 2 + 0] = a0; red[(wave * 64 + lane) * 2 + 1] = a1;
            __syncthreads();
            if (tid < 128) { const int ln = tid & 63, b = tid >> 6; float s = 0.f;
#pragma unroll
                for (int w = 0; w < 8; ++w) s += red[(w * 64 + ln) * 2 + b];
                const int cc = col0 + ln; const float bias = (cc < 4 * 12288) ? p->in[4][cc] : p->in[15][cc - 4 * 12288];
                mod[(size_t)b * MODC + cc] = s + bias; }
            __syncthreads();
        }
    }
    for (int job = 0; job < 9; ++job) {
        const float* src; bf16_t* dst; int N = 2048, Npad = 2048, nperm = 0;
        if (job < 2) { src = p->in[7] + (size_t)job * 2048 * GIN; dst = WSP(bf16_t, WS_WIN) + (size_t)job * GINP * 2048; N = GIN; Npad = GINP; }
        else if (job < 4) { src = p->in[12] + (size_t)(job - 2) * 2048 * 2048; dst = WSP(bf16_t, WS_WOUT) + (size_t)(job - 2) * 2048 * 2048; }
        else if (job == 4) { src = p->in[16]; dst = WSP(bf16_t, WS_KVW); N = 4096; Npad = 4096; nperm = 2048; }
        else if (job < 7) { src = p->in[17] + (size_t)(job - 5) * 2048 * 2048; dst = WSP(bf16_t, WS_DWQ) + (size_t)(job - 5) * 2048 * 2048; nperm = 2048; }
        else { src = p->in[20] + (size_t)(job - 7) * 2048 * 2048; dst = WSP(bf16_t, WS_DWO) + (size_t)(job - 7) * 2048 * 2048; }
        cvt_wt_job(src, dst, N, Npad, nperm, ldsf, wv);
    }
    {
        const int lane = tid & 63, r16 = lane & 15, quad = lane >> 4;
        bf16_t* wdst = WSP(bf16_t, WS_PWQ);
        for (int task = (blockIdx.x * 8 + wave); task < 4 * 16 * 128; task += gridDim.x * 8) {
            const int kt = task & 127, pj = (task >> 7) & 15, l = task >> 11, pp = pj >> 1, jh = pj & 1;
            const float* wq = p->in[21] + ((size_t)l * 2048 + kt * 16 + r16) * 2048 + pp * 256 + jh * 128 + quad * 8;
            const float* ky = p->in[22] + ((size_t)(l * 2 + jh) * 128 + r16) * 128 + quad * 8;
            bf16x8 bw[4];
#pragma unroll
            for (int ks = 0; ks < 4; ++ks) { const f32x4 a = *(const f32x4*)(wq + ks * 32), b = *(const f32x4*)(wq + ks * 32 + 4);
                u32x4 w; w.x = cvt_pk_bf16(a[0], a[1]); w.y = cvt_pk_bf16(a[2], a[3]); w.z = cvt_pk_bf16(b[0], b[1]); w.w = cvt_pk_bf16(b[2], b[3]); bw[ks] = __builtin_bit_cast(bf16x8, w); }
#pragma unroll
            for (int nt = 0; nt < 8; ++nt) { f32x4 acc = {0.f, 0.f, 0.f, 0.f};
#pragma unroll
                for (int ks = 0; ks < 4; ++ks) { const f32x4 a = *(const f32x4*)(ky + (size_t)nt * 16 * 128 + ks * 32), b = *(const f32x4*)(ky + (size_t)nt * 16 * 128 + ks * 32 + 4);
                    u32x4 w; w.x = cvt_pk_bf16(a[0], a[1]); w.y = cvt_pk_bf16(a[2], a[3]); w.z = cvt_pk_bf16(b[0], b[1]); w.w = cvt_pk_bf16(b[2], b[3]);
                    acc = MFMA16(bw[ks], __builtin_bit_cast(bf16x8, w), acc); }
                u32x2 wo; wo.x = cvt_pk_bf16(acc[0], acc[1]); wo.y = cvt_pk_bf16(acc[2], acc[3]);
                *(u32x2*)(wdst + ((size_t)l * 2048 + pp * 256 + jh * 128 + nt * 16 + r16) * 2048 + kt * 16 + quad * 4) = wo; }
        }
    }
    {
        float* cosT = WSP(float, WS_COS); float* sinT = WSP(float, WS_SIN); const int* pos = (const int*)p->in[2];
        for (int idx = blockIdx.x * 512 + tid; idx < T * 64; idx += gridDim.x * 512) {
            const int t = idx >> 6, j = idx & 63;
            const double inv = exp(-(double)j * (9.210340371976184 / 64.0));
            const double ang = (double)pos[t] * inv;
            const double n = rint(ang * 0.15915494309189535);
            double r = fma(-n, 6.283185307179586, ang); r = fma(-n, 2.4492935982947064e-16, r);
            float s, c; sincos_red(r, s, c); cosT[idx] = c; sinT[idx] = s;
        }
    }
}

template <int MODE>
DI void ph_norm(const float* x, const bf16_t* xb, const float* g, const float* shift, const float* scale, bf16_t* dstb, float* dstf, const int wv) {
    const int tid = ltid(wv), lane = tid & 63, wave = __builtin_amdgcn_readfirstlane(tid >> 6);
    for (int row = blockIdx.x * 8 + wave; row < T; row += gridDim.x * 8) {
        const int b = row >> 13;
        f32x4 v[8]; float ss = 0.f;
#pragma unroll
        for (int i = 0; i < 8; ++i) {
            if (MODE == 2) { const u32x2 w = *(const u32x2*)(xb + (size_t)row * D + i * 256 + lane * 4); v[i] = (f32x4){bflo(w.x), bfhi(w.x), bflo(w.y), bfhi(w.y)}; }
            else v[i] = *(const f32x4*)(x + (size_t)row * D + i * 256 + lane * 4);
            ss += v[i][0] * v[i][0] + v[i][1] * v[i][1] + v[i][2] * v[i][2] + v[i][3] * v[i][3]; }
        ss = wave_sum(ss);
        const float r = rsqrtf(ss * (1.f / D) + NORM_EPS);
#pragma unroll
        for (int i = 0; i < 8; ++i) { const int col = i * 256 + lane * 4; const f32x4 gv = *(const f32x4*)(g + col);
            if (MODE != 1) { const f32x4 sh = *(const f32x4*)(shift + (size_t)b * MODC + col), sc = *(const f32x4*)(scale + (size_t)b * MODC + col);
                f32x4 y;
#pragma unroll
                for (int e = 0; e < 4; ++e) y[e] = v[i][e] * r * gv[e] * (1.f + sc[e]) + sh[e];
                u32x2 w; w.x = cvt_pk_bf16(y[0], y[1]); w.y = cvt_pk_bf16(y[2], y[3]); *(u32x2*)(dstb + (size_t)row * D + col) = w; }
            else { f32x4 y;
#pragma unroll
                for (int e = 0; e < 4; ++e) y[e] = v[i][e] * r * gv[e];
                *(f32x4*)(dstf + (size_t)row * D + col) = y; } }
    }
}

DI void pc_load(PK p, int l, int row, f32x4 (&v)[8], const int lane) {
    const float* s = ((row >= 16384) ? p->in[24] : p->in[23]) + ((size_t)l * 16384 + (row & 16383)) * 2048;
#pragma unroll
    for (int i = 0; i < 8; ++i) v[i] = *(const f32x4*)(s + lane * 32 + i * 4);
}
DI void pc_store(PK p, int row, const f32x4 (&v)[8], const int lane) {
    const bool second = row >= 16384; const int r = row & 16383;
    unsigned char* dq = WSP(unsigned char, second ? WS_PV : WS_PU); unsigned short* ds = WSP(unsigned short, WS_PUS);
    float m0 = 0.f;
#pragma unroll
    for (int i = 0; i < 8; ++i) { const float mm = fmaxf(fmaxf(fabsf(v[i][0]), fabsf(v[i][1])), fmaxf(fabsf(v[i][2]), fabsf(v[i][3]))); m0 = fmaxf(m0, mm); }
    m0 = fmaxf(m0, sw_xor<1>(m0)); m0 = fmaxf(m0, sw_xor<2>(m0)); m0 = fmaxf(m0, dpp_full<0x141>(m0)); m0 = fmaxf(m0, dpp_full<0x140>(m0));
    const bf16_t sb0 = (m0 > 0.f) ? f2bf(m0 * (1.004f / 6.f)) : (bf16_t)0x3f80;
    const float inv = 1.f / bf2f(sb0);
    u32x4 w;
#pragma unroll
    for (int c = 0; c < 4; ++c) { unsigned x = 0u;
        x = __builtin_amdgcn_cvt_scalef32_pk_fp4_f32(x, v[2 * c][0] * inv, v[2 * c][1] * inv, 1.0f, 0);
        x = __builtin_amdgcn_cvt_scalef32_pk_fp4_f32(x, v[2 * c][2] * inv, v[2 * c][3] * inv, 1.0f, 1);
        x = __builtin_amdgcn_cvt_scalef32_pk_fp4_f32(x, v[2 * c + 1][0] * inv, v[2 * c + 1][1] * inv, 1.0f, 2);
        x = __builtin_amdgcn_cvt_scalef32_pk_fp4_f32(x, v[2 * c + 1][2] * inv, v[2 * c + 1][3] * inv, 1.0f, 3);
        w[c] = x; }
    *(u32x4*)(dq + (size_t)r * 1024 + lane * 16) = w;
    if ((lane & 15) == 0) ds[((size_t)r * 4 + (lane >> 4)) * 2 + (second ? 1 : 0)] = (unsigned short)sb0;
}
DI void ph_peer_cvt(PK p, int l, const int wv) {
    PK_FRESH(p);
    const int tid = ltid(wv), lane = tid & 63, wave = __builtin_amdgcn_readfirstlane(tid >> 6);
    for (int row = blockIdx.x * 8 + wave; row < 2 * 16384; row += gridDim.x * 8) { f32x4 v[8]; pc_load(p, l, row, v, lane); pc_store(p, row, v, lane); }
}


template <int I, int J>
DI void tinv_block(const bf16_t* Lb, bf16_t* Ti, bf16_t* TT, bf16_t* XT, const int r16, const int quad) {
    constexpr int nK = 16 * (I - J);
    const bf16x8 zero8 = {0, 0, 0, 0, 0, 0, 0, 0};
    f32x4 acc = {0.f, 0.f, 0.f, 0.f};
#pragma unroll
    for (int ks = 0; ks < (nK + 31) / 32; ++ks) {
        const int k0 = ks * 32 + quad * 8; const bool valid = k0 < nK;
        const bf16x8 a = valid ? *(const bf16x8*)(Lb + (16 * I + r16) * 72 + 16 * J + k0) : zero8;
        const bf16x8 b = valid ? *(const bf16x8*)(TT + (16 * J + r16) * 72 + 16 * J + k0) : zero8;
        acc = MFMA16(a, b, acc);
    }
    { u32x2 w; w.x = cvt_pk_bf16(acc[0], acc[1]); w.y = cvt_pk_bf16(acc[2], acc[3]); *(u32x2*)(XT + r16 * 24 + quad * 4) = w; }
    asm volatile("s_waitcnt lgkmcnt(0)" ::: "memory");
    const bool v2 = quad < 2;
    const bf16x8 a2 = v2 ? *(const bf16x8*)(Ti + (16 * I + r16) * 72 + 16 * I + quad * 8) : zero8;
    const bf16x8 b2 = v2 ? *(const bf16x8*)(XT + r16 * 24 + quad * 8) : zero8;
    f32x4 m = {0.f, 0.f, 0.f, 0.f};
    m = MFMA16(a2, b2, m);
#pragma unroll
    for (int r = 0; r < 4; ++r) Ti[(16 * I + quad * 4 + r) * 72 + 16 * J + r16] = f2bf(-m[r]);
    { u32x2 w; w.x = cvt_pk_bf16(-m[0], -m[1]); w.y = cvt_pk_bf16(-m[2], -m[3]); *(u32x2*)(TT + (16 * J + r16) * 72 + 16 * I + quad * 4) = w; }
    asm volatile("s_waitcnt lgkmcnt(0)" ::: "memory");
}

DI void ph_gdn_p1(PK p, int l, unsigned char* lds, const int wv) {
    PK_FRESH(p);
    const bf16_t* proj = WSP(const bf16_t, WS_PROJ);
    const float* convw = p->in[8] + (size_t)l * 4 * 6144; const float* alog = p->in[9] + l * 16; const float* dtb = p->in[10] + l * 16;
    bf16_t* Ag = WSP(bf16_t, WS_GA); bf16_t* Bg = WSP(bf16_t, WS_GB); bf16_t* Qg = WSP(bf16_t, WS_GQ); bf16_t* Og = WSP(bf16_t, WS_GO); float* glg = WSP(float, WS_GL);
    bf16_t* qb  = (bf16_t*)(lds + 0);
    bf16_t* kb  = (bf16_t*)(lds + 17408);
    bf16_t* Lb  = (bf16_t*)(lds + 34816);
    bf16_t* wT  = (bf16_t*)(lds + 17408);
    bf16_t* vbT = (bf16_t*)(lds + 44032);
    bf16_t* kdT = (bf16_t*)(lds + 62464);
    bf16_t* kbT = (bf16_t*)(lds + 80896);
    bf16_t* uT  = (bf16_t*)(lds + 80896);
    bf16_t* aqk = (bf16_t*)(lds + 99328);
    bf16_t* Ti  = (bf16_t*)(lds + 108544);
    bf16_t* TT  = (bf16_t*)(lds + 117760);
    float*  Ld  = (float*)(lds + 126976);
    bf16_t* XT  = (bf16_t*)(lds + 132096);
    float*  sc  = (float*)(lds + 133120);
    float*  cw  = (float*)(lds + 134144);
    int cached_bh = -1;
    u32x4 rawp[3][5]; float pa_[4] = {0.f, 0.f, 0.f, 0.f}, pb_[4] = {0.f, 0.f, 0.f, 0.f};
#define P1_PREFETCH(itx) do { const int tid_ = ltid(wv), bh_ = (itx) & 31, n_ = (itx) >> 5, hd_ = bh_ & 15, b_ = bh_ >> 4, c16_ = tid_ & 15, t0_ = (tid_ >> 4) * 2; \
        _Pragma("unroll") for (int part = 0; part < 3; ++part) _Pragma("unroll") for (int r = 0; r < 5; ++r) { const int sp = n_ * 64 + t0_ - 3 + r; u32x4 raw = {0u, 0u, 0u, 0u}; \
            if (sp >= 0) raw = *(const u32x4*)(proj + (size_t)(b_ * SEQ + sp) * GINP + part * 2048 + hd_ * 128 + c16_ * 8); rawp[part][r] = raw; } \
        if (tid_ < 64) { const float* pab = WSP(const float, WS_PAB) + (size_t)(b_ * SEQ + n_ * 64 + tid_) * 32 + hd_; const size_t qs = (size_t)T * 32; \
            _Pragma("unroll") for (int q4 = 0; q4 < 4; ++q4) { pa_[q4] = pab[q4 * qs]; pb_[q4] = pab[q4 * qs + 16]; } } } while (0)
    if ((int)blockIdx.x < 4096) P1_PREFETCH((int)blockIdx.x);
    for (int it = blockIdx.x; it < 4096; it += gridDim.x) {
        const int tid = ltid(wv), lane = tid & 63, wave = __builtin_amdgcn_readfirstlane(tid >> 6), r16 = lane & 15, quad = lane >> 4;
        const int bh = it & 31, n = it >> 5, hd = bh & 15, b = bh >> 4, tok0 = b * SEQ + n * 64, ci = bh * 128 + n;
        if (bh != cached_bh) {
            for (int idx = tid; idx < 1536; idx += 512) { const int part = idx >> 9, tap = (idx >> 7) & 3, c = idx & 127; cw[idx] = convw[tap * 6144 + part * 2048 + hd * 128 + c]; }
            cached_bh = bh;
            lds_barrier();
        }
        float dtbv = 0.f, alogv = 0.f;
        if (tid < 64) { dtbv = dtb[hd]; alogv = alog[hd]; }
        {
            const int c16 = tid & 15, t0 = (tid >> 4) * 2;
#pragma unroll
            for (int part = 0; part < 3; ++part) {
                const int ch = part * 2048 + hd * 128 + c16 * 8;
                float xr[5][8];
#pragma unroll
                for (int r = 0; r < 5; ++r) {
                    const u32x4 raw = rawp[part][r];
                    xr[r][0] = bflo(raw.x); xr[r][1] = bfhi(raw.x); xr[r][2] = bflo(raw.y); xr[r][3] = bfhi(raw.y); xr[r][4] = bflo(raw.z); xr[r][5] = bfhi(raw.z); xr[r][6] = bflo(raw.w); xr[r][7] = bfhi(raw.w);
                }
                float wt[4][8];
#pragma unroll
                for (int tap = 0; tap < 4; ++tap) { const f32x4 w0 = *(const f32x4*)(cw + (part * 4 + tap) * 128 + c16 * 8), w1 = *(const f32x4*)(cw + (part * 4 + tap) * 128 + c16 * 8 + 4);
                    wt[tap][0] = w0[0]; wt[tap][1] = w0[1]; wt[tap][2] = w0[2]; wt[tap][3] = w0[3]; wt[tap][4] = w1[0]; wt[tap][5] = w1[1]; wt[tap][6] = w1[2]; wt[tap][7] = w1[3]; }
                float av[2][8];
#pragma unroll
                for (int u = 0; u < 2; ++u) {
                    float ss = 0.f;
#pragma unroll
                    for (int e = 0; e < 8; ++e) { float a = wt[0][e] * xr[u][e]; a = fmaf(wt[1][e], xr[u + 1][e], a); a = fmaf(wt[2][e], xr[u + 2][e], a); a = fmaf(wt[3][e], xr[u + 3][e], a);
                        a = silu_f(a); av[u][e] = a; ss += a * a; }
                    if (part < 2) {
                        ss = row_sum16(ss);
                        const float r = rsqrtf(ss + NORM_EPS) * (part == 0 ? 0.08838834764831845f : 1.f);
                        u32x4 w; w.x = cvt_pk_bf16(av[u][0] * r, av[u][1] * r); w.y = cvt_pk_bf16(av[u][2] * r, av[u][3] * r); w.z = cvt_pk_bf16(av[u][4] * r, av[u][5] * r); w.w = cvt_pk_bf16(av[u][6] * r, av[u][7] * r);
                        *(u32x4*)((part == 0 ? qb : kb) + (t0 + u) * 136 + c16 * 8) = w;
                    }
                }
                if (part == 2) {
#pragma unroll
                    for (int e = 0; e < 8; ++e) *(unsigned*)(vbT + (c16 * 8 + e) * 72 + t0) = cvt_pk_bf16(av[0][e], av[1][e]);
                }
            }
        }
        if (tid < 64) {
            const int t = tid;
            const float av = (pa_[0] + pa_[1]) + (pa_[2] + pa_[3]), bv = (pb_[0] + pb_[1]) + (pb_[2] + pb_[3]);
            const float xx = av + dtbv;
            const float ex = __expf(xx); const float sp = (xx > 20.f) ? xx : ((xx < -8.f) ? ex * (1.f - 0.5f * ex) : __logf(1.f + ex));
            const float g = -__expf(alogv) * sp;
            const float beta = __builtin_amdgcn_rcpf(1.f + __expf(-bv));
            float G = g;
            G += __int_as_float(__builtin_amdgcn_update_dpp(0, __float_as_int(G), 0x111, 0xF, 0xF, true)); G += __int_as_float(__builtin_amdgcn_update_dpp(0, __float_as_int(G), 0x112, 0xF, 0xF, true));
            G += __int_as_float(__builtin_amdgcn_update_dpp(0, __float_as_int(G), 0x114, 0xF, 0xF, true)); G += __int_as_float(__builtin_amdgcn_update_dpp(0, __float_as_int(G), 0x118, 0xF, 0xF, true));
            G += dpp_mov<0x142, 0xA>(G); G += dpp_mov<0x143, 0xC>(G);
            const float Gl = __int_as_float(__builtin_amdgcn_readlane(__float_as_int(G), 63));
            sc[t] = beta; sc[64 + t] = G; sc[128 + t] = __expf(G); sc[192 + t] = __expf(Gl - G);
            if (t == 63) glg[ci] = __expf(G);
        }
        lds_barrier();
        {
            for (int k = wave; k < 20; k += 8) {
                const unsigned code = (unsigned)(((k < 12) ? (0xd1b25c0ea2a0600ull >> (5 * k)) : (0xfbfcbeab87ull >> (5 * (k - 12)))) & 31ull);
                const int which = (int)(code >> 4), mi = (int)((code >> 2) & 3u), ni = (int)(code & 3u);
                f32x4 acc = {0.f, 0.f, 0.f, 0.f};
                const bf16_t* Ab = (which ? qb : kb) + (mi * 16 + r16) * 136 + quad * 8;
                const bf16_t* Bb = kb + (ni * 16 + r16) * 136 + quad * 8;
#pragma unroll
                for (int ks = 0; ks < 4; ++ks) acc = MFMA16(*(const bf16x8*)(Ab + ks * 32), *(const bf16x8*)(Bb + ks * 32), acc);
                const int cidx = ni * 16 + r16; const float Gc = sc[64 + cidx];
                if (which == 0) {
                    const float bi = sc[cidx]; f32x4 lv;
#pragma unroll
                    for (int r = 0; r < 4; ++r) { const int jj = mi * 16 + quad * 4 + r; lv[r] = (jj < cidx) ? bi * acc[r] * __expf(fminf(Gc - sc[64 + jj], 0.f)) : 0.f; }
                    if (ni == mi) *(f32x4*)(Ld + mi * 320 + r16 * 20 + quad * 4) = lv;
                    else { u32x2 w; w.x = cvt_pk_bf16(lv[0], lv[1]); w.y = cvt_pk_bf16(lv[2], lv[3]); *(u32x2*)(Lb + cidx * 72 + mi * 16 + quad * 4) = w; }
                } else {
#pragma unroll
                    for (int r = 0; r < 4; ++r) { const int ii = mi * 16 + quad * 4 + r; aqk[ii * 72 + cidx] = f2bf((cidx <= ii) ? acc[r] * __expf(fminf(sc[64 + ii] - Gc, 0.f)) : 0.f); }
                }
            }
            if (wave >= 4) {
                for (int z = wave - 4; z < 6; z += 4) { const unsigned zc = (0xb76321u >> (4 * z)) & 15u; const int mi = (int)(zc >> 2), ni = (int)(zc & 3u);
#pragma unroll
                    for (int r = 0; r < 4; ++r) aqk[(mi * 16 + quad * 4 + r) * 72 + ni * 16 + r16] = 0; }
            }
        }
        lds_barrier();
        if (wave != 0) {
            for (int it3 = tid - 64; it3 < 1024; it3 += 448) { const int a = it3 & 127, t0 = (it3 >> 7) * 8; float v[8];
#pragma unroll
                for (int e = 0; e < 8; ++e) v[e] = bf2f(kb[(t0 + e) * 136 + a]);
                u32x4 w; w.x = cvt_pk_bf16(v[0], v[1]); w.y = cvt_pk_bf16(v[2], v[3]); w.z = cvt_pk_bf16(v[4], v[5]); w.w = cvt_pk_bf16(v[6], v[7]);
                *(u32x4*)(kbT + a * 72 + t0) = w;
#pragma unroll
                for (int e = 0; e < 8; ++e) v[e] *= sc[192 + t0 + e];
                w.x = cvt_pk_bf16(v[0], v[1]); w.y = cvt_pk_bf16(v[2], v[3]); w.z = cvt_pk_bf16(v[4], v[5]); w.w = cvt_pk_bf16(v[6], v[7]);
                *(u32x4*)(kdT + a * 72 + t0) = w; }
        }
        if (wave == 0) {
            const float* Lrow = Ld + quad * 320;
            float x[16];
#pragma unroll
            for (int i = 0; i < 16; ++i) { float s = (i == r16) ? 1.f : 0.f;
#pragma unroll
                for (int j = 0; j < i; ++j) s -= Lrow[i * 20 + j] * x[j];
                x[i] = s; }
#pragma unroll
            for (int i = 0; i < 16; ++i) Ti[(16 * quad + i) * 72 + 16 * quad + r16] = f2bf(x[i]);
            { u32x4 w0, w1; w0.x = cvt_pk_bf16(x[0], x[1]); w0.y = cvt_pk_bf16(x[2], x[3]); w0.z = cvt_pk_bf16(x[4], x[5]); w0.w = cvt_pk_bf16(x[6], x[7]);
              w1.x = cvt_pk_bf16(x[8], x[9]); w1.y = cvt_pk_bf16(x[10], x[11]); w1.z = cvt_pk_bf16(x[12], x[13]); w1.w = cvt_pk_bf16(x[14], x[15]);
              *(u32x4*)(TT + (16 * quad + r16) * 72 + 16 * quad) = w0; *(u32x4*)(TT + (16 * quad + r16) * 72 + 16 * quad + 8) = w1; }
            asm volatile("s_waitcnt lgkmcnt(0)" ::: "memory");
            tinv_block<1, 0>(Lb, Ti, TT, XT, r16, quad); tinv_block<2, 1>(Lb, Ti, TT, XT, r16, quad); tinv_block<3, 2>(Lb, Ti, TT, XT, r16, quad);
            tinv_block<2, 0>(Lb, Ti, TT, XT, r16, quad); tinv_block<3, 1>(Lb, Ti, TT, XT, r16, quad);
            tinv_block<3, 0>(Lb, Ti, TT, XT, r16, quad);
        }
        lds_barrier();
        {
            const int i = tid >> 3, t0 = (tid & 7) * 8; const bool low = (t0 >> 4) <= (i >> 4);
            const u32x4 raw = *(const u32x4*)(Ti + i * 72 + t0);
            float v[8] = {bflo(raw.x), bfhi(raw.x), bflo(raw.y), bfhi(raw.y), bflo(raw.z), bfhi(raw.z), bflo(raw.w), bfhi(raw.w)}; float tw[8], tu[8];
#pragma unroll
            for (int e = 0; e < 8; ++e) { const float be = sc[t0 + e]; tu[e] = low ? v[e] * be : 0.f; tw[e] = low ? v[e] * be * sc[128 + t0 + e] : 0.f; }
            u32x4 w; w.x = cvt_pk_bf16(tw[0], tw[1]); w.y = cvt_pk_bf16(tw[2], tw[3]); w.z = cvt_pk_bf16(tw[4], tw[5]); w.w = cvt_pk_bf16(tw[6], tw[7]);
            u32x4 u; u.x = cvt_pk_bf16(tu[0], tu[1]); u.y = cvt_pk_bf16(tu[2], tu[3]); u.z = cvt_pk_bf16(tu[4], tu[5]); u.w = cvt_pk_bf16(tu[6], tu[7]);
            *(u32x4*)(Ti + i * 72 + t0) = w; *(u32x4*)(TT + i * 72 + t0) = u;
        }
        lds_barrier();
#pragma unroll
        for (int pass = 0; pass < 2; ++pass) {
            const bf16_t* Aop = pass ? TT : Ti; const bf16_t* Bop = pass ? vbT : kbT; bf16_t* outT = pass ? uT : wT;
            f32x4 acc4[4];
#pragma unroll
            for (int mi = 0; mi < 4; ++mi) { f32x4 acc = {0.f, 0.f, 0.f, 0.f};
#pragma unroll
                for (int ks = 0; ks < 2; ++ks) acc = MFMA16(*(const bf16x8*)(Aop + (mi * 16 + r16) * 72 + ks * 32 + quad * 8), *(const bf16x8*)(Bop + (wave * 16 + r16) * 72 + ks * 32 + quad * 8), acc);
                acc4[mi] = acc; }
            if (pass == 1) lds_barrier();
#pragma unroll
            for (int mi = 0; mi < 4; ++mi) { u32x2 w; w.x = cvt_pk_bf16(acc4[mi][0], acc4[mi][1]); w.y = cvt_pk_bf16(acc4[mi][2], acc4[mi][3]); *(u32x2*)(outT + (wave * 16 + r16) * 72 + mi * 16 + quad * 4) = w; }
        }
        lds_barrier();
        if (it + (int)gridDim.x < 4096) P1_PREFETCH(it + (int)gridDim.x);
        {
            const int cg = wave & 1, rq = wave >> 1;
            const int nrow = 64 * cg + 16 * (r16 >> 2) + (r16 & 3);
#pragma unroll
            for (int prod = 0; prod < 4; ++prod) {
                if (prod == 1) continue;
                const bf16_t* Yb = (prod == 3) ? uT : wT; const bf16_t* Xb = (prod == 0) ? kdT : aqk;
                bf16x8 yf[4][2];
#pragma unroll
                for (int t = 0; t < 4; ++t)
#pragma unroll
                    for (int ks = 0; ks < 2; ++ks) yf[t][ks] = *(const bf16x8*)(Yb + (nrow + 4 * t) * 72 + quad * 8 + ks * 32);
#pragma unroll
                for (int u = 0; u < ((prod == 0) ? 2 : 1); ++u) {
                    const int mi = (prod == 0) ? rq * 2 + u : rq, m = mi * 16 + r16, n0 = 64 * cg + 16 * quad;
                    const bf16x8 xf0 = *(const bf16x8*)(Xb + m * 72 + quad * 8), xf1 = *(const bf16x8*)(Xb + m * 72 + quad * 8 + 32);
                    f32x4 acc[4];
#pragma unroll
                    for (int t = 0; t < 4; ++t) { acc[t] = (f32x4){0.f, 0.f, 0.f, 0.f}; acc[t] = MFMA16(yf[t][0], xf0, acc[t]); acc[t] = MFMA16(yf[t][1], xf1, acc[t]); }
                    if (prod == 0) {
#pragma unroll
                        for (int t = 0; t < 4; ++t) acc[t] = -acc[t];
                    }
                    if (prod == 2) { const u32x4 q0 = *(const u32x4*)(qb + m * 136 + n0), q1 = *(const u32x4*)(qb + m * 136 + n0 + 8); const float eg = sc[128 + m];
                        const unsigned qw[8] = {q0.x, q0.y, q0.z, q0.w, q1.x, q1.y, q1.z, q1.w};
#pragma unroll
                        for (int t = 0; t < 4; ++t) { acc[t][0] = bflo(qw[2 * t]) * eg - acc[t][0]; acc[t][1] = bfhi(qw[2 * t]) * eg - acc[t][1]; acc[t][2] = bflo(qw[2 * t + 1]) * eg - acc[t][2]; acc[t][3] = bfhi(qw[2 * t + 1]) * eg - acc[t][3]; } }
                    bf16_t* outp = ((prod == 0) ? (Ag + (size_t)ci * 16384) : (prod == 2) ? (Qg + (size_t)ci * 8192) : (Og + (size_t)ci * 8192)) + m * 128 + n0;
                    u32x4 w0, w1;
                    w0.x = cvt_pk_bf16(acc[0][0], acc[0][1]); w0.y = cvt_pk_bf16(acc[0][2], acc[0][3]); w0.z = cvt_pk_bf16(acc[1][0], acc[1][1]); w0.w = cvt_pk_bf16(acc[1][2], acc[1][3]);
                    w1.x = cvt_pk_bf16(acc[2][0], acc[2][1]); w1.y = cvt_pk_bf16(acc[2][2], acc[2][3]); w1.z = cvt_pk_bf16(acc[3][0], acc[3][1]); w1.w = cvt_pk_bf16(acc[3][2], acc[3][3]);
                    *(u32x4*)outp = w0; *(u32x4*)(outp + 8) = w1;
                }
            }
            {
                const int ah = wave & 1;
                bf16x8 xf[4][2];
#pragma unroll
                for (int t = 0; t < 4; ++t)
#pragma unroll
                    for (int ks = 0; ks < 2; ++ks) xf[t][ks] = *(const bf16x8*)(kdT + (64 * ah + 16 * (r16 >> 2) + (r16 & 3) + 4 * t) * 72 + quad * 8 + ks * 32);
#pragma unroll
                for (int u = 0; u < 2; ++u) {
                    const int vt = (wave >> 1) * 2 + u;
                    const bf16x8 yf0 = *(const bf16x8*)(uT + (vt * 16 + r16) * 72 + quad * 8), yf1 = *(const bf16x8*)(uT + (vt * 16 + r16) * 72 + quad * 8 + 32);
                    f32x4 acc[4];
#pragma unroll
                    for (int t = 0; t < 4; ++t) { acc[t] = (f32x4){0.f, 0.f, 0.f, 0.f}; acc[t] = MFMA16(xf[t][0], yf0, acc[t]); acc[t] = MFMA16(xf[t][1], yf1, acc[t]); }
                    bf16_t* outp = Bg + (size_t)ci * 16384 + (vt * 16 + r16) * 128 + 64 * ah + 16 * quad;
                    u32x4 w0, w1;
                    w0.x = cvt_pk_bf16(acc[0][0], acc[0][1]); w0.y = cvt_pk_bf16(acc[0][2], acc[0][3]); w0.z = cvt_pk_bf16(acc[1][0], acc[1][1]); w0.w = cvt_pk_bf16(acc[1][2], acc[1][3]);
                    w1.x = cvt_pk_bf16(acc[2][0], acc[2][1]); w1.y = cvt_pk_bf16(acc[2][2], acc[2][3]); w1.z = cvt_pk_bf16(acc[3][0], acc[3][1]); w1.w = cvt_pk_bf16(acc[3][2], acc[3][3]);
                    *(u32x4*)outp = w0; *(u32x4*)(outp + 8) = w1;
                }
            }
        }
        lds_barrier();
    }
#undef P1_PREFETCH
}

DI void ph_gdn_p2(PK p, unsigned char* lds, const int wv) {
    PK_FRESH(p);
    const int tid = ltid(wv), lane = tid & 63, wave = __builtin_amdgcn_readfirstlane(tid >> 6), r16 = lane & 15, quad = lane >> 4, a0 = wave * 16;
    const bf16_t* Ag = WSP(const bf16_t, WS_GA); const bf16_t* Bg = WSP(const bf16_t, WS_GB); bf16_t* Sg = WSP(bf16_t, WS_GS); const float* glg = WSP(const float, WS_GL);
    bf16_t* ST = (bf16_t*)lds;
#define P2_LOAD(AF, BM, GL, cidx) do { const size_t c_ = (cidx); _Pragma("unroll") for (int ks = 0; ks < 4; ++ks) AF[ks] = *(const bf16x8*)(Ag + c_ * 16384 + (size_t)(a0 + r16) * 128 + ks * 32 + quad * 8); \
        BM = *(const u32x2*)(Bg + c_ * 16384 + (size_t)(v0 + r16) * 128 + a0 + quad * 4); GL = glg[c_]; } while (0)
    for (int item = blockIdx.x; item < 256; item += gridDim.x) {
        const int bh = (item & 7) * 4 + (item >> 6), v0 = ((item >> 3) & 7) * 16;
        const size_t cb = (size_t)bh * 128;
        f32x4 S = {0.f, 0.f, 0.f, 0.f};
        bf16x8 afA[4], afB[4], afC[4], afD[4], afE[4], afF[4], afG[4], afH[4]; u32x2 bmA, bmB, bmC, bmD, bmE, bmF, bmG, bmH; float glA, glB, glC, glD, glE, glF, glG, glH;
        P2_LOAD(afA, bmA, glA, cb); P2_LOAD(afB, bmB, glB, cb + 1); P2_LOAD(afC, bmC, glC, cb + 2); P2_LOAD(afD, bmD, glD, cb + 3); P2_LOAD(afE, bmE, glE, cb + 4); P2_LOAD(afF, bmF, glF, cb + 5); P2_LOAD(afG, bmG, glG, cb + 6);
#define P2_STEP(AFc, BMc, GLc, AFp, BMp, GLp, nn) do { const int n_ = (nn); const size_t ci = cb + n_; \
            u32x2 sp; sp.x = cvt_pk_bf16(S[0], S[1]); sp.y = cvt_pk_bf16(S[2], S[3]); \
            bf16_t* STb = ST + (n_ & 1) * (16 * 136); \
            *(u32x2*)(STb + r16 * 136 + a0 + quad * 4) = sp; \
            lds_barrier(); \
            f32x4 acc; acc[0] = GLc * S[0] + bflo(BMc.x); acc[1] = GLc * S[1] + bfhi(BMc.x); acc[2] = GLc * S[2] + bflo(BMc.y); acc[3] = GLc * S[3] + bfhi(BMc.y); \
            bf16x8 bfr_[4]; _Pragma("unroll") for (int ks = 0; ks < 4; ++ks) bfr_[ks] = *(const bf16x8*)(STb + r16 * 136 + ks * 32 + quad * 8);        \
            P2_LOAD(AFp, BMp, GLp, cb + ((n_ + 7 < 128) ? n_ + 7 : 127));        \
            *(u32x2*)(Sg + ci * 16384 + (size_t)(v0 + r16) * 128 + a0 + quad * 4) = sp;        \
            _Pragma("unroll") for (int ks = 0; ks < 4; ++ks) acc = MFMA16(AFc[ks], bfr_[ks], acc); \
            S = acc; } while (0)
        for (int n = 0; n < 128; n += 8) {
            P2_STEP(afA, bmA, glA, afH, bmH, glH, n);
            P2_STEP(afB, bmB, glB, afA, bmA, glA, n + 1);
            P2_STEP(afC, bmC, glC, afB, bmB, glB, n + 2);
            P2_STEP(afD, bmD, glD, afC, bmC, glC, n + 3);
            P2_STEP(afE, bmE, glE, afD, bmD, glD, n + 4);
            P2_STEP(afF, bmF, glF, afE, bmE, glE, n + 5);
            P2_STEP(afG, bmG, glG, afF, bmF, glF, n + 6);
            P2_STEP(afH, bmH, glH, afG, bmG, glG, n + 7);
        }
#undef P2_STEP
        lds_barrier();
    }
#undef P2_LOAD
}

DI void ph_gdn_p3(PK p, int l, const int wv) {
    PK_FRESH(p);
    const int tid = ltid(wv), lane = tid & 63, wave = __builtin_amdgcn_readfirstlane(tid >> 6), r16 = lane & 15, quad = lane >> 4;
    const bf16_t* Qg = WSP(const bf16_t, WS_GQ); const bf16_t* Og = WSP(const bf16_t, WS_GO); const bf16_t* Sg = WSP(const bf16_t, WS_GS);
    const bf16_t* proj = WSP(const bf16_t, WS_PROJ); bf16_t* obuf = WSP(bf16_t, WS_OBUF); const float* ogain = p->in[11] + l * 128;
    for (int it = blockIdx.x; it < 2048; it += gridDim.x) {
        const int ci = it * 2 + (wave >> 2), mi = wave & 3;
        const int n = ci & 127, bh = ci >> 7, hd = bh & 15, b = bh >> 4;
        const int i = mi * 16 + r16; const size_t tok = (size_t)b * SEQ + n * 64 + i;
        bf16x8 qa[4], sf[4][8]; u32x2 ov[8], zv[8];
#pragma unroll
        for (int ks = 0; ks < 4; ++ks) { qa[ks] = *(const bf16x8*)(Qg + (size_t)ci * 8192 + i * 128 + ks * 32 + quad * 8);
#pragma unroll
            for (int ni = 0; ni < 8; ++ni) sf[ks][ni] = *(const bf16x8*)(Sg + (size_t)ci * 16384 + (ni * 16 + r16) * 128 + ks * 32 + quad * 8); }
#pragma unroll
        for (int ni = 0; ni < 8; ++ni) { ov[ni] = *(const u32x2*)(Og + (size_t)ci * 8192 + i * 128 + ni * 16 + quad * 4); zv[ni] = *(const u32x2*)(proj + tok * GINP + 6144 + hd * 128 + ni * 16 + quad * 4); }
        f32x4 acc[8];
#pragma unroll
        for (int ni = 0; ni < 8; ++ni) acc[ni] = (f32x4){0.f, 0.f, 0.f, 0.f};
#pragma unroll
        for (int ks = 0; ks < 4; ++ks)
#pragma unroll
            for (int ni = 0; ni < 8; ++ni) acc[ni] = MFMA16(sf[ks][ni], qa[ks], acc[ni]);
        float ss = 0.f;
#pragma unroll
        for (int ni = 0; ni < 8; ++ni) {
            acc[ni][0] += bflo(ov[ni].x); acc[ni][1] += bfhi(ov[ni].x); acc[ni][2] += bflo(ov[ni].y); acc[ni][3] += bfhi(ov[ni].y);
            ss += acc[ni][0] * acc[ni][0] + acc[ni][1] * acc[ni][1] + acc[ni][2] * acc[ni][2] + acc[ni][3] * acc[ni][3]; }
        ss += sw_xor<16>(ss); ss = sw_xor32_sum(ss);
        const float rms = rsqrtf(ss * (1.f / 128.f) + NORM_EPS);
#pragma unroll
        for (int ni = 0; ni < 8; ++ni) { const int v = ni * 16 + quad * 4; const f32x4 gv = *(const f32x4*)(ogain + v);
            const float y0 = acc[ni][0] * rms * gv[0] * silu_f(bflo(zv[ni].x)), y1 = acc[ni][1] * rms * gv[1] * silu_f(bfhi(zv[ni].x));
            const float y2 = acc[ni][2] * rms * gv[2] * silu_f(bflo(zv[ni].y)), y3 = acc[ni][3] * rms * gv[3] * silu_f(bfhi(zv[ni].y));
            u32x2 w; w.x = cvt_pk_bf16(y0, y1); w.y = cvt_pk_bf16(y2, y3); *(u32x2*)(obuf + tok * D + hd * 128 + v) = w; }
    }
}

DI void ph_rope(PK p, const bf16_t* src, int ld, bf16_t* dst, const int wv) {
    PK_FRESH(p);
    const int tid = ltid(wv); const float* cosT = WSP(const float, WS_COS); const float* sinT = WSP(const float, WS_SIN);
    for (int idx = blockIdx.x * 512 + tid; idx < T * 128; idx += gridDim.x * 512) {
        const int jc = idx & 7, hc = (idx >> 3) & 15, t = idx >> 7;
        const bf16_t* sp = src + (size_t)t * ld + hc * 128 + jc * 8;
        const u32x4 x1 = *(const u32x4*)sp, x2 = *(const u32x4*)(sp + 64);
        const f32x4 c0 = *(const f32x4*)(cosT + t * 64 + jc * 8), c1 = *(const f32x4*)(cosT + t * 64 + jc * 8 + 4);
        const f32x4 s0 = *(const f32x4*)(sinT + t * 64 + jc * 8), s1 = *(const f32x4*)(sinT + t * 64 + jc * 8 + 4);
        float a[8] = {bflo(x1.x), bfhi(x1.x), bflo(x1.y), bfhi(x1.y), bflo(x1.z), bfhi(x1.z), bflo(x1.w), bfhi(x1.w)};
        float bb[8] = {bflo(x2.x), bfhi(x2.x), bflo(x2.y), bfhi(x2.y), bflo(x2.z), bfhi(x2.z), bflo(x2.w), bfhi(x2.w)};
        float cs[8] = {c0[0], c0[1], c0[2], c0[3], c1[0], c1[1], c1[2], c1[3]}, sn[8] = {s0[0], s0[1], s0[2], s0[3], s1[0], s1[1], s1[2], s1[3]};
        float o1[8], o2[8];
#pragma unroll
        for (int e = 0; e < 8; ++e) { o1[e] = a[e] * cs[e] - bb[e] * sn[e]; o2[e] = bb[e] * cs[e] + a[e] * sn[e]; }
        const int b = t >> 13, s = t & 8191;
        bf16_t* dp = dst + ((size_t)(b * 16 + hc) * SEQ + s) * 128 + jc * 8;
        u32x4 w1, w2;
        w1.x = cvt_pk_bf16(o1[0], o1[1]); w1.y = cvt_pk_bf16(o1[2], o1[3]); w1.z = cvt_pk_bf16(o1[4], o1[5]); w1.w = cvt_pk_bf16(o1[6], o1[7]);
        w2.x = cvt_pk_bf16(o2[0], o2[1]); w2.y = cvt_pk_bf16(o2[2], o2[3]); w2.z = cvt_pk_bf16(o2[4], o2[5]); w2.w = cvt_pk_bf16(o2[6], o2[7]);
        *(u32x4*)dp = w1; *(u32x4*)(dp + 64) = w2;
    }
}
DI void ph_vrelayout(const bf16_t* src, bf16_t* dst, const int wv) {
    const int tid = ltid(wv);
    for (int idx = blockIdx.x * 512 + tid; idx < T * 256; idx += gridDim.x * 512) {
        const int ch = idx & 15, hc = (idx >> 4) & 15, t = idx >> 8; const int b = t >> 13, s = t & 8191;
        *(u32x4*)(dst + ((size_t)(b * 16 + hc) * SEQ + s) * 128 + ch * 8) = *(const u32x4*)(src + (size_t)t * 4096 + 2048 + hc * 128 + ch * 8);
    }
}

DI void ph_attn(PK p, unsigned char* lds, const int wv) {
    PK_FRESH(p);
    using att::bf16;
    const bf16* Qd = WSP(const bf16, WS_QD); const bf16* Ksh = WSP(const bf16, WS_KSH); const bf16* Vsh = WSP(const bf16, WS_VSH); bf16* Oat = WSP(bf16, WS_OAT);
    const int total = 64 * 16, stride = gridDim.x, W = SEQ;
    int L = blockIdx.x;
    if (L < total) {
        auto mkref = [&](int Li, int pass) {
            const int xcd = Li & 7, jk = Li >> 3, mm = (jk & 127) >> 4, x = jk & 15, h64 = xcd * 8 + mm, qb = pass ? (31 - x) : x;
            const int vh = h64 & 1, c = (h64 >> 1) & 1, bh = h64 >> 2;
            att::BlockRef<bf16, bf16> r;
            r.Q = Qd + ((size_t)(bh * 2 + c) * SEQ + (size_t)qb * 256) * 128;
            r.K = Ksh + (size_t)(bh * 2 + c) * SEQ * 128;
            r.V = Vsh + (size_t)(bh * 2 + vh) * SEQ * 128;
            r.O = Oat + ((size_t)((bh * 2 + c) * 2 + vh) * SEQ + (size_t)qb * 256) * 128;
            r.P0 = qb * 256; return r; };
        int pass = 0;
        att::BlockRef<bf16, bf16> cur = mkref(L, 0);
        att::Seam<bf16> S;
        att::causal_swa_prime<bf16, bf16>(cur, W, (char*)lds, S, wv);
        for (;;) {
            const bool more_pass = pass == 0, more_item = L + stride < total, last = !more_pass && !more_item;
            int passn = pass + 1, Ln = L;
            if (!more_pass) { passn = 0; Ln = more_item ? L + stride : L; }
            const att::BlockRef<bf16, bf16> nxt = last ? cur : mkref(Ln, passn);
            att::causal_swa_block<bf16, bf16>(cur, nxt, SEQ, W, (char*)lds, S, wv);
            if (last) break;
            cur = nxt; pass = passn; L = Ln;
        }
    }
    __syncthreads();
}

DI void ph_diff_combine(PK p, int j, int l, unsigned char* lds, const int wv) {
    PK_FRESH(p);
    const int tid = ltid(wv), lane = tid & 63, wave = __builtin_amdgcn_readfirstlane(tid >> 6);
    float* ldsf = (float*)lds;
    const float lambda_init = 0.8f - 0.6f * expf(-0.3f * (float)l);
    if (wave == 0) { const float* lp = p->in[18] + j * 512;
        float a = lp[lane] * lp[128 + lane] + lp[64 + lane] * lp[192 + lane], bsum = lp[256 + lane] * lp[384 + lane] + lp[320 + lane] * lp[448 + lane];
        a = wave_sum(a); bsum = wave_sum(bsum);
        if (lane == 0) ldsf[0] = expf(a) - expf(bsum) + lambda_init; }
    __syncthreads();
    const float lam = ldsf[0], om = 1.f - lambda_init;
    const bf16_t* Oat = WSP(const bf16_t, WS_OAT); bf16_t* obuf = WSP(bf16_t, WS_OBUF); const float* sg = p->in[19] + j * 256;
    for (int row = blockIdx.x * 8 + wave; row < T * 8; row += gridDim.x * 8) {
        const int t = row >> 3, h = row & 7, b = t >> 13, s = t & 8191, vh = lane >> 5, d = (lane & 31) * 4;
        const u32x2 o1 = *(const u32x2*)(Oat + ((size_t)(((b * 8 + h) * 2 + 0) * 2 + vh) * SEQ + s) * 128 + d);
        const u32x2 o2 = *(const u32x2*)(Oat + ((size_t)(((b * 8 + h) * 2 + 1) * 2 + vh) * SEQ + s) * 128 + d);
        float v[4] = {bflo(o1.x) - lam * bflo(o2.x), bfhi(o1.x) - lam * bfhi(o2.x), bflo(o1.y) - lam * bflo(o2.y), bfhi(o1.y) - lam * bfhi(o2.y)};
        float ss = v[0] * v[0] + v[1] * v[1] + v[2] * v[2] + v[3] * v[3];
        ss = wave_sum(ss);
        const float rms = rsqrtf(ss * (1.f / 256.f) + NORM_EPS) * om;
        const f32x4 gv = *(const f32x4*)(sg + vh * 128 + d);
        u32x2 w; w.x = cvt_pk_bf16(v[0] * rms * gv[0], v[1] * rms * gv[1]); w.y = cvt_pk_bf16(v[2] * rms * gv[2], v[3] * rms * gv[3]);
        *(u32x2*)(obuf + (size_t)t * D + h * 256 + vh * 128 + d) = w;
    }
    __syncthreads();
}

#define INS16(Lr, vv) do { _Pragma("unroll") for (int k_ = 0; k_ < 16; ++k_) { const float hi_ = fmaxf(Lr[k_], vv); vv = fminf(Lr[k_], vv); Lr[k_] = hi_; } } while (0)
DI void sort16_desc(float (&L)[16]) {
#pragma unroll
    for (int k = 2; k <= 16; k <<= 1)
#pragma unroll
        for (int j = k >> 1; j >= 1; j >>= 1)
#pragma unroll
            for (int i = 0; i < 16; ++i) { const int l = i ^ j;
                if (l > i) { const float hi_ = fmaxf(L[i], L[l]), lo_ = fminf(L[i], L[l]); const bool desc = (i & k) == 0; L[i] = desc ? hi_ : lo_; L[l] = desc ? lo_ : hi_; } }
}
template <int XM> DI void merge16(float (&L)[16]) {
    float P[16];
#pragma unroll
    for (int i = 0; i < 16; ++i) P[i] = (XM == 4) ? dpp_full<0x141>(L[15 - i]) : sw_xor<XM>(L[15 - i]);
#pragma unroll
    for (int i = 0; i < 16; ++i) L[i] = fmaxf(L[i], P[i]);
#pragma unroll
    for (int s = 8; s >= 1; s >>= 1)
#pragma unroll
        for (int i = 0; i < 16; ++i) if ((i & s) == 0) { const float hi_ = fmaxf(L[i], L[i + s]), lo_ = fminf(L[i], L[i + s]); L[i] = hi_; L[i + s] = lo_; }
}
__constant__ unsigned kStairPk[16] = {0x20100800u, 0xffe07033u, 0x21110901u, 0xfff07140u, 0x22120a02u, 0xffff8041u, 0x23130b03u, 0xffff9042u, 0x24140c04u, 0xffffa050u, 0x30150d05u, 0xffffb051u, 0x31160e06u, 0xffffc060u, 0x32170f07u, 0xffffd061u};
DI void ph_peer_topk(PK p, int l, unsigned char* lds, const int wv) {
    PK_FRESH(p);
    const int tid = ltid(wv);
    float* tops = (float*)lds; float* fin = tops + 64 * 2 * 16;
    const bf16_t* pq = WSP(const bf16_t, WS_PQ);
    int* pidx = WSP(int, WS_PIDX); float* pgate = WSP(float, WS_PGATE);
    const float NEG = -__builtin_inff();
    const int rowl = (tid & 255) >> 3, half = (tid >> 2) & 1, quarter = tid & 3, l8 = tid & 7;
    const int nitems = T * 8 / 32;
    const int lane = tid & 63, wave = __builtin_amdgcn_readfirstlane(tid >> 6);
    if (wave >= 4) {
        const int cstep = gridDim.x * 4, R = 2 * 16384; int r = blockIdx.x * 4 + (wave - 4);
        f32x4 ca[8], cb[8];
        if (r < R) pc_load(p, l, r, ca, lane);
        for (; r < R; r += 2 * cstep) {
            const int r2 = r + cstep, r3 = r + 2 * cstep;
            if (r2 < R) pc_load(p, l, r2, cb, lane);
            pc_store(p, r, ca, lane);
            if (r3 < R) pc_load(p, l, r3, ca, lane);
            if (r2 < R) pc_store(p, r2, cb, lane);
        }
        return;
    }
    const u32x2 stw = *(const u32x2*)(kStairPk + l8 * 2);
    u32x4 wn[4];
    if ((int)blockIdx.x < nitems) { const int row = blockIdx.x * 32 + rowl; const bf16_t* sp = pq + (size_t)(row >> 3) * 2048 + (row & 7) * 256 + half * 128 + quarter * 32;
#pragma unroll
        for (int c = 0; c < 4; ++c) wn[c] = *(const u32x4*)(sp + c * 8); }
    for (int item = blockIdx.x; item < nitems; item += gridDim.x) {
        const int row0 = item * 32;
        u32x4 wc[4];
#pragma unroll
        for (int c = 0; c < 4; ++c) wc[c] = wn[c];
        { const int itn = (item + (int)gridDim.x < nitems) ? item + (int)gridDim.x : item; const int row = itn * 32 + rowl;
          const bf16_t* sp = pq + (size_t)(row >> 3) * 2048 + (row & 7) * 256 + half * 128 + quarter * 32;
#pragma unroll
          for (int c = 0; c < 4; ++c) wn[c] = *(const u32x4*)(sp + c * 8); }
        float Lr[16], Lq[16];
#pragma unroll
        for (int c = 0; c < 4; ++c)
#pragma unroll
            for (int e = 0; e < 4; ++e) { const unsigned w = wc[c][e];
                const float v0 = __uint_as_float((w << 16) | (unsigned)(quarter * 32 + c * 8 + e * 2)), v1 = __uint_as_float((w & 0xffff0000u) | (unsigned)(quarter * 32 + c * 8 + e * 2 + 1));
                if (c < 2) { Lr[c * 8 + e * 2] = v0; Lr[c * 8 + e * 2 + 1] = v1; } else { Lq[(c - 2) * 8 + e * 2] = v0; Lq[(c - 2) * 8 + e * 2 + 1] = v1; } }
        sort16_desc(Lr); sort16_desc(Lq);
#pragma unroll
        for (int i = 0; i < 16; ++i) Lr[i] = fmaxf(Lr[i], Lq[15 - i]);
#pragma unroll
        for (int s = 8; s >= 1; s >>= 1)
#pragma unroll
            for (int i = 0; i < 16; ++i) if ((i & s) == 0) { const float hi_ = fmaxf(Lr[i], Lr[i + s]), lo_ = fminf(Lr[i], Lr[i + s]); Lr[i] = hi_; Lr[i + s] = lo_; }
        merge16<1>(Lr); merge16<2>(Lr);
        if (quarter == 0) {
#pragma unroll
            for (int k = 0; k < 16; ++k) tops[(rowl * 2 + half) * 16 + k] = Lr[k];
        }
        asm volatile("s_waitcnt lgkmcnt(0)" ::: "memory");
        float M[16];
#pragma unroll
        for (int k = 0; k < 16; ++k) M[k] = NEG;
        {
            const float* ta = tops + (rowl * 2) * 16; const float* tb = ta + 16;
#pragma unroll
            for (int m = 0; m < 7; ++m) { const unsigned code = (((m < 4) ? stw.x : stw.y) >> (8 * (m & 3))) & 255u;
                float s = (code < 255u) ? ta[code >> 4] + tb[code & 15u] : NEG;
                s = (code < 255u) ? __uint_as_float((__float_as_uint(s) & ~255u) | code) : NEG; INS16(M, s); }
        }
        merge16<1>(M); merge16<2>(M); merge16<4>(M);
        float sum = 0.f;
#pragma unroll
        for (int k = 0; k < 16; ++k) sum += __expf(M[k] - M[0]);
        if (l8 == 0) {
#pragma unroll
            for (int k = 0; k < 16; ++k) fin[rowl * 16 + k] = M[k];
        }
        asm volatile("s_waitcnt lgkmcnt(0)" ::: "memory");
        {
            const float inv = __builtin_amdgcn_rcpf(sum), m0 = M[0]; const int row = row0 + rowl; const size_t ob = (size_t)(row >> 3) * 128 + (row & 7) * 16;
#pragma unroll
            for (int u = 0; u < 2; ++u) { const int k = l8 * 2 + u; const float mk = fin[rowl * 16 + k]; const unsigned code = __float_as_uint(mk) & 255u;
                const unsigned i1 = __float_as_uint(tops[(rowl * 2) * 16 + (code >> 4)]) & 127u, i2 = __float_as_uint(tops[(rowl * 2 + 1) * 16 + (code & 15u)]) & 127u;
                pidx[ob + k] = (int)(i1 * 128u + i2); pgate[ob + k] = __expf(mk - m0) * inv; }
        }
        asm volatile("s_waitcnt lgkmcnt(0)" ::: "memory");
    }
}

DI float gelu_f(float v) {
    const float av = fabsf(v), t = __builtin_amdgcn_rcpf(fmaf(av, 0.2316418882f, 1.0f));
    float q = fmaf(t, 0.5307027145f, -0.7265760135f); q = fmaf(q, t, 0.7107068705f); q = fmaf(q, t, -0.142248368f); q = fmaf(q, t, 0.127414796f); q = q * t;
    const float e = __builtin_amdgcn_exp2f(v * v * -0.72134752044f), m = v * (q * e);
    return v < 0.f ? m : v - m;
}
#define FP4X8(w, o) const f32x2 o##0 = __builtin_amdgcn_cvt_scalef32_pk_f32_fp4(w, 1.0f, 0), o##1 = __builtin_amdgcn_cvt_scalef32_pk_f32_fp4(w, 1.0f, 1), \
                                o##2 = __builtin_amdgcn_cvt_scalef32_pk_f32_fp4(w, 1.0f, 2), o##3 = __builtin_amdgcn_cvt_scalef32_pk_f32_fp4(w, 1.0f, 3)
DI void ph_peer_gather(PK p, int l, unsigned char* lds, const int wv, const bool apply = true) {
    PK_FRESH(p);
    const int tid = ltid(wv), lane = tid & 63, wave = __builtin_amdgcn_readfirstlane(tid >> 6);
    const bf16_t* hb = WSP(const bf16_t, WS_HBUF); const unsigned char* ub = WSP(const unsigned char, WS_PU); const unsigned char* vb = WSP(const unsigned char, WS_PV);
    const unsigned char* psc8 = WSP(const unsigned char, WS_PUS);
    const int* pidx = WSP(const int, WS_PIDX); const float* pgate = WSP(const float, WS_PGATE); bf16_t* xc = WSP(bf16_t, WS_XCUR);
    const float* gt2 = WSP(const float, WS_MOD) + l * 12288 + 5 * 2048;
    const unsigned l16 = (unsigned)lane * 16u, l2 = (unsigned)(lane >> 4) * 4u;
    for (int tok = blockIdx.x * 8 + wave; tok < T; tok += gridDim.x * 8) {
        f32x2 hf2[16];
#pragma unroll
        for (int c = 0; c < 4; ++c) { const u32x4 w = *(const u32x4*)(hb + (size_t)tok * D + lane * 32 + c * 8);
            hf2[c * 4 + 0] = (f32x2){bflo(w.x), bfhi(w.x)}; hf2[c * 4 + 1] = (f32x2){bflo(w.y), bfhi(w.y)}; hf2[c * 4 + 2] = (f32x2){bflo(w.z), bfhi(w.z)}; hf2[c * 4 + 3] = (f32x2){bflo(w.w), bfhi(w.w)}; }
        f32x2 acc2[16];
#pragma unroll
        for (int i = 0; i < 16; ++i) acc2[i] = (f32x2){0.f, 0.f};
        u32x2* sraw = (u32x2*)(lds + wave * 2048); u32x2* ssrt = sraw + 128;
        {
            const unsigned k0 = (unsigned)pidx[(size_t)tok * 128 + lane], k1 = (unsigned)pidx[(size_t)tok * 128 + 64 + lane];
            const float g0 = pgate[(size_t)tok * 128 + lane], g1 = pgate[(size_t)tok * 128 + 64 + lane];
            sraw[lane] = (u32x2){k0, __float_as_uint(g0)}; sraw[64 + lane] = (u32x2){k1, __float_as_uint(g1)};
            asm volatile("s_waitcnt lgkmcnt(0)" ::: "memory");
            const unsigned key0 = k0 * 128u + (unsigned)lane, key1 = k1 * 128u + 64u + (unsigned)lane; unsigned r0 = 0, r1 = 0;
            for (int j = 0; j < 128; ++j) { const unsigned kj = sraw[j].x * 128u + (unsigned)j; r0 += (kj < key0) ? 1u : 0u; r1 += (kj < key1) ? 1u : 0u; }
            ssrt[r0] = (u32x2){k0, __float_as_uint(g0)}; ssrt[r1] = (u32x2){k1, __float_as_uint(g1)};
            asm volatile("s_waitcnt lgkmcnt(0)" ::: "memory");
        }
#define G_LOAD(gi, UR, VR, US, GT) do { unsigned o16_ = l16, o2_ = l2; asm("" : "+v"(o16_)); asm("" : "+v"(o2_));        \
        _Pragma("unroll") for (int q = 0; q < 4; ++q) { const u32x2 pr = ssrt[(gi) * 4 + q]; const unsigned e_ = (unsigned)__builtin_amdgcn_readfirstlane((int)pr.x); GT[q] = __uint_as_float(pr.y); \
            unsigned long long ue_ = (unsigned long long)ub + (unsigned long long)e_ * 1024ull, ve_ = (unsigned long long)vb + (unsigned long long)e_ * 1024ull, se_ = (unsigned long long)psc8 + (unsigned long long)e_ * 16ull; \
            asm("" : "+s"(ue_)); asm("" : "+s"(ve_)); asm("" : "+s"(se_));        \
            UR[q] = *(const __attribute__((address_space(1))) u32x4*)(ue_ + (unsigned long long)o16_); US[q] = *(const __attribute__((address_space(1))) unsigned*)(se_ + (unsigned long long)o2_); \
            VR[q] = *(const __attribute__((address_space(1))) u32x4*)(ve_ + (unsigned long long)o16_); } } while (0)
#define G_COMP(UR, VR, US, GT) do { float cf[4]; \
            _Pragma("unroll") for (int q = 0; q < 4; ++q) { f32x2 t2 = {0.f, 0.f}, t3 = {0.f, 0.f}; \
                _Pragma("unroll") for (int c = 0; c < 4; ++c) { FP4X8(UR[q][c], a); \
                    t2 = a0 * hf2[c * 4 + 0] + t2; t3 = a1 * hf2[c * 4 + 1] + t3; t2 = a2 * hf2[c * 4 + 2] + t2; t3 = a3 * hf2[c * 4 + 3] + t3; } \
                t2 = t2 + t3; \
                cf[q] = (t2.x + t2.y) * __uint_as_float(US[q] << 16); } \
            wave_sum4_dpp(cf[0], cf[1], cf[2], cf[3]); \
            _Pragma("unroll") for (int q = 0; q < 4; ++q) cf[q] = __int_as_float(__builtin_amdgcn_readlane(__float_as_int(cf[q]), 63)); \
            { float xg_ = 0.f;        \
              _Pragma("unroll") for (int q = 0; q < 4; ++q) asm("v_writelane_b32 %0, %1, %2" : "+v"(xg_) : "s"(cf[q]), "n"(q)); \
              const float yg_ = gelu_f(xg_); \
              _Pragma("unroll") for (int q = 0; q < 4; ++q) cf[q] = GT[q] * __int_as_float(__builtin_amdgcn_readlane(__float_as_int(yg_), q)); } \
            _Pragma("unroll") for (int q = 0; q < 4; ++q) { const float cs = cf[q] * __uint_as_float(US[q] & 0xffff0000u); const f32x2 cs2 = {cs, cs}; \
                _Pragma("unroll") for (int c = 0; c < 4; ++c) { FP4X8(VR[q][c], b); \
                    acc2[c * 4 + 0] = cs2 * b0 + acc2[c * 4 + 0]; acc2[c * 4 + 1] = cs2 * b1 + acc2[c * 4 + 1]; acc2[c * 4 + 2] = cs2 * b2 + acc2[c * 4 + 2]; acc2[c * 4 + 3] = cs2 * b3 + acc2[c * 4 + 3]; } } } while (0)
        {
            u32x4 urA[4], vrA[4], urB[4], vrB[4]; unsigned usA[4], usB[4]; float gtA[4], gtB[4];
            G_LOAD(0, urA, vrA, usA, gtA);
            for (int g = 0; g < 32; g += 2) {
                G_LOAD(g + 1, urB, vrB, usB, gtB);
                G_COMP(urA, vrA, usA, gtA);
                G_LOAD((g + 2 < 32) ? g + 2 : 31, urA, vrA, usA, gtA);
                G_COMP(urB, vrB, usB, gtB);
            }
        }
#undef G_LOAD
#undef G_COMP
        float acc[32];
#pragma unroll
        for (int i = 0; i < 16; ++i) { acc[2 * i] = acc2[i].x; acc[2 * i + 1] = acc2[i].y; }
        if (!apply) { if (p->ph_hi == -12345) { for (int i = 0; i < 32; ++i) xc[i * 64 + lane] = f2bf(acc[i]); } continue; }
        const int b = tok >> 13; const float gm = ((MK_SKIP >> (2 * l + 1)) & 1) ? 0.f : 1.f;
        float ss = 0.f;
#pragma unroll
        for (int c = 0; c < 4; ++c) { const int col = lane * 32 + c * 8; bf16_t* xp = xc + (size_t)tok * D + col;
            const u32x4 xb = *(const u32x4*)xp; const f32x4 g0 = *(const f32x4*)(gt2 + (size_t)b * MODC + col), g1 = *(const f32x4*)(gt2 + (size_t)b * MODC + col + 4);
            const float x8[8] = {bflo(xb.x), bfhi(xb.x), bflo(xb.y), bfhi(xb.y), bflo(xb.z), bfhi(xb.z), bflo(xb.w), bfhi(xb.w)}; float y8[8];
#pragma unroll
            for (int e2 = 0; e2 < 8; ++e2) { y8[e2] = x8[e2] + gm * ((e2 < 4) ? g0[e2] : g1[e2 - 4]) * acc[c * 8 + e2]; acc[c * 8 + e2] = y8[e2]; ss += y8[e2] * y8[e2]; }
            if (l < 3) { u32x4 w; w.x = cvt_pk_bf16(y8[0], y8[1]); w.y = cvt_pk_bf16(y8[2], y8[3]); w.z = cvt_pk_bf16(y8[4], y8[5]); w.w = cvt_pk_bf16(y8[6], y8[7]); *(u32x4*)xp = w; } }
        const float rn = rsqrtf(wave_sum(ss) * (1.f / D) + NORM_EPS);
        const float* modall = WSP(const float, WS_MOD) + (size_t)b * MODC;
        if (l == 3) {
#pragma unroll
            for (int c = 0; c < 8; ++c) { const int col = lane * 32 + c * 4; const f32x4 gv = *(const f32x4*)(p->in[25] + col); f32x4 o;
#pragma unroll
                for (int e2 = 0; e2 < 4; ++e2) o[e2] = acc[c * 4 + e2] * rn * gv[e2];
                *(f32x4*)(p->out + (size_t)tok * D + col) = o; }
        } else {
            const float* g1 = (l == 1) ? p->in[13] : (p->in[5] + (l + 1) * D);
            const float* sh1 = (l == 1) ? (modall + 4 * 12288) : (modall + (l + 1) * 12288);
            const float* sc1 = sh1 + D;
            bf16_t* d1 = WSP(bf16_t, WS_HBUF) + (size_t)tok * D;
#pragma unroll
            for (int c = 0; c < 4; ++c) { u32x4 w;
#pragma unroll
                for (int hh = 0; hh < 2; ++hh) { const int col = lane * 32 + c * 8 + hh * 4; const f32x4 gv = *(const f32x4*)(g1 + col), sv = *(const f32x4*)(sh1 + col), cv = *(const f32x4*)(sc1 + col); float o[4];
#pragma unroll
                    for (int e2 = 0; e2 < 4; ++e2) o[e2] = acc[c * 8 + hh * 4 + e2] * rn * gv[e2] * (1.f + cv[e2]) + sv[e2];
                    w[hh * 2] = cvt_pk_bf16(o[0], o[1]); w[hh * 2 + 1] = cvt_pk_bf16(o[2], o[3]); }
                *(u32x4*)(d1 + lane * 32 + c * 8) = w; }
            if (l == 1) {
                const float* g2 = p->in[5] + 2 * D; const float* sh2 = modall + 2 * 12288; const float* sc2 = sh2 + D;
                bf16_t* d2 = WSP(bf16_t, WS_OBUF) + (size_t)tok * D;
#pragma unroll
                for (int c = 0; c < 4; ++c) { u32x4 w;
#pragma unroll
                    for (int hh = 0; hh < 2; ++hh) { const int col = lane * 32 + c * 8 + hh * 4; const f32x4 gv = *(const f32x4*)(g2 + col), sv = *(const f32x4*)(sh2 + col), cv = *(const f32x4*)(sc2 + col); float o[4];
#pragma unroll
                        for (int e2 = 0; e2 < 4; ++e2) o[e2] = acc[c * 8 + hh * 4 + e2] * rn * gv[e2] * (1.f + cv[e2]) + sv[e2];
                        w[hh * 2] = cvt_pk_bf16(o[0], o[1]); w[hh * 2 + 1] = cvt_pk_bf16(o[2], o[3]); }
                    *(u32x4*)(d2 + lane * 32 + c * 8) = w; }
            }
        }
    }
}
#undef FP4X8

DI void ph_dbg(PK p, int mode, const int wv) {
    PK_FRESH(p);
    const int tid = ltid(wv);
    const bf16_t* Ag = WSP(const bf16_t, WS_GA); const bf16_t* Bg = WSP(const bf16_t, WS_GB); const bf16_t* Qg = WSP(const bf16_t, WS_GQ); const bf16_t* Og = WSP(const bf16_t, WS_GO); const bf16_t* Sg = WSP(const bf16_t, WS_GS);
    const bf16_t* proj = WSP(const bf16_t, WS_PROJ); bf16_t* obuf = WSP(bf16_t, WS_OBUF);
    for (int idx = blockIdx.x * 512 + tid; idx < T * D; idx += gridDim.x * 512) {
        const int tok = idx >> 11, col = idx & 2047, hd = col >> 7, v = col & 127, b = tok >> 13, s = tok & 8191, n = s >> 6, i = s & 63;
        const size_t ci = (size_t)(b * 16 + hd) * 128 + n;
        float r = 0.f;
        if (mode == 1) r = bf2f(Og[ci * 8192 + i * 128 + v]) + bf2f(Qg[ci * 8192 + i * 128 + v]);
        if (mode == 2) r = bf2f(Ag[ci * 16384 + i * 128 + v]) + bf2f(Bg[ci * 16384 + (i + 64) * 128 + v]) + bf2f(Ag[ci * 16384 + (i + 64) * 128 + v]) + bf2f(Bg[ci * 16384 + i * 128 + v]);
        if (mode == 3) r = bf2f(Sg[ci * 16384 + i * 128 + v]) + bf2f(Sg[ci * 16384 + (i + 64) * 128 + v]);
        if (mode == 4) r = bf2f(proj[(size_t)tok * GINP + col]) + bf2f(proj[(size_t)tok * GINP + 2048 + col]) + bf2f(proj[(size_t)tok * GINP + 4096 + col]) + bf2f(proj[(size_t)tok * GINP + 6144 + col]) + ((col < 256) ? bf2f(proj[(size_t)tok * GINP + 8192 + col]) : 0.f);
        obuf[idx] = f2bf(r);
    }
}
#ifndef MK_AOUT
#define MK_AOUT obuf
#endif
constexpr int NPHASES = 1 + 1 + 2 * 9 + 2 * 8 + 1;

__global__ void __launch_bounds__(512, 2) mk_fwd(Params p_arg) {
    extern __shared__ __attribute__((aligned(16))) unsigned char lds[];
    PK p = (PK)__builtin_amdgcn_kernarg_segment_ptr();
    const int lo = p->ph_lo, hi = p->ph_hi;
    const int wv = __builtin_amdgcn_readfirstlane((int)threadIdx.x >> 6);
    volatile LAS unsigned* st = (volatile LAS unsigned*)((LAS unsigned char*)lds + LDS_BARW);
    if (wv == 0 && lane_id() == 0) { st[0] = 0u; st[1] = 0u; }
    __syncthreads();
    XcdBarrier bar; bar.bar = (unsigned*)(p->ws + WS_BAR); bar.x = 0; bar.st = st; bar.wv = wv;
    if (hi - lo > 1) bar = xcd_barrier_post((unsigned*)(p->ws + WS_BAR), st, wv);
    int ph = 0;
#define PH_BEGIN if (lo <= ph && ph < hi) { PK_FRESH(p);
#define PH_END   if (ph + 1 < hi) xcd_barrier(bar); } ++ph;
#define mod  WSP(const float, WS_MOD)
#define xcur WSP(bf16_t, WS_XCUR)
#define hbuf WSP(bf16_t, WS_HBUF)
#define obuf WSP(bf16_t, WS_OBUF)
#define G    ((int)gridDim.x)
#define bx   ((int)blockIdx.x)
#define modl (mod + l * 12288)

    PH_BEGIN ph_prologue(p, lds, wv); if (MK_DUP & 1) { __syncthreads(); ph_prologue(p, lds, wv); } PH_END

    for (int l = 0; l < DEPTH; ++l) {
        if (l == 0) { PH_BEGIN ph_norm<0>(p->in[0], nullptr, p->in[5], modl + 0 * D, modl + 1 * D, hbuf, nullptr, wv); PH_END }
        PH_BEGIN
            pg8::Gemm g; pg8::EpiMk E; E.mode = 0; E.xin = nullptr; E.xinb = nullptr; E.xout = nullptr; E.gate = nullptr; E.gmul = 1.f; E.xoutf = nullptr; E.O2 = nullptr; E.nrope = 0; E.cosT = WSP(const float, WS_COS); E.sinT = WSP(const float, WS_SIN);
            g.A = (l == 2) ? obuf : hbuf; g.M = T; g.K = D; g.ld = D; g.ksplit = 0;
            if (l < 2) { g.Bt = WSP(const bf16_t, WS_WIN) + (size_t)l * GINP * D; g.N = 8192; E.O = WSP(bf16_t, WS_PROJ); E.ldc = GINP; }
            else { g.Bt = WSP(const bf16_t, WS_DWQ) + (size_t)(l - 2) * D * D; g.N = D; E.mode = 2; E.O = WSP(bf16_t, WS_QD); E.nrope = D; }
            pg8::StaticOrder S; S.init(g.M, g.N, G, bx);
            pg8::gemm_phase<pg8::EpiMk, pg8::StaticOrder>((PG8_LAS unsigned char*)lds, g, S, E, wv);
            if (MK_DUP & 2) { __syncthreads(); pg8::gemm_phase<pg8::EpiMk, pg8::StaticOrder>((PG8_LAS unsigned char*)lds, g, S, E, wv); }
            if (l < 2) {
                pg8::Gemm g2; g2.A = hbuf; g2.Bt = WSP(const bf16_t, WS_WIN) + (size_t)l * GINP * D + (size_t)8192 * D; g2.M = T; g2.N = 1024; g2.K = 512; g2.ld = D; g2.ksplit = 1;
                pg8::EpiMk E2 = E; E2.mode = 3; E2.xoutf = WSP(float, WS_PAB);
                pg8::StaticOrder S2; S2.init(g2.M, g2.N, G, bx);
                pg8::gemm_phase<pg8::EpiMk, pg8::StaticOrder>((PG8_LAS unsigned char*)lds, g2, S2, E2, wv);
            }
        PH_END
        if (l < 2) {
            PH_BEGIN ph_gdn_p1(p, l, lds, wv); if (MK_DUP & 8) { __syncthreads(); ph_gdn_p1(p, l, lds, wv); } PH_END
            PH_BEGIN ph_gdn_p2(p, lds, wv); if (MK_DUP & 16) { __syncthreads(); ph_gdn_p2(p, lds, wv); } PH_END
#ifdef MK_DBG
            PH_BEGIN ph_dbg(p, MK_DBG, wv); PH_END
#else
            PH_BEGIN ph_gdn_p3(p, l, wv); if (MK_DUP & 32) { __syncthreads(); ph_gdn_p3(p, l, wv); } PH_END
#endif
        } else {
            PH_BEGIN ph_attn(p, lds, wv); if (MK_DUP & 64) { __syncthreads(); ph_attn(p, lds, wv); } PH_END
            PH_BEGIN ph_diff_combine(p, l - 2, l, lds, wv); PH_END
        }
        PH_BEGIN
            pg8::Gemm g; pg8::EpiMk E; E.mode = 1; E.O = nullptr; E.ldc = 0; E.xoutf = nullptr; E.O2 = nullptr; E.nrope = 0; E.cosT = nullptr; E.sinT = nullptr; E.xin = (l == 0) ? p->in[0] : nullptr; E.xinb = xcur; E.xout = xcur; E.gate = modl + 2 * D; E.gmul = ((MK_SKIP >> (2 * l)) & 1) ? 0.f : 1.f;
            g.A = MK_AOUT; g.M = T; g.K = D; g.N = D; g.ld = D; g.ksplit = 0;
            g.Bt = (l < 2) ? (WSP(const bf16_t, WS_WOUT) + (size_t)l * D * D) : (WSP(const bf16_t, WS_DWO) + (size_t)(l - 2) * D * D);
            pg8::StaticOrder S; S.init(g.M, g.N, G, bx);
            pg8::gemm_phase<pg8::EpiMk, pg8::StaticOrder>((PG8_LAS unsigned char*)lds, g, S, E, wv);
        PH_END
        PH_BEGIN ph_norm<2>(nullptr, xcur, p->in[6] + l * D, modl + 3 * D, modl + 4 * D, hbuf, nullptr, wv); PH_END
        PH_BEGIN
            pg8::Gemm g; pg8::EpiMk E; E.mode = 0; E.xin = nullptr; E.xinb = nullptr; E.xout = nullptr; E.gate = nullptr; E.gmul = 1.f; E.xoutf = nullptr; E.O2 = nullptr; E.nrope = 0; E.cosT = WSP(const float, WS_COS); E.sinT = WSP(const float, WS_SIN); E.O = WSP(bf16_t, WS_PQ); E.ldc = D;
            g.A = hbuf; g.M = T; g.K = D; g.N = D; g.ld = D; g.ksplit = 0; g.Bt = WSP(const bf16_t, WS_PWQ) + (size_t)l * D * D;
            pg8::StaticOrder S; S.init(g.M, g.N, G, bx);
            pg8::gemm_phase<pg8::EpiMk, pg8::StaticOrder>((PG8_LAS unsigned char*)lds, g, S, E, wv);
        PH_END
        PH_BEGIN ph_peer_topk(p, l, lds, wv); if (MK_DUP & 128) { __syncthreads(); ph_peer_topk(p, l, lds, wv); } PH_END
        PH_BEGIN ph_peer_gather(p, l, lds, wv); if (MK_DUP & 256) { __syncthreads(); ph_peer_gather(p, l, lds, wv, false); } PH_END
        if (l == 1) {
            PH_BEGIN
                pg8::Gemm g; pg8::EpiMk E; E.mode = 0; E.xin = nullptr; E.xinb = nullptr; E.xout = nullptr; E.gate = nullptr; E.gmul = 1.f; E.xoutf = nullptr; E.O2 = nullptr; E.nrope = 0; E.cosT = WSP(const float, WS_COS); E.sinT = WSP(const float, WS_SIN); E.mode = 2; E.O = WSP(bf16_t, WS_KSH); E.O2 = WSP(bf16_t, WS_VSH); E.nrope = 2048;
                g.A = hbuf; g.M = T; g.K = D; g.N = 4096; g.ld = D; g.ksplit = 0; g.Bt = WSP(const bf16_t, WS_KVW);
                pg8::StaticOrder S; S.init(g.M, g.N, G, bx);
                pg8::gemm_phase<pg8::EpiMk, pg8::StaticOrder>((PG8_LAS unsigned char*)lds, g, S, E, wv);
            PH_END
        }
    }
#undef PH_BEGIN
#undef PH_END
#undef mod
#undef xcur
#undef hbuf
#undef obuf
#undef G
#undef bx
#undef modl
}

extern "C" void kernel_launch(void* const* d_in, const int* in_sizes, int n_in, void* d_out, int out_size, void* d_ws, size_t ws_size, hipStream_t stream) {
    static int grid = 0;
    if (grid == 0) {
        if (n_in != 26 || in_sizes[0] != T * D || out_size != T * D || ws_size < WS_END) {
            fprintf(stderr, "kernel_launch: unexpected shapes: n_in %d in0 %d out %d ws %zu (need %zu)\n", n_in, n_in > 0 ? in_sizes[0] : -1, out_size, ws_size, (size_t)WS_END); grid = -1; return; }
        int dev = 0, cus = 0;
        if (hipGetDevice(&dev) != hipSuccess || hipDeviceGetAttribute(&cus, hipDeviceAttributeMultiprocessorCount, dev) != hipSuccess || cus <= 0) cus = 256;
        if (hipFuncSetAttribute((const void*)mk_fwd, hipFuncAttributeMaxDynamicSharedMemorySize, LDS_BYTES) != hipSuccess) { fprintf(stderr, "kernel_launch: hipFuncSetAttribute failed\n"); grid = -1; return; }
        int per_cu = 0;
        if (hipOccupancyMaxActiveBlocksPerMultiprocessor(&per_cu, (const void*)mk_fwd, 512, LDS_BYTES) != hipSuccess || per_cu < 1) fprintf(stderr, "kernel_launch: occupancy query says %d\n", per_cu);
        (void)hipGetLastError();
        grid = cus;
    }
    if (grid < 0) return;
    (void)hipMemsetAsync((char*)d_ws + WS_BAR, 0, 16384, stream);
    Params p{};
    for (int i = 0; i < 26; ++i) p.in[i] = (const float*)d_in[i];
    p.out = (float*)d_out; p.ws = (unsigned char*)d_ws;
#if MK_N_LAUNCHES == 1
    p.ph_lo = 0; p.ph_hi = NPHASES;
    hipLaunchKernelGGL(mk_fwd, dim3(grid), dim3(512), LDS_BYTES, stream, p);
#else
#ifndef MK_PHMASK
#define MK_PHMASK 0xffffffffu
#endif
#ifndef MK_STOP
#define MK_STOP NPHASES
#endif
    for (int ph = 0; ph < NPHASES; ++ph) { if (ph >= MK_STOP && ph != NPHASES - 1) continue; if (!(MK_PHMASK >> (ph < 31 ? ph : 31) & 1u) && ph != NPHASES - 1) continue; p.ph_lo = ph; p.ph_hi = ph + 1; hipLaunchKernelGGL(mk_fwd, dim3(grid), dim3(512), LDS_BYTES, stream, p); }
#endif
    const hipError_t le = hipPeekAtLastError();
    if (le != hipSuccess) fprintf(stderr, "kernel_launch: launch failed: %s\n", hipGetErrorName(le));
}
```
